# Optimizing an MI355X kernel written in HIP

```python
import math
import jax
import jax.numpy as jnp
from jax import lax
import numpy as np

D_MODEL = 1024
BATCH = 32
SEQ = 2048
DEPTH = 2

CHUNK = 64
Q_BLOCK = 128
ROPE_THETA = 10000.0
NORM_EPS = 1e-6

DA_HEADS = 4
DA_QK_DIM = 64
DA_V_DIM = 2 * DA_QK_DIM
DA_WIDTH = DA_HEADS * DA_V_DIM

HG_HEADS = 4
HG_DIM = 128
HG_WIDTH = HG_HEADS * HG_DIM

RW_HEADS = 8
RW_DIM = 64
RW_WIDTH = RW_HEADS * RW_DIM
RW_DECAY_LORA = 64
RW_A_LORA = 64
RW_V_LORA = 32
RW_GATE_LORA = 128
RW_GN_EPS = 64e-5
RW_COLS = (RW_WIDTH, RW_WIDTH, RW_WIDTH, RW_DECAY_LORA, RW_A_LORA, RW_GATE_LORA)
RW_SHIFT_WIDTH = sum(RW_COLS)
RW_SPLIT_IDX = tuple(np.cumsum(RW_COLS)[:-1].tolist())

N_BRANCHES = 3
FFN_HIDDEN = -(-8 * D_MODEL // (3 * 256)) * 256
ADA_WIDTH = 6 * D_MODEL

COL_SIZES = (
    2 * DA_HEADS * DA_QK_DIM, 2 * DA_HEADS * DA_QK_DIM, DA_WIDTH,
    HG_WIDTH, HG_WIDTH, HG_WIDTH, HG_WIDTH,
    RW_SHIFT_WIDTH,
    N_BRANCHES * D_MODEL,
)
IN_COLS = sum(COL_SIZES)
SPLIT_IDX = tuple(np.cumsum(COL_SIZES)[:-1].tolist())

kernel_name = "chunk_causal_hybrid_diffattn_hgrn2_rwkv7"


def rms_norm(x, w, eps=NORM_EPS):
    xf = x.astype(jnp.float32)
    y = xf * lax.rsqrt(jnp.mean(xf * xf, axis=-1, keepdims=True) + eps)
    return (y * w.astype(jnp.float32)).astype(x.dtype)


def rope_tables(positions):
    inv_freq = ROPE_THETA ** (-jnp.arange(0, DA_QK_DIM, 2, dtype=jnp.float32) / DA_QK_DIM)
    ang = positions.astype(jnp.float32)[..., None] * inv_freq
    return jnp.cos(ang), jnp.sin(ang)


def apply_rope(x, cos, sin):
    cos = cos[:, :, None, None, :]
    sin = sin[:, :, None, None, :]
    x1, x2 = jnp.split(x, 2, axis=-1)
    return jnp.concatenate([x1 * cos - x2 * sin, x2 * cos + x1 * sin], axis=-1)


def diff_attention(q, k, v, cos, sin, lam_vecs, subln_w, layer_idx):
    Bn, Sn = q.shape[0], q.shape[1]
    q = apply_rope(q.reshape(Bn, Sn, DA_HEADS, 2, DA_QK_DIM).astype(jnp.float32), cos, sin) * (DA_QK_DIM ** -0.5)
    k = apply_rope(k.reshape(Bn, Sn, DA_HEADS, 2, DA_QK_DIM).astype(jnp.float32), cos, sin)
    v = v.reshape(Bn, Sn, DA_HEADS, DA_V_DIM).astype(jnp.float32)
    lam_init = 0.8 - 0.6 * math.exp(-0.3 * layer_idx)
    lv = lam_vecs.astype(jnp.float32)
    lam = jnp.exp(jnp.sum(lv[0] * lv[1])) - jnp.exp(jnp.sum(lv[2] * lv[3])) + lam_init
    outs = []
    for blk in range(Sn // Q_BLOCK):
        start = blk * Q_BLOCK
        end = start + Q_BLOCK
        s = jnp.einsum('bqhme,bkhme->bhmqk', q[:, start:end], k[:, :end])
        q_chunk = (start + jnp.arange(Q_BLOCK)) // CHUNK
        k_chunk = jnp.arange(end) // CHUNK
        allowed = k_chunk[None, :] <= q_chunk[:, None]
        p = jax.nn.softmax(jnp.where(allowed, s, -jnp.inf), axis=-1)
        pd = p[:, :, 0] - lam * p[:, :, 1]
        outs.append(jnp.einsum('bhqk,bkhd->bqhd', pd, v[:, :end]))
    o = jnp.concatenate(outs, axis=1)
    o = rms_norm(o, subln_w) * (1.0 - lam_init)
    return o.reshape(Bn, Sn, DA_WIDTH)


def hgrn2(f_pre, i_in, q_in, g_in, lb, norm_w):
    Bn, Sn = f_pre.shape[0], f_pre.shape[1]
    nc = Sn // CHUNK
    z = f_pre.astype(jnp.float32)
    lb = lb.astype(jnp.float32)
    log_f = jnp.logaddexp(jnp.log(lb), jnp.log1p(-lb) + jax.nn.log_sigmoid(z))
    key = (1.0 - lb) * jax.nn.sigmoid(-z)

    def to_chunks(t):
        return t.astype(jnp.float32).reshape(Bn, nc, CHUNK, HG_HEADS, HG_DIM).transpose(1, 0, 3, 2, 4)

    causal = jnp.tril(jnp.ones((CHUNK, CHUNK), dtype=bool))

    def chunk_step(state, inp):
        qc, kc, vc, lfc = inp
        b = jnp.cumsum(lfc, axis=2)
        rel = jnp.where(causal[:, :, None], b[:, :, :, None, :] - b[:, :, None, :, :], -jnp.inf)
        scores = jnp.einsum('bhqd,bhkd,bhqkd->bhqk', qc, kc, jnp.exp(rel))
        o_intra = jnp.einsum('bhqk,bhkv->bhqv', scores, vc)
        o_inter = jnp.einsum('bhqd,bhdv->bhqv', qc * jnp.exp(b), state)
        b_last = b[:, :, -1:, :]
        new_state = jnp.exp(b_last)[:, :, 0, :, None] * state + jnp.einsum(
            'bhkd,bhkv->bhdv', kc * jnp.exp(b_last - b), vc)
        return new_state, o_intra + o_inter

    s0 = jnp.zeros((Bn, HG_HEADS, HG_DIM, HG_DIM), jnp.float32)
    _, o = lax.scan(chunk_step, s0, (to_chunks(q_in), to_chunks(key), to_chunks(i_in), to_chunks(log_f)))
    o = o.transpose(1, 0, 3, 2, 4).reshape(Bn, Sn, HG_HEADS, HG_DIM)
    g = jax.nn.silu(g_in.astype(jnp.float32)).reshape(Bn, Sn, HG_HEADS, HG_DIM)
    return (rms_norm(o, norm_w) * g).reshape(Bn, Sn, HG_WIDTH)


def rwkv7(u, mu, w0, w2, a0, a2, g2, k_k, k_a, r_k, gn_w, gn_b, v_first, v_res):
    Bn, Sn = u.shape[0], u.shape[1]
    u = u.astype(jnp.float32)
    u_prev = jnp.pad(u, ((0, 0), (1, 0), (0, 0)))[:, :-1]
    u = u + (u_prev - u) * mu
    r, k, v, w_lo, a_lo, g_lo = jnp.split(u, RW_SPLIT_IDX, axis=-1)
    w = -jax.nn.softplus(-(w0 + jnp.tanh(w_lo) @ w2)) - 0.5
    decay = jnp.exp(-jnp.exp(w))
    a = jax.nn.sigmoid(a0 + a_lo @ a2)
    g = jax.nn.sigmoid(g_lo) @ g2
    if v_res is None:
        v_first = v
    else:
        v0, v1, v2 = v_res
        v = v + (v_first - v) * jax.nn.sigmoid(v0 + (v @ v1) @ v2)

    def heads(t):
        return t.reshape(Bn, Sn, RW_HEADS, RW_DIM)

    kk = heads(k * k_k)
    kk = kk * lax.rsqrt(jnp.maximum(jnp.sum(kk * kk, axis=-1, keepdims=True), 1e-24))
    k = k * (1.0 + (a - 1.0) * k_a)
    r_h, k_h, v_h, w_h, a_h = heads(r), heads(k), heads(v), heads(decay), heads(a)

    def step(state, inp):
        r_t, w_t, k_t, v_t, kk_t, a_t = inp
        sa = jnp.einsum('bhvk,bhk->bhv', state, -kk_t)
        state = (state * w_t[:, :, None, :] + sa[..., None] * (kk_t * a_t)[:, :, None, :]
                 + v_t[..., None] * k_t[:, :, None, :])
        return state, jnp.einsum('bhvk,bhk->bhv', state, r_t)

    s0 = jnp.zeros((Bn, RW_HEADS, RW_DIM, RW_DIM), jnp.float32)
    xs = tuple(t.transpose(1, 0, 2, 3) for t in (r_h, w_h, k_h, v_h, kk, a_h))
    _, o = lax.scan(step, s0, xs)
    o = o.transpose(1, 0, 2, 3)
    mean = jnp.mean(o, axis=-1, keepdims=True)
    var = jnp.mean(jnp.square(o - mean), axis=-1, keepdims=True)
    o = (o - mean) * lax.rsqrt(var + RW_GN_EPS) * gn_w.reshape(RW_HEADS, RW_DIM) + gn_b.reshape(RW_HEADS, RW_DIM)
    o = o + jnp.sum(r_h * k_h * r_k, axis=-1, keepdims=True) * v_h
    return o.reshape(Bn, Sn, RW_WIDTH) * g, v_first


def setup_inputs(seed: int = 0) -> dict:
    key = jax.random.key(seed)
    keys = jax.random.split(key, 40)
    counter = [0]

    def nk():
        counter[0] += 1
        return keys[counter[0] - 1]

    def normal(shape, scale):
        return jax.random.normal(nk(), shape, jnp.float32) * scale

    L, D = DEPTH, D_MODEL
    x = normal((BATCH, SEQ, D), 1.0)
    c = normal((BATCH, D), 1.0)
    offset = jax.random.randint(nk(), (BATCH, 1), 0, 1024, dtype=jnp.int32)
    positions = offset + jnp.arange(SEQ, dtype=jnp.int32)[None, :]
    return {
        "x": x,
        "c": c,
        "positions": positions,
        "ada_w": normal((L, D, ADA_WIDTH), 0.5 * D ** -0.5),
        "ada_b": normal((L, ADA_WIDTH), 0.01),
        "norm_mix_w": 1.0 + normal((L, D), 0.05),
        "norm_ffn_w": 1.0 + normal((L, D), 0.05),
        "w_in": normal((L, D, IN_COLS), D ** -0.5),
        "da_lambda": normal((L, 4, DA_QK_DIM), 0.1),
        "da_subln_w": 1.0 + normal((L, DA_V_DIM), 0.05),
        "hg_lb": normal((L, HG_WIDTH), 0.5),
        "hg_norm_w": 1.0 + normal((L, HG_DIM), 0.05),
        "rw_mu": jax.random.uniform(nk(), (L, RW_SHIFT_WIDTH), jnp.float32, 0.0, 1.0),
        "rw_w0": jax.random.uniform(nk(), (L, RW_WIDTH), jnp.float32, -6.0, -1.0),
        "rw_w2": normal((L, RW_DECAY_LORA, RW_WIDTH), RW_DECAY_LORA ** -0.5),
        "rw_a0": normal((L, RW_WIDTH), 0.1),
        "rw_a2": normal((L, RW_A_LORA, RW_WIDTH), RW_A_LORA ** -0.5),
        "rw_g2": normal((L, RW_GATE_LORA, RW_WIDTH), RW_GATE_LORA ** -0.5),
        "rw_k_k": 0.85 + normal((L, RW_WIDTH), 0.05),
        "rw_k_a": 1.0 + normal((L, RW_WIDTH), 0.05),
        "rw_r_k": normal((L, RW_HEADS, RW_DIM), 0.1),
        "rw_gn_w": 1.0 + normal((L, RW_WIDTH), 0.05),
        "rw_gn_b": normal((L, RW_WIDTH), 0.01),
        "rw_v0": normal((L - 1, RW_WIDTH), 0.1),
        "rw_v1": normal((L - 1, RW_WIDTH, RW_V_LORA), RW_WIDTH ** -0.5),
        "rw_v2": normal((L - 1, RW_V_LORA, RW_WIDTH), RW_V_LORA ** -0.5),
        "w_branch_a": normal((L, DA_WIDTH, D), DA_WIDTH ** -0.5),
        "w_branch_b": normal((L, HG_WIDTH, D), HG_WIDTH ** -0.5),
        "w_branch_c": normal((L, RW_WIDTH, D), RW_WIDTH ** -0.5),
        "w_out": normal((L, D, D), D ** -0.5),
        "ffn_w_in": normal((L, D, 2 * FFN_HIDDEN), D ** -0.5),
        "ffn_w_out": normal((L, FFN_HIDDEN, D), FFN_HIDDEN ** -0.5),
        "final_norm_w": 1.0 + normal((D,), 0.05),
    }


def reference(x, c, positions, ada_w, ada_b, norm_mix_w, norm_ffn_w, w_in, da_lambda, da_subln_w,
              hg_lb, hg_norm_w, rw_mu, rw_w0, rw_w2, rw_a0, rw_a2, rw_g2, rw_k_k, rw_k_a, rw_r_k,
              rw_gn_w, rw_gn_b, rw_v0, rw_v1, rw_v2, w_branch_a, w_branch_b, w_branch_c, w_out,
              ffn_w_in, ffn_w_out, final_norm_w):
    dt = x.dtype
    cos, sin = rope_tables(positions)
    lb_all = jnp.cumsum(jax.nn.softmax(hg_lb.astype(jnp.float32), axis=0), axis=0)
    lb_all = lb_all - lb_all[0]
    c_act = jax.nn.silu(c.astype(jnp.float32))
    v_first = None
    for l in range(DEPTH):
        ada = c_act @ ada_w[l].astype(jnp.float32) + ada_b[l].astype(jnp.float32)
        shift1, scale1, gate1, shift2, scale2, gate2 = [t[:, None, :] for t in jnp.split(ada, 6, axis=-1)]

        h = rms_norm(x, norm_mix_w[l]).astype(jnp.float32) * (1.0 + scale1) + shift1
        u = h.astype(dt) @ w_in[l]
        da_q, da_k, da_v, hg_f, hg_i, hg_q, hg_g, rw_u, gates = jnp.split(u, SPLIT_IDX, axis=-1)
        o_a = diff_attention(da_q, da_k, da_v, cos, sin, da_lambda[l], da_subln_w[l], l)
        o_b = hgrn2(hg_f, hg_i, hg_q, hg_g, lb_all[l], hg_norm_w[l])
        v_res = None if l == 0 else (rw_v0[l - 1], rw_v1[l - 1], rw_v2[l - 1])
        o_c, v_first = rwkv7(rw_u, rw_mu[l], rw_w0[l], rw_w2[l], rw_a0[l], rw_a2[l], rw_g2[l],
                             rw_k_k[l], rw_k_a[l], rw_r_k[l], rw_gn_w[l], rw_gn_b[l], v_first, v_res)
        g_a, g_b, g_c = jnp.split(jax.nn.sigmoid(gates.astype(jnp.float32)), N_BRANCHES, axis=-1)
        merged = g_a * (o_a @ w_branch_a[l]) + g_b * (o_b @ w_branch_b[l]) + g_c * (o_c @ w_branch_c[l])
        mix = merged.astype(dt) @ w_out[l]
        x = x + (gate1 * mix).astype(dt)

        h = rms_norm(x, norm_ffn_w[l]).astype(jnp.float32) * (1.0 + scale2) + shift2
        gate_h, up_h = jnp.split(h.astype(dt) @ ffn_w_in[l], 2, axis=-1)
        ffn = (jax.nn.silu(gate_h) * up_h) @ ffn_w_out[l]
        x = x + (gate2 * ffn).astype(dt)
    return rms_norm(x, final_norm_w)
```

```cpp
#include <hip/hip_runtime.h>
#include <hip/hip_cooperative_groups.h>
#include <stdint.h>
#include <cstdio>
namespace cg = cooperative_groups;

typedef unsigned short bf16_t;
typedef short bf16x8 __attribute__((ext_vector_type(8)));
typedef float f32x4 __attribute__((ext_vector_type(4)));
#define DEV __device__ __forceinline__
#define PHASE __device__ __forceinline__

#ifndef SINGLE_LAUNCH
#define SINGLE_LAUNCH 1
#endif

constexpr int T_TOK = 65536, DM = 1024, SEQ = 2048, US = 4864, ADAW = 6144, FFH = 2816;
constexpr size_t WIN = 0, WBA = 8650752, WBB = 9175040, WBC = 9699328, WOUT = 10223616, WFI = 11272192,
                 WFO = 17039360, WLAYER = 19922944;
constexpr int SMEM_BYTES = 80896;
constexpr int NPHASE = 20;

struct Params {
  const float* x; const float* c; const int* pos;
  const float *ada_w, *ada_b, *norm_mix_w, *norm_ffn_w, *w_in, *da_lambda, *da_subln_w, *hg_lb, *hg_norm_w;
  const float *rw_mu, *rw_w0, *rw_w2, *rw_a0, *rw_a2, *rw_g2, *rw_k_k, *rw_k_a, *rw_r_k, *rw_gn_w, *rw_gn_b;
  const float *rw_v0, *rw_v1, *rw_v2, *w_br_a, *w_br_b, *w_br_c, *w_out, *ffn_w_in, *ffn_w_out, *final_norm_w;
  float* out;
  bf16_t* wt; float* ada; bf16_t* h; bf16_t* u; bf16_t* vT; bf16_t* vfirst; float* vlo; unsigned* counters;
};

DEV unsigned short f2bf(float f) { unsigned u = __float_as_uint(f); u += 0x7FFFu + ((u >> 16) & 1u); return (unsigned short)(u >> 16); }
DEV float bf2f(unsigned short h) { return __uint_as_float(((unsigned)h) << 16); }
DEV unsigned pack2(float a, float b) { return (unsigned)f2bf(a) | ((unsigned)f2bf(b) << 16); }
DEV float sigm(float x) { return 1.f / (1.f + __expf(-x)); }
DEV float lo16(unsigned v) { return __uint_as_float(v << 16); }
DEV float hi16(unsigned v) { return __uint_as_float(v & 0xFFFF0000u); }
#define UNPACK8(v, f) { f[0]=lo16(v.x); f[1]=hi16(v.x); f[2]=lo16(v.y); f[3]=hi16(v.y); f[4]=lo16(v.z); f[5]=hi16(v.z); f[6]=lo16(v.w); f[7]=hi16(v.w); }
#define PACK8(f) make_uint4(pack2(f[0],f[1]), pack2(f[2],f[3]), pack2(f[4],f[5]), pack2(f[6],f[7]))
template <int CTRL> DEV float dpp(float x) { return __int_as_float(__builtin_amdgcn_update_dpp(0, __float_as_int(x), CTRL, 0xF, 0xF, true)); }
DEV float red8_sum(float x) { x += dpp<0xB1>(x); x += dpp<0x4E>(x); x += dpp<0x141>(x); return x; }
DEV float red16_sum(float x) { x = red8_sum(x); x += dpp<0x140>(x); return x; }
DEV float red16_max(float x) { x = fmaxf(x, dpp<0xB1>(x)); x = fmaxf(x, dpp<0x4E>(x)); x = fmaxf(x, dpp<0x141>(x)); x = fmaxf(x, dpp<0x140>(x)); return x; }
DEV float wave_sum(float x) {
#pragma unroll
  for (int o = 32; o >= 1; o >>= 1) x += __shfl_xor(x, o, 64);
  return x;
}
DEV int opaque_tid() { int t = threadIdx.x; asm volatile("" : "+v"(t)); return t; }
DEV bf16x8 as_frag(uint4 v) { union { uint4 u; bf16x8 b; } c; c.u = v; return c.b; }
#define MFMA(a, b, c) __builtin_amdgcn_mfma_f32_16x16x32_bf16(a, b, c, 0, 0, 0)

template <int NT>
DEV void gemm_tile(const int tid, const bf16_t* __restrict__ A, int lda, const bf16_t* __restrict__ B, int ldb, int K, char* smem,
                   f32x4 (&acc)[4][NT]) {
  constexpr int BN = NT * 32;
  constexpr int LS = 72;
  bf16_t* As = (bf16_t*)smem;
  bf16_t* Bs = As + 2 * 128 * LS;
  const int lane = tid & 63, wave = tid >> 6, wr = wave >> 1, wc = wave & 1;
  const int fr = lane & 15, fq = lane >> 4;
  constexpr int NA = 4, NB = BN * 8 / 256;
  uint4 ra[NA], rb[NB];
#pragma unroll
  for (int m = 0; m < 4; ++m)
#pragma unroll
    for (int n = 0; n < NT; ++n) acc[m][n] = (f32x4){0.f, 0.f, 0.f, 0.f};
  const int nk = K >> 6;
  const int lrow = tid >> 3, lcc = tid & 7;
  const bf16_t* Ap = A + (size_t)lrow * lda + lcc * 8;
  const bf16_t* Bp = B + (size_t)lrow * ldb + lcc * 8;
#pragma unroll
  for (int i = 0; i < NA; ++i) ra[i] = *(const uint4*)(Ap + (size_t)(i * 32) * lda);
#pragma unroll
  for (int i = 0; i < NB; ++i) rb[i] = *(const uint4*)(Bp + (size_t)(i * 32) * ldb);
#pragma unroll
  for (int i = 0; i < NA; ++i) *(uint4*)(As + (lrow + i * 32) * LS + lcc * 8) = ra[i];
#pragma unroll
  for (int i = 0; i < NB; ++i) *(uint4*)(Bs + (lrow + i * 32) * LS + lcc * 8) = rb[i];
  __syncthreads();
  for (int kt = 0; kt < nk; ++kt) {
    const int buf = kt & 1;
    if (kt + 1 < nk) {
#pragma unroll
      for (int i = 0; i < NA; ++i) ra[i] = *(const uint4*)(Ap + (size_t)(i * 32) * lda + (kt + 1) * 64);
#pragma unroll
      for (int i = 0; i < NB; ++i) rb[i] = *(const uint4*)(Bp + (size_t)(i * 32) * ldb + (kt + 1) * 64);
    }
    const bf16_t* Ab = As + buf * 128 * LS + (wr * 64 + fr) * LS + fq * 8;
    const bf16_t* Bb = Bs + buf * BN * LS + (wc * (NT * 16) + fr) * LS + fq * 8;
#pragma unroll
    for (int ks = 0; ks < 2; ++ks) {
      bf16x8 af[4], bfr[NT];
#pragma unroll
      for (int m = 0; m < 4; ++m) af[m] = *(const bf16x8*)(Ab + m * 16 * LS + ks * 32);
#pragma unroll
      for (int n = 0; n < NT; ++n) bfr[n] = *(const bf16x8*)(Bb + n * 16 * LS + ks * 32);
#pragma unroll
      for (int m = 0; m < 4; ++m)
#pragma unroll
        for (int n = 0; n < NT; ++n) acc[m][n] = MFMA(af[m], bfr[n], acc[m][n]);
    }
    if (kt + 1 < nk) {
      bf16_t* Aw = As + (buf ^ 1) * 128 * LS;
      bf16_t* Bw = Bs + (buf ^ 1) * BN * LS;
#pragma unroll
      for (int i = 0; i < NA; ++i) *(uint4*)(Aw + (lrow + i * 32) * LS + lcc * 8) = ra[i];
#pragma unroll
      for (int i = 0; i < NB; ++i) *(uint4*)(Bw + (lrow + i * 32) * LS + lcc * 8) = rb[i];
    }
    __syncthreads();
  }
}

template <int NT>
DEV void stage_acc(const int tid, float* Cs, const f32x4 (&acc)[4][NT]) {
  constexpr int LDC = NT * 32 + 4;
  const int lane = tid & 63, wave = tid >> 6, wr = wave >> 1, wc = wave & 1, fr = lane & 15, fq = lane >> 4;
#pragma unroll
  for (int m = 0; m < 4; ++m)
#pragma unroll
    for (int n = 0; n < NT; ++n)
#pragma unroll
      for (int j = 0; j < 4; ++j) Cs[(wr * 64 + m * 16 + fq * 4 + j) * LDC + wc * (NT * 16) + n * 16 + fr] = acc[m][n][j];
}

DEV bool tile_for(int it, int nM, int nN, int& tm, int& tn) {
  const int nx = gridDim.x >> 3;
  const int xcd = blockIdx.x & 7, local = blockIdx.x >> 3;
  const long id = ((long)it * 8 + xcd) * nx + local;
  if (local >= nx || id >= (long)nM * nN) return false;
  const int per_group = 8 * nN;
  const int g = (int)(id / per_group), r = (int)(id % per_group);
  tn = r >> 3; tm = g * 8 + (r & 7);
  return true;
}

PHASE void phase_prep(const Params& p, char* smem) {
  const int tid = opaque_tid();
  if (blockIdx.x == 0 && tid < 8) p.counters[tid] = 0u;
  float* tile = (float*)smem;
  const int NCONV = 2 * 4864, NADA = 192;
  for (int item = blockIdx.x; item < NCONV + NADA; item += gridDim.x) {
    if (item < NCONV) {
      const int l = item / 4864; int r = item % 4864;
      const float* src; int K, Nsrc, nT, perm = 0; size_t dst;
      if (r < 2112) { src = p.w_in + (size_t)l * 1024 * 8448; K = 1024; Nsrc = 8448; dst = WIN; nT = 132; }
      else if (r < 2240) { r -= 2112; src = p.w_br_a + (size_t)l * 512 * 1024; K = 512; Nsrc = 1024; dst = WBA; nT = 16; }
      else if (r < 2368) { r -= 2240; src = p.w_br_b + (size_t)l * 512 * 1024; K = 512; Nsrc = 1024; dst = WBB; nT = 16; }
      else if (r < 2496) { r -= 2368; src = p.w_br_c + (size_t)l * 512 * 1024; K = 512; Nsrc = 1024; dst = WBC; nT = 16; }
      else if (r < 2752) { r -= 2496; src = p.w_out + (size_t)l * 1024 * 1024; K = 1024; Nsrc = 1024; dst = WOUT; nT = 16; }
      else if (r < 4160) { r -= 2752; src = p.ffn_w_in + (size_t)l * 1024 * 5632; K = 1024; Nsrc = 5632; dst = WFI; nT = 88; perm = 1; }
      else { r -= 4160; src = p.ffn_w_out + (size_t)l * 2816 * 1024; K = 2816; Nsrc = 1024; dst = WFO; nT = 16; }
      const int kt = r / nT, nt = r % nT;
      const int colbase = perm ? ((nt & 1) * FFH + 64 * (nt >> 1)) : nt * 64;
      __syncthreads();
#pragma unroll
      for (int i = 0; i < 16; ++i) {
        const int k = i * 4 + (tid >> 6), j = tid & 63;
        tile[k * 65 + j] = src[(size_t)(kt * 64 + k) * Nsrc + colbase + j];
      }
      __syncthreads();
      const int row = tid >> 2, kc = (tid & 3) * 16;
      float f[16];
#pragma unroll
      for (int i = 0; i < 16; ++i) f[i] = tile[(kc + i) * 65 + row];
      bf16_t* d = p.wt + (size_t)l * WLAYER + dst + (size_t)(nt * 64 + row) * K + kt * 64 + kc;
      *(uint4*)d = make_uint4(pack2(f[0], f[1]), pack2(f[2], f[3]), pack2(f[4], f[5]), pack2(f[6], f[7]));
      *(uint4*)(d + 8) = make_uint4(pack2(f[8], f[9]), pack2(f[10], f[11]), pack2(f[12], f[13]), pack2(f[14], f[15]));
    } else {
      const int a = item - NCONV;
      const int l = a / 96, r = a % 96, ntile = r >> 2, bg = r & 3;
      float* cact = (float*)smem;
      __syncthreads();
      for (int i = tid; i < 8 * 1024; i += 256) {
        const float cv = p.c[(size_t)(bg * 8 + (i >> 10)) * DM + (i & 1023)];
        cact[i] = cv * sigm(cv);
      }
      __syncthreads();
      const int n = ntile * 256 + tid;
      const float* W = p.ada_w + (size_t)l * DM * ADAW + n;
      float acc[8];
#pragma unroll
      for (int b = 0; b < 8; ++b) acc[b] = 0.f;
      for (int k = 0; k < DM; ++k) {
        const float w = W[(size_t)k * ADAW];
#pragma unroll
        for (int b = 0; b < 8; ++b) acc[b] += cact[b * 1024 + k] * w;
      }
      const float bias = p.ada_b[l * ADAW + n];
#pragma unroll
      for (int b = 0; b < 8; ++b) p.ada[((size_t)l * 32 + bg * 8 + b) * ADAW + n] = acc[b] + bias;
    }
  }
}

PHASE void phase_norm(const float* __restrict__ x, const float* __restrict__ w, const float* __restrict__ ada_l,
                    int shift_off, int scale_off, bf16_t* __restrict__ h) {
  const int tid = opaque_tid();
  const int lane = tid & 63, wave = tid >> 6;
  for (int row = blockIdx.x * 4 + wave; row < T_TOK; row += gridDim.x * 4) {
    const float* xr = x + (size_t)row * DM;
    float4 v[4]; float ss = 0.f;
#pragma unroll
    for (int i = 0; i < 4; ++i) { v[i] = *(const float4*)(xr + i * 256 + lane * 4); ss += v[i].x * v[i].x + v[i].y * v[i].y + v[i].z * v[i].z + v[i].w * v[i].w; }
    ss = wave_sum(ss);
    const float rstd = rsqrtf(ss * (1.f / DM) + 1e-6f);
    const float* ad = ada_l + (size_t)(row / SEQ) * ADAW;
#pragma unroll
    for (int i = 0; i < 4; ++i) {
      const int col = i * 256 + lane * 4;
      const float4 ww = *(const float4*)(w + col), sc = *(const float4*)(ad + scale_off + col), sh = *(const float4*)(ad + shift_off + col);
      const float o0 = v[i].x * rstd * ww.x * (1.f + sc.x) + sh.x, o1 = v[i].y * rstd * ww.y * (1.f + sc.y) + sh.y;
      const float o2 = v[i].z * rstd * ww.z * (1.f + sc.z) + sh.z, o3 = v[i].w * rstd * ww.w * (1.f + sc.w) + sh.w;
      *(uint2*)(h + (size_t)row * DM + col) = make_uint2(pack2(o0, o1), pack2(o2, o3));
    }
  }
}

PHASE void phase_final(float* __restrict__ x, const float* __restrict__ w) {
  const int tid = opaque_tid();
  const int lane = tid & 63, wave = tid >> 6;
  for (int row = blockIdx.x * 4 + wave; row < T_TOK; row += gridDim.x * 4) {
    float* xr = x + (size_t)row * DM;
    float4 v[4]; float ss = 0.f;
#pragma unroll
    for (int i = 0; i < 4; ++i) { v[i] = *(const float4*)(xr + i * 256 + lane * 4); ss += v[i].x * v[i].x + v[i].y * v[i].y + v[i].z * v[i].z + v[i].w * v[i].w; }
    ss = wave_sum(ss);
    const float rstd = rsqrtf(ss * (1.f / DM) + 1e-6f);
#pragma unroll
    for (int i = 0; i < 4; ++i) {
      const int col = i * 256 + lane * 4;
      const float4 ww = *(const float4*)(w + col);
      *(float4*)(xr + col) = make_float4(v[i].x * rstd * ww.x, v[i].y * rstd * ww.y, v[i].z * rstd * ww.z, v[i].w * rstd * ww.w);
    }
  }
}

PHASE void phase_gemm_in(const Params& p, int l, char* smem) {
  const bf16_t* Wt = p.wt + (size_t)l * WLAYER + WIN;
  float* Cs = (float*)smem;
  const int tid = opaque_tid();
  for (int it = 0;; ++it) {
    int tm, tn;
    if (!tile_for(it, 512, 42, tm, tn)) break;
    f32x4 acc[4][4];
    gemm_tile<4>(tid, p.h + (size_t)tm * 128 * DM, DM, Wt + (size_t)tn * 128 * DM, DM, DM, smem, acc);
    stage_acc<4>(tid, Cs, acc);
    __syncthreads();
    const size_t row0 = (size_t)tm * 128;
    if (tn < 8) {
      const float qs = (tn < 4) ? 0.125f : 1.f;
      const int ch = tid & 15, g = ch >> 3, cc = ch & 7;
      if (cc < 4) {
#pragma unroll 1
        for (int i = 0; i < 8; ++i) {
          const int r = (tid >> 4) + i * 16;
          const float pos = (float)p.pos[row0 + r];
          const float* c1 = Cs + r * 132 + g * 64 + cc * 8;
          float o1[8], o2[8];
#pragma unroll
          for (int e = 0; e < 8; ++e) {
            const float x1 = c1[e], x2 = c1[32 + e];
            const float inv = exp2f(-(float)(cc * 8 + e) * 0.41524101186092029f);
            float rev = pos * inv * 0.15915494309189535f;
            rev -= rintf(rev);
            const float s = __builtin_amdgcn_sinf(rev), c = __builtin_amdgcn_cosf(rev);
            o1[e] = (x1 * c - x2 * s) * qs; o2[e] = (x2 * c + x1 * s) * qs;
          }
          bf16_t* d = p.u + (row0 + r) * US + tn * 128 + g * 64 + cc * 8;
          *(uint4*)d = PACK8(o1);
          *(uint4*)(d + 32) = PACK8(o2);
        }
      }
    } else if (tn < 12) {
      const int b = (int)(row0 / SEQ), s0 = (int)(row0 % SEQ), vc0 = (tn - 8) * 128;
      const int rch = tid & 15;
#pragma unroll 1
      for (int i = 0; i < 8; ++i) {
        const int c = (tid >> 4) + i * 16;
        float f[8];
#pragma unroll
        for (int j = 0; j < 8; ++j) f[j] = Cs[(rch * 8 + j) * 132 + c];
        *(uint4*)(p.vT + ((size_t)b * 512 + vc0 + c) * SEQ + s0 + rch * 8) = PACK8(f);
      }
    } else {
      const int ch = tid & 15;
#pragma unroll 1
      for (int i = 0; i < 8; ++i) {
        const int r = (tid >> 4) + i * 16;
        const float4 a = *(const float4*)(Cs + r * 132 + ch * 8), b = *(const float4*)(Cs + r * 132 + ch * 8 + 4);
        *(uint4*)(p.u + (row0 + r) * US + tn * 128 - 512 + ch * 8) = make_uint4(pack2(a.x, a.y), pack2(a.z, a.w), pack2(b.x, b.y), pack2(b.z, b.w));
      }
    }
    __syncthreads();
  }
}

PHASE void phase_vlo(const Params& p, int l, char* smem) {
  float* vs = (float*)smem;
  const int tid = opaque_tid();
  const float* mu = p.rw_mu + (size_t)l * 1792 + 1024;
  const float* v1 = p.rw_v1;
  for (int item = blockIdx.x; item < T_TOK / 32; item += gridDim.x) {
    const size_t tok0 = (size_t)item * 32;
    __syncthreads();
#pragma unroll 1
    for (int i = 0; i < 8; ++i) {
      const int c = tid + i * 256;
      const int t = c >> 6, cc = c & 63;
      const size_t tok = tok0 + t;
      const uint4 cur = *(const uint4*)(p.u + tok * US + 3072 + 1024 + cc * 8);
      uint4 prv = make_uint4(0, 0, 0, 0);
      if ((tok % SEQ) != 0) prv = *(const uint4*)(p.u + (tok - 1) * US + 3072 + 1024 + cc * 8);
      float a[8], b[8];
      UNPACK8(cur, a); UNPACK8(prv, b);
#pragma unroll
      for (int e = 0; e < 8; ++e) vs[t * 512 + cc * 8 + e] = a[e] + (b[e] - a[e]) * mu[cc * 8 + e];
    }
    __syncthreads();
    const int j = tid & 31, tg = tid >> 5;
    float acc[4] = {0.f, 0.f, 0.f, 0.f};
    for (int k = 0; k < 512; ++k) {
      const float w = v1[k * 32 + j];
#pragma unroll
      for (int i = 0; i < 4; ++i) acc[i] += vs[(tg * 4 + i) * 512 + k] * w;
    }
#pragma unroll
    for (int i = 0; i < 4; ++i) p.vlo[(tok0 + tg * 4 + i) * 32 + j] = acc[i];
  }
}

PHASE void att_item(const Params& p, int l, int item, char* smem) {
  const int qc = 31 - (item >> 7);
  const int bh = item & 127, b = bh >> 2, h = bh & 3;
  const int tid = opaque_tid(), lane = tid & 63, wave = tid >> 6, fr = lane & 15, fq = lane >> 4;
  const int m = wave >> 1, rh = wave & 1;
  bf16_t* Ks = (bf16_t*)smem;
  bf16_t* Vt = Ks + 2 * 64 * 72;
  bf16_t* Ps = Vt + 128 * 72;
  float* Ox = (float*)smem;
  const size_t tok0 = (size_t)b * SEQ + (size_t)qc * 64;
  const float* lv = p.da_lambda + (size_t)l * 256;
  float d1 = 0.f, d2 = 0.f;
  for (int i = 0; i < 64; ++i) { d1 += lv[i] * lv[64 + i]; d2 += lv[128 + i] * lv[192 + i]; }
  const float lam_init = 0.8f - 0.6f * __expf(-0.3f * (float)l);
  const float lam = __expf(d1) - __expf(d2) + lam_init;

  bf16x8 qf[2][2];
#pragma unroll
  for (int mt = 0; mt < 2; ++mt)
#pragma unroll
    for (int ks = 0; ks < 2; ++ks)
      qf[mt][ks] = *(const bf16x8*)(p.u + (tok0 + rh * 32 + mt * 16 + fr) * US + h * 128 + m * 64 + ks * 32 + fq * 8);
  f32x4 o[2][8];
  float mx[2][4], ls[2][4];
#pragma unroll
  for (int mt = 0; mt < 2; ++mt) {
#pragma unroll
    for (int n = 0; n < 8; ++n) o[mt][n] = (f32x4){0.f, 0.f, 0.f, 0.f};
#pragma unroll
    for (int j = 0; j < 4; ++j) { mx[mt][j] = -1e30f; ls[mt][j] = 0.f; }
  }
  bf16_t* Pw = Ps + wave * 32 * 72;
  for (int kt = 0; kt <= qc; ++kt) {
    __syncthreads();
#pragma unroll
    for (int i = 0; i < 4; ++i) {
      const int c = tid + i * 256;
      const int mm = c >> 9, key = (c >> 3) & 63, cc = c & 7;
      *(uint4*)(Ks + (mm * 64 + key) * 72 + cc * 8) =
          *(const uint4*)(p.u + ((size_t)b * SEQ + kt * 64 + key) * US + 512 + h * 128 + mm * 64 + cc * 8);
    }
#pragma unroll
    for (int i = 0; i < 4; ++i) {
      const int c = tid + i * 256;
      const int dim = c >> 3, cc = c & 7;
      *(uint4*)(Vt + dim * 72 + cc * 8) = *(const uint4*)(p.vT + ((size_t)b * 512 + h * 128 + dim) * SEQ + kt * 64 + cc * 8);
    }
    __syncthreads();
    f32x4 s[2][4];
#pragma unroll
    for (int mt = 0; mt < 2; ++mt)
#pragma unroll
      for (int n = 0; n < 4; ++n) s[mt][n] = (f32x4){0.f, 0.f, 0.f, 0.f};
#pragma unroll
    for (int ks = 0; ks < 2; ++ks)
#pragma unroll
      for (int n = 0; n < 4; ++n) {
        const bf16x8 kf = *(const bf16x8*)(Ks + (m * 64 + n * 16 + fr) * 72 + ks * 32 + fq * 8);
#pragma unroll
        for (int mt = 0; mt < 2; ++mt) s[mt][n] = MFMA(qf[mt][ks], kf, s[mt][n]);
      }
#pragma unroll
    for (int mt = 0; mt < 2; ++mt)
#pragma unroll
      for (int j = 0; j < 4; ++j) {
        float tmax = fmaxf(fmaxf(s[mt][0][j], s[mt][1][j]), fmaxf(s[mt][2][j], s[mt][3][j]));
        tmax = red16_max(tmax);
        const float mnew = fmaxf(mx[mt][j], tmax);
        const float alpha = __expf(mx[mt][j] - mnew);
        float rs = 0.f;
#pragma unroll
        for (int n = 0; n < 4; ++n) {
          const float pv = __expf(s[mt][n][j] - mnew);
          rs += pv;
          Pw[(mt * 16 + fq * 4 + j) * 72 + n * 16 + fr] = f2bf(pv);
        }
        rs = red16_sum(rs);
        ls[mt][j] = ls[mt][j] * alpha + rs;
        mx[mt][j] = mnew;
#pragma unroll
        for (int n = 0; n < 8; ++n) o[mt][n][j] *= alpha;
      }
    __syncthreads();
#pragma unroll
    for (int ks = 0; ks < 2; ++ks) {
      bf16x8 pf[2];
#pragma unroll
      for (int mt = 0; mt < 2; ++mt) pf[mt] = *(const bf16x8*)(Pw + (mt * 16 + fr) * 72 + ks * 32 + fq * 8);
#pragma unroll
      for (int n = 0; n < 8; ++n) {
        const bf16x8 vf = *(const bf16x8*)(Vt + (n * 16 + fr) * 72 + ks * 32 + fq * 8);
#pragma unroll
        for (int mt = 0; mt < 2; ++mt) o[mt][n] = MFMA(pf[mt], vf, o[mt][n]);
      }
    }
  }
  __syncthreads();
#pragma unroll
  for (int mt = 0; mt < 2; ++mt)
#pragma unroll
    for (int j = 0; j < 4; ++j) {
      const float inv = 1.f / ls[mt][j];
#pragma unroll
      for (int n = 0; n < 8; ++n) o[mt][n][j] *= inv;
    }
  if (m == 1) {
#pragma unroll
    for (int mt = 0; mt < 2; ++mt)
#pragma unroll
      for (int n = 0; n < 8; ++n)
#pragma unroll
        for (int j = 0; j < 4; ++j) Ox[(rh * 32 + mt * 16 + fq * 4 + j) * 132 + n * 16 + fr] = o[mt][n][j];
  }
  __syncthreads();
  if (m == 0) {
    const float* sw = p.da_subln_w + (size_t)l * 128;
    float wv[8];
#pragma unroll
    for (int n = 0; n < 8; ++n) wv[n] = sw[n * 16 + fr] * (1.f - lam_init);
#pragma unroll
    for (int mt = 0; mt < 2; ++mt)
#pragma unroll
      for (int j = 0; j < 4; ++j) {
        float ss = 0.f;
        float d[8];
#pragma unroll
        for (int n = 0; n < 8; ++n) {
          d[n] = o[mt][n][j] - lam * Ox[(rh * 32 + mt * 16 + fq * 4 + j) * 132 + n * 16 + fr];
          ss += d[n] * d[n];
        }
        ss = red16_sum(ss);
        const float rstd = rsqrtf(ss * (1.f / 128.f) + 1e-6f);
        bf16_t* dst = p.u + (tok0 + rh * 32 + mt * 16 + fq * 4 + j) * US + h * 128 + fr;
#pragma unroll
        for (int n = 0; n < 8; ++n) dst[n * 16] = f2bf(d[n] * rstd * wv[n]);
      }
  }
  __syncthreads();
}

PHASE void hgrn_item(const Params& p, int l, int item, char* smem) {
  const int b = item >> 2, h = item & 3;
  const int tid = opaque_tid(), lane = tid & 63, wave = tid >> 6, fr = lane & 15, fq = lane >> 4;
  bf16_t* Qs = (bf16_t*)smem;
  bf16_t* Kn = Qs + 32 * 136;
  bf16_t* KT = Kn + 32 * 136;
  bf16_t* VT = KT + 128 * 40;
  bf16_t* Ps = VT + 128 * 40;
  bf16_t* ST = Ps + 32 * 40;
  float* lfb = (float*)ST;
  float* red = (float*)(ST + 128 * 136);
  float* blast = red + 64;
  const int t_ = tid >> 3, d0 = (tid & 7) * 16;
  float lbv[16];
#pragma unroll
  for (int i = 0; i < 16; ++i) {
    const int c = h * 128 + d0 + i;
    lbv[i] = (l == 0) ? 0.f : sigm(p.hg_lb[512 + c] - p.hg_lb[c]);
  }
  f32x4 S[2][8];
#pragma unroll
  for (int mm = 0; mm < 2; ++mm)
#pragma unroll
    for (int n = 0; n < 8; ++n) S[mm][n] = (f32x4){0.f, 0.f, 0.f, 0.f};
  const float* nw = p.hg_norm_w + (size_t)l * 128;

  for (int ch = 0; ch < 64; ++ch) {
    const size_t tok0 = (size_t)b * SEQ + (size_t)ch * 32;
    __syncthreads();
    float qv[16], kv[16];
    {
      const bf16_t* base = p.u + (tok0 + t_) * US + h * 128 + d0;
      float zv[16], iv[16];
      { const uint4 a = *(const uint4*)(base + 1024), c = *(const uint4*)(base + 1024 + 8); float* z0 = zv; float* z1 = zv + 8; UNPACK8(a, z0); UNPACK8(c, z1); }
      { const uint4 a = *(const uint4*)(base + 1536), c = *(const uint4*)(base + 1536 + 8); float* z0 = iv; float* z1 = iv + 8; UNPACK8(a, z0); UNPACK8(c, z1); }
      { const uint4 a = *(const uint4*)(base + 2048), c = *(const uint4*)(base + 2048 + 8); float* z0 = qv; float* z1 = qv + 8; UNPACK8(a, z0); UNPACK8(c, z1); }
#pragma unroll
      for (int i = 0; i < 16; ++i) {
        const float z = zv[i], lb = lbv[i];
        const float ez = __expf(-fabsf(z));
        float lf;
        if (lb > 0.f) {
          const float sg = (z >= 0.f) ? 1.f / (1.f + ez) : ez / (1.f + ez);
          lf = __logf(lb + (1.f - lb) * sg);
        } else {
          lf = -(fmaxf(-z, 0.f) + __logf(1.f + ez));
        }
        const float sgn = (z >= 0.f) ? ez / (1.f + ez) : 1.f / (1.f + ez);
        kv[i] = (1.f - lb) * sgn;
        lfb[t_ * 128 + d0 + i] = lf;
        VT[(d0 + i) * 40 + t_] = f2bf(iv[i]);
      }
    }
    __syncthreads();
    if (tid < 128) {
      float bsum = 0.f;
#pragma unroll 8
      for (int t = 0; t < 32; ++t) { bsum += lfb[t * 128 + tid]; lfb[t * 128 + tid] = bsum; }
      blast[tid] = bsum;
    }
    __syncthreads();
    {
      float qo[16], ko[16];
#pragma unroll
      for (int i = 0; i < 16; ++i) {
        const float bb = lfb[t_ * 128 + d0 + i];
        qo[i] = qv[i] * __expf(bb);
        ko[i] = kv[i] * __expf(fminf(-bb, 80.f));
        KT[(d0 + i) * 40 + t_] = f2bf(ko[i]);
      }
      float* q0 = qo; float* q1 = qo + 8; float* k0 = ko; float* k1 = ko + 8;
      *(uint4*)(Qs + t_ * 136 + d0) = PACK8(q0);
      *(uint4*)(Qs + t_ * 136 + d0 + 8) = PACK8(q1);
      *(uint4*)(Kn + t_ * 136 + d0) = PACK8(k0);
      *(uint4*)(Kn + t_ * 136 + d0 + 8) = PACK8(k1);
    }
    __syncthreads();
#pragma unroll
    for (int mm = 0; mm < 2; ++mm)
#pragma unroll
      for (int n = 0; n < 8; ++n)
        *(uint2*)(ST + (n * 16 + fr) * 136 + wave * 32 + mm * 16 + fq * 4) =
            make_uint2(pack2(S[mm][n][0], S[mm][n][1]), pack2(S[mm][n][2], S[mm][n][3]));
    {
      const int mt = wave >> 1, nt = wave & 1;
      f32x4 sc = (f32x4){0.f, 0.f, 0.f, 0.f};
#pragma unroll
      for (int ks = 0; ks < 4; ++ks) {
        const bf16x8 a = *(const bf16x8*)(Qs + (mt * 16 + fr) * 136 + ks * 32 + fq * 8);
        const bf16x8 bb = *(const bf16x8*)(Kn + (nt * 16 + fr) * 136 + ks * 32 + fq * 8);
        sc = MFMA(a, bb, sc);
      }
#pragma unroll
      for (int j = 0; j < 4; ++j) {
        const int t = mt * 16 + fq * 4 + j, key = nt * 16 + fr;
        Ps[t * 40 + key] = f2bf(key <= t ? sc[j] : 0.f);
      }
    }
    __syncthreads();
    {
      const int mt = wave & 1, nb = (wave >> 1) * 4;
      f32x4 oo[4];
#pragma unroll
      for (int n = 0; n < 4; ++n) oo[n] = (f32x4){0.f, 0.f, 0.f, 0.f};
      {
        const bf16x8 a = *(const bf16x8*)(Ps + (mt * 16 + fr) * 40 + fq * 8);
#pragma unroll
        for (int n = 0; n < 4; ++n) {
          const bf16x8 bb = *(const bf16x8*)(VT + ((nb + n) * 16 + fr) * 40 + fq * 8);
          oo[n] = MFMA(a, bb, oo[n]);
        }
      }
#pragma unroll
      for (int ks = 0; ks < 4; ++ks) {
        const bf16x8 a = *(const bf16x8*)(Qs + (mt * 16 + fr) * 136 + ks * 32 + fq * 8);
#pragma unroll
        for (int n = 0; n < 4; ++n) {
          const bf16x8 bb = *(const bf16x8*)(ST + ((nb + n) * 16 + fr) * 136 + ks * 32 + fq * 8);
          oo[n] = MFMA(a, bb, oo[n]);
        }
      }
#pragma unroll
      for (int j = 0; j < 4; ++j) {
        float ss = 0.f;
#pragma unroll
        for (int n = 0; n < 4; ++n) ss += oo[n][j] * oo[n][j];
        ss = red16_sum(ss);
        if (fr == 0) red[(mt * 16 + fq * 4 + j) * 2 + (wave >> 1)] = ss;
      }
      __syncthreads();
#pragma unroll
      for (int j = 0; j < 4; ++j) {
        const int t = mt * 16 + fq * 4 + j;
        const float rstd = rsqrtf((red[t * 2] + red[t * 2 + 1]) * (1.f / 128.f) + 1e-6f);
        bf16_t* gp = p.u + (tok0 + t) * US + 2560 + h * 128 + nb * 16 + fr;
#pragma unroll
        for (int n = 0; n < 4; ++n) {
          const float g = bf2f(gp[n * 16]);
          gp[n * 16] = f2bf(oo[n][j] * rstd * nw[(nb + n) * 16 + fr] * (g * sigm(g)));
        }
      }
    }
    {
      bf16x8 af[2];
#pragma unroll
      for (int mm = 0; mm < 2; ++mm) af[mm] = *(const bf16x8*)(KT + (wave * 32 + mm * 16 + fr) * 40 + fq * 8);
#pragma unroll
      for (int n = 0; n < 8; ++n) {
        const bf16x8 bb = *(const bf16x8*)(VT + (n * 16 + fr) * 40 + fq * 8);
#pragma unroll
        for (int mm = 0; mm < 2; ++mm) S[mm][n] = MFMA(af[mm], bb, S[mm][n]);
      }
#pragma unroll
      for (int mm = 0; mm < 2; ++mm)
#pragma unroll
        for (int j = 0; j < 4; ++j) {
          const float e = __expf(blast[wave * 32 + mm * 16 + fq * 4 + j]);
#pragma unroll
          for (int n = 0; n < 8; ++n) S[mm][n][j] *= e;
        }
    }
  }
  __syncthreads();
}

DEV bf16x8 rw_afrag(const bf16_t* u, size_t tok, int col, const float* mu, int mode) {
  const uint4 cur = *(const uint4*)(u + tok * US + 3072 + col);
  uint4 prv = make_uint4(0, 0, 0, 0);
  if ((tok % SEQ) != 0) prv = *(const uint4*)(u + (tok - 1) * US + 3072 + col);
  float a[8], b[8], o[8];
  UNPACK8(cur, a); UNPACK8(prv, b);
#pragma unroll
  for (int e = 0; e < 8; ++e) {
    float v = a[e] + (b[e] - a[e]) * mu[col + e];
    if (mode == 1) { const float t = __expf(-2.f * fabsf(v)); const float th = (1.f - t) / (1.f + t); v = (v >= 0.f) ? th : -th; }
    else if (mode == 2) v = sigm(v);
    o[e] = v;
  }
  return as_frag(PACK8(o));
}
DEV bf16x8 rw_bfrag(const float* W, int k0, int col) {
  float o[8];
#pragma unroll
  for (int e = 0; e < 8; ++e) o[e] = W[(size_t)(k0 + e) * 512 + col];
  return as_frag(PACK8(o));
}

PHASE void rwkv_item(const Params& p, int l, int item, char* smem) {
  const int b = item >> 3, h = item & 7;
  const int tid = opaque_tid(), lane = tid & 63, wave = tid >> 6, fr = lane & 15, fq = lane >> 4;
  float* R = (float*)smem;
  float* W = R + 2048; float* K = W + 2048; float* KK = K + 2048; float* BB = KK + 2048;
  float* V = BB + 2048; float* G = V + 2048; float* O = G + 2048;
  float* carry = O + 2048;
  const float* mu = p.rw_mu + (size_t)l * 1792;
  const int hc_n = h * 64 + wave * 16 + fr;
  bf16x8 w2f[2], a2f[2], g2f[4], v2f;
#pragma unroll
  for (int ks = 0; ks < 2; ++ks) {
    w2f[ks] = rw_bfrag(p.rw_w2 + (size_t)l * 64 * 512, ks * 32 + fq * 8, hc_n);
    a2f[ks] = rw_bfrag(p.rw_a2 + (size_t)l * 64 * 512, ks * 32 + fq * 8, hc_n);
  }
#pragma unroll
  for (int ks = 0; ks < 4; ++ks) g2f[ks] = rw_bfrag(p.rw_g2 + (size_t)l * 128 * 512, ks * 32 + fq * 8, hc_n);
  v2f = w2f[0];
  if (l > 0) v2f = rw_bfrag(p.rw_v2, fq * 8, hc_n);
  const float w0c = p.rw_w0[l * 512 + hc_n], a0c = p.rw_a0[l * 512 + hc_n];
  const float v0c = (l > 0) ? p.rw_v0[hc_n] : 0.f;
  const int t_ = tid >> 3, n0 = (tid & 7) * 8;
  float* cst = carry + 128;
  __syncthreads();
  if (tid < 64) {
    const int hc = h * 64 + tid;
    cst[tid] = p.rw_k_k[l * 512 + hc]; cst[64 + tid] = p.rw_k_a[l * 512 + hc]; cst[128 + tid] = p.rw_r_k[l * 512 + hc];
    cst[192 + tid] = p.rw_gn_w[l * 512 + hc]; cst[256 + tid] = p.rw_gn_b[l * 512 + hc];
    cst[320 + tid] = mu[hc]; cst[384 + tid] = mu[512 + hc]; cst[448 + tid] = mu[1024 + hc];
  }
  const float* kkc = cst + n0; const float* kac = cst + 64 + n0; const float* rkc = cst + 128 + n0;
  const float* gnw = cst + 192 + n0; const float* gnb = cst + 256 + n0;
  const float* mur = cst + 320 + n0; const float* muk = cst + 384 + n0; const float* muv = cst + 448 + n0;
  const int kq = lane & 7, row0 = wave * 16 + (lane >> 3), row1 = row0 + 8;
  float S0[8], S1[8];
#pragma unroll
  for (int e = 0; e < 8; ++e) { S0[e] = 0.f; S1[e] = 0.f; }

  for (int ch = 0; ch < 64; ++ch) {
    const size_t tok0 = (size_t)b * SEQ + (size_t)ch * 32;
    __syncthreads();
#pragma unroll
    for (int mt = 0; mt < 2; ++mt) {
      const size_t tok = tok0 + mt * 16 + fr;
      f32x4 aw = (f32x4){0.f, 0.f, 0.f, 0.f}, aa = aw, ag = aw, av = aw;
#pragma unroll
      for (int ks = 0; ks < 2; ++ks) {
        aw = MFMA(rw_afrag(p.u, tok, 1536 + ks * 32 + fq * 8, mu, 1), w2f[ks], aw);
        aa = MFMA(rw_afrag(p.u, tok, 1600 + ks * 32 + fq * 8, mu, 0), a2f[ks], aa);
      }
#pragma unroll
      for (int ks = 0; ks < 4; ++ks) ag = MFMA(rw_afrag(p.u, tok, 1664 + ks * 32 + fq * 8, mu, 2), g2f[ks], ag);
      if (l > 0) {
        const float4 x0 = *(const float4*)(p.vlo + tok * 32 + fq * 8), x1 = *(const float4*)(p.vlo + tok * 32 + fq * 8 + 4);
        const uint4 pk = make_uint4(pack2(x0.x, x0.y), pack2(x0.z, x0.w), pack2(x1.x, x1.y), pack2(x1.z, x1.w));
        av = MFMA(as_frag(pk), v2f, av);
      }
#pragma unroll
      for (int j = 0; j < 4; ++j) {
        const int t = mt * 16 + fq * 4 + j, n = wave * 16 + fr;
        const float wv = -(w0c + aw[j]);
        const float sp = fmaxf(wv, 0.f) + __logf(1.f + __expf(-fabsf(wv)));
        const float wl = -sp - 0.5f;
        W[t * 64 + n] = __expf(-__expf(wl));
        BB[t * 64 + n] = sigm(a0c + aa[j]);
        G[t * 64 + n] = ag[j];
        if (l > 0) O[t * 64 + n] = sigm(v0c + av[j]);
      }
    }
    {
      const size_t tok = tok0 + t_;
      const bf16_t* cu = p.u + tok * US + 3072 + h * 64 + n0;
      const bool first = (tok % SEQ) == 0;
      float cr[8], ck[8], cv[8], pr[8], pk[8], pv[8];
      { const uint4 x = *(const uint4*)cu; UNPACK8(x, cr); }
      { const uint4 x = *(const uint4*)(cu + 512); UNPACK8(x, ck); }
      { const uint4 x = *(const uint4*)(cu + 1024); UNPACK8(x, cv); }
      if (first) {
#pragma unroll
        for (int e = 0; e < 8; ++e) { pr[e] = 0.f; pk[e] = 0.f; pv[e] = 0.f; }
      } else {
        { const uint4 x = *(const uint4*)(cu - US + 512); UNPACK8(x, pk); }
        { const uint4 x = *(const uint4*)(cu - US + 1024); UNPACK8(x, pv); }
        if (t_ == 0) {
#pragma unroll
          for (int e = 0; e < 8; ++e) pr[e] = carry[(ch & 1) * 64 + n0 + e];
        } else { const uint4 x = *(const uint4*)(cu - US); UNPACK8(x, pr); }
      }
      if (t_ == 31) {
#pragma unroll
        for (int e = 0; e < 8; ++e) carry[((ch + 1) & 1) * 64 + n0 + e] = cr[e];
      }
      float vs[8];
#pragma unroll
      for (int e = 0; e < 8; ++e) {
        R[t_ * 64 + n0 + e] = cr[e] + (pr[e] - cr[e]) * mur[e];
        K[t_ * 64 + n0 + e] = ck[e] + (pk[e] - ck[e]) * muk[e];
        vs[e] = cv[e] + (pv[e] - cv[e]) * muv[e];
        V[t_ * 64 + n0 + e] = vs[e];
      }
      if (l == 0) *(uint4*)(p.vfirst + tok * 512 + h * 64 + n0) = PACK8(vs);
    }
    __syncthreads();
    {
      const size_t tok = tok0 + t_;
      float kx[8], kkv[8], ss = 0.f;
#pragma unroll
      for (int e = 0; e < 8; ++e) { kx[e] = K[t_ * 64 + n0 + e]; kkv[e] = kx[e] * kkc[e]; ss += kkv[e] * kkv[e]; }
      ss = red8_sum(ss);
      const float rn = rsqrtf(fmaxf(ss, 1e-24f));
#pragma unroll
      for (int e = 0; e < 8; ++e) {
        const float a = BB[t_ * 64 + n0 + e];
        const float kn = kkv[e] * rn;
        K[t_ * 64 + n0 + e] = kx[e] * (1.f + (a - 1.f) * kac[e]);
        KK[t_ * 64 + n0 + e] = kn;
        BB[t_ * 64 + n0 + e] = kn * a;
      }
      if (l > 0) {
        const uint4 x = *(const uint4*)(p.vfirst + tok * 512 + h * 64 + n0);
        float vf[8]; UNPACK8(x, vf);
#pragma unroll
        for (int e = 0; e < 8; ++e) {
          const float v = V[t_ * 64 + n0 + e];
          V[t_ * 64 + n0 + e] = v + (vf[e] - v) * O[t_ * 64 + n0 + e];
        }
      }
    }
    __syncthreads();
#pragma unroll 2
    for (int t = 0; t < 32; ++t) {
      const float* base = R + t * 64 + kq * 8;
      const float4 r0 = *(const float4*)(base), r1 = *(const float4*)(base + 4);
      const float4 w0 = *(const float4*)(base + 2048), w1 = *(const float4*)(base + 2048 + 4);
      const float4 k0 = *(const float4*)(base + 4096), k1 = *(const float4*)(base + 4096 + 4);
      const float4 q0 = *(const float4*)(base + 6144), q1 = *(const float4*)(base + 6144 + 4);
      const float4 b0 = *(const float4*)(base + 8192), b1 = *(const float4*)(base + 8192 + 4);
      const float va = V[t * 64 + row0], vb = V[t * 64 + row1];
      const float rr[8] = {r0.x, r0.y, r0.z, r0.w, r1.x, r1.y, r1.z, r1.w};
      const float ww[8] = {w0.x, w0.y, w0.z, w0.w, w1.x, w1.y, w1.z, w1.w};
      const float kk_[8] = {k0.x, k0.y, k0.z, k0.w, k1.x, k1.y, k1.z, k1.w};
      const float qq[8] = {q0.x, q0.y, q0.z, q0.w, q1.x, q1.y, q1.z, q1.w};
      const float bb[8] = {b0.x, b0.y, b0.z, b0.w, b1.x, b1.y, b1.z, b1.w};
      float sa0 = 0.f, sa1 = 0.f;
#pragma unroll
      for (int e = 0; e < 8; ++e) { sa0 += S0[e] * qq[e]; sa1 += S1[e] * qq[e]; }
      sa0 = -red8_sum(sa0); sa1 = -red8_sum(sa1);
      float o0 = 0.f, o1 = 0.f;
#pragma unroll
      for (int e = 0; e < 8; ++e) {
        S0[e] = S0[e] * ww[e] + sa0 * bb[e] + va * kk_[e];
        S1[e] = S1[e] * ww[e] + sa1 * bb[e] + vb * kk_[e];
        o0 += S0[e] * rr[e]; o1 += S1[e] * rr[e];
      }
      o0 = red8_sum(o0); o1 = red8_sum(o1);
      if (kq == 0) { O[t * 64 + row0] = o0; O[t * 64 + row1] = o1; }
    }
    __syncthreads();
    {
      const size_t tok = tok0 + t_;
      float ov[8], s1 = 0.f, bon = 0.f;
#pragma unroll
      for (int e = 0; e < 8; ++e) {
        ov[e] = O[t_ * 64 + n0 + e]; s1 += ov[e];
        bon += R[t_ * 64 + n0 + e] * K[t_ * 64 + n0 + e] * rkc[e];
      }
      s1 = red8_sum(s1); bon = red8_sum(bon);
      const float mean = s1 * (1.f / 64.f);
      float s2 = 0.f;
#pragma unroll
      for (int e = 0; e < 8; ++e) { const float d = ov[e] - mean; s2 += d * d; }
      s2 = red8_sum(s2);
      const float rstd = rsqrtf(s2 * (1.f / 64.f) + 64e-5f);
      float y[8];
#pragma unroll
      for (int e = 0; e < 8; ++e)
        y[e] = ((ov[e] - mean) * rstd * gnw[e] + gnb[e] + bon * V[t_ * 64 + n0 + e]) * G[t_ * 64 + n0 + e];
      *(uint4*)(p.u + tok * US + 3072 + h * 64 + n0) = PACK8(y);
    }
  }
  __syncthreads();
}

PHASE void phase_mix(const Params& p, int l, char* smem) {
  int* sitem = (int*)(smem + SMEM_BYTES - 16);
  const int tid0 = opaque_tid();
  while (true) {
    __syncthreads();
    if (tid0 == 0) *sitem = (int)atomicAdd(p.counters + l * 4 + 0, 1u);
    __syncthreads();
    const int item = *sitem;
    if (item >= 256) break;
    rwkv_item(p, l, item, smem);
  }
  while (true) {
    __syncthreads();
    if (tid0 == 0) *sitem = (int)atomicAdd(p.counters + l * 4 + 1, 1u);
    __syncthreads();
    const int item = *sitem;
    if (item >= 128) break;
    hgrn_item(p, l, item, smem);
  }
  while (true) {
    __syncthreads();
    if (tid0 == 0) *sitem = (int)atomicAdd(p.counters + l * 4 + 2, 1u);
    __syncthreads();
    const int item = *sitem;
    if (item >= 4096) break;
    att_item(p, l, item, smem);
  }
}

PHASE void phase_merge(const Params& p, int l, char* smem) {
  const bf16_t* Wl = p.wt + (size_t)l * WLAYER;
  float* Cs = (float*)smem;
  const int tid = opaque_tid();
  for (int it = 0;; ++it) {
    int tm, tn;
    if (!tile_for(it, 512, 16, tm, tn)) break;
    const size_t row0 = (size_t)tm * 128;
    f32x4 acc[4][2], G[4][2], M[4][2];
#pragma unroll
    for (int m = 0; m < 4; ++m)
#pragma unroll
      for (int n = 0; n < 2; ++n) M[m][n] = (f32x4){0.f, 0.f, 0.f, 0.f};
#pragma unroll 1
    for (int br = 0; br < 3; ++br) {
      gemm_tile<2>(tid, p.h + row0 * DM, DM, Wl + WIN + (size_t)(5376 + br * 1024 + tn * 64) * DM, DM, DM, smem, acc);
#pragma unroll
      for (int m = 0; m < 4; ++m)
#pragma unroll
        for (int n = 0; n < 2; ++n)
#pragma unroll
          for (int j = 0; j < 4; ++j) G[m][n][j] = sigm(acc[m][n][j]);
      const int aoff = (br == 0) ? 0 : (br == 1 ? 2560 : 3072);
      const size_t woff = (br == 0) ? WBA : (br == 1 ? WBB : WBC);
      gemm_tile<2>(tid, p.u + row0 * US + aoff, US, Wl + woff + (size_t)(tn * 64) * 512, 512, 512, smem, acc);
#pragma unroll
      for (int m = 0; m < 4; ++m)
#pragma unroll
        for (int n = 0; n < 2; ++n)
#pragma unroll
          for (int j = 0; j < 4; ++j) M[m][n][j] += G[m][n][j] * acc[m][n][j];
    }
    stage_acc<2>(tid, Cs, M);
    __syncthreads();
    {
      const int ch = tid & 7;
#pragma unroll 1
      for (int i = 0; i < 4; ++i) {
        const int r = (tid >> 3) + i * 32;
        const float4 a = *(const float4*)(Cs + r * 68 + ch * 8), b = *(const float4*)(Cs + r * 68 + ch * 8 + 4);
        *(uint4*)(p.u + (row0 + r) * US + 1024 + tn * 64 + ch * 8) = make_uint4(pack2(a.x, a.y), pack2(a.z, a.w), pack2(b.x, b.y), pack2(b.z, b.w));
      }
    }
    __syncthreads();
  }
}

PHASE void phase_gemm_res(const bf16_t* A, int lda, const bf16_t* Wt, int K, const float* xin, float* xout,
                        const float* ada_l, int gate_off, char* smem) {
  float* Cs = (float*)smem;
  const int tid = opaque_tid();
  for (int it = 0;; ++it) {
    int tm, tn;
    if (!tile_for(it, 512, 8, tm, tn)) break;
    const size_t row0 = (size_t)tm * 128;
    f32x4 acc[4][4];
    gemm_tile<4>(tid, A + row0 * lda, lda, Wt + (size_t)(tn * 128) * K, K, K, smem, acc);
    stage_acc<4>(tid, Cs, acc);
    __syncthreads();
    const float* gate = ada_l + (size_t)(row0 / SEQ) * ADAW + gate_off + tn * 128;
    const int c4 = (tid & 31) * 4;
    const float4 gv = *(const float4*)(gate + c4);
#pragma unroll 1
    for (int i = 0; i < 16; ++i) {
      const int r = (tid >> 5) + i * 8;
      const float4 cv = *(const float4*)(Cs + r * 132 + c4);
      const size_t off = (row0 + r) * DM + tn * 128 + c4;
      const float4 xv = *(const float4*)(xin + off);
      *(float4*)(xout + off) = make_float4(xv.x + gv.x * cv.x, xv.y + gv.y * cv.y, xv.z + gv.z * cv.z, xv.w + gv.w * cv.w);
    }
    __syncthreads();
  }
}

PHASE void phase_ffn_in(const Params& p, int l, char* smem) {
  const bf16_t* Wt = p.wt + (size_t)l * WLAYER + WFI;
  float* Cs = (float*)smem;
  const int tid = opaque_tid();
  for (int it = 0;; ++it) {
    int tm, tn;
    if (!tile_for(it, 512, 44, tm, tn)) break;
    const size_t row0 = (size_t)tm * 128;
    f32x4 acc[4][4];
    gemm_tile<4>(tid, p.h + row0 * DM, DM, Wt + (size_t)(tn * 128) * DM, DM, DM, smem, acc);
    stage_acc<4>(tid, Cs, acc);
    __syncthreads();
    const int ch = tid & 7;
#pragma unroll 1
    for (int i = 0; i < 4; ++i) {
      const int r = (tid >> 3) + i * 32;
      const float* cp = Cs + r * 132 + ch * 8;
      float o[8];
#pragma unroll
      for (int e = 0; e < 8; ++e) { const float g = cp[e], uu = cp[64 + e]; o[e] = g * sigm(g) * uu; }
      *(uint4*)(p.u + (row0 + r) * FFH + tn * 64 + ch * 8) = PACK8(o);
    }
    __syncthreads();
  }
}

__global__ void __launch_bounds__(256, 2) mega(Params p_in, int ph_lo, int ph_hi) {
  extern __shared__ __attribute__((aligned(16))) char smem[];
  cg::grid_group grid = cg::this_grid();
  const Params& p = p_in;
  bool first = true;
#define RUN(ph) if ((ph) >= ph_lo && (ph) < ph_hi)
#define SYNC { if (!first) grid.sync(); first = false; }
  RUN(0) { SYNC; phase_prep(p, smem); }
#pragma unroll 1
  for (int l = 0; l < 2; ++l) {
    const int base = 1 + 9 * l;
    const float* ada_l = p.ada + (size_t)l * 32 * ADAW;
    const bf16_t* Wl = p.wt + (size_t)l * WLAYER;
    const float* xin = (l == 0) ? p.x : p.out;
    RUN(base + 0) { SYNC; phase_norm(xin, p.norm_mix_w + l * DM, ada_l, 0, 1024, p.h); }
    RUN(base + 1) { SYNC; phase_gemm_in(p, l, smem); }
    RUN(base + 2) { SYNC; if (l > 0) phase_vlo(p, l, smem); }
    RUN(base + 3) { SYNC; phase_mix(p, l, smem); }
    RUN(base + 4) { SYNC; phase_merge(p, l, smem); }
    RUN(base + 5) { SYNC; phase_gemm_res(p.u + 1024, US, Wl + WOUT, DM, xin, p.out, ada_l, 2048, smem); }
    RUN(base + 6) { SYNC; phase_norm(p.out, p.norm_ffn_w + l * DM, ada_l, 3072, 4096, p.h); }
    RUN(base + 7) { SYNC; phase_ffn_in(p, l, smem); }
    RUN(base + 8) { SYNC; phase_gemm_res(p.u, FFH, Wl + WFO, FFH, p.out, p.out, ada_l, 5120, smem); }
  }
  RUN(NPHASE - 1) { SYNC; phase_final(p.out, p.final_norm_w); }
}

extern "C" void kernel_launch(void* const* d_in, const int* in_sizes, int n_in, void* d_out, int out_size, void* d_ws,
                              size_t ws_size, hipStream_t stream) {
  Params p{};
  p.x = (const float*)d_in[0]; p.c = (const float*)d_in[1]; p.pos = (const int*)d_in[2];
  p.ada_w = (const float*)d_in[3]; p.ada_b = (const float*)d_in[4]; p.norm_mix_w = (const float*)d_in[5];
  p.norm_ffn_w = (const float*)d_in[6]; p.w_in = (const float*)d_in[7]; p.da_lambda = (const float*)d_in[8];
  p.da_subln_w = (const float*)d_in[9]; p.hg_lb = (const float*)d_in[10]; p.hg_norm_w = (const float*)d_in[11];
  p.rw_mu = (const float*)d_in[12]; p.rw_w0 = (const float*)d_in[13]; p.rw_w2 = (const float*)d_in[14];
  p.rw_a0 = (const float*)d_in[15]; p.rw_a2 = (const float*)d_in[16]; p.rw_g2 = (const float*)d_in[17];
  p.rw_k_k = (const float*)d_in[18]; p.rw_k_a = (const float*)d_in[19]; p.rw_r_k = (const float*)d_in[20];
  p.rw_gn_w = (const float*)d_in[21]; p.rw_gn_b = (const float*)d_in[22]; p.rw_v0 = (const float*)d_in[23];
  p.rw_v1 = (const float*)d_in[24]; p.rw_v2 = (const float*)d_in[25]; p.w_br_a = (const float*)d_in[26];
  p.w_br_b = (const float*)d_in[27]; p.w_br_c = (const float*)d_in[28]; p.w_out = (const float*)d_in[29];
  p.ffn_w_in = (const float*)d_in[30]; p.ffn_w_out = (const float*)d_in[31]; p.final_norm_w = (const float*)d_in[32];
  p.out = (float*)d_out;
  char* ws = (char*)d_ws;
  size_t off = 0;
  auto take = [&](size_t bytes) { char* r = ws + off; off += (bytes + 255) & ~(size_t)255; return r; };
  p.counters = (unsigned*)take(256);
  p.wt = (bf16_t*)take(2 * WLAYER * 2);
  p.ada = (float*)take((size_t)2 * 32 * ADAW * 4);
  p.h = (bf16_t*)take((size_t)T_TOK * DM * 2);
  p.u = (bf16_t*)take((size_t)T_TOK * US * 2);
  p.vT = (bf16_t*)take((size_t)T_TOK * 512 * 2);
  p.vfirst = (bf16_t*)take((size_t)T_TOK * 512 * 2);
  p.vlo = (float*)take((size_t)T_TOK * 32 * 4);
  if (off > ws_size) { fprintf(stderr, "workspace too small: need %zu have %zu\n", off, ws_size); return; }

  static int grid_blocks = 0;
  if (!grid_blocks) {
    hipFuncSetAttribute((const void*)mega, hipFuncAttributeMaxDynamicSharedMemorySize, SMEM_BYTES);
    int dev = 0, cus = 0, per_cu = 0;
    hipGetDevice(&dev);
    hipDeviceGetAttribute(&cus, hipDeviceAttributeMultiprocessorCount, dev);
    hipOccupancyMaxActiveBlocksPerMultiprocessor(&per_cu, mega, 256, SMEM_BYTES);
    if (per_cu > 2) per_cu = 2;
    if (per_cu < 1) per_cu = 1;
    grid_blocks = cus * per_cu;
  }
#if SINGLE_LAUNCH
  int lo = 0, hi = NPHASE;
  void* args[] = {&p, &lo, &hi};
  hipError_t e = hipLaunchCooperativeKernel((void*)mega, dim3(grid_blocks), dim3(256), args, SMEM_BYTES, stream);
  if (e != hipSuccess) fprintf(stderr, "cooperative launch failed: %s (grid %d)\n", hipGetErrorString(e), grid_blocks);
#else
  for (int ph = 0; ph < NPHASE; ++ph) {
    if (ph == 3) continue;
    hipLaunchKernelGGL(mega, dim3(grid_blocks), dim3(256), SMEM_BYTES, stream, p, ph, ph + 1);
  }
#endif
}
```

```cpp
#include <hip/hip_runtime.h>
#include <hip/hip_cooperative_groups.h>
#include <stdint.h>
#include <cstdio>
namespace cg = cooperative_groups;

typedef unsigned short bf16_t;
typedef short bf16x8 __attribute__((ext_vector_type(8)));
typedef float f32x4 __attribute__((ext_vector_type(4)));
#define DEV __device__ __forceinline__
#define PHASE __device__ __forceinline__

#ifndef SINGLE_LAUNCH
#define SINGLE_LAUNCH 1
#endif

constexpr int T_TOK = 65536, DM = 1024, SEQ = 2048, US = 4864, ADAW = 6144, FFH = 2816;
constexpr size_t WIN = 0, WBA = 8650752, WBB = 9175040, WBC = 9699328, WOUT = 10223616, WFI = 11272192,
                 WFO = 17039360, WLAYER = 19922944;
constexpr int SMEM_BYTES = 80896;
constexpr int NPHASE = 20;

struct Params {
  const float* x; const float* c; const int* pos;
  const float *ada_w, *ada_b, *norm_mix_w, *norm_ffn_w, *w_in, *da_lambda, *da_subln_w, *hg_lb, *hg_norm_w;
  const float *rw_mu, *rw_w0, *rw_w2, *rw_a0, *rw_a2, *rw_g2, *rw_k_k, *rw_k_a, *rw_r_k, *rw_gn_w, *rw_gn_b;
  const float *rw_v0, *rw_v1, *rw_v2, *w_br_a, *w_br_b, *w_br_c, *w_out, *ffn_w_in, *ffn_w_out, *final_norm_w;
  float* out;
  bf16_t* wt; float* ada; bf16_t* h; bf16_t* u; bf16_t* vT; bf16_t* vfirst; float* vlo; unsigned* counters;
};

DEV unsigned short f2bf(float f) { unsigned u = __float_as_uint(f); u += 0x7FFFu + ((u >> 16) & 1u); return (unsigned short)(u >> 16); }
DEV float bf2f(unsigned short h) { return __uint_as_float(((unsigned)h) << 16); }
DEV unsigned pack2(float a, float b) { return (unsigned)f2bf(a) | ((unsigned)f2bf(b) << 16); }
DEV float sigm(float x) { return 1.f / (1.f + __expf(-x)); }
DEV float lo16(unsigned v) { return __uint_as_float(v << 16); }
DEV float hi16(unsigned v) { return __uint_as_float(v & 0xFFFF0000u); }
#define UNPACK8(v, f) { f[0]=lo16(v.x); f[1]=hi16(v.x); f[2]=lo16(v.y); f[3]=hi16(v.y); f[4]=lo16(v.z); f[5]=hi16(v.z); f[6]=lo16(v.w); f[7]=hi16(v.w); }
#define PACK8(f) make_uint4(pack2(f[0],f[1]), pack2(f[2],f[3]), pack2(f[4],f[5]), pack2(f[6],f[7]))
template <int CTRL> DEV float dpp(float x) { return __int_as_float(__builtin_amdgcn_update_dpp(0, __float_as_int(x), CTRL, 0xF, 0xF, true)); }
DEV float red8_sum(float x) { x += dpp<0xB1>(x); x += dpp<0x4E>(x); x += dpp<0x141>(x); return x; }
DEV float red16_sum(float x) { x = red8_sum(x); x += dpp<0x140>(x); return x; }
DEV float red16_max(float x) { x = fmaxf(x, dpp<0xB1>(x)); x = fmaxf(x, dpp<0x4E>(x)); x = fmaxf(x, dpp<0x141>(x)); x = fmaxf(x, dpp<0x140>(x)); return x; }
DEV float wave_sum(float x) {
#pragma unroll
  for (int o = 32; o >= 1; o >>= 1) x += __shfl_xor(x, o, 64);
  return x;
}
DEV int opaque_tid() { int t = threadIdx.x; asm volatile("" : "+v"(t)); return t; }
DEV bf16x8 as_frag(uint4 v) { union { uint4 u; bf16x8 b; } c; c.u = v; return c.b; }
#define MFMA(a, b, c) __builtin_amdgcn_mfma_f32_16x16x32_bf16(a, b, c, 0, 0, 0)

template <int NT>
DEV void gemm_tile(const int tid, const bf16_t* A, int lda, const bf16_t* B, int ldb, int K, char* smem,
                   f32x4 (&acc)[4][NT]) {
  constexpr int BN = NT * 32;
  constexpr int LS = 72;
  bf16_t* As = (bf16_t*)smem;
  bf16_t* Bs = As + 2 * 128 * LS;
  const int lane = tid & 63, wave = tid >> 6, wr = wave >> 1, wc = wave & 1;
  const int fr = lane & 15, fq = lane >> 4;
  constexpr int NB = BN * 8 / 256;
#pragma unroll
  for (int m = 0; m < 4; ++m)
#pragma unroll
    for (int n = 0; n < NT; ++n) acc[m][n] = (f32x4){0.f, 0.f, 0.f, 0.f};
  const int nk = K >> 6;
  const int lrow = tid >> 3, lcc = tid & 7;
  const bf16_t* Ap = A + (size_t)lrow * lda + lcc * 8;
  const bf16_t* Bp = B + (size_t)lrow * ldb + lcc * 8;
  const size_t a32 = (size_t)32 * lda, b32 = (size_t)32 * ldb;
  uint4 ra0, ra1, ra2, ra3, rb0, rb1, rb2, rb3;
#define GT_LOAD(koff)                                                                      \
  ra0 = *(const uint4*)(Ap + (koff)); ra1 = *(const uint4*)(Ap + a32 + (koff));            \
  ra2 = *(const uint4*)(Ap + 2 * a32 + (koff)); ra3 = *(const uint4*)(Ap + 3 * a32 + (koff)); \
  rb0 = *(const uint4*)(Bp + (koff)); rb1 = *(const uint4*)(Bp + b32 + (koff));            \
  if (NB > 2) { rb2 = *(const uint4*)(Bp + 2 * b32 + (koff)); rb3 = *(const uint4*)(Bp + 3 * b32 + (koff)); }
#define GT_STORE(Aw, Bw)                                                                   \
  *(uint4*)((Aw) + (lrow) * LS + lcc * 8) = ra0; *(uint4*)((Aw) + (lrow + 32) * LS + lcc * 8) = ra1;   \
  *(uint4*)((Aw) + (lrow + 64) * LS + lcc * 8) = ra2; *(uint4*)((Aw) + (lrow + 96) * LS + lcc * 8) = ra3; \
  *(uint4*)((Bw) + (lrow) * LS + lcc * 8) = rb0; *(uint4*)((Bw) + (lrow + 32) * LS + lcc * 8) = rb1;   \
  if (NB > 2) { *(uint4*)((Bw) + (lrow + 64) * LS + lcc * 8) = rb2; *(uint4*)((Bw) + (lrow + 96) * LS + lcc * 8) = rb3; }
  GT_LOAD(0)
  GT_STORE(As, Bs)
  __syncthreads();
  for (int kt = 0; kt < nk; ++kt) {
    const int buf = kt & 1;
    const int kn = (kt + 1 < nk) ? (kt + 1) : kt;
    GT_LOAD(kn * 64)
    asm volatile("" ::: "memory");
    __builtin_amdgcn_sched_barrier(0);
    const bf16_t* Ab = As + buf * 128 * LS + (wr * 64 + fr) * LS + fq * 8;
    const bf16_t* Bb = Bs + buf * BN * LS + (wc * (NT * 16) + fr) * LS + fq * 8;
#pragma unroll
    for (int ks = 0; ks < 2; ++ks) {
      bf16x8 af[4], bfr[NT];
#pragma unroll
      for (int m = 0; m < 4; ++m) af[m] = *(const bf16x8*)(Ab + m * 16 * LS + ks * 32);
#pragma unroll
      for (int n = 0; n < NT; ++n) bfr[n] = *(const bf16x8*)(Bb + n * 16 * LS + ks * 32);
#pragma unroll
      for (int m = 0; m < 4; ++m)
#pragma unroll
        for (int n = 0; n < NT; ++n) acc[m][n] = MFMA(af[m], bfr[n], acc[m][n]);
    }
    __builtin_amdgcn_sched_barrier(0);
    {
      bf16_t* Aw = As + (buf ^ 1) * 128 * LS;
      bf16_t* Bw = Bs + (buf ^ 1) * BN * LS;
      GT_STORE(Aw, Bw)
    }
    __syncthreads();
  }
#undef GT_LOAD
#undef GT_STORE
}

template <int NT>
DEV void stage_acc(const int tid, float* Cs, const f32x4 (&acc)[4][NT]) {
  constexpr int LDC = NT * 32 + 4;
  const int lane = tid & 63, wave = tid >> 6, wr = wave >> 1, wc = wave & 1, fr = lane & 15, fq = lane >> 4;
#pragma unroll
  for (int m = 0; m < 4; ++m)
#pragma unroll
    for (int n = 0; n < NT; ++n)
#pragma unroll
      for (int j = 0; j < 4; ++j) Cs[(wr * 64 + m * 16 + fq * 4 + j) * LDC + wc * (NT * 16) + n * 16 + fr] = acc[m][n][j];
}

DEV bool tile_for(int it, int nM, int nN, int& tm, int& tn) {
  const int nx = gridDim.x >> 3;
  const int xcd = blockIdx.x & 7, local = blockIdx.x >> 3;
  const long id = ((long)it * 8 + xcd) * nx + local;
  if (local >= nx || id >= (long)nM * nN) return false;
  const int per_group = 8 * nN;
  const int g = (int)(id / per_group), r = (int)(id % per_group);
  tn = r >> 3; tm = g * 8 + (r & 7);
  return true;
}

PHASE void phase_prep(const Params& p, char* smem) {
  const int tid = opaque_tid();
  if (blockIdx.x == 0 && tid < 8) p.counters[tid] = 0u;
  float* tile = (float*)smem;
  const int NCONV = 2 * 4864, NADA = 192;
  for (int item = blockIdx.x; item < NCONV + NADA; item += gridDim.x) {
    if (item < NCONV) {
      const int l = item / 4864; int r = item % 4864;
      const float* src; int K, Nsrc, nT, perm = 0; size_t dst;
      if (r < 2112) { src = p.w_in + (size_t)l * 1024 * 8448; K = 1024; Nsrc = 8448; dst = WIN; nT = 132; }
      else if (r < 2240) { r -= 2112; src = p.w_br_a + (size_t)l * 512 * 1024; K = 512; Nsrc = 1024; dst = WBA; nT = 16; }
      else if (r < 2368) { r -= 2240; src = p.w_br_b + (size_t)l * 512 * 1024; K = 512; Nsrc = 1024; dst = WBB; nT = 16; }
      else if (r < 2496) { r -= 2368; src = p.w_br_c + (size_t)l * 512 * 1024; K = 512; Nsrc = 1024; dst = WBC; nT = 16; }
      else if (r < 2752) { r -= 2496; src = p.w_out + (size_t)l * 1024 * 1024; K = 1024; Nsrc = 1024; dst = WOUT; nT = 16; }
      else if (r < 4160) { r -= 2752; src = p.ffn_w_in + (size_t)l * 1024 * 5632; K = 1024; Nsrc = 5632; dst = WFI; nT = 88; perm = 1; }
      else { r -= 4160; src = p.ffn_w_out + (size_t)l * 2816 * 1024; K = 2816; Nsrc = 1024; dst = WFO; nT = 16; }
      const int kt = r / nT, nt = r % nT;
      const int colbase = perm ? ((nt & 1) * FFH + 64 * (nt >> 1)) : nt * 64;
      __syncthreads();
#pragma unroll
      for (int i = 0; i < 16; ++i) {
        const int k = i * 4 + (tid >> 6), j = tid & 63;
        tile[k * 65 + j] = src[(size_t)(kt * 64 + k) * Nsrc + colbase + j];
      }
      __syncthreads();
      const int row = tid >> 2, kc = (tid & 3) * 16;
      float f[16];
#pragma unroll
      for (int i = 0; i < 16; ++i) f[i] = tile[(kc + i) * 65 + row];
      bf16_t* d = p.wt + (size_t)l * WLAYER + dst + (size_t)(nt * 64 + row) * K + kt * 64 + kc;
      *(uint4*)d = make_uint4(pack2(f[0], f[1]), pack2(f[2], f[3]), pack2(f[4], f[5]), pack2(f[6], f[7]));
      *(uint4*)(d + 8) = make_uint4(pack2(f[8], f[9]), pack2(f[10], f[11]), pack2(f[12], f[13]), pack2(f[14], f[15]));
    } else {
      const int a = item - NCONV;
      const int l = a / 96, r = a % 96, ntile = r >> 2, bg = r & 3;
      float* cact = (float*)smem;
      __syncthreads();
      for (int i = tid; i < 8 * 1024; i += 256) {
        const float cv = p.c[(size_t)(bg * 8 + (i >> 10)) * DM + (i & 1023)];
        cact[i] = cv * sigm(cv);
      }
      __syncthreads();
      const int n = ntile * 256 + tid;
      const float* W = p.ada_w + (size_t)l * DM * ADAW + n;
      float acc[8];
#pragma unroll
      for (int b = 0; b < 8; ++b) acc[b] = 0.f;
      for (int k = 0; k < DM; ++k) {
        const float w = W[(size_t)k * ADAW];
#pragma unroll
        for (int b = 0; b < 8; ++b) acc[b] += cact[b * 1024 + k] * w;
      }
      const float bias = p.ada_b[l * ADAW + n];
#pragma unroll
      for (int b = 0; b < 8; ++b) p.ada[((size_t)l * 32 + bg * 8 + b) * ADAW + n] = acc[b] + bias;
    }
  }
}

PHASE void phase_norm(const float* __restrict__ x, const float* __restrict__ w, const float* __restrict__ ada_l,
                    int shift_off, int scale_off, bf16_t* __restrict__ h) {
  const int tid = opaque_tid();
  const int lane = tid & 63, wave = tid >> 6;
  for (int row = blockIdx.x * 4 + wave; row < T_TOK; row += gridDim.x * 4) {
    const float* xr = x + (size_t)row * DM;
    float4 v[4]; float ss = 0.f;
#pragma unroll
    for (int i = 0; i < 4; ++i) { v[i] = *(const float4*)(xr + i * 256 + lane * 4); ss += v[i].x * v[i].x + v[i].y * v[i].y + v[i].z * v[i].z + v[i].w * v[i].w; }
    ss = wave_sum(ss);
    const float rstd = rsqrtf(ss * (1.f / DM) + 1e-6f);
    const float* ad = ada_l + (size_t)(row / SEQ) * ADAW;
#pragma unroll
    for (int i = 0; i < 4; ++i) {
      const int col = i * 256 + lane * 4;
      const float4 ww = *(const float4*)(w + col), sc = *(const float4*)(ad + scale_off + col), sh = *(const float4*)(ad + shift_off + col);
      const float o0 = v[i].x * rstd * ww.x * (1.f + sc.x) + sh.x, o1 = v[i].y * rstd * ww.y * (1.f + sc.y) + sh.y;
      const float o2 = v[i].z * rstd * ww.z * (1.f + sc.z) + sh.z, o3 = v[i].w * rstd * ww.w * (1.f + sc.w) + sh.w;
      *(uint2*)(h + (size_t)row * DM + col) = make_uint2(pack2(o0, o1), pack2(o2, o3));
    }
  }
}

PHASE void phase_final(float* __restrict__ x, const float* __restrict__ w) {
  const int tid = opaque_tid();
  const int lane = tid & 63, wave = tid >> 6;
  for (int row = blockIdx.x * 4 + wave; row < T_TOK; row += gridDim.x * 4) {
    float* xr = x + (size_t)row * DM;
    float4 v[4]; float ss = 0.f;
#pragma unroll
    for (int i = 0; i < 4; ++i) { v[i] = *(const float4*)(xr + i * 256 + lane * 4); ss += v[i].x * v[i].x + v[i].y * v[i].y + v[i].z * v[i].z + v[i].w * v[i].w; }
    ss = wave_sum(ss);
    const float rstd = rsqrtf(ss * (1.f / DM) + 1e-6f);
#pragma unroll
    for (int i = 0; i < 4; ++i) {
      const int col = i * 256 + lane * 4;
      const float4 ww = *(const float4*)(w + col);
      *(float4*)(xr + col) = make_float4(v[i].x * rstd * ww.x, v[i].y * rstd * ww.y, v[i].z * rstd * ww.z, v[i].w * rstd * ww.w);
    }
  }
}

PHASE void phase_gemm_in(const Params& p, int l, char* smem) {
  const bf16_t* Wt = p.wt + (size_t)l * WLAYER + WIN;
  float* Cs = (float*)smem;
  const int tid = opaque_tid();
  for (int it = 0;; ++it) {
    int tm, tn;
    if (!tile_for(it, 512, 42, tm, tn)) break;
    f32x4 acc[4][4];
    gemm_tile<4>(tid, p.h + (size_t)tm * 128 * DM, DM, Wt + (size_t)tn * 128 * DM, DM, DM, smem, acc);
    stage_acc<4>(tid, Cs, acc);
    __syncthreads();
    const size_t row0 = (size_t)tm * 128;
    if (tn < 8) {
      const float qs = (tn < 4) ? 0.125f : 1.f;
      const int ch = tid & 15, g = ch >> 3, cc = ch & 7;
      if (cc < 4) {
#pragma unroll 1
        for (int i = 0; i < 8; ++i) {
          const int r = (tid >> 4) + i * 16;
          const float pos = (float)p.pos[row0 + r];
          const float* c1 = Cs + r * 132 + g * 64 + cc * 8;
          float o1[8], o2[8];
#pragma unroll
          for (int e = 0; e < 8; ++e) {
            const float x1 = c1[e], x2 = c1[32 + e];
            const float inv = exp2f(-(float)(cc * 8 + e) * 0.41524101186092029f);
            float rev = pos * inv * 0.15915494309189535f;
            rev -= rintf(rev);
            const float s = __builtin_amdgcn_sinf(rev), c = __builtin_amdgcn_cosf(rev);
            o1[e] = (x1 * c - x2 * s) * qs; o2[e] = (x2 * c + x1 * s) * qs;
          }
          bf16_t* d = p.u + (row0 + r) * US + tn * 128 + g * 64 + cc * 8;
          *(uint4*)d = PACK8(o1);
          *(uint4*)(d + 32) = PACK8(o2);
        }
      }
    } else if (tn < 12) {
      const int b = (int)(row0 / SEQ), s0 = (int)(row0 % SEQ), vc0 = (tn - 8) * 128;
      const int rch = tid & 15;
#pragma unroll 1
      for (int i = 0; i < 8; ++i) {
        const int c = (tid >> 4) + i * 16;
        float f[8];
#pragma unroll
        for (int j = 0; j < 8; ++j) f[j] = Cs[(rch * 8 + j) * 132 + c];
        *(uint4*)(p.vT + ((size_t)b * 512 + vc0 + c) * SEQ + s0 + rch * 8) = PACK8(f);
      }
    } else {
      const int ch = tid & 15;
#pragma unroll 1
      for (int i = 0; i < 8; ++i) {
        const int r = (tid >> 4) + i * 16;
        const float4 a = *(const float4*)(Cs + r * 132 + ch * 8), b = *(const float4*)(Cs + r * 132 + ch * 8 + 4);
        *(uint4*)(p.u + (row0 + r) * US + tn * 128 - 512 + ch * 8) = make_uint4(pack2(a.x, a.y), pack2(a.z, a.w), pack2(b.x, b.y), pack2(b.z, b.w));
      }
    }
    __syncthreads();
  }
}

PHASE void phase_vlo(const Params& p, int l, char* smem) {
  float* vs = (float*)smem;
  const int tid = opaque_tid();
  const float* mu = p.rw_mu + (size_t)l * 1792 + 1024;
  const float* v1 = p.rw_v1;
  for (int item = blockIdx.x; item < T_TOK / 32; item += gridDim.x) {
    const size_t tok0 = (size_t)item * 32;
    __syncthreads();
#pragma unroll 1
    for (int i = 0; i < 8; ++i) {
      const int c = tid + i * 256;
      const int t = c >> 6, cc = c & 63;
      const size_t tok = tok0 + t;
      const uint4 cur = *(const uint4*)(p.u + tok * US + 3072 + 1024 + cc * 8);
      uint4 prv = make_uint4(0, 0, 0, 0);
      if ((tok % SEQ) != 0) prv = *(const uint4*)(p.u + (tok - 1) * US + 3072 + 1024 + cc * 8);
      float a[8], b[8];
      UNPACK8(cur, a); UNPACK8(prv, b);
#pragma unroll
      for (int e = 0; e < 8; ++e) vs[t * 512 + cc * 8 + e] = a[e] + (b[e] - a[e]) * mu[cc * 8 + e];
    }
    __syncthreads();
    const int j = tid & 31, tg = tid >> 5;
    float acc[4] = {0.f, 0.f, 0.f, 0.f};
    for (int k = 0; k < 512; ++k) {
      const float w = v1[k * 32 + j];
#pragma unroll
      for (int i = 0; i < 4; ++i) acc[i] += vs[(tg * 4 + i) * 512 + k] * w;
    }
#pragma unroll
    for (int i = 0; i < 4; ++i) p.vlo[(tok0 + tg * 4 + i) * 32 + j] = acc[i];
  }
}

PHASE void att_item(const Params& p, int l, int item, char* smem) {
  const int qc = 31 - (item >> 7);
  const int bh = item & 127, b = bh >> 2, h = bh & 3;
  const int tid = opaque_tid(), lane = tid & 63, wave = tid >> 6, fr = lane & 15, fq = lane >> 4;
  const int m = wave >> 1, rh = wave & 1;
  bf16_t* Ks = (bf16_t*)smem;
  bf16_t* Vt = Ks + 2 * 64 * 72;
  bf16_t* Ps = Vt + 128 * 72;
  float* Ox = (float*)smem;
  const size_t tok0 = (size_t)b * SEQ + (size_t)qc * 64;
  const float* lv = p.da_lambda + (size_t)l * 256;
  float d1 = 0.f, d2 = 0.f;
  for (int i = 0; i < 64; ++i) { d1 += lv[i] * lv[64 + i]; d2 += lv[128 + i] * lv[192 + i]; }
  const float lam_init = 0.8f - 0.6f * __expf(-0.3f * (float)l);
  const float lam = __expf(d1) - __expf(d2) + lam_init;

  bf16x8 qf[2][2];
#pragma unroll
  for (int mt = 0; mt < 2; ++mt)
#pragma unroll
    for (int ks = 0; ks < 2; ++ks)
      qf[mt][ks] = *(const bf16x8*)(p.u + (tok0 + rh * 32 + mt * 16 + fr) * US + h * 128 + m * 64 + ks * 32 + fq * 8);
  f32x4 o[2][8];
  float mx[2][4], ls[2][4];
#pragma unroll
  for (int mt = 0; mt < 2; ++mt) {
#pragma unroll
    for (int n = 0; n < 8; ++n) o[mt][n] = (f32x4){0.f, 0.f, 0.f, 0.f};
#pragma unroll
    for (int j = 0; j < 4; ++j) { mx[mt][j] = -1e30f; ls[mt][j] = 0.f; }
  }
  bf16_t* Pw = Ps + wave * 32 * 72;
  for (int kt = 0; kt <= qc; ++kt) {
    __syncthreads();
#pragma unroll
    for (int i = 0; i < 4; ++i) {
      const int c = tid + i * 256;
      const int mm = c >> 9, key = (c >> 3) & 63, cc = c & 7;
      *(uint4*)(Ks + (mm * 64 + key) * 72 + cc * 8) =
          *(const uint4*)(p.u + ((size_t)b * SEQ + kt * 64 + key) * US + 512 + h * 128 + mm * 64 + cc * 8);
    }
#pragma unroll
    for (int i = 0; i < 4; ++i) {
      const int c = tid + i * 256;
      const int dim = c >> 3, cc = c & 7;
      *(uint4*)(Vt + dim * 72 + cc * 8) = *(const uint4*)(p.vT + ((size_t)b * 512 + h * 128 + dim) * SEQ + kt * 64 + cc * 8);
    }
    __syncthreads();
    f32x4 s[2][4];
#pragma unroll
    for (int mt = 0; mt < 2; ++mt)
#pragma unroll
      for (int n = 0; n < 4; ++n) s[mt][n] = (f32x4){0.f, 0.f, 0.f, 0.f};
#pragma unroll
    for (int ks = 0; ks < 2; ++ks)
#pragma unroll
      for (int n = 0; n < 4; ++n) {
        const bf16x8 kf = *(const bf16x8*)(Ks + (m * 64 + n * 16 + fr) * 72 + ks * 32 + fq * 8);
#pragma unroll
        for (int mt = 0; mt < 2; ++mt) s[mt][n] = MFMA(qf[mt][ks], kf, s[mt][n]);
      }
#pragma unroll
    for (int mt = 0; mt < 2; ++mt)
#pragma unroll
      for (int j = 0; j < 4; ++j) {
        float tmax = fmaxf(fmaxf(s[mt][0][j], s[mt][1][j]), fmaxf(s[mt][2][j], s[mt][3][j]));
        tmax = red16_max(tmax);
        const float mnew = fmaxf(mx[mt][j], tmax);
        const float alpha = __expf(mx[mt][j] - mnew);
        float rs = 0.f;
#pragma unroll
        for (int n = 0; n < 4; ++n) {
          const float pv = __expf(s[mt][n][j] - mnew);
          rs += pv;
          Pw[(mt * 16 + fq * 4 + j) * 72 + n * 16 + fr] = f2bf(pv);
        }
        rs = red16_sum(rs);
        ls[mt][j] = ls[mt][j] * alpha + rs;
        mx[mt][j] = mnew;
#pragma unroll
        for (int n = 0; n < 8; ++n) o[mt][n][j] *= alpha;
      }
    __syncthreads();
#pragma unroll
    for (int ks = 0; ks < 2; ++ks) {
      bf16x8 pf[2];
#pragma unroll
      for (int mt = 0; mt < 2; ++mt) pf[mt] = *(const bf16x8*)(Pw + (mt * 16 + fr) * 72 + ks * 32 + fq * 8);
#pragma unroll
      for (int n = 0; n < 8; ++n) {
        const bf16x8 vf = *(const bf16x8*)(Vt + (n * 16 + fr) * 72 + ks * 32 + fq * 8);
#pragma unroll
        for (int mt = 0; mt < 2; ++mt) o[mt][n] = MFMA(pf[mt], vf, o[mt][n]);
      }
    }
  }
  __syncthreads();
#pragma unroll
  for (int mt = 0; mt < 2; ++mt)
#pragma unroll
    for (int j = 0; j < 4; ++j) {
      const float inv = 1.f / ls[mt][j];
#pragma unroll
      for (int n = 0; n < 8; ++n) o[mt][n][j] *= inv;
    }
  if (m == 1) {
#pragma unroll
    for (int mt = 0; mt < 2; ++mt)
#pragma unroll
      for (int n = 0; n < 8; ++n)
#pragma unroll
        for (int j = 0; j < 4; ++j) Ox[(rh * 32 + mt * 16 + fq * 4 + j) * 132 + n * 16 + fr] = o[mt][n][j];
  }
  __syncthreads();
  if (m == 0) {
    const float* sw = p.da_subln_w + (size_t)l * 128;
    float wv[8];
#pragma unroll
    for (int n = 0; n < 8; ++n) wv[n] = sw[n * 16 + fr] * (1.f - lam_init);
#pragma unroll
    for (int mt = 0; mt < 2; ++mt)
#pragma unroll
      for (int j = 0; j < 4; ++j) {
        float ss = 0.f;
        float d[8];
#pragma unroll
        for (int n = 0; n < 8; ++n) {
          d[n] = o[mt][n][j] - lam * Ox[(rh * 32 + mt * 16 + fq * 4 + j) * 132 + n * 16 + fr];
          ss += d[n] * d[n];
        }
        ss = red16_sum(ss);
        const float rstd = rsqrtf(ss * (1.f / 128.f) + 1e-6f);
        bf16_t* dst = p.u + (tok0 + rh * 32 + mt * 16 + fq * 4 + j) * US + h * 128 + fr;
#pragma unroll
        for (int n = 0; n < 8; ++n) dst[n * 16] = f2bf(d[n] * rstd * wv[n]);
      }
  }
  __syncthreads();
}

PHASE void hgrn_item(const Params& p, int l, int item, char* smem) {
  const int b = item >> 2, h = item & 3;
  const int tid = opaque_tid(), lane = tid & 63, wave = tid >> 6, fr = lane & 15, fq = lane >> 4;
  bf16_t* Qs = (bf16_t*)smem;
  bf16_t* Kn = Qs + 32 * 136;
  bf16_t* KT = Kn + 32 * 136;
  bf16_t* VT = KT + 128 * 40;
  bf16_t* Ps = VT + 128 * 40;
  bf16_t* ST = Ps + 32 * 40;
  float* lfb = (float*)ST;
  float* red = (float*)(ST + 128 * 136);
  float* blast = red + 64;
  const int t_ = tid >> 3, d0 = (tid & 7) * 16;
  float lbv[16];
#pragma unroll
  for (int i = 0; i < 16; ++i) {
    const int c = h * 128 + d0 + i;
    lbv[i] = (l == 0) ? 0.f : sigm(p.hg_lb[512 + c] - p.hg_lb[c]);
  }
  f32x4 S[2][8];
#pragma unroll
  for (int mm = 0; mm < 2; ++mm)
#pragma unroll
    for (int n = 0; n < 8; ++n) S[mm][n] = (f32x4){0.f, 0.f, 0.f, 0.f};
  const float* nw = p.hg_norm_w + (size_t)l * 128;

  for (int ch = 0; ch < 64; ++ch) {
    const size_t tok0 = (size_t)b * SEQ + (size_t)ch * 32;
    __syncthreads();
    float qv[16], kv[16];
    {
      const bf16_t* base = p.u + (tok0 + t_) * US + h * 128 + d0;
      float zv[16], iv[16];
      { const uint4 a = *(const uint4*)(base + 1024), c = *(const uint4*)(base + 1024 + 8); float* z0 = zv; float* z1 = zv + 8; UNPACK8(a, z0); UNPACK8(c, z1); }
      { const uint4 a = *(const uint4*)(base + 1536), c = *(const uint4*)(base + 1536 + 8); float* z0 = iv; float* z1 = iv + 8; UNPACK8(a, z0); UNPACK8(c, z1); }
      { const uint4 a = *(const uint4*)(base + 2048), c = *(const uint4*)(base + 2048 + 8); float* z0 = qv; float* z1 = qv + 8; UNPACK8(a, z0); UNPACK8(c, z1); }
#pragma unroll
      for (int i = 0; i < 16; ++i) {
        const float z = zv[i], lb = lbv[i];
        const float ez = __expf(-fabsf(z));
        float lf;
        if (lb > 0.f) {
          const float sg = (z >= 0.f) ? 1.f / (1.f + ez) : ez / (1.f + ez);
          lf = __logf(lb + (1.f - lb) * sg);
        } else {
          lf = -(fmaxf(-z, 0.f) + __logf(1.f + ez));
        }
        const float sgn = (z >= 0.f) ? ez / (1.f + ez) : 1.f / (1.f + ez);
        kv[i] = (1.f - lb) * sgn;
        lfb[t_ * 128 + d0 + i] = lf;
        VT[(d0 + i) * 40 + t_] = f2bf(iv[i]);
      }
    }
    __syncthreads();
    if (tid < 128) {
      float bsum = 0.f;
#pragma unroll 8
      for (int t = 0; t < 32; ++t) { bsum += lfb[t * 128 + tid]; lfb[t * 128 + tid] = bsum; }
      blast[tid] = bsum;
    }
    __syncthreads();
    {
      float qo[16], ko[16];
#pragma unroll
      for (int i = 0; i < 16; ++i) {
        const float bb = lfb[t_ * 128 + d0 + i];
        qo[i] = qv[i] * __expf(bb);
        ko[i] = kv[i] * __expf(fminf(-bb, 80.f));
        KT[(d0 + i) * 40 + t_] = f2bf(ko[i]);
      }
      float* q0 = qo; float* q1 = qo + 8; float* k0 = ko; float* k1 = ko + 8;
      *(uint4*)(Qs + t_ * 136 + d0) = PACK8(q0);
      *(uint4*)(Qs + t_ * 136 + d0 + 8) = PACK8(q1);
      *(uint4*)(Kn + t_ * 136 + d0) = PACK8(k0);
      *(uint4*)(Kn + t_ * 136 + d0 + 8) = PACK8(k1);
    }
    __syncthreads();
#pragma unroll
    for (int mm = 0; mm < 2; ++mm)
#pragma unroll
      for (int n = 0; n < 8; ++n)
        *(uint2*)(ST + (n * 16 + fr) * 136 + wave * 32 + mm * 16 + fq * 4) =
            make_uint2(pack2(S[mm][n][0], S[mm][n][1]), pack2(S[mm][n][2], S[mm][n][3]));
    {
      const int mt = wave >> 1, nt = wave & 1;
      f32x4 sc = (f32x4){0.f, 0.f, 0.f, 0.f};
#pragma unroll
      for (int ks = 0; ks < 4; ++ks) {
        const bf16x8 a = *(const bf16x8*)(Qs + (mt * 16 + fr) * 136 + ks * 32 + fq * 8);
        const bf16x8 bb = *(const bf16x8*)(Kn + (nt * 16 + fr) * 136 + ks * 32 + fq * 8);
        sc = MFMA(a, bb, sc);
      }
#pragma unroll
      for (int j = 0; j < 4; ++j) {
        const int t = mt * 16 + fq * 4 + j, key = nt * 16 + fr;
        Ps[t * 40 + key] = f2bf(key <= t ? sc[j] : 0.f);
      }
    }
    __syncthreads();
    {
      const int mt = wave & 1, nb = (wave >> 1) * 4;
      f32x4 oo[4];
#pragma unroll
      for (int n = 0; n < 4; ++n) oo[n] = (f32x4){0.f, 0.f, 0.f, 0.f};
      {
        const bf16x8 a = *(const bf16x8*)(Ps + (mt * 16 + fr) * 40 + fq * 8);
#pragma unroll
        for (int n = 0; n < 4; ++n) {
          const bf16x8 bb = *(const bf16x8*)(VT + ((nb + n) * 16 + fr) * 40 + fq * 8);
          oo[n] = MFMA(a, bb, oo[n]);
        }
      }
#pragma unroll
      for (int ks = 0; ks < 4; ++ks) {
        const bf16x8 a = *(const bf16x8*)(Qs + (mt * 16 + fr) * 136 + ks * 32 + fq * 8);
#pragma unroll
        for (int n = 0; n < 4; ++n) {
          const bf16x8 bb = *(const bf16x8*)(ST + ((nb + n) * 16 + fr) * 136 + ks * 32 + fq * 8);
          oo[n] = MFMA(a, bb, oo[n]);
        }
      }
#pragma unroll
      for (int j = 0; j < 4; ++j) {
        float ss = 0.f;
#pragma unroll
        for (int n = 0; n < 4; ++n) ss += oo[n][j] * oo[n][j];
        ss = red16_sum(ss);
        if (fr == 0) red[(mt * 16 + fq * 4 + j) * 2 + (wave >> 1)] = ss;
      }
      __syncthreads();
#pragma unroll
      for (int j = 0; j < 4; ++j) {
        const int t = mt * 16 + fq * 4 + j;
        const float rstd = rsqrtf((red[t * 2] + red[t * 2 + 1]) * (1.f / 128.f) + 1e-6f);
        bf16_t* gp = p.u + (tok0 + t) * US + 2560 + h * 128 + nb * 16 + fr;
#pragma unroll
        for (int n = 0; n < 4; ++n) {
          const float g = bf2f(gp[n * 16]);
          gp[n * 16] = f2bf(oo[n][j] * rstd * nw[(nb + n) * 16 + fr] * (g * sigm(g)));
        }
      }
    }
    {
      bf16x8 af[2];
#pragma unroll
      for (int mm = 0; mm < 2; ++mm) af[mm] = *(const bf16x8*)(KT + (wave * 32 + mm * 16 + fr) * 40 + fq * 8);
#pragma unroll
      for (int n = 0; n < 8; ++n) {
        const bf16x8 bb = *(const bf16x8*)(VT + (n * 16 + fr) * 40 + fq * 8);
#pragma unroll
        for (int mm = 0; mm < 2; ++mm) S[mm][n] = MFMA(af[mm], bb, S[mm][n]);
      }
#pragma unroll
      for (int mm = 0; mm < 2; ++mm)
#pragma unroll
        for (int j = 0; j < 4; ++j) {
          const float e = __expf(blast[wave * 32 + mm * 16 + fq * 4 + j]);
#pragma unroll
          for (int n = 0; n < 8; ++n) S[mm][n][j] *= e;
        }
    }
  }
  __syncthreads();
}

DEV bf16x8 rw_afrag(const bf16_t* u, size_t tok, int col, const float* mu, int mode) {
  const uint4 cur = *(const uint4*)(u + tok * US + 3072 + col);
  uint4 prv = make_uint4(0, 0, 0, 0);
  if ((tok % SEQ) != 0) prv = *(const uint4*)(u + (tok - 1) * US + 3072 + col);
  float a[8], b[8], o[8];
  UNPACK8(cur, a); UNPACK8(prv, b);
#pragma unroll
  for (int e = 0; e < 8; ++e) {
    float v = a[e] + (b[e] - a[e]) * mu[col + e];
    if (mode == 1) { const float t = __expf(-2.f * fabsf(v)); const float th = (1.f - t) / (1.f + t); v = (v >= 0.f) ? th : -th; }
    else if (mode == 2) v = sigm(v);
    o[e] = v;
  }
  return as_frag(PACK8(o));
}
DEV bf16x8 rw_bfrag(const float* W, int k0, int col) {
  float o[8];
#pragma unroll
  for (int e = 0; e < 8; ++e) o[e] = W[(size_t)(k0 + e) * 512 + col];
  return as_frag(PACK8(o));
}

PHASE void rwkv_item(const Params& p, int l, int item, char* smem) {
  const int b = item >> 3, h = item & 7;
  const int tid = opaque_tid(), lane = tid & 63, wave = tid >> 6, fr = lane & 15, fq = lane >> 4;
  float* R = (float*)smem;
  float* W = R + 2048; float* K = W + 2048; float* KK = K + 2048; float* BB = KK + 2048;
  float* V = BB + 2048; float* G = V + 2048; float* O = G + 2048;
  float* carry = O + 2048;
  const float* mu = p.rw_mu + (size_t)l * 1792;
  const int hc_n = h * 64 + wave * 16 + fr;
  bf16x8 w2f[2], a2f[2], g2f[4], v2f;
#pragma unroll
  for (int ks = 0; ks < 2; ++ks) {
    w2f[ks] = rw_bfrag(p.rw_w2 + (size_t)l * 64 * 512, ks * 32 + fq * 8, hc_n);
    a2f[ks] = rw_bfrag(p.rw_a2 + (size_t)l * 64 * 512, ks * 32 + fq * 8, hc_n);
  }
#pragma unroll
  for (int ks = 0; ks < 4; ++ks) g2f[ks] = rw_bfrag(p.rw_g2 + (size_t)l * 128 * 512, ks * 32 + fq * 8, hc_n);
  v2f = w2f[0];
  if (l > 0) v2f = rw_bfrag(p.rw_v2, fq * 8, hc_n);
  const float w0c = p.rw_w0[l * 512 + hc_n], a0c = p.rw_a0[l * 512 + hc_n];
  const float v0c = (l > 0) ? p.rw_v0[hc_n] : 0.f;
  const int t_ = tid >> 3, n0 = (tid & 7) * 8;
  float* cst = carry + 128;
  __syncthreads();
  if (tid < 64) {
    const int hc = h * 64 + tid;
    cst[tid] = p.rw_k_k[l * 512 + hc]; cst[64 + tid] = p.rw_k_a[l * 512 + hc]; cst[128 + tid] = p.rw_r_k[l * 512 + hc];
    cst[192 + tid] = p.rw_gn_w[l * 512 + hc]; cst[256 + tid] = p.rw_gn_b[l * 512 + hc];
    cst[320 + tid] = mu[hc]; cst[384 + tid] = mu[512 + hc]; cst[448 + tid] = mu[1024 + hc];
  }
  const float* kkc = cst + n0; const float* kac = cst + 64 + n0; const float* rkc = cst + 128 + n0;
  const float* gnw = cst + 192 + n0; const float* gnb = cst + 256 + n0;
  const float* mur = cst + 320 + n0; const float* muk = cst + 384 + n0; const float* muv = cst + 448 + n0;
  const int kq = lane & 7, row0 = wave * 16 + (lane >> 3), row1 = row0 + 8;
  float S0[8], S1[8];
#pragma unroll
  for (int e = 0; e < 8; ++e) { S0[e] = 0.f; S1[e] = 0.f; }

  for (int ch = 0; ch < 64; ++ch) {
    const size_t tok0 = (size_t)b * SEQ + (size_t)ch * 32;
    __syncthreads();
#pragma unroll
    for (int mt = 0; mt < 2; ++mt) {
      const size_t tok = tok0 + mt * 16 + fr;
      f32x4 aw = (f32x4){0.f, 0.f, 0.f, 0.f}, aa = aw, ag = aw, av = aw;
#pragma unroll
      for (int ks = 0; ks < 2; ++ks) {
        aw = MFMA(rw_afrag(p.u, tok, 1536 + ks * 32 + fq * 8, mu, 1), w2f[ks], aw);
        aa = MFMA(rw_afrag(p.u, tok, 1600 + ks * 32 + fq * 8, mu, 0), a2f[ks], aa);
      }
#pragma unroll
      for (int ks = 0; ks < 4; ++ks) ag = MFMA(rw_afrag(p.u, tok, 1664 + ks * 32 + fq * 8, mu, 2), g2f[ks], ag);
      if (l > 0) {
        const float4 x0 = *(const float4*)(p.vlo + tok * 32 + fq * 8), x1 = *(const float4*)(p.vlo + tok * 32 + fq * 8 + 4);
        const uint4 pk = make_uint4(pack2(x0.x, x0.y), pack2(x0.z, x0.w), pack2(x1.x, x1.y), pack2(x1.z, x1.w));
        av = MFMA(as_frag(pk), v2f, av);
      }
#pragma unroll
      for (int j = 0; j < 4; ++j) {
        const int t = mt * 16 + fq * 4 + j, n = wave * 16 + fr;
        const float wv = -(w0c + aw[j]);
        const float sp = fmaxf(wv, 0.f) + __logf(1.f + __expf(-fabsf(wv)));
        const float wl = -sp - 0.5f;
        W[t * 64 + n] = __expf(-__expf(wl));
        BB[t * 64 + n] = sigm(a0c + aa[j]);
        G[t * 64 + n] = ag[j];
        if (l > 0) O[t * 64 + n] = sigm(v0c + av[j]);
      }
    }
    {
      const size_t tok = tok0 + t_;
      const bf16_t* cu = p.u + tok * US + 3072 + h * 64 + n0;
      const bool first = (tok % SEQ) == 0;
      float cr[8], ck[8], cv[8], pr[8], pk[8], pv[8];
      { const uint4 x = *(const uint4*)cu; UNPACK8(x, cr); }
      { const uint4 x = *(const uint4*)(cu + 512); UNPACK8(x, ck); }
      { const uint4 x = *(const uint4*)(cu + 1024); UNPACK8(x, cv); }
      if (first) {
#pragma unroll
        for (int e = 0; e < 8; ++e) { pr[e] = 0.f; pk[e] = 0.f; pv[e] = 0.f; }
      } else {
        { const uint4 x = *(const uint4*)(cu - US + 512); UNPACK8(x, pk); }
        { const uint4 x = *(const uint4*)(cu - US + 1024); UNPACK8(x, pv); }
        if (t_ == 0) {
#pragma unroll
          for (int e = 0; e < 8; ++e) pr[e] = carry[(ch & 1) * 64 + n0 + e];
        } else { const uint4 x = *(const uint4*)(cu - US); UNPACK8(x, pr); }
      }
      if (t_ == 31) {
#pragma unroll
        for (int e = 0; e < 8; ++e) carry[((ch + 1) & 1) * 64 + n0 + e] = cr[e];
      }
      float vs[8];
#pragma unroll
      for (int e = 0; e < 8; ++e) {
        R[t_ * 64 + n0 + e] = cr[e] + (pr[e] - cr[e]) * mur[e];
        K[t_ * 64 + n0 + e] = ck[e] + (pk[e] - ck[e]) * muk[e];
        vs[e] = cv[e] + (pv[e] - cv[e]) * muv[e];
        V[t_ * 64 + n0 + e] = vs[e];
      }
      if (l == 0) *(uint4*)(p.vfirst + tok * 512 + h * 64 + n0) = PACK8(vs);
    }
    __syncthreads();
    {
      const size_t tok = tok0 + t_;
      float kx[8], kkv[8], ss = 0.f;
#pragma unroll
      for (int e = 0; e < 8; ++e) { kx[e] = K[t_ * 64 + n0 + e]; kkv[e] = kx[e] * kkc[e]; ss += kkv[e] * kkv[e]; }
      ss = red8_sum(ss);
      const float rn = rsqrtf(fmaxf(ss, 1e-24f));
#pragma unroll
      for (int e = 0; e < 8; ++e) {
        const float a = BB[t_ * 64 + n0 + e];
        const float kn = kkv[e] * rn;
        K[t_ * 64 + n0 + e] = kx[e] * (1.f + (a - 1.f) * kac[e]);
        KK[t_ * 64 + n0 + e] = kn;
        BB[t_ * 64 + n0 + e] = kn * a;
      }
      if (l > 0) {
        const uint4 x = *(const uint4*)(p.vfirst + tok * 512 + h * 64 + n0);
        float vf[8]; UNPACK8(x, vf);
#pragma unroll
        for (int e = 0; e < 8; ++e) {
          const float v = V[t_ * 64 + n0 + e];
          V[t_ * 64 + n0 + e] = v + (vf[e] - v) * O[t_ * 64 + n0 + e];
        }
      }
    }
    __syncthreads();
#pragma unroll 2
    for (int t = 0; t < 32; ++t) {
      const float* base = R + t * 64 + kq * 8;
      const float4 r0 = *(const float4*)(base), r1 = *(const float4*)(base + 4);
      const float4 w0 = *(const float4*)(base + 2048), w1 = *(const float4*)(base + 2048 + 4);
      const float4 k0 = *(const float4*)(base + 4096), k1 = *(const float4*)(base + 4096 + 4);
      const float4 q0 = *(const float4*)(base + 6144), q1 = *(const float4*)(base + 6144 + 4);
      const float4 b0 = *(const float4*)(base + 8192), b1 = *(const float4*)(base + 8192 + 4);
      const float va = V[t * 64 + row0], vb = V[t * 64 + row1];
      const float rr[8] = {r0.x, r0.y, r0.z, r0.w, r1.x, r1.y, r1.z, r1.w};
      const float ww[8] = {w0.x, w0.y, w0.z, w0.w, w1.x, w1.y, w1.z, w1.w};
      const float kk_[8] = {k0.x, k0.y, k0.z, k0.w, k1.x, k1.y, k1.z, k1.w};
      const float qq[8] = {q0.x, q0.y, q0.z, q0.w, q1.x, q1.y, q1.z, q1.w};
      const float bb[8] = {b0.x, b0.y, b0.z, b0.w, b1.x, b1.y, b1.z, b1.w};
      float sa0 = 0.f, sa1 = 0.f;
#pragma unroll
      for (int e = 0; e < 8; ++e) { sa0 += S0[e] * qq[e]; sa1 += S1[e] * qq[e]; }
      sa0 = -red8_sum(sa0); sa1 = -red8_sum(sa1);
      float o0 = 0.f, o1 = 0.f;
#pragma unroll
      for (int e = 0; e < 8; ++e) {
        S0[e] = S0[e] * ww[e] + sa0 * bb[e] + va * kk_[e];
        S1[e] = S1[e] * ww[e] + sa1 * bb[e] + vb * kk_[e];
        o0 += S0[e] * rr[e]; o1 += S1[e] * rr[e];
      }
      o0 = red8_sum(o0); o1 = red8_sum(o1);
      if (kq == 0) { O[t * 64 + row0] = o0; O[t * 64 + row1] = o1; }
    }
    __syncthreads();
    {
      const size_t tok = tok0 + t_;
      float ov[8], s1 = 0.f, bon = 0.f;
#pragma unroll
      for (int e = 0; e < 8; ++e) {
        ov[e] = O[t_ * 64 + n0 + e]; s1 += ov[e];
        bon += R[t_ * 64 + n0 + e] * K[t_ * 64 + n0 + e] * rkc[e];
      }
      s1 = red8_sum(s1); bon = red8_sum(bon);
      const float mean = s1 * (1.f / 64.f);
      float s2 = 0.f;
#pragma unroll
      for (int e = 0; e < 8; ++e) { const float d = ov[e] - mean; s2 += d * d; }
      s2 = red8_sum(s2);
      const float rstd = rsqrtf(s2 * (1.f / 64.f) + 64e-5f);
      float y[8];
#pragma unroll
      for (int e = 0; e < 8; ++e)
        y[e] = ((ov[e] - mean) * rstd * gnw[e] + gnb[e] + bon * V[t_ * 64 + n0 + e]) * G[t_ * 64 + n0 + e];
      *(uint4*)(p.u + tok * US + 3072 + h * 64 + n0) = PACK8(y);
    }
  }
  __syncthreads();
}

PHASE void phase_mix(const Params& p, int l, char* smem) {
  int* sitem = (int*)(smem + SMEM_BYTES - 16);
  const int tid0 = opaque_tid();
  while (true) {
    __syncthreads();
    if (tid0 == 0) *sitem = (int)atomicAdd(p.counters + l * 4 + 0, 1u);
    __syncthreads();
    const int item = *sitem;
    if (item >= 256) break;
    rwkv_item(p, l, item, smem);
  }
  while (true) {
    __syncthreads();
    if (tid0 == 0) *sitem = (int)atomicAdd(p.counters + l * 4 + 1, 1u);
    __syncthreads();
    const int item = *sitem;
    if (item >= 128) break;
    hgrn_item(p, l, item, smem);
  }
  while (true) {
    __syncthreads();
    if (tid0 == 0) *sitem = (int)atomicAdd(p.counters + l * 4 + 2, 1u);
    __syncthreads();
    const int item = *sitem;
    if (item >= 4096) break;
    att_item(p, l, item, smem);
  }
}

PHASE void phase_merge(const Params& p, int l, char* smem) {
  const bf16_t* Wl = p.wt + (size_t)l * WLAYER;
  float* Cs = (float*)smem;
  const int tid = opaque_tid();
  for (int it = 0;; ++it) {
    int tm, tn;
    if (!tile_for(it, 512, 16, tm, tn)) break;
    const size_t row0 = (size_t)tm * 128;
    f32x4 acc[4][2], G[4][2], M[4][2];
#pragma unroll
    for (int m = 0; m < 4; ++m)
#pragma unroll
      for (int n = 0; n < 2; ++n) M[m][n] = (f32x4){0.f, 0.f, 0.f, 0.f};
#pragma unroll 1
    for (int br = 0; br < 3; ++br) {
      gemm_tile<2>(tid, p.h + row0 * DM, DM, Wl + WIN + (size_t)(5376 + br * 1024 + tn * 64) * DM, DM, DM, smem, acc);
#pragma unroll
      for (int m = 0; m < 4; ++m)
#pragma unroll
        for (int n = 0; n < 2; ++n)
#pragma unroll
          for (int j = 0; j < 4; ++j) G[m][n][j] = sigm(acc[m][n][j]);
      const int aoff = (br == 0) ? 0 : (br == 1 ? 2560 : 3072);
      const size_t woff = (br == 0) ? WBA : (br == 1 ? WBB : WBC);
      gemm_tile<2>(tid, p.u + row0 * US + aoff, US, Wl + woff + (size_t)(tn * 64) * 512, 512, 512, smem, acc);
#pragma unroll
      for (int m = 0; m < 4; ++m)
#pragma unroll
        for (int n = 0; n < 2; ++n)
#pragma unroll
          for (int j = 0; j < 4; ++j) M[m][n][j] += G[m][n][j] * acc[m][n][j];
    }
    stage_acc<2>(tid, Cs, M);
    __syncthreads();
    {
      const int ch = tid & 7;
#pragma unroll 1
      for (int i = 0; i < 4; ++i) {
        const int r = (tid >> 3) + i * 32;
        const float4 a = *(const float4*)(Cs + r * 68 + ch * 8), b = *(const float4*)(Cs + r * 68 + ch * 8 + 4);
        *(uint4*)(p.u + (row0 + r) * US + 1024 + tn * 64 + ch * 8) = make_uint4(pack2(a.x, a.y), pack2(a.z, a.w), pack2(b.x, b.y), pack2(b.z, b.w));
      }
    }
    __syncthreads();
  }
}

PHASE void phase_gemm_res(const bf16_t* A, int lda, const bf16_t* Wt, int K, const float* xin, float* xout,
                        const float* ada_l, int gate_off, char* smem) {
  float* Cs = (float*)smem;
  const int tid = opaque_tid();
  for (int it = 0;; ++it) {
    int tm, tn;
    if (!tile_for(it, 512, 8, tm, tn)) break;
    const size_t row0 = (size_t)tm * 128;
    f32x4 acc[4][4];
    gemm_tile<4>(tid, A + row0 * lda, lda, Wt + (size_t)(tn * 128) * K, K, K, smem, acc);
    stage_acc<4>(tid, Cs, acc);
    __syncthreads();
    const float* gate = ada_l + (size_t)(row0 / SEQ) * ADAW + gate_off + tn * 128;
    const int c4 = (tid & 31) * 4;
    const float4 gv = *(const float4*)(gate + c4);
#pragma unroll 1
    for (int i = 0; i < 16; ++i) {
      const int r = (tid >> 5) + i * 8;
      const float4 cv = *(const float4*)(Cs + r * 132 + c4);
      const size_t off = (row0 + r) * DM + tn * 128 + c4;
      const float4 xv = *(const float4*)(xin + off);
      *(float4*)(xout + off) = make_float4(xv.x + gv.x * cv.x, xv.y + gv.y * cv.y, xv.z + gv.z * cv.z, xv.w + gv.w * cv.w);
    }
    __syncthreads();
  }
}

PHASE void phase_ffn_in(const Params& p, int l, char* smem) {
  const bf16_t* Wt = p.wt + (size_t)l * WLAYER + WFI;
  float* Cs = (float*)smem;
  const int tid = opaque_tid();
  for (int it = 0;; ++it) {
    int tm, tn;
    if (!tile_for(it, 512, 44, tm, tn)) break;
    const size_t row0 = (size_t)tm * 128;
    f32x4 acc[4][4];
    gemm_tile<4>(tid, p.h + row0 * DM, DM, Wt + (size_t)(tn * 128) * DM, DM, DM, smem, acc);
    stage_acc<4>(tid, Cs, acc);
    __syncthreads();
    const int ch = tid & 7;
#pragma unroll 1
    for (int i = 0; i < 4; ++i) {
      const int r = (tid >> 3) + i * 32;
      const float* cp = Cs + r * 132 + ch * 8;
      float o[8];
#pragma unroll
      for (int e = 0; e < 8; ++e) { const float g = cp[e], uu = cp[64 + e]; o[e] = g * sigm(g) * uu; }
      *(uint4*)(p.u + (row0 + r) * FFH + tn * 64 + ch * 8) = PACK8(o);
    }
    __syncthreads();
  }
}

__global__ void __launch_bounds__(256, 2) mega(Params p_in, int ph_lo, int ph_hi) {
  extern __shared__ __attribute__((aligned(16))) char smem[];
  cg::grid_group grid = cg::this_grid();
  const Params& p = p_in;
  bool first = true;
#define RUN(ph) if ((ph) >= ph_lo && (ph) < ph_hi)
#define SYNC { if (!first) grid.sync(); first = false; }
  RUN(0) { SYNC; phase_prep(p, smem); }
#pragma unroll 1
  for (int l = 0; l < 2; ++l) {
    const int base = 1 + 9 * l;
    const float* ada_l = p.ada + (size_t)l * 32 * ADAW;
    const bf16_t* Wl = p.wt + (size_t)l * WLAYER;
    const float* xin = (l == 0) ? p.x : p.out;
    RUN(base + 0) { SYNC; phase_norm(xin, p.norm_mix_w + l * DM, ada_l, 0, 1024, p.h); }
    RUN(base + 1) { SYNC; phase_gemm_in(p, l, smem); }
    RUN(base + 2) { SYNC; if (l > 0) phase_vlo(p, l, smem); }
    RUN(base + 3) { SYNC; phase_mix(p, l, smem); }
    RUN(base + 4) { SYNC; phase_merge(p, l, smem); }
    RUN(base + 5) { SYNC; phase_gemm_res(p.u + 1024, US, Wl + WOUT, DM, xin, p.out, ada_l, 2048, smem); }
    RUN(base + 6) { SYNC; phase_norm(p.out, p.norm_ffn_w + l * DM, ada_l, 3072, 4096, p.h); }
    RUN(base + 7) { SYNC; phase_ffn_in(p, l, smem); }
    RUN(base + 8) { SYNC; phase_gemm_res(p.u, FFH, Wl + WFO, FFH, p.out, p.out, ada_l, 5120, smem); }
  }
  RUN(NPHASE - 1) { SYNC; phase_final(p.out, p.final_norm_w); }
}

extern "C" void kernel_launch(void* const* d_in, const int* in_sizes, int n_in, void* d_out, int out_size, void* d_ws,
                              size_t ws_size, hipStream_t stream) {
  Params p{};
  p.x = (const float*)d_in[0]; p.c = (const float*)d_in[1]; p.pos = (const int*)d_in[2];
  p.ada_w = (const float*)d_in[3]; p.ada_b = (const float*)d_in[4]; p.norm_mix_w = (const float*)d_in[5];
  p.norm_ffn_w = (const float*)d_in[6]; p.w_in = (const float*)d_in[7]; p.da_lambda = (const float*)d_in[8];
  p.da_subln_w = (const float*)d_in[9]; p.hg_lb = (const float*)d_in[10]; p.hg_norm_w = (const float*)d_in[11];
  p.rw_mu = (const float*)d_in[12]; p.rw_w0 = (const float*)d_in[13]; p.rw_w2 = (const float*)d_in[14];
  p.rw_a0 = (const float*)d_in[15]; p.rw_a2 = (const float*)d_in[16]; p.rw_g2 = (const float*)d_in[17];
  p.rw_k_k = (const float*)d_in[18]; p.rw_k_a = (const float*)d_in[19]; p.rw_r_k = (const float*)d_in[20];
  p.rw_gn_w = (const float*)d_in[21]; p.rw_gn_b = (const float*)d_in[22]; p.rw_v0 = (const float*)d_in[23];
  p.rw_v1 = (const float*)d_in[24]; p.rw_v2 = (const float*)d_in[25]; p.w_br_a = (const float*)d_in[26];
  p.w_br_b = (const float*)d_in[27]; p.w_br_c = (const float*)d_in[28]; p.w_out = (const float*)d_in[29];
  p.ffn_w_in = (const float*)d_in[30]; p.ffn_w_out = (const float*)d_in[31]; p.final_norm_w = (const float*)d_in[32];
  p.out = (float*)d_out;
  char* ws = (char*)d_ws;
  size_t off = 0;
  auto take = [&](size_t bytes) { char* r = ws + off; off += (bytes + 255) & ~(size_t)255; return r; };
  p.counters = (unsigned*)take(256);
  p.wt = (bf16_t*)take(2 * WLAYER * 2);
  p.ada = (float*)take((size_t)2 * 32 * ADAW * 4);
  p.h = (bf16_t*)take((size_t)T_TOK * DM * 2);
  p.u = (bf16_t*)take((size_t)T_TOK * US * 2);
  p.vT = (bf16_t*)take((size_t)T_TOK * 512 * 2);
  p.vfirst = (bf16_t*)take((size_t)T_TOK * 512 * 2);
  p.vlo = (float*)take((size_t)T_TOK * 32 * 4);
  if (off > ws_size) { fprintf(stderr, "workspace too small: need %zu have %zu\n", off, ws_size); return; }

  static int grid_blocks = 0;
  if (!grid_blocks) {
    hipFuncSetAttribute((const void*)mega, hipFuncAttributeMaxDynamicSharedMemorySize, SMEM_BYTES);
    int dev = 0, cus = 0, per_cu = 0;
    hipGetDevice(&dev);
    hipDeviceGetAttribute(&cus, hipDeviceAttributeMultiprocessorCount, dev);
    hipOccupancyMaxActiveBlocksPerMultiprocessor(&per_cu, mega, 256, SMEM_BYTES);
    if (per_cu > 2) per_cu = 2;
    if (per_cu < 1) per_cu = 1;
    grid_blocks = cus * per_cu;
  }
#if SINGLE_LAUNCH
  int lo = 0, hi = NPHASE;
  void* args[] = {&p, &lo, &hi};
  hipError_t e = hipLaunchCooperativeKernel((void*)mega, dim3(grid_blocks), dim3(256), args, SMEM_BYTES, stream);
  if (e != hipSuccess) fprintf(stderr, "cooperative launch failed: %s (grid %d)\n", hipGetErrorString(e), grid_blocks);
#else
  for (int ph = 0; ph < NPHASE; ++ph) {
    if (ph == 3) continue;
    hipLaunchKernelGGL(mega, dim3(grid_blocks), dim3(256), SMEM_BYTES, stream, p, ph, ph + 1);
  }
#endif
}
```

```cpp
#include <hip/hip_runtime.h>
#include <hip/hip_cooperative_groups.h>
#include <stdint.h>
#include <cstdio>
namespace cg = cooperative_groups;

typedef unsigned short bf16_t;
typedef short bf16x8 __attribute__((ext_vector_type(8)));
typedef float f32x4 __attribute__((ext_vector_type(4)));
#define DEV __device__ __forceinline__
#define PHASE __device__ __forceinline__

#ifndef SINGLE_LAUNCH
#define SINGLE_LAUNCH 1
#endif

constexpr int T_TOK = 65536, DM = 1024, SEQ = 2048, US = 4864, ADAW = 6144, FFH = 2816;
constexpr size_t WIN = 0, WBA = 8650752, WBB = 9175040, WBC = 9699328, WOUT = 10223616, WFI = 11272192,
                 WFO = 17039360, WLAYER = 19922944;
constexpr int SMEM_BYTES = 80896;
constexpr int NPHASE = 20;

struct Params {
  const float* x; const float* c; const int* pos;
  const float *ada_w, *ada_b, *norm_mix_w, *norm_ffn_w, *w_in, *da_lambda, *da_subln_w, *hg_lb, *hg_norm_w;
  const float *rw_mu, *rw_w0, *rw_w2, *rw_a0, *rw_a2, *rw_g2, *rw_k_k, *rw_k_a, *rw_r_k, *rw_gn_w, *rw_gn_b;
  const float *rw_v0, *rw_v1, *rw_v2, *w_br_a, *w_br_b, *w_br_c, *w_out, *ffn_w_in, *ffn_w_out, *final_norm_w;
  float* out;
  bf16_t* wt; float* ada; bf16_t* h; bf16_t* u; bf16_t* vT; bf16_t* vfirst; float* vlo; unsigned* counters;
};

DEV unsigned short f2bf(float f) { unsigned u = __float_as_uint(f); u += 0x7FFFu + ((u >> 16) & 1u); return (unsigned short)(u >> 16); }
DEV float bf2f(unsigned short h) { return __uint_as_float(((unsigned)h) << 16); }
DEV unsigned pack2(float a, float b) { return (unsigned)f2bf(a) | ((unsigned)f2bf(b) << 16); }
DEV float sigm(float x) { return 1.f / (1.f + __expf(-x)); }
DEV float lo16(unsigned v) { return __uint_as_float(v << 16); }
DEV float hi16(unsigned v) { return __uint_as_float(v & 0xFFFF0000u); }
#define UNPACK8(v, f) { f[0]=lo16(v.x); f[1]=hi16(v.x); f[2]=lo16(v.y); f[3]=hi16(v.y); f[4]=lo16(v.z); f[5]=hi16(v.z); f[6]=lo16(v.w); f[7]=hi16(v.w); }
#define PACK8(f) make_uint4(pack2(f[0],f[1]), pack2(f[2],f[3]), pack2(f[4],f[5]), pack2(f[6],f[7]))
template <int CTRL> DEV float dpp(float x) { return __int_as_float(__builtin_amdgcn_update_dpp(0, __float_as_int(x), CTRL, 0xF, 0xF, true)); }
DEV float red8_sum(float x) { x += dpp<0xB1>(x); x += dpp<0x4E>(x); x += dpp<0x141>(x); return x; }
DEV float red16_sum(float x) { x = red8_sum(x); x += dpp<0x140>(x); return x; }
DEV float red16_max(float x) { x = fmaxf(x, dpp<0xB1>(x)); x = fmaxf(x, dpp<0x4E>(x)); x = fmaxf(x, dpp<0x141>(x)); x = fmaxf(x, dpp<0x140>(x)); return x; }
DEV float wave_sum(float x) {
#pragma unroll
  for (int o = 32; o >= 1; o >>= 1) x += __shfl_xor(x, o, 64);
  return x;
}
DEV int opaque_tid() { int t = threadIdx.x; asm volatile("" : "+v"(t)); return t; }
DEV bf16x8 as_frag(uint4 v) { union { uint4 u; bf16x8 b; } c; c.u = v; return c.b; }
#define MFMA(a, b, c) __builtin_amdgcn_mfma_f32_16x16x32_bf16(a, b, c, 0, 0, 0)

template <int NT>
DEV void gemm_tile(const int tid, const bf16_t* A, int lda, const bf16_t* B, int ldb, int K, char* smem,
                   f32x4 (&acc)[4][NT]) {
  constexpr int BN = NT * 32;
  constexpr int LS = 64;
  bf16_t* As = (bf16_t*)smem;
  bf16_t* Bs = As + 2 * 128 * LS;
  const int lane = tid & 63, wave = tid >> 6, wr = wave >> 1, wc = wave & 1;
  const int fr = lane & 15, fq = lane >> 4;
  constexpr int NB = BN * 8 / 256;
#pragma unroll
  for (int m = 0; m < 4; ++m)
#pragma unroll
    for (int n = 0; n < NT; ++n) acc[m][n] = (f32x4){0.f, 0.f, 0.f, 0.f};
  const int nk = K >> 6;
  const int lrow = tid >> 3, lcc = tid & 7;
  const bf16_t* Ap = A + (size_t)lrow * lda + ((lcc ^ (lrow & 7)) * 8);
  const bf16_t* Bp = B + (size_t)lrow * ldb + ((lcc ^ (lrow & 7)) * 8);
  const size_t a32 = (size_t)32 * lda, b32 = (size_t)32 * ldb;
  const int rofs0 = (fq ^ (fr & 7)) * 8, rofs1 = rofs0 ^ 32;
#define GT_DMA(buf, koff)                                                                                    \
  {                                                                                                          \
    bf16_t* Ad = As + (buf) * 128 * LS + tid * 8;                                                            \
    bf16_t* Bd = Bs + (buf) * BN * LS + tid * 8;                                                             \
    _Pragma("unroll") for (int i = 0; i < 4; ++i)                                                            \
      __builtin_amdgcn_global_load_lds((const unsigned*)(Ap + i * a32 + (koff)), (unsigned*)(Ad + i * 32 * LS), 16, 0, 0); \
    _Pragma("unroll") for (int i = 0; i < NB; ++i)                                                           \
      __builtin_amdgcn_global_load_lds((const unsigned*)(Bp + i * b32 + (koff)), (unsigned*)(Bd + i * 32 * LS), 16, 0, 0); \
  }
  GT_DMA(0, 0)
  asm volatile("s_waitcnt vmcnt(0)" ::: "memory");
  __syncthreads();
  for (int kt = 0; kt < nk; ++kt) {
    const int buf = kt & 1;
    if (kt + 1 < nk) GT_DMA(buf ^ 1, (kt + 1) * 64)
    const bf16_t* Ab = As + buf * 128 * LS + (wr * 64 + fr) * LS;
    const bf16_t* Bb = Bs + buf * BN * LS + (wc * (NT * 16) + fr) * LS;
#pragma unroll
    for (int ks = 0; ks < 2; ++ks) {
      const int ro = ks ? rofs1 : rofs0;
      bf16x8 af[4], bfr[NT];
#pragma unroll
      for (int m = 0; m < 4; ++m) af[m] = *(const bf16x8*)(Ab + m * 16 * LS + ro);
#pragma unroll
      for (int n = 0; n < NT; ++n) bfr[n] = *(const bf16x8*)(Bb + n * 16 * LS + ro);
#pragma unroll
      for (int m = 0; m < 4; ++m)
#pragma unroll
        for (int n = 0; n < NT; ++n) acc[m][n] = MFMA(af[m], bfr[n], acc[m][n]);
    }
    asm volatile("s_waitcnt vmcnt(0)" ::: "memory");
    __syncthreads();
  }
#undef GT_DMA
}

template <int NT>
DEV void stage_acc(const int tid, float* Cs, const f32x4 (&acc)[4][NT]) {
  constexpr int LDC = NT * 32 + 4;
  const int lane = tid & 63, wave = tid >> 6, wr = wave >> 1, wc = wave & 1, fr = lane & 15, fq = lane >> 4;
#pragma unroll
  for (int m = 0; m < 4; ++m)
#pragma unroll
    for (int n = 0; n < NT; ++n)
#pragma unroll
      for (int j = 0; j < 4; ++j) Cs[(wr * 64 + m * 16 + fq * 4 + j) * LDC + wc * (NT * 16) + n * 16 + fr] = acc[m][n][j];
}

DEV bool tile_for(int it, int nM, int nN, int& tm, int& tn) {
  const int nx = gridDim.x >> 3;
  const int xcd = blockIdx.x & 7, local = blockIdx.x >> 3;
  const long id = ((long)it * 8 + xcd) * nx + local;
  if (local >= nx || id >= (long)nM * nN) return false;
  const int per_group = 8 * nN;
  const int g = (int)(id / per_group), r = (int)(id % per_group);
  tn = r >> 3; tm = g * 8 + (r & 7);
  return true;
}

PHASE void phase_prep(const Params& p, char* smem) {
  const int tid = opaque_tid();
  if (blockIdx.x == 0 && tid < 8) p.counters[tid] = 0u;
  float* tile = (float*)smem;
  const int NCONV = 2 * 4864, NADA = 192;
  for (int item = blockIdx.x; item < NCONV + NADA; item += gridDim.x) {
    if (item < NCONV) {
      const int l = item / 4864; int r = item % 4864;
      const float* src; int K, Nsrc, nT, perm = 0; size_t dst;
      if (r < 2112) { src = p.w_in + (size_t)l * 1024 * 8448; K = 1024; Nsrc = 8448; dst = WIN; nT = 132; }
      else if (r < 2240) { r -= 2112; src = p.w_br_a + (size_t)l * 512 * 1024; K = 512; Nsrc = 1024; dst = WBA; nT = 16; }
      else if (r < 2368) { r -= 2240; src = p.w_br_b + (size_t)l * 512 * 1024; K = 512; Nsrc = 1024; dst = WBB; nT = 16; }
      else if (r < 2496) { r -= 2368; src = p.w_br_c + (size_t)l * 512 * 1024; K = 512; Nsrc = 1024; dst = WBC; nT = 16; }
      else if (r < 2752) { r -= 2496; src = p.w_out + (size_t)l * 1024 * 1024; K = 1024; Nsrc = 1024; dst = WOUT; nT = 16; }
      else if (r < 4160) { r -= 2752; src = p.ffn_w_in + (size_t)l * 1024 * 5632; K = 1024; Nsrc = 5632; dst = WFI; nT = 88; perm = 1; }
      else { r -= 4160; src = p.ffn_w_out + (size_t)l * 2816 * 1024; K = 2816; Nsrc = 1024; dst = WFO; nT = 16; }
      const int kt = r / nT, nt = r % nT;
      const int colbase = perm ? ((nt & 1) * FFH + 64 * (nt >> 1)) : nt * 64;
      __syncthreads();
#pragma unroll
      for (int i = 0; i < 16; ++i) {
        const int k = i * 4 + (tid >> 6), j = tid & 63;
        tile[k * 65 + j] = src[(size_t)(kt * 64 + k) * Nsrc + colbase + j];
      }
      __syncthreads();
      const int row = tid >> 2, kc = (tid & 3) * 16;
      float f[16];
#pragma unroll
      for (int i = 0; i < 16; ++i) f[i] = tile[(kc + i) * 65 + row];
      bf16_t* d = p.wt + (size_t)l * WLAYER + dst + (size_t)(nt * 64 + row) * K + kt * 64 + kc;
      *(uint4*)d = make_uint4(pack2(f[0], f[1]), pack2(f[2], f[3]), pack2(f[4], f[5]), pack2(f[6], f[7]));
      *(uint4*)(d + 8) = make_uint4(pack2(f[8], f[9]), pack2(f[10], f[11]), pack2(f[12], f[13]), pack2(f[14], f[15]));
    } else {
      const int a = item - NCONV;
      const int l = a / 96, r = a % 96, ntile = r >> 2, bg = r & 3;
      float* cact = (float*)smem;
      __syncthreads();
      for (int i = tid; i < 8 * 1024; i += 256) {
        const float cv = p.c[(size_t)(bg * 8 + (i >> 10)) * DM + (i & 1023)];
        cact[i] = cv * sigm(cv);
      }
      __syncthreads();
      const int n = ntile * 256 + tid;
      const float* W = p.ada_w + (size_t)l * DM * ADAW + n;
      float acc[8];
#pragma unroll
      for (int b = 0; b < 8; ++b) acc[b] = 0.f;
      for (int k = 0; k < DM; ++k) {
        const float w = W[(size_t)k * ADAW];
#pragma unroll
        for (int b = 0; b < 8; ++b) acc[b] += cact[b * 1024 + k] * w;
      }
      const float bias = p.ada_b[l * ADAW + n];
#pragma unroll
      for (int b = 0; b < 8; ++b) p.ada[((size_t)l * 32 + bg * 8 + b) * ADAW + n] = acc[b] + bias;
    }
  }
}

PHASE void phase_norm(const float* __restrict__ x, const float* __restrict__ w, const float* __restrict__ ada_l,
                    int shift_off, int scale_off, bf16_t* __restrict__ h) {
  const int tid = opaque_tid();
  const int lane = tid & 63, wave = tid >> 6;
  for (int row = blockIdx.x * 4 + wave; row < T_TOK; row += gridDim.x * 4) {
    const float* xr = x + (size_t)row * DM;
    float4 v[4]; float ss = 0.f;
#pragma unroll
    for (int i = 0; i < 4; ++i) { v[i] = *(const float4*)(xr + i * 256 + lane * 4); ss += v[i].x * v[i].x + v[i].y * v[i].y + v[i].z * v[i].z + v[i].w * v[i].w; }
    ss = wave_sum(ss);
    const float rstd = rsqrtf(ss * (1.f / DM) + 1e-6f);
    const float* ad = ada_l + (size_t)(row / SEQ) * ADAW;
#pragma unroll
    for (int i = 0; i < 4; ++i) {
      const int col = i * 256 + lane * 4;
      const float4 ww = *(const float4*)(w + col), sc = *(const float4*)(ad + scale_off + col), sh = *(const float4*)(ad + shift_off + col);
      const float o0 = v[i].x * rstd * ww.x * (1.f + sc.x) + sh.x, o1 = v[i].y * rstd * ww.y * (1.f + sc.y) + sh.y;
      const float o2 = v[i].z * rstd * ww.z * (1.f + sc.z) + sh.z, o3 = v[i].w * rstd * ww.w * (1.f + sc.w) + sh.w;
      *(uint2*)(h + (size_t)row * DM + col) = make_uint2(pack2(o0, o1), pack2(o2, o3));
    }
  }
}

PHASE void phase_final(float* __restrict__ x, const float* __restrict__ w) {
  const int tid = opaque_tid();
  const int lane = tid & 63, wave = tid >> 6;
  for (int row = blockIdx.x * 4 + wave; row < T_TOK; row += gridDim.x * 4) {
    float* xr = x + (size_t)row * DM;
    float4 v[4]; float ss = 0.f;
#pragma unroll
    for (int i = 0; i < 4; ++i) { v[i] = *(const float4*)(xr + i * 256 + lane * 4); ss += v[i].x * v[i].x + v[i].y * v[i].y + v[i].z * v[i].z + v[i].w * v[i].w; }
    ss = wave_sum(ss);
    const float rstd = rsqrtf(ss * (1.f / DM) + 1e-6f);
#pragma unroll
    for (int i = 0; i < 4; ++i) {
      const int col = i * 256 + lane * 4;
      const float4 ww = *(const float4*)(w + col);
      *(float4*)(xr + col) = make_float4(v[i].x * rstd * ww.x, v[i].y * rstd * ww.y, v[i].z * rstd * ww.z, v[i].w * rstd * ww.w);
    }
  }
}

PHASE void phase_gemm_in(const Params& p, int l, char* smem) {
  const bf16_t* Wt = p.wt + (size_t)l * WLAYER + WIN;
  float* Cs = (float*)smem;
  const int tid = opaque_tid();
  for (int it = 0;; ++it) {
    int tm, tn;
    if (!tile_for(it, 512, 42, tm, tn)) break;
    f32x4 acc[4][4];
    gemm_tile<4>(tid, p.h + (size_t)tm * 128 * DM, DM, Wt + (size_t)tn * 128 * DM, DM, DM, smem, acc);
    stage_acc<4>(tid, Cs, acc);
    __syncthreads();
    const size_t row0 = (size_t)tm * 128;
    if (tn < 8) {
      const float qs = (tn < 4) ? 0.125f : 1.f;
      const int ch = tid & 15, g = ch >> 3, cc = ch & 7;
      if (cc < 4) {
#pragma unroll 1
        for (int i = 0; i < 8; ++i) {
          const int r = (tid >> 4) + i * 16;
          const float pos = (float)p.pos[row0 + r];
          const float* c1 = Cs + r * 132 + g * 64 + cc * 8;
          float o1[8], o2[8];
#pragma unroll
          for (int e = 0; e < 8; ++e) {
            const float x1 = c1[e], x2 = c1[32 + e];
            const float inv = exp2f(-(float)(cc * 8 + e) * 0.41524101186092029f);
            float rev = pos * inv * 0.15915494309189535f;
            rev -= rintf(rev);
            const float s = __builtin_amdgcn_sinf(rev), c = __builtin_amdgcn_cosf(rev);
            o1[e] = (x1 * c - x2 * s) * qs; o2[e] = (x2 * c + x1 * s) * qs;
          }
          bf16_t* d = p.u + (row0 + r) * US + tn * 128 + g * 64 + cc * 8;
          *(uint4*)d = PACK8(o1);
          *(uint4*)(d + 32) = PACK8(o2);
        }
      }
    } else if (tn < 12) {
      const int b = (int)(row0 / SEQ), s0 = (int)(row0 % SEQ), vc0 = (tn - 8) * 128;
      const int rch = tid & 15;
#pragma unroll 1
      for (int i = 0; i < 8; ++i) {
        const int c = (tid >> 4) + i * 16;
        float f[8];
#pragma unroll
        for (int j = 0; j < 8; ++j) f[j] = Cs[(rch * 8 + j) * 132 + c];
        *(uint4*)(p.vT + ((size_t)b * 512 + vc0 + c) * SEQ + s0 + rch * 8) = PACK8(f);
      }
    } else {
      const int ch = tid & 15;
#pragma unroll 1
      for (int i = 0; i < 8; ++i) {
        const int r = (tid >> 4) + i * 16;
        const float4 a = *(const float4*)(Cs + r * 132 + ch * 8), b = *(const float4*)(Cs + r * 132 + ch * 8 + 4);
        *(uint4*)(p.u + (row0 + r) * US + tn * 128 - 512 + ch * 8) = make_uint4(pack2(a.x, a.y), pack2(a.z, a.w), pack2(b.x, b.y), pack2(b.z, b.w));
      }
    }
    __syncthreads();
  }
}

PHASE void phase_vlo(const Params& p, int l, char* smem) {
  float* vs = (float*)smem;
  const int tid = opaque_tid();
  const float* mu = p.rw_mu + (size_t)l * 1792 + 1024;
  const float* v1 = p.rw_v1;
  for (int item = blockIdx.x; item < T_TOK / 32; item += gridDim.x) {
    const size_t tok0 = (size_t)item * 32;
    __syncthreads();
#pragma unroll 1
    for (int i = 0; i < 8; ++i) {
      const int c = tid + i * 256;
      const int t = c >> 6, cc = c & 63;
      const size_t tok = tok0 + t;
      const uint4 cur = *(const uint4*)(p.u + tok * US + 3072 + 1024 + cc * 8);
      uint4 prv = make_uint4(0, 0, 0, 0);
      if ((tok % SEQ) != 0) prv = *(const uint4*)(p.u + (tok - 1) * US + 3072 + 1024 + cc * 8);
      float a[8], b[8];
      UNPACK8(cur, a); UNPACK8(prv, b);
#pragma unroll
      for (int e = 0; e < 8; ++e) vs[t * 512 + cc * 8 + e] = a[e] + (b[e] - a[e]) * mu[cc * 8 + e];
    }
    __syncthreads();
    const int j = tid & 31, tg = tid >> 5;
    float acc[4] = {0.f, 0.f, 0.f, 0.f};
    for (int k = 0; k < 512; ++k) {
      const float w = v1[k * 32 + j];
#pragma unroll
      for (int i = 0; i < 4; ++i) acc[i] += vs[(tg * 4 + i) * 512 + k] * w;
    }
#pragma unroll
    for (int i = 0; i < 4; ++i) p.vlo[(tok0 + tg * 4 + i) * 32 + j] = acc[i];
  }
}

PHASE void att_item(const Params& p, int l, int item, char* smem) {
  const int qc = 31 - (item >> 7);
  const int bh = item & 127, b = bh >> 2, h = bh & 3;
  const int tid = opaque_tid(), lane = tid & 63, wave = tid >> 6, fr = lane & 15, fq = lane >> 4;
  const int m = wave >> 1, rh = wave & 1;
  bf16_t* Ks = (bf16_t*)smem;
  bf16_t* Vt = Ks + 2 * 64 * 72;
  bf16_t* Ps = Vt + 128 * 72;
  float* Ox = (float*)smem;
  const size_t tok0 = (size_t)b * SEQ + (size_t)qc * 64;
  const float* lv = p.da_lambda + (size_t)l * 256;
  float d1 = 0.f, d2 = 0.f;
  for (int i = 0; i < 64; ++i) { d1 += lv[i] * lv[64 + i]; d2 += lv[128 + i] * lv[192 + i]; }
  const float lam_init = 0.8f - 0.6f * __expf(-0.3f * (float)l);
  const float lam = __expf(d1) - __expf(d2) + lam_init;

  bf16x8 qf[2][2];
#pragma unroll
  for (int mt = 0; mt < 2; ++mt)
#pragma unroll
    for (int ks = 0; ks < 2; ++ks)
      qf[mt][ks] = *(const bf16x8*)(p.u + (tok0 + rh * 32 + mt * 16 + fr) * US + h * 128 + m * 64 + ks * 32 + fq * 8);
  f32x4 o[2][8];
  float mx[2][4], ls[2][4];
#pragma unroll
  for (int mt = 0; mt < 2; ++mt) {
#pragma unroll
    for (int n = 0; n < 8; ++n) o[mt][n] = (f32x4){0.f, 0.f, 0.f, 0.f};
#pragma unroll
    for (int j = 0; j < 4; ++j) { mx[mt][j] = -1e30f; ls[mt][j] = 0.f; }
  }
  bf16_t* Pw = Ps + wave * 32 * 72;
  for (int kt = 0; kt <= qc; ++kt) {
    __syncthreads();
#pragma unroll
    for (int i = 0; i < 4; ++i) {
      const int c = tid + i * 256;
      const int mm = c >> 9, key = (c >> 3) & 63, cc = c & 7;
      *(uint4*)(Ks + (mm * 64 + key) * 72 + cc * 8) =
          *(const uint4*)(p.u + ((size_t)b * SEQ + kt * 64 + key) * US + 512 + h * 128 + mm * 64 + cc * 8);
    }
#pragma unroll
    for (int i = 0; i < 4; ++i) {
      const int c = tid + i * 256;
      const int dim = c >> 3, cc = c & 7;
      *(uint4*)(Vt + dim * 72 + cc * 8) = *(const uint4*)(p.vT + ((size_t)b * 512 + h * 128 + dim) * SEQ + kt * 64 + cc * 8);
    }
    __syncthreads();
    f32x4 s[2][4];
#pragma unroll
    for (int mt = 0; mt < 2; ++mt)
#pragma unroll
      for (int n = 0; n < 4; ++n) s[mt][n] = (f32x4){0.f, 0.f, 0.f, 0.f};
#pragma unroll
    for (int ks = 0; ks < 2; ++ks)
#pragma unroll
      for (int n = 0; n < 4; ++n) {
        const bf16x8 kf = *(const bf16x8*)(Ks + (m * 64 + n * 16 + fr) * 72 + ks * 32 + fq * 8);
#pragma unroll
        for (int mt = 0; mt < 2; ++mt) s[mt][n] = MFMA(qf[mt][ks], kf, s[mt][n]);
      }
#pragma unroll
    for (int mt = 0; mt < 2; ++mt)
#pragma unroll
      for (int j = 0; j < 4; ++j) {
        float tmax = fmaxf(fmaxf(s[mt][0][j], s[mt][1][j]), fmaxf(s[mt][2][j], s[mt][3][j]));
        tmax = red16_max(tmax);
        const float mnew = fmaxf(mx[mt][j], tmax);
        const float alpha = __expf(mx[mt][j] - mnew);
        float rs = 0.f;
#pragma unroll
        for (int n = 0; n < 4; ++n) {
          const float pv = __expf(s[mt][n][j] - mnew);
          rs += pv;
          Pw[(mt * 16 + fq * 4 + j) * 72 + n * 16 + fr] = f2bf(pv);
        }
        rs = red16_sum(rs);
        ls[mt][j] = ls[mt][j] * alpha + rs;
        mx[mt][j] = mnew;
#pragma unroll
        for (int n = 0; n < 8; ++n) o[mt][n][j] *= alpha;
      }
    __syncthreads();
#pragma unroll
    for (int ks = 0; ks < 2; ++ks) {
      bf16x8 pf[2];
#pragma unroll
      for (int mt = 0; mt < 2; ++mt) pf[mt] = *(const bf16x8*)(Pw + (mt * 16 + fr) * 72 + ks * 32 + fq * 8);
#pragma unroll
      for (int n = 0; n < 8; ++n) {
        const bf16x8 vf = *(const bf16x8*)(Vt + (n * 16 + fr) * 72 + ks * 32 + fq * 8);
#pragma unroll
        for (int mt = 0; mt < 2; ++mt) o[mt][n] = MFMA(pf[mt], vf, o[mt][n]);
      }
    }
  }
  __syncthreads();
#pragma unroll
  for (int mt = 0; mt < 2; ++mt)
#pragma unroll
    for (int j = 0; j < 4; ++j) {
      const float inv = 1.f / ls[mt][j];
#pragma unroll
      for (int n = 0; n < 8; ++n) o[mt][n][j] *= inv;
    }
  if (m == 1) {
#pragma unroll
    for (int mt = 0; mt < 2; ++mt)
#pragma unroll
      for (int n = 0; n < 8; ++n)
#pragma unroll
        for (int j = 0; j < 4; ++j) Ox[(rh * 32 + mt * 16 + fq * 4 + j) * 132 + n * 16 + fr] = o[mt][n][j];
  }
  __syncthreads();
  if (m == 0) {
    const float* sw = p.da_subln_w + (size_t)l * 128;
    float wv[8];
#pragma unroll
    for (int n = 0; n < 8; ++n) wv[n] = sw[n * 16 + fr] * (1.f - lam_init);
#pragma unroll
    for (int mt = 0; mt < 2; ++mt)
#pragma unroll
      for (int j = 0; j < 4; ++j) {
        float ss = 0.f;
        float d[8];
#pragma unroll
        for (int n = 0; n < 8; ++n) {
          d[n] = o[mt][n][j] - lam * Ox[(rh * 32 + mt * 16 + fq * 4 + j) * 132 + n * 16 + fr];
          ss += d[n] * d[n];
        }
        ss = red16_sum(ss);
        const float rstd = rsqrtf(ss * (1.f / 128.f) + 1e-6f);
        bf16_t* dst = p.u + (tok0 + rh * 32 + mt * 16 + fq * 4 + j) * US + h * 128 + fr;
#pragma unroll
        for (int n = 0; n < 8; ++n) dst[n * 16] = f2bf(d[n] * rstd * wv[n]);
      }
  }
  __syncthreads();
}

PHASE void hgrn_item(const Params& p, int l, int item, char* smem) {
  const int b = item >> 2, h = item & 3;
  const int tid = opaque_tid(), lane = tid & 63, wave = tid >> 6, fr = lane & 15, fq = lane >> 4;
  bf16_t* Qs = (bf16_t*)smem;
  bf16_t* Kn = Qs + 32 * 136;
  bf16_t* KT = Kn + 32 * 136;
  bf16_t* VT = KT + 128 * 40;
  bf16_t* Ps = VT + 128 * 40;
  bf16_t* ST = Ps + 32 * 40;
  float* lfb = (float*)ST;
  float* red = (float*)(ST + 128 * 136);
  float* blast = red + 64;
  const int t_ = tid >> 3, d0 = (tid & 7) * 16;
  float lbv[16];
#pragma unroll
  for (int i = 0; i < 16; ++i) {
    const int c = h * 128 + d0 + i;
    lbv[i] = (l == 0) ? 0.f : sigm(p.hg_lb[512 + c] - p.hg_lb[c]);
  }
  f32x4 S[2][8];
#pragma unroll
  for (int mm = 0; mm < 2; ++mm)
#pragma unroll
    for (int n = 0; n < 8; ++n) S[mm][n] = (f32x4){0.f, 0.f, 0.f, 0.f};
  const float* nw = p.hg_norm_w + (size_t)l * 128;

  for (int ch = 0; ch < 64; ++ch) {
    const size_t tok0 = (size_t)b * SEQ + (size_t)ch * 32;
    __syncthreads();
    float qv[16], kv[16];
    {
      const bf16_t* base = p.u + (tok0 + t_) * US + h * 128 + d0;
      float zv[16], iv[16];
      { const uint4 a = *(const uint4*)(base + 1024), c = *(const uint4*)(base + 1024 + 8); float* z0 = zv; float* z1 = zv + 8; UNPACK8(a, z0); UNPACK8(c, z1); }
      { const uint4 a = *(const uint4*)(base + 1536), c = *(const uint4*)(base + 1536 + 8); float* z0 = iv; float* z1 = iv + 8; UNPACK8(a, z0); UNPACK8(c, z1); }
      { const uint4 a = *(const uint4*)(base + 2048), c = *(const uint4*)(base + 2048 + 8); float* z0 = qv; float* z1 = qv + 8; UNPACK8(a, z0); UNPACK8(c, z1); }
#pragma unroll
      for (int i = 0; i < 16; ++i) {
        const float z = zv[i], lb = lbv[i];
        const float ez = __expf(-fabsf(z));
        float lf;
        if (lb > 0.f) {
          const float sg = (z >= 0.f) ? 1.f / (1.f + ez) : ez / (1.f + ez);
          lf = __logf(lb + (1.f - lb) * sg);
        } else {
          lf = -(fmaxf(-z, 0.f) + __logf(1.f + ez));
        }
        const float sgn = (z >= 0.f) ? ez / (1.f + ez) : 1.f / (1.f + ez);
        kv[i] = (1.f - lb) * sgn;
        lfb[t_ * 128 + d0 + i] = lf;
        VT[(d0 + i) * 40 + t_] = f2bf(iv[i]);
      }
    }
    __syncthreads();
    if (tid < 128) {
      float bsum = 0.f;
#pragma unroll 8
      for (int t = 0; t < 32; ++t) { bsum += lfb[t * 128 + tid]; lfb[t * 128 + tid] = bsum; }
      blast[tid] = bsum;
    }
    __syncthreads();
    {
      float qo[16], ko[16];
#pragma unroll
      for (int i = 0; i < 16; ++i) {
        const float bb = lfb[t_ * 128 + d0 + i];
        qo[i] = qv[i] * __expf(bb);
        ko[i] = kv[i] * __expf(fminf(-bb, 80.f));
        KT[(d0 + i) * 40 + t_] = f2bf(ko[i]);
      }
      float* q0 = qo; float* q1 = qo + 8; float* k0 = ko; float* k1 = ko + 8;
      *(uint4*)(Qs + t_ * 136 + d0) = PACK8(q0);
      *(uint4*)(Qs + t_ * 136 + d0 + 8) = PACK8(q1);
      *(uint4*)(Kn + t_ * 136 + d0) = PACK8(k0);
      *(uint4*)(Kn + t_ * 136 + d0 + 8) = PACK8(k1);
    }
    __syncthreads();
#pragma unroll
    for (int mm = 0; mm < 2; ++mm)
#pragma unroll
      for (int n = 0; n < 8; ++n)
        *(uint2*)(ST + (n * 16 + fr) * 136 + wave * 32 + mm * 16 + fq * 4) =
            make_uint2(pack2(S[mm][n][0], S[mm][n][1]), pack2(S[mm][n][2], S[mm][n][3]));
    {
      const int mt = wave >> 1, nt = wave & 1;
      f32x4 sc = (f32x4){0.f, 0.f, 0.f, 0.f};
#pragma unroll
      for (int ks = 0; ks < 4; ++ks) {
        const bf16x8 a = *(const bf16x8*)(Qs + (mt * 16 + fr) * 136 + ks * 32 + fq * 8);
        const bf16x8 bb = *(const bf16x8*)(Kn + (nt * 16 + fr) * 136 + ks * 32 + fq * 8);
        sc = MFMA(a, bb, sc);
      }
#pragma unroll
      for (int j = 0; j < 4; ++j) {
        const int t = mt * 16 + fq * 4 + j, key = nt * 16 + fr;
        Ps[t * 40 + key] = f2bf(key <= t ? sc[j] : 0.f);
      }
    }
    __syncthreads();
    {
      const int mt = wave & 1, nb = (wave >> 1) * 4;
      f32x4 oo[4];
#pragma unroll
      for (int n = 0; n < 4; ++n) oo[n] = (f32x4){0.f, 0.f, 0.f, 0.f};
      {
        const bf16x8 a = *(const bf16x8*)(Ps + (mt * 16 + fr) * 40 + fq * 8);
#pragma unroll
        for (int n = 0; n < 4; ++n) {
          const bf16x8 bb = *(const bf16x8*)(VT + ((nb + n) * 16 + fr) * 40 + fq * 8);
          oo[n] = MFMA(a, bb, oo[n]);
        }
      }
#pragma unroll
      for (int ks = 0; ks < 4; ++ks) {
        const bf16x8 a = *(const bf16x8*)(Qs + (mt * 16 + fr) * 136 + ks * 32 + fq * 8);
#pragma unroll
        for (int n = 0; n < 4; ++n) {
          const bf16x8 bb = *(const bf16x8*)(ST + ((nb + n) * 16 + fr) * 136 + ks * 32 + fq * 8);
          oo[n] = MFMA(a, bb, oo[n]);
        }
      }
#pragma unroll
      for (int j = 0; j < 4; ++j) {
        float ss = 0.f;
#pragma unroll
        for (int n = 0; n < 4; ++n) ss += oo[n][j] * oo[n][j];
        ss = red16_sum(ss);
        if (fr == 0) red[(mt * 16 + fq * 4 + j) * 2 + (wave >> 1)] = ss;
      }
      __syncthreads();
#pragma unroll
      for (int j = 0; j < 4; ++j) {
        const int t = mt * 16 + fq * 4 + j;
        const float rstd = rsqrtf((red[t * 2] + red[t * 2 + 1]) * (1.f / 128.f) + 1e-6f);
        bf16_t* gp = p.u + (tok0 + t) * US + 2560 + h * 128 + nb * 16 + fr;
#pragma unroll
        for (int n = 0; n < 4; ++n) {
          const float g = bf2f(gp[n * 16]);
          gp[n * 16] = f2bf(oo[n][j] * rstd * nw[(nb + n) * 16 + fr] * (g * sigm(g)));
        }
      }
    }
    {
      bf16x8 af[2];
#pragma unroll
      for (int mm = 0; mm < 2; ++mm) af[mm] = *(const bf16x8*)(KT + (wave * 32 + mm * 16 + fr) * 40 + fq * 8);
#pragma unroll
      for (int n = 0; n < 8; ++n) {
        const bf16x8 bb = *(const bf16x8*)(VT + (n * 16 + fr) * 40 + fq * 8);
#pragma unroll
        for (int mm = 0; mm < 2; ++mm) S[mm][n] = MFMA(af[mm], bb, S[mm][n]);
      }
#pragma unroll
      for (int mm = 0; mm < 2; ++mm)
#pragma unroll
        for (int j = 0; j < 4; ++j) {
          const float e = __expf(blast[wave * 32 + mm * 16 + fq * 4 + j]);
#pragma unroll
          for (int n = 0; n < 8; ++n) S[mm][n][j] *= e;
        }
    }
  }
  __syncthreads();
}

DEV bf16x8 rw_afrag(const bf16_t* rawL, const float* mul, int row, int col, int mode) {
  const uint4 cur = *(const uint4*)(rawL + (row + 1) * 264 + col);
  const uint4 prv = *(const uint4*)(rawL + row * 264 + col);
  const float4 m0 = *(const float4*)(mul + col), m1 = *(const float4*)(mul + col + 4);
  const float mm[8] = {m0.x, m0.y, m0.z, m0.w, m1.x, m1.y, m1.z, m1.w};
  float a[8], b[8], o[8];
  UNPACK8(cur, a); UNPACK8(prv, b);
#pragma unroll
  for (int e = 0; e < 8; ++e) {
    float v = a[e] + (b[e] - a[e]) * mm[e];
    if (mode == 1) { const float t = __expf(-2.f * fabsf(v)); const float th = (1.f - t) / (1.f + t); v = (v >= 0.f) ? th : -th; }
    else if (mode == 2) v = sigm(v);
    o[e] = v;
  }
  return as_frag(PACK8(o));
}
DEV bf16x8 rw_bfrag(const float* W, int k0, int col) {
  float o[8];
#pragma unroll
  for (int e = 0; e < 8; ++e) o[e] = W[(size_t)(k0 + e) * 512 + col];
  return as_frag(PACK8(o));
}

PHASE void rwkv_item(const Params& p, int l, int item, char* smem) {
  const int b = item >> 3, h = item & 7;
  const int tid = opaque_tid(), lane = tid & 63, wave = tid >> 6, fr = lane & 15, fq = lane >> 4;
  float* R = (float*)smem;
  float* K = R + 2048; float* KK = K + 2048; float* W = KK + 2048; float* BB = W + 2048;
  float* V = BB + 2048; float* G = V + 2048; float* O = G + 2048;
  float* cst = O + 2048;
  float* mul = cst + 512;
  bf16_t* rawL = (bf16_t*)smem;
  float* vloL = (float*)(smem + 17424);
  const float* mu = p.rw_mu + (size_t)l * 1792;
  const int hc_n = h * 64 + wave * 16 + fr;
  bf16x8 w2f[2], a2f[2], g2f[4], v2f;
#pragma unroll
  for (int ks = 0; ks < 2; ++ks) {
    w2f[ks] = rw_bfrag(p.rw_w2 + (size_t)l * 64 * 512, ks * 32 + fq * 8, hc_n);
    a2f[ks] = rw_bfrag(p.rw_a2 + (size_t)l * 64 * 512, ks * 32 + fq * 8, hc_n);
  }
#pragma unroll
  for (int ks = 0; ks < 4; ++ks) g2f[ks] = rw_bfrag(p.rw_g2 + (size_t)l * 128 * 512, ks * 32 + fq * 8, hc_n);
  v2f = w2f[0];
  if (l > 0) v2f = rw_bfrag(p.rw_v2, fq * 8, hc_n);
  const float w0c = p.rw_w0[l * 512 + hc_n], a0c = p.rw_a0[l * 512 + hc_n];
  const float v0c = (l > 0) ? p.rw_v0[hc_n] : 0.f;
  const int t_ = tid >> 3, n0 = (tid & 7) * 8;
  __syncthreads();
  if (tid < 64) {
    const int hc = h * 64 + tid;
    cst[tid] = p.rw_k_k[l * 512 + hc]; cst[64 + tid] = p.rw_k_a[l * 512 + hc]; cst[128 + tid] = p.rw_r_k[l * 512 + hc];
    cst[192 + tid] = p.rw_gn_w[l * 512 + hc]; cst[256 + tid] = p.rw_gn_b[l * 512 + hc];
    cst[320 + tid] = mu[hc]; cst[384 + tid] = mu[512 + hc]; cst[448 + tid] = mu[1024 + hc];
  }
  mul[tid] = mu[1536 + tid];
  const float* kkc = cst + n0; const float* kac = cst + 64 + n0; const float* rkc = cst + 128 + n0;
  const float* gnw = cst + 192 + n0; const float* gnb = cst + 256 + n0;
  const float* mur = cst + 320 + n0; const float* muk = cst + 384 + n0; const float* muv = cst + 448 + n0;
  const int kq = lane & 7, row0 = wave * 16 + (lane >> 3), row1 = row0 + 8;
  float S0[8], S1[8];
#pragma unroll
  for (int e = 0; e < 8; ++e) { S0[e] = 0.f; S1[e] = 0.f; }

  uint4 pl0, pl1, pl2, pl3, pl4, pcr, pck, pcv, ppr, ppk, ppv, pvf;
  float4 pvl;
#define RW_PREFETCH(ch_)                                                                                    \
  {                                                                                                         \
    const size_t tk0 = (size_t)b * SEQ + (size_t)(ch_) * 32;                                                 \
    const bf16_t* lb_ = p.u + (tk0 - 1) * US + 3072 + 1536 + (tid & 31) * 8;                                 \
    const int r0_ = tid >> 5;                                                                               \
    pl0 = make_uint4(0, 0, 0, 0); if (!((ch_) == 0 && r0_ == 0)) pl0 = *(const uint4*)(lb_ + (size_t)r0_ * US); \
    pl1 = *(const uint4*)(lb_ + (size_t)(r0_ + 8) * US);                                                     \
    pl2 = *(const uint4*)(lb_ + (size_t)(r0_ + 16) * US);                                                    \
    pl3 = *(const uint4*)(lb_ + (size_t)(r0_ + 24) * US);                                                    \
    pl4 = make_uint4(0, 0, 0, 0); if (tid < 32) pl4 = *(const uint4*)(lb_ + (size_t)32 * US);                \
    const bf16_t* cu_ = p.u + (tk0 + t_) * US + 3072 + h * 64 + n0;                                          \
    pcr = *(const uint4*)cu_; pck = *(const uint4*)(cu_ + 512); pcv = *(const uint4*)(cu_ + 1024);           \
    if ((ch_) == 0 && t_ == 0) { ppr = make_uint4(0, 0, 0, 0); ppk = ppr; ppv = ppr; }                        \
    else { ppr = *(const uint4*)(cu_ - US); ppk = *(const uint4*)(cu_ - US + 512); ppv = *(const uint4*)(cu_ - US + 1024); } \
    if (l > 0) {                                                                                            \
      pvl = *(const float4*)(p.vlo + (tk0 + (tid >> 3)) * 32 + (tid & 7) * 4);                               \
      pvf = *(const uint4*)(p.vfirst + (tk0 + t_) * 512 + h * 64 + n0);                                      \
    } else { pvl = make_float4(0.f, 0.f, 0.f, 0.f); pvf = make_uint4(0, 0, 0, 0); }                          \
  }
  RW_PREFETCH(0)

  for (int ch = 0; ch < 64; ++ch) {
    const size_t tok0 = (size_t)b * SEQ + (size_t)ch * 32;
    __syncthreads();
    {
      const int r0_ = tid >> 5, cc_ = (tid & 31) * 8;
      *(uint4*)(rawL + r0_ * 264 + cc_) = pl0;
      *(uint4*)(rawL + (r0_ + 8) * 264 + cc_) = pl1;
      *(uint4*)(rawL + (r0_ + 16) * 264 + cc_) = pl2;
      *(uint4*)(rawL + (r0_ + 24) * 264 + cc_) = pl3;
      if (tid < 32) *(uint4*)(rawL + 32 * 264 + cc_) = pl4;
      *(float4*)(vloL + (tid >> 3) * 36 + (tid & 7) * 4) = pvl;
    }
    __syncthreads();
#pragma unroll 1
    for (int mt = 0; mt < 2; ++mt) {
      const int row = mt * 16 + fr;
      f32x4 aw = (f32x4){0.f, 0.f, 0.f, 0.f}, aa = aw, ag = aw, av = aw;
#pragma unroll
      for (int ks = 0; ks < 2; ++ks) {
        aw = MFMA(rw_afrag(rawL, mul, row, ks * 32 + fq * 8, 1), w2f[ks], aw);
        aa = MFMA(rw_afrag(rawL, mul, row, 64 + ks * 32 + fq * 8, 0), a2f[ks], aa);
      }
#pragma unroll
      for (int ks = 0; ks < 4; ++ks) ag = MFMA(rw_afrag(rawL, mul, row, 128 + ks * 32 + fq * 8, 2), g2f[ks], ag);
      if (l > 0) {
        const float4 x0 = *(const float4*)(vloL + row * 36 + fq * 8), x1 = *(const float4*)(vloL + row * 36 + fq * 8 + 4);
        const uint4 pk = make_uint4(pack2(x0.x, x0.y), pack2(x0.z, x0.w), pack2(x1.x, x1.y), pack2(x1.z, x1.w));
        av = MFMA(as_frag(pk), v2f, av);
      }
#pragma unroll
      for (int j = 0; j < 4; ++j) {
        const int t = mt * 16 + fq * 4 + j, n = wave * 16 + fr;
        const float wv = -(w0c + aw[j]);
        const float sp = fmaxf(wv, 0.f) + __logf(1.f + __expf(-fabsf(wv)));
        const float wl = -sp - 0.5f;
        W[t * 64 + n] = __expf(-__expf(wl));
        BB[t * 64 + n] = sigm(a0c + aa[j]);
        G[t * 64 + n] = ag[j];
        if (l > 0) O[t * 64 + n] = sigm(v0c + av[j]);
      }
    }
    __syncthreads();
    {
      const size_t tok = tok0 + t_;
      float cr[8], ck[8], cv[8], pr[8], pk[8], pv[8];
      UNPACK8(pcr, cr); UNPACK8(pck, ck); UNPACK8(pcv, cv);
      UNPACK8(ppr, pr); UNPACK8(ppk, pk); UNPACK8(ppv, pv);
      float kx[8], kkv[8], vs[8], ss = 0.f;
#pragma unroll
      for (int e = 0; e < 8; ++e) {
        R[t_ * 64 + n0 + e] = cr[e] + (pr[e] - cr[e]) * mur[e];
        kx[e] = ck[e] + (pk[e] - ck[e]) * muk[e];
        vs[e] = cv[e] + (pv[e] - cv[e]) * muv[e];
        kkv[e] = kx[e] * kkc[e]; ss += kkv[e] * kkv[e];
      }
      ss = red8_sum(ss);
      const float rn = rsqrtf(fmaxf(ss, 1e-24f));
#pragma unroll
      for (int e = 0; e < 8; ++e) {
        const float a = BB[t_ * 64 + n0 + e];
        const float kn = kkv[e] * rn;
        K[t_ * 64 + n0 + e] = kx[e] * (1.f + (a - 1.f) * kac[e]);
        KK[t_ * 64 + n0 + e] = kn;
        BB[t_ * 64 + n0 + e] = kn * a;
      }
      if (l == 0) {
        *(uint4*)(p.vfirst + tok * 512 + h * 64 + n0) = PACK8(vs);
      } else {
        float vf[8]; UNPACK8(pvf, vf);
#pragma unroll
        for (int e = 0; e < 8; ++e) vs[e] = vs[e] + (vf[e] - vs[e]) * O[t_ * 64 + n0 + e];
      }
#pragma unroll
      for (int e = 0; e < 8; ++e) V[t_ * 64 + n0 + e] = vs[e];
    }
    __syncthreads();
    if (ch + 1 < 64) RW_PREFETCH(ch + 1)
    asm volatile("" ::: "memory");
#pragma unroll 2
    for (int t = 0; t < 32; ++t) {
      const float* base = R + t * 64 + kq * 8;
      const float4 r0 = *(const float4*)(base), r1 = *(const float4*)(base + 4);
      const float4 k0 = *(const float4*)(base + 2048), k1 = *(const float4*)(base + 2048 + 4);
      const float4 q0 = *(const float4*)(base + 4096), q1 = *(const float4*)(base + 4096 + 4);
      const float4 w0 = *(const float4*)(base + 6144), w1 = *(const float4*)(base + 6144 + 4);
      const float4 b0 = *(const float4*)(base + 8192), b1 = *(const float4*)(base + 8192 + 4);
      const float va = V[t * 64 + row0], vb = V[t * 64 + row1];
      const float rr[8] = {r0.x, r0.y, r0.z, r0.w, r1.x, r1.y, r1.z, r1.w};
      const float ww[8] = {w0.x, w0.y, w0.z, w0.w, w1.x, w1.y, w1.z, w1.w};
      const float kk_[8] = {k0.x, k0.y, k0.z, k0.w, k1.x, k1.y, k1.z, k1.w};
      const float qq[8] = {q0.x, q0.y, q0.z, q0.w, q1.x, q1.y, q1.z, q1.w};
      const float bb[8] = {b0.x, b0.y, b0.z, b0.w, b1.x, b1.y, b1.z, b1.w};
      float sa0 = 0.f, sa1 = 0.f;
#pragma unroll
      for (int e = 0; e < 8; ++e) { sa0 += S0[e] * qq[e]; sa1 += S1[e] * qq[e]; }
      sa0 = -red8_sum(sa0); sa1 = -red8_sum(sa1);
      float o0 = 0.f, o1 = 0.f;
#pragma unroll
      for (int e = 0; e < 8; ++e) {
        S0[e] = S0[e] * ww[e] + sa0 * bb[e] + va * kk_[e];
        S1[e] = S1[e] * ww[e] + sa1 * bb[e] + vb * kk_[e];
        o0 += S0[e] * rr[e]; o1 += S1[e] * rr[e];
      }
      o0 = red8_sum(o0); o1 = red8_sum(o1);
      if (kq == 0) { O[t * 64 + row0] = o0; O[t * 64 + row1] = o1; }
    }
    asm volatile("s_waitcnt vmcnt(0)" ::: "memory");
    __syncthreads();
    {
      const size_t tok = tok0 + t_;
      float ov[8], s1 = 0.f, bon = 0.f;
#pragma unroll
      for (int e = 0; e < 8; ++e) {
        ov[e] = O[t_ * 64 + n0 + e]; s1 += ov[e];
        bon += R[t_ * 64 + n0 + e] * K[t_ * 64 + n0 + e] * rkc[e];
      }
      s1 = red8_sum(s1); bon = red8_sum(bon);
      const float mean = s1 * (1.f / 64.f);
      float s2 = 0.f;
#pragma unroll
      for (int e = 0; e < 8; ++e) { const float d = ov[e] - mean; s2 += d * d; }
      s2 = red8_sum(s2);
      const float rstd = rsqrtf(s2 * (1.f / 64.f) + 64e-5f);
      float y[8];
#pragma unroll
      for (int e = 0; e < 8; ++e)
        y[e] = ((ov[e] - mean) * rstd * gnw[e] + gnb[e] + bon * V[t_ * 64 + n0 + e]) * G[t_ * 64 + n0 + e];
      *(uint4*)(p.u + tok * US + 3072 + h * 64 + n0) = PACK8(y);
    }
  }
#undef RW_PREFETCH
  __syncthreads();
}

PHASE void phase_mix(const Params& p, int l, char* smem) {
  int* sitem = (int*)(smem + SMEM_BYTES - 16);
  const int tid0 = opaque_tid();
  while (true) {
    __syncthreads();
    if (tid0 == 0) *sitem = (int)atomicAdd(p.counters + l * 4 + 0, 1u);
    __syncthreads();
    const int item = *sitem;
    if (item >= 256) break;
    rwkv_item(p, l, item, smem);
  }
  while (true) {
    __syncthreads();
    if (tid0 == 0) *sitem = (int)atomicAdd(p.counters + l * 4 + 1, 1u);
    __syncthreads();
    const int item = *sitem;
    if (item >= 128) break;
    hgrn_item(p, l, item, smem);
  }
  while (true) {
    __syncthreads();
    if (tid0 == 0) *sitem = (int)atomicAdd(p.counters + l * 4 + 2, 1u);
    __syncthreads();
    const int item = *sitem;
    if (item >= 4096) break;
    att_item(p, l, item, smem);
  }
}

PHASE void phase_merge(const Params& p, int l, char* smem) {
  const bf16_t* Wl = p.wt + (size_t)l * WLAYER;
  float* Cs = (float*)smem;
  const int tid = opaque_tid();
  for (int it = 0;; ++it) {
    int tm, tn;
    if (!tile_for(it, 512, 16, tm, tn)) break;
    const size_t row0 = (size_t)tm * 128;
    f32x4 acc[4][2], G[4][2], M[4][2];
#pragma unroll
    for (int m = 0; m < 4; ++m)
#pragma unroll
      for (int n = 0; n < 2; ++n) M[m][n] = (f32x4){0.f, 0.f, 0.f, 0.f};
#pragma unroll 1
    for (int br = 0; br < 3; ++br) {
      gemm_tile<2>(tid, p.h + row0 * DM, DM, Wl + WIN + (size_t)(5376 + br * 1024 + tn * 64) * DM, DM, DM, smem, acc);
#pragma unroll
      for (int m = 0; m < 4; ++m)
#pragma unroll
        for (int n = 0; n < 2; ++n)
#pragma unroll
          for (int j = 0; j < 4; ++j) G[m][n][j] = sigm(acc[m][n][j]);
      const int aoff = (br == 0) ? 0 : (br == 1 ? 2560 : 3072);
      const size_t woff = (br == 0) ? WBA : (br == 1 ? WBB : WBC);
      gemm_tile<2>(tid, p.u + row0 * US + aoff, US, Wl + woff + (size_t)(tn * 64) * 512, 512, 512, smem, acc);
#pragma unroll
      for (int m = 0; m < 4; ++m)
#pragma unroll
        for (int n = 0; n < 2; ++n)
#pragma unroll
          for (int j = 0; j < 4; ++j) M[m][n][j] += G[m][n][j] * acc[m][n][j];
    }
    stage_acc<2>(tid, Cs, M);
    __syncthreads();
    {
      const int ch = tid & 7;
#pragma unroll 1
      for (int i = 0; i < 4; ++i) {
        const int r = (tid >> 3) + i * 32;
        const float4 a = *(const float4*)(Cs + r * 68 + ch * 8), b = *(const float4*)(Cs + r * 68 + ch * 8 + 4);
        *(uint4*)(p.u + (row0 + r) * US + 1024 + tn * 64 + ch * 8) = make_uint4(pack2(a.x, a.y), pack2(a.z, a.w), pack2(b.x, b.y), pack2(b.z, b.w));
      }
    }
    __syncthreads();
  }
}

PHASE void phase_gemm_res(const bf16_t* A, int lda, const bf16_t* Wt, int K, const float* xin, float* xout,
                        const float* ada_l, int gate_off, char* smem) {
  float* Cs = (float*)smem;
  const int tid = opaque_tid();
  for (int it = 0;; ++it) {
    int tm, tn;
    if (!tile_for(it, 512, 8, tm, tn)) break;
    const size_t row0 = (size_t)tm * 128;
    f32x4 acc[4][4];
    gemm_tile<4>(tid, A + row0 * lda, lda, Wt + (size_t)(tn * 128) * K, K, K, smem, acc);
    stage_acc<4>(tid, Cs, acc);
    __syncthreads();
    const float* gate = ada_l + (size_t)(row0 / SEQ) * ADAW + gate_off + tn * 128;
    const int c4 = (tid & 31) * 4;
    const float4 gv = *(const float4*)(gate + c4);
#pragma unroll 1
    for (int i = 0; i < 16; ++i) {
      const int r = (tid >> 5) + i * 8;
      const float4 cv = *(const float4*)(Cs + r * 132 + c4);
      const size_t off = (row0 + r) * DM + tn * 128 + c4;
      const float4 xv = *(const float4*)(xin + off);
      *(float4*)(xout + off) = make_float4(xv.x + gv.x * cv.x, xv.y + gv.y * cv.y, xv.z + gv.z * cv.z, xv.w + gv.w * cv.w);
    }
    __syncthreads();
  }
}

PHASE void phase_ffn_in(const Params& p, int l, char* smem) {
  const bf16_t* Wt = p.wt + (size_t)l * WLAYER + WFI;
  float* Cs = (float*)smem;
  const int tid = opaque_tid();
  for (int it = 0;; ++it) {
    int tm, tn;
    if (!tile_for(it, 512, 44, tm, tn)) break;
    const size_t row0 = (size_t)tm * 128;
    f32x4 acc[4][4];
    gemm_tile<4>(tid, p.h + row0 * DM, DM, Wt + (size_t)(tn * 128) * DM, DM, DM, smem, acc);
    stage_acc<4>(tid, Cs, acc);
    __syncthreads();
    const int ch = tid & 7;
#pragma unroll 1
    for (int i = 0; i < 4; ++i) {
      const int r = (tid >> 3) + i * 32;
      const float* cp = Cs + r * 132 + ch * 8;
      float o[8];
#pragma unroll
      for (int e = 0; e < 8; ++e) { const float g = cp[e], uu = cp[64 + e]; o[e] = g * sigm(g) * uu; }
      *(uint4*)(p.u + (row0 + r) * FFH + tn * 64 + ch * 8) = PACK8(o);
    }
    __syncthreads();
  }
}

__global__ void __launch_bounds__(256, 2) mega(Params p_in, int ph_lo, int ph_hi) {
  extern __shared__ __attribute__((aligned(16))) char smem[];
  cg::grid_group grid = cg::this_grid();
  const Params& p = p_in;
  bool first = true;
#define RUN(ph) if ((ph) >= ph_lo && (ph) < ph_hi)
#define SYNC { if (!first) grid.sync(); first = false; }
  RUN(0) { SYNC; phase_prep(p, smem); }
#pragma unroll 1
  for (int l = 0; l < 2; ++l) {
    const int base = 1 + 9 * l;
    const float* ada_l = p.ada + (size_t)l * 32 * ADAW;
    const bf16_t* Wl = p.wt + (size_t)l * WLAYER;
    const float* xin = (l == 0) ? p.x : p.out;
    RUN(base + 0) { SYNC; phase_norm(xin, p.norm_mix_w + l * DM, ada_l, 0, 1024, p.h); }
    RUN(base + 1) { SYNC; phase_gemm_in(p, l, smem); }
    RUN(base + 2) { SYNC; if (l > 0) phase_vlo(p, l, smem); }
    RUN(base + 3) { SYNC; phase_mix(p, l, smem); }
    RUN(base + 4) { SYNC; phase_merge(p, l, smem); }
    RUN(base + 5) { SYNC; phase_gemm_res(p.u + 1024, US, Wl + WOUT, DM, xin, p.out, ada_l, 2048, smem); }
    RUN(base + 6) { SYNC; phase_norm(p.out, p.norm_ffn_w + l * DM, ada_l, 3072, 4096, p.h); }
    RUN(base + 7) { SYNC; phase_ffn_in(p, l, smem); }
    RUN(base + 8) { SYNC; phase_gemm_res(p.u, FFH, Wl + WFO, FFH, p.out, p.out, ada_l, 5120, smem); }
  }
  RUN(NPHASE - 1) { SYNC; phase_final(p.out, p.final_norm_w); }
}

extern "C" void kernel_launch(void* const* d_in, const int* in_sizes, int n_in, void* d_out, int out_size, void* d_ws,
                              size_t ws_size, hipStream_t stream) {
  Params p{};
  p.x = (const float*)d_in[0]; p.c = (const float*)d_in[1]; p.pos = (const int*)d_in[2];
  p.ada_w = (const float*)d_in[3]; p.ada_b = (const float*)d_in[4]; p.norm_mix_w = (const float*)d_in[5];
  p.norm_ffn_w = (const float*)d_in[6]; p.w_in = (const float*)d_in[7]; p.da_lambda = (const float*)d_in[8];
  p.da_subln_w = (const float*)d_in[9]; p.hg_lb = (const float*)d_in[10]; p.hg_norm_w = (const float*)d_in[11];
  p.rw_mu = (const float*)d_in[12]; p.rw_w0 = (const float*)d_in[13]; p.rw_w2 = (const float*)d_in[14];
  p.rw_a0 = (const float*)d_in[15]; p.rw_a2 = (const float*)d_in[16]; p.rw_g2 = (const float*)d_in[17];
  p.rw_k_k = (const float*)d_in[18]; p.rw_k_a = (const float*)d_in[19]; p.rw_r_k = (const float*)d_in[20];
  p.rw_gn_w = (const float*)d_in[21]; p.rw_gn_b = (const float*)d_in[22]; p.rw_v0 = (const float*)d_in[23];
  p.rw_v1 = (const float*)d_in[24]; p.rw_v2 = (const float*)d_in[25]; p.w_br_a = (const float*)d_in[26];
  p.w_br_b = (const float*)d_in[27]; p.w_br_c = (const float*)d_in[28]; p.w_out = (const float*)d_in[29];
  p.ffn_w_in = (const float*)d_in[30]; p.ffn_w_out = (const float*)d_in[31]; p.final_norm_w = (const float*)d_in[32];
  p.out = (float*)d_out;
  char* ws = (char*)d_ws;
  size_t off = 0;
  auto take = [&](size_t bytes) { char* r = ws + off; off += (bytes + 255) & ~(size_t)255; return r; };
  p.counters = (unsigned*)take(256);
  p.wt = (bf16_t*)take(2 * WLAYER * 2);
  p.ada = (float*)take((size_t)2 * 32 * ADAW * 4);
  p.h = (bf16_t*)take((size_t)T_TOK * DM * 2);
  p.u = (bf16_t*)take((size_t)T_TOK * US * 2);
  p.vT = (bf16_t*)take((size_t)T_TOK * 512 * 2);
  p.vfirst = (bf16_t*)take((size_t)T_TOK * 512 * 2);
  p.vlo = (float*)take((size_t)T_TOK * 32 * 4);
  if (off > ws_size) { fprintf(stderr, "workspace too small: need %zu have %zu\n", off, ws_size); return; }

  static int grid_blocks = 0;
  if (!grid_blocks) {
    hipFuncSetAttribute((const void*)mega, hipFuncAttributeMaxDynamicSharedMemorySize, SMEM_BYTES);
    int dev = 0, cus = 0, per_cu = 0;
    hipGetDevice(&dev);
    hipDeviceGetAttribute(&cus, hipDeviceAttributeMultiprocessorCount, dev);
    hipOccupancyMaxActiveBlocksPerMultiprocessor(&per_cu, mega, 256, SMEM_BYTES);
    if (per_cu > 2) per_cu = 2;
    if (per_cu < 1) per_cu = 1;
    grid_blocks = cus * per_cu;
  }
#if SINGLE_LAUNCH
  int lo = 0, hi = NPHASE;
  void* args[] = {&p, &lo, &hi};
  hipError_t e = hipLaunchCooperativeKernel((void*)mega, dim3(grid_blocks), dim3(256), args, SMEM_BYTES, stream);
  if (e != hipSuccess) fprintf(stderr, "cooperative launch failed: %s (grid %d)\n", hipGetErrorString(e), grid_blocks);
#else
  for (int ph = 0; ph < NPHASE; ++ph) {
    if (ph == 3) continue;
    hipLaunchKernelGGL(mega, dim3(grid_blocks), dim3(256), SMEM_BYTES, stream, p, ph, ph + 1);
  }
#endif
}
```

```cpp
#include <hip/hip_runtime.h>
#include <hip/hip_cooperative_groups.h>
#include <stdint.h>
#include <cstdio>
namespace cg = cooperative_groups;

typedef unsigned short bf16_t;
typedef short bf16x8 __attribute__((ext_vector_type(8)));
typedef float f32x4 __attribute__((ext_vector_type(4)));
typedef float f32x2 __attribute__((ext_vector_type(2)));
#define DEV __device__ __forceinline__
#define PHASE __device__ __forceinline__

#ifndef SINGLE_LAUNCH
#define SINGLE_LAUNCH 1
#endif

constexpr int T_TOK = 65536, DM = 1024, SEQ = 2048, US = 4864, ADAW = 6144, FFH = 2816;
constexpr size_t WIN = 0, WBA = 8650752, WBB = 9175040, WBC = 9699328, WOUT = 10223616, WFI = 11272192,
                 WFO = 17039360, WLAYER = 19922944;
constexpr int SMEM_BYTES = 80896;
constexpr int NPHASE = 20;

struct Params {
  const float* x; const float* c; const int* pos;
  const float *ada_w, *ada_b, *norm_mix_w, *norm_ffn_w, *w_in, *da_lambda, *da_subln_w, *hg_lb, *hg_norm_w;
  const float *rw_mu, *rw_w0, *rw_w2, *rw_a0, *rw_a2, *rw_g2, *rw_k_k, *rw_k_a, *rw_r_k, *rw_gn_w, *rw_gn_b;
  const float *rw_v0, *rw_v1, *rw_v2, *w_br_a, *w_br_b, *w_br_c, *w_out, *ffn_w_in, *ffn_w_out, *final_norm_w;
  float* out;
  bf16_t* wt; float* ada; bf16_t* h; bf16_t* u; bf16_t* vT; bf16_t* vfirst; float* vlo; unsigned* counters;
};

DEV unsigned short f2bf(float f) { unsigned u = __float_as_uint(f); u += 0x7FFFu + ((u >> 16) & 1u); return (unsigned short)(u >> 16); }
DEV float bf2f(unsigned short h) { return __uint_as_float(((unsigned)h) << 16); }
DEV unsigned pack2(float a, float b) { return (unsigned)f2bf(a) | ((unsigned)f2bf(b) << 16); }
DEV float sigm(float x) { return 1.f / (1.f + __expf(-x)); }
DEV float lo16(unsigned v) { return __uint_as_float(v << 16); }
DEV float hi16(unsigned v) { return __uint_as_float(v & 0xFFFF0000u); }
#define UNPACK8(v, f) { f[0]=lo16(v.x); f[1]=hi16(v.x); f[2]=lo16(v.y); f[3]=hi16(v.y); f[4]=lo16(v.z); f[5]=hi16(v.z); f[6]=lo16(v.w); f[7]=hi16(v.w); }
#define PACK8(f) make_uint4(pack2(f[0],f[1]), pack2(f[2],f[3]), pack2(f[4],f[5]), pack2(f[6],f[7]))
template <int CTRL> DEV float dpp(float x) { return __int_as_float(__builtin_amdgcn_update_dpp(0, __float_as_int(x), CTRL, 0xF, 0xF, true)); }
DEV float red8_sum(float x) { x += dpp<0xB1>(x); x += dpp<0x4E>(x); x += dpp<0x141>(x); return x; }
DEV float red16_sum(float x) { x = red8_sum(x); x += dpp<0x140>(x); return x; }
DEV float red16_max(float x) { x = fmaxf(x, dpp<0xB1>(x)); x = fmaxf(x, dpp<0x4E>(x)); x = fmaxf(x, dpp<0x141>(x)); x = fmaxf(x, dpp<0x140>(x)); return x; }
DEV float wave_sum(float x) {
#pragma unroll
  for (int o = 32; o >= 1; o >>= 1) x += __shfl_xor(x, o, 64);
  return x;
}
DEV int opaque_tid() { int t = threadIdx.x; asm volatile("" : "+v"(t)); return t; }
DEV bf16x8 as_frag(uint4 v) { union { uint4 u; bf16x8 b; } c; c.u = v; return c.b; }
#define MFMA(a, b, c) __builtin_amdgcn_mfma_f32_16x16x32_bf16(a, b, c, 0, 0, 0)

template <int NT>
DEV void gemm_tile(const int tid, const bf16_t* A, int lda, const bf16_t* B, int ldb, int K, char* smem,
                   f32x4 (&acc)[4][NT]) {
  constexpr int BN = NT * 32;
  constexpr int LS = 64;
  bf16_t* As = (bf16_t*)smem;
  bf16_t* Bs = As + 2 * 128 * LS;
  const int lane = tid & 63, wave = tid >> 6, wr = wave >> 1, wc = wave & 1;
  const int fr = lane & 15, fq = lane >> 4;
  constexpr int NB = BN * 8 / 256;
#pragma unroll
  for (int m = 0; m < 4; ++m)
#pragma unroll
    for (int n = 0; n < NT; ++n) acc[m][n] = (f32x4){0.f, 0.f, 0.f, 0.f};
  const int nk = K >> 6;
  const int lrow = tid >> 3, lcc = tid & 7;
  const bf16_t* Ap = A + (size_t)lrow * lda + ((lcc ^ (lrow & 7)) * 8);
  const bf16_t* Bp = B + (size_t)lrow * ldb + ((lcc ^ (lrow & 7)) * 8);
  const size_t a32 = (size_t)32 * lda, b32 = (size_t)32 * ldb;
  const int rofs0 = (fq ^ (fr & 7)) * 8, rofs1 = rofs0 ^ 32;
#define GT_DMA(buf, koff)                                                                                    \
  {                                                                                                          \
    bf16_t* Ad = As + (buf) * 128 * LS + tid * 8;                                                            \
    bf16_t* Bd = Bs + (buf) * BN * LS + tid * 8;                                                             \
    _Pragma("unroll") for (int i = 0; i < 4; ++i)                                                            \
      __builtin_amdgcn_global_load_lds((const unsigned*)(Ap + i * a32 + (koff)), (unsigned*)(Ad + i * 32 * LS), 16, 0, 0); \
    _Pragma("unroll") for (int i = 0; i < NB; ++i)                                                           \
      __builtin_amdgcn_global_load_lds((const unsigned*)(Bp + i * b32 + (koff)), (unsigned*)(Bd + i * 32 * LS), 16, 0, 0); \
  }
  GT_DMA(0, 0)
  asm volatile("s_waitcnt vmcnt(0)" ::: "memory");
  __syncthreads();
  for (int kt = 0; kt < nk; ++kt) {
    const int buf = kt & 1;
    if (kt + 1 < nk) GT_DMA(buf ^ 1, (kt + 1) * 64)
    const bf16_t* Ab = As + buf * 128 * LS + (wr * 64 + fr) * LS;
    const bf16_t* Bb = Bs + buf * BN * LS + (wc * (NT * 16) + fr) * LS;
#pragma unroll
    for (int ks = 0; ks < 2; ++ks) {
      const int ro = ks ? rofs1 : rofs0;
      bf16x8 af[4], bfr[NT];
#pragma unroll
      for (int m = 0; m < 4; ++m) af[m] = *(const bf16x8*)(Ab + m * 16 * LS + ro);
#pragma unroll
      for (int n = 0; n < NT; ++n) bfr[n] = *(const bf16x8*)(Bb + n * 16 * LS + ro);
#pragma unroll
      for (int m = 0; m < 4; ++m)
#pragma unroll
        for (int n = 0; n < NT; ++n) acc[m][n] = MFMA(af[m], bfr[n], acc[m][n]);
    }
    asm volatile("s_waitcnt vmcnt(0)" ::: "memory");
    __syncthreads();
  }
#undef GT_DMA
}

template <int NT>
DEV void stage_acc(const int tid, float* Cs, const f32x4 (&acc)[4][NT]) {
  constexpr int LDC = NT * 32 + 4;
  const int lane = tid & 63, wave = tid >> 6, wr = wave >> 1, wc = wave & 1, fr = lane & 15, fq = lane >> 4;
#pragma unroll
  for (int m = 0; m < 4; ++m)
#pragma unroll
    for (int n = 0; n < NT; ++n)
#pragma unroll
      for (int j = 0; j < 4; ++j) Cs[(wr * 64 + m * 16 + fq * 4 + j) * LDC + wc * (NT * 16) + n * 16 + fr] = acc[m][n][j];
}

DEV bool tile_for(int it, int nM, int nN, int& tm, int& tn) {
  const int nx = gridDim.x >> 3;
  const int xcd = blockIdx.x & 7, local = blockIdx.x >> 3;
  const long id = ((long)it * 8 + xcd) * nx + local;
  if (local >= nx || id >= (long)nM * nN) return false;
  const int per_group = 8 * nN;
  const int g = (int)(id / per_group), r = (int)(id % per_group);
  tn = r >> 3; tm = g * 8 + (r & 7);
  return true;
}

PHASE void phase_prep(const Params& p, char* smem) {
  const int tid = opaque_tid();
  if (blockIdx.x == 0 && tid < 8) p.counters[tid] = 0u;
  float* tile = (float*)smem;
  const int NCONV = 2 * 4864, NADA = 192;
  for (int item0 = blockIdx.x; item0 < NCONV + NADA; item0 += gridDim.x) {
    const int item = (item0 < NADA) ? (NCONV + item0) : (item0 - NADA);
    if (item < NCONV) {
      const int l = item / 4864; int r = item % 4864;
      const float* src; int K, Nsrc, nT, perm = 0; size_t dst;
      if (r < 2112) { src = p.w_in + (size_t)l * 1024 * 8448; K = 1024; Nsrc = 8448; dst = WIN; nT = 132; }
      else if (r < 2240) { r -= 2112; src = p.w_br_a + (size_t)l * 512 * 1024; K = 512; Nsrc = 1024; dst = WBA; nT = 16; }
      else if (r < 2368) { r -= 2240; src = p.w_br_b + (size_t)l * 512 * 1024; K = 512; Nsrc = 1024; dst = WBB; nT = 16; }
      else if (r < 2496) { r -= 2368; src = p.w_br_c + (size_t)l * 512 * 1024; K = 512; Nsrc = 1024; dst = WBC; nT = 16; }
      else if (r < 2752) { r -= 2496; src = p.w_out + (size_t)l * 1024 * 1024; K = 1024; Nsrc = 1024; dst = WOUT; nT = 16; }
      else if (r < 4160) { r -= 2752; src = p.ffn_w_in + (size_t)l * 1024 * 5632; K = 1024; Nsrc = 5632; dst = WFI; nT = 88; perm = 1; }
      else { r -= 4160; src = p.ffn_w_out + (size_t)l * 2816 * 1024; K = 2816; Nsrc = 1024; dst = WFO; nT = 16; }
      const int kt = r / nT, nt = r % nT;
      const int colbase = perm ? ((nt & 1) * FFH + 64 * (nt >> 1)) : nt * 64;
      __syncthreads();
#pragma unroll
      for (int i = 0; i < 16; ++i) {
        const int k = i * 4 + (tid >> 6), j = tid & 63;
        tile[k * 65 + j] = src[(size_t)(kt * 64 + k) * Nsrc + colbase + j];
      }
      __syncthreads();
      const int row = tid >> 2, kc = (tid & 3) * 16;
      float f[16];
#pragma unroll
      for (int i = 0; i < 16; ++i) f[i] = tile[(kc + i) * 65 + row];
      bf16_t* d = p.wt + (size_t)l * WLAYER + dst + (size_t)(nt * 64 + row) * K + kt * 64 + kc;
      *(uint4*)d = make_uint4(pack2(f[0], f[1]), pack2(f[2], f[3]), pack2(f[4], f[5]), pack2(f[6], f[7]));
      *(uint4*)(d + 8) = make_uint4(pack2(f[8], f[9]), pack2(f[10], f[11]), pack2(f[12], f[13]), pack2(f[14], f[15]));
    } else {
      const int a = item - NCONV;
      const int l = a / 96, r = a % 96, ntile = r >> 2, bg = r & 3;
      float* cact = (float*)smem;
      __syncthreads();
      for (int i = tid; i < 8 * 1024; i += 256) {
        const float cv = p.c[(size_t)(bg * 8 + (i >> 10)) * DM + (i & 1023)];
        cact[i] = cv * sigm(cv);
      }
      __syncthreads();
      const int n = ntile * 256 + tid;
      const float* W = p.ada_w + (size_t)l * DM * ADAW + n;
      float acc[8];
#pragma unroll
      for (int b = 0; b < 8; ++b) acc[b] = 0.f;
      for (int k0 = 0; k0 < DM; k0 += 16) {
        float w[16];
#pragma unroll
        for (int kk = 0; kk < 16; ++kk) w[kk] = W[(size_t)(k0 + kk) * ADAW];
#pragma unroll
        for (int kk = 0; kk < 16; ++kk)
#pragma unroll
          for (int b = 0; b < 8; ++b) acc[b] += cact[b * 1024 + k0 + kk] * w[kk];
      }
      const float bias = p.ada_b[l * ADAW + n];
#pragma unroll
      for (int b = 0; b < 8; ++b) p.ada[((size_t)l * 32 + bg * 8 + b) * ADAW + n] = acc[b] + bias;
    }
  }
}

PHASE void phase_norm(const float* __restrict__ x, const float* __restrict__ w, const float* __restrict__ ada_l,
                    int shift_off, int scale_off, bf16_t* __restrict__ h) {
  const int tid = opaque_tid();
  const int lane = tid & 63, wave = tid >> 6;
  for (int row = blockIdx.x * 4 + wave; row < T_TOK; row += gridDim.x * 4) {
    const float* xr = x + (size_t)row * DM;
    float4 v[4]; float ss = 0.f;
#pragma unroll
    for (int i = 0; i < 4; ++i) { v[i] = *(const float4*)(xr + i * 256 + lane * 4); ss += v[i].x * v[i].x + v[i].y * v[i].y + v[i].z * v[i].z + v[i].w * v[i].w; }
    ss = wave_sum(ss);
    const float rstd = rsqrtf(ss * (1.f / DM) + 1e-6f);
    const float* ad = ada_l + (size_t)(row / SEQ) * ADAW;
#pragma unroll
    for (int i = 0; i < 4; ++i) {
      const int col = i * 256 + lane * 4;
      const float4 ww = *(const float4*)(w + col), sc = *(const float4*)(ad + scale_off + col), sh = *(const float4*)(ad + shift_off + col);
      const float o0 = v[i].x * rstd * ww.x * (1.f + sc.x) + sh.x, o1 = v[i].y * rstd * ww.y * (1.f + sc.y) + sh.y;
      const float o2 = v[i].z * rstd * ww.z * (1.f + sc.z) + sh.z, o3 = v[i].w * rstd * ww.w * (1.f + sc.w) + sh.w;
      *(uint2*)(h + (size_t)row * DM + col) = make_uint2(pack2(o0, o1), pack2(o2, o3));
    }
  }
}

PHASE void phase_final(float* __restrict__ x, const float* __restrict__ w) {
  const int tid = opaque_tid();
  const int lane = tid & 63, wave = tid >> 6;
  for (int row = blockIdx.x * 4 + wave; row < T_TOK; row += gridDim.x * 4) {
    float* xr = x + (size_t)row * DM;
    float4 v[4]; float ss = 0.f;
#pragma unroll
    for (int i = 0; i < 4; ++i) { v[i] = *(const float4*)(xr + i * 256 + lane * 4); ss += v[i].x * v[i].x + v[i].y * v[i].y + v[i].z * v[i].z + v[i].w * v[i].w; }
    ss = wave_sum(ss);
    const float rstd = rsqrtf(ss * (1.f / DM) + 1e-6f);
#pragma unroll
    for (int i = 0; i < 4; ++i) {
      const int col = i * 256 + lane * 4;
      const float4 ww = *(const float4*)(w + col);
      *(float4*)(xr + col) = make_float4(v[i].x * rstd * ww.x, v[i].y * rstd * ww.y, v[i].z * rstd * ww.z, v[i].w * rstd * ww.w);
    }
  }
}

PHASE void phase_gemm_in(const Params& p, int l, char* smem) {
  const bf16_t* Wt = p.wt + (size_t)l * WLAYER + WIN;
  float* Cs = (float*)smem;
  const int tid = opaque_tid();
  for (int it = 0;; ++it) {
    int tm, tn;
    if (!tile_for(it, 512, 42, tm, tn)) break;
    f32x4 acc[4][4];
    gemm_tile<4>(tid, p.h + (size_t)tm * 128 * DM, DM, Wt + (size_t)tn * 128 * DM, DM, DM, smem, acc);
    stage_acc<4>(tid, Cs, acc);
    __syncthreads();
    const size_t row0 = (size_t)tm * 128;
    if (tn < 8) {
      const float qs = (tn < 4) ? 0.125f : 1.f;
      const int ch = tid & 15, g = ch >> 3, cc = ch & 7;
      if (cc < 4) {
#pragma unroll 1
        for (int i = 0; i < 8; ++i) {
          const int r = (tid >> 4) + i * 16;
          const float pos = (float)p.pos[row0 + r];
          const float* c1 = Cs + r * 132 + g * 64 + cc * 8;
          float o1[8], o2[8];
#pragma unroll
          for (int e = 0; e < 8; ++e) {
            const float x1 = c1[e], x2 = c1[32 + e];
            const float inv = exp2f(-(float)(cc * 8 + e) * 0.41524101186092029f);
            float rev = pos * inv * 0.15915494309189535f;
            rev -= rintf(rev);
            const float s = __builtin_amdgcn_sinf(rev), c = __builtin_amdgcn_cosf(rev);
            o1[e] = (x1 * c - x2 * s) * qs; o2[e] = (x2 * c + x1 * s) * qs;
          }
          bf16_t* d = p.u + (row0 + r) * US + tn * 128 + g * 64 + cc * 8;
          *(uint4*)d = PACK8(o1);
          *(uint4*)(d + 32) = PACK8(o2);
        }
      }
    } else if (tn < 12) {
      const int b = (int)(row0 / SEQ), s0 = (int)(row0 % SEQ), vc0 = (tn - 8) * 128;
      const int rch = tid & 15;
#pragma unroll 1
      for (int i = 0; i < 8; ++i) {
        const int c = (tid >> 4) + i * 16;
        float f[8];
#pragma unroll
        for (int j = 0; j < 8; ++j) f[j] = Cs[(rch * 8 + j) * 132 + c];
        *(uint4*)(p.vT + ((size_t)b * 512 + vc0 + c) * SEQ + s0 + rch * 8) = PACK8(f);
      }
    } else {
      const int ch = tid & 15;
#pragma unroll 1
      for (int i = 0; i < 8; ++i) {
        const int r = (tid >> 4) + i * 16;
        const float4 a = *(const float4*)(Cs + r * 132 + ch * 8), b = *(const float4*)(Cs + r * 132 + ch * 8 + 4);
        *(uint4*)(p.u + (row0 + r) * US + tn * 128 - 512 + ch * 8) = make_uint4(pack2(a.x, a.y), pack2(a.z, a.w), pack2(b.x, b.y), pack2(b.z, b.w));
      }
    }
    __syncthreads();
  }
}

PHASE void phase_vlo(const Params& p, int l, char* smem) {
  float* vs = (float*)smem;
  const int tid = opaque_tid();
  const float* mu = p.rw_mu + (size_t)l * 1792 + 1024;
  const float* v1 = p.rw_v1;
  for (int item = blockIdx.x; item < T_TOK / 32; item += gridDim.x) {
    const size_t tok0 = (size_t)item * 32;
    __syncthreads();
#pragma unroll 1
    for (int i = 0; i < 8; ++i) {
      const int c = tid + i * 256;
      const int t = c >> 6, cc = c & 63;
      const size_t tok = tok0 + t;
      const uint4 cur = *(const uint4*)(p.u + tok * US + 3072 + 1024 + cc * 8);
      uint4 prv = make_uint4(0, 0, 0, 0);
      if ((tok % SEQ) != 0) prv = *(const uint4*)(p.u + (tok - 1) * US + 3072 + 1024 + cc * 8);
      float a[8], b[8];
      UNPACK8(cur, a); UNPACK8(prv, b);
#pragma unroll
      for (int e = 0; e < 8; ++e) vs[t * 512 + cc * 8 + e] = a[e] + (b[e] - a[e]) * mu[cc * 8 + e];
    }
    __syncthreads();
    const int j = tid & 31, tg = tid >> 5;
    float acc[4] = {0.f, 0.f, 0.f, 0.f};
    for (int k0 = 0; k0 < 512; k0 += 16) {
      float w[16];
#pragma unroll
      for (int kk = 0; kk < 16; ++kk) w[kk] = v1[(k0 + kk) * 32 + j];
#pragma unroll
      for (int kk = 0; kk < 16; ++kk)
#pragma unroll
        for (int i = 0; i < 4; ++i) acc[i] += vs[(tg * 4 + i) * 512 + k0 + kk] * w[kk];
    }
#pragma unroll
    for (int i = 0; i < 4; ++i) p.vlo[(tok0 + tg * 4 + i) * 32 + j] = acc[i];
  }
}

PHASE void att_item(const Params& p, int l, int item, char* smem) {
  const int qc = 31 - (item >> 7);
  const int bh = item & 127, b = bh >> 2, h = bh & 3;
  const int tid = opaque_tid(), lane = tid & 63, wave = tid >> 6, fr = lane & 15, fq = lane >> 4;
  const int m = wave >> 1, rh = wave & 1;
  bf16_t* Ks = (bf16_t*)smem;
  bf16_t* Vt = Ks + 2 * 64 * 72;
  bf16_t* Ps = Vt + 128 * 72;
  float* Ox = (float*)smem;
  const size_t tok0 = (size_t)b * SEQ + (size_t)qc * 64;
  const float* lv = p.da_lambda + (size_t)l * 256;
  float d1 = 0.f, d2 = 0.f;
  for (int i = 0; i < 64; ++i) { d1 += lv[i] * lv[64 + i]; d2 += lv[128 + i] * lv[192 + i]; }
  const float lam_init = 0.8f - 0.6f * __expf(-0.3f * (float)l);
  const float lam = __expf(d1) - __expf(d2) + lam_init;

  bf16x8 qf[2][2];
#pragma unroll
  for (int mt = 0; mt < 2; ++mt)
#pragma unroll
    for (int ks = 0; ks < 2; ++ks)
      qf[mt][ks] = *(const bf16x8*)(p.u + (tok0 + rh * 32 + mt * 16 + fr) * US + h * 128 + m * 64 + ks * 32 + fq * 8);
  f32x4 o[2][8];
  float mx[2][4], ls[2][4];
#pragma unroll
  for (int mt = 0; mt < 2; ++mt) {
#pragma unroll
    for (int n = 0; n < 8; ++n) o[mt][n] = (f32x4){0.f, 0.f, 0.f, 0.f};
#pragma unroll
    for (int j = 0; j < 4; ++j) { mx[mt][j] = -1e30f; ls[mt][j] = 0.f; }
  }
  bf16_t* Pw = Ps + wave * 32 * 72;
  for (int kt = 0; kt <= qc; ++kt) {
    __syncthreads();
#pragma unroll
    for (int i = 0; i < 4; ++i) {
      const int c = tid + i * 256;
      const int mm = c >> 9, key = (c >> 3) & 63, cc = c & 7;
      *(uint4*)(Ks + (mm * 64 + key) * 72 + cc * 8) =
          *(const uint4*)(p.u + ((size_t)b * SEQ + kt * 64 + key) * US + 512 + h * 128 + mm * 64 + cc * 8);
    }
#pragma unroll
    for (int i = 0; i < 4; ++i) {
      const int c = tid + i * 256;
      const int dim = c >> 3, cc = c & 7;
      *(uint4*)(Vt + dim * 72 + cc * 8) = *(const uint4*)(p.vT + ((size_t)b * 512 + h * 128 + dim) * SEQ + kt * 64 + cc * 8);
    }
    __syncthreads();
    f32x4 s[2][4];
#pragma unroll
    for (int mt = 0; mt < 2; ++mt)
#pragma unroll
      for (int n = 0; n < 4; ++n) s[mt][n] = (f32x4){0.f, 0.f, 0.f, 0.f};
#pragma unroll
    for (int ks = 0; ks < 2; ++ks)
#pragma unroll
      for (int n = 0; n < 4; ++n) {
        const bf16x8 kf = *(const bf16x8*)(Ks + (m * 64 + n * 16 + fr) * 72 + ks * 32 + fq * 8);
#pragma unroll
        for (int mt = 0; mt < 2; ++mt) s[mt][n] = MFMA(qf[mt][ks], kf, s[mt][n]);
      }
#pragma unroll
    for (int mt = 0; mt < 2; ++mt)
#pragma unroll
      for (int j = 0; j < 4; ++j) {
        float tmax = fmaxf(fmaxf(s[mt][0][j], s[mt][1][j]), fmaxf(s[mt][2][j], s[mt][3][j]));
        tmax = red16_max(tmax);
        const float mnew = fmaxf(mx[mt][j], tmax);
        const float alpha = __expf(mx[mt][j] - mnew);
        float rs = 0.f;
#pragma unroll
        for (int n = 0; n < 4; ++n) {
          const float pv = __expf(s[mt][n][j] - mnew);
          rs += pv;
          Pw[(mt * 16 + fq * 4 + j) * 72 + n * 16 + fr] = f2bf(pv);
        }
        rs = red16_sum(rs);
        ls[mt][j] = ls[mt][j] * alpha + rs;
        mx[mt][j] = mnew;
#pragma unroll
        for (int n = 0; n < 8; ++n) o[mt][n][j] *= alpha;
      }
    __syncthreads();
#pragma unroll
    for (int ks = 0; ks < 2; ++ks) {
      bf16x8 pf[2];
#pragma unroll
      for (int mt = 0; mt < 2; ++mt) pf[mt] = *(const bf16x8*)(Pw + (mt * 16 + fr) * 72 + ks * 32 + fq * 8);
#pragma unroll
      for (int n = 0; n < 8; ++n) {
        const bf16x8 vf = *(const bf16x8*)(Vt + (n * 16 + fr) * 72 + ks * 32 + fq * 8);
#pragma unroll
        for (int mt = 0; mt < 2; ++mt) o[mt][n] = MFMA(pf[mt], vf, o[mt][n]);
      }
    }
  }
  __syncthreads();
#pragma unroll
  for (int mt = 0; mt < 2; ++mt)
#pragma unroll
    for (int j = 0; j < 4; ++j) {
      const float inv = 1.f / ls[mt][j];
#pragma unroll
      for (int n = 0; n < 8; ++n) o[mt][n][j] *= inv;
    }
  if (m == 1) {
#pragma unroll
    for (int mt = 0; mt < 2; ++mt)
#pragma unroll
      for (int n = 0; n < 8; ++n)
#pragma unroll
        for (int j = 0; j < 4; ++j) Ox[(rh * 32 + mt * 16 + fq * 4 + j) * 132 + n * 16 + fr] = o[mt][n][j];
  }
  __syncthreads();
  if (m == 0) {
    const float* sw = p.da_subln_w + (size_t)l * 128;
    float wv[8];
#pragma unroll
    for (int n = 0; n < 8; ++n) wv[n] = sw[n * 16 + fr] * (1.f - lam_init);
#pragma unroll
    for (int mt = 0; mt < 2; ++mt)
#pragma unroll
      for (int j = 0; j < 4; ++j) {
        float ss = 0.f;
        float d[8];
#pragma unroll
        for (int n = 0; n < 8; ++n) {
          d[n] = o[mt][n][j] - lam * Ox[(rh * 32 + mt * 16 + fq * 4 + j) * 132 + n * 16 + fr];
          ss += d[n] * d[n];
        }
        ss = red16_sum(ss);
        const float rstd = rsqrtf(ss * (1.f / 128.f) + 1e-6f);
        bf16_t* dst = p.u + (tok0 + rh * 32 + mt * 16 + fq * 4 + j) * US + h * 128 + fr;
#pragma unroll
        for (int n = 0; n < 8; ++n) dst[n * 16] = f2bf(d[n] * rstd * wv[n]);
      }
  }
  __syncthreads();
}

PHASE void hgrn_item(const Params& p, int l, int item, char* smem) {
  const int b = item >> 2, h = item & 3;
  const int tid = opaque_tid(), lane = tid & 63, wave = tid >> 6, fr = lane & 15, fq = lane >> 4;
  bf16_t* Qs = (bf16_t*)smem;
  bf16_t* Kn = Qs + 32 * 136;
  bf16_t* KT = Kn + 32 * 136;
  bf16_t* VT = KT + 128 * 40;
  bf16_t* Ps = VT + 128 * 40;
  bf16_t* ST = Ps + 32 * 40;
  float* lfb = (float*)ST;
  float* red = (float*)(ST + 128 * 136);
  float* blast = red + 64;
  const int t_ = tid >> 3, d0 = (tid & 7) * 16;
  float lbv[16];
#pragma unroll
  for (int i = 0; i < 16; ++i) {
    const int c = h * 128 + d0 + i;
    lbv[i] = (l == 0) ? 0.f : sigm(p.hg_lb[512 + c] - p.hg_lb[c]);
  }
  f32x4 S[2][8];
#pragma unroll
  for (int mm = 0; mm < 2; ++mm)
#pragma unroll
    for (int n = 0; n < 8; ++n) S[mm][n] = (f32x4){0.f, 0.f, 0.f, 0.f};
  const float* nw = p.hg_norm_w + (size_t)l * 128;

  for (int ch = 0; ch < 64; ++ch) {
    const size_t tok0 = (size_t)b * SEQ + (size_t)ch * 32;
    __syncthreads();
    float qv[16], kv[16];
    {
      const bf16_t* base = p.u + (tok0 + t_) * US + h * 128 + d0;
      float zv[16], iv[16];
      { const uint4 a = *(const uint4*)(base + 1024), c = *(const uint4*)(base + 1024 + 8); float* z0 = zv; float* z1 = zv + 8; UNPACK8(a, z0); UNPACK8(c, z1); }
      { const uint4 a = *(const uint4*)(base + 1536), c = *(const uint4*)(base + 1536 + 8); float* z0 = iv; float* z1 = iv + 8; UNPACK8(a, z0); UNPACK8(c, z1); }
      { const uint4 a = *(const uint4*)(base + 2048), c = *(const uint4*)(base + 2048 + 8); float* z0 = qv; float* z1 = qv + 8; UNPACK8(a, z0); UNPACK8(c, z1); }
#pragma unroll
      for (int i = 0; i < 16; ++i) {
        const float z = zv[i], lb = lbv[i];
        const float ez = __expf(-fabsf(z));
        float lf;
        if (lb > 0.f) {
          const float sg = (z >= 0.f) ? 1.f / (1.f + ez) : ez / (1.f + ez);
          lf = __logf(lb + (1.f - lb) * sg);
        } else {
          lf = -(fmaxf(-z, 0.f) + __logf(1.f + ez));
        }
        const float sgn = (z >= 0.f) ? ez / (1.f + ez) : 1.f / (1.f + ez);
        kv[i] = (1.f - lb) * sgn;
        lfb[t_ * 128 + d0 + i] = lf;
        VT[(d0 + i) * 40 + t_] = f2bf(iv[i]);
      }
    }
    __syncthreads();
    if (tid < 128) {
      float bsum = 0.f;
#pragma unroll 8
      for (int t = 0; t < 32; ++t) { bsum += lfb[t * 128 + tid]; lfb[t * 128 + tid] = bsum; }
      blast[tid] = bsum;
    }
    __syncthreads();
    {
      float qo[16], ko[16];
#pragma unroll
      for (int i = 0; i < 16; ++i) {
        const float bb = lfb[t_ * 128 + d0 + i];
        qo[i] = qv[i] * __expf(bb);
        ko[i] = kv[i] * __expf(fminf(-bb, 80.f));
        KT[(d0 + i) * 40 + t_] = f2bf(ko[i]);
      }
      float* q0 = qo; float* q1 = qo + 8; float* k0 = ko; float* k1 = ko + 8;
      *(uint4*)(Qs + t_ * 136 + d0) = PACK8(q0);
      *(uint4*)(Qs + t_ * 136 + d0 + 8) = PACK8(q1);
      *(uint4*)(Kn + t_ * 136 + d0) = PACK8(k0);
      *(uint4*)(Kn + t_ * 136 + d0 + 8) = PACK8(k1);
    }
    __syncthreads();
#pragma unroll
    for (int mm = 0; mm < 2; ++mm)
#pragma unroll
      for (int n = 0; n < 8; ++n)
        *(uint2*)(ST + (n * 16 + fr) * 136 + wave * 32 + mm * 16 + fq * 4) =
            make_uint2(pack2(S[mm][n][0], S[mm][n][1]), pack2(S[mm][n][2], S[mm][n][3]));
    {
      const int mt = wave >> 1, nt = wave & 1;
      f32x4 sc = (f32x4){0.f, 0.f, 0.f, 0.f};
#pragma unroll
      for (int ks = 0; ks < 4; ++ks) {
        const bf16x8 a = *(const bf16x8*)(Qs + (mt * 16 + fr) * 136 + ks * 32 + fq * 8);
        const bf16x8 bb = *(const bf16x8*)(Kn + (nt * 16 + fr) * 136 + ks * 32 + fq * 8);
        sc = MFMA(a, bb, sc);
      }
#pragma unroll
      for (int j = 0; j < 4; ++j) {
        const int t = mt * 16 + fq * 4 + j, key = nt * 16 + fr;
        Ps[t * 40 + key] = f2bf(key <= t ? sc[j] : 0.f);
      }
    }
    __syncthreads();
    {
      const int mt = wave & 1, nb = (wave >> 1) * 4;
      f32x4 oo[4];
#pragma unroll
      for (int n = 0; n < 4; ++n) oo[n] = (f32x4){0.f, 0.f, 0.f, 0.f};
      {
        const bf16x8 a = *(const bf16x8*)(Ps + (mt * 16 + fr) * 40 + fq * 8);
#pragma unroll
        for (int n = 0; n < 4; ++n) {
          const bf16x8 bb = *(const bf16x8*)(VT + ((nb + n) * 16 + fr) * 40 + fq * 8);
          oo[n] = MFMA(a, bb, oo[n]);
        }
      }
#pragma unroll
      for (int ks = 0; ks < 4; ++ks) {
        const bf16x8 a = *(const bf16x8*)(Qs + (mt * 16 + fr) * 136 + ks * 32 + fq * 8);
#pragma unroll
        for (int n = 0; n < 4; ++n) {
          const bf16x8 bb = *(const bf16x8*)(ST + ((nb + n) * 16 + fr) * 136 + ks * 32 + fq * 8);
          oo[n] = MFMA(a, bb, oo[n]);
        }
      }
#pragma unroll
      for (int j = 0; j < 4; ++j) {
        float ss = 0.f;
#pragma unroll
        for (int n = 0; n < 4; ++n) ss += oo[n][j] * oo[n][j];
        ss = red16_sum(ss);
        if (fr == 0) red[(mt * 16 + fq * 4 + j) * 2 + (wave >> 1)] = ss;
      }
      __syncthreads();
#pragma unroll
      for (int j = 0; j < 4; ++j) {
        const int t = mt * 16 + fq * 4 + j;
        const float rstd = rsqrtf((red[t * 2] + red[t * 2 + 1]) * (1.f / 128.f) + 1e-6f);
        bf16_t* gp = p.u + (tok0 + t) * US + 2560 + h * 128 + nb * 16 + fr;
#pragma unroll
        for (int n = 0; n < 4; ++n) {
          const float g = bf2f(gp[n * 16]);
          gp[n * 16] = f2bf(oo[n][j] * rstd * nw[(nb + n) * 16 + fr] * (g * sigm(g)));
        }
      }
    }
    {
      bf16x8 af[2];
#pragma unroll
      for (int mm = 0; mm < 2; ++mm) af[mm] = *(const bf16x8*)(KT + (wave * 32 + mm * 16 + fr) * 40 + fq * 8);
#pragma unroll
      for (int n = 0; n < 8; ++n) {
        const bf16x8 bb = *(const bf16x8*)(VT + (n * 16 + fr) * 40 + fq * 8);
#pragma unroll
        for (int mm = 0; mm < 2; ++mm) S[mm][n] = MFMA(af[mm], bb, S[mm][n]);
      }
#pragma unroll
      for (int mm = 0; mm < 2; ++mm)
#pragma unroll
        for (int j = 0; j < 4; ++j) {
          const float e = __expf(blast[wave * 32 + mm * 16 + fq * 4 + j]);
#pragma unroll
          for (int n = 0; n < 8; ++n) S[mm][n][j] *= e;
        }
    }
  }
  __syncthreads();
}

DEV uint4 rw_act(const uint4 cur, const uint4 prv, const float* mul8, int mode) {
  const float4 m0 = *(const float4*)(mul8), m1 = *(const float4*)(mul8 + 4);
  const float mm[8] = {m0.x, m0.y, m0.z, m0.w, m1.x, m1.y, m1.z, m1.w};
  float a[8], b[8], o[8];
  UNPACK8(cur, a); UNPACK8(prv, b);
#pragma unroll
  for (int e = 0; e < 8; ++e) {
    float v = a[e] + (b[e] - a[e]) * mm[e];
    if (mode == 1) { const float t = __expf(-2.f * fabsf(v)); const float th = (1.f - t) / (1.f + t); v = (v >= 0.f) ? th : -th; }
    else if (mode == 2) v = sigm(v);
    o[e] = v;
  }
  return PACK8(o);
}
DEV bf16x8 rw_bfrag(const float* W, int k0, int col) {
  float o[8];
#pragma unroll
  for (int e = 0; e < 8; ++e) o[e] = W[(size_t)(k0 + e) * 512 + col];
  return as_frag(PACK8(o));
}

PHASE void rwkv_item(const Params& p, int l, int item, char* smem) {
  const int b = item >> 3, h = item & 7;
  const int tid = opaque_tid(), lane = tid & 63, wave = tid >> 6, fr = lane & 15, fq = lane >> 4;
  float* R = (float*)smem;
  float* K = R + 2048; float* KK = K + 2048; float* W = KK + 2048; float* BB = W + 2048;
  float* V = BB + 2048; float* G = V + 2048; float* O = G + 2048;
  float* cst = O + 2048;
  float* mul = cst + 512;
  bf16_t* rawL = (bf16_t*)smem;
  float* vloL = (float*)(smem + 17424);
  const float* mu = p.rw_mu + (size_t)l * 1792;
  const int hc_n = h * 64 + wave * 16 + fr;
  bf16x8 w2f[2], a2f[2], g2f[4], v2f;
#pragma unroll
  for (int ks = 0; ks < 2; ++ks) {
    w2f[ks] = rw_bfrag(p.rw_w2 + (size_t)l * 64 * 512, ks * 32 + fq * 8, hc_n);
    a2f[ks] = rw_bfrag(p.rw_a2 + (size_t)l * 64 * 512, ks * 32 + fq * 8, hc_n);
  }
#pragma unroll
  for (int ks = 0; ks < 4; ++ks) g2f[ks] = rw_bfrag(p.rw_g2 + (size_t)l * 128 * 512, ks * 32 + fq * 8, hc_n);
  v2f = w2f[0];
  if (l > 0) v2f = rw_bfrag(p.rw_v2, fq * 8, hc_n);
  const float w0c = p.rw_w0[l * 512 + hc_n], a0c = p.rw_a0[l * 512 + hc_n];
  const float v0c = (l > 0) ? p.rw_v0[hc_n] : 0.f;
  const int t_ = tid >> 3, n0 = (tid & 7) * 8;
  __syncthreads();
  if (tid < 64) {
    const int hc = h * 64 + tid;
    cst[tid] = p.rw_k_k[l * 512 + hc]; cst[64 + tid] = p.rw_k_a[l * 512 + hc]; cst[128 + tid] = p.rw_r_k[l * 512 + hc];
    cst[192 + tid] = p.rw_gn_w[l * 512 + hc]; cst[256 + tid] = p.rw_gn_b[l * 512 + hc];
    cst[320 + tid] = mu[hc]; cst[384 + tid] = mu[512 + hc]; cst[448 + tid] = mu[1024 + hc];
  }
  mul[tid] = mu[1536 + tid];
  const float* kkc = cst + n0; const float* kac = cst + 64 + n0; const float* rkc = cst + 128 + n0;
  const float* gnw = cst + 192 + n0; const float* gnb = cst + 256 + n0;
  const float* mur = cst + 320 + n0; const float* muk = cst + 384 + n0; const float* muv = cst + 448 + n0;
  const int kq = lane & 7, row0 = wave * 16 + (lane >> 3), row1 = row0 + 8;
  float S0[8], S1[8];
#pragma unroll
  for (int e = 0; e < 8; ++e) { S0[e] = 0.f; S1[e] = 0.f; }

  uint4 pl0, pl1, pl2, pl3, pl4, pcr, pck, pcv, ppr, ppk, ppv, pvf;
  float4 pvl;
#define RW_PREFETCH(ch_)                                                                                    \
  {                                                                                                         \
    const size_t tk0 = (size_t)b * SEQ + (size_t)(ch_) * 32;                                                 \
    const bf16_t* lb_ = p.u + (tk0 - 1) * US + 3072 + 1536 + (tid & 31) * 8;                                 \
    const int r0_ = tid >> 5;                                                                               \
    pl0 = make_uint4(0, 0, 0, 0); if (!((ch_) == 0 && r0_ == 0)) pl0 = *(const uint4*)(lb_ + (size_t)r0_ * US); \
    pl1 = *(const uint4*)(lb_ + (size_t)(r0_ + 8) * US);                                                     \
    pl2 = *(const uint4*)(lb_ + (size_t)(r0_ + 16) * US);                                                    \
    pl3 = *(const uint4*)(lb_ + (size_t)(r0_ + 24) * US);                                                    \
    pl4 = make_uint4(0, 0, 0, 0); if (tid < 32) pl4 = *(const uint4*)(lb_ + (size_t)32 * US);                \
    const bf16_t* cu_ = p.u + (tk0 + t_) * US + 3072 + h * 64 + n0;                                          \
    pcr = *(const uint4*)cu_; pck = *(const uint4*)(cu_ + 512); pcv = *(const uint4*)(cu_ + 1024);           \
    if ((ch_) == 0 && t_ == 0) { ppr = make_uint4(0, 0, 0, 0); ppk = ppr; ppv = ppr; }                        \
    else { ppr = *(const uint4*)(cu_ - US); ppk = *(const uint4*)(cu_ - US + 512); ppv = *(const uint4*)(cu_ - US + 1024); } \
    if (l > 0) {                                                                                            \
      pvl = *(const float4*)(p.vlo + (tk0 + (tid >> 3)) * 32 + (tid & 7) * 4);                               \
      pvf = *(const uint4*)(p.vfirst + (tk0 + t_) * 512 + h * 64 + n0);                                      \
    } else { pvl = make_float4(0.f, 0.f, 0.f, 0.f); pvf = make_uint4(0, 0, 0, 0); }                          \
  }
  RW_PREFETCH(0)

  for (int ch = 0; ch < 64; ++ch) {
    const size_t tok0 = (size_t)b * SEQ + (size_t)ch * 32;
    __syncthreads();
    {
      const int r0_ = tid >> 5, cc_ = (tid & 31) * 8;
      *(uint4*)(rawL + r0_ * 264 + cc_) = pl0;
      *(uint4*)(rawL + (r0_ + 8) * 264 + cc_) = pl1;
      *(uint4*)(rawL + (r0_ + 16) * 264 + cc_) = pl2;
      *(uint4*)(rawL + (r0_ + 24) * 264 + cc_) = pl3;
      if (tid < 32) *(uint4*)(rawL + 32 * 264 + cc_) = pl4;
      *(float4*)(vloL + (tid >> 3) * 36 + (tid & 7) * 4) = pvl;
    }
    __syncthreads();
    {
      const int cc_ = (tid & 31) * 8, tr = tid >> 5;
      const int mode = (cc_ < 64) ? 1 : ((cc_ < 128) ? 0 : 2);
      uint4 a0, a1, a2, a3;
      a0 = rw_act(*(const uint4*)(rawL + (tr + 1) * 264 + cc_), *(const uint4*)(rawL + tr * 264 + cc_), mul + cc_, mode);
      a1 = rw_act(*(const uint4*)(rawL + (tr + 9) * 264 + cc_), *(const uint4*)(rawL + (tr + 8) * 264 + cc_), mul + cc_, mode);
      a2 = rw_act(*(const uint4*)(rawL + (tr + 17) * 264 + cc_), *(const uint4*)(rawL + (tr + 16) * 264 + cc_), mul + cc_, mode);
      a3 = rw_act(*(const uint4*)(rawL + (tr + 25) * 264 + cc_), *(const uint4*)(rawL + (tr + 24) * 264 + cc_), mul + cc_, mode);
      __syncthreads();
      *(uint4*)(rawL + tr * 264 + cc_) = a0;
      *(uint4*)(rawL + (tr + 8) * 264 + cc_) = a1;
      *(uint4*)(rawL + (tr + 16) * 264 + cc_) = a2;
      *(uint4*)(rawL + (tr + 24) * 264 + cc_) = a3;
    }
    __syncthreads();
#pragma unroll 1
    for (int mt = 0; mt < 2; ++mt) {
      const int row = mt * 16 + fr;
      const bf16_t* ar = rawL + row * 264 + fq * 8;
      f32x4 aw = (f32x4){0.f, 0.f, 0.f, 0.f}, aa = aw, ag = aw, av = aw;
#pragma unroll
      for (int ks = 0; ks < 2; ++ks) {
        aw = MFMA(*(const bf16x8*)(ar + ks * 32), w2f[ks], aw);
        aa = MFMA(*(const bf16x8*)(ar + 64 + ks * 32), a2f[ks], aa);
      }
#pragma unroll
      for (int ks = 0; ks < 4; ++ks) ag = MFMA(*(const bf16x8*)(ar + 128 + ks * 32), g2f[ks], ag);
      if (l > 0) {
        const float4 x0 = *(const float4*)(vloL + row * 36 + fq * 8), x1 = *(const float4*)(vloL + row * 36 + fq * 8 + 4);
        const uint4 pk = make_uint4(pack2(x0.x, x0.y), pack2(x0.z, x0.w), pack2(x1.x, x1.y), pack2(x1.z, x1.w));
        av = MFMA(as_frag(pk), v2f, av);
      }
#pragma unroll
      for (int j = 0; j < 4; ++j) {
        const int t = mt * 16 + fq * 4 + j, n = wave * 16 + fr;
        const float wv = -(w0c + aw[j]);
        const float sp = fmaxf(wv, 0.f) + __logf(1.f + __expf(-fabsf(wv)));
        const float wl = -sp - 0.5f;
        W[t * 64 + n] = __expf(-__expf(wl));
        BB[t * 64 + n] = sigm(a0c + aa[j]);
        G[t * 64 + n] = ag[j];
        if (l > 0) O[t * 64 + n] = sigm(v0c + av[j]);
      }
    }
    __syncthreads();
    {
      const size_t tok = tok0 + t_;
      float cr[8], ck[8], cv[8], pr[8], pk[8], pv[8];
      UNPACK8(pcr, cr); UNPACK8(pck, ck); UNPACK8(pcv, cv);
      UNPACK8(ppr, pr); UNPACK8(ppk, pk); UNPACK8(ppv, pv);
      float kx[8], kkv[8], vs[8], ss = 0.f;
#pragma unroll
      for (int e = 0; e < 8; ++e) {
        R[t_ * 64 + n0 + e] = cr[e] + (pr[e] - cr[e]) * mur[e];
        kx[e] = ck[e] + (pk[e] - ck[e]) * muk[e];
        vs[e] = cv[e] + (pv[e] - cv[e]) * muv[e];
        kkv[e] = kx[e] * kkc[e]; ss += kkv[e] * kkv[e];
      }
      ss = red8_sum(ss);
      const float rn = rsqrtf(fmaxf(ss, 1e-24f));
#pragma unroll
      for (int e = 0; e < 8; ++e) {
        const float a = BB[t_ * 64 + n0 + e];
        const float kn = kkv[e] * rn;
        K[t_ * 64 + n0 + e] = kx[e] * (1.f + (a - 1.f) * kac[e]);
        KK[t_ * 64 + n0 + e] = kn;
        BB[t_ * 64 + n0 + e] = kn * a;
      }
      if (l == 0) {
        *(uint4*)(p.vfirst + tok * 512 + h * 64 + n0) = PACK8(vs);
      } else {
        float vf[8]; UNPACK8(pvf, vf);
#pragma unroll
        for (int e = 0; e < 8; ++e) vs[e] = vs[e] + (vf[e] - vs[e]) * O[t_ * 64 + n0 + e];
      }
#pragma unroll
      for (int e = 0; e < 8; ++e) V[t_ * 64 + n0 + e] = vs[e];
    }
    __syncthreads();
    if (ch + 1 < 64) RW_PREFETCH(ch + 1)
    asm volatile("" ::: "memory");
#pragma unroll 2
    for (int t = 0; t < 32; ++t) {
      const float* base = R + t * 64 + kq * 8;
      const float4 r0 = *(const float4*)(base), r1 = *(const float4*)(base + 4);
      const float4 k0 = *(const float4*)(base + 2048), k1 = *(const float4*)(base + 2048 + 4);
      const float4 q0 = *(const float4*)(base + 4096), q1 = *(const float4*)(base + 4096 + 4);
      const float4 w0 = *(const float4*)(base + 6144), w1 = *(const float4*)(base + 6144 + 4);
      const float4 b0 = *(const float4*)(base + 8192), b1 = *(const float4*)(base + 8192 + 4);
      const float va = V[t * 64 + row0], vb = V[t * 64 + row1];
      const float rr[8] = {r0.x, r0.y, r0.z, r0.w, r1.x, r1.y, r1.z, r1.w};
      const float ww[8] = {w0.x, w0.y, w0.z, w0.w, w1.x, w1.y, w1.z, w1.w};
      const float kk_[8] = {k0.x, k0.y, k0.z, k0.w, k1.x, k1.y, k1.z, k1.w};
      const float qq[8] = {q0.x, q0.y, q0.z, q0.w, q1.x, q1.y, q1.z, q1.w};
      const float bb[8] = {b0.x, b0.y, b0.z, b0.w, b1.x, b1.y, b1.z, b1.w};
      float sa0 = 0.f, sa1 = 0.f;
#pragma unroll
      for (int e = 0; e < 8; ++e) { sa0 += S0[e] * qq[e]; sa1 += S1[e] * qq[e]; }
      sa0 = -red8_sum(sa0); sa1 = -red8_sum(sa1);
      float o0 = 0.f, o1 = 0.f;
#pragma unroll
      for (int e = 0; e < 8; ++e) {
        S0[e] = S0[e] * ww[e] + sa0 * bb[e] + va * kk_[e];
        S1[e] = S1[e] * ww[e] + sa1 * bb[e] + vb * kk_[e];
        o0 += S0[e] * rr[e]; o1 += S1[e] * rr[e];
      }
      o0 = red8_sum(o0); o1 = red8_sum(o1);
      if (kq == 0) { O[t * 64 + row0] = o0; O[t * 64 + row1] = o1; }
    }
    asm volatile("s_waitcnt vmcnt(0)" ::: "memory");
    __syncthreads();
    {
      const size_t tok = tok0 + t_;
      float ov[8], s1 = 0.f, bon = 0.f;
#pragma unroll
      for (int e = 0; e < 8; ++e) {
        ov[e] = O[t_ * 64 + n0 + e]; s1 += ov[e];
        bon += R[t_ * 64 + n0 + e] * K[t_ * 64 + n0 + e] * rkc[e];
      }
      s1 = red8_sum(s1); bon = red8_sum(bon);
      const float mean = s1 * (1.f / 64.f);
      float s2 = 0.f;
#pragma unroll
      for (int e = 0; e < 8; ++e) { const float d = ov[e] - mean; s2 += d * d; }
      s2 = red8_sum(s2);
      const float rstd = rsqrtf(s2 * (1.f / 64.f) + 64e-5f);
      float y[8];
#pragma unroll
      for (int e = 0; e < 8; ++e)
        y[e] = ((ov[e] - mean) * rstd * gnw[e] + gnb[e] + bon * V[t_ * 64 + n0 + e]) * G[t_ * 64 + n0 + e];
      *(uint4*)(p.u + tok * US + 3072 + h * 64 + n0) = PACK8(y);
    }
  }
#undef RW_PREFETCH
  __syncthreads();
}

PHASE void phase_mix(const Params& p, int l, char* smem) {
  int* sitem = (int*)(smem + SMEM_BYTES - 16);
  const int tid0 = opaque_tid();
  while (true) {
    __syncthreads();
    if (tid0 == 0) *sitem = (int)atomicAdd(p.counters + l * 4 + 0, 1u);
    __syncthreads();
    const int item = *sitem;
    if (item >= 256) break;
    rwkv_item(p, l, item, smem);
  }
  while (true) {
    __syncthreads();
    if (tid0 == 0) *sitem = (int)atomicAdd(p.counters + l * 4 + 1, 1u);
    __syncthreads();
    const int item = *sitem;
    if (item >= 128) break;
    hgrn_item(p, l, item, smem);
  }
  while (true) {
    __syncthreads();
    if (tid0 == 0) *sitem = (int)atomicAdd(p.counters + l * 4 + 2, 1u);
    __syncthreads();
    const int item = *sitem;
    if (item >= 4096) break;
    att_item(p, l, item, smem);
  }
}

PHASE void phase_merge(const Params& p, int l, char* smem) {
  const bf16_t* Wl = p.wt + (size_t)l * WLAYER;
  float* Cs = (float*)smem;
  const int tid = opaque_tid();
  for (int it = 0;; ++it) {
    int tm, tn;
    if (!tile_for(it, 512, 16, tm, tn)) break;
    const size_t row0 = (size_t)tm * 128;
    f32x4 acc[4][2], G[4][2], M[4][2];
#pragma unroll
    for (int m = 0; m < 4; ++m)
#pragma unroll
      for (int n = 0; n < 2; ++n) M[m][n] = (f32x4){0.f, 0.f, 0.f, 0.f};
#pragma unroll 1
    for (int br = 0; br < 3; ++br) {
      gemm_tile<2>(tid, p.h + row0 * DM, DM, Wl + WIN + (size_t)(5376 + br * 1024 + tn * 64) * DM, DM, DM, smem, acc);
#pragma unroll
      for (int m = 0; m < 4; ++m)
#pragma unroll
        for (int n = 0; n < 2; ++n)
#pragma unroll
          for (int j = 0; j < 4; ++j) G[m][n][j] = sigm(acc[m][n][j]);
      const int aoff = (br == 0) ? 0 : (br == 1 ? 2560 : 3072);
      const size_t woff = (br == 0) ? WBA : (br == 1 ? WBB : WBC);
      gemm_tile<2>(tid, p.u + row0 * US + aoff, US, Wl + woff + (size_t)(tn * 64) * 512, 512, 512, smem, acc);
#pragma unroll
      for (int m = 0; m < 4; ++m)
#pragma unroll
        for (int n = 0; n < 2; ++n)
#pragma unroll
          for (int j = 0; j < 4; ++j) M[m][n][j] += G[m][n][j] * acc[m][n][j];
    }
    stage_acc<2>(tid, Cs, M);
    __syncthreads();
    {
      const int ch = tid & 7;
#pragma unroll 1
      for (int i = 0; i < 4; ++i) {
        const int r = (tid >> 3) + i * 32;
        const float4 a = *(const float4*)(Cs + r * 68 + ch * 8), b = *(const float4*)(Cs + r * 68 + ch * 8 + 4);
        *(uint4*)(p.u + (row0 + r) * US + 1024 + tn * 64 + ch * 8) = make_uint4(pack2(a.x, a.y), pack2(a.z, a.w), pack2(b.x, b.y), pack2(b.z, b.w));
      }
    }
    __syncthreads();
  }
}

PHASE void phase_gemm_res(const bf16_t* A, int lda, const bf16_t* Wt, int K, const float* xin, float* xout,
                        const float* ada_l, int gate_off, char* smem) {
  float* Cs = (float*)smem;
  const int tid = opaque_tid();
  for (int it = 0;; ++it) {
    int tm, tn;
    if (!tile_for(it, 512, 8, tm, tn)) break;
    const size_t row0 = (size_t)tm * 128;
    f32x4 acc[4][4];
    gemm_tile<4>(tid, A + row0 * lda, lda, Wt + (size_t)(tn * 128) * K, K, K, smem, acc);
    stage_acc<4>(tid, Cs, acc);
    __syncthreads();
    const float* gate = ada_l + (size_t)(row0 / SEQ) * ADAW + gate_off + tn * 128;
    const int c4 = (tid & 31) * 4;
    const float4 gv = *(const float4*)(gate + c4);
#pragma unroll 1
    for (int i = 0; i < 16; ++i) {
      const int r = (tid >> 5) + i * 8;
      const float4 cv = *(const float4*)(Cs + r * 132 + c4);
      const size_t off = (row0 + r) * DM + tn * 128 + c4;
      const float4 xv = *(const float4*)(xin + off);
      *(float4*)(xout + off) = make_float4(xv.x + gv.x * cv.x, xv.y + gv.y * cv.y, xv.z + gv.z * cv.z, xv.w + gv.w * cv.w);
    }
    __syncthreads();
  }
}

PHASE void phase_ffn_in(const Params& p, int l, char* smem) {
  const bf16_t* Wt = p.wt + (size_t)l * WLAYER + WFI;
  float* Cs = (float*)smem;
  const int tid = opaque_tid();
  for (int it = 0;; ++it) {
    int tm, tn;
    if (!tile_for(it, 512, 44, tm, tn)) break;
    const size_t row0 = (size_t)tm * 128;
    f32x4 acc[4][4];
    gemm_tile<4>(tid, p.h + row0 * DM, DM, Wt + (size_t)(tn * 128) * DM, DM, DM, smem, acc);
    stage_acc<4>(tid, Cs, acc);
    __syncthreads();
    const int ch = tid & 7;
#pragma unroll 1
    for (int i = 0; i < 4; ++i) {
      const int r = (tid >> 3) + i * 32;
      const float* cp = Cs + r * 132 + ch * 8;
      float o[8];
#pragma unroll
      for (int e = 0; e < 8; ++e) { const float g = cp[e], uu = cp[64 + e]; o[e] = g * sigm(g) * uu; }
      *(uint4*)(p.u + (row0 + r) * FFH + tn * 64 + ch * 8) = PACK8(o);
    }
    __syncthreads();
  }
}

__global__ void __launch_bounds__(256, 2) mega(Params p_in, int ph_lo, int ph_hi) {
  extern __shared__ __attribute__((aligned(16))) char smem[];
  cg::grid_group grid = cg::this_grid();
  const Params& p = p_in;
  bool first = true;
#define RUN(ph) if ((ph) >= ph_lo && (ph) < ph_hi)
#define SYNC { if (!first) grid.sync(); first = false; }
  RUN(0) { SYNC; phase_prep(p, smem); }
#pragma unroll 1
  for (int l = 0; l < 2; ++l) {
    const int base = 1 + 9 * l;
    const float* ada_l = p.ada + (size_t)l * 32 * ADAW;
    const bf16_t* Wl = p.wt + (size_t)l * WLAYER;
    const float* xin = (l == 0) ? p.x : p.out;
    RUN(base + 0) { SYNC; phase_norm(xin, p.norm_mix_w + l * DM, ada_l, 0, 1024, p.h); }
    RUN(base + 1) { SYNC; phase_gemm_in(p, l, smem); }
    RUN(base + 2) { SYNC; if (l > 0) phase_vlo(p, l, smem); }
    RUN(base + 3) { SYNC; phase_mix(p, l, smem); }
    RUN(base + 4) { SYNC; phase_merge(p, l, smem); }
    RUN(base + 5) { SYNC; phase_gemm_res(p.u + 1024, US, Wl + WOUT, DM, xin, p.out, ada_l, 2048, smem); }
    RUN(base + 6) { SYNC; phase_norm(p.out, p.norm_ffn_w + l * DM, ada_l, 3072, 4096, p.h); }
    RUN(base + 7) { SYNC; phase_ffn_in(p, l, smem); }
    RUN(base + 8) { SYNC; phase_gemm_res(p.u, FFH, Wl + WFO, FFH, p.out, p.out, ada_l, 5120, smem); }
  }
  RUN(NPHASE - 1) { SYNC; phase_final(p.out, p.final_norm_w); }
}

extern "C" void kernel_launch(void* const* d_in, const int* in_sizes, int n_in, void* d_out, int out_size, void* d_ws,
                              size_t ws_size, hipStream_t stream) {
  Params p{};
  p.x = (const float*)d_in[0]; p.c = (const float*)d_in[1]; p.pos = (const int*)d_in[2];
  p.ada_w = (const float*)d_in[3]; p.ada_b = (const float*)d_in[4]; p.norm_mix_w = (const float*)d_in[5];
  p.norm_ffn_w = (const float*)d_in[6]; p.w_in = (const float*)d_in[7]; p.da_lambda = (const float*)d_in[8];
  p.da_subln_w = (const float*)d_in[9]; p.hg_lb = (const float*)d_in[10]; p.hg_norm_w = (const float*)d_in[11];
  p.rw_mu = (const float*)d_in[12]; p.rw_w0 = (const float*)d_in[13]; p.rw_w2 = (const float*)d_in[14];
  p.rw_a0 = (const float*)d_in[15]; p.rw_a2 = (const float*)d_in[16]; p.rw_g2 = (const float*)d_in[17];
  p.rw_k_k = (const float*)d_in[18]; p.rw_k_a = (const float*)d_in[19]; p.rw_r_k = (const float*)d_in[20];
  p.rw_gn_w = (const float*)d_in[21]; p.rw_gn_b = (const float*)d_in[22]; p.rw_v0 = (const float*)d_in[23];
  p.rw_v1 = (const float*)d_in[24]; p.rw_v2 = (const float*)d_in[25]; p.w_br_a = (const float*)d_in[26];
  p.w_br_b = (const float*)d_in[27]; p.w_br_c = (const float*)d_in[28]; p.w_out = (const float*)d_in[29];
  p.ffn_w_in = (const float*)d_in[30]; p.ffn_w_out = (const float*)d_in[31]; p.final_norm_w = (const float*)d_in[32];
  p.out = (float*)d_out;
  char* ws = (char*)d_ws;
  size_t off = 0;
  auto take = [&](size_t bytes) { char* r = ws + off; off += (bytes + 255) & ~(size_t)255; return r; };
  p.counters = (unsigned*)take(256);
  p.wt = (bf16_t*)take(2 * WLAYER * 2);
  p.ada = (float*)take((size_t)2 * 32 * ADAW * 4);
  p.h = (bf16_t*)take((size_t)T_TOK * DM * 2);
  p.u = (bf16_t*)take((size_t)T_TOK * US * 2);
  p.vT = (bf16_t*)take((size_t)T_TOK * 512 * 2);
  p.vfirst = (bf16_t*)take((size_t)T_TOK * 512 * 2);
  p.vlo = (float*)take((size_t)T_TOK * 32 * 4);
  if (off > ws_size) { fprintf(stderr, "workspace too small: need %zu have %zu\n", off, ws_size); return; }

  static int grid_blocks = 0;
  if (!grid_blocks) {
    hipFuncSetAttribute((const void*)mega, hipFuncAttributeMaxDynamicSharedMemorySize, SMEM_BYTES);
    int dev = 0, cus = 0, per_cu = 0;
    hipGetDevice(&dev);
    hipDeviceGetAttribute(&cus, hipDeviceAttributeMultiprocessorCount, dev);
    hipOccupancyMaxActiveBlocksPerMultiprocessor(&per_cu, mega, 256, SMEM_BYTES);
    if (per_cu > 2) per_cu = 2;
    if (per_cu < 1) per_cu = 1;
    grid_blocks = cus * per_cu;
  }
#if SINGLE_LAUNCH
  int lo = 0, hi = NPHASE;
  void* args[] = {&p, &lo, &hi};
  hipError_t e = hipLaunchCooperativeKernel((void*)mega, dim3(grid_blocks), dim3(256), args, SMEM_BYTES, stream);
  if (e != hipSuccess) fprintf(stderr, "cooperative launch failed: %s (grid %d)\n", hipGetErrorString(e), grid_blocks);
#else
  for (int ph = 0; ph < NPHASE; ++ph) {
    if (ph == 3) continue;
    hipLaunchKernelGGL(mega, dim3(grid_blocks), dim3(256), SMEM_BYTES, stream, p, ph, ph + 1);
  }
#endif
}
```

```cpp
#include <hip/hip_runtime.h>
#include <hip/hip_cooperative_groups.h>
#include <stdint.h>
#include <cstdio>
namespace cg = cooperative_groups;

typedef unsigned short bf16_t;
typedef short bf16x8 __attribute__((ext_vector_type(8)));
typedef float f32x4 __attribute__((ext_vector_type(4)));
typedef float f32x2 __attribute__((ext_vector_type(2)));
#define DEV __device__ __forceinline__
#define PHASE __device__ __forceinline__

#ifndef SINGLE_LAUNCH
#define SINGLE_LAUNCH 1
#endif

constexpr int T_TOK = 65536, DM = 1024, SEQ = 2048, US = 4864, ADAW = 6144, FFH = 2816;
constexpr size_t WIN = 0, WBA = 8650752, WBB = 9175040, WBC = 9699328, WOUT = 10223616, WFI = 11272192,
                 WFO = 17039360, WLAYER = 19922944;
constexpr int SMEM_BYTES = 80896;
constexpr int NPHASE = 20;

struct Params {
  const float* x; const float* c; const int* pos;
  const float *ada_w, *ada_b, *norm_mix_w, *norm_ffn_w, *w_in, *da_lambda, *da_subln_w, *hg_lb, *hg_norm_w;
  const float *rw_mu, *rw_w0, *rw_w2, *rw_a0, *rw_a2, *rw_g2, *rw_k_k, *rw_k_a, *rw_r_k, *rw_gn_w, *rw_gn_b;
  const float *rw_v0, *rw_v1, *rw_v2, *w_br_a, *w_br_b, *w_br_c, *w_out, *ffn_w_in, *ffn_w_out, *final_norm_w;
  float* out;
  bf16_t* wt; float* ada; bf16_t* h; bf16_t* u; bf16_t* vT; bf16_t* vfirst; float* vlo; unsigned* counters;
};

DEV unsigned short f2bf(float f) { unsigned u = __float_as_uint(f); u += 0x7FFFu + ((u >> 16) & 1u); return (unsigned short)(u >> 16); }
DEV float bf2f(unsigned short h) { return __uint_as_float(((unsigned)h) << 16); }
DEV unsigned pack2(float a, float b) { return (unsigned)f2bf(a) | ((unsigned)f2bf(b) << 16); }
DEV float sigm(float x) { return 1.f / (1.f + __expf(-x)); }
DEV float lo16(unsigned v) { return __uint_as_float(v << 16); }
DEV float hi16(unsigned v) { return __uint_as_float(v & 0xFFFF0000u); }
#define UNPACK8(v, f) { f[0]=lo16(v.x); f[1]=hi16(v.x); f[2]=lo16(v.y); f[3]=hi16(v.y); f[4]=lo16(v.z); f[5]=hi16(v.z); f[6]=lo16(v.w); f[7]=hi16(v.w); }
#define PACK8(f) make_uint4(pack2(f[0],f[1]), pack2(f[2],f[3]), pack2(f[4],f[5]), pack2(f[6],f[7]))
template <int CTRL> DEV float dpp(float x) { return __int_as_float(__builtin_amdgcn_update_dpp(0, __float_as_int(x), CTRL, 0xF, 0xF, true)); }
DEV float red8_sum(float x) { x += dpp<0xB1>(x); x += dpp<0x4E>(x); x += dpp<0x141>(x); return x; }
DEV float red16_sum(float x) { x = red8_sum(x); x += dpp<0x140>(x); return x; }
DEV float red16_max(float x) { x = fmaxf(x, dpp<0xB1>(x)); x = fmaxf(x, dpp<0x4E>(x)); x = fmaxf(x, dpp<0x141>(x)); x = fmaxf(x, dpp<0x140>(x)); return x; }
DEV float wave_sum(float x) {
#pragma unroll
  for (int o = 32; o >= 1; o >>= 1) x += __shfl_xor(x, o, 64);
  return x;
}
DEV int opaque_tid() { int t = threadIdx.x; asm volatile("" : "+v"(t)); return t; }
DEV bf16x8 as_frag(uint4 v) { union { uint4 u; bf16x8 b; } c; c.u = v; return c.b; }
#define MFMA(a, b, c) __builtin_amdgcn_mfma_f32_16x16x32_bf16(a, b, c, 0, 0, 0)

template <int NT>
DEV void gemm_tile(const int tid, const bf16_t* A, int lda, const bf16_t* B, int ldb, int K, char* smem,
                   f32x4 (&acc)[4][NT]) {
  constexpr int BN = NT * 32;
  constexpr int LS = 64;
  bf16_t* As = (bf16_t*)smem;
  bf16_t* Bs = As + 2 * 128 * LS;
  const int lane = tid & 63, wave = tid >> 6, wr = wave >> 1, wc = wave & 1;
  const int fr = lane & 15, fq = lane >> 4;
  constexpr int NB = BN * 8 / 256;
#pragma unroll
  for (int m = 0; m < 4; ++m)
#pragma unroll
    for (int n = 0; n < NT; ++n) acc[m][n] = (f32x4){0.f, 0.f, 0.f, 0.f};
  const int nk = K >> 6;
  const int lrow = tid >> 3, lcc = tid & 7;
  const bf16_t* Ap = A + (size_t)lrow * lda + ((lcc ^ (lrow & 7)) * 8);
  const bf16_t* Bp = B + (size_t)lrow * ldb + ((lcc ^ (lrow & 7)) * 8);
  const size_t a32 = (size_t)32 * lda, b32 = (size_t)32 * ldb;
  const int rofs0 = (fq ^ (fr & 7)) * 8, rofs1 = rofs0 ^ 32;
#define GT_DMA(buf, koff)                                                                                    \
  {                                                                                                          \
    bf16_t* Ad = As + (buf) * 128 * LS + tid * 8;                                                            \
    bf16_t* Bd = Bs + (buf) * BN * LS + tid * 8;                                                             \
    _Pragma("unroll") for (int i = 0; i < 4; ++i)                                                            \
      __builtin_amdgcn_global_load_lds((const unsigned*)(Ap + i * a32 + (koff)), (unsigned*)(Ad + i * 32 * LS), 16, 0, 0); \
    _Pragma("unroll") for (int i = 0; i < NB; ++i)                                                           \
      __builtin_amdgcn_global_load_lds((const unsigned*)(Bp + i * b32 + (koff)), (unsigned*)(Bd + i * 32 * LS), 16, 0, 0); \
  }
  GT_DMA(0, 0)
  asm volatile("s_waitcnt vmcnt(0)" ::: "memory");
  __syncthreads();
  for (int kt = 0; kt < nk; ++kt) {
    const int buf = kt & 1;
    if (kt + 1 < nk) GT_DMA(buf ^ 1, (kt + 1) * 64)
    const bf16_t* Ab = As + buf * 128 * LS + (wr * 64 + fr) * LS;
    const bf16_t* Bb = Bs + buf * BN * LS + (wc * (NT * 16) + fr) * LS;
#pragma unroll
    for (int ks = 0; ks < 2; ++ks) {
      const int ro = ks ? rofs1 : rofs0;
      bf16x8 af[4], bfr[NT];
#pragma unroll
      for (int m = 0; m < 4; ++m) af[m] = *(const bf16x8*)(Ab + m * 16 * LS + ro);
#pragma unroll
      for (int n = 0; n < NT; ++n) bfr[n] = *(const bf16x8*)(Bb + n * 16 * LS + ro);
#pragma unroll
      for (int m = 0; m < 4; ++m)
#pragma unroll
        for (int n = 0; n < NT; ++n) acc[m][n] = MFMA(af[m], bfr[n], acc[m][n]);
    }
    asm volatile("s_waitcnt vmcnt(0)" ::: "memory");
    __syncthreads();
  }
#undef GT_DMA
}

template <int NT>
DEV void stage_acc(const int tid, float* Cs, const f32x4 (&acc)[4][NT]) {
  constexpr int LDC = NT * 32 + 4;
  const int lane = tid & 63, wave = tid >> 6, wr = wave >> 1, wc = wave & 1, fr = lane & 15, fq = lane >> 4;
#pragma unroll
  for (int m = 0; m < 4; ++m)
#pragma unroll
    for (int n = 0; n < NT; ++n)
#pragma unroll
      for (int j = 0; j < 4; ++j) Cs[(wr * 64 + m * 16 + fq * 4 + j) * LDC + wc * (NT * 16) + n * 16 + fr] = acc[m][n][j];
}

DEV bool tile_for(int it, int nM, int nN, int& tm, int& tn) {
  const int nx = gridDim.x >> 3;
  const int xcd = blockIdx.x & 7, local = blockIdx.x >> 3;
  const long id = ((long)it * 8 + xcd) * nx + local;
  if (local >= nx || id >= (long)nM * nN) return false;
  const int per_group = 8 * nN;
  const int g = (int)(id / per_group), r = (int)(id % per_group);
  tn = r >> 3; tm = g * 8 + (r & 7);
  return true;
}

PHASE void phase_prep(const Params& p, char* smem) {
  const int tid = opaque_tid();
  if (blockIdx.x == 0 && tid < 8) p.counters[tid] = 0u;
  if (blockIdx.x == 0) for (int i = tid; i < 3456; i += 256) p.counters[256 + i] = 0u;
  float* tile = (float*)smem;
  const int NCONV = 2 * 4864, NADA = 192;
  for (int item0 = blockIdx.x; item0 < NCONV + NADA; item0 += gridDim.x) {
    const int item = (item0 < NADA) ? (NCONV + item0) : (item0 - NADA);
    if (item < NCONV) {
      const int l = item / 4864; int r = item % 4864;
      const float* src; int K, Nsrc, nT, perm = 0; size_t dst;
      if (r < 2112) { src = p.w_in + (size_t)l * 1024 * 8448; K = 1024; Nsrc = 8448; dst = WIN; nT = 132; }
      else if (r < 2240) { r -= 2112; src = p.w_br_a + (size_t)l * 512 * 1024; K = 512; Nsrc = 1024; dst = WBA; nT = 16; }
      else if (r < 2368) { r -= 2240; src = p.w_br_b + (size_t)l * 512 * 1024; K = 512; Nsrc = 1024; dst = WBB; nT = 16; }
      else if (r < 2496) { r -= 2368; src = p.w_br_c + (size_t)l * 512 * 1024; K = 512; Nsrc = 1024; dst = WBC; nT = 16; }
      else if (r < 2752) { r -= 2496; src = p.w_out + (size_t)l * 1024 * 1024; K = 1024; Nsrc = 1024; dst = WOUT; nT = 16; }
      else if (r < 4160) { r -= 2752; src = p.ffn_w_in + (size_t)l * 1024 * 5632; K = 1024; Nsrc = 5632; dst = WFI; nT = 88; perm = 1; }
      else { r -= 4160; src = p.ffn_w_out + (size_t)l * 2816 * 1024; K = 2816; Nsrc = 1024; dst = WFO; nT = 16; }
      const int kt = r / nT, nt = r % nT;
      const int colbase = perm ? ((nt & 1) * FFH + 64 * (nt >> 1)) : nt * 64;
      __syncthreads();
#pragma unroll
      for (int i = 0; i < 16; ++i) {
        const int k = i * 4 + (tid >> 6), j = tid & 63;
        tile[k * 65 + j] = src[(size_t)(kt * 64 + k) * Nsrc + colbase + j];
      }
      __syncthreads();
      const int row = tid >> 2, kc = (tid & 3) * 16;
      float f[16];
#pragma unroll
      for (int i = 0; i < 16; ++i) f[i] = tile[(kc + i) * 65 + row];
      bf16_t* d = p.wt + (size_t)l * WLAYER + dst + (size_t)(nt * 64 + row) * K + kt * 64 + kc;
      *(uint4*)d = make_uint4(pack2(f[0], f[1]), pack2(f[2], f[3]), pack2(f[4], f[5]), pack2(f[6], f[7]));
      *(uint4*)(d + 8) = make_uint4(pack2(f[8], f[9]), pack2(f[10], f[11]), pack2(f[12], f[13]), pack2(f[14], f[15]));
    } else {
      const int a = item - NCONV;
      const int l = a / 96, r = a % 96, ntile = r >> 2, bg = r & 3;
      float* cact = (float*)smem;
      __syncthreads();
      for (int i = tid; i < 8 * 1024; i += 256) {
        const float cv = p.c[(size_t)(bg * 8 + (i >> 10)) * DM + (i & 1023)];
        cact[i] = cv * sigm(cv);
      }
      __syncthreads();
      const int n = ntile * 256 + tid;
      const float* W = p.ada_w + (size_t)l * DM * ADAW + n;
      float acc[8];
#pragma unroll
      for (int b = 0; b < 8; ++b) acc[b] = 0.f;
      for (int k0 = 0; k0 < DM; k0 += 16) {
        float w[16];
#pragma unroll
        for (int kk = 0; kk < 16; ++kk) w[kk] = W[(size_t)(k0 + kk) * ADAW];
#pragma unroll
        for (int kk = 0; kk < 16; ++kk)
#pragma unroll
          for (int b = 0; b < 8; ++b) acc[b] += cact[b * 1024 + k0 + kk] * w[kk];
      }
      const float bias = p.ada_b[l * ADAW + n];
#pragma unroll
      for (int b = 0; b < 8; ++b) p.ada[((size_t)l * 32 + bg * 8 + b) * ADAW + n] = acc[b] + bias;
    }
  }
}

PHASE void phase_norm(const float* __restrict__ x, const float* __restrict__ w, const float* __restrict__ ada_l,
                    int shift_off, int scale_off, bf16_t* __restrict__ h) {
  const int tid = opaque_tid();
  const int lane = tid & 63, wave = tid >> 6;
  for (int row = blockIdx.x * 4 + wave; row < T_TOK; row += gridDim.x * 4) {
    const float* xr = x + (size_t)row * DM;
    float4 v[4]; float ss = 0.f;
#pragma unroll
    for (int i = 0; i < 4; ++i) { v[i] = *(const float4*)(xr + i * 256 + lane * 4); ss += v[i].x * v[i].x + v[i].y * v[i].y + v[i].z * v[i].z + v[i].w * v[i].w; }
    ss = wave_sum(ss);
    const float rstd = rsqrtf(ss * (1.f / DM) + 1e-6f);
    const float* ad = ada_l + (size_t)(row / SEQ) * ADAW;
#pragma unroll
    for (int i = 0; i < 4; ++i) {
      const int col = i * 256 + lane * 4;
      const float4 ww = *(const float4*)(w + col), sc = *(const float4*)(ad + scale_off + col), sh = *(const float4*)(ad + shift_off + col);
      const float o0 = v[i].x * rstd * ww.x * (1.f + sc.x) + sh.x, o1 = v[i].y * rstd * ww.y * (1.f + sc.y) + sh.y;
      const float o2 = v[i].z * rstd * ww.z * (1.f + sc.z) + sh.z, o3 = v[i].w * rstd * ww.w * (1.f + sc.w) + sh.w;
      *(uint2*)(h + (size_t)row * DM + col) = make_uint2(pack2(o0, o1), pack2(o2, o3));
    }
  }
}

PHASE void phase_final(float* __restrict__ x, const float* __restrict__ w) {
  const int tid = opaque_tid();
  const int lane = tid & 63, wave = tid >> 6;
  for (int row = blockIdx.x * 4 + wave; row < T_TOK; row += gridDim.x * 4) {
    float* xr = x + (size_t)row * DM;
    float4 v[4]; float ss = 0.f;
#pragma unroll
    for (int i = 0; i < 4; ++i) { v[i] = *(const float4*)(xr + i * 256 + lane * 4); ss += v[i].x * v[i].x + v[i].y * v[i].y + v[i].z * v[i].z + v[i].w * v[i].w; }
    ss = wave_sum(ss);
    const float rstd = rsqrtf(ss * (1.f / DM) + 1e-6f);
#pragma unroll
    for (int i = 0; i < 4; ++i) {
      const int col = i * 256 + lane * 4;
      const float4 ww = *(const float4*)(w + col);
      *(float4*)(xr + col) = make_float4(v[i].x * rstd * ww.x, v[i].y * rstd * ww.y, v[i].z * rstd * ww.z, v[i].w * rstd * ww.w);
    }
  }
}

PHASE void phase_gemm_in(const Params& p, int l, char* smem) {
  const bf16_t* Wt = p.wt + (size_t)l * WLAYER + WIN;
  float* Cs = (float*)smem;
  const int tid = opaque_tid();
  for (int it = 0;; ++it) {
    int tm, tn;
    if (!tile_for(it, 512, 42, tm, tn)) break;
    f32x4 acc[4][4];
    gemm_tile<4>(tid, p.h + (size_t)tm * 128 * DM, DM, Wt + (size_t)tn * 128 * DM, DM, DM, smem, acc);
    stage_acc<4>(tid, Cs, acc);
    __syncthreads();
    const size_t row0 = (size_t)tm * 128;
    if (tn < 8) {
      const float qs = (tn < 4) ? 0.125f : 1.f;
      const int ch = tid & 15, g = ch >> 3, cc = ch & 7;
      if (cc < 4) {
#pragma unroll 1
        for (int i = 0; i < 8; ++i) {
          const int r = (tid >> 4) + i * 16;
          const float pos = (float)p.pos[row0 + r];
          const float* c1 = Cs + r * 132 + g * 64 + cc * 8;
          float o1[8], o2[8];
#pragma unroll
          for (int e = 0; e < 8; ++e) {
            const float x1 = c1[e], x2 = c1[32 + e];
            const float inv = exp2f(-(float)(cc * 8 + e) * 0.41524101186092029f);
            float rev = pos * inv * 0.15915494309189535f;
            rev -= rintf(rev);
            const float s = __builtin_amdgcn_sinf(rev), c = __builtin_amdgcn_cosf(rev);
            o1[e] = (x1 * c - x2 * s) * qs; o2[e] = (x2 * c + x1 * s) * qs;
          }
          bf16_t* d = p.u + (row0 + r) * US + tn * 128 + g * 64 + cc * 8;
          *(uint4*)d = PACK8(o1);
          *(uint4*)(d + 32) = PACK8(o2);
        }
      }
    } else if (tn < 12) {
      const int b = (int)(row0 / SEQ), s0 = (int)(row0 % SEQ), vc0 = (tn - 8) * 128;
      const int rch = tid & 15;
#pragma unroll 1
      for (int i = 0; i < 8; ++i) {
        const int c = (tid >> 4) + i * 16;
        float f[8];
#pragma unroll
        for (int j = 0; j < 8; ++j) f[j] = Cs[(rch * 8 + j) * 132 + c];
        *(uint4*)(p.vT + ((size_t)b * 512 + vc0 + c) * SEQ + s0 + rch * 8) = PACK8(f);
      }
    } else {
      const int ch = tid & 15;
#pragma unroll 1
      for (int i = 0; i < 8; ++i) {
        const int r = (tid >> 4) + i * 16;
        const float4 a = *(const float4*)(Cs + r * 132 + ch * 8), b = *(const float4*)(Cs + r * 132 + ch * 8 + 4);
        *(uint4*)(p.u + (row0 + r) * US + tn * 128 - 512 + ch * 8) = make_uint4(pack2(a.x, a.y), pack2(a.z, a.w), pack2(b.x, b.y), pack2(b.z, b.w));
      }
    }
    __syncthreads();
  }
}

PHASE void phase_vlo(const Params& p, int l, char* smem) {
  float* vs = (float*)smem;
  const int tid = opaque_tid();
  const float* mu = p.rw_mu + (size_t)l * 1792 + 1024;
  const float* v1 = p.rw_v1;
  for (int item = blockIdx.x; item < T_TOK / 32; item += gridDim.x) {
    const size_t tok0 = (size_t)item * 32;
    __syncthreads();
#pragma unroll 1
    for (int i = 0; i < 8; ++i) {
      const int c = tid + i * 256;
      const int t = c >> 6, cc = c & 63;
      const size_t tok = tok0 + t;
      const uint4 cur = *(const uint4*)(p.u + tok * US + 3072 + 1024 + cc * 8);
      uint4 prv = make_uint4(0, 0, 0, 0);
      if ((tok % SEQ) != 0) prv = *(const uint4*)(p.u + (tok - 1) * US + 3072 + 1024 + cc * 8);
      float a[8], b[8];
      UNPACK8(cur, a); UNPACK8(prv, b);
#pragma unroll
      for (int e = 0; e < 8; ++e) vs[t * 512 + cc * 8 + e] = a[e] + (b[e] - a[e]) * mu[cc * 8 + e];
    }
    __syncthreads();
    const int j = tid & 31, tg = tid >> 5;
    float acc[4] = {0.f, 0.f, 0.f, 0.f};
    for (int k0 = 0; k0 < 512; k0 += 16) {
      float w[16];
#pragma unroll
      for (int kk = 0; kk < 16; ++kk) w[kk] = v1[(k0 + kk) * 32 + j];
#pragma unroll
      for (int kk = 0; kk < 16; ++kk)
#pragma unroll
        for (int i = 0; i < 4; ++i) acc[i] += vs[(tg * 4 + i) * 512 + k0 + kk] * w[kk];
    }
#pragma unroll
    for (int i = 0; i < 4; ++i) p.vlo[(tok0 + tg * 4 + i) * 32 + j] = acc[i];
  }
}

PHASE void att_item(const Params& p, int l, int item, char* smem) {
  const int qc = 31 - (item >> 7);
  const int bh = item & 127, b = bh >> 2, h = bh & 3;
  const int tid = opaque_tid(), lane = tid & 63, wave = tid >> 6, fr = lane & 15, fq = lane >> 4;
  const int m = wave >> 1, rh = wave & 1;
  bf16_t* Ks = (bf16_t*)smem;
  bf16_t* Vt = Ks + 2 * 64 * 72;
  bf16_t* Ps = Vt + 128 * 72;
  float* Ox = (float*)smem;
  const size_t tok0 = (size_t)b * SEQ + (size_t)qc * 64;
  const float* lv = p.da_lambda + (size_t)l * 256;
  float d1 = 0.f, d2 = 0.f;
  for (int i = 0; i < 64; ++i) { d1 += lv[i] * lv[64 + i]; d2 += lv[128 + i] * lv[192 + i]; }
  const float lam_init = 0.8f - 0.6f * __expf(-0.3f * (float)l);
  const float lam = __expf(d1) - __expf(d2) + lam_init;

  bf16x8 qf[2][2];
#pragma unroll
  for (int mt = 0; mt < 2; ++mt)
#pragma unroll
    for (int ks = 0; ks < 2; ++ks)
      qf[mt][ks] = *(const bf16x8*)(p.u + (tok0 + rh * 32 + mt * 16 + fr) * US + h * 128 + m * 64 + ks * 32 + fq * 8);
  f32x4 o[2][8];
  float mx[2][4], ls[2][4];
#pragma unroll
  for (int mt = 0; mt < 2; ++mt) {
#pragma unroll
    for (int n = 0; n < 8; ++n) o[mt][n] = (f32x4){0.f, 0.f, 0.f, 0.f};
#pragma unroll
    for (int j = 0; j < 4; ++j) { mx[mt][j] = -1e30f; ls[mt][j] = 0.f; }
  }
  bf16_t* Pw = Ps + wave * 32 * 72;
  for (int kt = 0; kt <= qc; ++kt) {
    __syncthreads();
#pragma unroll
    for (int i = 0; i < 4; ++i) {
      const int c = tid + i * 256;
      const int mm = c >> 9, key = (c >> 3) & 63, cc = c & 7;
      *(uint4*)(Ks + (mm * 64 + key) * 72 + cc * 8) =
          *(const uint4*)(p.u + ((size_t)b * SEQ + kt * 64 + key) * US + 512 + h * 128 + mm * 64 + cc * 8);
    }
#pragma unroll
    for (int i = 0; i < 4; ++i) {
      const int c = tid + i * 256;
      const int dim = c >> 3, cc = c & 7;
      *(uint4*)(Vt + dim * 72 + cc * 8) = *(const uint4*)(p.vT + ((size_t)b * 512 + h * 128 + dim) * SEQ + kt * 64 + cc * 8);
    }
    __syncthreads();
    f32x4 s[2][4];
#pragma unroll
    for (int mt = 0; mt < 2; ++mt)
#pragma unroll
      for (int n = 0; n < 4; ++n) s[mt][n] = (f32x4){0.f, 0.f, 0.f, 0.f};
#pragma unroll
    for (int ks = 0; ks < 2; ++ks)
#pragma unroll
      for (int n = 0; n < 4; ++n) {
        const bf16x8 kf = *(const bf16x8*)(Ks + (m * 64 + n * 16 + fr) * 72 + ks * 32 + fq * 8);
#pragma unroll
        for (int mt = 0; mt < 2; ++mt) s[mt][n] = MFMA(qf[mt][ks], kf, s[mt][n]);
      }
#pragma unroll
    for (int mt = 0; mt < 2; ++mt)
#pragma unroll
      for (int j = 0; j < 4; ++j) {
        float tmax = fmaxf(fmaxf(s[mt][0][j], s[mt][1][j]), fmaxf(s[mt][2][j], s[mt][3][j]));
        tmax = red16_max(tmax);
        const float mnew = fmaxf(mx[mt][j], tmax);
        const float alpha = __expf(mx[mt][j] - mnew);
        float rs = 0.f;
#pragma unroll
        for (int n = 0; n < 4; ++n) {
          const float pv = __expf(s[mt][n][j] - mnew);
          rs += pv;
          Pw[(mt * 16 + fq * 4 + j) * 72 + n * 16 + fr] = f2bf(pv);
        }
        rs = red16_sum(rs);
        ls[mt][j] = ls[mt][j] * alpha + rs;
        mx[mt][j] = mnew;
#pragma unroll
        for (int n = 0; n < 8; ++n) o[mt][n][j] *= alpha;
      }
    __syncthreads();
#pragma unroll
    for (int ks = 0; ks < 2; ++ks) {
      bf16x8 pf[2];
#pragma unroll
      for (int mt = 0; mt < 2; ++mt) pf[mt] = *(const bf16x8*)(Pw + (mt * 16 + fr) * 72 + ks * 32 + fq * 8);
#pragma unroll
      for (int n = 0; n < 8; ++n) {
        const bf16x8 vf = *(const bf16x8*)(Vt + (n * 16 + fr) * 72 + ks * 32 + fq * 8);
#pragma unroll
        for (int mt = 0; mt < 2; ++mt) o[mt][n] = MFMA(pf[mt], vf, o[mt][n]);
      }
    }
  }
  __syncthreads();
#pragma unroll
  for (int mt = 0; mt < 2; ++mt)
#pragma unroll
    for (int j = 0; j < 4; ++j) {
      const float inv = 1.f / ls[mt][j];
#pragma unroll
      for (int n = 0; n < 8; ++n) o[mt][n][j] *= inv;
    }
  if (m == 1) {
#pragma unroll
    for (int mt = 0; mt < 2; ++mt)
#pragma unroll
      for (int n = 0; n < 8; ++n)
#pragma unroll
        for (int j = 0; j < 4; ++j) Ox[(rh * 32 + mt * 16 + fq * 4 + j) * 132 + n * 16 + fr] = o[mt][n][j];
  }
  __syncthreads();
  if (m == 0) {
    const float* sw = p.da_subln_w + (size_t)l * 128;
    float wv[8];
#pragma unroll
    for (int n = 0; n < 8; ++n) wv[n] = sw[n * 16 + fr] * (1.f - lam_init);
#pragma unroll
    for (int mt = 0; mt < 2; ++mt)
#pragma unroll
      for (int j = 0; j < 4; ++j) {
        float ss = 0.f;
        float d[8];
#pragma unroll
        for (int n = 0; n < 8; ++n) {
          d[n] = o[mt][n][j] - lam * Ox[(rh * 32 + mt * 16 + fq * 4 + j) * 132 + n * 16 + fr];
          ss += d[n] * d[n];
        }
        ss = red16_sum(ss);
        const float rstd = rsqrtf(ss * (1.f / 128.f) + 1e-6f);
        bf16_t* dst = p.u + (tok0 + rh * 32 + mt * 16 + fq * 4 + j) * US + h * 128 + fr;
#pragma unroll
        for (int n = 0; n < 8; ++n) dst[n * 16] = f2bf(d[n] * rstd * wv[n]);
      }
  }
  __syncthreads();
}

PHASE void hgrn_item(const Params& p, int l, int item, char* smem) {
  const int b = item >> 2, h = item & 3;
  const int tid = opaque_tid(), lane = tid & 63, wave = tid >> 6, fr = lane & 15, fq = lane >> 4;
  bf16_t* Qs = (bf16_t*)smem;
  bf16_t* Kn = Qs + 32 * 136;
  bf16_t* KT = Kn + 32 * 136;
  bf16_t* VT = KT + 128 * 40;
  bf16_t* Ps = VT + 128 * 40;
  bf16_t* ST = Ps + 32 * 40;
  float* lfb = (float*)ST;
  float* red = (float*)(ST + 128 * 136);
  float* blast = red + 64;
  const int t_ = tid >> 3, d0 = (tid & 7) * 16;
  float lbv[16];
#pragma unroll
  for (int i = 0; i < 16; ++i) {
    const int c = h * 128 + d0 + i;
    lbv[i] = (l == 0) ? 0.f : sigm(p.hg_lb[512 + c] - p.hg_lb[c]);
  }
  f32x4 S[2][8];
#pragma unroll
  for (int mm = 0; mm < 2; ++mm)
#pragma unroll
    for (int n = 0; n < 8; ++n) S[mm][n] = (f32x4){0.f, 0.f, 0.f, 0.f};
  const float* nw = p.hg_norm_w + (size_t)l * 128;

  for (int ch = 0; ch < 64; ++ch) {
    const size_t tok0 = (size_t)b * SEQ + (size_t)ch * 32;
    __syncthreads();
    float qv[16], kv[16];
    {
      const bf16_t* base = p.u + (tok0 + t_) * US + h * 128 + d0;
      float zv[16], iv[16];
      { const uint4 a = *(const uint4*)(base + 1024), c = *(const uint4*)(base + 1024 + 8); float* z0 = zv; float* z1 = zv + 8; UNPACK8(a, z0); UNPACK8(c, z1); }
      { const uint4 a = *(const uint4*)(base + 1536), c = *(const uint4*)(base + 1536 + 8); float* z0 = iv; float* z1 = iv + 8; UNPACK8(a, z0); UNPACK8(c, z1); }
      { const uint4 a = *(const uint4*)(base + 2048), c = *(const uint4*)(base + 2048 + 8); float* z0 = qv; float* z1 = qv + 8; UNPACK8(a, z0); UNPACK8(c, z1); }
#pragma unroll
      for (int i = 0; i < 16; ++i) {
        const float z = zv[i], lb = lbv[i];
        const float ez = __expf(-fabsf(z));
        float lf;
        if (lb > 0.f) {
          const float sg = (z >= 0.f) ? 1.f / (1.f + ez) : ez / (1.f + ez);
          lf = __logf(lb + (1.f - lb) * sg);
        } else {
          lf = -(fmaxf(-z, 0.f) + __logf(1.f + ez));
        }
        const float sgn = (z >= 0.f) ? ez / (1.f + ez) : 1.f / (1.f + ez);
        kv[i] = (1.f - lb) * sgn;
        lfb[t_ * 128 + d0 + i] = lf;
        VT[(d0 + i) * 40 + t_] = f2bf(iv[i]);
      }
    }
    __syncthreads();
    if (tid < 128) {
      float bsum = 0.f;
#pragma unroll 8
      for (int t = 0; t < 32; ++t) { bsum += lfb[t * 128 + tid]; lfb[t * 128 + tid] = bsum; }
      blast[tid] = bsum;
    }
    __syncthreads();
    {
      float qo[16], ko[16];
#pragma unroll
      for (int i = 0; i < 16; ++i) {
        const float bb = lfb[t_ * 128 + d0 + i];
        qo[i] = qv[i] * __expf(bb);
        ko[i] = kv[i] * __expf(fminf(-bb, 80.f));
        KT[(d0 + i) * 40 + t_] = f2bf(ko[i]);
      }
      float* q0 = qo; float* q1 = qo + 8; float* k0 = ko; float* k1 = ko + 8;
      *(uint4*)(Qs + t_ * 136 + d0) = PACK8(q0);
      *(uint4*)(Qs + t_ * 136 + d0 + 8) = PACK8(q1);
      *(uint4*)(Kn + t_ * 136 + d0) = PACK8(k0);
      *(uint4*)(Kn + t_ * 136 + d0 + 8) = PACK8(k1);
    }
    __syncthreads();
#pragma unroll
    for (int mm = 0; mm < 2; ++mm)
#pragma unroll
      for (int n = 0; n < 8; ++n)
        *(uint2*)(ST + (n * 16 + fr) * 136 + wave * 32 + mm * 16 + fq * 4) =
            make_uint2(pack2(S[mm][n][0], S[mm][n][1]), pack2(S[mm][n][2], S[mm][n][3]));
    {
      const int mt = wave >> 1, nt = wave & 1;
      f32x4 sc = (f32x4){0.f, 0.f, 0.f, 0.f};
#pragma unroll
      for (int ks = 0; ks < 4; ++ks) {
        const bf16x8 a = *(const bf16x8*)(Qs + (mt * 16 + fr) * 136 + ks * 32 + fq * 8);
        const bf16x8 bb = *(const bf16x8*)(Kn + (nt * 16 + fr) * 136 + ks * 32 + fq * 8);
        sc = MFMA(a, bb, sc);
      }
#pragma unroll
      for (int j = 0; j < 4; ++j) {
        const int t = mt * 16 + fq * 4 + j, key = nt * 16 + fr;
        Ps[t * 40 + key] = f2bf(key <= t ? sc[j] : 0.f);
      }
    }
    __syncthreads();
    {
      const int mt = wave & 1, nb = (wave >> 1) * 4;
      f32x4 oo[4];
#pragma unroll
      for (int n = 0; n < 4; ++n) oo[n] = (f32x4){0.f, 0.f, 0.f, 0.f};
      {
        const bf16x8 a = *(const bf16x8*)(Ps + (mt * 16 + fr) * 40 + fq * 8);
#pragma unroll
        for (int n = 0; n < 4; ++n) {
          const bf16x8 bb = *(const bf16x8*)(VT + ((nb + n) * 16 + fr) * 40 + fq * 8);
          oo[n] = MFMA(a, bb, oo[n]);
        }
      }
#pragma unroll
      for (int ks = 0; ks < 4; ++ks) {
        const bf16x8 a = *(const bf16x8*)(Qs + (mt * 16 + fr) * 136 + ks * 32 + fq * 8);
#pragma unroll
        for (int n = 0; n < 4; ++n) {
          const bf16x8 bb = *(const bf16x8*)(ST + ((nb + n) * 16 + fr) * 136 + ks * 32 + fq * 8);
          oo[n] = MFMA(a, bb, oo[n]);
        }
      }
#pragma unroll
      for (int j = 0; j < 4; ++j) {
        float ss = 0.f;
#pragma unroll
        for (int n = 0; n < 4; ++n) ss += oo[n][j] * oo[n][j];
        ss = red16_sum(ss);
        if (fr == 0) red[(mt * 16 + fq * 4 + j) * 2 + (wave >> 1)] = ss;
      }
      __syncthreads();
#pragma unroll
      for (int j = 0; j < 4; ++j) {
        const int t = mt * 16 + fq * 4 + j;
        const float rstd = rsqrtf((red[t * 2] + red[t * 2 + 1]) * (1.f / 128.f) + 1e-6f);
        bf16_t* gp = p.u + (tok0 + t) * US + 2560 + h * 128 + nb * 16 + fr;
#pragma unroll
        for (int n = 0; n < 4; ++n) {
          const float g = bf2f(gp[n * 16]);
          gp[n * 16] = f2bf(oo[n][j] * rstd * nw[(nb + n) * 16 + fr] * (g * sigm(g)));
        }
      }
    }
    {
      bf16x8 af[2];
#pragma unroll
      for (int mm = 0; mm < 2; ++mm) af[mm] = *(const bf16x8*)(KT + (wave * 32 + mm * 16 + fr) * 40 + fq * 8);
#pragma unroll
      for (int n = 0; n < 8; ++n) {
        const bf16x8 bb = *(const bf16x8*)(VT + (n * 16 + fr) * 40 + fq * 8);
#pragma unroll
        for (int mm = 0; mm < 2; ++mm) S[mm][n] = MFMA(af[mm], bb, S[mm][n]);
      }
#pragma unroll
      for (int mm = 0; mm < 2; ++mm)
#pragma unroll
        for (int j = 0; j < 4; ++j) {
          const float e = __expf(blast[wave * 32 + mm * 16 + fq * 4 + j]);
#pragma unroll
          for (int n = 0; n < 8; ++n) S[mm][n][j] *= e;
        }
    }
  }
  __syncthreads();
}

DEV uint4 rw_act(const uint4 cur, const uint4 prv, const float* mul8, int mode) {
  const float4 m0 = *(const float4*)(mul8), m1 = *(const float4*)(mul8 + 4);
  const float mm[8] = {m0.x, m0.y, m0.z, m0.w, m1.x, m1.y, m1.z, m1.w};
  float a[8], b[8], o[8];
  UNPACK8(cur, a); UNPACK8(prv, b);
#pragma unroll
  for (int e = 0; e < 8; ++e) {
    float v = a[e] + (b[e] - a[e]) * mm[e];
    if (mode == 1) { const float t = __expf(-2.f * fabsf(v)); const float th = (1.f - t) / (1.f + t); v = (v >= 0.f) ? th : -th; }
    else if (mode == 2) v = sigm(v);
    o[e] = v;
  }
  return PACK8(o);
}
DEV bf16x8 rw_bfrag(const float* W, int k0, int col) {
  float o[8];
#pragma unroll
  for (int e = 0; e < 8; ++e) o[e] = W[(size_t)(k0 + e) * 512 + col];
  return as_frag(PACK8(o));
}

PHASE void rwkv_item(const Params& p, int l, int item, char* smem) {
  const int b = item >> 3, h = item & 7;
  const int tid = opaque_tid(), lane = tid & 63, wave = tid >> 6, fr = lane & 15, fq = lane >> 4;
  float* R = (float*)smem;
  float* K = R + 2048; float* KK = K + 2048; float* W = KK + 2048; float* BB = W + 2048;
  float* V = BB + 2048; float* G = V + 2048; float* O = G + 2048;
  float* cst = O + 2048;
  float* mul = cst + 512;
  bf16_t* rawL = (bf16_t*)smem;
  float* vloL = (float*)(smem + 17424);
  const float* mu = p.rw_mu + (size_t)l * 1792;
  const int hc_n = h * 64 + wave * 16 + fr;
  bf16x8 w2f[2], a2f[2], g2f[4], v2f;
#pragma unroll
  for (int ks = 0; ks < 2; ++ks) {
    w2f[ks] = rw_bfrag(p.rw_w2 + (size_t)l * 64 * 512, ks * 32 + fq * 8, hc_n);
    a2f[ks] = rw_bfrag(p.rw_a2 + (size_t)l * 64 * 512, ks * 32 + fq * 8, hc_n);
  }
#pragma unroll
  for (int ks = 0; ks < 4; ++ks) g2f[ks] = rw_bfrag(p.rw_g2 + (size_t)l * 128 * 512, ks * 32 + fq * 8, hc_n);
  v2f = w2f[0];
  if (l > 0) v2f = rw_bfrag(p.rw_v2, fq * 8, hc_n);
  const float w0c = p.rw_w0[l * 512 + hc_n], a0c = p.rw_a0[l * 512 + hc_n];
  const float v0c = (l > 0) ? p.rw_v0[hc_n] : 0.f;
  const int t_ = tid >> 3, n0 = (tid & 7) * 8;
  __syncthreads();
  if (tid < 64) {
    const int hc = h * 64 + tid;
    cst[tid] = p.rw_k_k[l * 512 + hc]; cst[64 + tid] = p.rw_k_a[l * 512 + hc]; cst[128 + tid] = p.rw_r_k[l * 512 + hc];
    cst[192 + tid] = p.rw_gn_w[l * 512 + hc]; cst[256 + tid] = p.rw_gn_b[l * 512 + hc];
    cst[320 + tid] = mu[hc]; cst[384 + tid] = mu[512 + hc]; cst[448 + tid] = mu[1024 + hc];
  }
  mul[tid] = mu[1536 + tid];
  const float* kkc = cst + n0; const float* kac = cst + 64 + n0; const float* rkc = cst + 128 + n0;
  const float* gnw = cst + 192 + n0; const float* gnb = cst + 256 + n0;
  const float* mur = cst + 320 + n0; const float* muk = cst + 384 + n0; const float* muv = cst + 448 + n0;
  const int kq = lane & 7, row0 = wave * 16 + (lane >> 3), row1 = row0 + 8;
  float S0[8], S1[8];
#pragma unroll
  for (int e = 0; e < 8; ++e) { S0[e] = 0.f; S1[e] = 0.f; }

  uint4 pl0, pl1, pl2, pl3, pl4, pcr, pck, pcv, ppr, ppk, ppv, pvf;
  float4 pvl;
#define RW_PREFETCH(ch_)                                                                                    \
  {                                                                                                         \
    const size_t tk0 = (size_t)b * SEQ + (size_t)(ch_) * 32;                                                 \
    const bf16_t* lb_ = p.u + (tk0 - 1) * US + 3072 + 1536 + (tid & 31) * 8;                                 \
    const int r0_ = tid >> 5;                                                                               \
    pl0 = make_uint4(0, 0, 0, 0); if (!((ch_) == 0 && r0_ == 0)) pl0 = *(const uint4*)(lb_ + (size_t)r0_ * US); \
    pl1 = *(const uint4*)(lb_ + (size_t)(r0_ + 8) * US);                                                     \
    pl2 = *(const uint4*)(lb_ + (size_t)(r0_ + 16) * US);                                                    \
    pl3 = *(const uint4*)(lb_ + (size_t)(r0_ + 24) * US);                                                    \
    pl4 = make_uint4(0, 0, 0, 0); if (tid < 32) pl4 = *(const uint4*)(lb_ + (size_t)32 * US);                \
    const bf16_t* cu_ = p.u + (tk0 + t_) * US + 3072 + h * 64 + n0;                                          \
    pcr = *(const uint4*)cu_; pck = *(const uint4*)(cu_ + 512); pcv = *(const uint4*)(cu_ + 1024);           \
    if ((ch_) == 0 && t_ == 0) { ppr = make_uint4(0, 0, 0, 0); ppk = ppr; ppv = ppr; }                        \
    else { ppr = *(const uint4*)(cu_ - US); ppk = *(const uint4*)(cu_ - US + 512); ppv = *(const uint4*)(cu_ - US + 1024); } \
    if (l > 0) {                                                                                            \
      pvl = *(const float4*)(p.vlo + (tk0 + (tid >> 3)) * 32 + (tid & 7) * 4);                               \
      pvf = *(const uint4*)(p.vfirst + (tk0 + t_) * 512 + h * 64 + n0);                                      \
    } else { pvl = make_float4(0.f, 0.f, 0.f, 0.f); pvf = make_uint4(0, 0, 0, 0); }                          \
  }
  RW_PREFETCH(0)

  for (int ch = 0; ch < 64; ++ch) {
    const size_t tok0 = (size_t)b * SEQ + (size_t)ch * 32;
    __syncthreads();
    {
      const int r0_ = tid >> 5, cc_ = (tid & 31) * 8;
      *(uint4*)(rawL + r0_ * 264 + cc_) = pl0;
      *(uint4*)(rawL + (r0_ + 8) * 264 + cc_) = pl1;
      *(uint4*)(rawL + (r0_ + 16) * 264 + cc_) = pl2;
      *(uint4*)(rawL + (r0_ + 24) * 264 + cc_) = pl3;
      if (tid < 32) *(uint4*)(rawL + 32 * 264 + cc_) = pl4;
      *(float4*)(vloL + (tid >> 3) * 36 + (tid & 7) * 4) = pvl;
    }
    __syncthreads();
    {
      const int cc_ = (tid & 31) * 8, tr = tid >> 5;
      const int mode = (cc_ < 64) ? 1 : ((cc_ < 128) ? 0 : 2);
      uint4 a0, a1, a2, a3;
      a0 = rw_act(*(const uint4*)(rawL + (tr + 1) * 264 + cc_), *(const uint4*)(rawL + tr * 264 + cc_), mul + cc_, mode);
      a1 = rw_act(*(const uint4*)(rawL + (tr + 9) * 264 + cc_), *(const uint4*)(rawL + (tr + 8) * 264 + cc_), mul + cc_, mode);
      a2 = rw_act(*(const uint4*)(rawL + (tr + 17) * 264 + cc_), *(const uint4*)(rawL + (tr + 16) * 264 + cc_), mul + cc_, mode);
      a3 = rw_act(*(const uint4*)(rawL + (tr + 25) * 264 + cc_), *(const uint4*)(rawL + (tr + 24) * 264 + cc_), mul + cc_, mode);
      __syncthreads();
      *(uint4*)(rawL + tr * 264 + cc_) = a0;
      *(uint4*)(rawL + (tr + 8) * 264 + cc_) = a1;
      *(uint4*)(rawL + (tr + 16) * 264 + cc_) = a2;
      *(uint4*)(rawL + (tr + 24) * 264 + cc_) = a3;
    }
    __syncthreads();
#pragma unroll 1
    for (int mt = 0; mt < 2; ++mt) {
      const int row = mt * 16 + fr;
      const bf16_t* ar = rawL + row * 264 + fq * 8;
      f32x4 aw = (f32x4){0.f, 0.f, 0.f, 0.f}, aa = aw, ag = aw, av = aw;
#pragma unroll
      for (int ks = 0; ks < 2; ++ks) {
        aw = MFMA(*(const bf16x8*)(ar + ks * 32), w2f[ks], aw);
        aa = MFMA(*(const bf16x8*)(ar + 64 + ks * 32), a2f[ks], aa);
      }
#pragma unroll
      for (int ks = 0; ks < 4; ++ks) ag = MFMA(*(const bf16x8*)(ar + 128 + ks * 32), g2f[ks], ag);
      if (l > 0) {
        const float4 x0 = *(const float4*)(vloL + row * 36 + fq * 8), x1 = *(const float4*)(vloL + row * 36 + fq * 8 + 4);
        const uint4 pk = make_uint4(pack2(x0.x, x0.y), pack2(x0.z, x0.w), pack2(x1.x, x1.y), pack2(x1.z, x1.w));
        av = MFMA(as_frag(pk), v2f, av);
      }
#pragma unroll
      for (int j = 0; j < 4; ++j) {
        const int t = mt * 16 + fq * 4 + j, n = wave * 16 + fr;
        const float wv = -(w0c + aw[j]);
        const float sp = fmaxf(wv, 0.f) + __logf(1.f + __expf(-fabsf(wv)));
        const float wl = -sp - 0.5f;
        W[t * 64 + n] = __expf(-__expf(wl));
        BB[t * 64 + n] = sigm(a0c + aa[j]);
        G[t * 64 + n] = ag[j];
        if (l > 0) O[t * 64 + n] = sigm(v0c + av[j]);
      }
    }
    __syncthreads();
    {
      const size_t tok = tok0 + t_;
      float cr[8], ck[8], cv[8], pr[8], pk[8], pv[8];
      UNPACK8(pcr, cr); UNPACK8(pck, ck); UNPACK8(pcv, cv);
      UNPACK8(ppr, pr); UNPACK8(ppk, pk); UNPACK8(ppv, pv);
      float kx[8], kkv[8], vs[8], ss = 0.f;
#pragma unroll
      for (int e = 0; e < 8; ++e) {
        R[t_ * 64 + n0 + e] = cr[e] + (pr[e] - cr[e]) * mur[e];
        kx[e] = ck[e] + (pk[e] - ck[e]) * muk[e];
        vs[e] = cv[e] + (pv[e] - cv[e]) * muv[e];
        kkv[e] = kx[e] * kkc[e]; ss += kkv[e] * kkv[e];
      }
      ss = red8_sum(ss);
      const float rn = rsqrtf(fmaxf(ss, 1e-24f));
#pragma unroll
      for (int e = 0; e < 8; ++e) {
        const float a = BB[t_ * 64 + n0 + e];
        const float kn = kkv[e] * rn;
        K[t_ * 64 + n0 + e] = kx[e] * (1.f + (a - 1.f) * kac[e]);
        KK[t_ * 64 + n0 + e] = kn;
        BB[t_ * 64 + n0 + e] = kn * a;
      }
      if (l == 0) {
        *(uint4*)(p.vfirst + tok * 512 + h * 64 + n0) = PACK8(vs);
      } else {
        float vf[8]; UNPACK8(pvf, vf);
#pragma unroll
        for (int e = 0; e < 8; ++e) vs[e] = vs[e] + (vf[e] - vs[e]) * O[t_ * 64 + n0 + e];
      }
#pragma unroll
      for (int e = 0; e < 8; ++e) V[t_ * 64 + n0 + e] = vs[e];
    }
    __syncthreads();
    if (ch + 1 < 64) RW_PREFETCH(ch + 1)
    asm volatile("" ::: "memory");
#pragma unroll 2
    for (int t = 0; t < 32; ++t) {
      const float* base = R + t * 64 + kq * 8;
      const float4 r0 = *(const float4*)(base), r1 = *(const float4*)(base + 4);
      const float4 k0 = *(const float4*)(base + 2048), k1 = *(const float4*)(base + 2048 + 4);
      const float4 q0 = *(const float4*)(base + 4096), q1 = *(const float4*)(base + 4096 + 4);
      const float4 w0 = *(const float4*)(base + 6144), w1 = *(const float4*)(base + 6144 + 4);
      const float4 b0 = *(const float4*)(base + 8192), b1 = *(const float4*)(base + 8192 + 4);
      const float va = V[t * 64 + row0], vb = V[t * 64 + row1];
      const float rr[8] = {r0.x, r0.y, r0.z, r0.w, r1.x, r1.y, r1.z, r1.w};
      const float ww[8] = {w0.x, w0.y, w0.z, w0.w, w1.x, w1.y, w1.z, w1.w};
      const float kk_[8] = {k0.x, k0.y, k0.z, k0.w, k1.x, k1.y, k1.z, k1.w};
      const float qq[8] = {q0.x, q0.y, q0.z, q0.w, q1.x, q1.y, q1.z, q1.w};
      const float bb[8] = {b0.x, b0.y, b0.z, b0.w, b1.x, b1.y, b1.z, b1.w};
      float sa0 = 0.f, sa1 = 0.f;
#pragma unroll
      for (int e = 0; e < 8; ++e) { sa0 += S0[e] * qq[e]; sa1 += S1[e] * qq[e]; }
      sa0 = -red8_sum(sa0); sa1 = -red8_sum(sa1);
      float o0 = 0.f, o1 = 0.f;
#pragma unroll
      for (int e = 0; e < 8; ++e) {
        S0[e] = S0[e] * ww[e] + sa0 * bb[e] + va * kk_[e];
        S1[e] = S1[e] * ww[e] + sa1 * bb[e] + vb * kk_[e];
        o0 += S0[e] * rr[e]; o1 += S1[e] * rr[e];
      }
      o0 = red8_sum(o0); o1 = red8_sum(o1);
      if (kq == 0) { O[t * 64 + row0] = o0; O[t * 64 + row1] = o1; }
    }
    asm volatile("s_waitcnt vmcnt(0)" ::: "memory");
    __syncthreads();
    {
      const size_t tok = tok0 + t_;
      float ov[8], s1 = 0.f, bon = 0.f;
#pragma unroll
      for (int e = 0; e < 8; ++e) {
        ov[e] = O[t_ * 64 + n0 + e]; s1 += ov[e];
        bon += R[t_ * 64 + n0 + e] * K[t_ * 64 + n0 + e] * rkc[e];
      }
      s1 = red8_sum(s1); bon = red8_sum(bon);
      const float mean = s1 * (1.f / 64.f);
      float s2 = 0.f;
#pragma unroll
      for (int e = 0; e < 8; ++e) { const float d = ov[e] - mean; s2 += d * d; }
      s2 = red8_sum(s2);
      const float rstd = rsqrtf(s2 * (1.f / 64.f) + 64e-5f);
      float y[8];
#pragma unroll
      for (int e = 0; e < 8; ++e)
        y[e] = ((ov[e] - mean) * rstd * gnw[e] + gnb[e] + bon * V[t_ * 64 + n0 + e]) * G[t_ * 64 + n0 + e];
      *(uint4*)(p.u + tok * US + 3072 + h * 64 + n0) = PACK8(y);
    }
  }
#undef RW_PREFETCH
  __syncthreads();
}

PHASE void phase_mix(const Params& p, int l, char* smem) {
  int* sitem = (int*)(smem + SMEM_BYTES - 16);
  const int tid0 = opaque_tid();
  while (true) {
    __syncthreads();
    if (tid0 == 0) *sitem = (int)atomicAdd(p.counters + l * 4 + 0, 1u);
    __syncthreads();
    const int item = *sitem;
    if (item >= 256) break;
    rwkv_item(p, l, item, smem);
  }
  while (true) {
    __syncthreads();
    if (tid0 == 0) *sitem = (int)atomicAdd(p.counters + l * 4 + 1, 1u);
    __syncthreads();
    const int item = *sitem;
    if (item >= 128) break;
    hgrn_item(p, l, item, smem);
  }
  while (true) {
    __syncthreads();
    if (tid0 == 0) *sitem = (int)atomicAdd(p.counters + l * 4 + 2, 1u);
    __syncthreads();
    const int item = *sitem;
    if (item >= 4096) break;
    att_item(p, l, item, smem);
  }
}

PHASE void phase_merge(const Params& p, int l, char* smem) {
  const bf16_t* Wl = p.wt + (size_t)l * WLAYER;
  float* Cs = (float*)smem;
  const int tid = opaque_tid();
  for (int it = 0;; ++it) {
    int tm, tn;
    if (!tile_for(it, 512, 16, tm, tn)) break;
    const size_t row0 = (size_t)tm * 128;
    f32x4 acc[4][2], G[4][2], M[4][2];
#pragma unroll
    for (int m = 0; m < 4; ++m)
#pragma unroll
      for (int n = 0; n < 2; ++n) M[m][n] = (f32x4){0.f, 0.f, 0.f, 0.f};
#pragma unroll 1
    for (int br = 0; br < 3; ++br) {
      gemm_tile<2>(tid, p.h + row0 * DM, DM, Wl + WIN + (size_t)(5376 + br * 1024 + tn * 64) * DM, DM, DM, smem, acc);
#pragma unroll
      for (int m = 0; m < 4; ++m)
#pragma unroll
        for (int n = 0; n < 2; ++n)
#pragma unroll
          for (int j = 0; j < 4; ++j) G[m][n][j] = sigm(acc[m][n][j]);
      const int aoff = (br == 0) ? 0 : (br == 1 ? 2560 : 3072);
      const size_t woff = (br == 0) ? WBA : (br == 1 ? WBB : WBC);
      gemm_tile<2>(tid, p.u + row0 * US + aoff, US, Wl + woff + (size_t)(tn * 64) * 512, 512, 512, smem, acc);
#pragma unroll
      for (int m = 0; m < 4; ++m)
#pragma unroll
        for (int n = 0; n < 2; ++n)
#pragma unroll
          for (int j = 0; j < 4; ++j) M[m][n][j] += G[m][n][j] * acc[m][n][j];
    }
    stage_acc<2>(tid, Cs, M);
    __syncthreads();
    {
      const int ch = tid & 7;
#pragma unroll 1
      for (int i = 0; i < 4; ++i) {
        const int r = (tid >> 3) + i * 32;
        const float4 a = *(const float4*)(Cs + r * 68 + ch * 8), b = *(const float4*)(Cs + r * 68 + ch * 8 + 4);
        *(uint4*)(p.u + (row0 + r) * US + 1024 + tn * 64 + ch * 8) = make_uint4(pack2(a.x, a.y), pack2(a.z, a.w), pack2(b.x, b.y), pack2(b.z, b.w));
      }
    }
    __syncthreads();
  }
}

PHASE void phase_gemm_res(const bf16_t* A, int lda, const bf16_t* Wt, int K, const float* xin, float* xout,
                        const float* ada_l, int gate_off, char* smem) {
  float* Cs = (float*)smem;
  const int tid = opaque_tid();
  for (int it = 0;; ++it) {
    int tm, tn;
    if (!tile_for(it, 512, 8, tm, tn)) break;
    const size_t row0 = (size_t)tm * 128;
    f32x4 acc[4][4];
    gemm_tile<4>(tid, A + row0 * lda, lda, Wt + (size_t)(tn * 128) * K, K, K, smem, acc);
    stage_acc<4>(tid, Cs, acc);
    __syncthreads();
    const float* gate = ada_l + (size_t)(row0 / SEQ) * ADAW + gate_off + tn * 128;
    const int c4 = (tid & 31) * 4;
    const float4 gv = *(const float4*)(gate + c4);
#pragma unroll 1
    for (int i = 0; i < 16; ++i) {
      const int r = (tid >> 5) + i * 8;
      const float4 cv = *(const float4*)(Cs + r * 132 + c4);
      const size_t off = (row0 + r) * DM + tn * 128 + c4;
      const float4 xv = *(const float4*)(xin + off);
      *(float4*)(xout + off) = make_float4(xv.x + gv.x * cv.x, xv.y + gv.y * cv.y, xv.z + gv.z * cv.z, xv.w + gv.w * cv.w);
    }
    __syncthreads();
  }
}

PHASE void phase_ffn_in(const Params& p, int l, char* smem) {
  const bf16_t* Wt = p.wt + (size_t)l * WLAYER + WFI;
  float* Cs = (float*)smem;
  const int tid = opaque_tid();
  for (int it = 0;; ++it) {
    int tm, tn;
    if (!tile_for(it, 512, 44, tm, tn)) break;
    const size_t row0 = (size_t)tm * 128;
    f32x4 acc[4][4];
    gemm_tile<4>(tid, p.h + row0 * DM, DM, Wt + (size_t)(tn * 128) * DM, DM, DM, smem, acc);
    stage_acc<4>(tid, Cs, acc);
    __syncthreads();
    const int ch = tid & 7;
#pragma unroll 1
    for (int i = 0; i < 4; ++i) {
      const int r = (tid >> 3) + i * 32;
      const float* cp = Cs + r * 132 + ch * 8;
      float o[8];
#pragma unroll
      for (int e = 0; e < 8; ++e) { const float g = cp[e], uu = cp[64 + e]; o[e] = g * sigm(g) * uu; }
      *(uint4*)(p.u + (row0 + r) * FFH + tn * 64 + ch * 8) = PACK8(o);
    }
    __syncthreads();
  }
}

#define XB_TMO      128
#define XB_XCNT(j)  (256  + 64 * (j))
#define XB_XSUB(j)  (1280 + 64 * (j))
#define XB_XGEN(j)  (2304 + 64 * (j))
#define XB_TOP      3328
#define XB_TOPGEN   3392
#define XCD_BAR_WORDS 3456
#define XB_SPIN_CAP (1u << 18)
#define LAS __attribute__((address_space(3)))
DEV unsigned xb_ld(unsigned* p) { return __hip_atomic_load(p, __ATOMIC_RELAXED, __HIP_MEMORY_SCOPE_AGENT); }
DEV unsigned xb_add(unsigned* p, unsigned v) { return __hip_atomic_fetch_add(p, v, __ATOMIC_RELAXED, __HIP_MEMORY_SCOPE_AGENT); }
DEV unsigned xb_xcc_id() { return (unsigned)__builtin_amdgcn_s_getreg((3 << 11) | 20) & 0xFu; }
#define XB_SPIN(cond, bar) do { unsigned _sp = 0; while (cond) { __builtin_amdgcn_s_sleep(1); \
    if ((++_sp & 255u) == 0u) { if (xb_ld(&(bar)[XB_TMO])) break; if (_sp > XB_SPIN_CAP) { atomicAdd(&(bar)[XB_TMO], 1u); break; } } } } while (0)
struct XcdBarrier { unsigned* bar; unsigned x; volatile LAS unsigned* st; };
DEV XcdBarrier xcd_barrier_post(unsigned* bar, volatile LAS unsigned* st) {
  XcdBarrier b; b.bar = bar; b.x = xb_xcc_id(); b.st = st;
  if (threadIdx.x == 0) (void)xb_add(&bar[XB_XCNT(b.x)], 1u);
  return b;
}
DEV void xcd_barrier_complete(unsigned* bar, unsigned x, unsigned& nloc, unsigned& nx) {
  const unsigned G = gridDim.x * gridDim.y * gridDim.z;
  unsigned sum, cnt, mine, sp = 0u;
  for (;;) {
    sum = 0u; cnt = 0u; mine = 0u;
#pragma unroll
    for (unsigned j = 0; j < 16; ++j) { const unsigned c = xb_ld(&bar[XB_XCNT(j)]); sum += c; cnt += (c > 0u) ? 1u : 0u; mine = (j == x) ? c : mine; }
    if (sum == G) break;
    __builtin_amdgcn_s_sleep(1);
    if ((++sp & 255u) == 0u) { if (xb_ld(&bar[XB_TMO])) break; if (sp > XB_SPIN_CAP) { atomicAdd(&bar[XB_TMO], 1u); break; } }
  }
  nloc = mine > 0u ? mine : 1u; nx = cnt > 0u ? cnt : 1u;
}
DEV void xcd_barrier(const XcdBarrier& b) {
  asm volatile("s_waitcnt vmcnt(0)" ::: "memory");
  __syncthreads();
  if (threadIdx.x == 0) {
    unsigned* bar = b.bar;
    __builtin_amdgcn_s_waitcnt(0);
    unsigned nloc = b.st[0], nx = b.st[1];
    if (nloc == 0u) { xcd_barrier_complete(bar, b.x, nloc, nx); b.st[0] = nloc; b.st[1] = nx; }
    const unsigned old = xb_add(&bar[XB_XSUB(b.x)], 1u);
    const unsigned gen = old / nloc;
    if (old + 1u == (gen + 1u) * nloc) {
      __builtin_amdgcn_fence(__ATOMIC_RELEASE, "agent");
      asm volatile("s_waitcnt vmcnt(0)" ::: "memory");
      const unsigned og = xb_add(&bar[XB_TOP], 1u);
      const unsigned tg = og / nx;
      if (og + 1u == (tg + 1u) * nx) xb_add(&bar[XB_TOPGEN], 1u);
      else XB_SPIN(xb_ld(&bar[XB_TOPGEN]) == tg, bar);
      __builtin_amdgcn_fence(__ATOMIC_ACQUIRE, "agent");
      xb_add(&bar[XB_XGEN(b.x)], 1u);
      asm volatile("s_waitcnt vmcnt(0)" ::: "memory");
    } else {
      XB_SPIN(xb_ld(&bar[XB_XGEN(b.x)]) == gen, bar);
      __builtin_amdgcn_fence(__ATOMIC_ACQUIRE, "agent");
      asm volatile("s_waitcnt vmcnt(0)" ::: "memory");
    }
  }
  __syncthreads();
}

__global__ void __launch_bounds__(256, 2) mega(Params p_in, int ph_lo, int ph_hi) {
  extern __shared__ __attribute__((aligned(16))) char smem[];
  cg::grid_group grid = cg::this_grid();
  const Params& p = p_in;
  bool first = true;
#define RUN(ph) if ((ph) >= ph_lo && (ph) < ph_hi)
  unsigned epoch = 0;
  __shared__ unsigned xb_words[4];
  if (threadIdx.x < 4) xb_words[threadIdx.x] = 0u;
  __syncthreads();
  XcdBarrier xb;
  xb.bar = p.counters + 256; xb.x = 0u; xb.st = (volatile LAS unsigned*)xb_words;
#define SYNC { if (!first) { ++epoch; if (epoch == 1) { grid.sync(); xb = xcd_barrier_post(p.counters + 256, (volatile LAS unsigned*)xb_words); } else xcd_barrier(xb); } first = false; }
  RUN(0) { SYNC; phase_prep(p, smem); }
#pragma unroll 1
  for (int l = 0; l < 2; ++l) {
    const int base = 1 + 9 * l;
    const float* ada_l = p.ada + (size_t)l * 32 * ADAW;
    const bf16_t* Wl = p.wt + (size_t)l * WLAYER;
    const float* xin = (l == 0) ? p.x : p.out;
    RUN(base + 0) { SYNC; phase_norm(xin, p.norm_mix_w + l * DM, ada_l, 0, 1024, p.h); }
    RUN(base + 1) { SYNC; phase_gemm_in(p, l, smem); }
    RUN(base + 2) { if (l > 0) { SYNC; phase_vlo(p, l, smem); } }
    RUN(base + 3) { SYNC; phase_mix(p, l, smem); }
    RUN(base + 4) { SYNC; phase_merge(p, l, smem); }
    RUN(base + 5) { SYNC; phase_gemm_res(p.u + 1024, US, Wl + WOUT, DM, xin, p.out, ada_l, 2048, smem); }
    RUN(base + 6) { SYNC; phase_norm(p.out, p.norm_ffn_w + l * DM, ada_l, 3072, 4096, p.h); }
    RUN(base + 7) { SYNC; phase_ffn_in(p, l, smem); }
    RUN(base + 8) { SYNC; phase_gemm_res(p.u, FFH, Wl + WFO, FFH, p.out, p.out, ada_l, 5120, smem); }
  }
  RUN(NPHASE - 1) { SYNC; phase_final(p.out, p.final_norm_w); }
}

extern "C" void kernel_launch(void* const* d_in, const int* in_sizes, int n_in, void* d_out, int out_size, void* d_ws,
                              size_t ws_size, hipStream_t stream) {
  Params p{};
  p.x = (const float*)d_in[0]; p.c = (const float*)d_in[1]; p.pos = (const int*)d_in[2];
  p.ada_w = (const float*)d_in[3]; p.ada_b = (const float*)d_in[4]; p.norm_mix_w = (const float*)d_in[5];
  p.norm_ffn_w = (const float*)d_in[6]; p.w_in = (const float*)d_in[7]; p.da_lambda = (const float*)d_in[8];
  p.da_subln_w = (const float*)d_in[9]; p.hg_lb = (const float*)d_in[10]; p.hg_norm_w = (const float*)d_in[11];
  p.rw_mu = (const float*)d_in[12]; p.rw_w0 = (const float*)d_in[13]; p.rw_w2 = (const float*)d_in[14];
  p.rw_a0 = (const float*)d_in[15]; p.rw_a2 = (const float*)d_in[16]; p.rw_g2 = (const float*)d_in[17];
  p.rw_k_k = (const float*)d_in[18]; p.rw_k_a = (const float*)d_in[19]; p.rw_r_k = (const float*)d_in[20];
  p.rw_gn_w = (const float*)d_in[21]; p.rw_gn_b = (const float*)d_in[22]; p.rw_v0 = (const float*)d_in[23];
  p.rw_v1 = (const float*)d_in[24]; p.rw_v2 = (const float*)d_in[25]; p.w_br_a = (const float*)d_in[26];
  p.w_br_b = (const float*)d_in[27]; p.w_br_c = (const float*)d_in[28]; p.w_out = (const float*)d_in[29];
  p.ffn_w_in = (const float*)d_in[30]; p.ffn_w_out = (const float*)d_in[31]; p.final_norm_w = (const float*)d_in[32];
  p.out = (float*)d_out;
  char* ws = (char*)d_ws;
  size_t off = 0;
  auto take = [&](size_t bytes) { char* r = ws + off; off += (bytes + 255) & ~(size_t)255; return r; };
  p.counters = (unsigned*)take(16384);
  p.wt = (bf16_t*)take(2 * WLAYER * 2);
  p.ada = (float*)take((size_t)2 * 32 * ADAW * 4);
  p.h = (bf16_t*)take((size_t)T_TOK * DM * 2);
  p.u = (bf16_t*)take((size_t)T_TOK * US * 2);
  p.vT = (bf16_t*)take((size_t)T_TOK * 512 * 2);
  p.vfirst = (bf16_t*)take((size_t)T_TOK * 512 * 2);
  p.vlo = (float*)take((size_t)T_TOK * 32 * 4);
  if (off > ws_size) { fprintf(stderr, "workspace too small: need %zu have %zu\n", off, ws_size); return; }

  static int grid_blocks = 0;
  if (!grid_blocks) {
    hipFuncSetAttribute((const void*)mega, hipFuncAttributeMaxDynamicSharedMemorySize, SMEM_BYTES);
    int dev = 0, cus = 0, per_cu = 0;
    hipGetDevice(&dev);
    hipDeviceGetAttribute(&cus, hipDeviceAttributeMultiprocessorCount, dev);
    hipOccupancyMaxActiveBlocksPerMultiprocessor(&per_cu, mega, 256, SMEM_BYTES);
    if (per_cu > 2) per_cu = 2;
    if (per_cu < 1) per_cu = 1;
    grid_blocks = cus * per_cu;
  }
#if SINGLE_LAUNCH
  int lo = 0, hi = NPHASE;
  void* args[] = {&p, &lo, &hi};
  hipError_t e = hipLaunchCooperativeKernel((void*)mega, dim3(grid_blocks), dim3(256), args, SMEM_BYTES, stream);
  if (e != hipSuccess) fprintf(stderr, "cooperative launch failed: %s (grid %d)\n", hipGetErrorString(e), grid_blocks);
#else
  for (int ph = 0; ph < NPHASE; ++ph) {
    if (ph == 3) continue;
    hipLaunchKernelGGL(mega, dim3(grid_blocks), dim3(256), SMEM_BYTES, stream, p, ph, ph + 1);
  }
#endif
}
```

```cpp
#include <hip/hip_runtime.h>
#include <hip/hip_cooperative_groups.h>
#include <stdint.h>
#include <cstdio>
namespace cg = cooperative_groups;

typedef unsigned short bf16_t;
typedef short bf16x8 __attribute__((ext_vector_type(8)));
typedef float f32x4 __attribute__((ext_vector_type(4)));
typedef float f32x2 __attribute__((ext_vector_type(2)));
#define DEV __device__ __forceinline__
#define PHASE __device__ __forceinline__

#ifndef SINGLE_LAUNCH
#define SINGLE_LAUNCH 1
#endif

constexpr int T_TOK = 65536, DM = 1024, SEQ = 2048, US = 4864, ADAW = 6144, FFH = 2816;
constexpr size_t WIN = 0, WBA = 8650752, WBB = 9175040, WBC = 9699328, WOUT = 10223616, WFI = 11272192,
                 WFO = 17039360, WLAYER = 19922944;
constexpr int SMEM_BYTES = 80896;
constexpr int NPHASE = 20;

struct Params {
  const float* x; const float* c; const int* pos;
  const float *ada_w, *ada_b, *norm_mix_w, *norm_ffn_w, *w_in, *da_lambda, *da_subln_w, *hg_lb, *hg_norm_w;
  const float *rw_mu, *rw_w0, *rw_w2, *rw_a0, *rw_a2, *rw_g2, *rw_k_k, *rw_k_a, *rw_r_k, *rw_gn_w, *rw_gn_b;
  const float *rw_v0, *rw_v1, *rw_v2, *w_br_a, *w_br_b, *w_br_c, *w_out, *ffn_w_in, *ffn_w_out, *final_norm_w;
  float* out;
  bf16_t* wt; float* ada; bf16_t* h; bf16_t* u; bf16_t* vT; bf16_t* vfirst; float* vlo; unsigned* counters;
};

DEV unsigned short f2bf(float f) { unsigned u = __float_as_uint(f); u += 0x7FFFu + ((u >> 16) & 1u); return (unsigned short)(u >> 16); }
DEV float bf2f(unsigned short h) { return __uint_as_float(((unsigned)h) << 16); }
DEV unsigned pack2(float a, float b) { return (unsigned)f2bf(a) | ((unsigned)f2bf(b) << 16); }
DEV float sigm(float x) { return 1.f / (1.f + __expf(-x)); }
DEV float lo16(unsigned v) { return __uint_as_float(v << 16); }
DEV float hi16(unsigned v) { return __uint_as_float(v & 0xFFFF0000u); }
#define UNPACK8(v, f) { f[0]=lo16(v.x); f[1]=hi16(v.x); f[2]=lo16(v.y); f[3]=hi16(v.y); f[4]=lo16(v.z); f[5]=hi16(v.z); f[6]=lo16(v.w); f[7]=hi16(v.w); }
#define PACK8(f) make_uint4(pack2(f[0],f[1]), pack2(f[2],f[3]), pack2(f[4],f[5]), pack2(f[6],f[7]))
template <int CTRL> DEV float dpp(float x) { return __int_as_float(__builtin_amdgcn_update_dpp(0, __float_as_int(x), CTRL, 0xF, 0xF, true)); }
DEV float red8_sum(float x) { x += dpp<0xB1>(x); x += dpp<0x4E>(x); x += dpp<0x141>(x); return x; }
DEV float red16_sum(float x) { x = red8_sum(x); x += dpp<0x140>(x); return x; }
DEV float red16_max(float x) { x = fmaxf(x, dpp<0xB1>(x)); x = fmaxf(x, dpp<0x4E>(x)); x = fmaxf(x, dpp<0x141>(x)); x = fmaxf(x, dpp<0x140>(x)); return x; }
DEV float wave_sum(float x) {
#pragma unroll
  for (int o = 32; o >= 1; o >>= 1) x += __shfl_xor(x, o, 64);
  return x;
}
DEV int opaque_tid() { int t = threadIdx.x; asm volatile("" : "+v"(t)); return t; }
DEV bf16x8 as_frag(uint4 v) { union { uint4 u; bf16x8 b; } c; c.u = v; return c.b; }
#define MFMA(a, b, c) __builtin_amdgcn_mfma_f32_16x16x32_bf16(a, b, c, 0, 0, 0)

template <int NT>
DEV void gemm_tile(const int tid, const bf16_t* A, int lda, const bf16_t* B, int ldb, int K, char* smem,
                   f32x4 (&acc)[4][NT]) {
  constexpr int BN = NT * 32;
  constexpr int LS = 64;
  bf16_t* As = (bf16_t*)smem;
  bf16_t* Bs = As + 2 * 128 * LS;
  const int lane = tid & 63, wave = tid >> 6, wr = wave >> 1, wc = wave & 1;
  const int fr = lane & 15, fq = lane >> 4;
  constexpr int NB = BN * 8 / 256;
#pragma unroll
  for (int m = 0; m < 4; ++m)
#pragma unroll
    for (int n = 0; n < NT; ++n) acc[m][n] = (f32x4){0.f, 0.f, 0.f, 0.f};
  const int nk = K >> 6;
  const int lrow = tid >> 3, lcc = tid & 7;
  const bf16_t* Ap = A + (size_t)lrow * lda + ((lcc ^ (lrow & 7)) * 8);
  const bf16_t* Bp = B + (size_t)lrow * ldb + ((lcc ^ (lrow & 7)) * 8);
  const size_t a32 = (size_t)32 * lda, b32 = (size_t)32 * ldb;
  const int rofs0 = (fq ^ (fr & 7)) * 8, rofs1 = rofs0 ^ 32;
#define GT_DMA(buf, koff)                                                                                    \
  {                                                                                                          \
    bf16_t* Ad = As + (buf) * 128 * LS + tid * 8;                                                            \
    bf16_t* Bd = Bs + (buf) * BN * LS + tid * 8;                                                             \
    _Pragma("unroll") for (int i = 0; i < 4; ++i)                                                            \
      __builtin_amdgcn_global_load_lds((const unsigned*)(Ap + i * a32 + (koff)), (unsigned*)(Ad + i * 32 * LS), 16, 0, 0); \
    _Pragma("unroll") for (int i = 0; i < NB; ++i)                                                           \
      __builtin_amdgcn_global_load_lds((const unsigned*)(Bp + i * b32 + (koff)), (unsigned*)(Bd + i * 32 * LS), 16, 0, 0); \
  }
  GT_DMA(0, 0)
  asm volatile("s_waitcnt vmcnt(0)" ::: "memory");
  __syncthreads();
  for (int kt = 0; kt < nk; ++kt) {
    const int buf = kt & 1;
    if (kt + 1 < nk) GT_DMA(buf ^ 1, (kt + 1) * 64)
    const bf16_t* Ab = As + buf * 128 * LS + (wr * 64 + fr) * LS;
    const bf16_t* Bb = Bs + buf * BN * LS + (wc * (NT * 16) + fr) * LS;
#pragma unroll
    for (int ks = 0; ks < 2; ++ks) {
      const int ro = ks ? rofs1 : rofs0;
      bf16x8 af[4], bfr[NT];
#pragma unroll
      for (int m = 0; m < 4; ++m) af[m] = *(const bf16x8*)(Ab + m * 16 * LS + ro);
#pragma unroll
      for (int n = 0; n < NT; ++n) bfr[n] = *(const bf16x8*)(Bb + n * 16 * LS + ro);
#pragma unroll
      for (int m = 0; m < 4; ++m)
#pragma unroll
        for (int n = 0; n < NT; ++n) acc[m][n] = MFMA(af[m], bfr[n], acc[m][n]);
    }
    asm volatile("s_waitcnt vmcnt(0)" ::: "memory");
    __syncthreads();
  }
#undef GT_DMA
}

template <int NT>
DEV void stage_acc(const int tid, float* Cs, const f32x4 (&acc)[4][NT]) {
  constexpr int LDC = NT * 32 + 4;
  const int lane = tid & 63, wave = tid >> 6, wr = wave >> 1, wc = wave & 1, fr = lane & 15, fq = lane >> 4;
#pragma unroll
  for (int m = 0; m < 4; ++m)
#pragma unroll
    for (int n = 0; n < NT; ++n)
#pragma unroll
      for (int j = 0; j < 4; ++j) Cs[(wr * 64 + m * 16 + fq * 4 + j) * LDC + wc * (NT * 16) + n * 16 + fr] = acc[m][n][j];
}

DEV void gemm_tile256(const int tid, const bf16_t* A, int lda, const bf16_t* B, int ldb, int K, char* smem,
                      f32x4 (&acc)[8][4]) {
  bf16_t* As = (bf16_t*)smem;
  bf16_t* Bs = As + 3 * 8192;
  const int lane = tid & 63, wave = tid >> 6, wr = wave >> 1, wc = wave & 1;
  const int fr = lane & 15, fq = lane >> 4;
#pragma unroll
  for (int m = 0; m < 8; ++m)
#pragma unroll
    for (int n = 0; n < 4; ++n) acc[m][n] = (f32x4){0.f, 0.f, 0.f, 0.f};
  const int nk = K >> 5;
  const int drow = tid >> 2, dphys = tid & 3, dg = (0 - (tid >> 4)) & 3;
  const bf16_t* Ap = A + (size_t)drow * lda + ((dphys ^ dg) * 8);
  const bf16_t* Bp = B + (size_t)drow * ldb + ((dphys ^ dg) * 8);
  const size_t a64 = (size_t)64 * lda, b64 = (size_t)64 * ldb;
  const int rofs = (fq ^ ((0 - (fr >> 2)) & 3)) * 8;
#define G2_DMA(st, kk)                                                                                        \
  {                                                                                                           \
    bf16_t* Ad = As + (st) * 8192 + tid * 8;                                                                  \
    bf16_t* Bd = Bs + (st) * 4096 + tid * 8;                                                                  \
    _Pragma("unroll") for (int i = 0; i < 4; ++i)                                                             \
      __builtin_amdgcn_global_load_lds((const unsigned*)(Ap + i * a64 + (kk) * 32), (unsigned*)(Ad + i * 2048), 16, 0, 0); \
    _Pragma("unroll") for (int i = 0; i < 2; ++i)                                                             \
      __builtin_amdgcn_global_load_lds((const unsigned*)(Bp + i * b64 + (kk) * 32), (unsigned*)(Bd + i * 2048), 16, 0, 0); \
  }
  G2_DMA(0, 0)
  G2_DMA(1, 1)
  int st = 0;
  for (int kt = 0; kt < nk; ++kt) {
    if (kt + 1 < nk) asm volatile("s_waitcnt vmcnt(6)" ::: "memory");
    else asm volatile("s_waitcnt vmcnt(0)" ::: "memory");
    __builtin_amdgcn_s_barrier();
    asm volatile("" ::: "memory");
    const int s2 = (st >= 1) ? st - 1 : 2;
    const bool pf = (kt + 2 < nk);
    bf16_t* Ad = As + s2 * 8192 + tid * 8;
    bf16_t* Bd = Bs + s2 * 4096 + tid * 8;
    const bf16_t* Asrc = Ap + (kt + 2) * 32;
    const bf16_t* Bsrc = Bp + (kt + 2) * 32;
    const bf16_t* Ab = As + st * 8192 + (wr * 128 + fr) * 32 + rofs;
    const bf16_t* Bb = Bs + st * 4096 + (wc * 64 + fr) * 32 + rofs;
    bf16x8 bfr[4], af[4];
#pragma unroll
    for (int n = 0; n < 4; ++n) bfr[n] = *(const bf16x8*)(Bb + n * 512);
#pragma unroll
    for (int m = 0; m < 4; ++m) af[m] = *(const bf16x8*)(Ab + m * 512);
#pragma unroll
    for (int m = 0; m < 8; ++m) {
#pragma unroll
      for (int n = 0; n < 4; ++n) acc[m][n] = MFMA(af[m & 3], bfr[n], acc[m][n]);
      if (m + 4 < 8) af[m & 3] = *(const bf16x8*)(Ab + (m + 4) * 512);
      if (pf) {
        if (m < 4) __builtin_amdgcn_global_load_lds((const unsigned*)(Asrc + m * a64), (unsigned*)(Ad + m * 2048), 16, 0, 0);
        else if (m < 6) __builtin_amdgcn_global_load_lds((const unsigned*)(Bsrc + (m - 4) * b64), (unsigned*)(Bd + (m - 4) * 2048), 16, 0, 0);
      }
      __builtin_amdgcn_sched_barrier(0);
    }
    st = (st == 2) ? 0 : st + 1;
  }
#undef G2_DMA
  __syncthreads();
}

template <int PS>
DEV void stage_half(const int tid, float* Cs, const f32x4 (&acc)[8][4]) {
  const int lane = tid & 63, wave = tid >> 6, wr = wave >> 1, wc = wave & 1, fr = lane & 15, fq = lane >> 4;
#pragma unroll
  for (int m = 0; m < 4; ++m)
#pragma unroll
    for (int n = 0; n < 4; ++n)
#pragma unroll
      for (int j = 0; j < 4; ++j) Cs[(wr * 64 + m * 16 + fq * 4 + j) * 132 + wc * 64 + n * 16 + fr] = acc[PS * 4 + m][n][j];
}
#define RMAP(r, ps) ((((r) >> 6) << 7) + (ps) * 64 + ((r) & 63))

DEV bool tile_for(int it, int nM, int nN, int& tm, int& tn) {
  const int nx = gridDim.x >> 3;
  const int xcd = blockIdx.x & 7, local = blockIdx.x >> 3;
  const long id = ((long)it * 8 + xcd) * nx + local;
  if (local >= nx || id >= (long)nM * nN) return false;
  const int per_group = 8 * nN;
  const int g = (int)(id / per_group), r = (int)(id % per_group);
  tn = r >> 3; tm = g * 8 + (r & 7);
  return true;
}

PHASE void phase_prep(const Params& p, char* smem) {
  const int tid = opaque_tid();
  if (blockIdx.x == 0 && tid < 8) p.counters[tid] = 0u;
  if (blockIdx.x == 0) for (int i = tid; i < 3456; i += 256) p.counters[256 + i] = 0u;
  float* tile = (float*)smem;
  const int NCONV = 2 * 4864, NADA = 192;
  for (int item0 = blockIdx.x; item0 < NCONV + NADA; item0 += gridDim.x) {
    const int item = (item0 < NADA) ? (NCONV + item0) : (item0 - NADA);
    if (item < NCONV) {
      const int l = item / 4864; int r = item % 4864;
      const float* src; int K, Nsrc, nT, perm = 0; size_t dst;
      if (r < 2112) { src = p.w_in + (size_t)l * 1024 * 8448; K = 1024; Nsrc = 8448; dst = WIN; nT = 132; }
      else if (r < 2240) { r -= 2112; src = p.w_br_a + (size_t)l * 512 * 1024; K = 512; Nsrc = 1024; dst = WBA; nT = 16; }
      else if (r < 2368) { r -= 2240; src = p.w_br_b + (size_t)l * 512 * 1024; K = 512; Nsrc = 1024; dst = WBB; nT = 16; }
      else if (r < 2496) { r -= 2368; src = p.w_br_c + (size_t)l * 512 * 1024; K = 512; Nsrc = 1024; dst = WBC; nT = 16; }
      else if (r < 2752) { r -= 2496; src = p.w_out + (size_t)l * 1024 * 1024; K = 1024; Nsrc = 1024; dst = WOUT; nT = 16; }
      else if (r < 4160) { r -= 2752; src = p.ffn_w_in + (size_t)l * 1024 * 5632; K = 1024; Nsrc = 5632; dst = WFI; nT = 88; perm = 1; }
      else { r -= 4160; src = p.ffn_w_out + (size_t)l * 2816 * 1024; K = 2816; Nsrc = 1024; dst = WFO; nT = 16; }
      const int kt = r / nT, nt = r % nT;
      const int colbase = perm ? ((nt & 1) * FFH + 64 * (nt >> 1)) : nt * 64;
      __syncthreads();
#pragma unroll
      for (int i = 0; i < 16; ++i) {
        const int k = i * 4 + (tid >> 6), j = tid & 63;
        tile[k * 65 + j] = src[(size_t)(kt * 64 + k) * Nsrc + colbase + j];
      }
      __syncthreads();
      const int row = tid >> 2, kc = (tid & 3) * 16;
      float f[16];
#pragma unroll
      for (int i = 0; i < 16; ++i) f[i] = tile[(kc + i) * 65 + row];
      bf16_t* d = p.wt + (size_t)l * WLAYER + dst + (size_t)(nt * 64 + row) * K + kt * 64 + kc;
      *(uint4*)d = make_uint4(pack2(f[0], f[1]), pack2(f[2], f[3]), pack2(f[4], f[5]), pack2(f[6], f[7]));
      *(uint4*)(d + 8) = make_uint4(pack2(f[8], f[9]), pack2(f[10], f[11]), pack2(f[12], f[13]), pack2(f[14], f[15]));
    } else {
      const int a = item - NCONV;
      const int l = a / 96, r = a % 96, ntile = r >> 2, bg = r & 3;
      float* cact = (float*)smem;
      __syncthreads();
      for (int i = tid; i < 8 * 1024; i += 256) {
        const float cv = p.c[(size_t)(bg * 8 + (i >> 10)) * DM + (i & 1023)];
        cact[i] = cv * sigm(cv);
      }
      __syncthreads();
      const int n = ntile * 256 + tid;
      const float* W = p.ada_w + (size_t)l * DM * ADAW + n;
      float acc[8];
#pragma unroll
      for (int b = 0; b < 8; ++b) acc[b] = 0.f;
      for (int k0 = 0; k0 < DM; k0 += 16) {
        float w[16];
#pragma unroll
        for (int kk = 0; kk < 16; ++kk) w[kk] = W[(size_t)(k0 + kk) * ADAW];
#pragma unroll
        for (int kk = 0; kk < 16; ++kk)
#pragma unroll
          for (int b = 0; b < 8; ++b) acc[b] += cact[b * 1024 + k0 + kk] * w[kk];
      }
      const float bias = p.ada_b[l * ADAW + n];
#pragma unroll
      for (int b = 0; b < 8; ++b) p.ada[((size_t)l * 32 + bg * 8 + b) * ADAW + n] = acc[b] + bias;
    }
  }
}

PHASE void phase_norm(const float* __restrict__ x, const float* __restrict__ w, const float* __restrict__ ada_l,
                    int shift_off, int scale_off, bf16_t* __restrict__ h) {
  const int tid = opaque_tid();
  const int lane = tid & 63, wave = tid >> 6;
  for (int row = blockIdx.x * 4 + wave; row < T_TOK; row += gridDim.x * 4) {
    const float* xr = x + (size_t)row * DM;
    float4 v[4]; float ss = 0.f;
#pragma unroll
    for (int i = 0; i < 4; ++i) { v[i] = *(const float4*)(xr + i * 256 + lane * 4); ss += v[i].x * v[i].x + v[i].y * v[i].y + v[i].z * v[i].z + v[i].w * v[i].w; }
    ss = wave_sum(ss);
    const float rstd = rsqrtf(ss * (1.f / DM) + 1e-6f);
    const float* ad = ada_l + (size_t)(row / SEQ) * ADAW;
#pragma unroll
    for (int i = 0; i < 4; ++i) {
      const int col = i * 256 + lane * 4;
      const float4 ww = *(const float4*)(w + col), sc = *(const float4*)(ad + scale_off + col), sh = *(const float4*)(ad + shift_off + col);
      const float o0 = v[i].x * rstd * ww.x * (1.f + sc.x) + sh.x, o1 = v[i].y * rstd * ww.y * (1.f + sc.y) + sh.y;
      const float o2 = v[i].z * rstd * ww.z * (1.f + sc.z) + sh.z, o3 = v[i].w * rstd * ww.w * (1.f + sc.w) + sh.w;
      *(uint2*)(h + (size_t)row * DM + col) = make_uint2(pack2(o0, o1), pack2(o2, o3));
    }
  }
}

PHASE void phase_final(float* __restrict__ x, const float* __restrict__ w) {
  const int tid = opaque_tid();
  const int lane = tid & 63, wave = tid >> 6;
  for (int row = blockIdx.x * 4 + wave; row < T_TOK; row += gridDim.x * 4) {
    float* xr = x + (size_t)row * DM;
    float4 v[4]; float ss = 0.f;
#pragma unroll
    for (int i = 0; i < 4; ++i) { v[i] = *(const float4*)(xr + i * 256 + lane * 4); ss += v[i].x * v[i].x + v[i].y * v[i].y + v[i].z * v[i].z + v[i].w * v[i].w; }
    ss = wave_sum(ss);
    const float rstd = rsqrtf(ss * (1.f / DM) + 1e-6f);
#pragma unroll
    for (int i = 0; i < 4; ++i) {
      const int col = i * 256 + lane * 4;
      const float4 ww = *(const float4*)(w + col);
      *(float4*)(xr + col) = make_float4(v[i].x * rstd * ww.x, v[i].y * rstd * ww.y, v[i].z * rstd * ww.z, v[i].w * rstd * ww.w);
    }
  }
}

PHASE void phase_gemm_in(const Params& p, int l, char* smem) {
  const bf16_t* Wt = p.wt + (size_t)l * WLAYER + WIN;
  float* Cs = (float*)smem;
  const int tid = opaque_tid();
  for (int it = 0;; ++it) {
    int tm, tn;
    if (!tile_for(it, 256, 42, tm, tn)) break;
    f32x4 acc[8][4];
    gemm_tile256(tid, p.h + (size_t)tm * 256 * DM, DM, Wt + (size_t)tn * 128 * DM, DM, DM, smem, acc);
    const size_t row0 = (size_t)tm * 256;
#pragma unroll
    for (int ps = 0; ps < 2; ++ps) {
      if (ps == 0) stage_half<0>(tid, Cs, acc); else stage_half<1>(tid, Cs, acc);
      __syncthreads();
      if (tn < 8) {
        const float qs = (tn < 4) ? 0.125f : 1.f;
        const int ch = tid & 15, g = ch >> 3, cc = ch & 7;
        if (cc < 4) {
#pragma unroll 1
          for (int i = 0; i < 8; ++i) {
            const int r = (tid >> 4) + i * 16;
            const size_t grow = row0 + RMAP(r, ps);
            const float pos = (float)p.pos[grow];
            const float* c1 = Cs + r * 132 + g * 64 + cc * 8;
            float o1[8], o2[8];
#pragma unroll
            for (int e = 0; e < 8; ++e) {
              const float x1 = c1[e], x2 = c1[32 + e];
              const float inv = exp2f(-(float)(cc * 8 + e) * 0.41524101186092029f);
              float rev = pos * inv * 0.15915494309189535f;
              rev -= rintf(rev);
              const float sn = __builtin_amdgcn_sinf(rev), cs = __builtin_amdgcn_cosf(rev);
              o1[e] = (x1 * cs - x2 * sn) * qs; o2[e] = (x2 * cs + x1 * sn) * qs;
            }
            bf16_t* d = p.u + grow * US + tn * 128 + g * 64 + cc * 8;
            *(uint4*)d = PACK8(o1);
            *(uint4*)(d + 32) = PACK8(o2);
          }
        }
      } else if (tn < 12) {
        const int b = (int)(row0 / SEQ), s0 = (int)(row0 % SEQ), vc0 = (tn - 8) * 128;
        const int rch = tid & 15;
#pragma unroll 1
        for (int i = 0; i < 8; ++i) {
          const int c = (tid >> 4) + i * 16;
          float f[8];
#pragma unroll
          for (int j = 0; j < 8; ++j) f[j] = Cs[(rch * 8 + j) * 132 + c];
          *(uint4*)(p.vT + ((size_t)b * 512 + vc0 + c) * SEQ + s0 + RMAP(rch * 8, ps)) = PACK8(f);
        }
      } else {
        const int ch = tid & 15;
#pragma unroll 1
        for (int i = 0; i < 8; ++i) {
          const int r = (tid >> 4) + i * 16;
          const float4 a = *(const float4*)(Cs + r * 132 + ch * 8), b = *(const float4*)(Cs + r * 132 + ch * 8 + 4);
          *(uint4*)(p.u + (row0 + RMAP(r, ps)) * US + tn * 128 - 512 + ch * 8) = make_uint4(pack2(a.x, a.y), pack2(a.z, a.w), pack2(b.x, b.y), pack2(b.z, b.w));
        }
      }
      __syncthreads();
    }
  }
}

PHASE void phase_vlo(const Params& p, int l, char* smem) {
  float* vs = (float*)smem;
  const int tid = opaque_tid();
  const float* mu = p.rw_mu + (size_t)l * 1792 + 1024;
  const float* v1 = p.rw_v1;
  for (int item = blockIdx.x; item < T_TOK / 32; item += gridDim.x) {
    const size_t tok0 = (size_t)item * 32;
    __syncthreads();
#pragma unroll 1
    for (int i = 0; i < 8; ++i) {
      const int c = tid + i * 256;
      const int t = c >> 6, cc = c & 63;
      const size_t tok = tok0 + t;
      const uint4 cur = *(const uint4*)(p.u + tok * US + 3072 + 1024 + cc * 8);
      uint4 prv = make_uint4(0, 0, 0, 0);
      if ((tok % SEQ) != 0) prv = *(const uint4*)(p.u + (tok - 1) * US + 3072 + 1024 + cc * 8);
      float a[8], b[8];
      UNPACK8(cur, a); UNPACK8(prv, b);
#pragma unroll
      for (int e = 0; e < 8; ++e) vs[t * 512 + cc * 8 + e] = a[e] + (b[e] - a[e]) * mu[cc * 8 + e];
    }
    __syncthreads();
    const int j = tid & 31, tg = tid >> 5;
    float acc[4] = {0.f, 0.f, 0.f, 0.f};
    for (int k0 = 0; k0 < 512; k0 += 16) {
      float w[16];
#pragma unroll
      for (int kk = 0; kk < 16; ++kk) w[kk] = v1[(k0 + kk) * 32 + j];
#pragma unroll
      for (int kk = 0; kk < 16; ++kk)
#pragma unroll
        for (int i = 0; i < 4; ++i) acc[i] += vs[(tg * 4 + i) * 512 + k0 + kk] * w[kk];
    }
#pragma unroll
    for (int i = 0; i < 4; ++i) p.vlo[(tok0 + tg * 4 + i) * 32 + j] = acc[i];
  }
}

PHASE void att_item(const Params& p, int l, int item, char* smem) {
  const int qc = 31 - (item >> 7);
  const int bh = item & 127, b = bh >> 2, h = bh & 3;
  const int tid = opaque_tid(), lane = tid & 63, wave = tid >> 6, fr = lane & 15, fq = lane >> 4;
  const int m = wave >> 1, rh = wave & 1;
  bf16_t* Ks = (bf16_t*)smem;
  bf16_t* Vt = Ks + 2 * 64 * 72;
  bf16_t* Ps = Vt + 128 * 72;
  float* Ox = (float*)smem;
  const size_t tok0 = (size_t)b * SEQ + (size_t)qc * 64;
  const float* lv = p.da_lambda + (size_t)l * 256;
  float d1 = 0.f, d2 = 0.f;
  for (int i = 0; i < 64; ++i) { d1 += lv[i] * lv[64 + i]; d2 += lv[128 + i] * lv[192 + i]; }
  const float lam_init = 0.8f - 0.6f * __expf(-0.3f * (float)l);
  const float lam = __expf(d1) - __expf(d2) + lam_init;

  bf16x8 qf[2][2];
#pragma unroll
  for (int mt = 0; mt < 2; ++mt)
#pragma unroll
    for (int ks = 0; ks < 2; ++ks)
      qf[mt][ks] = *(const bf16x8*)(p.u + (tok0 + rh * 32 + mt * 16 + fr) * US + h * 128 + m * 64 + ks * 32 + fq * 8);
  f32x4 o[2][8];
  float mx[2][4], ls[2][4];
#pragma unroll
  for (int mt = 0; mt < 2; ++mt) {
#pragma unroll
    for (int n = 0; n < 8; ++n) o[mt][n] = (f32x4){0.f, 0.f, 0.f, 0.f};
#pragma unroll
    for (int j = 0; j < 4; ++j) { mx[mt][j] = -1e30f; ls[mt][j] = 0.f; }
  }
  bf16_t* Pw = Ps + wave * 32 * 72;
  for (int kt = 0; kt <= qc; ++kt) {
    __syncthreads();
#pragma unroll
    for (int i = 0; i < 4; ++i) {
      const int c = tid + i * 256;
      const int mm = c >> 9, key = (c >> 3) & 63, cc = c & 7;
      *(uint4*)(Ks + (mm * 64 + key) * 72 + cc * 8) =
          *(const uint4*)(p.u + ((size_t)b * SEQ + kt * 64 + key) * US + 512 + h * 128 + mm * 64 + cc * 8);
    }
#pragma unroll
    for (int i = 0; i < 4; ++i) {
      const int c = tid + i * 256;
      const int dim = c >> 3, cc = c & 7;
      *(uint4*)(Vt + dim * 72 + cc * 8) = *(const uint4*)(p.vT + ((size_t)b * 512 + h * 128 + dim) * SEQ + kt * 64 + cc * 8);
    }
    __syncthreads();
    f32x4 s[2][4];
#pragma unroll
    for (int mt = 0; mt < 2; ++mt)
#pragma unroll
      for (int n = 0; n < 4; ++n) s[mt][n] = (f32x4){0.f, 0.f, 0.f, 0.f};
#pragma unroll
    for (int ks = 0; ks < 2; ++ks)
#pragma unroll
      for (int n = 0; n < 4; ++n) {
        const bf16x8 kf = *(const bf16x8*)(Ks + (m * 64 + n * 16 + fr) * 72 + ks * 32 + fq * 8);
#pragma unroll
        for (int mt = 0; mt < 2; ++mt) s[mt][n] = MFMA(qf[mt][ks], kf, s[mt][n]);
      }
#pragma unroll
    for (int mt = 0; mt < 2; ++mt)
#pragma unroll
      for (int j = 0; j < 4; ++j) {
        float tmax = fmaxf(fmaxf(s[mt][0][j], s[mt][1][j]), fmaxf(s[mt][2][j], s[mt][3][j]));
        tmax = red16_max(tmax);
        const float mnew = fmaxf(mx[mt][j], tmax);
        const float alpha = __expf(mx[mt][j] - mnew);
        float rs = 0.f;
#pragma unroll
        for (int n = 0; n < 4; ++n) {
          const float pv = __expf(s[mt][n][j] - mnew);
          rs += pv;
          Pw[(mt * 16 + fq * 4 + j) * 72 + n * 16 + fr] = f2bf(pv);
        }
        rs = red16_sum(rs);
        ls[mt][j] = ls[mt][j] * alpha + rs;
        mx[mt][j] = mnew;
#pragma unroll
        for (int n = 0; n < 8; ++n) o[mt][n][j] *= alpha;
      }
    __syncthreads();
#pragma unroll
    for (int ks = 0; ks < 2; ++ks) {
      bf16x8 pf[2];
#pragma unroll
      for (int mt = 0; mt < 2; ++mt) pf[mt] = *(const bf16x8*)(Pw + (mt * 16 + fr) * 72 + ks * 32 + fq * 8);
#pragma unroll
      for (int n = 0; n < 8; ++n) {
        const bf16x8 vf = *(const bf16x8*)(Vt + (n * 16 + fr) * 72 + ks * 32 + fq * 8);
#pragma unroll
        for (int mt = 0; mt < 2; ++mt) o[mt][n] = MFMA(pf[mt], vf, o[mt][n]);
      }
    }
  }
  __syncthreads();
#pragma unroll
  for (int mt = 0; mt < 2; ++mt)
#pragma unroll
    for (int j = 0; j < 4; ++j) {
      const float inv = 1.f / ls[mt][j];
#pragma unroll
      for (int n = 0; n < 8; ++n) o[mt][n][j] *= inv;
    }
  if (m == 1) {
#pragma unroll
    for (int mt = 0; mt < 2; ++mt)
#pragma unroll
      for (int n = 0; n < 8; ++n)
#pragma unroll
        for (int j = 0; j < 4; ++j) Ox[(rh * 32 + mt * 16 + fq * 4 + j) * 132 + n * 16 + fr] = o[mt][n][j];
  }
  __syncthreads();
  if (m == 0) {
    const float* sw = p.da_subln_w + (size_t)l * 128;
    float wv[8];
#pragma unroll
    for (int n = 0; n < 8; ++n) wv[n] = sw[n * 16 + fr] * (1.f - lam_init);
#pragma unroll
    for (int mt = 0; mt < 2; ++mt)
#pragma unroll
      for (int j = 0; j < 4; ++j) {
        float ss = 0.f;
        float d[8];
#pragma unroll
        for (int n = 0; n < 8; ++n) {
          d[n] = o[mt][n][j] - lam * Ox[(rh * 32 + mt * 16 + fq * 4 + j) * 132 + n * 16 + fr];
          ss += d[n] * d[n];
        }
        ss = red16_sum(ss);
        const float rstd = rsqrtf(ss * (1.f / 128.f) + 1e-6f);
        bf16_t* dst = p.u + (tok0 + rh * 32 + mt * 16 + fq * 4 + j) * US + h * 128 + fr;
#pragma unroll
        for (int n = 0; n < 8; ++n) dst[n * 16] = f2bf(d[n] * rstd * wv[n]);
      }
  }
  __syncthreads();
}

PHASE void hgrn_item(const Params& p, int l, int item, char* smem) {
  const int b = item >> 2, h = item & 3;
  const int tid = opaque_tid(), lane = tid & 63, wave = tid >> 6, fr = lane & 15, fq = lane >> 4;
  bf16_t* Qs = (bf16_t*)smem;
  bf16_t* Kn = Qs + 32 * 136;
  bf16_t* KT = Kn + 32 * 136;
  bf16_t* VT = KT + 128 * 40;
  bf16_t* Ps = VT + 128 * 40;
  bf16_t* ST = Ps + 32 * 40;
  float* lfb = (float*)ST;
  float* red = (float*)(ST + 128 * 136);
  float* blast = red + 64;
  const int t_ = tid >> 3, d0 = (tid & 7) * 16;
  float lbv[16];
#pragma unroll
  for (int i = 0; i < 16; ++i) {
    const int c = h * 128 + d0 + i;
    lbv[i] = (l == 0) ? 0.f : sigm(p.hg_lb[512 + c] - p.hg_lb[c]);
  }
  f32x4 S[2][8];
#pragma unroll
  for (int mm = 0; mm < 2; ++mm)
#pragma unroll
    for (int n = 0; n < 8; ++n) S[mm][n] = (f32x4){0.f, 0.f, 0.f, 0.f};
  const float* nw = p.hg_norm_w + (size_t)l * 128;

  for (int ch = 0; ch < 64; ++ch) {
    const size_t tok0 = (size_t)b * SEQ + (size_t)ch * 32;
    __syncthreads();
    float qv[16], kv[16];
    {
      const bf16_t* base = p.u + (tok0 + t_) * US + h * 128 + d0;
      float zv[16], iv[16];
      { const uint4 a = *(const uint4*)(base + 1024), c = *(const uint4*)(base + 1024 + 8); float* z0 = zv; float* z1 = zv + 8; UNPACK8(a, z0); UNPACK8(c, z1); }
      { const uint4 a = *(const uint4*)(base + 1536), c = *(const uint4*)(base + 1536 + 8); float* z0 = iv; float* z1 = iv + 8; UNPACK8(a, z0); UNPACK8(c, z1); }
      { const uint4 a = *(const uint4*)(base + 2048), c = *(const uint4*)(base + 2048 + 8); float* z0 = qv; float* z1 = qv + 8; UNPACK8(a, z0); UNPACK8(c, z1); }
#pragma unroll
      for (int i = 0; i < 16; ++i) {
        const float z = zv[i], lb = lbv[i];
        const float ez = __expf(-fabsf(z));
        float lf;
        if (lb > 0.f) {
          const float sg = (z >= 0.f) ? 1.f / (1.f + ez) : ez / (1.f + ez);
          lf = __logf(lb + (1.f - lb) * sg);
        } else {
          lf = -(fmaxf(-z, 0.f) + __logf(1.f + ez));
        }
        const float sgn = (z >= 0.f) ? ez / (1.f + ez) : 1.f / (1.f + ez);
        kv[i] = (1.f - lb) * sgn;
        lfb[t_ * 128 + d0 + i] = lf;
        VT[(d0 + i) * 40 + t_] = f2bf(iv[i]);
      }
    }
    __syncthreads();
    if (tid < 128) {
      float bsum = 0.f;
#pragma unroll 8
      for (int t = 0; t < 32; ++t) { bsum += lfb[t * 128 + tid]; lfb[t * 128 + tid] = bsum; }
      blast[tid] = bsum;
    }
    __syncthreads();
    {
      float qo[16], ko[16];
#pragma unroll
      for (int i = 0; i < 16; ++i) {
        const float bb = lfb[t_ * 128 + d0 + i];
        qo[i] = qv[i] * __expf(bb);
        ko[i] = kv[i] * __expf(fminf(-bb, 80.f));
        KT[(d0 + i) * 40 + t_] = f2bf(ko[i]);
      }
      float* q0 = qo; float* q1 = qo + 8; float* k0 = ko; float* k1 = ko + 8;
      *(uint4*)(Qs + t_ * 136 + d0) = PACK8(q0);
      *(uint4*)(Qs + t_ * 136 + d0 + 8) = PACK8(q1);
      *(uint4*)(Kn + t_ * 136 + d0) = PACK8(k0);
      *(uint4*)(Kn + t_ * 136 + d0 + 8) = PACK8(k1);
    }
    __syncthreads();
#pragma unroll
    for (int mm = 0; mm < 2; ++mm)
#pragma unroll
      for (int n = 0; n < 8; ++n)
        *(uint2*)(ST + (n * 16 + fr) * 136 + wave * 32 + mm * 16 + fq * 4) =
            make_uint2(pack2(S[mm][n][0], S[mm][n][1]), pack2(S[mm][n][2], S[mm][n][3]));
    {
      const int mt = wave >> 1, nt = wave & 1;
      f32x4 sc = (f32x4){0.f, 0.f, 0.f, 0.f};
#pragma unroll
      for (int ks = 0; ks < 4; ++ks) {
        const bf16x8 a = *(const bf16x8*)(Qs + (mt * 16 + fr) * 136 + ks * 32 + fq * 8);
        const bf16x8 bb = *(const bf16x8*)(Kn + (nt * 16 + fr) * 136 + ks * 32 + fq * 8);
        sc = MFMA(a, bb, sc);
      }
#pragma unroll
      for (int j = 0; j < 4; ++j) {
        const int t = mt * 16 + fq * 4 + j, key = nt * 16 + fr;
        Ps[t * 40 + key] = f2bf(key <= t ? sc[j] : 0.f);
      }
    }
    __syncthreads();
    {
      const int mt = wave & 1, nb = (wave >> 1) * 4;
      f32x4 oo[4];
#pragma unroll
      for (int n = 0; n < 4; ++n) oo[n] = (f32x4){0.f, 0.f, 0.f, 0.f};
      {
        const bf16x8 a = *(const bf16x8*)(Ps + (mt * 16 + fr) * 40 + fq * 8);
#pragma unroll
        for (int n = 0; n < 4; ++n) {
          const bf16x8 bb = *(const bf16x8*)(VT + ((nb + n) * 16 + fr) * 40 + fq * 8);
          oo[n] = MFMA(a, bb, oo[n]);
        }
      }
#pragma unroll
      for (int ks = 0; ks < 4; ++ks) {
        const bf16x8 a = *(const bf16x8*)(Qs + (mt * 16 + fr) * 136 + ks * 32 + fq * 8);
#pragma unroll
        for (int n = 0; n < 4; ++n) {
          const bf16x8 bb = *(const bf16x8*)(ST + ((nb + n) * 16 + fr) * 136 + ks * 32 + fq * 8);
          oo[n] = MFMA(a, bb, oo[n]);
        }
      }
#pragma unroll
      for (int j = 0; j < 4; ++j) {
        float ss = 0.f;
#pragma unroll
        for (int n = 0; n < 4; ++n) ss += oo[n][j] * oo[n][j];
        ss = red16_sum(ss);
        if (fr == 0) red[(mt * 16 + fq * 4 + j) * 2 + (wave >> 1)] = ss;
      }
      __syncthreads();
#pragma unroll
      for (int j = 0; j < 4; ++j) {
        const int t = mt * 16 + fq * 4 + j;
        const float rstd = rsqrtf((red[t * 2] + red[t * 2 + 1]) * (1.f / 128.f) + 1e-6f);
        bf16_t* gp = p.u + (tok0 + t) * US + 2560 + h * 128 + nb * 16 + fr;
#pragma unroll
        for (int n = 0; n < 4; ++n) {
          const float g = bf2f(gp[n * 16]);
          gp[n * 16] = f2bf(oo[n][j] * rstd * nw[(nb + n) * 16 + fr] * (g * sigm(g)));
        }
      }
    }
    {
      bf16x8 af[2];
#pragma unroll
      for (int mm = 0; mm < 2; ++mm) af[mm] = *(const bf16x8*)(KT + (wave * 32 + mm * 16 + fr) * 40 + fq * 8);
#pragma unroll
      for (int n = 0; n < 8; ++n) {
        const bf16x8 bb = *(const bf16x8*)(VT + (n * 16 + fr) * 40 + fq * 8);
#pragma unroll
        for (int mm = 0; mm < 2; ++mm) S[mm][n] = MFMA(af[mm], bb, S[mm][n]);
      }
#pragma unroll
      for (int mm = 0; mm < 2; ++mm)
#pragma unroll
        for (int j = 0; j < 4; ++j) {
          const float e = __expf(blast[wave * 32 + mm * 16 + fq * 4 + j]);
#pragma unroll
          for (int n = 0; n < 8; ++n) S[mm][n][j] *= e;
        }
    }
  }
  __syncthreads();
}

DEV uint4 rw_act(const uint4 cur, const uint4 prv, const float* mul8, int mode) {
  const float4 m0 = *(const float4*)(mul8), m1 = *(const float4*)(mul8 + 4);
  const float mm[8] = {m0.x, m0.y, m0.z, m0.w, m1.x, m1.y, m1.z, m1.w};
  float a[8], b[8], o[8];
  UNPACK8(cur, a); UNPACK8(prv, b);
#pragma unroll
  for (int e = 0; e < 8; ++e) {
    float v = a[e] + (b[e] - a[e]) * mm[e];
    if (mode == 1) { const float t = __expf(-2.f * fabsf(v)); const float th = (1.f - t) / (1.f + t); v = (v >= 0.f) ? th : -th; }
    else if (mode == 2) v = sigm(v);
    o[e] = v;
  }
  return PACK8(o);
}
DEV bf16x8 rw_bfrag(const float* W, int k0, int col) {
  float o[8];
#pragma unroll
  for (int e = 0; e < 8; ++e) o[e] = W[(size_t)(k0 + e) * 512 + col];
  return as_frag(PACK8(o));
}

PHASE void rwkv_item(const Params& p, int l, int item, char* smem) {
  const int b = item >> 3, h = item & 7;
  const int tid = opaque_tid(), lane = tid & 63, wave = tid >> 6, fr = lane & 15, fq = lane >> 4;
  float* R = (float*)smem;
  float* K = R + 2048; float* KK = K + 2048; float* W = KK + 2048; float* BB = W + 2048;
  float* V = BB + 2048; float* G = V + 2048; float* O = G + 2048;
  float* cst = O + 2048;
  float* mul = cst + 512;
  bf16_t* rawL = (bf16_t*)smem;
  float* vloL = (float*)(smem + 17424);
  const float* mu = p.rw_mu + (size_t)l * 1792;
  const int hc_n = h * 64 + wave * 16 + fr;
  bf16x8 w2f[2], a2f[2], g2f[4], v2f;
#pragma unroll
  for (int ks = 0; ks < 2; ++ks) {
    w2f[ks] = rw_bfrag(p.rw_w2 + (size_t)l * 64 * 512, ks * 32 + fq * 8, hc_n);
    a2f[ks] = rw_bfrag(p.rw_a2 + (size_t)l * 64 * 512, ks * 32 + fq * 8, hc_n);
  }
#pragma unroll
  for (int ks = 0; ks < 4; ++ks) g2f[ks] = rw_bfrag(p.rw_g2 + (size_t)l * 128 * 512, ks * 32 + fq * 8, hc_n);
  v2f = w2f[0];
  if (l > 0) v2f = rw_bfrag(p.rw_v2, fq * 8, hc_n);
  const float w0c = p.rw_w0[l * 512 + hc_n], a0c = p.rw_a0[l * 512 + hc_n];
  const float v0c = (l > 0) ? p.rw_v0[hc_n] : 0.f;
  const int t_ = tid >> 3, n0 = (tid & 7) * 8;
  __syncthreads();
  if (tid < 64) {
    const int hc = h * 64 + tid;
    cst[tid] = p.rw_k_k[l * 512 + hc]; cst[64 + tid] = p.rw_k_a[l * 512 + hc]; cst[128 + tid] = p.rw_r_k[l * 512 + hc];
    cst[192 + tid] = p.rw_gn_w[l * 512 + hc]; cst[256 + tid] = p.rw_gn_b[l * 512 + hc];
    cst[320 + tid] = mu[hc]; cst[384 + tid] = mu[512 + hc]; cst[448 + tid] = mu[1024 + hc];
  }
  mul[tid] = mu[1536 + tid];
  const float* kkc = cst + n0; const float* kac = cst + 64 + n0; const float* rkc = cst + 128 + n0;
  const float* gnw = cst + 192 + n0; const float* gnb = cst + 256 + n0;
  const float* mur = cst + 320 + n0; const float* muk = cst + 384 + n0; const float* muv = cst + 448 + n0;
  const int kq = lane & 7, row0 = wave * 16 + (lane >> 3), row1 = row0 + 8;
  float S0[8], S1[8];
#pragma unroll
  for (int e = 0; e < 8; ++e) { S0[e] = 0.f; S1[e] = 0.f; }

  uint4 pl0, pl1, pl2, pl3, pl4, pcr, pck, pcv, ppr, ppk, ppv, pvf;
  float4 pvl;
#define RW_PREFETCH(ch_)                                                                                    \
  {                                                                                                         \
    const size_t tk0 = (size_t)b * SEQ + (size_t)(ch_) * 32;                                                 \
    const bf16_t* lb_ = p.u + (tk0 - 1) * US + 3072 + 1536 + (tid & 31) * 8;                                 \
    const int r0_ = tid >> 5;                                                                               \
    pl0 = make_uint4(0, 0, 0, 0); if (!((ch_) == 0 && r0_ == 0)) pl0 = *(const uint4*)(lb_ + (size_t)r0_ * US); \
    pl1 = *(const uint4*)(lb_ + (size_t)(r0_ + 8) * US);                                                     \
    pl2 = *(const uint4*)(lb_ + (size_t)(r0_ + 16) * US);                                                    \
    pl3 = *(const uint4*)(lb_ + (size_t)(r0_ + 24) * US);                                                    \
    pl4 = make_uint4(0, 0, 0, 0); if (tid < 32) pl4 = *(const uint4*)(lb_ + (size_t)32 * US);                \
    const bf16_t* cu_ = p.u + (tk0 + t_) * US + 3072 + h * 64 + n0;                                          \
    pcr = *(const uint4*)cu_; pck = *(const uint4*)(cu_ + 512); pcv = *(const uint4*)(cu_ + 1024);           \
    if ((ch_) == 0 && t_ == 0) { ppr = make_uint4(0, 0, 0, 0); ppk = ppr; ppv = ppr; }                        \
    else { ppr = *(const uint4*)(cu_ - US); ppk = *(const uint4*)(cu_ - US + 512); ppv = *(const uint4*)(cu_ - US + 1024); } \
    if (l > 0) {                                                                                            \
      pvl = *(const float4*)(p.vlo + (tk0 + (tid >> 3)) * 32 + (tid & 7) * 4);                               \
      pvf = *(const uint4*)(p.vfirst + (tk0 + t_) * 512 + h * 64 + n0);                                      \
    } else { pvl = make_float4(0.f, 0.f, 0.f, 0.f); pvf = make_uint4(0, 0, 0, 0); }                          \
  }
  RW_PREFETCH(0)

  for (int ch = 0; ch < 64; ++ch) {
    const size_t tok0 = (size_t)b * SEQ + (size_t)ch * 32;
    __syncthreads();
    {
      const int r0_ = tid >> 5, cc_ = (tid & 31) * 8;
      *(uint4*)(rawL + r0_ * 264 + cc_) = pl0;
      *(uint4*)(rawL + (r0_ + 8) * 264 + cc_) = pl1;
      *(uint4*)(rawL + (r0_ + 16) * 264 + cc_) = pl2;
      *(uint4*)(rawL + (r0_ + 24) * 264 + cc_) = pl3;
      if (tid < 32) *(uint4*)(rawL + 32 * 264 + cc_) = pl4;
      *(float4*)(vloL + (tid >> 3) * 36 + (tid & 7) * 4) = pvl;
    }
    __syncthreads();
    {
      const int cc_ = (tid & 31) * 8, tr = tid >> 5;
      const int mode = (cc_ < 64) ? 1 : ((cc_ < 128) ? 0 : 2);
      uint4 a0, a1, a2, a3;
      a0 = rw_act(*(const uint4*)(rawL + (tr + 1) * 264 + cc_), *(const uint4*)(rawL + tr * 264 + cc_), mul + cc_, mode);
      a1 = rw_act(*(const uint4*)(rawL + (tr + 9) * 264 + cc_), *(const uint4*)(rawL + (tr + 8) * 264 + cc_), mul + cc_, mode);
      a2 = rw_act(*(const uint4*)(rawL + (tr + 17) * 264 + cc_), *(const uint4*)(rawL + (tr + 16) * 264 + cc_), mul + cc_, mode);
      a3 = rw_act(*(const uint4*)(rawL + (tr + 25) * 264 + cc_), *(const uint4*)(rawL + (tr + 24) * 264 + cc_), mul + cc_, mode);
      __syncthreads();
      *(uint4*)(rawL + tr * 264 + cc_) = a0;
      *(uint4*)(rawL + (tr + 8) * 264 + cc_) = a1;
      *(uint4*)(rawL + (tr + 16) * 264 + cc_) = a2;
      *(uint4*)(rawL + (tr + 24) * 264 + cc_) = a3;
    }
    __syncthreads();
#pragma unroll 1
    for (int mt = 0; mt < 2; ++mt) {
      const int row = mt * 16 + fr;
      const bf16_t* ar = rawL + row * 264 + fq * 8;
      f32x4 aw = (f32x4){0.f, 0.f, 0.f, 0.f}, aa = aw, ag = aw, av = aw;
#pragma unroll
      for (int ks = 0; ks < 2; ++ks) {
        aw = MFMA(*(const bf16x8*)(ar + ks * 32), w2f[ks], aw);
        aa = MFMA(*(const bf16x8*)(ar + 64 + ks * 32), a2f[ks], aa);
      }
#pragma unroll
      for (int ks = 0; ks < 4; ++ks) ag = MFMA(*(const bf16x8*)(ar + 128 + ks * 32), g2f[ks], ag);
      if (l > 0) {
        const float4 x0 = *(const float4*)(vloL + row * 36 + fq * 8), x1 = *(const float4*)(vloL + row * 36 + fq * 8 + 4);
        const uint4 pk = make_uint4(pack2(x0.x, x0.y), pack2(x0.z, x0.w), pack2(x1.x, x1.y), pack2(x1.z, x1.w));
        av = MFMA(as_frag(pk), v2f, av);
      }
#pragma unroll
      for (int j = 0; j < 4; ++j) {
        const int t = mt * 16 + fq * 4 + j, n = wave * 16 + fr;
        const float wv = -(w0c + aw[j]);
        const float sp = fmaxf(wv, 0.f) + __logf(1.f + __expf(-fabsf(wv)));
        const float wl = -sp - 0.5f;
        W[t * 64 + n] = __expf(-__expf(wl));
        BB[t * 64 + n] = sigm(a0c + aa[j]);
        G[t * 64 + n] = ag[j];
        if (l > 0) O[t * 64 + n] = sigm(v0c + av[j]);
      }
    }
    __syncthreads();
    {
      const size_t tok = tok0 + t_;
      float cr[8], ck[8], cv[8], pr[8], pk[8], pv[8];
      UNPACK8(pcr, cr); UNPACK8(pck, ck); UNPACK8(pcv, cv);
      UNPACK8(ppr, pr); UNPACK8(ppk, pk); UNPACK8(ppv, pv);
      float kx[8], kkv[8], vs[8], ss = 0.f;
#pragma unroll
      for (int e = 0; e < 8; ++e) {
        R[t_ * 64 + n0 + e] = cr[e] + (pr[e] - cr[e]) * mur[e];
        kx[e] = ck[e] + (pk[e] - ck[e]) * muk[e];
        vs[e] = cv[e] + (pv[e] - cv[e]) * muv[e];
        kkv[e] = kx[e] * kkc[e]; ss += kkv[e] * kkv[e];
      }
      ss = red8_sum(ss);
      const float rn = rsqrtf(fmaxf(ss, 1e-24f));
#pragma unroll
      for (int e = 0; e < 8; ++e) {
        const float a = BB[t_ * 64 + n0 + e];
        const float kn = kkv[e] * rn;
        K[t_ * 64 + n0 + e] = kx[e] * (1.f + (a - 1.f) * kac[e]);
        KK[t_ * 64 + n0 + e] = kn;
        BB[t_ * 64 + n0 + e] = kn * a;
      }
      if (l == 0) {
        *(uint4*)(p.vfirst + tok * 512 + h * 64 + n0) = PACK8(vs);
      } else {
        float vf[8]; UNPACK8(pvf, vf);
#pragma unroll
        for (int e = 0; e < 8; ++e) vs[e] = vs[e] + (vf[e] - vs[e]) * O[t_ * 64 + n0 + e];
      }
#pragma unroll
      for (int e = 0; e < 8; ++e) V[t_ * 64 + n0 + e] = vs[e];
    }
    __syncthreads();
    if (ch + 1 < 64) RW_PREFETCH(ch + 1)
    asm volatile("" ::: "memory");
#pragma unroll 2
    for (int t = 0; t < 32; ++t) {
      const float* base = R + t * 64 + kq * 8;
      const float4 r0 = *(const float4*)(base), r1 = *(const float4*)(base + 4);
      const float4 k0 = *(const float4*)(base + 2048), k1 = *(const float4*)(base + 2048 + 4);
      const float4 q0 = *(const float4*)(base + 4096), q1 = *(const float4*)(base + 4096 + 4);
      const float4 w0 = *(const float4*)(base + 6144), w1 = *(const float4*)(base + 6144 + 4);
      const float4 b0 = *(const float4*)(base + 8192), b1 = *(const float4*)(base + 8192 + 4);
      const float va = V[t * 64 + row0], vb = V[t * 64 + row1];
      const float rr[8] = {r0.x, r0.y, r0.z, r0.w, r1.x, r1.y, r1.z, r1.w};
      const float ww[8] = {w0.x, w0.y, w0.z, w0.w, w1.x, w1.y, w1.z, w1.w};
      const float kk_[8] = {k0.x, k0.y, k0.z, k0.w, k1.x, k1.y, k1.z, k1.w};
      const float qq[8] = {q0.x, q0.y, q0.z, q0.w, q1.x, q1.y, q1.z, q1.w};
      const float bb[8] = {b0.x, b0.y, b0.z, b0.w, b1.x, b1.y, b1.z, b1.w};
      float sa0 = 0.f, sa1 = 0.f;
#pragma unroll
      for (int e = 0; e < 8; ++e) { sa0 += S0[e] * qq[e]; sa1 += S1[e] * qq[e]; }
      sa0 = -red8_sum(sa0); sa1 = -red8_sum(sa1);
      float o0 = 0.f, o1 = 0.f;
#pragma unroll
      for (int e = 0; e < 8; ++e) {
        S0[e] = S0[e] * ww[e] + sa0 * bb[e] + va * kk_[e];
        S1[e] = S1[e] * ww[e] + sa1 * bb[e] + vb * kk_[e];
        o0 += S0[e] * rr[e]; o1 += S1[e] * rr[e];
      }
      o0 = red8_sum(o0); o1 = red8_sum(o1);
      if (kq == 0) { O[t * 64 + row0] = o0; O[t * 64 + row1] = o1; }
    }
    asm volatile("s_waitcnt vmcnt(0)" ::: "memory");
    __syncthreads();
    {
      const size_t tok = tok0 + t_;
      float ov[8], s1 = 0.f, bon = 0.f;
#pragma unroll
      for (int e = 0; e < 8; ++e) {
        ov[e] = O[t_ * 64 + n0 + e]; s1 += ov[e];
        bon += R[t_ * 64 + n0 + e] * K[t_ * 64 + n0 + e] * rkc[e];
      }
      s1 = red8_sum(s1); bon = red8_sum(bon);
      const float mean = s1 * (1.f / 64.f);
      float s2 = 0.f;
#pragma unroll
      for (int e = 0; e < 8; ++e) { const float d = ov[e] - mean; s2 += d * d; }
      s2 = red8_sum(s2);
      const float rstd = rsqrtf(s2 * (1.f / 64.f) + 64e-5f);
      float y[8];
#pragma unroll
      for (int e = 0; e < 8; ++e)
        y[e] = ((ov[e] - mean) * rstd * gnw[e] + gnb[e] + bon * V[t_ * 64 + n0 + e]) * G[t_ * 64 + n0 + e];
      *(uint4*)(p.u + tok * US + 3072 + h * 64 + n0) = PACK8(y);
    }
  }
#undef RW_PREFETCH
  __syncthreads();
}

PHASE void phase_mix(const Params& p, int l, char* smem) {
  int* sitem = (int*)(smem + SMEM_BYTES - 16);
  const int tid0 = opaque_tid();
  while (true) {
    __syncthreads();
    if (tid0 == 0) *sitem = (int)atomicAdd(p.counters + l * 4 + 0, 1u);
    __syncthreads();
    const int item = *sitem;
    if (item >= 256) break;
    rwkv_item(p, l, item, smem);
  }
  while (true) {
    __syncthreads();
    if (tid0 == 0) *sitem = (int)atomicAdd(p.counters + l * 4 + 1, 1u);
    __syncthreads();
    const int item = *sitem;
    if (item >= 128) break;
    hgrn_item(p, l, item, smem);
  }
  while (true) {
    __syncthreads();
    if (tid0 == 0) *sitem = (int)atomicAdd(p.counters + l * 4 + 2, 1u);
    __syncthreads();
    const int item = *sitem;
    if (item >= 4096) break;
    att_item(p, l, item, smem);
  }
}

PHASE void phase_merge(const Params& p, int l, char* smem) {
  const bf16_t* Wl = p.wt + (size_t)l * WLAYER;
  float* Cs = (float*)smem;
  const int tid = opaque_tid();
  for (int it = 0;; ++it) {
    int tm, tn;
    if (!tile_for(it, 512, 16, tm, tn)) break;
    const size_t row0 = (size_t)tm * 128;
    f32x4 acc[4][2], G[4][2], M[4][2];
#pragma unroll
    for (int m = 0; m < 4; ++m)
#pragma unroll
      for (int n = 0; n < 2; ++n) M[m][n] = (f32x4){0.f, 0.f, 0.f, 0.f};
#pragma unroll 1
    for (int br = 0; br < 3; ++br) {
      gemm_tile<2>(tid, p.h + row0 * DM, DM, Wl + WIN + (size_t)(5376 + br * 1024 + tn * 64) * DM, DM, DM, smem, acc);
#pragma unroll
      for (int m = 0; m < 4; ++m)
#pragma unroll
        for (int n = 0; n < 2; ++n)
#pragma unroll
          for (int j = 0; j < 4; ++j) G[m][n][j] = sigm(acc[m][n][j]);
      const int aoff = (br == 0) ? 0 : (br == 1 ? 2560 : 3072);
      const size_t woff = (br == 0) ? WBA : (br == 1 ? WBB : WBC);
      gemm_tile<2>(tid, p.u + row0 * US + aoff, US, Wl + woff + (size_t)(tn * 64) * 512, 512, 512, smem, acc);
#pragma unroll
      for (int m = 0; m < 4; ++m)
#pragma unroll
        for (int n = 0; n < 2; ++n)
#pragma unroll
          for (int j = 0; j < 4; ++j) M[m][n][j] += G[m][n][j] * acc[m][n][j];
    }
    stage_acc<2>(tid, Cs, M);
    __syncthreads();
    {
      const int ch = tid & 7;
#pragma unroll 1
      for (int i = 0; i < 4; ++i) {
        const int r = (tid >> 3) + i * 32;
        const float4 a = *(const float4*)(Cs + r * 68 + ch * 8), b = *(const float4*)(Cs + r * 68 + ch * 8 + 4);
        *(uint4*)(p.u + (row0 + r) * US + 1024 + tn * 64 + ch * 8) = make_uint4(pack2(a.x, a.y), pack2(a.z, a.w), pack2(b.x, b.y), pack2(b.z, b.w));
      }
    }
    __syncthreads();
  }
}

PHASE void phase_gemm_res(const bf16_t* A, int lda, const bf16_t* Wt, int K, const float* xin, float* xout,
                        const float* ada_l, int gate_off, char* smem) {
  float* Cs = (float*)smem;
  const int tid = opaque_tid();
  for (int it = 0;; ++it) {
    int tm, tn;
    if (!tile_for(it, 256, 8, tm, tn)) break;
    const size_t row0 = (size_t)tm * 256;
    f32x4 acc[8][4];
    gemm_tile256(tid, A + row0 * lda, lda, Wt + (size_t)(tn * 128) * K, K, K, smem, acc);
    const float* gate = ada_l + (size_t)(row0 / SEQ) * ADAW + gate_off + tn * 128;
    const int c4 = (tid & 31) * 4;
    const float4 gv = *(const float4*)(gate + c4);
#pragma unroll
    for (int ps = 0; ps < 2; ++ps) {
      if (ps == 0) stage_half<0>(tid, Cs, acc); else stage_half<1>(tid, Cs, acc);
      __syncthreads();
#pragma unroll 1
      for (int i = 0; i < 16; ++i) {
        const int r = (tid >> 5) + i * 8;
        const float4 cv = *(const float4*)(Cs + r * 132 + c4);
        const size_t off = (row0 + RMAP(r, ps)) * DM + tn * 128 + c4;
        const float4 xv = *(const float4*)(xin + off);
        *(float4*)(xout + off) = make_float4(xv.x + gv.x * cv.x, xv.y + gv.y * cv.y, xv.z + gv.z * cv.z, xv.w + gv.w * cv.w);
      }
      __syncthreads();
    }
  }
}

PHASE void phase_ffn_in(const Params& p, int l, char* smem) {
  const bf16_t* Wt = p.wt + (size_t)l * WLAYER + WFI;
  float* Cs = (float*)smem;
  const int tid = opaque_tid();
  for (int it = 0;; ++it) {
    int tm, tn;
    if (!tile_for(it, 256, 44, tm, tn)) break;
    const size_t row0 = (size_t)tm * 256;
    f32x4 acc[8][4];
    gemm_tile256(tid, p.h + row0 * DM, DM, Wt + (size_t)(tn * 128) * DM, DM, DM, smem, acc);
    const int ch = tid & 7;
#pragma unroll
    for (int ps = 0; ps < 2; ++ps) {
      if (ps == 0) stage_half<0>(tid, Cs, acc); else stage_half<1>(tid, Cs, acc);
      __syncthreads();
#pragma unroll 1
      for (int i = 0; i < 4; ++i) {
        const int r = (tid >> 3) + i * 32;
        const float* cp = Cs + r * 132 + ch * 8;
        float o[8];
#pragma unroll
        for (int e = 0; e < 8; ++e) { const float g = cp[e], uu = cp[64 + e]; o[e] = g * sigm(g) * uu; }
        *(uint4*)(p.u + (row0 + RMAP(r, ps)) * FFH + tn * 64 + ch * 8) = PACK8(o);
      }
      __syncthreads();
    }
  }
}

#define XB_TMO      128
#define XB_XCNT(j)  (256  + 64 * (j))
#define XB_XSUB(j)  (1280 + 64 * (j))
#define XB_XGEN(j)  (2304 + 64 * (j))
#define XB_TOP      3328
#define XB_TOPGEN   3392
#define XCD_BAR_WORDS 3456
#define XB_SPIN_CAP (1u << 18)
#define LAS __attribute__((address_space(3)))
DEV unsigned xb_ld(unsigned* p) { return __hip_atomic_load(p, __ATOMIC_RELAXED, __HIP_MEMORY_SCOPE_AGENT); }
DEV unsigned xb_add(unsigned* p, unsigned v) { return __hip_atomic_fetch_add(p, v, __ATOMIC_RELAXED, __HIP_MEMORY_SCOPE_AGENT); }
DEV unsigned xb_xcc_id() { return (unsigned)__builtin_amdgcn_s_getreg((3 << 11) | 20) & 0xFu; }
#define XB_SPIN(cond, bar) do { unsigned _sp = 0; while (cond) { __builtin_amdgcn_s_sleep(1); \
    if ((++_sp & 255u) == 0u) { if (xb_ld(&(bar)[XB_TMO])) break; if (_sp > XB_SPIN_CAP) { atomicAdd(&(bar)[XB_TMO], 1u); break; } } } } while (0)
struct XcdBarrier { unsigned* bar; unsigned x; volatile LAS unsigned* st; };
DEV XcdBarrier xcd_barrier_post(unsigned* bar, volatile LAS unsigned* st) {
  XcdBarrier b; b.bar = bar; b.x = xb_xcc_id(); b.st = st;
  if (threadIdx.x == 0) (void)xb_add(&bar[XB_XCNT(b.x)], 1u);
  return b;
}
DEV void xcd_barrier_complete(unsigned* bar, unsigned x, unsigned& nloc, unsigned& nx) {
  const unsigned G = gridDim.x * gridDim.y * gridDim.z;
  unsigned sum, cnt, mine, sp = 0u;
  for (;;) {
    sum = 0u; cnt = 0u; mine = 0u;
#pragma unroll
    for (unsigned j = 0; j < 16; ++j) { const unsigned c = xb_ld(&bar[XB_XCNT(j)]); sum += c; cnt += (c > 0u) ? 1u : 0u; mine = (j == x) ? c : mine; }
    if (sum == G) break;
    __builtin_amdgcn_s_sleep(1);
    if ((++sp & 255u) == 0u) { if (xb_ld(&bar[XB_TMO])) break; if (sp > XB_SPIN_CAP) { atomicAdd(&bar[XB_TMO], 1u); break; } }
  }
  nloc = mine > 0u ? mine : 1u; nx = cnt > 0u ? cnt : 1u;
}
DEV void xcd_barrier(const XcdBarrier& b) {
  asm volatile("s_waitcnt vmcnt(0)" ::: "memory");
  __syncthreads();
  if (threadIdx.x == 0) {
    unsigned* bar = b.bar;
    __builtin_amdgcn_s_waitcnt(0);
    unsigned nloc = b.st[0], nx = b.st[1];
    if (nloc == 0u) { xcd_barrier_complete(bar, b.x, nloc, nx); b.st[0] = nloc; b.st[1] = nx; }
    const unsigned old = xb_add(&bar[XB_XSUB(b.x)], 1u);
    const unsigned gen = old / nloc;
    if (old + 1u == (gen + 1u) * nloc) {
      __builtin_amdgcn_fence(__ATOMIC_RELEASE, "agent");
      asm volatile("s_waitcnt vmcnt(0)" ::: "memory");
      const unsigned og = xb_add(&bar[XB_TOP], 1u);
      const unsigned tg = og / nx;
      if (og + 1u == (tg + 1u) * nx) xb_add(&bar[XB_TOPGEN], 1u);
      else XB_SPIN(xb_ld(&bar[XB_TOPGEN]) == tg, bar);
      __builtin_amdgcn_fence(__ATOMIC_ACQUIRE, "agent");
      xb_add(&bar[XB_XGEN(b.x)], 1u);
      asm volatile("s_waitcnt vmcnt(0)" ::: "memory");
    } else {
      XB_SPIN(xb_ld(&bar[XB_XGEN(b.x)]) == gen, bar);
      __builtin_amdgcn_fence(__ATOMIC_ACQUIRE, "agent");
      asm volatile("s_waitcnt vmcnt(0)" ::: "memory");
    }
  }
  __syncthreads();
}

__global__ void __launch_bounds__(256, 2) mega(Params p_in, int ph_lo, int ph_hi) {
  extern __shared__ __attribute__((aligned(16))) char smem[];
  cg::grid_group grid = cg::this_grid();
  const Params& p = p_in;
  bool first = true;
#define RUN(ph) if ((ph) >= ph_lo && (ph) < ph_hi)
  unsigned epoch = 0;
  __shared__ unsigned xb_words[4];
  if (threadIdx.x < 4) xb_words[threadIdx.x] = 0u;
  __syncthreads();
  XcdBarrier xb;
  xb.bar = p.counters + 256; xb.x = 0u; xb.st = (volatile LAS unsigned*)xb_words;
#define SYNC { if (!first) { ++epoch; if (epoch == 1) { grid.sync(); xb = xcd_barrier_post(p.counters + 256, (volatile LAS unsigned*)xb_words); } else xcd_barrier(xb); } first = false; }
  RUN(0) { SYNC; phase_prep(p, smem); }
#pragma unroll 1
  for (int l = 0; l < 2; ++l) {
    const int base = 1 + 9 * l;
    const float* ada_l = p.ada + (size_t)l * 32 * ADAW;
    const bf16_t* Wl = p.wt + (size_t)l * WLAYER;
    const float* xin = (l == 0) ? p.x : p.out;
    RUN(base + 0) { SYNC; phase_norm(xin, p.norm_mix_w + l * DM, ada_l, 0, 1024, p.h); }
    RUN(base + 1) { SYNC; phase_gemm_in(p, l, smem); }
    RUN(base + 2) { if (l > 0) { SYNC; phase_vlo(p, l, smem); } }
    RUN(base + 3) { SYNC; phase_mix(p, l, smem); }
    RUN(base + 4) { SYNC; phase_merge(p, l, smem); }
    RUN(base + 5) { SYNC; phase_gemm_res(p.u + 1024, US, Wl + WOUT, DM, xin, p.out, ada_l, 2048, smem); }
    RUN(base + 6) { SYNC; phase_norm(p.out, p.norm_ffn_w + l * DM, ada_l, 3072, 4096, p.h); }
    RUN(base + 7) { SYNC; phase_ffn_in(p, l, smem); }
    RUN(base + 8) { SYNC; phase_gemm_res(p.u, FFH, Wl + WFO, FFH, p.out, p.out, ada_l, 5120, smem); }
  }
  RUN(NPHASE - 1) { SYNC; phase_final(p.out, p.final_norm_w); }
}

extern "C" void kernel_launch(void* const* d_in, const int* in_sizes, int n_in, void* d_out, int out_size, void* d_ws,
                              size_t ws_size, hipStream_t stream) {
  Params p{};
  p.x = (const float*)d_in[0]; p.c = (const float*)d_in[1]; p.pos = (const int*)d_in[2];
  p.ada_w = (const float*)d_in[3]; p.ada_b = (const float*)d_in[4]; p.norm_mix_w = (const float*)d_in[5];
  p.norm_ffn_w = (const float*)d_in[6]; p.w_in = (const float*)d_in[7]; p.da_lambda = (const float*)d_in[8];
  p.da_subln_w = (const float*)d_in[9]; p.hg_lb = (const float*)d_in[10]; p.hg_norm_w = (const float*)d_in[11];
  p.rw_mu = (const float*)d_in[12]; p.rw_w0 = (const float*)d_in[13]; p.rw_w2 = (const float*)d_in[14];
  p.rw_a0 = (const float*)d_in[15]; p.rw_a2 = (const float*)d_in[16]; p.rw_g2 = (const float*)d_in[17];
  p.rw_k_k = (const float*)d_in[18]; p.rw_k_a = (const float*)d_in[19]; p.rw_r_k = (const float*)d_in[20];
  p.rw_gn_w = (const float*)d_in[21]; p.rw_gn_b = (const float*)d_in[22]; p.rw_v0 = (const float*)d_in[23];
  p.rw_v1 = (const float*)d_in[24]; p.rw_v2 = (const float*)d_in[25]; p.w_br_a = (const float*)d_in[26];
  p.w_br_b = (const float*)d_in[27]; p.w_br_c = (const float*)d_in[28]; p.w_out = (const float*)d_in[29];
  p.ffn_w_in = (const float*)d_in[30]; p.ffn_w_out = (const float*)d_in[31]; p.final_norm_w = (const float*)d_in[32];
  p.out = (float*)d_out;
  char* ws = (char*)d_ws;
  size_t off = 0;
  auto take = [&](size_t bytes) { char* r = ws + off; off += (bytes + 255) & ~(size_t)255; return r; };
  p.counters = (unsigned*)take(16384);
  p.wt = (bf16_t*)take(2 * WLAYER * 2);
  p.ada = (float*)take((size_t)2 * 32 * ADAW * 4);
  p.h = (bf16_t*)take((size_t)T_TOK * DM * 2);
  p.u = (bf16_t*)take((size_t)T_TOK * US * 2);
  p.vT = (bf16_t*)take((size_t)T_TOK * 512 * 2);
  p.vfirst = (bf16_t*)take((size_t)T_TOK * 512 * 2);
  p.vlo = (float*)take((size_t)T_TOK * 32 * 4);
  if (off > ws_size) { fprintf(stderr, "workspace too small: need %zu have %zu\n", off, ws_size); return; }

  static int grid_blocks = 0;
  if (!grid_blocks) {
    hipFuncSetAttribute((const void*)mega, hipFuncAttributeMaxDynamicSharedMemorySize, SMEM_BYTES);
    int dev = 0, cus = 0, per_cu = 0;
    hipGetDevice(&dev);
    hipDeviceGetAttribute(&cus, hipDeviceAttributeMultiprocessorCount, dev);
    hipOccupancyMaxActiveBlocksPerMultiprocessor(&per_cu, mega, 256, SMEM_BYTES);
    if (per_cu > 2) per_cu = 2;
    if (per_cu < 1) per_cu = 1;
    grid_blocks = cus * per_cu;
  }
#if SINGLE_LAUNCH
  int lo = 0, hi = NPHASE;
  void* args[] = {&p, &lo, &hi};
  hipError_t e = hipLaunchCooperativeKernel((void*)mega, dim3(grid_blocks), dim3(256), args, SMEM_BYTES, stream);
  if (e != hipSuccess) fprintf(stderr, "cooperative launch failed: %s (grid %d)\n", hipGetErrorString(e), grid_blocks);
#else
  for (int ph = 0; ph < NPHASE; ++ph) {
    if (ph == 3) continue;
    hipLaunchKernelGGL(mega, dim3(grid_blocks), dim3(256), SMEM_BYTES, stream, p, ph, ph + 1);
  }
#endif
}
```

```cpp
#include <hip/hip_runtime.h>
#include <hip/hip_cooperative_groups.h>
#include <stdint.h>
#include <cstdio>
namespace cg = cooperative_groups;

typedef unsigned short bf16_t;
typedef short bf16x8 __attribute__((ext_vector_type(8)));
typedef float f32x4 __attribute__((ext_vector_type(4)));
typedef float f32x2 __attribute__((ext_vector_type(2)));
#define DEV __device__ __forceinline__
#define PHASE __device__ __forceinline__

#ifndef SINGLE_LAUNCH
#define SINGLE_LAUNCH 1
#endif

constexpr int T_TOK = 65536, DM = 1024, SEQ = 2048, US = 4864, ADAW = 6144, FFH = 2816;
constexpr size_t WIN = 0, WBA = 8650752, WBB = 9175040, WBC = 9699328, WOUT = 10223616, WFI = 11272192,
                 WFO = 17039360, WLAYER = 19922944;
constexpr int SMEM_BYTES = 80896;
constexpr int NPHASE = 20;

struct Params {
  const float* x; const float* c; const int* pos;
  const float *ada_w, *ada_b, *norm_mix_w, *norm_ffn_w, *w_in, *da_lambda, *da_subln_w, *hg_lb, *hg_norm_w;
  const float *rw_mu, *rw_w0, *rw_w2, *rw_a0, *rw_a2, *rw_g2, *rw_k_k, *rw_k_a, *rw_r_k, *rw_gn_w, *rw_gn_b;
  const float *rw_v0, *rw_v1, *rw_v2, *w_br_a, *w_br_b, *w_br_c, *w_out, *ffn_w_in, *ffn_w_out, *final_norm_w;
  float* out;
  bf16_t* wt; float* ada; bf16_t* h; bf16_t* u; bf16_t* vT; bf16_t* vfirst; float* vlo; unsigned* counters;
};

DEV unsigned short f2bf(float f) { unsigned u = __float_as_uint(f); u += 0x7FFFu + ((u >> 16) & 1u); return (unsigned short)(u >> 16); }
DEV float bf2f(unsigned short h) { return __uint_as_float(((unsigned)h) << 16); }
DEV unsigned pack2(float a, float b) { return (unsigned)f2bf(a) | ((unsigned)f2bf(b) << 16); }
DEV float sigm(float x) { return 1.f / (1.f + __expf(-x)); }
DEV float lo16(unsigned v) { return __uint_as_float(v << 16); }
DEV float hi16(unsigned v) { return __uint_as_float(v & 0xFFFF0000u); }
#define UNPACK8(v, f) { f[0]=lo16(v.x); f[1]=hi16(v.x); f[2]=lo16(v.y); f[3]=hi16(v.y); f[4]=lo16(v.z); f[5]=hi16(v.z); f[6]=lo16(v.w); f[7]=hi16(v.w); }
#define PACK8(f) make_uint4(pack2(f[0],f[1]), pack2(f[2],f[3]), pack2(f[4],f[5]), pack2(f[6],f[7]))
template <int CTRL> DEV float dpp(float x) { return __int_as_float(__builtin_amdgcn_update_dpp(0, __float_as_int(x), CTRL, 0xF, 0xF, true)); }
DEV float red8_sum(float x) { x += dpp<0xB1>(x); x += dpp<0x4E>(x); x += dpp<0x141>(x); return x; }
DEV float red16_sum(float x) { x = red8_sum(x); x += dpp<0x140>(x); return x; }
DEV float red16_max(float x) { x = fmaxf(x, dpp<0xB1>(x)); x = fmaxf(x, dpp<0x4E>(x)); x = fmaxf(x, dpp<0x141>(x)); x = fmaxf(x, dpp<0x140>(x)); return x; }
DEV float wave_sum(float x) {
#pragma unroll
  for (int o = 32; o >= 1; o >>= 1) x += __shfl_xor(x, o, 64);
  return x;
}
DEV int opaque_tid() { int t = threadIdx.x; asm volatile("" : "+v"(t)); return t; }
DEV bf16x8 as_frag(uint4 v) { union { uint4 u; bf16x8 b; } c; c.u = v; return c.b; }
#define MFMA(a, b, c) __builtin_amdgcn_mfma_f32_16x16x32_bf16(a, b, c, 0, 0, 0)

template <int NT>
DEV void gemm_tile(const int tid, const bf16_t* A, int lda, const bf16_t* B, int ldb, int K, char* smem,
                   f32x4 (&acc)[4][NT]) {
  constexpr int BN = NT * 32;
  constexpr int LS = 64;
  bf16_t* As = (bf16_t*)smem;
  bf16_t* Bs = As + 2 * 128 * LS;
  const int lane = tid & 63, wave = tid >> 6, wr = wave >> 1, wc = wave & 1;
  const int fr = lane & 15, fq = lane >> 4;
  constexpr int NB = BN * 8 / 256;
#pragma unroll
  for (int m = 0; m < 4; ++m)
#pragma unroll
    for (int n = 0; n < NT; ++n) acc[m][n] = (f32x4){0.f, 0.f, 0.f, 0.f};
  const int nk = K >> 6;
  const int lrow = tid >> 3, lcc = tid & 7;
  const bf16_t* Ap = A + (size_t)lrow * lda + ((lcc ^ (lrow & 7)) * 8);
  const bf16_t* Bp = B + (size_t)lrow * ldb + ((lcc ^ (lrow & 7)) * 8);
  const size_t a32 = (size_t)32 * lda, b32 = (size_t)32 * ldb;
  const int rofs0 = (fq ^ (fr & 7)) * 8, rofs1 = rofs0 ^ 32;
#define GT_DMA(buf, koff)                                                                                    \
  {                                                                                                          \
    bf16_t* Ad = As + (buf) * 128 * LS + tid * 8;                                                            \
    bf16_t* Bd = Bs + (buf) * BN * LS + tid * 8;                                                             \
    _Pragma("unroll") for (int i = 0; i < 4; ++i)                                                            \
      __builtin_amdgcn_global_load_lds((const unsigned*)(Ap + i * a32 + (koff)), (unsigned*)(Ad + i * 32 * LS), 16, 0, 0); \
    _Pragma("unroll") for (int i = 0; i < NB; ++i)                                                           \
      __builtin_amdgcn_global_load_lds((const unsigned*)(Bp + i * b32 + (koff)), (unsigned*)(Bd + i * 32 * LS), 16, 0, 0); \
  }
  GT_DMA(0, 0)
  asm volatile("s_waitcnt vmcnt(0)" ::: "memory");
  __syncthreads();
  for (int kt = 0; kt < nk; ++kt) {
    const int buf = kt & 1;
    if (kt + 1 < nk) GT_DMA(buf ^ 1, (kt + 1) * 64)
    const bf16_t* Ab = As + buf * 128 * LS + (wr * 64 + fr) * LS;
    const bf16_t* Bb = Bs + buf * BN * LS + (wc * (NT * 16) + fr) * LS;
#pragma unroll
    for (int ks = 0; ks < 2; ++ks) {
      const int ro = ks ? rofs1 : rofs0;
      bf16x8 af[4], bfr[NT];
#pragma unroll
      for (int m = 0; m < 4; ++m) af[m] = *(const bf16x8*)(Ab + m * 16 * LS + ro);
#pragma unroll
      for (int n = 0; n < NT; ++n) bfr[n] = *(const bf16x8*)(Bb + n * 16 * LS + ro);
#pragma unroll
      for (int m = 0; m < 4; ++m)
#pragma unroll
        for (int n = 0; n < NT; ++n) acc[m][n] = MFMA(af[m], bfr[n], acc[m][n]);
    }
    asm volatile("s_waitcnt vmcnt(0)" ::: "memory");
    __syncthreads();
  }
#undef GT_DMA
}

template <int NT>
DEV void stage_acc(const int tid, float* Cs, const f32x4 (&acc)[4][NT]) {
  constexpr int LDC = NT * 32 + 4;
  const int lane = tid & 63, wave = tid >> 6, wr = wave >> 1, wc = wave & 1, fr = lane & 15, fq = lane >> 4;
#pragma unroll
  for (int m = 0; m < 4; ++m)
#pragma unroll
    for (int n = 0; n < NT; ++n)
#pragma unroll
      for (int j = 0; j < 4; ++j) Cs[(wr * 64 + m * 16 + fq * 4 + j) * LDC + wc * (NT * 16) + n * 16 + fr] = acc[m][n][j];
}

DEV void gemm_tile256(const int tid, const bf16_t* A, int lda, const bf16_t* B, int ldb, int K, char* smem,
                      f32x4 (&acc)[8][4]) {
  bf16_t* As = (bf16_t*)smem;
  bf16_t* Bs = As + 3 * 8192;
  const int lane = tid & 63, wave = tid >> 6, wr = wave >> 1, wc = wave & 1;
  const int fr = lane & 15, fq = lane >> 4;
#pragma unroll
  for (int m = 0; m < 8; ++m)
#pragma unroll
    for (int n = 0; n < 4; ++n) acc[m][n] = (f32x4){0.f, 0.f, 0.f, 0.f};
  const int nk = K >> 5;
  const int drow = tid >> 2, dphys = tid & 3, dg = (0 - (tid >> 4)) & 3;
  const bf16_t* Ap = A + (size_t)drow * lda + ((dphys ^ dg) * 8);
  const bf16_t* Bp = B + (size_t)drow * ldb + ((dphys ^ dg) * 8);
  const size_t a64 = (size_t)64 * lda, b64 = (size_t)64 * ldb;
  const int rofs = (fq ^ ((0 - (fr >> 2)) & 3)) * 8;
#define G2_DMA(st, kk)                                                                                        \
  {                                                                                                           \
    bf16_t* Ad = As + (st) * 8192 + tid * 8;                                                                  \
    bf16_t* Bd = Bs + (st) * 4096 + tid * 8;                                                                  \
    _Pragma("unroll") for (int i = 0; i < 4; ++i)                                                             \
      __builtin_amdgcn_global_load_lds((const unsigned*)(Ap + i * a64 + (kk) * 32), (unsigned*)(Ad + i * 2048), 16, 0, 0); \
    _Pragma("unroll") for (int i = 0; i < 2; ++i)                                                             \
      __builtin_amdgcn_global_load_lds((const unsigned*)(Bp + i * b64 + (kk) * 32), (unsigned*)(Bd + i * 2048), 16, 0, 0); \
  }
  G2_DMA(0, 0)
  G2_DMA(1, 1)
  int st = 0;
  for (int kt = 0; kt < nk; ++kt) {
    if (kt + 1 < nk) asm volatile("s_waitcnt vmcnt(6)" ::: "memory");
    else asm volatile("s_waitcnt vmcnt(0)" ::: "memory");
    __builtin_amdgcn_s_barrier();
    asm volatile("" ::: "memory");
    const int s2 = (st >= 1) ? st - 1 : 2;
    const bool pf = (kt + 2 < nk);
    bf16_t* Ad = As + s2 * 8192 + tid * 8;
    bf16_t* Bd = Bs + s2 * 4096 + tid * 8;
    const bf16_t* Asrc = Ap + (kt + 2) * 32;
    const bf16_t* Bsrc = Bp + (kt + 2) * 32;
    const bf16_t* Ab = As + st * 8192 + (wr * 128 + fr) * 32 + rofs;
    const bf16_t* Bb = Bs + st * 4096 + (wc * 64 + fr) * 32 + rofs;
    bf16x8 bfr[4], af[4];
#pragma unroll
    for (int n = 0; n < 4; ++n) bfr[n] = *(const bf16x8*)(Bb + n * 512);
#pragma unroll
    for (int m = 0; m < 4; ++m) af[m] = *(const bf16x8*)(Ab + m * 512);
#pragma unroll
    for (int m = 0; m < 8; ++m) {
#pragma unroll
      for (int n = 0; n < 4; ++n) acc[m][n] = MFMA(af[m & 3], bfr[n], acc[m][n]);
      if (m + 4 < 8) af[m & 3] = *(const bf16x8*)(Ab + (m + 4) * 512);
      if (pf) {
        if (m < 4) __builtin_amdgcn_global_load_lds((const unsigned*)(Asrc + m * a64), (unsigned*)(Ad + m * 2048), 16, 0, 0);
        else if (m < 6) __builtin_amdgcn_global_load_lds((const unsigned*)(Bsrc + (m - 4) * b64), (unsigned*)(Bd + (m - 4) * 2048), 16, 0, 0);
      }
      __builtin_amdgcn_sched_barrier(0);
    }
    st = (st == 2) ? 0 : st + 1;
  }
#undef G2_DMA
  __syncthreads();
}

template <int PS>
DEV void stage_half(const int tid, float* Cs, const f32x4 (&acc)[8][4]) {
  const int lane = tid & 63, wave = tid >> 6, wr = wave >> 1, wc = wave & 1, fr = lane & 15, fq = lane >> 4;
#pragma unroll
  for (int m = 0; m < 4; ++m)
#pragma unroll
    for (int n = 0; n < 4; ++n)
#pragma unroll
      for (int j = 0; j < 4; ++j) Cs[(wr * 64 + m * 16 + fq * 4 + j) * 132 + wc * 64 + n * 16 + fr] = acc[PS * 4 + m][n][j];
}
#define RMAP(r, ps) ((((r) >> 6) << 7) + (ps) * 64 + ((r) & 63))

DEV bool tile_for(int it, int nM, int nN, int& tm, int& tn) {
  const int nx = gridDim.x >> 3;
  const int xcd = blockIdx.x & 7, local = blockIdx.x >> 3;
  const long id = ((long)it * 8 + xcd) * nx + local;
  if (local >= nx || id >= (long)nM * nN) return false;
  const int per_group = 8 * nN;
  const int g = (int)(id / per_group), r = (int)(id % per_group);
  tn = r >> 3; tm = g * 8 + (r & 7);
  return true;
}

PHASE void phase_prep(const Params& p, char* smem) {
  const int tid = opaque_tid();
  if (blockIdx.x == 0 && tid < 8) p.counters[tid] = 0u;
  if (blockIdx.x == 0) for (int i = tid; i < 3456; i += 256) p.counters[256 + i] = 0u;
  float* tile = (float*)smem;
  const int NCONV = 2 * 4864, NADA = 192;
  for (int item0 = blockIdx.x; item0 < NCONV + NADA; item0 += gridDim.x) {
    const int item = (item0 < NADA) ? (NCONV + item0) : (item0 - NADA);
    if (item < NCONV) {
      const int l = item / 4864; int r = item % 4864;
      const float* src; int K, Nsrc, nT, perm = 0; size_t dst;
      if (r < 2112) { src = p.w_in + (size_t)l * 1024 * 8448; K = 1024; Nsrc = 8448; dst = WIN; nT = 132; }
      else if (r < 2240) { r -= 2112; src = p.w_br_a + (size_t)l * 512 * 1024; K = 512; Nsrc = 1024; dst = WBA; nT = 16; }
      else if (r < 2368) { r -= 2240; src = p.w_br_b + (size_t)l * 512 * 1024; K = 512; Nsrc = 1024; dst = WBB; nT = 16; }
      else if (r < 2496) { r -= 2368; src = p.w_br_c + (size_t)l * 512 * 1024; K = 512; Nsrc = 1024; dst = WBC; nT = 16; }
      else if (r < 2752) { r -= 2496; src = p.w_out + (size_t)l * 1024 * 1024; K = 1024; Nsrc = 1024; dst = WOUT; nT = 16; }
      else if (r < 4160) { r -= 2752; src = p.ffn_w_in + (size_t)l * 1024 * 5632; K = 1024; Nsrc = 5632; dst = WFI; nT = 88; perm = 1; }
      else { r -= 4160; src = p.ffn_w_out + (size_t)l * 2816 * 1024; K = 2816; Nsrc = 1024; dst = WFO; nT = 16; }
      const int kt = r / nT, nt = r % nT;
      const int colbase = perm ? ((nt & 1) * FFH + 64 * (nt >> 1)) : nt * 64;
      __syncthreads();
#pragma unroll
      for (int i = 0; i < 16; ++i) {
        const int k = i * 4 + (tid >> 6), j = tid & 63;
        tile[k * 65 + j] = src[(size_t)(kt * 64 + k) * Nsrc + colbase + j];
      }
      __syncthreads();
      const int row = tid >> 2, kc = (tid & 3) * 16;
      float f[16];
#pragma unroll
      for (int i = 0; i < 16; ++i) f[i] = tile[(kc + i) * 65 + row];
      bf16_t* d = p.wt + (size_t)l * WLAYER + dst + (size_t)(nt * 64 + row) * K + kt * 64 + kc;
      *(uint4*)d = make_uint4(pack2(f[0], f[1]), pack2(f[2], f[3]), pack2(f[4], f[5]), pack2(f[6], f[7]));
      *(uint4*)(d + 8) = make_uint4(pack2(f[8], f[9]), pack2(f[10], f[11]), pack2(f[12], f[13]), pack2(f[14], f[15]));
    } else {
      const int a = item - NCONV;
      const int l = a / 96, r = a % 96, ntile = r >> 2, bg = r & 3;
      float* cact = (float*)smem;
      __syncthreads();
      for (int i = tid; i < 8 * 1024; i += 256) {
        const float cv = p.c[(size_t)(bg * 8 + (i >> 10)) * DM + (i & 1023)];
        cact[i] = cv * sigm(cv);
      }
      __syncthreads();
      const int n = ntile * 256 + tid;
      const float* W = p.ada_w + (size_t)l * DM * ADAW + n;
      float acc[8];
#pragma unroll
      for (int b = 0; b < 8; ++b) acc[b] = 0.f;
      for (int k0 = 0; k0 < DM; k0 += 16) {
        float w[16];
#pragma unroll
        for (int kk = 0; kk < 16; ++kk) w[kk] = W[(size_t)(k0 + kk) * ADAW];
#pragma unroll
        for (int kk = 0; kk < 16; ++kk)
#pragma unroll
          for (int b = 0; b < 8; ++b) acc[b] += cact[b * 1024 + k0 + kk] * w[kk];
      }
      const float bias = p.ada_b[l * ADAW + n];
#pragma unroll
      for (int b = 0; b < 8; ++b) p.ada[((size_t)l * 32 + bg * 8 + b) * ADAW + n] = acc[b] + bias;
    }
  }
}

PHASE void phase_norm(const float* __restrict__ x, const float* __restrict__ w, const float* __restrict__ ada_l,
                    int shift_off, int scale_off, bf16_t* __restrict__ h) {
  const int tid = opaque_tid();
  const int lane = tid & 63, wave = tid >> 6;
  for (int row = blockIdx.x * 4 + wave; row < T_TOK; row += gridDim.x * 4) {
    const float* xr = x + (size_t)row * DM;
    float4 v[4]; float ss = 0.f;
#pragma unroll
    for (int i = 0; i < 4; ++i) { v[i] = *(const float4*)(xr + i * 256 + lane * 4); ss += v[i].x * v[i].x + v[i].y * v[i].y + v[i].z * v[i].z + v[i].w * v[i].w; }
    ss = wave_sum(ss);
    const float rstd = rsqrtf(ss * (1.f / DM) + 1e-6f);
    const float* ad = ada_l + (size_t)(row / SEQ) * ADAW;
#pragma unroll
    for (int i = 0; i < 4; ++i) {
      const int col = i * 256 + lane * 4;
      const float4 ww = *(const float4*)(w + col), sc = *(const float4*)(ad + scale_off + col), sh = *(const float4*)(ad + shift_off + col);
      const float o0 = v[i].x * rstd * ww.x * (1.f + sc.x) + sh.x, o1 = v[i].y * rstd * ww.y * (1.f + sc.y) + sh.y;
      const float o2 = v[i].z * rstd * ww.z * (1.f + sc.z) + sh.z, o3 = v[i].w * rstd * ww.w * (1.f + sc.w) + sh.w;
      *(uint2*)(h + (size_t)row * DM + col) = make_uint2(pack2(o0, o1), pack2(o2, o3));
    }
  }
}

PHASE void phase_final(float* __restrict__ x, const float* __restrict__ w) {
  const int tid = opaque_tid();
  const int lane = tid & 63, wave = tid >> 6;
  for (int row = blockIdx.x * 4 + wave; row < T_TOK; row += gridDim.x * 4) {
    float* xr = x + (size_t)row * DM;
    float4 v[4]; float ss = 0.f;
#pragma unroll
    for (int i = 0; i < 4; ++i) { v[i] = *(const float4*)(xr + i * 256 + lane * 4); ss += v[i].x * v[i].x + v[i].y * v[i].y + v[i].z * v[i].z + v[i].w * v[i].w; }
    ss = wave_sum(ss);
    const float rstd = rsqrtf(ss * (1.f / DM) + 1e-6f);
#pragma unroll
    for (int i = 0; i < 4; ++i) {
      const int col = i * 256 + lane * 4;
      const float4 ww = *(const float4*)(w + col);
      *(float4*)(xr + col) = make_float4(v[i].x * rstd * ww.x, v[i].y * rstd * ww.y, v[i].z * rstd * ww.z, v[i].w * rstd * ww.w);
    }
  }
}

PHASE void phase_gemm_in(const Params& p, int l, char* smem) {
  const bf16_t* Wt = p.wt + (size_t)l * WLAYER + WIN;
  float* Cs = (float*)smem;
  const int tid = opaque_tid();
  for (int it = 0;; ++it) {
    int tm, tn;
    if (!tile_for(it, 256, 42, tm, tn)) break;
    f32x4 acc[8][4];
    gemm_tile256(tid, p.h + (size_t)tm * 256 * DM, DM, Wt + (size_t)tn * 128 * DM, DM, DM, smem, acc);
    const size_t row0 = (size_t)tm * 256;
#pragma unroll
    for (int ps = 0; ps < 2; ++ps) {
      if (ps == 0) stage_half<0>(tid, Cs, acc); else stage_half<1>(tid, Cs, acc);
      __syncthreads();
      if (tn < 8) {
        const float qs = (tn < 4) ? 0.125f : 1.f;
        const int ch = tid & 15, g = ch >> 3, cc = ch & 7;
        if (cc < 4) {
#pragma unroll 1
          for (int i = 0; i < 8; ++i) {
            const int r = (tid >> 4) + i * 16;
            const size_t grow = row0 + RMAP(r, ps);
            const float pos = (float)p.pos[grow];
            const float* c1 = Cs + r * 132 + g * 64 + cc * 8;
            float o1[8], o2[8];
#pragma unroll
            for (int e = 0; e < 8; ++e) {
              const float x1 = c1[e], x2 = c1[32 + e];
              const float inv = exp2f(-(float)(cc * 8 + e) * 0.41524101186092029f);
              float rev = pos * inv * 0.15915494309189535f;
              rev -= rintf(rev);
              const float sn = __builtin_amdgcn_sinf(rev), cs = __builtin_amdgcn_cosf(rev);
              o1[e] = (x1 * cs - x2 * sn) * qs; o2[e] = (x2 * cs + x1 * sn) * qs;
            }
            bf16_t* d = p.u + grow * US + tn * 128 + g * 64 + cc * 8;
            *(uint4*)d = PACK8(o1);
            *(uint4*)(d + 32) = PACK8(o2);
          }
        }
      } else if (tn < 12) {
        const int b = (int)(row0 / SEQ), s0 = (int)(row0 % SEQ), vc0 = (tn - 8) * 128;
        const int rch = tid & 15;
#pragma unroll 1
        for (int i = 0; i < 8; ++i) {
          const int c = (tid >> 4) + i * 16;
          float f[8];
#pragma unroll
          for (int j = 0; j < 8; ++j) f[j] = Cs[(rch * 8 + j) * 132 + c];
          *(uint4*)(p.vT + ((size_t)b * 512 + vc0 + c) * SEQ + s0 + RMAP(rch * 8, ps)) = PACK8(f);
        }
      } else {
        const int ch = tid & 15;
#pragma unroll 1
        for (int i = 0; i < 8; ++i) {
          const int r = (tid >> 4) + i * 16;
          const float4 a = *(const float4*)(Cs + r * 132 + ch * 8), b = *(const float4*)(Cs + r * 132 + ch * 8 + 4);
          *(uint4*)(p.u + (row0 + RMAP(r, ps)) * US + tn * 128 - 512 + ch * 8) = make_uint4(pack2(a.x, a.y), pack2(a.z, a.w), pack2(b.x, b.y), pack2(b.z, b.w));
        }
      }
      __syncthreads();
    }
  }
}

PHASE void phase_vlo(const Params& p, int l, char* smem) {
  float* vs = (float*)smem;
  const int tid = opaque_tid();
  const float* mu = p.rw_mu + (size_t)l * 1792 + 1024;
  const float* v1 = p.rw_v1;
  for (int item = blockIdx.x; item < T_TOK / 32; item += gridDim.x) {
    const size_t tok0 = (size_t)item * 32;
    __syncthreads();
#pragma unroll 1
    for (int i = 0; i < 8; ++i) {
      const int c = tid + i * 256;
      const int t = c >> 6, cc = c & 63;
      const size_t tok = tok0 + t;
      const uint4 cur = *(const uint4*)(p.u + tok * US + 3072 + 1024 + cc * 8);
      uint4 prv = make_uint4(0, 0, 0, 0);
      if ((tok % SEQ) != 0) prv = *(const uint4*)(p.u + (tok - 1) * US + 3072 + 1024 + cc * 8);
      float a[8], b[8];
      UNPACK8(cur, a); UNPACK8(prv, b);
#pragma unroll
      for (int e = 0; e < 8; ++e) vs[t * 512 + cc * 8 + e] = a[e] + (b[e] - a[e]) * mu[cc * 8 + e];
    }
    __syncthreads();
    const int j = tid & 31, tg = tid >> 5;
    float acc[4] = {0.f, 0.f, 0.f, 0.f};
    for (int k0 = 0; k0 < 512; k0 += 16) {
      float w[16];
#pragma unroll
      for (int kk = 0; kk < 16; ++kk) w[kk] = v1[(k0 + kk) * 32 + j];
#pragma unroll
      for (int kk = 0; kk < 16; ++kk)
#pragma unroll
        for (int i = 0; i < 4; ++i) acc[i] += vs[(tg * 4 + i) * 512 + k0 + kk] * w[kk];
    }
#pragma unroll
    for (int i = 0; i < 4; ++i) p.vlo[(tok0 + tg * 4 + i) * 32 + j] = acc[i];
  }
}

PHASE void att_item(const Params& p, int l, int item, char* smem) {
  const int qc = 31 - (item >> 7);
  const int bh = item & 127, b = bh >> 2, h = bh & 3;
  const int tid = opaque_tid(), lane = tid & 63, wave = tid >> 6, fr = lane & 15, fq = lane >> 4;
  const int m = wave >> 1, rh = wave & 1;
  bf16_t* Ks = (bf16_t*)smem;
  bf16_t* Vt = Ks + 2 * 64 * 72;
  bf16_t* Ps = Vt + 128 * 72;
  float* Ox = (float*)smem;
  const size_t tok0 = (size_t)b * SEQ + (size_t)qc * 64;
  const float* lv = p.da_lambda + (size_t)l * 256;
  float d1 = 0.f, d2 = 0.f;
  for (int i = 0; i < 64; ++i) { d1 += lv[i] * lv[64 + i]; d2 += lv[128 + i] * lv[192 + i]; }
  const float lam_init = 0.8f - 0.6f * __expf(-0.3f * (float)l);
  const float lam = __expf(d1) - __expf(d2) + lam_init;

  bf16x8 qf[2][2];
#pragma unroll
  for (int mt = 0; mt < 2; ++mt)
#pragma unroll
    for (int ks = 0; ks < 2; ++ks)
      qf[mt][ks] = *(const bf16x8*)(p.u + (tok0 + rh * 32 + mt * 16 + fr) * US + h * 128 + m * 64 + ks * 32 + fq * 8);
  f32x4 o[2][8];
  float mx[2][4], ls[2][4];
#pragma unroll
  for (int mt = 0; mt < 2; ++mt) {
#pragma unroll
    for (int n = 0; n < 8; ++n) o[mt][n] = (f32x4){0.f, 0.f, 0.f, 0.f};
#pragma unroll
    for (int j = 0; j < 4; ++j) { mx[mt][j] = -1e30f; ls[mt][j] = 0.f; }
  }
  bf16_t* Pw = Ps + wave * 32 * 72;
  for (int kt = 0; kt <= qc; ++kt) {
    __syncthreads();
#pragma unroll
    for (int i = 0; i < 4; ++i) {
      const int c = tid + i * 256;
      const int mm = c >> 9, key = (c >> 3) & 63, cc = c & 7;
      *(uint4*)(Ks + (mm * 64 + key) * 72 + cc * 8) =
          *(const uint4*)(p.u + ((size_t)b * SEQ + kt * 64 + key) * US + 512 + h * 128 + mm * 64 + cc * 8);
    }
#pragma unroll
    for (int i = 0; i < 4; ++i) {
      const int c = tid + i * 256;
      const int dim = c >> 3, cc = c & 7;
      *(uint4*)(Vt + dim * 72 + cc * 8) = *(const uint4*)(p.vT + ((size_t)b * 512 + h * 128 + dim) * SEQ + kt * 64 + cc * 8);
    }
    __syncthreads();
    f32x4 s[2][4];
#pragma unroll
    for (int mt = 0; mt < 2; ++mt)
#pragma unroll
      for (int n = 0; n < 4; ++n) s[mt][n] = (f32x4){0.f, 0.f, 0.f, 0.f};
#pragma unroll
    for (int ks = 0; ks < 2; ++ks)
#pragma unroll
      for (int n = 0; n < 4; ++n) {
        const bf16x8 kf = *(const bf16x8*)(Ks + (m * 64 + n * 16 + fr) * 72 + ks * 32 + fq * 8);
#pragma unroll
        for (int mt = 0; mt < 2; ++mt) s[mt][n] = MFMA(qf[mt][ks], kf, s[mt][n]);
      }
#pragma unroll
    for (int mt = 0; mt < 2; ++mt)
#pragma unroll
      for (int j = 0; j < 4; ++j) {
        float tmax = fmaxf(fmaxf(s[mt][0][j], s[mt][1][j]), fmaxf(s[mt][2][j], s[mt][3][j]));
        tmax = red16_max(tmax);
        const float mnew = fmaxf(mx[mt][j], tmax);
        const float alpha = __expf(mx[mt][j] - mnew);
        float rs = 0.f;
#pragma unroll
        for (int n = 0; n < 4; ++n) {
          const float pv = __expf(s[mt][n][j] - mnew);
          rs += pv;
          Pw[(mt * 16 + fq * 4 + j) * 72 + n * 16 + fr] = f2bf(pv);
        }
        rs = red16_sum(rs);
        ls[mt][j] = ls[mt][j] * alpha + rs;
        mx[mt][j] = mnew;
#pragma unroll
        for (int n = 0; n < 8; ++n) o[mt][n][j] *= alpha;
      }
    __syncthreads();
#pragma unroll
    for (int ks = 0; ks < 2; ++ks) {
      bf16x8 pf[2];
#pragma unroll
      for (int mt = 0; mt < 2; ++mt) pf[mt] = *(const bf16x8*)(Pw + (mt * 16 + fr) * 72 + ks * 32 + fq * 8);
#pragma unroll
      for (int n = 0; n < 8; ++n) {
        const bf16x8 vf = *(const bf16x8*)(Vt + (n * 16 + fr) * 72 + ks * 32 + fq * 8);
#pragma unroll
        for (int mt = 0; mt < 2; ++mt) o[mt][n] = MFMA(pf[mt], vf, o[mt][n]);
      }
    }
  }
  __syncthreads();
#pragma unroll
  for (int mt = 0; mt < 2; ++mt)
#pragma unroll
    for (int j = 0; j < 4; ++j) {
      const float inv = 1.f / ls[mt][j];
#pragma unroll
      for (int n = 0; n < 8; ++n) o[mt][n][j] *= inv;
    }
  if (m == 1) {
#pragma unroll
    for (int mt = 0; mt < 2; ++mt)
#pragma unroll
      for (int n = 0; n < 8; ++n)
#pragma unroll
        for (int j = 0; j < 4; ++j) Ox[(rh * 32 + mt * 16 + fq * 4 + j) * 132 + n * 16 + fr] = o[mt][n][j];
  }
  __syncthreads();
  if (m == 0) {
    const float* sw = p.da_subln_w + (size_t)l * 128;
    float wv[8];
#pragma unroll
    for (int n = 0; n < 8; ++n) wv[n] = sw[n * 16 + fr] * (1.f - lam_init);
#pragma unroll
    for (int mt = 0; mt < 2; ++mt)
#pragma unroll
      for (int j = 0; j < 4; ++j) {
        float ss = 0.f;
        float d[8];
#pragma unroll
        for (int n = 0; n < 8; ++n) {
          d[n] = o[mt][n][j] - lam * Ox[(rh * 32 + mt * 16 + fq * 4 + j) * 132 + n * 16 + fr];
          ss += d[n] * d[n];
        }
        ss = red16_sum(ss);
        const float rstd = rsqrtf(ss * (1.f / 128.f) + 1e-6f);
        bf16_t* dst = p.u + (tok0 + rh * 32 + mt * 16 + fq * 4 + j) * US + h * 128 + fr;
#pragma unroll
        for (int n = 0; n < 8; ++n) dst[n * 16] = f2bf(d[n] * rstd * wv[n]);
      }
  }
  __syncthreads();
}

PHASE void hgrn_item(const Params& p, int l, int item, char* smem) {
  const int b = item >> 2, h = item & 3;
  const int tid = opaque_tid(), lane = tid & 63, wave = tid >> 6, fr = lane & 15, fq = lane >> 4;
  bf16_t* Qs = (bf16_t*)smem;
  bf16_t* Kn = Qs + 32 * 136;
  bf16_t* KT = Kn + 32 * 136;
  bf16_t* VT = KT + 128 * 40;
  bf16_t* Ps = VT + 128 * 40;
  bf16_t* ST = Ps + 32 * 40;
  float* lfb = (float*)ST;
  float* red = (float*)(ST + 128 * 136);
  float* blast = red + 64;
  const int t_ = tid >> 3, d0 = (tid & 7) * 16;
  float lbv[16];
#pragma unroll
  for (int i = 0; i < 16; ++i) {
    const int c = h * 128 + d0 + i;
    lbv[i] = (l == 0) ? 0.f : sigm(p.hg_lb[512 + c] - p.hg_lb[c]);
  }
  f32x4 S[2][8];
#pragma unroll
  for (int mm = 0; mm < 2; ++mm)
#pragma unroll
    for (int n = 0; n < 8; ++n) S[mm][n] = (f32x4){0.f, 0.f, 0.f, 0.f};
  const float* nw = p.hg_norm_w + (size_t)l * 128;

  for (int ch = 0; ch < 64; ++ch) {
    const size_t tok0 = (size_t)b * SEQ + (size_t)ch * 32;
    __syncthreads();
    float qv[16], kv[16];
    {
      const bf16_t* base = p.u + (tok0 + t_) * US + h * 128 + d0;
      float zv[16], iv[16];
      { const uint4 a = *(const uint4*)(base + 1024), c = *(const uint4*)(base + 1024 + 8); float* z0 = zv; float* z1 = zv + 8; UNPACK8(a, z0); UNPACK8(c, z1); }
      { const uint4 a = *(const uint4*)(base + 1536), c = *(const uint4*)(base + 1536 + 8); float* z0 = iv; float* z1 = iv + 8; UNPACK8(a, z0); UNPACK8(c, z1); }
      { const uint4 a = *(const uint4*)(base + 2048), c = *(const uint4*)(base + 2048 + 8); float* z0 = qv; float* z1 = qv + 8; UNPACK8(a, z0); UNPACK8(c, z1); }
#pragma unroll
      for (int i = 0; i < 16; ++i) {
        const float z = zv[i], lb = lbv[i];
        const float ez = __expf(-fabsf(z));
        float lf;
        if (lb > 0.f) {
          const float sg = (z >= 0.f) ? 1.f / (1.f + ez) : ez / (1.f + ez);
          lf = __logf(lb + (1.f - lb) * sg);
        } else {
          lf = -(fmaxf(-z, 0.f) + __logf(1.f + ez));
        }
        const float sgn = (z >= 0.f) ? ez / (1.f + ez) : 1.f / (1.f + ez);
        kv[i] = (1.f - lb) * sgn;
        lfb[t_ * 128 + d0 + i] = lf;
        VT[(d0 + i) * 40 + t_] = f2bf(iv[i]);
      }
    }
    __syncthreads();
    if (tid < 128) {
      float bsum = 0.f;
#pragma unroll 8
      for (int t = 0; t < 32; ++t) { bsum += lfb[t * 128 + tid]; lfb[t * 128 + tid] = bsum; }
      blast[tid] = bsum;
    }
    __syncthreads();
    {
      float qo[16], ko[16];
#pragma unroll
      for (int i = 0; i < 16; ++i) {
        const float bb = lfb[t_ * 128 + d0 + i];
        qo[i] = qv[i] * __expf(bb);
        ko[i] = kv[i] * __expf(fminf(-bb, 80.f));
        KT[(d0 + i) * 40 + t_] = f2bf(ko[i]);
      }
      float* q0 = qo; float* q1 = qo + 8; float* k0 = ko; float* k1 = ko + 8;
      *(uint4*)(Qs + t_ * 136 + d0) = PACK8(q0);
      *(uint4*)(Qs + t_ * 136 + d0 + 8) = PACK8(q1);
      *(uint4*)(Kn + t_ * 136 + d0) = PACK8(k0);
      *(uint4*)(Kn + t_ * 136 + d0 + 8) = PACK8(k1);
    }
    __syncthreads();
#pragma unroll
    for (int mm = 0; mm < 2; ++mm)
#pragma unroll
      for (int n = 0; n < 8; ++n)
        *(uint2*)(ST + (n * 16 + fr) * 136 + wave * 32 + mm * 16 + fq * 4) =
            make_uint2(pack2(S[mm][n][0], S[mm][n][1]), pack2(S[mm][n][2], S[mm][n][3]));
    {
      const int mt = wave >> 1, nt = wave & 1;
      f32x4 sc = (f32x4){0.f, 0.f, 0.f, 0.f};
#pragma unroll
      for (int ks = 0; ks < 4; ++ks) {
        const bf16x8 a = *(const bf16x8*)(Qs + (mt * 16 + fr) * 136 + ks * 32 + fq * 8);
        const bf16x8 bb = *(const bf16x8*)(Kn + (nt * 16 + fr) * 136 + ks * 32 + fq * 8);
        sc = MFMA(a, bb, sc);
      }
#pragma unroll
      for (int j = 0; j < 4; ++j) {
        const int t = mt * 16 + fq * 4 + j, key = nt * 16 + fr;
        Ps[t * 40 + key] = f2bf(key <= t ? sc[j] : 0.f);
      }
    }
    __syncthreads();
    {
      const int mt = wave & 1, nb = (wave >> 1) * 4;
      f32x4 oo[4];
#pragma unroll
      for (int n = 0; n < 4; ++n) oo[n] = (f32x4){0.f, 0.f, 0.f, 0.f};
      {
        const bf16x8 a = *(const bf16x8*)(Ps + (mt * 16 + fr) * 40 + fq * 8);
#pragma unroll
        for (int n = 0; n < 4; ++n) {
          const bf16x8 bb = *(const bf16x8*)(VT + ((nb + n) * 16 + fr) * 40 + fq * 8);
          oo[n] = MFMA(a, bb, oo[n]);
        }
      }
#pragma unroll
      for (int ks = 0; ks < 4; ++ks) {
        const bf16x8 a = *(const bf16x8*)(Qs + (mt * 16 + fr) * 136 + ks * 32 + fq * 8);
#pragma unroll
        for (int n = 0; n < 4; ++n) {
          const bf16x8 bb = *(const bf16x8*)(ST + ((nb + n) * 16 + fr) * 136 + ks * 32 + fq * 8);
          oo[n] = MFMA(a, bb, oo[n]);
        }
      }
#pragma unroll
      for (int j = 0; j < 4; ++j) {
        float ss = 0.f;
#pragma unroll
        for (int n = 0; n < 4; ++n) ss += oo[n][j] * oo[n][j];
        ss = red16_sum(ss);
        if (fr == 0) red[(mt * 16 + fq * 4 + j) * 2 + (wave >> 1)] = ss;
      }
      __syncthreads();
#pragma unroll
      for (int j = 0; j < 4; ++j) {
        const int t = mt * 16 + fq * 4 + j;
        const float rstd = rsqrtf((red[t * 2] + red[t * 2 + 1]) * (1.f / 128.f) + 1e-6f);
        bf16_t* gp = p.u + (tok0 + t) * US + 2560 + h * 128 + nb * 16 + fr;
#pragma unroll
        for (int n = 0; n < 4; ++n) {
          const float g = bf2f(gp[n * 16]);
          gp[n * 16] = f2bf(oo[n][j] * rstd * nw[(nb + n) * 16 + fr] * (g * sigm(g)));
        }
      }
    }
    {
      bf16x8 af[2];
#pragma unroll
      for (int mm = 0; mm < 2; ++mm) af[mm] = *(const bf16x8*)(KT + (wave * 32 + mm * 16 + fr) * 40 + fq * 8);
#pragma unroll
      for (int n = 0; n < 8; ++n) {
        const bf16x8 bb = *(const bf16x8*)(VT + (n * 16 + fr) * 40 + fq * 8);
#pragma unroll
        for (int mm = 0; mm < 2; ++mm) S[mm][n] = MFMA(af[mm], bb, S[mm][n]);
      }
#pragma unroll
      for (int mm = 0; mm < 2; ++mm)
#pragma unroll
        for (int j = 0; j < 4; ++j) {
          const float e = __expf(blast[wave * 32 + mm * 16 + fq * 4 + j]);
#pragma unroll
          for (int n = 0; n < 8; ++n) S[mm][n][j] *= e;
        }
    }
  }
  __syncthreads();
}

DEV uint4 rw_act(const uint4 cur, const uint4 prv, const float* mul8, int mode) {
  const float4 m0 = *(const float4*)(mul8), m1 = *(const float4*)(mul8 + 4);
  const float mm[8] = {m0.x, m0.y, m0.z, m0.w, m1.x, m1.y, m1.z, m1.w};
  float a[8], b[8], o[8];
  UNPACK8(cur, a); UNPACK8(prv, b);
#pragma unroll
  for (int e = 0; e < 8; ++e) {
    float v = a[e] + (b[e] - a[e]) * mm[e];
    if (mode == 1) { const float t = __expf(-2.f * fabsf(v)); const float th = (1.f - t) / (1.f + t); v = (v >= 0.f) ? th : -th; }
    else if (mode == 2) v = sigm(v);
    o[e] = v;
  }
  return PACK8(o);
}
DEV bf16x8 rw_bfrag(const float* W, int k0, int col) {
  float o[8];
#pragma unroll
  for (int e = 0; e < 8; ++e) o[e] = W[(size_t)(k0 + e) * 512 + col];
  return as_frag(PACK8(o));
}

PHASE void rwkv_item(const Params& p, int l, int item, char* smem) {
  const int b = item >> 3, h = item & 7;
  const int tid = opaque_tid(), lane = tid & 63, wave = tid >> 6, fr = lane & 15, fq = lane >> 4;
  float* R = (float*)smem;
  float* K = R + 2048; float* KK = K + 2048; float* W = KK + 2048; float* BB = W + 2048;
  float* V = BB + 2048; float* G = V + 2048; float* O = G + 2048;
  float* cst = O + 2048;
  float* mul = cst + 512;
  bf16_t* rawL = (bf16_t*)smem;
  float* vloL = (float*)(smem + 17424);
  const float* mu = p.rw_mu + (size_t)l * 1792;
  const int hc_n = h * 64 + wave * 16 + fr;
  bf16x8 w2f[2], a2f[2], g2f[4], v2f;
#pragma unroll
  for (int ks = 0; ks < 2; ++ks) {
    w2f[ks] = rw_bfrag(p.rw_w2 + (size_t)l * 64 * 512, ks * 32 + fq * 8, hc_n);
    a2f[ks] = rw_bfrag(p.rw_a2 + (size_t)l * 64 * 512, ks * 32 + fq * 8, hc_n);
  }
#pragma unroll
  for (int ks = 0; ks < 4; ++ks) g2f[ks] = rw_bfrag(p.rw_g2 + (size_t)l * 128 * 512, ks * 32 + fq * 8, hc_n);
  v2f = w2f[0];
  if (l > 0) v2f = rw_bfrag(p.rw_v2, fq * 8, hc_n);
  const float w0c = p.rw_w0[l * 512 + hc_n], a0c = p.rw_a0[l * 512 + hc_n];
  const float v0c = (l > 0) ? p.rw_v0[hc_n] : 0.f;
  const int t_ = tid >> 3, n0 = (tid & 7) * 8;
  __syncthreads();
  if (tid < 64) {
    const int hc = h * 64 + tid;
    cst[tid] = p.rw_k_k[l * 512 + hc]; cst[64 + tid] = p.rw_k_a[l * 512 + hc]; cst[128 + tid] = p.rw_r_k[l * 512 + hc];
    cst[192 + tid] = p.rw_gn_w[l * 512 + hc]; cst[256 + tid] = p.rw_gn_b[l * 512 + hc];
    cst[320 + tid] = mu[hc]; cst[384 + tid] = mu[512 + hc]; cst[448 + tid] = mu[1024 + hc];
  }
  mul[tid] = mu[1536 + tid];
  const float* kkc = cst + n0; const float* kac = cst + 64 + n0; const float* rkc = cst + 128 + n0;
  const float* gnw = cst + 192 + n0; const float* gnb = cst + 256 + n0;
  const float* mur = cst + 320 + n0; const float* muk = cst + 384 + n0; const float* muv = cst + 448 + n0;
  const int kq = lane & 7, row0 = wave * 16 + (lane >> 3), row1 = row0 + 8;
  float S0[8], S1[8];
#pragma unroll
  for (int e = 0; e < 8; ++e) { S0[e] = 0.f; S1[e] = 0.f; }

  uint4 pl0, pl1, pl2, pl3, pl4, pcr, pck, pcv, ppr, ppk, ppv, pvf;
  float4 pvl;
#define RW_PREFETCH(ch_)                                                                                    \
  {                                                                                                         \
    const size_t tk0 = (size_t)b * SEQ + (size_t)(ch_) * 32;                                                 \
    const bf16_t* lb_ = p.u + (tk0 - 1) * US + 3072 + 1536 + (tid & 31) * 8;                                 \
    const int r0_ = tid >> 5;                                                                               \
    pl0 = make_uint4(0, 0, 0, 0); if (!((ch_) == 0 && r0_ == 0)) pl0 = *(const uint4*)(lb_ + (size_t)r0_ * US); \
    pl1 = *(const uint4*)(lb_ + (size_t)(r0_ + 8) * US);                                                     \
    pl2 = *(const uint4*)(lb_ + (size_t)(r0_ + 16) * US);                                                    \
    pl3 = *(const uint4*)(lb_ + (size_t)(r0_ + 24) * US);                                                    \
    pl4 = make_uint4(0, 0, 0, 0); if (tid < 32) pl4 = *(const uint4*)(lb_ + (size_t)32 * US);                \
    const bf16_t* cu_ = p.u + (tk0 + t_) * US + 3072 + h * 64 + n0;                                          \
    pcr = *(const uint4*)cu_; pck = *(const uint4*)(cu_ + 512); pcv = *(const uint4*)(cu_ + 1024);           \
    if ((ch_) == 0 && t_ == 0) { ppr = make_uint4(0, 0, 0, 0); ppk = ppr; ppv = ppr; }                        \
    else { ppr = *(const uint4*)(cu_ - US); ppk = *(const uint4*)(cu_ - US + 512); ppv = *(const uint4*)(cu_ - US + 1024); } \
    if (l > 0) {                                                                                            \
      pvl = *(const float4*)(p.vlo + (tk0 + (tid >> 3)) * 32 + (tid & 7) * 4);                               \
      pvf = *(const uint4*)(p.vfirst + (tk0 + t_) * 512 + h * 64 + n0);                                      \
    } else { pvl = make_float4(0.f, 0.f, 0.f, 0.f); pvf = make_uint4(0, 0, 0, 0); }                          \
  }
  RW_PREFETCH(0)

  for (int ch = 0; ch < 64; ++ch) {
    const size_t tok0 = (size_t)b * SEQ + (size_t)ch * 32;
    __syncthreads();
    {
      const int r0_ = tid >> 5, cc_ = (tid & 31) * 8;
      *(uint4*)(rawL + r0_ * 264 + cc_) = pl0;
      *(uint4*)(rawL + (r0_ + 8) * 264 + cc_) = pl1;
      *(uint4*)(rawL + (r0_ + 16) * 264 + cc_) = pl2;
      *(uint4*)(rawL + (r0_ + 24) * 264 + cc_) = pl3;
      if (tid < 32) *(uint4*)(rawL + 32 * 264 + cc_) = pl4;
      *(float4*)(vloL + (tid >> 3) * 36 + (tid & 7) * 4) = pvl;
    }
    __syncthreads();
    {
      const int cc_ = (tid & 31) * 8, tr = tid >> 5;
      const int mode = (cc_ < 64) ? 1 : ((cc_ < 128) ? 0 : 2);
      uint4 a0, a1, a2, a3;
      a0 = rw_act(*(const uint4*)(rawL + (tr + 1) * 264 + cc_), *(const uint4*)(rawL + tr * 264 + cc_), mul + cc_, mode);
      a1 = rw_act(*(const uint4*)(rawL + (tr + 9) * 264 + cc_), *(const uint4*)(rawL + (tr + 8) * 264 + cc_), mul + cc_, mode);
      a2 = rw_act(*(const uint4*)(rawL + (tr + 17) * 264 + cc_), *(const uint4*)(rawL + (tr + 16) * 264 + cc_), mul + cc_, mode);
      a3 = rw_act(*(const uint4*)(rawL + (tr + 25) * 264 + cc_), *(const uint4*)(rawL + (tr + 24) * 264 + cc_), mul + cc_, mode);
      __syncthreads();
      *(uint4*)(rawL + tr * 264 + cc_) = a0;
      *(uint4*)(rawL + (tr + 8) * 264 + cc_) = a1;
      *(uint4*)(rawL + (tr + 16) * 264 + cc_) = a2;
      *(uint4*)(rawL + (tr + 24) * 264 + cc_) = a3;
    }
    __syncthreads();
#pragma unroll 1
    for (int mt = 0; mt < 2; ++mt) {
      const int row = mt * 16 + fr;
      const bf16_t* ar = rawL + row * 264 + fq * 8;
      f32x4 aw = (f32x4){0.f, 0.f, 0.f, 0.f}, aa = aw, ag = aw, av = aw;
#pragma unroll
      for (int ks = 0; ks < 2; ++ks) {
        aw = MFMA(*(const bf16x8*)(ar + ks * 32), w2f[ks], aw);
        aa = MFMA(*(const bf16x8*)(ar + 64 + ks * 32), a2f[ks], aa);
      }
#pragma unroll
      for (int ks = 0; ks < 4; ++ks) ag = MFMA(*(const bf16x8*)(ar + 128 + ks * 32), g2f[ks], ag);
      if (l > 0) {
        const float4 x0 = *(const float4*)(vloL + row * 36 + fq * 8), x1 = *(const float4*)(vloL + row * 36 + fq * 8 + 4);
        const uint4 pk = make_uint4(pack2(x0.x, x0.y), pack2(x0.z, x0.w), pack2(x1.x, x1.y), pack2(x1.z, x1.w));
        av = MFMA(as_frag(pk), v2f, av);
      }
#pragma unroll
      for (int j = 0; j < 4; ++j) {
        const int t = mt * 16 + fq * 4 + j, n = wave * 16 + fr;
        const float wv = -(w0c + aw[j]);
        const float sp = fmaxf(wv, 0.f) + __logf(1.f + __expf(-fabsf(wv)));
        const float wl = -sp - 0.5f;
        W[t * 64 + n] = __expf(-__expf(wl));
        BB[t * 64 + n] = sigm(a0c + aa[j]);
        G[t * 64 + n] = ag[j];
        if (l > 0) O[t * 64 + n] = sigm(v0c + av[j]);
      }
    }
    __syncthreads();
    {
      const size_t tok = tok0 + t_;
      float cr[8], ck[8], cv[8], pr[8], pk[8], pv[8];
      UNPACK8(pcr, cr); UNPACK8(pck, ck); UNPACK8(pcv, cv);
      UNPACK8(ppr, pr); UNPACK8(ppk, pk); UNPACK8(ppv, pv);
      float kx[8], kkv[8], vs[8], ss = 0.f;
#pragma unroll
      for (int e = 0; e < 8; ++e) {
        R[t_ * 64 + n0 + e] = cr[e] + (pr[e] - cr[e]) * mur[e];
        kx[e] = ck[e] + (pk[e] - ck[e]) * muk[e];
        vs[e] = cv[e] + (pv[e] - cv[e]) * muv[e];
        kkv[e] = kx[e] * kkc[e]; ss += kkv[e] * kkv[e];
      }
      ss = red8_sum(ss);
      const float rn = rsqrtf(fmaxf(ss, 1e-24f));
#pragma unroll
      for (int e = 0; e < 8; ++e) {
        const float a = BB[t_ * 64 + n0 + e];
        const float kn = kkv[e] * rn;
        K[t_ * 64 + n0 + e] = kx[e] * (1.f + (a - 1.f) * kac[e]);
        KK[t_ * 64 + n0 + e] = kn;
        BB[t_ * 64 + n0 + e] = kn * a;
      }
      if (l == 0) {
        *(uint4*)(p.vfirst + tok * 512 + h * 64 + n0) = PACK8(vs);
      } else {
        float vf[8]; UNPACK8(pvf, vf);
#pragma unroll
        for (int e = 0; e < 8; ++e) vs[e] = vs[e] + (vf[e] - vs[e]) * O[t_ * 64 + n0 + e];
      }
#pragma unroll
      for (int e = 0; e < 8; ++e) V[t_ * 64 + n0 + e] = vs[e];
    }
    __syncthreads();
    if (ch + 1 < 64) RW_PREFETCH(ch + 1)
    asm volatile("" ::: "memory");
#pragma unroll 2
    for (int t = 0; t < 32; ++t) {
      const float* base = R + t * 64 + kq * 8;
      const float4 r0 = *(const float4*)(base), r1 = *(const float4*)(base + 4);
      const float4 k0 = *(const float4*)(base + 2048), k1 = *(const float4*)(base + 2048 + 4);
      const float4 q0 = *(const float4*)(base + 4096), q1 = *(const float4*)(base + 4096 + 4);
      const float4 w0 = *(const float4*)(base + 6144), w1 = *(const float4*)(base + 6144 + 4);
      const float4 b0 = *(const float4*)(base + 8192), b1 = *(const float4*)(base + 8192 + 4);
      const float va = V[t * 64 + row0], vb = V[t * 64 + row1];
      const float rr[8] = {r0.x, r0.y, r0.z, r0.w, r1.x, r1.y, r1.z, r1.w};
      const float ww[8] = {w0.x, w0.y, w0.z, w0.w, w1.x, w1.y, w1.z, w1.w};
      const float kk_[8] = {k0.x, k0.y, k0.z, k0.w, k1.x, k1.y, k1.z, k1.w};
      const float qq[8] = {q0.x, q0.y, q0.z, q0.w, q1.x, q1.y, q1.z, q1.w};
      const float bb[8] = {b0.x, b0.y, b0.z, b0.w, b1.x, b1.y, b1.z, b1.w};
      float sa0 = 0.f, sa1 = 0.f;
#pragma unroll
      for (int e = 0; e < 8; ++e) { sa0 += S0[e] * qq[e]; sa1 += S1[e] * qq[e]; }
      sa0 = -red8_sum(sa0); sa1 = -red8_sum(sa1);
      float o0 = 0.f, o1 = 0.f;
#pragma unroll
      for (int e = 0; e < 8; ++e) {
        S0[e] = S0[e] * ww[e] + sa0 * bb[e] + va * kk_[e];
        S1[e] = S1[e] * ww[e] + sa1 * bb[e] + vb * kk_[e];
        o0 += S0[e] * rr[e]; o1 += S1[e] * rr[e];
      }
      o0 = red8_sum(o0); o1 = red8_sum(o1);
      if (kq == 0) { O[t * 64 + row0] = o0; O[t * 64 + row1] = o1; }
    }
    asm volatile("s_waitcnt vmcnt(0)" ::: "memory");
    __syncthreads();
    {
      const size_t tok = tok0 + t_;
      float ov[8], s1 = 0.f, bon = 0.f;
#pragma unroll
      for (int e = 0; e < 8; ++e) {
        ov[e] = O[t_ * 64 + n0 + e]; s1 += ov[e];
        bon += R[t_ * 64 + n0 + e] * K[t_ * 64 + n0 + e] * rkc[e];
      }
      s1 = red8_sum(s1); bon = red8_sum(bon);
      const float mean = s1 * (1.f / 64.f);
      float s2 = 0.f;
#pragma unroll
      for (int e = 0; e < 8; ++e) { const float d = ov[e] - mean; s2 += d * d; }
      s2 = red8_sum(s2);
      const float rstd = rsqrtf(s2 * (1.f / 64.f) + 64e-5f);
      float y[8];
#pragma unroll
      for (int e = 0; e < 8; ++e)
        y[e] = ((ov[e] - mean) * rstd * gnw[e] + gnb[e] + bon * V[t_ * 64 + n0 + e]) * G[t_ * 64 + n0 + e];
      *(uint4*)(p.u + tok * US + 3072 + h * 64 + n0) = PACK8(y);
    }
  }
#undef RW_PREFETCH
  __syncthreads();
}

PHASE void phase_mix(const Params& p, int l, char* smem) {
  int* sitem = (int*)(smem + SMEM_BYTES - 16);
  const int tid0 = opaque_tid();
  while (true) {
    __syncthreads();
    if (tid0 == 0) *sitem = (int)atomicAdd(p.counters + l * 4 + 0, 1u);
    __syncthreads();
    const int item = *sitem;
    if (item >= 256) break;
    rwkv_item(p, l, item, smem);
  }
  while (true) {
    __syncthreads();
    if (tid0 == 0) *sitem = (int)atomicAdd(p.counters + l * 4 + 1, 1u);
    __syncthreads();
    const int item = *sitem;
    if (item >= 128) break;
    hgrn_item(p, l, item, smem);
  }
  while (true) {
    __syncthreads();
    if (tid0 == 0) *sitem = (int)atomicAdd(p.counters + l * 4 + 2, 1u);
    __syncthreads();
    const int item = *sitem;
    if (item >= 4096) break;
    att_item(p, l, item, smem);
  }
}

DEV void gemm_gates(const int tid, const bf16_t* A, const bf16_t* Wg, int tn, char* smem, unsigned (&Gp)[4][6][2]) {
  bf16_t* As = (bf16_t*)smem;
  bf16_t* Bs = As + 3 * 4096;
  const int lane = tid & 63, wave = tid >> 6, wr = wave >> 1, wc = wave & 1;
  const int fr = lane & 15, fq = lane >> 4;
  f32x4 acc[4][6];
#pragma unroll
  for (int m = 0; m < 4; ++m)
#pragma unroll
    for (int n = 0; n < 6; ++n) acc[m][n] = (f32x4){0.f, 0.f, 0.f, 0.f};
  const int nk = DM >> 5;
  const int drow = tid >> 2, dphys = tid & 3, dg = (0 - (tid >> 4)) & 3;
  const int cofs = (dphys ^ dg) * 8;
  const bf16_t* Ap = A + (size_t)drow * DM + cofs;
  const bf16_t* Bp0; const bf16_t* Bp1; const bf16_t* Bp2;
  {
    int r = drow;
    int wcb = r / 96, br = (r % 96) >> 5, c = r & 31;
    c = (r % 96) & 31;
    Bp0 = Wg + (size_t)(5376 + br * 1024 + tn * 64 + wcb * 32 + c) * DM + cofs;
    r = drow + 64; wcb = r / 96; br = (r % 96) >> 5; c = (r % 96) & 31;
    Bp1 = Wg + (size_t)(5376 + br * 1024 + tn * 64 + wcb * 32 + c) * DM + cofs;
    r = drow + 128; wcb = r / 96; br = (r % 96) >> 5; c = (r % 96) & 31;
    Bp2 = Wg + (size_t)(5376 + br * 1024 + tn * 64 + wcb * 32 + c) * DM + cofs;
  }
  const int rofs = (fq ^ ((0 - (fr >> 2)) & 3)) * 8;
#define GG_DMA(st, kk)                                                                                       \
  {                                                                                                          \
    __builtin_amdgcn_global_load_lds((const unsigned*)(Ap + (kk) * 32), (unsigned*)(As + (st) * 4096 + tid * 8), 16, 0, 0);                     \
    __builtin_amdgcn_global_load_lds((const unsigned*)(Ap + (size_t)64 * DM + (kk) * 32), (unsigned*)(As + (st) * 4096 + tid * 8 + 2048), 16, 0, 0); \
    __builtin_amdgcn_global_load_lds((const unsigned*)(Bp0 + (kk) * 32), (unsigned*)(Bs + (st) * 6144 + tid * 8), 16, 0, 0);                    \
    __builtin_amdgcn_global_load_lds((const unsigned*)(Bp1 + (kk) * 32), (unsigned*)(Bs + (st) * 6144 + tid * 8 + 2048), 16, 0, 0);             \
    __builtin_amdgcn_global_load_lds((const unsigned*)(Bp2 + (kk) * 32), (unsigned*)(Bs + (st) * 6144 + tid * 8 + 4096), 16, 0, 0);             \
  }
  GG_DMA(0, 0)
  GG_DMA(1, 1)
  int st = 0;
  for (int kt = 0; kt < nk; ++kt) {
    if (kt + 1 < nk) asm volatile("s_waitcnt vmcnt(5)" ::: "memory");
    else asm volatile("s_waitcnt vmcnt(0)" ::: "memory");
    __builtin_amdgcn_s_barrier();
    asm volatile("" ::: "memory");
    const int s2 = (st >= 1) ? st - 1 : 2;
    const bf16_t* Ab = As + st * 4096 + (wr * 64 + fr) * 32 + rofs;
    const bf16_t* Bb = Bs + st * 6144 + (wc * 96 + fr) * 32 + rofs;
    bf16x8 bfr[6], af[4];
#pragma unroll
    for (int n = 0; n < 6; ++n) bfr[n] = *(const bf16x8*)(Bb + n * 512);
#pragma unroll
    for (int m = 0; m < 4; ++m) af[m] = *(const bf16x8*)(Ab + m * 512);
    if (kt + 2 < nk) GG_DMA(s2, kt + 2)
#pragma unroll
    for (int m = 0; m < 4; ++m)
#pragma unroll
      for (int n = 0; n < 6; ++n) acc[m][n] = MFMA(af[m], bfr[n], acc[m][n]);
    st = (st == 2) ? 0 : st + 1;
  }
#undef GG_DMA
  __syncthreads();
#pragma unroll
  for (int m = 0; m < 4; ++m)
#pragma unroll
    for (int n = 0; n < 6; ++n) {
      Gp[m][n][0] = pack2(sigm(acc[m][n][0]), sigm(acc[m][n][1]));
      Gp[m][n][1] = pack2(sigm(acc[m][n][2]), sigm(acc[m][n][3]));
    }
}

PHASE void phase_merge(const Params& p, int l, char* smem) {
  const bf16_t* Wl = p.wt + (size_t)l * WLAYER;
  float* Cs = (float*)smem;
  const int tid = opaque_tid();
  for (int it = 0;; ++it) {
    int tm, tn;
    if (!tile_for(it, 512, 16, tm, tn)) break;
    const size_t row0 = (size_t)tm * 128;
    unsigned Gp[4][6][2];
    gemm_gates(tid, p.h + row0 * DM, Wl + WIN, tn, smem, Gp);
    f32x4 acc[4][2], M[4][2];
#pragma unroll
    for (int m = 0; m < 4; ++m)
#pragma unroll
      for (int n = 0; n < 2; ++n) M[m][n] = (f32x4){0.f, 0.f, 0.f, 0.f};
#pragma unroll
    for (int br = 0; br < 3; ++br) {
      const int aoff = (br == 0) ? 0 : (br == 1 ? 2560 : 3072);
      const size_t woff = (br == 0) ? WBA : (br == 1 ? WBB : WBC);
      gemm_tile<2>(tid, p.u + row0 * US + aoff, US, Wl + woff + (size_t)(tn * 64) * 512, 512, 512, smem, acc);
#pragma unroll
      for (int m = 0; m < 4; ++m)
#pragma unroll
        for (int n = 0; n < 2; ++n) {
          M[m][n][0] += lo16(Gp[m][2 * br + n][0]) * acc[m][n][0];
          M[m][n][1] += hi16(Gp[m][2 * br + n][0]) * acc[m][n][1];
          M[m][n][2] += lo16(Gp[m][2 * br + n][1]) * acc[m][n][2];
          M[m][n][3] += hi16(Gp[m][2 * br + n][1]) * acc[m][n][3];
        }
    }
    stage_acc<2>(tid, Cs, M);
    __syncthreads();
    {
      const int ch = tid & 7;
#pragma unroll 1
      for (int i = 0; i < 4; ++i) {
        const int r = (tid >> 3) + i * 32;
        const float4 a = *(const float4*)(Cs + r * 68 + ch * 8), b = *(const float4*)(Cs + r * 68 + ch * 8 + 4);
        *(uint4*)(p.u + (row0 + r) * US + 1024 + tn * 64 + ch * 8) = make_uint4(pack2(a.x, a.y), pack2(a.z, a.w), pack2(b.x, b.y), pack2(b.z, b.w));
      }
    }
    __syncthreads();
  }
}

PHASE void phase_gemm_res(const bf16_t* A, int lda, const bf16_t* Wt, int K, const float* xin, float* xout,
                        const float* ada_l, int gate_off, char* smem) {
  float* Cs = (float*)smem;
  const int tid = opaque_tid();
  for (int it = 0;; ++it) {
    int tm, tn;
    if (!tile_for(it, 256, 8, tm, tn)) break;
    const size_t row0 = (size_t)tm * 256;
    f32x4 acc[8][4];
    gemm_tile256(tid, A + row0 * lda, lda, Wt + (size_t)(tn * 128) * K, K, K, smem, acc);
    const float* gate = ada_l + (size_t)(row0 / SEQ) * ADAW + gate_off + tn * 128;
    const int c4 = (tid & 31) * 4;
    const float4 gv = *(const float4*)(gate + c4);
#pragma unroll
    for (int ps = 0; ps < 2; ++ps) {
      if (ps == 0) stage_half<0>(tid, Cs, acc); else stage_half<1>(tid, Cs, acc);
      __syncthreads();
#pragma unroll 1
      for (int i = 0; i < 16; ++i) {
        const int r = (tid >> 5) + i * 8;
        const float4 cv = *(const float4*)(Cs + r * 132 + c4);
        const size_t off = (row0 + RMAP(r, ps)) * DM + tn * 128 + c4;
        const float4 xv = *(const float4*)(xin + off);
        *(float4*)(xout + off) = make_float4(xv.x + gv.x * cv.x, xv.y + gv.y * cv.y, xv.z + gv.z * cv.z, xv.w + gv.w * cv.w);
      }
      __syncthreads();
    }
  }
}

PHASE void phase_ffn_in(const Params& p, int l, char* smem) {
  const bf16_t* Wt = p.wt + (size_t)l * WLAYER + WFI;
  float* Cs = (float*)smem;
  const int tid = opaque_tid();
  for (int it = 0;; ++it) {
    int tm, tn;
    if (!tile_for(it, 256, 44, tm, tn)) break;
    const size_t row0 = (size_t)tm * 256;
    f32x4 acc[8][4];
    gemm_tile256(tid, p.h + row0 * DM, DM, Wt + (size_t)(tn * 128) * DM, DM, DM, smem, acc);
    const int ch = tid & 7;
#pragma unroll
    for (int ps = 0; ps < 2; ++ps) {
      if (ps == 0) stage_half<0>(tid, Cs, acc); else stage_half<1>(tid, Cs, acc);
      __syncthreads();
#pragma unroll 1
      for (int i = 0; i < 4; ++i) {
        const int r = (tid >> 3) + i * 32;
        const float* cp = Cs + r * 132 + ch * 8;
        float o[8];
#pragma unroll
        for (int e = 0; e < 8; ++e) { const float g = cp[e], uu = cp[64 + e]; o[e] = g * sigm(g) * uu; }
        *(uint4*)(p.u + (row0 + RMAP(r, ps)) * FFH + tn * 64 + ch * 8) = PACK8(o);
      }
      __syncthreads();
    }
  }
}

#define XB_TMO      128
#define XB_XCNT(j)  (256  + 64 * (j))
#define XB_XSUB(j)  (1280 + 64 * (j))
#define XB_XGEN(j)  (2304 + 64 * (j))
#define XB_TOP      3328
#define XB_TOPGEN   3392
#define XCD_BAR_WORDS 3456
#define XB_SPIN_CAP (1u << 18)
#define LAS __attribute__((address_space(3)))
DEV unsigned xb_ld(unsigned* p) { return __hip_atomic_load(p, __ATOMIC_RELAXED, __HIP_MEMORY_SCOPE_AGENT); }
DEV unsigned xb_add(unsigned* p, unsigned v) { return __hip_atomic_fetch_add(p, v, __ATOMIC_RELAXED, __HIP_MEMORY_SCOPE_AGENT); }
DEV unsigned xb_xcc_id() { return (unsigned)__builtin_amdgcn_s_getreg((3 << 11) | 20) & 0xFu; }
#define XB_SPIN(cond, bar) do { unsigned _sp = 0; while (cond) { __builtin_amdgcn_s_sleep(1); \
    if ((++_sp & 255u) == 0u) { if (xb_ld(&(bar)[XB_TMO])) break; if (_sp > XB_SPIN_CAP) { atomicAdd(&(bar)[XB_TMO], 1u); break; } } } } while (0)
struct XcdBarrier { unsigned* bar; unsigned x; volatile LAS unsigned* st; };
DEV XcdBarrier xcd_barrier_post(unsigned* bar, volatile LAS unsigned* st) {
  XcdBarrier b; b.bar = bar; b.x = xb_xcc_id(); b.st = st;
  if (threadIdx.x == 0) (void)xb_add(&bar[XB_XCNT(b.x)], 1u);
  return b;
}
DEV void xcd_barrier_complete(unsigned* bar, unsigned x, unsigned& nloc, unsigned& nx) {
  const unsigned G = gridDim.x * gridDim.y * gridDim.z;
  unsigned sum, cnt, mine, sp = 0u;
  for (;;) {
    sum = 0u; cnt = 0u; mine = 0u;
#pragma unroll
    for (unsigned j = 0; j < 16; ++j) { const unsigned c = xb_ld(&bar[XB_XCNT(j)]); sum += c; cnt += (c > 0u) ? 1u : 0u; mine = (j == x) ? c : mine; }
    if (sum == G) break;
    __builtin_amdgcn_s_sleep(1);
    if ((++sp & 255u) == 0u) { if (xb_ld(&bar[XB_TMO])) break; if (sp > XB_SPIN_CAP) { atomicAdd(&bar[XB_TMO], 1u); break; } }
  }
  nloc = mine > 0u ? mine : 1u; nx = cnt > 0u ? cnt : 1u;
}
DEV void xcd_barrier(const XcdBarrier& b) {
  asm volatile("s_waitcnt vmcnt(0)" ::: "memory");
  __syncthreads();
  if (threadIdx.x == 0) {
    unsigned* bar = b.bar;
    __builtin_amdgcn_s_waitcnt(0);
    unsigned nloc = b.st[0], nx = b.st[1];
    if (nloc == 0u) { xcd_barrier_complete(bar, b.x, nloc, nx); b.st[0] = nloc; b.st[1] = nx; }
    const unsigned old = xb_add(&bar[XB_XSUB(b.x)], 1u);
    const unsigned gen = old / nloc;
    if (old + 1u == (gen + 1u) * nloc) {
      __builtin_amdgcn_fence(__ATOMIC_RELEASE, "agent");
      asm volatile("s_waitcnt vmcnt(0)" ::: "memory");
      const unsigned og = xb_add(&bar[XB_TOP], 1u);
      const unsigned tg = og / nx;
      if (og + 1u == (tg + 1u) * nx) xb_add(&bar[XB_TOPGEN], 1u);
      else XB_SPIN(xb_ld(&bar[XB_TOPGEN]) == tg, bar);
      __builtin_amdgcn_fence(__ATOMIC_ACQUIRE, "agent");
      xb_add(&bar[XB_XGEN(b.x)], 1u);
      asm volatile("s_waitcnt vmcnt(0)" ::: "memory");
    } else {
      XB_SPIN(xb_ld(&bar[XB_XGEN(b.x)]) == gen, bar);
      __builtin_amdgcn_fence(__ATOMIC_ACQUIRE, "agent");
      asm volatile("s_waitcnt vmcnt(0)" ::: "memory");
    }
  }
  __syncthreads();
}

__global__ void __launch_bounds__(256, 2) mega(Params p_in, int ph_lo, int ph_hi) {
  extern __shared__ __attribute__((aligned(16))) char smem[];
  cg::grid_group grid = cg::this_grid();
  const Params& p = p_in;
  bool first = true;
#define RUN(ph) if ((ph) >= ph_lo && (ph) < ph_hi)
  unsigned epoch = 0;
  __shared__ unsigned xb_words[4];
  if (threadIdx.x < 4) xb_words[threadIdx.x] = 0u;
  __syncthreads();
  XcdBarrier xb;
  xb.bar = p.counters + 256; xb.x = 0u; xb.st = (volatile LAS unsigned*)xb_words;
#define SYNC { if (!first) { ++epoch; if (epoch == 1) { grid.sync(); xb = xcd_barrier_post(p.counters + 256, (volatile LAS unsigned*)xb_words); } else xcd_barrier(xb); } first = false; }
  RUN(0) { SYNC; phase_prep(p, smem); }
#pragma unroll 1
  for (int l = 0; l < 2; ++l) {
    const int base = 1 + 9 * l;
    const float* ada_l = p.ada + (size_t)l * 32 * ADAW;
    const bf16_t* Wl = p.wt + (size_t)l * WLAYER;
    const float* xin = (l == 0) ? p.x : p.out;
    RUN(base + 0) { SYNC; phase_norm(xin, p.norm_mix_w + l * DM, ada_l, 0, 1024, p.h); }
    RUN(base + 1) { SYNC; phase_gemm_in(p, l, smem); }
    RUN(base + 2) { if (l > 0) { SYNC; phase_vlo(p, l, smem); } }
    RUN(base + 3) { SYNC; phase_mix(p, l, smem); }
    RUN(base + 4) { SYNC; phase_merge(p, l, smem); }
    RUN(base + 5) { SYNC; phase_gemm_res(p.u + 1024, US, Wl + WOUT, DM, xin, p.out, ada_l, 2048, smem); }
    RUN(base + 6) { SYNC; phase_norm(p.out, p.norm_ffn_w + l * DM, ada_l, 3072, 4096, p.h); }
    RUN(base + 7) { SYNC; phase_ffn_in(p, l, smem); }
    RUN(base + 8) { SYNC; phase_gemm_res(p.u, FFH, Wl + WFO, FFH, p.out, p.out, ada_l, 5120, smem); }
  }
  RUN(NPHASE - 1) { SYNC; phase_final(p.out, p.final_norm_w); }
}

extern "C" void kernel_launch(void* const* d_in, const int* in_sizes, int n_in, void* d_out, int out_size, void* d_ws,
                              size_t ws_size, hipStream_t stream) {
  Params p{};
  p.x = (const float*)d_in[0]; p.c = (const float*)d_in[1]; p.pos = (const int*)d_in[2];
  p.ada_w = (const float*)d_in[3]; p.ada_b = (const float*)d_in[4]; p.norm_mix_w = (const float*)d_in[5];
  p.norm_ffn_w = (const float*)d_in[6]; p.w_in = (const float*)d_in[7]; p.da_lambda = (const float*)d_in[8];
  p.da_subln_w = (const float*)d_in[9]; p.hg_lb = (const float*)d_in[10]; p.hg_norm_w = (const float*)d_in[11];
  p.rw_mu = (const float*)d_in[12]; p.rw_w0 = (const float*)d_in[13]; p.rw_w2 = (const float*)d_in[14];
  p.rw_a0 = (const float*)d_in[15]; p.rw_a2 = (const float*)d_in[16]; p.rw_g2 = (const float*)d_in[17];
  p.rw_k_k = (const float*)d_in[18]; p.rw_k_a = (const float*)d_in[19]; p.rw_r_k = (const float*)d_in[20];
  p.rw_gn_w = (const float*)d_in[21]; p.rw_gn_b = (const float*)d_in[22]; p.rw_v0 = (const float*)d_in[23];
  p.rw_v1 = (const float*)d_in[24]; p.rw_v2 = (const float*)d_in[25]; p.w_br_a = (const float*)d_in[26];
  p.w_br_b = (const float*)d_in[27]; p.w_br_c = (const float*)d_in[28]; p.w_out = (const float*)d_in[29];
  p.ffn_w_in = (const float*)d_in[30]; p.ffn_w_out = (const float*)d_in[31]; p.final_norm_w = (const float*)d_in[32];
  p.out = (float*)d_out;
  char* ws = (char*)d_ws;
  size_t off = 0;
  auto take = [&](size_t bytes) { char* r = ws + off; off += (bytes + 255) & ~(size_t)255; return r; };
  p.counters = (unsigned*)take(16384);
  p.wt = (bf16_t*)take(2 * WLAYER * 2);
  p.ada = (float*)take((size_t)2 * 32 * ADAW * 4);
  p.h = (bf16_t*)take((size_t)T_TOK * DM * 2);
  p.u = (bf16_t*)take((size_t)T_TOK * US * 2);
  p.vT = (bf16_t*)take((size_t)T_TOK * 512 * 2);
  p.vfirst = (bf16_t*)take((size_t)T_TOK * 512 * 2);
  p.vlo = (float*)take((size_t)T_TOK * 32 * 4);
  if (off > ws_size) { fprintf(stderr, "workspace too small: need %zu have %zu\n", off, ws_size); return; }

  static int grid_blocks = 0;
  if (!grid_blocks) {
    hipFuncSetAttribute((const void*)mega, hipFuncAttributeMaxDynamicSharedMemorySize, SMEM_BYTES);
    int dev = 0, cus = 0, per_cu = 0;
    hipGetDevice(&dev);
    hipDeviceGetAttribute(&cus, hipDeviceAttributeMultiprocessorCount, dev);
    hipOccupancyMaxActiveBlocksPerMultiprocessor(&per_cu, mega, 256, SMEM_BYTES);
    if (per_cu > 2) per_cu = 2;
    if (per_cu < 1) per_cu = 1;
    grid_blocks = cus * per_cu;
  }
#if SINGLE_LAUNCH
  int lo = 0, hi = NPHASE;
  void* args[] = {&p, &lo, &hi};
  hipError_t e = hipLaunchCooperativeKernel((void*)mega, dim3(grid_blocks), dim3(256), args, SMEM_BYTES, stream);
  if (e != hipSuccess) fprintf(stderr, "cooperative launch failed: %s (grid %d)\n", hipGetErrorString(e), grid_blocks);
#else
  for (int ph = 0; ph < NPHASE; ++ph) {
    if (ph == 3) continue;
    hipLaunchKernelGGL(mega, dim3(grid_blocks), dim3(256), SMEM_BYTES, stream, p, ph, ph + 1);
  }
#endif
}
```

```cpp
#include <hip/hip_runtime.h>
#include <hip/hip_cooperative_groups.h>
#include <stdint.h>
#include <cstdio>
namespace cg = cooperative_groups;

typedef unsigned short bf16_t;
typedef short bf16x8 __attribute__((ext_vector_type(8)));
typedef float f32x4 __attribute__((ext_vector_type(4)));
typedef float f32x2 __attribute__((ext_vector_type(2)));
#define DEV __device__ __forceinline__
#define PHASE __device__ __forceinline__

#ifndef SINGLE_LAUNCH
#define SINGLE_LAUNCH 1
#endif

constexpr int T_TOK = 65536, DM = 1024, SEQ = 2048, US = 4864, ADAW = 6144, FFH = 2816;
constexpr size_t WIN = 0, WBA = 8650752, WBB = 9175040, WBC = 9699328, WOUT = 10223616, WFI = 11272192,
                 WFO = 17039360, WLAYER = 19922944;
constexpr int SMEM_BYTES = 80896;
constexpr int NPHASE = 20;

struct Params {
  const float* x; const float* c; const int* pos;
  const float *ada_w, *ada_b, *norm_mix_w, *norm_ffn_w, *w_in, *da_lambda, *da_subln_w, *hg_lb, *hg_norm_w;
  const float *rw_mu, *rw_w0, *rw_w2, *rw_a0, *rw_a2, *rw_g2, *rw_k_k, *rw_k_a, *rw_r_k, *rw_gn_w, *rw_gn_b;
  const float *rw_v0, *rw_v1, *rw_v2, *w_br_a, *w_br_b, *w_br_c, *w_out, *ffn_w_in, *ffn_w_out, *final_norm_w;
  float* out;
  bf16_t* wt; float* ada; bf16_t* h; bf16_t* u; bf16_t* vT; bf16_t* vfirst; float* vlo; unsigned* counters;
};

DEV unsigned short f2bf(float f) { unsigned u = __float_as_uint(f); u += 0x7FFFu + ((u >> 16) & 1u); return (unsigned short)(u >> 16); }
DEV float bf2f(unsigned short h) { return __uint_as_float(((unsigned)h) << 16); }
DEV unsigned pack2(float a, float b) { return (unsigned)f2bf(a) | ((unsigned)f2bf(b) << 16); }
DEV float sigm(float x) { return 1.f / (1.f + __expf(-x)); }
DEV float lo16(unsigned v) { return __uint_as_float(v << 16); }
DEV float hi16(unsigned v) { return __uint_as_float(v & 0xFFFF0000u); }
#define UNPACK8(v, f) { f[0]=lo16(v.x); f[1]=hi16(v.x); f[2]=lo16(v.y); f[3]=hi16(v.y); f[4]=lo16(v.z); f[5]=hi16(v.z); f[6]=lo16(v.w); f[7]=hi16(v.w); }
#define PACK8(f) make_uint4(pack2(f[0],f[1]), pack2(f[2],f[3]), pack2(f[4],f[5]), pack2(f[6],f[7]))
template <int CTRL> DEV float dpp(float x) { return __int_as_float(__builtin_amdgcn_update_dpp(0, __float_as_int(x), CTRL, 0xF, 0xF, true)); }
DEV float red8_sum(float x) { x += dpp<0xB1>(x); x += dpp<0x4E>(x); x += dpp<0x141>(x); return x; }
DEV float red16_sum(float x) { x = red8_sum(x); x += dpp<0x140>(x); return x; }
DEV float red16_max(float x) { x = fmaxf(x, dpp<0xB1>(x)); x = fmaxf(x, dpp<0x4E>(x)); x = fmaxf(x, dpp<0x141>(x)); x = fmaxf(x, dpp<0x140>(x)); return x; }
DEV float wave_sum(float x) {
#pragma unroll
  for (int o = 32; o >= 1; o >>= 1) x += __shfl_xor(x, o, 64);
  return x;
}
DEV int opaque_tid() { int t = threadIdx.x; asm volatile("" : "+v"(t)); return t; }
DEV bf16x8 as_frag(uint4 v) { union { uint4 u; bf16x8 b; } c; c.u = v; return c.b; }
#define MFMA(a, b, c) __builtin_amdgcn_mfma_f32_16x16x32_bf16(a, b, c, 0, 0, 0)

template <int NT>
DEV void gemm_tile(const int tid, const bf16_t* A, int lda, const bf16_t* B, int ldb, int K, char* smem,
                   f32x4 (&acc)[4][NT]) {
  constexpr int BN = NT * 32;
  constexpr int LS = 64;
  bf16_t* As = (bf16_t*)smem;
  bf16_t* Bs = As + 2 * 128 * LS;
  const int lane = tid & 63, wave = tid >> 6, wr = wave >> 1, wc = wave & 1;
  const int fr = lane & 15, fq = lane >> 4;
  constexpr int NB = BN * 8 / 256;
#pragma unroll
  for (int m = 0; m < 4; ++m)
#pragma unroll
    for (int n = 0; n < NT; ++n) acc[m][n] = (f32x4){0.f, 0.f, 0.f, 0.f};
  const int nk = K >> 6;
  const int lrow = tid >> 3, lcc = tid & 7;
  const bf16_t* Ap = A + (size_t)lrow * lda + ((lcc ^ (lrow & 7)) * 8);
  const bf16_t* Bp = B + (size_t)lrow * ldb + ((lcc ^ (lrow & 7)) * 8);
  const size_t a32 = (size_t)32 * lda, b32 = (size_t)32 * ldb;
  const int rofs0 = (fq ^ (fr & 7)) * 8, rofs1 = rofs0 ^ 32;
#define GT_DMA(buf, koff)                                                                                    \
  {                                                                                                          \
    bf16_t* Ad = As + (buf) * 128 * LS + tid * 8;                                                            \
    bf16_t* Bd = Bs + (buf) * BN * LS + tid * 8;                                                             \
    _Pragma("unroll") for (int i = 0; i < 4; ++i)                                                            \
      __builtin_amdgcn_global_load_lds((const unsigned*)(Ap + i * a32 + (koff)), (unsigned*)(Ad + i * 32 * LS), 16, 0, 0); \
    _Pragma("unroll") for (int i = 0; i < NB; ++i)                                                           \
      __builtin_amdgcn_global_load_lds((const unsigned*)(Bp + i * b32 + (koff)), (unsigned*)(Bd + i * 32 * LS), 16, 0, 0); \
  }
  GT_DMA(0, 0)
  asm volatile("s_waitcnt vmcnt(0)" ::: "memory");
  __syncthreads();
  for (int kt = 0; kt < nk; ++kt) {
    const int buf = kt & 1;
    if (kt + 1 < nk) GT_DMA(buf ^ 1, (kt + 1) * 64)
    const bf16_t* Ab = As + buf * 128 * LS + (wr * 64 + fr) * LS;
    const bf16_t* Bb = Bs + buf * BN * LS + (wc * (NT * 16) + fr) * LS;
#pragma unroll
    for (int ks = 0; ks < 2; ++ks) {
      const int ro = ks ? rofs1 : rofs0;
      bf16x8 af[4], bfr[NT];
#pragma unroll
      for (int m = 0; m < 4; ++m) af[m] = *(const bf16x8*)(Ab + m * 16 * LS + ro);
#pragma unroll
      for (int n = 0; n < NT; ++n) bfr[n] = *(const bf16x8*)(Bb + n * 16 * LS + ro);
#pragma unroll
      for (int m = 0; m < 4; ++m)
#pragma unroll
        for (int n = 0; n < NT; ++n) acc[m][n] = MFMA(af[m], bfr[n], acc[m][n]);
    }
    asm volatile("s_waitcnt vmcnt(0)" ::: "memory");
    __syncthreads();
  }
#undef GT_DMA
}

template <int NT>
DEV void stage_acc(const int tid, float* Cs, const f32x4 (&acc)[4][NT]) {
  constexpr int LDC = NT * 32 + 4;
  const int lane = tid & 63, wave = tid >> 6, wr = wave >> 1, wc = wave & 1, fr = lane & 15, fq = lane >> 4;
#pragma unroll
  for (int m = 0; m < 4; ++m)
#pragma unroll
    for (int n = 0; n < NT; ++n)
#pragma unroll
      for (int j = 0; j < 4; ++j) Cs[(wr * 64 + m * 16 + fq * 4 + j) * LDC + wc * (NT * 16) + n * 16 + fr] = acc[m][n][j];
}

DEV void gemm_tile256(const int tid, const bf16_t* A, int lda, const bf16_t* B, int ldb, int K, char* smem,
                      f32x4 (&acc)[8][4]) {
  bf16_t* As = (bf16_t*)smem;
  bf16_t* Bs = As + 3 * 8192;
  const int lane = tid & 63, wave = tid >> 6, wr = wave >> 1, wc = wave & 1;
  const int fr = lane & 15, fq = lane >> 4;
#pragma unroll
  for (int m = 0; m < 8; ++m)
#pragma unroll
    for (int n = 0; n < 4; ++n) acc[m][n] = (f32x4){0.f, 0.f, 0.f, 0.f};
  const int nk = K >> 5;
  const int drow = tid >> 2, dphys = tid & 3, dg = (0 - (tid >> 4)) & 3;
  const bf16_t* Ap = A + (size_t)drow * lda + ((dphys ^ dg) * 8);
  const bf16_t* Bp = B + (size_t)drow * ldb + ((dphys ^ dg) * 8);
  const size_t a64 = (size_t)64 * lda, b64 = (size_t)64 * ldb;
  const int rofs = (fq ^ ((0 - (fr >> 2)) & 3)) * 8;
#define G2_DMA(st, kk)                                                                                        \
  {                                                                                                           \
    bf16_t* Ad = As + (st) * 8192 + tid * 8;                                                                  \
    bf16_t* Bd = Bs + (st) * 4096 + tid * 8;                                                                  \
    _Pragma("unroll") for (int i = 0; i < 4; ++i)                                                             \
      __builtin_amdgcn_global_load_lds((const unsigned*)(Ap + i * a64 + (kk) * 32), (unsigned*)(Ad + i * 2048), 16, 0, 0); \
    _Pragma("unroll") for (int i = 0; i < 2; ++i)                                                             \
      __builtin_amdgcn_global_load_lds((const unsigned*)(Bp + i * b64 + (kk) * 32), (unsigned*)(Bd + i * 2048), 16, 0, 0); \
  }
  G2_DMA(0, 0)
  G2_DMA(1, 1)
  int st = 0;
  for (int kt = 0; kt < nk; ++kt) {
    if (kt + 1 < nk) asm volatile("s_waitcnt vmcnt(6)" ::: "memory");
    else asm volatile("s_waitcnt vmcnt(0)" ::: "memory");
    __builtin_amdgcn_s_barrier();
    asm volatile("" ::: "memory");
    const int s2 = (st >= 1) ? st - 1 : 2;
    const bool pf = (kt + 2 < nk);
    bf16_t* Ad = As + s2 * 8192 + tid * 8;
    bf16_t* Bd = Bs + s2 * 4096 + tid * 8;
    const bf16_t* Asrc = Ap + (kt + 2) * 32;
    const bf16_t* Bsrc = Bp + (kt + 2) * 32;
    const bf16_t* Ab = As + st * 8192 + (wr * 128 + fr) * 32 + rofs;
    const bf16_t* Bb = Bs + st * 4096 + (wc * 64 + fr) * 32 + rofs;
    bf16x8 bfr[4], af[4];
#pragma unroll
    for (int n = 0; n < 4; ++n) bfr[n] = *(const bf16x8*)(Bb + n * 512);
#pragma unroll
    for (int m = 0; m < 4; ++m) af[m] = *(const bf16x8*)(Ab + m * 512);
#pragma unroll
    for (int m = 0; m < 8; ++m) {
#pragma unroll
      for (int n = 0; n < 4; ++n) acc[m][n] = MFMA(af[m & 3], bfr[n], acc[m][n]);
      if (m + 4 < 8) af[m & 3] = *(const bf16x8*)(Ab + (m + 4) * 512);
      if (pf) {
        if (m < 4) __builtin_amdgcn_global_load_lds((const unsigned*)(Asrc + m * a64), (unsigned*)(Ad + m * 2048), 16, 0, 0);
        else if (m < 6) __builtin_amdgcn_global_load_lds((const unsigned*)(Bsrc + (m - 4) * b64), (unsigned*)(Bd + (m - 4) * 2048), 16, 0, 0);
      }
      __builtin_amdgcn_sched_barrier(0);
    }
    st = (st == 2) ? 0 : st + 1;
  }
#undef G2_DMA
  __syncthreads();
}

template <int PS>
DEV void stage_half(const int tid, float* Cs, const f32x4 (&acc)[8][4]) {
  const int lane = tid & 63, wave = tid >> 6, wr = wave >> 1, wc = wave & 1, fr = lane & 15, fq = lane >> 4;
#pragma unroll
  for (int m = 0; m < 4; ++m)
#pragma unroll
    for (int n = 0; n < 4; ++n)
#pragma unroll
      for (int j = 0; j < 4; ++j) Cs[(wr * 64 + m * 16 + fq * 4 + j) * 132 + wc * 64 + n * 16 + fr] = acc[PS * 4 + m][n][j];
}
#define RMAP(r, ps) ((((r) >> 6) << 7) + (ps) * 64 + ((r) & 63))

DEV bool tile_for(int it, int nM, int nN, int& tm, int& tn) {
  const int nx = gridDim.x >> 3;
  const int xcd = blockIdx.x & 7, local = blockIdx.x >> 3;
  const long id = ((long)it * 8 + xcd) * nx + local;
  if (local >= nx || id >= (long)nM * nN) return false;
  const int per_group = 8 * nN;
  const int g = (int)(id / per_group), r = (int)(id % per_group);
  tn = r >> 3; tm = g * 8 + (r & 7);
  return true;
}

PHASE void phase_prep(const Params& p, char* smem) {
  const int tid = opaque_tid();
  if (blockIdx.x == 0 && tid < 8) p.counters[tid] = 0u;
  if (blockIdx.x == 0) for (int i = tid; i < 3456; i += 256) p.counters[256 + i] = 0u;
  float* tile = (float*)smem;
  const int NCONV = 2 * 4864, NADA = 192;
  for (int item0 = blockIdx.x; item0 < NCONV + NADA; item0 += gridDim.x) {
    const int item = (item0 < NADA) ? (NCONV + item0) : (item0 - NADA);
    if (item < NCONV) {
      const int l = item / 4864; int r = item % 4864;
      const float* src; int K, Nsrc, nT, perm = 0; size_t dst;
      if (r < 2112) { src = p.w_in + (size_t)l * 1024 * 8448; K = 1024; Nsrc = 8448; dst = WIN; nT = 132; }
      else if (r < 2240) { r -= 2112; src = p.w_br_a + (size_t)l * 512 * 1024; K = 512; Nsrc = 1024; dst = WBA; nT = 16; }
      else if (r < 2368) { r -= 2240; src = p.w_br_b + (size_t)l * 512 * 1024; K = 512; Nsrc = 1024; dst = WBB; nT = 16; }
      else if (r < 2496) { r -= 2368; src = p.w_br_c + (size_t)l * 512 * 1024; K = 512; Nsrc = 1024; dst = WBC; nT = 16; }
      else if (r < 2752) { r -= 2496; src = p.w_out + (size_t)l * 1024 * 1024; K = 1024; Nsrc = 1024; dst = WOUT; nT = 16; }
      else if (r < 4160) { r -= 2752; src = p.ffn_w_in + (size_t)l * 1024 * 5632; K = 1024; Nsrc = 5632; dst = WFI; nT = 88; perm = 1; }
      else { r -= 4160; src = p.ffn_w_out + (size_t)l * 2816 * 1024; K = 2816; Nsrc = 1024; dst = WFO; nT = 16; }
      const int kt = r / nT, nt = r % nT;
      const int colbase = perm ? ((nt & 1) * FFH + 64 * (nt >> 1)) : nt * 64;
      __syncthreads();
#pragma unroll
      for (int i = 0; i < 16; ++i) {
        const int k = i * 4 + (tid >> 6), j = tid & 63;
        tile[k * 65 + j] = src[(size_t)(kt * 64 + k) * Nsrc + colbase + j];
      }
      __syncthreads();
      const int row = tid >> 2, kc = (tid & 3) * 16;
      float f[16];
#pragma unroll
      for (int i = 0; i < 16; ++i) f[i] = tile[(kc + i) * 65 + row];
      bf16_t* d = p.wt + (size_t)l * WLAYER + dst + (size_t)(nt * 64 + row) * K + kt * 64 + kc;
      *(uint4*)d = make_uint4(pack2(f[0], f[1]), pack2(f[2], f[3]), pack2(f[4], f[5]), pack2(f[6], f[7]));
      *(uint4*)(d + 8) = make_uint4(pack2(f[8], f[9]), pack2(f[10], f[11]), pack2(f[12], f[13]), pack2(f[14], f[15]));
    } else {
      const int a = item - NCONV;
      const int l = a / 96, r = a % 96, ntile = r >> 2, bg = r & 3;
      float* cact = (float*)smem;
      __syncthreads();
      for (int i = tid; i < 8 * 1024; i += 256) {
        const float cv = p.c[(size_t)(bg * 8 + (i >> 10)) * DM + (i & 1023)];
        cact[i] = cv * sigm(cv);
      }
      __syncthreads();
      const int n = ntile * 256 + tid;
      const float* W = p.ada_w + (size_t)l * DM * ADAW + n;
      float acc[8];
#pragma unroll
      for (int b = 0; b < 8; ++b) acc[b] = 0.f;
      for (int k0 = 0; k0 < DM; k0 += 16) {
        float w[16];
#pragma unroll
        for (int kk = 0; kk < 16; ++kk) w[kk] = W[(size_t)(k0 + kk) * ADAW];
#pragma unroll
        for (int kk = 0; kk < 16; ++kk)
#pragma unroll
          for (int b = 0; b < 8; ++b) acc[b] += cact[b * 1024 + k0 + kk] * w[kk];
      }
      const float bias = p.ada_b[l * ADAW + n];
#pragma unroll
      for (int b = 0; b < 8; ++b) p.ada[((size_t)l * 32 + bg * 8 + b) * ADAW + n] = acc[b] + bias;
    }
  }
}

PHASE void phase_norm(const float* __restrict__ x, const float* __restrict__ w, const float* __restrict__ ada_l,
                    int shift_off, int scale_off, bf16_t* __restrict__ h) {
  const int tid = opaque_tid();
  const int lane = tid & 63, wave = tid >> 6;
  for (int row = blockIdx.x * 4 + wave; row < T_TOK; row += gridDim.x * 4) {
    const float* xr = x + (size_t)row * DM;
    float4 v[4]; float ss = 0.f;
#pragma unroll
    for (int i = 0; i < 4; ++i) { v[i] = *(const float4*)(xr + i * 256 + lane * 4); ss += v[i].x * v[i].x + v[i].y * v[i].y + v[i].z * v[i].z + v[i].w * v[i].w; }
    ss = wave_sum(ss);
    const float rstd = rsqrtf(ss * (1.f / DM) + 1e-6f);
    const float* ad = ada_l + (size_t)(row / SEQ) * ADAW;
#pragma unroll
    for (int i = 0; i < 4; ++i) {
      const int col = i * 256 + lane * 4;
      const float4 ww = *(const float4*)(w + col), sc = *(const float4*)(ad + scale_off + col), sh = *(const float4*)(ad + shift_off + col);
      const float o0 = v[i].x * rstd * ww.x * (1.f + sc.x) + sh.x, o1 = v[i].y * rstd * ww.y * (1.f + sc.y) + sh.y;
      const float o2 = v[i].z * rstd * ww.z * (1.f + sc.z) + sh.z, o3 = v[i].w * rstd * ww.w * (1.f + sc.w) + sh.w;
      *(uint2*)(h + (size_t)row * DM + col) = make_uint2(pack2(o0, o1), pack2(o2, o3));
    }
  }
}

PHASE void phase_final(float* __restrict__ x, const float* __restrict__ w) {
  const int tid = opaque_tid();
  const int lane = tid & 63, wave = tid >> 6;
  for (int row = blockIdx.x * 4 + wave; row < T_TOK; row += gridDim.x * 4) {
    float* xr = x + (size_t)row * DM;
    float4 v[4]; float ss = 0.f;
#pragma unroll
    for (int i = 0; i < 4; ++i) { v[i] = *(const float4*)(xr + i * 256 + lane * 4); ss += v[i].x * v[i].x + v[i].y * v[i].y + v[i].z * v[i].z + v[i].w * v[i].w; }
    ss = wave_sum(ss);
    const float rstd = rsqrtf(ss * (1.f / DM) + 1e-6f);
#pragma unroll
    for (int i = 0; i < 4; ++i) {
      const int col = i * 256 + lane * 4;
      const float4 ww = *(const float4*)(w + col);
      *(float4*)(xr + col) = make_float4(v[i].x * rstd * ww.x, v[i].y * rstd * ww.y, v[i].z * rstd * ww.z, v[i].w * rstd * ww.w);
    }
  }
}

PHASE void phase_gemm_in(const Params& p, int l, char* smem) {
  const bf16_t* Wt = p.wt + (size_t)l * WLAYER + WIN;
  float* Cs = (float*)smem;
  const int tid = opaque_tid();
  for (int it = 0;; ++it) {
    int tm, tn;
    if (!tile_for(it, 256, 42, tm, tn)) break;
    f32x4 acc[8][4];
    gemm_tile256(tid, p.h + (size_t)tm * 256 * DM, DM, Wt + (size_t)tn * 128 * DM, DM, DM, smem, acc);
    const size_t row0 = (size_t)tm * 256;
#pragma unroll
    for (int ps = 0; ps < 2; ++ps) {
      if (ps == 0) stage_half<0>(tid, Cs, acc); else stage_half<1>(tid, Cs, acc);
      __syncthreads();
      if (tn < 8) {
        const float qs = (tn < 4) ? 0.125f : 1.f;
        const int ch = tid & 15, g = ch >> 3, cc = ch & 7;
        if (cc < 4) {
#pragma unroll 1
          for (int i = 0; i < 8; ++i) {
            const int r = (tid >> 4) + i * 16;
            const size_t grow = row0 + RMAP(r, ps);
            const float pos = (float)p.pos[grow];
            const float* c1 = Cs + r * 132 + g * 64 + cc * 8;
            float o1[8], o2[8];
#pragma unroll
            for (int e = 0; e < 8; ++e) {
              const float x1 = c1[e], x2 = c1[32 + e];
              const float inv = exp2f(-(float)(cc * 8 + e) * 0.41524101186092029f);
              float rev = pos * inv * 0.15915494309189535f;
              rev -= rintf(rev);
              const float sn = __builtin_amdgcn_sinf(rev), cs = __builtin_amdgcn_cosf(rev);
              o1[e] = (x1 * cs - x2 * sn) * qs; o2[e] = (x2 * cs + x1 * sn) * qs;
            }
            bf16_t* d = p.u + grow * US + tn * 128 + g * 64 + cc * 8;
            *(uint4*)d = PACK8(o1);
            *(uint4*)(d + 32) = PACK8(o2);
          }
        }
      } else if (tn < 12) {
        const int b = (int)(row0 / SEQ), s0 = (int)(row0 % SEQ), vc0 = (tn - 8) * 128;
        const int rch = tid & 15;
#pragma unroll 1
        for (int i = 0; i < 8; ++i) {
          const int c = (tid >> 4) + i * 16;
          float f[8];
#pragma unroll
          for (int j = 0; j < 8; ++j) f[j] = Cs[(rch * 8 + j) * 132 + c];
          *(uint4*)(p.vT + ((size_t)b * 512 + vc0 + c) * SEQ + s0 + RMAP(rch * 8, ps)) = PACK8(f);
        }
      } else {
        const int ch = tid & 15;
#pragma unroll 1
        for (int i = 0; i < 8; ++i) {
          const int r = (tid >> 4) + i * 16;
          const float4 a = *(const float4*)(Cs + r * 132 + ch * 8), b = *(const float4*)(Cs + r * 132 + ch * 8 + 4);
          *(uint4*)(p.u + (row0 + RMAP(r, ps)) * US + tn * 128 - 512 + ch * 8) = make_uint4(pack2(a.x, a.y), pack2(a.z, a.w), pack2(b.x, b.y), pack2(b.z, b.w));
        }
      }
      __syncthreads();
    }
  }
}

PHASE void phase_vlo(const Params& p, int l, char* smem) {
  float* vs = (float*)smem;
  const int tid = opaque_tid();
  const float* mu = p.rw_mu + (size_t)l * 1792 + 1024;
  const float* v1 = p.rw_v1;
  for (int item = blockIdx.x; item < T_TOK / 32; item += gridDim.x) {
    const size_t tok0 = (size_t)item * 32;
    __syncthreads();
#pragma unroll 1
    for (int i = 0; i < 8; ++i) {
      const int c = tid + i * 256;
      const int t = c >> 6, cc = c & 63;
      const size_t tok = tok0 + t;
      const uint4 cur = *(const uint4*)(p.u + tok * US + 3072 + 1024 + cc * 8);
      uint4 prv = make_uint4(0, 0, 0, 0);
      if ((tok % SEQ) != 0) prv = *(const uint4*)(p.u + (tok - 1) * US + 3072 + 1024 + cc * 8);
      float a[8], b[8];
      UNPACK8(cur, a); UNPACK8(prv, b);
#pragma unroll
      for (int e = 0; e < 8; ++e) vs[t * 512 + cc * 8 + e] = a[e] + (b[e] - a[e]) * mu[cc * 8 + e];
    }
    __syncthreads();
    const int j = tid & 31, tg = tid >> 5;
    float acc[4] = {0.f, 0.f, 0.f, 0.f};
    for (int k0 = 0; k0 < 512; k0 += 16) {
      float w[16];
#pragma unroll
      for (int kk = 0; kk < 16; ++kk) w[kk] = v1[(k0 + kk) * 32 + j];
#pragma unroll
      for (int kk = 0; kk < 16; ++kk)
#pragma unroll
        for (int i = 0; i < 4; ++i) acc[i] += vs[(tg * 4 + i) * 512 + k0 + kk] * w[kk];
    }
#pragma unroll
    for (int i = 0; i < 4; ++i) p.vlo[(tok0 + tg * 4 + i) * 32 + j] = acc[i];
  }
}

PHASE void att_item(const Params& p, int l, int item, char* smem) {
  const int qc = 31 - (item >> 7);
  const int bh = item & 127, b = bh >> 2, h = bh & 3;
  const int tid = opaque_tid(), lane = tid & 63, wave = tid >> 6, fr = lane & 15, fq = lane >> 4;
  const int m = wave >> 1, rh = wave & 1;
  bf16_t* Ks = (bf16_t*)smem;
  bf16_t* Vt = Ks + 2 * 64 * 64;
  bf16_t* Ps = Vt + 128 * 64;
  float* Ox = (float*)smem;
  const size_t tok0 = (size_t)b * SEQ + (size_t)qc * 64;
  const float* lv = p.da_lambda + (size_t)l * 256;
  float d1 = 0.f, d2 = 0.f;
  for (int i = 0; i < 64; ++i) { d1 += lv[i] * lv[64 + i]; d2 += lv[128 + i] * lv[192 + i]; }
  const float lam_init = 0.8f - 0.6f * __expf(-0.3f * (float)l);
  const float lam = __expf(d1) - __expf(d2) + lam_init;

  bf16x8 qf[2][2];
#pragma unroll
  for (int mt = 0; mt < 2; ++mt)
#pragma unroll
    for (int ks = 0; ks < 2; ++ks)
      qf[mt][ks] = *(const bf16x8*)(p.u + (tok0 + rh * 32 + mt * 16 + fr) * US + h * 128 + m * 64 + ks * 32 + fq * 8);
  f32x4 o[2][8];
  float mx[2][4], ls[2][4];
#pragma unroll
  for (int mt = 0; mt < 2; ++mt) {
#pragma unroll
    for (int n = 0; n < 8; ++n) o[mt][n] = (f32x4){0.f, 0.f, 0.f, 0.f};
#pragma unroll
    for (int j = 0; j < 4; ++j) { mx[mt][j] = -1e30f; ls[mt][j] = 0.f; }
  }
  bf16_t* Pw = Ps + wave * 32 * 72;
  const int drow = tid >> 3, dlog = ((tid & 7) ^ ((tid >> 3) & 7)) * 8;
  const bf16_t* Kg = p.u + ((size_t)b * SEQ + (drow & 63)) * US + 512 + h * 128 + dlog;
  const bf16_t* Vg = p.vT + ((size_t)b * 512 + h * 128 + drow) * SEQ + dlog;
  const int rsw = fr & 7;
#define ATT_DMA_K(kt_)                                                                                              \
  _Pragma("unroll") for (int i = 0; i < 4; ++i)                                                                     \
    __builtin_amdgcn_global_load_lds((const unsigned*)(Kg + ((size_t)(kt_) * 64 + (i & 1) * 32) * US + (i >> 1) * 64), \
                                     (unsigned*)(Ks + tid * 8 + i * 2048), 16, 0, 0);
#define ATT_DMA_V(kt_)                                                                                              \
  _Pragma("unroll") for (int i = 0; i < 4; ++i)                                                                     \
    __builtin_amdgcn_global_load_lds((const unsigned*)(Vg + (size_t)(i * 32) * SEQ + (kt_) * 64),                  \
                                     (unsigned*)(Vt + tid * 8 + i * 2048), 16, 0, 0);
  __syncthreads();
  ATT_DMA_K(0)
  for (int kt = 0; kt <= qc; ++kt) {
    asm volatile("s_waitcnt vmcnt(0)" ::: "memory");
    __syncthreads();
    ATT_DMA_V(kt)
    f32x4 s[2][4];
#pragma unroll
    for (int mt = 0; mt < 2; ++mt)
#pragma unroll
      for (int n = 0; n < 4; ++n) s[mt][n] = (f32x4){0.f, 0.f, 0.f, 0.f};
#pragma unroll
    for (int ks = 0; ks < 2; ++ks)
#pragma unroll
      for (int n = 0; n < 4; ++n) {
        const bf16x8 kf = *(const bf16x8*)(Ks + (m * 64 + n * 16 + fr) * 64 + (((ks * 4 + fq) ^ rsw) * 8));
#pragma unroll
        for (int mt = 0; mt < 2; ++mt) s[mt][n] = MFMA(qf[mt][ks], kf, s[mt][n]);
      }
#pragma unroll
    for (int mt = 0; mt < 2; ++mt)
#pragma unroll
      for (int j = 0; j < 4; ++j) {
        float tmax = fmaxf(fmaxf(s[mt][0][j], s[mt][1][j]), fmaxf(s[mt][2][j], s[mt][3][j]));
        tmax = red16_max(tmax);
        const float mnew = fmaxf(mx[mt][j], tmax);
        const float alpha = __expf(mx[mt][j] - mnew);
        float rs = 0.f;
#pragma unroll
        for (int n = 0; n < 4; ++n) {
          const float pv = __expf(s[mt][n][j] - mnew);
          rs += pv;
          Pw[(mt * 16 + fq * 4 + j) * 72 + n * 16 + fr] = f2bf(pv);
        }
        rs = red16_sum(rs);
        ls[mt][j] = ls[mt][j] * alpha + rs;
        mx[mt][j] = mnew;
#pragma unroll
        for (int n = 0; n < 8; ++n) o[mt][n][j] *= alpha;
      }
    asm volatile("s_waitcnt vmcnt(0)" ::: "memory");
    __syncthreads();
    if (kt < qc) { ATT_DMA_K(kt + 1) }
#pragma unroll
    for (int ks = 0; ks < 2; ++ks) {
      bf16x8 pf[2];
#pragma unroll
      for (int mt = 0; mt < 2; ++mt) pf[mt] = *(const bf16x8*)(Pw + (mt * 16 + fr) * 72 + ks * 32 + fq * 8);
#pragma unroll
      for (int n = 0; n < 8; ++n) {
        const bf16x8 vf = *(const bf16x8*)(Vt + (n * 16 + fr) * 64 + (((ks * 4 + fq) ^ rsw) * 8));
#pragma unroll
        for (int mt = 0; mt < 2; ++mt) o[mt][n] = MFMA(pf[mt], vf, o[mt][n]);
      }
    }
  }
#undef ATT_DMA_K
#undef ATT_DMA_V
  __syncthreads();
#pragma unroll
  for (int mt = 0; mt < 2; ++mt)
#pragma unroll
    for (int j = 0; j < 4; ++j) {
      const float inv = 1.f / ls[mt][j];
#pragma unroll
      for (int n = 0; n < 8; ++n) o[mt][n][j] *= inv;
    }
  if (m == 1) {
#pragma unroll
    for (int mt = 0; mt < 2; ++mt)
#pragma unroll
      for (int n = 0; n < 8; ++n)
#pragma unroll
        for (int j = 0; j < 4; ++j) Ox[(rh * 32 + mt * 16 + fq * 4 + j) * 132 + n * 16 + fr] = o[mt][n][j];
  }
  __syncthreads();
  if (m == 0) {
    const float* sw = p.da_subln_w + (size_t)l * 128;
    float wv[8];
#pragma unroll
    for (int n = 0; n < 8; ++n) wv[n] = sw[n * 16 + fr] * (1.f - lam_init);
#pragma unroll
    for (int mt = 0; mt < 2; ++mt)
#pragma unroll
      for (int j = 0; j < 4; ++j) {
        float ss = 0.f;
        float d[8];
#pragma unroll
        for (int n = 0; n < 8; ++n) {
          d[n] = o[mt][n][j] - lam * Ox[(rh * 32 + mt * 16 + fq * 4 + j) * 132 + n * 16 + fr];
          ss += d[n] * d[n];
        }
        ss = red16_sum(ss);
        const float rstd = rsqrtf(ss * (1.f / 128.f) + 1e-6f);
        bf16_t* dst = p.u + (tok0 + rh * 32 + mt * 16 + fq * 4 + j) * US + h * 128 + fr;
#pragma unroll
        for (int n = 0; n < 8; ++n) dst[n * 16] = f2bf(d[n] * rstd * wv[n]);
      }
  }
  __syncthreads();
}

PHASE void hgrn_item(const Params& p, int l, int item, char* smem) {
  const int b = item >> 2, h = item & 3;
  const int tid = opaque_tid(), lane = tid & 63, wave = tid >> 6, fr = lane & 15, fq = lane >> 4;
  bf16_t* Qs = (bf16_t*)smem;
  bf16_t* Kn = Qs + 32 * 136;
  bf16_t* KT = Kn + 32 * 136;
  bf16_t* VT = KT + 128 * 40;
  bf16_t* Ps = VT + 128 * 40;
  bf16_t* ST = Ps + 32 * 40;
  float* lfb = (float*)ST;
  float* red = (float*)(ST + 128 * 136);
  float* blast = red + 64;
  const int t_ = tid >> 3, d0 = (tid & 7) * 16;
  float lbv[16];
#pragma unroll
  for (int i = 0; i < 16; ++i) {
    const int c = h * 128 + d0 + i;
    lbv[i] = (l == 0) ? 0.f : sigm(p.hg_lb[512 + c] - p.hg_lb[c]);
  }
  f32x4 S[2][8];
#pragma unroll
  for (int mm = 0; mm < 2; ++mm)
#pragma unroll
    for (int n = 0; n < 8; ++n) S[mm][n] = (f32x4){0.f, 0.f, 0.f, 0.f};
  const float* nw = p.hg_norm_w + (size_t)l * 128;

  for (int ch = 0; ch < 64; ++ch) {
    const size_t tok0 = (size_t)b * SEQ + (size_t)ch * 32;
    __syncthreads();
    float qv[16], kv[16];
    {
      const bf16_t* base = p.u + (tok0 + t_) * US + h * 128 + d0;
      float zv[16], iv[16];
      { const uint4 a = *(const uint4*)(base + 1024), c = *(const uint4*)(base + 1024 + 8); float* z0 = zv; float* z1 = zv + 8; UNPACK8(a, z0); UNPACK8(c, z1); }
      { const uint4 a = *(const uint4*)(base + 1536), c = *(const uint4*)(base + 1536 + 8); float* z0 = iv; float* z1 = iv + 8; UNPACK8(a, z0); UNPACK8(c, z1); }
      { const uint4 a = *(const uint4*)(base + 2048), c = *(const uint4*)(base + 2048 + 8); float* z0 = qv; float* z1 = qv + 8; UNPACK8(a, z0); UNPACK8(c, z1); }
#pragma unroll
      for (int i = 0; i < 16; ++i) {
        const float z = zv[i], lb = lbv[i];
        const float ez = __expf(-fabsf(z));
        float lf;
        if (lb > 0.f) {
          const float sg = (z >= 0.f) ? 1.f / (1.f + ez) : ez / (1.f + ez);
          lf = __logf(lb + (1.f - lb) * sg);
        } else {
          lf = -(fmaxf(-z, 0.f) + __logf(1.f + ez));
        }
        const float sgn = (z >= 0.f) ? ez / (1.f + ez) : 1.f / (1.f + ez);
        kv[i] = (1.f - lb) * sgn;
        lfb[t_ * 128 + d0 + i] = lf;
        VT[(d0 + i) * 40 + t_] = f2bf(iv[i]);
      }
    }
    __syncthreads();
    if (tid < 128) {
      float v[32];
#pragma unroll
      for (int t = 0; t < 32; ++t) v[t] = lfb[t * 128 + tid];
      float bsum = 0.f;
#pragma unroll
      for (int t = 0; t < 32; ++t) { bsum += v[t]; lfb[t * 128 + tid] = bsum; }
      blast[tid] = bsum;
    }
    __syncthreads();
    {
      float qo[16], ko[16];
#pragma unroll
      for (int i = 0; i < 16; ++i) {
        const float bb = lfb[t_ * 128 + d0 + i];
        qo[i] = qv[i] * __expf(bb);
        ko[i] = kv[i] * __expf(fminf(-bb, 80.f));
        KT[(d0 + i) * 40 + t_] = f2bf(ko[i]);
      }
      float* q0 = qo; float* q1 = qo + 8; float* k0 = ko; float* k1 = ko + 8;
      *(uint4*)(Qs + t_ * 136 + d0) = PACK8(q0);
      *(uint4*)(Qs + t_ * 136 + d0 + 8) = PACK8(q1);
      *(uint4*)(Kn + t_ * 136 + d0) = PACK8(k0);
      *(uint4*)(Kn + t_ * 136 + d0 + 8) = PACK8(k1);
    }
    __syncthreads();
#pragma unroll
    for (int mm = 0; mm < 2; ++mm)
#pragma unroll
      for (int n = 0; n < 8; ++n)
        *(uint2*)(ST + (n * 16 + fr) * 136 + wave * 32 + mm * 16 + fq * 4) =
            make_uint2(pack2(S[mm][n][0], S[mm][n][1]), pack2(S[mm][n][2], S[mm][n][3]));
    {
      const int mt = wave >> 1, nt = wave & 1;
      f32x4 sc = (f32x4){0.f, 0.f, 0.f, 0.f};
#pragma unroll
      for (int ks = 0; ks < 4; ++ks) {
        const bf16x8 a = *(const bf16x8*)(Qs + (mt * 16 + fr) * 136 + ks * 32 + fq * 8);
        const bf16x8 bb = *(const bf16x8*)(Kn + (nt * 16 + fr) * 136 + ks * 32 + fq * 8);
        sc = MFMA(a, bb, sc);
      }
#pragma unroll
      for (int j = 0; j < 4; ++j) {
        const int t = mt * 16 + fq * 4 + j, key = nt * 16 + fr;
        Ps[t * 40 + key] = f2bf(key <= t ? sc[j] : 0.f);
      }
    }
    __syncthreads();
    {
      const int mt = wave & 1, nb = (wave >> 1) * 4;
      f32x4 oo[4];
#pragma unroll
      for (int n = 0; n < 4; ++n) oo[n] = (f32x4){0.f, 0.f, 0.f, 0.f};
      {
        const bf16x8 a = *(const bf16x8*)(Ps + (mt * 16 + fr) * 40 + fq * 8);
#pragma unroll
        for (int n = 0; n < 4; ++n) {
          const bf16x8 bb = *(const bf16x8*)(VT + ((nb + n) * 16 + fr) * 40 + fq * 8);
          oo[n] = MFMA(a, bb, oo[n]);
        }
      }
#pragma unroll
      for (int ks = 0; ks < 4; ++ks) {
        const bf16x8 a = *(const bf16x8*)(Qs + (mt * 16 + fr) * 136 + ks * 32 + fq * 8);
#pragma unroll
        for (int n = 0; n < 4; ++n) {
          const bf16x8 bb = *(const bf16x8*)(ST + ((nb + n) * 16 + fr) * 136 + ks * 32 + fq * 8);
          oo[n] = MFMA(a, bb, oo[n]);
        }
      }
#pragma unroll
      for (int j = 0; j < 4; ++j) {
        float ss = 0.f;
#pragma unroll
        for (int n = 0; n < 4; ++n) ss += oo[n][j] * oo[n][j];
        ss = red16_sum(ss);
        if (fr == 0) red[(mt * 16 + fq * 4 + j) * 2 + (wave >> 1)] = ss;
      }
      __syncthreads();
#pragma unroll
      for (int j = 0; j < 4; ++j) {
        const int t = mt * 16 + fq * 4 + j;
        const float rstd = rsqrtf((red[t * 2] + red[t * 2 + 1]) * (1.f / 128.f) + 1e-6f);
        bf16_t* gp = p.u + (tok0 + t) * US + 2560 + h * 128 + nb * 16 + fr;
#pragma unroll
        for (int n = 0; n < 4; ++n) {
          const float g = bf2f(gp[n * 16]);
          gp[n * 16] = f2bf(oo[n][j] * rstd * nw[(nb + n) * 16 + fr] * (g * sigm(g)));
        }
      }
    }
    {
      bf16x8 af[2];
#pragma unroll
      for (int mm = 0; mm < 2; ++mm) af[mm] = *(const bf16x8*)(KT + (wave * 32 + mm * 16 + fr) * 40 + fq * 8);
#pragma unroll
      for (int n = 0; n < 8; ++n) {
        const bf16x8 bb = *(const bf16x8*)(VT + (n * 16 + fr) * 40 + fq * 8);
#pragma unroll
        for (int mm = 0; mm < 2; ++mm) S[mm][n] = MFMA(af[mm], bb, S[mm][n]);
      }
#pragma unroll
      for (int mm = 0; mm < 2; ++mm)
#pragma unroll
        for (int j = 0; j < 4; ++j) {
          const float e = __expf(blast[wave * 32 + mm * 16 + fq * 4 + j]);
#pragma unroll
          for (int n = 0; n < 8; ++n) S[mm][n][j] *= e;
        }
    }
  }
  __syncthreads();
}

DEV uint4 rw_act(const uint4 cur, const uint4 prv, const float* mul8, int mode) {
  const float4 m0 = *(const float4*)(mul8), m1 = *(const float4*)(mul8 + 4);
  const float mm[8] = {m0.x, m0.y, m0.z, m0.w, m1.x, m1.y, m1.z, m1.w};
  float a[8], b[8], o[8];
  UNPACK8(cur, a); UNPACK8(prv, b);
#pragma unroll
  for (int e = 0; e < 8; ++e) {
    float v = a[e] + (b[e] - a[e]) * mm[e];
    if (mode == 1) { const float t = __expf(-2.f * fabsf(v)); const float th = (1.f - t) / (1.f + t); v = (v >= 0.f) ? th : -th; }
    else if (mode == 2) v = sigm(v);
    o[e] = v;
  }
  return PACK8(o);
}
DEV bf16x8 rw_bfrag(const float* W, int k0, int col) {
  float o[8];
#pragma unroll
  for (int e = 0; e < 8; ++e) o[e] = W[(size_t)(k0 + e) * 512 + col];
  return as_frag(PACK8(o));
}

PHASE void rwkv_item(const Params& p, int l, int item, char* smem) {
  const int b = item >> 3, h = item & 7;
  const int tid = opaque_tid(), lane = tid & 63, wave = tid >> 6, fr = lane & 15, fq = lane >> 4;
  float* R = (float*)smem;
  float* K = R + 2048; float* KK = K + 2048; float* W = KK + 2048; float* BB = W + 2048;
  float* V = BB + 2048; float* G = V + 2048; float* O = G + 2048;
  float* cst = O + 2048;
  float* mul = cst + 512;
  bf16_t* rawL = (bf16_t*)smem;
  float* vloL = (float*)(smem + 17424);
  const float* mu = p.rw_mu + (size_t)l * 1792;
  const int hc_n = h * 64 + wave * 16 + fr;
  bf16x8 w2f[2], a2f[2], g2f[4], v2f;
#pragma unroll
  for (int ks = 0; ks < 2; ++ks) {
    w2f[ks] = rw_bfrag(p.rw_w2 + (size_t)l * 64 * 512, ks * 32 + fq * 8, hc_n);
    a2f[ks] = rw_bfrag(p.rw_a2 + (size_t)l * 64 * 512, ks * 32 + fq * 8, hc_n);
  }
#pragma unroll
  for (int ks = 0; ks < 4; ++ks) g2f[ks] = rw_bfrag(p.rw_g2 + (size_t)l * 128 * 512, ks * 32 + fq * 8, hc_n);
  v2f = w2f[0];
  if (l > 0) v2f = rw_bfrag(p.rw_v2, fq * 8, hc_n);
  const float w0c = p.rw_w0[l * 512 + hc_n], a0c = p.rw_a0[l * 512 + hc_n];
  const float v0c = (l > 0) ? p.rw_v0[hc_n] : 0.f;
  const int t_ = tid >> 3, n0 = (tid & 7) * 8;
  __syncthreads();
  if (tid < 64) {
    const int hc = h * 64 + tid;
    cst[tid] = p.rw_k_k[l * 512 + hc]; cst[64 + tid] = p.rw_k_a[l * 512 + hc]; cst[128 + tid] = p.rw_r_k[l * 512 + hc];
    cst[192 + tid] = p.rw_gn_w[l * 512 + hc]; cst[256 + tid] = p.rw_gn_b[l * 512 + hc];
    cst[320 + tid] = mu[hc]; cst[384 + tid] = mu[512 + hc]; cst[448 + tid] = mu[1024 + hc];
  }
  mul[tid] = mu[1536 + tid];
  const float* kkc = cst + n0; const float* kac = cst + 64 + n0; const float* rkc = cst + 128 + n0;
  const float* gnw = cst + 192 + n0; const float* gnb = cst + 256 + n0;
  const float* mur = cst + 320 + n0; const float* muk = cst + 384 + n0; const float* muv = cst + 448 + n0;
  const int kq = lane & 7, row0 = wave * 16 + (lane >> 3), row1 = row0 + 8;
  f32x2 S0p[4], S1p[4];
#pragma unroll
  for (int e = 0; e < 4; ++e) { S0p[e] = (f32x2){0.f, 0.f}; S1p[e] = (f32x2){0.f, 0.f}; }

  uint4 pl0, pl1, pl2, pl3, pl4, pcr, pck, pcv, ppr, ppk, ppv, pvf;
  float4 pvl;
#define RW_PREFETCH(ch_)                                                                                    \
  {                                                                                                         \
    const size_t tk0 = (size_t)b * SEQ + (size_t)(ch_) * 32;                                                 \
    const bf16_t* lb_ = p.u + (tk0 - 1) * US + 3072 + 1536 + (tid & 31) * 8;                                 \
    const int r0_ = tid >> 5;                                                                               \
    pl0 = make_uint4(0, 0, 0, 0); if (!((ch_) == 0 && r0_ == 0)) pl0 = *(const uint4*)(lb_ + (size_t)r0_ * US); \
    pl1 = *(const uint4*)(lb_ + (size_t)(r0_ + 8) * US);                                                     \
    pl2 = *(const uint4*)(lb_ + (size_t)(r0_ + 16) * US);                                                    \
    pl3 = *(const uint4*)(lb_ + (size_t)(r0_ + 24) * US);                                                    \
    pl4 = make_uint4(0, 0, 0, 0); if (tid < 32) pl4 = *(const uint4*)(lb_ + (size_t)32 * US);                \
    const bf16_t* cu_ = p.u + (tk0 + t_) * US + 3072 + h * 64 + n0;                                          \
    pcr = *(const uint4*)cu_; pck = *(const uint4*)(cu_ + 512); pcv = *(const uint4*)(cu_ + 1024);           \
    if ((ch_) == 0 && t_ == 0) { ppr = make_uint4(0, 0, 0, 0); ppk = ppr; ppv = ppr; }                        \
    else { ppr = *(const uint4*)(cu_ - US); ppk = *(const uint4*)(cu_ - US + 512); ppv = *(const uint4*)(cu_ - US + 1024); } \
    if (l > 0) {                                                                                            \
      pvl = *(const float4*)(p.vlo + (tk0 + (tid >> 3)) * 32 + (tid & 7) * 4);                               \
      pvf = *(const uint4*)(p.vfirst + (tk0 + t_) * 512 + h * 64 + n0);                                      \
    } else { pvl = make_float4(0.f, 0.f, 0.f, 0.f); pvf = make_uint4(0, 0, 0, 0); }                          \
  }
  RW_PREFETCH(0)

  for (int ch = 0; ch < 64; ++ch) {
    const size_t tok0 = (size_t)b * SEQ + (size_t)ch * 32;
    __syncthreads();
    {
      const int r0_ = tid >> 5, cc_ = (tid & 31) * 8;
      *(uint4*)(rawL + r0_ * 264 + cc_) = pl0;
      *(uint4*)(rawL + (r0_ + 8) * 264 + cc_) = pl1;
      *(uint4*)(rawL + (r0_ + 16) * 264 + cc_) = pl2;
      *(uint4*)(rawL + (r0_ + 24) * 264 + cc_) = pl3;
      if (tid < 32) *(uint4*)(rawL + 32 * 264 + cc_) = pl4;
      *(float4*)(vloL + (tid >> 3) * 36 + (tid & 7) * 4) = pvl;
    }
    __syncthreads();
    {
      const int cc_ = (tid & 31) * 8, tr = tid >> 5;
      const int mode = (cc_ < 64) ? 1 : ((cc_ < 128) ? 0 : 2);
      uint4 a0, a1, a2, a3;
      a0 = rw_act(*(const uint4*)(rawL + (tr + 1) * 264 + cc_), *(const uint4*)(rawL + tr * 264 + cc_), mul + cc_, mode);
      a1 = rw_act(*(const uint4*)(rawL + (tr + 9) * 264 + cc_), *(const uint4*)(rawL + (tr + 8) * 264 + cc_), mul + cc_, mode);
      a2 = rw_act(*(const uint4*)(rawL + (tr + 17) * 264 + cc_), *(const uint4*)(rawL + (tr + 16) * 264 + cc_), mul + cc_, mode);
      a3 = rw_act(*(const uint4*)(rawL + (tr + 25) * 264 + cc_), *(const uint4*)(rawL + (tr + 24) * 264 + cc_), mul + cc_, mode);
      __syncthreads();
      *(uint4*)(rawL + tr * 264 + cc_) = a0;
      *(uint4*)(rawL + (tr + 8) * 264 + cc_) = a1;
      *(uint4*)(rawL + (tr + 16) * 264 + cc_) = a2;
      *(uint4*)(rawL + (tr + 24) * 264 + cc_) = a3;
    }
    __syncthreads();
#pragma unroll 1
    for (int mt = 0; mt < 2; ++mt) {
      const int row = mt * 16 + fr;
      const bf16_t* ar = rawL + row * 264 + fq * 8;
      f32x4 aw = (f32x4){0.f, 0.f, 0.f, 0.f}, aa = aw, ag = aw, av = aw;
#pragma unroll
      for (int ks = 0; ks < 2; ++ks) {
        aw = MFMA(*(const bf16x8*)(ar + ks * 32), w2f[ks], aw);
        aa = MFMA(*(const bf16x8*)(ar + 64 + ks * 32), a2f[ks], aa);
      }
#pragma unroll
      for (int ks = 0; ks < 4; ++ks) ag = MFMA(*(const bf16x8*)(ar + 128 + ks * 32), g2f[ks], ag);
      if (l > 0) {
        const float4 x0 = *(const float4*)(vloL + row * 36 + fq * 8), x1 = *(const float4*)(vloL + row * 36 + fq * 8 + 4);
        const uint4 pk = make_uint4(pack2(x0.x, x0.y), pack2(x0.z, x0.w), pack2(x1.x, x1.y), pack2(x1.z, x1.w));
        av = MFMA(as_frag(pk), v2f, av);
      }
#pragma unroll
      for (int j = 0; j < 4; ++j) {
        const int t = mt * 16 + fq * 4 + j, n = wave * 16 + fr;
        const float wv = -(w0c + aw[j]);
        const float sp = fmaxf(wv, 0.f) + __logf(1.f + __expf(-fabsf(wv)));
        const float wl = -sp - 0.5f;
        W[t * 64 + n] = __expf(-__expf(wl));
        BB[t * 64 + n] = sigm(a0c + aa[j]);
        G[t * 64 + n] = ag[j];
        if (l > 0) O[t * 64 + n] = sigm(v0c + av[j]);
      }
    }
    __syncthreads();
    {
      const size_t tok = tok0 + t_;
      float cr[8], ck[8], cv[8], pr[8], pk[8], pv[8];
      UNPACK8(pcr, cr); UNPACK8(pck, ck); UNPACK8(pcv, cv);
      UNPACK8(ppr, pr); UNPACK8(ppk, pk); UNPACK8(ppv, pv);
      float kx[8], kkv[8], vs[8], ss = 0.f;
#pragma unroll
      for (int e = 0; e < 8; ++e) {
        R[t_ * 64 + n0 + e] = cr[e] + (pr[e] - cr[e]) * mur[e];
        kx[e] = ck[e] + (pk[e] - ck[e]) * muk[e];
        vs[e] = cv[e] + (pv[e] - cv[e]) * muv[e];
        kkv[e] = kx[e] * kkc[e]; ss += kkv[e] * kkv[e];
      }
      ss = red8_sum(ss);
      const float rn = rsqrtf(fmaxf(ss, 1e-24f));
#pragma unroll
      for (int e = 0; e < 8; ++e) {
        const float a = BB[t_ * 64 + n0 + e];
        const float kn = kkv[e] * rn;
        K[t_ * 64 + n0 + e] = kx[e] * (1.f + (a - 1.f) * kac[e]);
        KK[t_ * 64 + n0 + e] = kn;
        BB[t_ * 64 + n0 + e] = kn * a;
      }
      if (l == 0) {
        *(uint4*)(p.vfirst + tok * 512 + h * 64 + n0) = PACK8(vs);
      } else {
        float vf[8]; UNPACK8(pvf, vf);
#pragma unroll
        for (int e = 0; e < 8; ++e) vs[e] = vs[e] + (vf[e] - vs[e]) * O[t_ * 64 + n0 + e];
      }
#pragma unroll
      for (int e = 0; e < 8; ++e) V[t_ * 64 + n0 + e] = vs[e];
    }
    __syncthreads();
    if (ch + 1 < 64) RW_PREFETCH(ch + 1)
    asm volatile("" ::: "memory");
#pragma unroll 2
    for (int t = 0; t < 32; ++t) {
      const float* base = R + t * 64 + kq * 8;
      const float4 r0 = *(const float4*)(base), r1 = *(const float4*)(base + 4);
      const float4 k0 = *(const float4*)(base + 2048), k1 = *(const float4*)(base + 2048 + 4);
      const float4 q0 = *(const float4*)(base + 4096), q1 = *(const float4*)(base + 4096 + 4);
      const float4 w0 = *(const float4*)(base + 6144), w1 = *(const float4*)(base + 6144 + 4);
      const float4 b0 = *(const float4*)(base + 8192), b1 = *(const float4*)(base + 8192 + 4);
      const float va = V[t * 64 + row0], vb = V[t * 64 + row1];
      const f32x2 rr[4] = {{r0.x, r0.y}, {r0.z, r0.w}, {r1.x, r1.y}, {r1.z, r1.w}};
      const f32x2 ww[4] = {{w0.x, w0.y}, {w0.z, w0.w}, {w1.x, w1.y}, {w1.z, w1.w}};
      const f32x2 kk_[4] = {{k0.x, k0.y}, {k0.z, k0.w}, {k1.x, k1.y}, {k1.z, k1.w}};
      const f32x2 qq[4] = {{q0.x, q0.y}, {q0.z, q0.w}, {q1.x, q1.y}, {q1.z, q1.w}};
      const f32x2 bb[4] = {{b0.x, b0.y}, {b0.z, b0.w}, {b1.x, b1.y}, {b1.z, b1.w}};
      f32x2 a0 = S0p[0] * qq[0], a1 = S1p[0] * qq[0];
#pragma unroll
      for (int e = 1; e < 4; ++e) { a0 += S0p[e] * qq[e]; a1 += S1p[e] * qq[e]; }
      const float sa0 = -red8_sum(a0.x + a0.y), sa1 = -red8_sum(a1.x + a1.y);
      f32x2 sa0v, sa1v, vav, vbv;
      sa0v.x = sa0; sa0v.y = sa0; sa1v.x = sa1; sa1v.y = sa1; vav.x = va; vav.y = va; vbv.x = vb; vbv.y = vb;
      f32x2 o0v = {0.f, 0.f}, o1v = {0.f, 0.f};
#pragma unroll
      for (int e = 0; e < 4; ++e) {
        S0p[e] = S0p[e] * ww[e] + sa0v * bb[e] + vav * kk_[e];
        S1p[e] = S1p[e] * ww[e] + sa1v * bb[e] + vbv * kk_[e];
        o0v += S0p[e] * rr[e]; o1v += S1p[e] * rr[e];
      }
      const float o0 = red8_sum(o0v.x + o0v.y), o1 = red8_sum(o1v.x + o1v.y);
      if (kq == 0) { O[t * 64 + row0] = o0; O[t * 64 + row1] = o1; }
    }
    asm volatile("s_waitcnt vmcnt(0)" ::: "memory");
    __syncthreads();
    {
      const size_t tok = tok0 + t_;
      float ov[8], s1 = 0.f, bon = 0.f;
#pragma unroll
      for (int e = 0; e < 8; ++e) {
        ov[e] = O[t_ * 64 + n0 + e]; s1 += ov[e];
        bon += R[t_ * 64 + n0 + e] * K[t_ * 64 + n0 + e] * rkc[e];
      }
      s1 = red8_sum(s1); bon = red8_sum(bon);
      const float mean = s1 * (1.f / 64.f);
      float s2 = 0.f;
#pragma unroll
      for (int e = 0; e < 8; ++e) { const float d = ov[e] - mean; s2 += d * d; }
      s2 = red8_sum(s2);
      const float rstd = rsqrtf(s2 * (1.f / 64.f) + 64e-5f);
      float y[8];
#pragma unroll
      for (int e = 0; e < 8; ++e)
        y[e] = ((ov[e] - mean) * rstd * gnw[e] + gnb[e] + bon * V[t_ * 64 + n0 + e]) * G[t_ * 64 + n0 + e];
      *(uint4*)(p.u + tok * US + 3072 + h * 64 + n0) = PACK8(y);
    }
  }
#undef RW_PREFETCH
  __syncthreads();
}

PHASE void phase_mix(const Params& p, int l, char* smem) {
  int* sitem = (int*)(smem + SMEM_BYTES - 16);
  const int tid0 = opaque_tid();
  while (true) {
    __syncthreads();
    if (tid0 == 0) *sitem = (int)atomicAdd(p.counters + l * 4 + 0, 1u);
    __syncthreads();
    const int item = *sitem;
    if (item >= 256) break;
    rwkv_item(p, l, item, smem);
  }
  while (true) {
    __syncthreads();
    if (tid0 == 0) *sitem = (int)atomicAdd(p.counters + l * 4 + 1, 1u);
    __syncthreads();
    const int item = *sitem;
    if (item >= 128) break;
    hgrn_item(p, l, item, smem);
  }
  while (true) {
    __syncthreads();
    if (tid0 == 0) *sitem = (int)atomicAdd(p.counters + l * 4 + 2, 1u);
    __syncthreads();
    const int item = *sitem;
    if (item >= 4096) break;
    att_item(p, l, item, smem);
  }
}

DEV void gemm_gates(const int tid, const bf16_t* A, const bf16_t* Wg, int tn, char* smem, unsigned (&Gp)[4][6][2]) {
  bf16_t* As = (bf16_t*)smem;
  bf16_t* Bs = As + 3 * 4096;
  const int lane = tid & 63, wave = tid >> 6, wr = wave >> 1, wc = wave & 1;
  const int fr = lane & 15, fq = lane >> 4;
  f32x4 acc[4][6];
#pragma unroll
  for (int m = 0; m < 4; ++m)
#pragma unroll
    for (int n = 0; n < 6; ++n) acc[m][n] = (f32x4){0.f, 0.f, 0.f, 0.f};
  const int nk = DM >> 5;
  const int drow = tid >> 2, dphys = tid & 3, dg = (0 - (tid >> 4)) & 3;
  const int cofs = (dphys ^ dg) * 8;
  const bf16_t* Ap = A + (size_t)drow * DM + cofs;
  const bf16_t* Bp0; const bf16_t* Bp1; const bf16_t* Bp2;
  {
    int r = drow;
    int wcb = r / 96, br = (r % 96) >> 5, c = r & 31;
    c = (r % 96) & 31;
    Bp0 = Wg + (size_t)(5376 + br * 1024 + tn * 64 + wcb * 32 + c) * DM + cofs;
    r = drow + 64; wcb = r / 96; br = (r % 96) >> 5; c = (r % 96) & 31;
    Bp1 = Wg + (size_t)(5376 + br * 1024 + tn * 64 + wcb * 32 + c) * DM + cofs;
    r = drow + 128; wcb = r / 96; br = (r % 96) >> 5; c = (r % 96) & 31;
    Bp2 = Wg + (size_t)(5376 + br * 1024 + tn * 64 + wcb * 32 + c) * DM + cofs;
  }
  const int rofs = (fq ^ ((0 - (fr >> 2)) & 3)) * 8;
#define GG_DMA(st, kk)                                                                                       \
  {                                                                                                          \
    __builtin_amdgcn_global_load_lds((const unsigned*)(Ap + (kk) * 32), (unsigned*)(As + (st) * 4096 + tid * 8), 16, 0, 0);                     \
    __builtin_amdgcn_global_load_lds((const unsigned*)(Ap + (size_t)64 * DM + (kk) * 32), (unsigned*)(As + (st) * 4096 + tid * 8 + 2048), 16, 0, 0); \
    __builtin_amdgcn_global_load_lds((const unsigned*)(Bp0 + (kk) * 32), (unsigned*)(Bs + (st) * 6144 + tid * 8), 16, 0, 0);                    \
    __builtin_amdgcn_global_load_lds((const unsigned*)(Bp1 + (kk) * 32), (unsigned*)(Bs + (st) * 6144 + tid * 8 + 2048), 16, 0, 0);             \
    __builtin_amdgcn_global_load_lds((const unsigned*)(Bp2 + (kk) * 32), (unsigned*)(Bs + (st) * 6144 + tid * 8 + 4096), 16, 0, 0);             \
  }
  GG_DMA(0, 0)
  GG_DMA(1, 1)
  int st = 0;
  for (int kt = 0; kt < nk; ++kt) {
    if (kt + 1 < nk) asm volatile("s_waitcnt vmcnt(5)" ::: "memory");
    else asm volatile("s_waitcnt vmcnt(0)" ::: "memory");
    __builtin_amdgcn_s_barrier();
    asm volatile("" ::: "memory");
    const int s2 = (st >= 1) ? st - 1 : 2;
    const bf16_t* Ab = As + st * 4096 + (wr * 64 + fr) * 32 + rofs;
    const bf16_t* Bb = Bs + st * 6144 + (wc * 96 + fr) * 32 + rofs;
    bf16x8 bfr[6], af[4];
#pragma unroll
    for (int n = 0; n < 6; ++n) bfr[n] = *(const bf16x8*)(Bb + n * 512);
#pragma unroll
    for (int m = 0; m < 4; ++m) af[m] = *(const bf16x8*)(Ab + m * 512);
    if (kt + 2 < nk) GG_DMA(s2, kt + 2)
#pragma unroll
    for (int m = 0; m < 4; ++m)
#pragma unroll
      for (int n = 0; n < 6; ++n) acc[m][n] = MFMA(af[m], bfr[n], acc[m][n]);
    st = (st == 2) ? 0 : st + 1;
  }
#undef GG_DMA
  __syncthreads();
#pragma unroll
  for (int m = 0; m < 4; ++m)
#pragma unroll
    for (int n = 0; n < 6; ++n) {
      Gp[m][n][0] = pack2(sigm(acc[m][n][0]), sigm(acc[m][n][1]));
      Gp[m][n][1] = pack2(sigm(acc[m][n][2]), sigm(acc[m][n][3]));
    }
}

PHASE void phase_merge(const Params& p, int l, char* smem) {
  const bf16_t* Wl = p.wt + (size_t)l * WLAYER;
  float* Cs = (float*)smem;
  const int tid = opaque_tid();
  for (int it = 0;; ++it) {
    int tm, tn;
    if (!tile_for(it, 512, 16, tm, tn)) break;
    const size_t row0 = (size_t)tm * 128;
    unsigned Gp[4][6][2];
    gemm_gates(tid, p.h + row0 * DM, Wl + WIN, tn, smem, Gp);
    f32x4 acc[4][2], M[4][2];
#pragma unroll
    for (int m = 0; m < 4; ++m)
#pragma unroll
      for (int n = 0; n < 2; ++n) M[m][n] = (f32x4){0.f, 0.f, 0.f, 0.f};
#pragma unroll
    for (int br = 0; br < 3; ++br) {
      const int aoff = (br == 0) ? 0 : (br == 1 ? 2560 : 3072);
      const size_t woff = (br == 0) ? WBA : (br == 1 ? WBB : WBC);
      gemm_tile<2>(tid, p.u + row0 * US + aoff, US, Wl + woff + (size_t)(tn * 64) * 512, 512, 512, smem, acc);
#pragma unroll
      for (int m = 0; m < 4; ++m)
#pragma unroll
        for (int n = 0; n < 2; ++n) {
          M[m][n][0] += lo16(Gp[m][2 * br + n][0]) * acc[m][n][0];
          M[m][n][1] += hi16(Gp[m][2 * br + n][0]) * acc[m][n][1];
          M[m][n][2] += lo16(Gp[m][2 * br + n][1]) * acc[m][n][2];
          M[m][n][3] += hi16(Gp[m][2 * br + n][1]) * acc[m][n][3];
        }
    }
    stage_acc<2>(tid, Cs, M);
    __syncthreads();
    {
      const int ch = tid & 7;
#pragma unroll 1
      for (int i = 0; i < 4; ++i) {
        const int r = (tid >> 3) + i * 32;
        const float4 a = *(const float4*)(Cs + r * 68 + ch * 8), b = *(const float4*)(Cs + r * 68 + ch * 8 + 4);
        *(uint4*)(p.u + (row0 + r) * US + 1024 + tn * 64 + ch * 8) = make_uint4(pack2(a.x, a.y), pack2(a.z, a.w), pack2(b.x, b.y), pack2(b.z, b.w));
      }
    }
    __syncthreads();
  }
}

PHASE void phase_gemm_res(const bf16_t* A, int lda, const bf16_t* Wt, int K, const float* xin, float* xout,
                        const float* ada_l, int gate_off, char* smem) {
  float* Cs = (float*)smem;
  const int tid = opaque_tid();
  for (int it = 0;; ++it) {
    int tm, tn;
    if (!tile_for(it, 256, 8, tm, tn)) break;
    const size_t row0 = (size_t)tm * 256;
    f32x4 acc[8][4];
    gemm_tile256(tid, A + row0 * lda, lda, Wt + (size_t)(tn * 128) * K, K, K, smem, acc);
    const float* gate = ada_l + (size_t)(row0 / SEQ) * ADAW + gate_off + tn * 128;
    const int c4 = (tid & 31) * 4;
    const float4 gv = *(const float4*)(gate + c4);
#pragma unroll
    for (int ps = 0; ps < 2; ++ps) {
      if (ps == 0) stage_half<0>(tid, Cs, acc); else stage_half<1>(tid, Cs, acc);
      __syncthreads();
#pragma unroll 1
      for (int i = 0; i < 16; ++i) {
        const int r = (tid >> 5) + i * 8;
        const float4 cv = *(const float4*)(Cs + r * 132 + c4);
        const size_t off = (row0 + RMAP(r, ps)) * DM + tn * 128 + c4;
        const float4 xv = *(const float4*)(xin + off);
        *(float4*)(xout + off) = make_float4(xv.x + gv.x * cv.x, xv.y + gv.y * cv.y, xv.z + gv.z * cv.z, xv.w + gv.w * cv.w);
      }
      __syncthreads();
    }
  }
}

PHASE void phase_ffn_in(const Params& p, int l, char* smem) {
  const bf16_t* Wt = p.wt + (size_t)l * WLAYER + WFI;
  float* Cs = (float*)smem;
  const int tid = opaque_tid();
  for (int it = 0;; ++it) {
    int tm, tn;
    if (!tile_for(it, 256, 44, tm, tn)) break;
    const size_t row0 = (size_t)tm * 256;
    f32x4 acc[8][4];
    gemm_tile256(tid, p.h + row0 * DM, DM, Wt + (size_t)(tn * 128) * DM, DM, DM, smem, acc);
    const int ch = tid & 7;
#pragma unroll
    for (int ps = 0; ps < 2; ++ps) {
      if (ps == 0) stage_half<0>(tid, Cs, acc); else stage_half<1>(tid, Cs, acc);
      __syncthreads();
#pragma unroll 1
      for (int i = 0; i < 4; ++i) {
        const int r = (tid >> 3) + i * 32;
        const float* cp = Cs + r * 132 + ch * 8;
        float o[8];
#pragma unroll
        for (int e = 0; e < 8; ++e) { const float g = cp[e], uu = cp[64 + e]; o[e] = g * sigm(g) * uu; }
        *(uint4*)(p.u + (row0 + RMAP(r, ps)) * FFH + tn * 64 + ch * 8) = PACK8(o);
      }
      __syncthreads();
    }
  }
}

#define XB_TMO      128
#define XB_XCNT(j)  (256  + 64 * (j))
#define XB_XSUB(j)  (1280 + 64 * (j))
#define XB_XGEN(j)  (2304 + 64 * (j))
#define XB_TOP      3328
#define XB_TOPGEN   3392
#define XCD_BAR_WORDS 3456
#define XB_SPIN_CAP (1u << 18)
#define LAS __attribute__((address_space(3)))
DEV unsigned xb_ld(unsigned* p) { return __hip_atomic_load(p, __ATOMIC_RELAXED, __HIP_MEMORY_SCOPE_AGENT); }
DEV unsigned xb_add(unsigned* p, unsigned v) { return __hip_atomic_fetch_add(p, v, __ATOMIC_RELAXED, __HIP_MEMORY_SCOPE_AGENT); }
DEV unsigned xb_xcc_id() { return (unsigned)__builtin_amdgcn_s_getreg((3 << 11) | 20) & 0xFu; }
#define XB_SPIN(cond, bar) do { unsigned _sp = 0; while (cond) { __builtin_amdgcn_s_sleep(1); \
    if ((++_sp & 255u) == 0u) { if (xb_ld(&(bar)[XB_TMO])) break; if (_sp > XB_SPIN_CAP) { atomicAdd(&(bar)[XB_TMO], 1u); break; } } } } while (0)
struct XcdBarrier { unsigned* bar; unsigned x; volatile LAS unsigned* st; };
DEV XcdBarrier xcd_barrier_post(unsigned* bar, volatile LAS unsigned* st) {
  XcdBarrier b; b.bar = bar; b.x = xb_xcc_id(); b.st = st;
  if (threadIdx.x == 0) (void)xb_add(&bar[XB_XCNT(b.x)], 1u);
  return b;
}
DEV void xcd_barrier_complete(unsigned* bar, unsigned x, unsigned& nloc, unsigned& nx) {
  const unsigned G = gridDim.x * gridDim.y * gridDim.z;
  unsigned sum, cnt, mine, sp = 0u;
  for (;;) {
    sum = 0u; cnt = 0u; mine = 0u;
#pragma unroll
    for (unsigned j = 0; j < 16; ++j) { const unsigned c = xb_ld(&bar[XB_XCNT(j)]); sum += c; cnt += (c > 0u) ? 1u : 0u; mine = (j == x) ? c : mine; }
    if (sum == G) break;
    __builtin_amdgcn_s_sleep(1);
    if ((++sp & 255u) == 0u) { if (xb_ld(&bar[XB_TMO])) break; if (sp > XB_SPIN_CAP) { atomicAdd(&bar[XB_TMO], 1u); break; } }
  }
  nloc = mine > 0u ? mine : 1u; nx = cnt > 0u ? cnt : 1u;
}
DEV void xcd_barrier(const XcdBarrier& b) {
  asm volatile("s_waitcnt vmcnt(0)" ::: "memory");
  __syncthreads();
  if (threadIdx.x == 0) {
    unsigned* bar = b.bar;
    __builtin_amdgcn_s_waitcnt(0);
    unsigned nloc = b.st[0], nx = b.st[1];
    if (nloc == 0u) { xcd_barrier_complete(bar, b.x, nloc, nx); b.st[0] = nloc; b.st[1] = nx; }
    const unsigned old = xb_add(&bar[XB_XSUB(b.x)], 1u);
    const unsigned gen = old / nloc;
    if (old + 1u == (gen + 1u) * nloc) {
      __builtin_amdgcn_fence(__ATOMIC_RELEASE, "agent");
      asm volatile("s_waitcnt vmcnt(0)" ::: "memory");
      const unsigned og = xb_add(&bar[XB_TOP], 1u);
      const unsigned tg = og / nx;
      if (og + 1u == (tg + 1u) * nx) xb_add(&bar[XB_TOPGEN], 1u);
      else XB_SPIN(xb_ld(&bar[XB_TOPGEN]) == tg, bar);
      __builtin_amdgcn_fence(__ATOMIC_ACQUIRE, "agent");
      xb_add(&bar[XB_XGEN(b.x)], 1u);
      asm volatile("s_waitcnt vmcnt(0)" ::: "memory");
    } else {
      XB_SPIN(xb_ld(&bar[XB_XGEN(b.x)]) == gen, bar);
      __builtin_amdgcn_fence(__ATOMIC_ACQUIRE, "agent");
      asm volatile("s_waitcnt vmcnt(0)" ::: "memory");
    }
  }
  __syncthreads();
}

__global__ void __launch_bounds__(256, 2) mega(Params p_in, int ph_lo, int ph_hi) {
  extern __shared__ __attribute__((aligned(16))) char smem[];
  cg::grid_group grid = cg::this_grid();
  const Params& p = p_in;
  bool first = true;
#define RUN(ph) if ((ph) >= ph_lo && (ph) < ph_hi)
  unsigned epoch = 0;
  __shared__ unsigned xb_words[4];
  if (threadIdx.x < 4) xb_words[threadIdx.x] = 0u;
  __syncthreads();
  XcdBarrier xb;
  xb.bar = p.counters + 256; xb.x = 0u; xb.st = (volatile LAS unsigned*)xb_words;
#define SYNC { if (!first) { ++epoch; if (epoch == 1) { grid.sync(); xb = xcd_barrier_post(p.counters + 256, (volatile LAS unsigned*)xb_words); } else xcd_barrier(xb); } first = false; }
  RUN(0) { SYNC; phase_prep(p, smem); }
#pragma unroll 1
  for (int l = 0; l < 2; ++l) {
    const int base = 1 + 9 * l;
    const float* ada_l = p.ada + (size_t)l * 32 * ADAW;
    const bf16_t* Wl = p.wt + (size_t)l * WLAYER;
    const float* xin = (l == 0) ? p.x : p.out;
    RUN(base + 0) { SYNC; phase_norm(xin, p.norm_mix_w + l * DM, ada_l, 0, 1024, p.h); }
    RUN(base + 1) { SYNC; phase_gemm_in(p, l, smem); }
    RUN(base + 2) { if (l > 0) { SYNC; phase_vlo(p, l, smem); } }
    RUN(base + 3) { SYNC; phase_mix(p, l, smem); }
    RUN(base + 4) { SYNC; phase_merge(p, l, smem); }
    RUN(base + 5) { SYNC; phase_gemm_res(p.u + 1024, US, Wl + WOUT, DM, xin, p.out, ada_l, 2048, smem); }
    RUN(base + 6) { SYNC; phase_norm(p.out, p.norm_ffn_w + l * DM, ada_l, 3072, 4096, p.h); }
    RUN(base + 7) { SYNC; phase_ffn_in(p, l, smem); }
    RUN(base + 8) { SYNC; phase_gemm_res(p.u, FFH, Wl + WFO, FFH, p.out, p.out, ada_l, 5120, smem); }
  }
  RUN(NPHASE - 1) { SYNC; phase_final(p.out, p.final_norm_w); }
}

extern "C" void kernel_launch(void* const* d_in, const int* in_sizes, int n_in, void* d_out, int out_size, void* d_ws,
                              size_t ws_size, hipStream_t stream) {
  Params p{};
  p.x = (const float*)d_in[0]; p.c = (const float*)d_in[1]; p.pos = (const int*)d_in[2];
  p.ada_w = (const float*)d_in[3]; p.ada_b = (const float*)d_in[4]; p.norm_mix_w = (const float*)d_in[5];
  p.norm_ffn_w = (const float*)d_in[6]; p.w_in = (const float*)d_in[7]; p.da_lambda = (const float*)d_in[8];
  p.da_subln_w = (const float*)d_in[9]; p.hg_lb = (const float*)d_in[10]; p.hg_norm_w = (const float*)d_in[11];
  p.rw_mu = (const float*)d_in[12]; p.rw_w0 = (const float*)d_in[13]; p.rw_w2 = (const float*)d_in[14];
  p.rw_a0 = (const float*)d_in[15]; p.rw_a2 = (const float*)d_in[16]; p.rw_g2 = (const float*)d_in[17];
  p.rw_k_k = (const float*)d_in[18]; p.rw_k_a = (const float*)d_in[19]; p.rw_r_k = (const float*)d_in[20];
  p.rw_gn_w = (const float*)d_in[21]; p.rw_gn_b = (const float*)d_in[22]; p.rw_v0 = (const float*)d_in[23];
  p.rw_v1 = (const float*)d_in[24]; p.rw_v2 = (const float*)d_in[25]; p.w_br_a = (const float*)d_in[26];
  p.w_br_b = (const float*)d_in[27]; p.w_br_c = (const float*)d_in[28]; p.w_out = (const float*)d_in[29];
  p.ffn_w_in = (const float*)d_in[30]; p.ffn_w_out = (const float*)d_in[31]; p.final_norm_w = (const float*)d_in[32];
  p.out = (float*)d_out;
  char* ws = (char*)d_ws;
  size_t off = 0;
  auto take = [&](size_t bytes) { char* r = ws + off; off += (bytes + 255) & ~(size_t)255; return r; };
  p.counters = (unsigned*)take(16384);
  p.wt = (bf16_t*)take(2 * WLAYER * 2);
  p.ada = (float*)take((size_t)2 * 32 * ADAW * 4);
  p.h = (bf16_t*)take((size_t)T_TOK * DM * 2);
  p.u = (bf16_t*)take((size_t)T_TOK * US * 2);
  p.vT = (bf16_t*)take((size_t)T_TOK * 512 * 2);
  p.vfirst = (bf16_t*)take((size_t)T_TOK * 512 * 2);
  p.vlo = (float*)take((size_t)T_TOK * 32 * 4);
  if (off > ws_size) { fprintf(stderr, "workspace too small: need %zu have %zu\n", off, ws_size); return; }

  static int grid_blocks = 0;
  if (!grid_blocks) {
    hipFuncSetAttribute((const void*)mega, hipFuncAttributeMaxDynamicSharedMemorySize, SMEM_BYTES);
    int dev = 0, cus = 0, per_cu = 0;
    hipGetDevice(&dev);
    hipDeviceGetAttribute(&cus, hipDeviceAttributeMultiprocessorCount, dev);
    hipOccupancyMaxActiveBlocksPerMultiprocessor(&per_cu, mega, 256, SMEM_BYTES);
    if (per_cu > 2) per_cu = 2;
    if (per_cu < 1) per_cu = 1;
    grid_blocks = cus * per_cu;
  }
#if SINGLE_LAUNCH
  int lo = 0, hi = NPHASE;
  void* args[] = {&p, &lo, &hi};
  hipError_t e = hipLaunchCooperativeKernel((void*)mega, dim3(grid_blocks), dim3(256), args, SMEM_BYTES, stream);
  if (e != hipSuccess) fprintf(stderr, "cooperative launch failed: %s (grid %d)\n", hipGetErrorString(e), grid_blocks);
#else
  for (int ph = 0; ph < NPHASE; ++ph) {
    if (ph == 3) continue;
    hipLaunchKernelGGL(mega, dim3(grid_blocks), dim3(256), SMEM_BYTES, stream, p, ph, ph + 1);
  }
#endif
}
```

```cpp
#include <hip/hip_runtime.h>
#include <hip/hip_cooperative_groups.h>
#include <stdint.h>
#include <cstdio>
namespace cg = cooperative_groups;

typedef unsigned short bf16_t;
typedef short bf16x8 __attribute__((ext_vector_type(8)));
typedef float f32x4 __attribute__((ext_vector_type(4)));
typedef float f32x2 __attribute__((ext_vector_type(2)));
#define DEV __device__ __forceinline__
#define PHASE __device__ __forceinline__

#ifndef SINGLE_LAUNCH
#define SINGLE_LAUNCH 1
#endif

constexpr int T_TOK = 65536, DM = 1024, SEQ = 2048, US = 4864, ADAW = 6144, FFH = 2816;
constexpr size_t WIN = 0, WBA = 8650752, WBB = 9175040, WBC = 9699328, WOUT = 10223616, WFI = 11272192,
                 WFO = 17039360, WLAYER = 19922944;
constexpr int SMEM_BYTES = 80896;
constexpr int NPHASE = 20;

struct Params {
  const float* x; const float* c; const int* pos;
  const float *ada_w, *ada_b, *norm_mix_w, *norm_ffn_w, *w_in, *da_lambda, *da_subln_w, *hg_lb, *hg_norm_w;
  const float *rw_mu, *rw_w0, *rw_w2, *rw_a0, *rw_a2, *rw_g2, *rw_k_k, *rw_k_a, *rw_r_k, *rw_gn_w, *rw_gn_b;
  const float *rw_v0, *rw_v1, *rw_v2, *w_br_a, *w_br_b, *w_br_c, *w_out, *ffn_w_in, *ffn_w_out, *final_norm_w;
  float* out;
  bf16_t* wt; float* ada; bf16_t* h; bf16_t* u; bf16_t* vT; bf16_t* vfirst; float* vlo; unsigned* counters;
};

DEV unsigned short f2bf(float f) { unsigned u = __float_as_uint(f); u += 0x7FFFu + ((u >> 16) & 1u); return (unsigned short)(u >> 16); }
DEV float bf2f(unsigned short h) { return __uint_as_float(((unsigned)h) << 16); }
DEV unsigned pack2(float a, float b) { return (unsigned)f2bf(a) | ((unsigned)f2bf(b) << 16); }
DEV float sigm(float x) { return 1.f / (1.f + __expf(-x)); }
DEV float lo16(unsigned v) { return __uint_as_float(v << 16); }
DEV float hi16(unsigned v) { return __uint_as_float(v & 0xFFFF0000u); }
#define UNPACK8(v, f) { f[0]=lo16(v.x); f[1]=hi16(v.x); f[2]=lo16(v.y); f[3]=hi16(v.y); f[4]=lo16(v.z); f[5]=hi16(v.z); f[6]=lo16(v.w); f[7]=hi16(v.w); }
#define PACK8(f) make_uint4(pack2(f[0],f[1]), pack2(f[2],f[3]), pack2(f[4],f[5]), pack2(f[6],f[7]))
template <int CTRL> DEV float dpp(float x) { return __int_as_float(__builtin_amdgcn_update_dpp(0, __float_as_int(x), CTRL, 0xF, 0xF, true)); }
DEV float red8_sum(float x) { x += dpp<0xB1>(x); x += dpp<0x4E>(x); x += dpp<0x141>(x); return x; }
DEV float red16_sum(float x) { x = red8_sum(x); x += dpp<0x140>(x); return x; }
DEV float red16_max(float x) { x = fmaxf(x, dpp<0xB1>(x)); x = fmaxf(x, dpp<0x4E>(x)); x = fmaxf(x, dpp<0x141>(x)); x = fmaxf(x, dpp<0x140>(x)); return x; }
DEV float wave_sum(float x) {
#pragma unroll
  for (int o = 32; o >= 1; o >>= 1) x += __shfl_xor(x, o, 64);
  return x;
}
DEV int opaque_tid() { int t = threadIdx.x; asm volatile("" : "+v"(t)); return t; }
DEV bf16x8 as_frag(uint4 v) { union { uint4 u; bf16x8 b; } c; c.u = v; return c.b; }
#define MFMA(a, b, c) __builtin_amdgcn_mfma_f32_16x16x32_bf16(a, b, c, 0, 0, 0)

template <int NT>
DEV void gemm_tile(const int tid, const bf16_t* A, int lda, const bf16_t* B, int ldb, int K, char* smem,
                   f32x4 (&acc)[4][NT]) {
  constexpr int BN = NT * 32;
  constexpr int LS = 64;
  bf16_t* As = (bf16_t*)smem;
  bf16_t* Bs = As + 2 * 128 * LS;
  const int lane = tid & 63, wave = tid >> 6, wr = wave >> 1, wc = wave & 1;
  const int fr = lane & 15, fq = lane >> 4;
  constexpr int NB = BN * 8 / 256;
#pragma unroll
  for (int m = 0; m < 4; ++m)
#pragma unroll
    for (int n = 0; n < NT; ++n) acc[m][n] = (f32x4){0.f, 0.f, 0.f, 0.f};
  const int nk = K >> 6;
  const int lrow = tid >> 3, lcc = tid & 7;
  const bf16_t* Ap = A + (size_t)lrow * lda + ((lcc ^ (lrow & 7)) * 8);
  const bf16_t* Bp = B + (size_t)lrow * ldb + ((lcc ^ (lrow & 7)) * 8);
  const size_t a32 = (size_t)32 * lda, b32 = (size_t)32 * ldb;
  const int rofs0 = (fq ^ (fr & 7)) * 8, rofs1 = rofs0 ^ 32;
#define GT_DMA(buf, koff)                                                                                    \
  {                                                                                                          \
    bf16_t* Ad = As + (buf) * 128 * LS + tid * 8;                                                            \
    bf16_t* Bd = Bs + (buf) * BN * LS + tid * 8;                                                             \
    _Pragma("unroll") for (int i = 0; i < 4; ++i)                                                            \
      __builtin_amdgcn_global_load_lds((const unsigned*)(Ap + i * a32 + (koff)), (unsigned*)(Ad + i * 32 * LS), 16, 0, 0); \
    _Pragma("unroll") for (int i = 0; i < NB; ++i)                                                           \
      __builtin_amdgcn_global_load_lds((const unsigned*)(Bp + i * b32 + (koff)), (unsigned*)(Bd + i * 32 * LS), 16, 0, 0); \
  }
  GT_DMA(0, 0)
  asm volatile("s_waitcnt vmcnt(0)" ::: "memory");
  __syncthreads();
  for (int kt = 0; kt < nk; ++kt) {
    const int buf = kt & 1;
    if (kt + 1 < nk) GT_DMA(buf ^ 1, (kt + 1) * 64)
    const bf16_t* Ab = As + buf * 128 * LS + (wr * 64 + fr) * LS;
    const bf16_t* Bb = Bs + buf * BN * LS + (wc * (NT * 16) + fr) * LS;
#pragma unroll
    for (int ks = 0; ks < 2; ++ks) {
      const int ro = ks ? rofs1 : rofs0;
      bf16x8 af[4], bfr[NT];
#pragma unroll
      for (int m = 0; m < 4; ++m) af[m] = *(const bf16x8*)(Ab + m * 16 * LS + ro);
#pragma unroll
      for (int n = 0; n < NT; ++n) bfr[n] = *(const bf16x8*)(Bb + n * 16 * LS + ro);
#pragma unroll
      for (int m = 0; m < 4; ++m)
#pragma unroll
        for (int n = 0; n < NT; ++n) acc[m][n] = MFMA(af[m], bfr[n], acc[m][n]);
    }
    asm volatile("s_waitcnt vmcnt(0)" ::: "memory");
    __syncthreads();
  }
#undef GT_DMA
}

template <int NT>
DEV void stage_acc(const int tid, float* Cs, const f32x4 (&acc)[4][NT]) {
  constexpr int LDC = NT * 32 + 4;
  const int lane = tid & 63, wave = tid >> 6, wr = wave >> 1, wc = wave & 1, fr = lane & 15, fq = lane >> 4;
#pragma unroll
  for (int m = 0; m < 4; ++m)
#pragma unroll
    for (int n = 0; n < NT; ++n)
#pragma unroll
      for (int j = 0; j < 4; ++j) Cs[(wr * 64 + m * 16 + fq * 4 + j) * LDC + wc * (NT * 16) + n * 16 + fr] = acc[m][n][j];
}

DEV void gemm_tile256(const int tid, const bf16_t* A, int lda, const bf16_t* B, int ldb, int K, char* smem,
                      f32x4 (&acc)[8][4]) {
  bf16_t* As = (bf16_t*)smem;
  bf16_t* Bs = As + 3 * 8192;
  const int lane = tid & 63, wave = tid >> 6, wr = wave >> 1, wc = wave & 1;
  const int fr = lane & 15, fq = lane >> 4;
#pragma unroll
  for (int m = 0; m < 8; ++m)
#pragma unroll
    for (int n = 0; n < 4; ++n) acc[m][n] = (f32x4){0.f, 0.f, 0.f, 0.f};
  const int nk = K >> 5;
  const int drow = tid >> 2, dphys = tid & 3, dg = (0 - (tid >> 4)) & 3;
  const bf16_t* Ap = A + (size_t)drow * lda + ((dphys ^ dg) * 8);
  const bf16_t* Bp = B + (size_t)drow * ldb + ((dphys ^ dg) * 8);
  const size_t a64 = (size_t)64 * lda, b64 = (size_t)64 * ldb;
  const int rofs = (fq ^ ((0 - (fr >> 2)) & 3)) * 8;
#define G2_DMA(st, kk)                                                                                        \
  {                                                                                                           \
    bf16_t* Ad = As + (st) * 8192 + tid * 8;                                                                  \
    bf16_t* Bd = Bs + (st) * 4096 + tid * 8;                                                                  \
    _Pragma("unroll") for (int i = 0; i < 4; ++i)                                                             \
      __builtin_amdgcn_global_load_lds((const unsigned*)(Ap + i * a64 + (kk) * 32), (unsigned*)(Ad + i * 2048), 16, 0, 0); \
    _Pragma("unroll") for (int i = 0; i < 2; ++i)                                                             \
      __builtin_amdgcn_global_load_lds((const unsigned*)(Bp + i * b64 + (kk) * 32), (unsigned*)(Bd + i * 2048), 16, 0, 0); \
  }
  G2_DMA(0, 0)
  G2_DMA(1, 1)
  int st = 0;
  for (int kt = 0; kt < nk; ++kt) {
    if (kt + 1 < nk) asm volatile("s_waitcnt vmcnt(6)" ::: "memory");
    else asm volatile("s_waitcnt vmcnt(0)" ::: "memory");
    __builtin_amdgcn_s_barrier();
    asm volatile("" ::: "memory");
    const int s2 = (st >= 1) ? st - 1 : 2;
    const bool pf = (kt + 2 < nk);
    bf16_t* Ad = As + s2 * 8192 + tid * 8;
    bf16_t* Bd = Bs + s2 * 4096 + tid * 8;
    const bf16_t* Asrc = Ap + (kt + 2) * 32;
    const bf16_t* Bsrc = Bp + (kt + 2) * 32;
    const bf16_t* Ab = As + st * 8192 + (wr * 128 + fr) * 32 + rofs;
    const bf16_t* Bb = Bs + st * 4096 + (wc * 64 + fr) * 32 + rofs;
    bf16x8 bfr[4], af[4];
#pragma unroll
    for (int n = 0; n < 4; ++n) bfr[n] = *(const bf16x8*)(Bb + n * 512);
#pragma unroll
    for (int m = 0; m < 4; ++m) af[m] = *(const bf16x8*)(Ab + m * 512);
#pragma unroll
    for (int m = 0; m < 8; ++m) {
#pragma unroll
      for (int n = 0; n < 4; ++n) acc[m][n] = MFMA(af[m & 3], bfr[n], acc[m][n]);
      if (m + 4 < 8) af[m & 3] = *(const bf16x8*)(Ab + (m + 4) * 512);
      if (pf) {
        if (m < 4) __builtin_amdgcn_global_load_lds((const unsigned*)(Asrc + m * a64), (unsigned*)(Ad + m * 2048), 16, 0, 0);
        else if (m < 6) __builtin_amdgcn_global_load_lds((const unsigned*)(Bsrc + (m - 4) * b64), (unsigned*)(Bd + (m - 4) * 2048), 16, 0, 0);
      }
      __builtin_amdgcn_sched_barrier(0);
    }
    st = (st == 2) ? 0 : st + 1;
  }
#undef G2_DMA
  __syncthreads();
}

template <int PS>
DEV void stage_half(const int tid, float* Cs, const f32x4 (&acc)[8][4]) {
  const int lane = tid & 63, wave = tid >> 6, wr = wave >> 1, wc = wave & 1, fr = lane & 15, fq = lane >> 4;
#pragma unroll
  for (int m = 0; m < 4; ++m)
#pragma unroll
    for (int n = 0; n < 4; ++n)
#pragma unroll
      for (int j = 0; j < 4; ++j) Cs[(wr * 64 + m * 16 + fq * 4 + j) * 132 + wc * 64 + n * 16 + fr] = acc[PS * 4 + m][n][j];
}
#define RMAP(r, ps) ((((r) >> 6) << 7) + (ps) * 64 + ((r) & 63))

DEV bool tile_for(int it, int nM, int nN, int& tm, int& tn) {
  const int nx = gridDim.x >> 3;
  const int xcd = blockIdx.x & 7, local = blockIdx.x >> 3;
  const long id = ((long)it * 8 + xcd) * nx + local;
  if (local >= nx || id >= (long)nM * nN) return false;
  const int per_group = 8 * nN;
  const int g = (int)(id / per_group), r = (int)(id % per_group);
  tn = r >> 3; tm = g * 8 + (r & 7);
  return true;
}

PHASE void phase_prep(const Params& p, char* smem) {
  const int tid = opaque_tid();
  if (blockIdx.x == 0 && tid < 8) p.counters[tid] = 0u;
  if (blockIdx.x == 0) for (int i = tid; i < 3456; i += 256) p.counters[256 + i] = 0u;
  float* tile = (float*)smem;
  const int NCONV = 2 * 4864, NADA = 192;
  for (int item0 = blockIdx.x; item0 < NCONV + NADA; item0 += gridDim.x) {
    const int item = (item0 < NADA) ? (NCONV + item0) : (item0 - NADA);
    if (item < NCONV) {
      const int l = item / 4864; int r = item % 4864;
      const float* src; int K, Nsrc, nT, perm = 0; size_t dst;
      if (r < 2112) { src = p.w_in + (size_t)l * 1024 * 8448; K = 1024; Nsrc = 8448; dst = WIN; nT = 132; }
      else if (r < 2240) { r -= 2112; src = p.w_br_a + (size_t)l * 512 * 1024; K = 512; Nsrc = 1024; dst = WBA; nT = 16; }
      else if (r < 2368) { r -= 2240; src = p.w_br_b + (size_t)l * 512 * 1024; K = 512; Nsrc = 1024; dst = WBB; nT = 16; }
      else if (r < 2496) { r -= 2368; src = p.w_br_c + (size_t)l * 512 * 1024; K = 512; Nsrc = 1024; dst = WBC; nT = 16; }
      else if (r < 2752) { r -= 2496; src = p.w_out + (size_t)l * 1024 * 1024; K = 1024; Nsrc = 1024; dst = WOUT; nT = 16; }
      else if (r < 4160) { r -= 2752; src = p.ffn_w_in + (size_t)l * 1024 * 5632; K = 1024; Nsrc = 5632; dst = WFI; nT = 88; perm = 1; }
      else { r -= 4160; src = p.ffn_w_out + (size_t)l * 2816 * 1024; K = 2816; Nsrc = 1024; dst = WFO; nT = 16; }
      const int kt = r / nT, nt = r % nT;
      const int colbase = perm ? ((nt & 1) * FFH + 64 * (nt >> 1)) : nt * 64;
      __syncthreads();
#pragma unroll
      for (int i = 0; i < 16; ++i) {
        const int k = i * 4 + (tid >> 6), j = tid & 63;
        tile[k * 65 + j] = src[(size_t)(kt * 64 + k) * Nsrc + colbase + j];
      }
      __syncthreads();
      const int row = tid >> 2, kc = (tid & 3) * 16;
      float f[16];
#pragma unroll
      for (int i = 0; i < 16; ++i) f[i] = tile[(kc + i) * 65 + row];
      bf16_t* d = p.wt + (size_t)l * WLAYER + dst + (size_t)(nt * 64 + row) * K + kt * 64 + kc;
      *(uint4*)d = make_uint4(pack2(f[0], f[1]), pack2(f[2], f[3]), pack2(f[4], f[5]), pack2(f[6], f[7]));
      *(uint4*)(d + 8) = make_uint4(pack2(f[8], f[9]), pack2(f[10], f[11]), pack2(f[12], f[13]), pack2(f[14], f[15]));
    } else {
      const int a = item - NCONV;
      const int l = a / 96, r = a % 96, ntile = r >> 2, bg = r & 3;
      float* cact = (float*)smem;
      __syncthreads();
      for (int i = tid; i < 8 * 1024; i += 256) {
        const float cv = p.c[(size_t)(bg * 8 + (i >> 10)) * DM + (i & 1023)];
        cact[i] = cv * sigm(cv);
      }
      __syncthreads();
      const int n = ntile * 256 + tid;
      const float* W = p.ada_w + (size_t)l * DM * ADAW + n;
      float acc[8];
#pragma unroll
      for (int b = 0; b < 8; ++b) acc[b] = 0.f;
      for (int k0 = 0; k0 < DM; k0 += 16) {
        float w[16];
#pragma unroll
        for (int kk = 0; kk < 16; ++kk) w[kk] = W[(size_t)(k0 + kk) * ADAW];
#pragma unroll
        for (int kk = 0; kk < 16; ++kk)
#pragma unroll
          for (int b = 0; b < 8; ++b) acc[b] += cact[b * 1024 + k0 + kk] * w[kk];
      }
      const float bias = p.ada_b[l * ADAW + n];
#pragma unroll
      for (int b = 0; b < 8; ++b) p.ada[((size_t)l * 32 + bg * 8 + b) * ADAW + n] = acc[b] + bias;
    }
  }
}

PHASE void phase_norm(const float* __restrict__ x, const float* __restrict__ w, const float* __restrict__ ada_l,
                    int shift_off, int scale_off, bf16_t* __restrict__ h) {
  const int tid = opaque_tid();
  const int lane = tid & 63, wave = tid >> 6;
  for (int row = blockIdx.x * 4 + wave; row < T_TOK; row += gridDim.x * 4) {
    const float* xr = x + (size_t)row * DM;
    float4 v[4]; float ss = 0.f;
#pragma unroll
    for (int i = 0; i < 4; ++i) { v[i] = *(const float4*)(xr + i * 256 + lane * 4); ss += v[i].x * v[i].x + v[i].y * v[i].y + v[i].z * v[i].z + v[i].w * v[i].w; }
    ss = wave_sum(ss);
    const float rstd = rsqrtf(ss * (1.f / DM) + 1e-6f);
    const float* ad = ada_l + (size_t)(row / SEQ) * ADAW;
#pragma unroll
    for (int i = 0; i < 4; ++i) {
      const int col = i * 256 + lane * 4;
      const float4 ww = *(const float4*)(w + col), sc = *(const float4*)(ad + scale_off + col), sh = *(const float4*)(ad + shift_off + col);
      const float o0 = v[i].x * rstd * ww.x * (1.f + sc.x) + sh.x, o1 = v[i].y * rstd * ww.y * (1.f + sc.y) + sh.y;
      const float o2 = v[i].z * rstd * ww.z * (1.f + sc.z) + sh.z, o3 = v[i].w * rstd * ww.w * (1.f + sc.w) + sh.w;
      *(uint2*)(h + (size_t)row * DM + col) = make_uint2(pack2(o0, o1), pack2(o2, o3));
    }
  }
}

PHASE void phase_final(float* __restrict__ x, const float* __restrict__ w) {
  const int tid = opaque_tid();
  const int lane = tid & 63, wave = tid >> 6;
  for (int row = blockIdx.x * 4 + wave; row < T_TOK; row += gridDim.x * 4) {
    float* xr = x + (size_t)row * DM;
    float4 v[4]; float ss = 0.f;
#pragma unroll
    for (int i = 0; i < 4; ++i) { v[i] = *(const float4*)(xr + i * 256 + lane * 4); ss += v[i].x * v[i].x + v[i].y * v[i].y + v[i].z * v[i].z + v[i].w * v[i].w; }
    ss = wave_sum(ss);
    const float rstd = rsqrtf(ss * (1.f / DM) + 1e-6f);
#pragma unroll
    for (int i = 0; i < 4; ++i) {
      const int col = i * 256 + lane * 4;
      const float4 ww = *(const float4*)(w + col);
      *(float4*)(xr + col) = make_float4(v[i].x * rstd * ww.x, v[i].y * rstd * ww.y, v[i].z * rstd * ww.z, v[i].w * rstd * ww.w);
    }
  }
}

PHASE void phase_gemm_in(const Params& p, int l, char* smem) {
  const bf16_t* Wt = p.wt + (size_t)l * WLAYER + WIN;
  float* Cs = (float*)smem;
  const int tid = opaque_tid();
  for (int it = 0;; ++it) {
    int tm, tn;
    if (!tile_for(it, 256, 42, tm, tn)) break;
    f32x4 acc[8][4];
    gemm_tile256(tid, p.h + (size_t)tm * 256 * DM, DM, Wt + (size_t)tn * 128 * DM, DM, DM, smem, acc);
    const size_t row0 = (size_t)tm * 256;
#pragma unroll
    for (int ps = 0; ps < 2; ++ps) {
      if (ps == 0) stage_half<0>(tid, Cs, acc); else stage_half<1>(tid, Cs, acc);
      __syncthreads();
      if (tn < 8) {
        const float qs = (tn < 4) ? 0.125f : 1.f;
        const int ch = tid & 15, g = ch >> 3, cc = ch & 7;
        if (cc < 4) {
#pragma unroll 1
          for (int i = 0; i < 8; ++i) {
            const int r = (tid >> 4) + i * 16;
            const size_t grow = row0 + RMAP(r, ps);
            const float pos = (float)p.pos[grow];
            const float* c1 = Cs + r * 132 + g * 64 + cc * 8;
            float o1[8], o2[8];
#pragma unroll
            for (int e = 0; e < 8; ++e) {
              const float x1 = c1[e], x2 = c1[32 + e];
              const float inv = exp2f(-(float)(cc * 8 + e) * 0.41524101186092029f);
              float rev = pos * inv * 0.15915494309189535f;
              rev -= rintf(rev);
              const float sn = __builtin_amdgcn_sinf(rev), cs = __builtin_amdgcn_cosf(rev);
              o1[e] = (x1 * cs - x2 * sn) * qs; o2[e] = (x2 * cs + x1 * sn) * qs;
            }
            bf16_t* d = p.u + grow * US + tn * 128 + g * 64 + cc * 8;
            *(uint4*)d = PACK8(o1);
            *(uint4*)(d + 32) = PACK8(o2);
          }
        }
      } else if (tn < 12) {
        const int b = (int)(row0 / SEQ), s0 = (int)(row0 % SEQ), vc0 = (tn - 8) * 128;
        const int rch = tid & 15;
#pragma unroll 1
        for (int i = 0; i < 8; ++i) {
          const int c = (tid >> 4) + i * 16;
          float f[8];
#pragma unroll
          for (int j = 0; j < 8; ++j) f[j] = Cs[(rch * 8 + j) * 132 + c];
          *(uint4*)(p.vT + ((size_t)b * 512 + vc0 + c) * SEQ + s0 + RMAP(rch * 8, ps)) = PACK8(f);
        }
      } else {
        const int ch = tid & 15;
#pragma unroll 1
        for (int i = 0; i < 8; ++i) {
          const int r = (tid >> 4) + i * 16;
          const float4 a = *(const float4*)(Cs + r * 132 + ch * 8), b = *(const float4*)(Cs + r * 132 + ch * 8 + 4);
          *(uint4*)(p.u + (row0 + RMAP(r, ps)) * US + tn * 128 - 512 + ch * 8) = make_uint4(pack2(a.x, a.y), pack2(a.z, a.w), pack2(b.x, b.y), pack2(b.z, b.w));
        }
      }
      __syncthreads();
    }
  }
}

PHASE void phase_vlo(const Params& p, int l, char* smem) {
  float* vs = (float*)smem;
  const int tid = opaque_tid();
  const float* mu = p.rw_mu + (size_t)l * 1792 + 1024;
  const float* v1 = p.rw_v1;
  for (int item = blockIdx.x; item < T_TOK / 32; item += gridDim.x) {
    const size_t tok0 = (size_t)item * 32;
    __syncthreads();
#pragma unroll 1
    for (int i = 0; i < 8; ++i) {
      const int c = tid + i * 256;
      const int t = c >> 6, cc = c & 63;
      const size_t tok = tok0 + t;
      const uint4 cur = *(const uint4*)(p.u + tok * US + 3072 + 1024 + cc * 8);
      uint4 prv = make_uint4(0, 0, 0, 0);
      if ((tok % SEQ) != 0) prv = *(const uint4*)(p.u + (tok - 1) * US + 3072 + 1024 + cc * 8);
      float a[8], b[8];
      UNPACK8(cur, a); UNPACK8(prv, b);
#pragma unroll
      for (int e = 0; e < 8; ++e) vs[t * 512 + cc * 8 + e] = a[e] + (b[e] - a[e]) * mu[cc * 8 + e];
    }
    __syncthreads();
    const int j = tid & 31, tg = tid >> 5;
    float acc[4] = {0.f, 0.f, 0.f, 0.f};
    for (int k0 = 0; k0 < 512; k0 += 16) {
      float w[16];
#pragma unroll
      for (int kk = 0; kk < 16; ++kk) w[kk] = v1[(k0 + kk) * 32 + j];
#pragma unroll
      for (int kk = 0; kk < 16; ++kk)
#pragma unroll
        for (int i = 0; i < 4; ++i) acc[i] += vs[(tg * 4 + i) * 512 + k0 + kk] * w[kk];
    }
#pragma unroll
    for (int i = 0; i < 4; ++i) p.vlo[(tok0 + tg * 4 + i) * 32 + j] = acc[i];
  }
}

PHASE void att_item(const Params& p, int l, int item, char* smem) {
  const int qc = 31 - (item >> 7);
  const int bh = item & 127, b = bh >> 2, h = bh & 3;
  const int tid = opaque_tid(), lane = tid & 63, wave = tid >> 6, fr = lane & 15, fq = lane >> 4;
  const int m = wave >> 1, rh = wave & 1;
  bf16_t* Ks = (bf16_t*)smem;
  bf16_t* Vt = Ks + 2 * 64 * 64;
  bf16_t* Ps = Vt + 128 * 64;
  float* Ox = (float*)smem;
  const size_t tok0 = (size_t)b * SEQ + (size_t)qc * 64;
  const float* lv = p.da_lambda + (size_t)l * 256;
  float d1 = 0.f, d2 = 0.f;
  for (int i = 0; i < 64; ++i) { d1 += lv[i] * lv[64 + i]; d2 += lv[128 + i] * lv[192 + i]; }
  const float lam_init = 0.8f - 0.6f * __expf(-0.3f * (float)l);
  const float lam = __expf(d1) - __expf(d2) + lam_init;

  bf16x8 qf[2][2];
#pragma unroll
  for (int mt = 0; mt < 2; ++mt)
#pragma unroll
    for (int ks = 0; ks < 2; ++ks)
      qf[mt][ks] = *(const bf16x8*)(p.u + (tok0 + rh * 32 + mt * 16 + fr) * US + h * 128 + m * 64 + ks * 32 + fq * 8);
  f32x4 o[2][8];
  float mx[2][4], ls[2][4];
#pragma unroll
  for (int mt = 0; mt < 2; ++mt) {
#pragma unroll
    for (int n = 0; n < 8; ++n) o[mt][n] = (f32x4){0.f, 0.f, 0.f, 0.f};
#pragma unroll
    for (int j = 0; j < 4; ++j) { mx[mt][j] = -1e30f; ls[mt][j] = 0.f; }
  }
  bf16_t* Pw = Ps + wave * 32 * 72;
  const int drow = tid >> 3, dlog = ((tid & 7) ^ ((tid >> 3) & 7)) * 8;
  const bf16_t* Kg = p.u + ((size_t)b * SEQ + (drow & 63)) * US + 512 + h * 128 + dlog;
  const bf16_t* Vg = p.vT + ((size_t)b * 512 + h * 128 + drow) * SEQ + dlog;
  const int rsw = fr & 7;
#define ATT_DMA_K(kt_)                                                                                              \
  _Pragma("unroll") for (int i = 0; i < 4; ++i)                                                                     \
    __builtin_amdgcn_global_load_lds((const unsigned*)(Kg + ((size_t)(kt_) * 64 + (i & 1) * 32) * US + (i >> 1) * 64), \
                                     (unsigned*)(Ks + tid * 8 + i * 2048), 16, 0, 0);
#define ATT_DMA_V(kt_)                                                                                              \
  _Pragma("unroll") for (int i = 0; i < 4; ++i)                                                                     \
    __builtin_amdgcn_global_load_lds((const unsigned*)(Vg + (size_t)(i * 32) * SEQ + (kt_) * 64),                  \
                                     (unsigned*)(Vt + tid * 8 + i * 2048), 16, 0, 0);
  __syncthreads();
  ATT_DMA_K(0)
  for (int kt = 0; kt <= qc; ++kt) {
    asm volatile("s_waitcnt vmcnt(0)" ::: "memory");
    __syncthreads();
    ATT_DMA_V(kt)
    f32x4 s[2][4];
#pragma unroll
    for (int mt = 0; mt < 2; ++mt)
#pragma unroll
      for (int n = 0; n < 4; ++n) s[mt][n] = (f32x4){0.f, 0.f, 0.f, 0.f};
#pragma unroll
    for (int ks = 0; ks < 2; ++ks)
#pragma unroll
      for (int n = 0; n < 4; ++n) {
        const bf16x8 kf = *(const bf16x8*)(Ks + (m * 64 + n * 16 + fr) * 64 + (((ks * 4 + fq) ^ rsw) * 8));
#pragma unroll
        for (int mt = 0; mt < 2; ++mt) s[mt][n] = MFMA(qf[mt][ks], kf, s[mt][n]);
      }
#pragma unroll
    for (int mt = 0; mt < 2; ++mt)
#pragma unroll
      for (int j = 0; j < 4; ++j) {
        float tmax = fmaxf(fmaxf(s[mt][0][j], s[mt][1][j]), fmaxf(s[mt][2][j], s[mt][3][j]));
        tmax = red16_max(tmax);
        const float mnew = fmaxf(mx[mt][j], tmax);
        const float alpha = __expf(mx[mt][j] - mnew);
        float rs = 0.f;
#pragma unroll
        for (int n = 0; n < 4; ++n) {
          const float pv = __expf(s[mt][n][j] - mnew);
          rs += pv;
          Pw[(mt * 16 + fq * 4 + j) * 72 + n * 16 + fr] = f2bf(pv);
        }
        rs = red16_sum(rs);
        ls[mt][j] = ls[mt][j] * alpha + rs;
        mx[mt][j] = mnew;
#pragma unroll
        for (int n = 0; n < 8; ++n) o[mt][n][j] *= alpha;
      }
    asm volatile("s_waitcnt vmcnt(0)" ::: "memory");
    __syncthreads();
    if (kt < qc) { ATT_DMA_K(kt + 1) }
#pragma unroll
    for (int ks = 0; ks < 2; ++ks) {
      bf16x8 pf[2];
#pragma unroll
      for (int mt = 0; mt < 2; ++mt) pf[mt] = *(const bf16x8*)(Pw + (mt * 16 + fr) * 72 + ks * 32 + fq * 8);
#pragma unroll
      for (int n = 0; n < 8; ++n) {
        const bf16x8 vf = *(const bf16x8*)(Vt + (n * 16 + fr) * 64 + (((ks * 4 + fq) ^ rsw) * 8));
#pragma unroll
        for (int mt = 0; mt < 2; ++mt) o[mt][n] = MFMA(pf[mt], vf, o[mt][n]);
      }
    }
  }
#undef ATT_DMA_K
#undef ATT_DMA_V
  __syncthreads();
#pragma unroll
  for (int mt = 0; mt < 2; ++mt)
#pragma unroll
    for (int j = 0; j < 4; ++j) {
      const float inv = 1.f / ls[mt][j];
#pragma unroll
      for (int n = 0; n < 8; ++n) o[mt][n][j] *= inv;
    }
  if (m == 1) {
#pragma unroll
    for (int mt = 0; mt < 2; ++mt)
#pragma unroll
      for (int n = 0; n < 8; ++n)
#pragma unroll
        for (int j = 0; j < 4; ++j) Ox[(rh * 32 + mt * 16 + fq * 4 + j) * 132 + n * 16 + fr] = o[mt][n][j];
  }
  __syncthreads();
  if (m == 0) {
    const float* sw = p.da_subln_w + (size_t)l * 128;
    float wv[8];
#pragma unroll
    for (int n = 0; n < 8; ++n) wv[n] = sw[n * 16 + fr] * (1.f - lam_init);
#pragma unroll
    for (int mt = 0; mt < 2; ++mt)
#pragma unroll
      for (int j = 0; j < 4; ++j) {
        float ss = 0.f;
        float d[8];
#pragma unroll
        for (int n = 0; n < 8; ++n) {
          d[n] = o[mt][n][j] - lam * Ox[(rh * 32 + mt * 16 + fq * 4 + j) * 132 + n * 16 + fr];
          ss += d[n] * d[n];
        }
        ss = red16_sum(ss);
        const float rstd = rsqrtf(ss * (1.f / 128.f) + 1e-6f);
        bf16_t* dst = p.u + (tok0 + rh * 32 + mt * 16 + fq * 4 + j) * US + h * 128 + fr;
#pragma unroll
        for (int n = 0; n < 8; ++n) dst[n * 16] = f2bf(d[n] * rstd * wv[n]);
      }
  }
  __syncthreads();
}

PHASE void hgrn_item(const Params& p, int l, int item, char* smem) {
  const int b = item >> 2, h = item & 3;
  const int tid = opaque_tid(), lane = tid & 63, wave = tid >> 6, fr = lane & 15, fq = lane >> 4;
  bf16_t* Qs = (bf16_t*)smem;
  bf16_t* Kn = Qs + 32 * 136;
  bf16_t* KT = Kn + 32 * 136;
  bf16_t* VT = KT + 128 * 40;
  bf16_t* Ps = VT + 128 * 40;
  bf16_t* ST = Ps + 32 * 40;
  float* lfb = (float*)ST;
  float* red = (float*)(ST + 128 * 136);
  float* blast = red + 64;
  const int t_ = tid >> 3, d0 = (tid & 7) * 16;
  float lbv[16];
#pragma unroll
  for (int i = 0; i < 16; ++i) {
    const int c = h * 128 + d0 + i;
    lbv[i] = (l == 0) ? 0.f : sigm(p.hg_lb[512 + c] - p.hg_lb[c]);
  }
  f32x4 S[2][8];
#pragma unroll
  for (int mm = 0; mm < 2; ++mm)
#pragma unroll
    for (int n = 0; n < 8; ++n) S[mm][n] = (f32x4){0.f, 0.f, 0.f, 0.f};
  const float* nw = p.hg_norm_w + (size_t)l * 128;

  for (int ch = 0; ch < 64; ++ch) {
    const size_t tok0 = (size_t)b * SEQ + (size_t)ch * 32;
    __syncthreads();
    float qv[16], kv[16];
    {
      const bf16_t* base = p.u + (tok0 + t_) * US + h * 128 + d0;
      float zv[16], iv[16];
      { const uint4 a = *(const uint4*)(base + 1024), c = *(const uint4*)(base + 1024 + 8); float* z0 = zv; float* z1 = zv + 8; UNPACK8(a, z0); UNPACK8(c, z1); }
      { const uint4 a = *(const uint4*)(base + 1536), c = *(const uint4*)(base + 1536 + 8); float* z0 = iv; float* z1 = iv + 8; UNPACK8(a, z0); UNPACK8(c, z1); }
      { const uint4 a = *(const uint4*)(base + 2048), c = *(const uint4*)(base + 2048 + 8); float* z0 = qv; float* z1 = qv + 8; UNPACK8(a, z0); UNPACK8(c, z1); }
#pragma unroll
      for (int i = 0; i < 16; ++i) {
        const float z = zv[i], lb = lbv[i];
        const float ez = __expf(-fabsf(z));
        float lf;
        if (lb > 0.f) {
          const float sg = (z >= 0.f) ? 1.f / (1.f + ez) : ez / (1.f + ez);
          lf = __logf(lb + (1.f - lb) * sg);
        } else {
          lf = -(fmaxf(-z, 0.f) + __logf(1.f + ez));
        }
        const float sgn = (z >= 0.f) ? ez / (1.f + ez) : 1.f / (1.f + ez);
        kv[i] = (1.f - lb) * sgn;
        lfb[t_ * 128 + d0 + i] = lf;
        VT[(d0 + i) * 40 + t_] = f2bf(iv[i]);
      }
    }
    __syncthreads();
    if (tid < 128) {
      float v[32];
#pragma unroll
      for (int t = 0; t < 32; ++t) v[t] = lfb[t * 128 + tid];
      float bsum = 0.f;
#pragma unroll
      for (int t = 0; t < 32; ++t) { bsum += v[t]; lfb[t * 128 + tid] = bsum; }
      blast[tid] = bsum;
    }
    __syncthreads();
    {
      float qo[16], ko[16];
#pragma unroll
      for (int i = 0; i < 16; ++i) {
        const float bb = lfb[t_ * 128 + d0 + i];
        qo[i] = qv[i] * __expf(bb);
        ko[i] = kv[i] * __expf(fminf(-bb, 80.f));
        KT[(d0 + i) * 40 + t_] = f2bf(ko[i]);
      }
      float* q0 = qo; float* q1 = qo + 8; float* k0 = ko; float* k1 = ko + 8;
      *(uint4*)(Qs + t_ * 136 + d0) = PACK8(q0);
      *(uint4*)(Qs + t_ * 136 + d0 + 8) = PACK8(q1);
      *(uint4*)(Kn + t_ * 136 + d0) = PACK8(k0);
      *(uint4*)(Kn + t_ * 136 + d0 + 8) = PACK8(k1);
    }
    __syncthreads();
#pragma unroll
    for (int mm = 0; mm < 2; ++mm)
#pragma unroll
      for (int n = 0; n < 8; ++n)
        *(uint2*)(ST + (n * 16 + fr) * 136 + wave * 32 + mm * 16 + fq * 4) =
            make_uint2(pack2(S[mm][n][0], S[mm][n][1]), pack2(S[mm][n][2], S[mm][n][3]));
    {
      const int mt = wave >> 1, nt = wave & 1;
      f32x4 sc = (f32x4){0.f, 0.f, 0.f, 0.f};
#pragma unroll
      for (int ks = 0; ks < 4; ++ks) {
        const bf16x8 a = *(const bf16x8*)(Qs + (mt * 16 + fr) * 136 + ks * 32 + fq * 8);
        const bf16x8 bb = *(const bf16x8*)(Kn + (nt * 16 + fr) * 136 + ks * 32 + fq * 8);
        sc = MFMA(a, bb, sc);
      }
#pragma unroll
      for (int j = 0; j < 4; ++j) {
        const int t = mt * 16 + fq * 4 + j, key = nt * 16 + fr;
        Ps[t * 40 + key] = f2bf(key <= t ? sc[j] : 0.f);
      }
    }
    __syncthreads();
    {
      const int mt = wave & 1, nb = (wave >> 1) * 4;
      f32x4 oo[4];
#pragma unroll
      for (int n = 0; n < 4; ++n) oo[n] = (f32x4){0.f, 0.f, 0.f, 0.f};
      {
        const bf16x8 a = *(const bf16x8*)(Ps + (mt * 16 + fr) * 40 + fq * 8);
#pragma unroll
        for (int n = 0; n < 4; ++n) {
          const bf16x8 bb = *(const bf16x8*)(VT + ((nb + n) * 16 + fr) * 40 + fq * 8);
          oo[n] = MFMA(a, bb, oo[n]);
        }
      }
#pragma unroll
      for (int ks = 0; ks < 4; ++ks) {
        const bf16x8 a = *(const bf16x8*)(Qs + (mt * 16 + fr) * 136 + ks * 32 + fq * 8);
#pragma unroll
        for (int n = 0; n < 4; ++n) {
          const bf16x8 bb = *(const bf16x8*)(ST + ((nb + n) * 16 + fr) * 136 + ks * 32 + fq * 8);
          oo[n] = MFMA(a, bb, oo[n]);
        }
      }
#pragma unroll
      for (int j = 0; j < 4; ++j) {
        float ss = 0.f;
#pragma unroll
        for (int n = 0; n < 4; ++n) ss += oo[n][j] * oo[n][j];
        ss = red16_sum(ss);
        if (fr == 0) red[(mt * 16 + fq * 4 + j) * 2 + (wave >> 1)] = ss;
      }
      __syncthreads();
#pragma unroll
      for (int j = 0; j < 4; ++j) {
        const int t = mt * 16 + fq * 4 + j;
        const float rstd = rsqrtf((red[t * 2] + red[t * 2 + 1]) * (1.f / 128.f) + 1e-6f);
        bf16_t* gp = p.u + (tok0 + t) * US + 2560 + h * 128 + nb * 16 + fr;
#pragma unroll
        for (int n = 0; n < 4; ++n) {
          const float g = bf2f(gp[n * 16]);
          gp[n * 16] = f2bf(oo[n][j] * rstd * nw[(nb + n) * 16 + fr] * (g * sigm(g)));
        }
      }
    }
    {
      bf16x8 af[2];
#pragma unroll
      for (int mm = 0; mm < 2; ++mm) af[mm] = *(const bf16x8*)(KT + (wave * 32 + mm * 16 + fr) * 40 + fq * 8);
#pragma unroll
      for (int n = 0; n < 8; ++n) {
        const bf16x8 bb = *(const bf16x8*)(VT + (n * 16 + fr) * 40 + fq * 8);
#pragma unroll
        for (int mm = 0; mm < 2; ++mm) S[mm][n] = MFMA(af[mm], bb, S[mm][n]);
      }
#pragma unroll
      for (int mm = 0; mm < 2; ++mm)
#pragma unroll
        for (int j = 0; j < 4; ++j) {
          const float e = __expf(blast[wave * 32 + mm * 16 + fq * 4 + j]);
#pragma unroll
          for (int n = 0; n < 8; ++n) S[mm][n][j] *= e;
        }
    }
  }
  __syncthreads();
}

DEV uint4 rw_act(const uint4 cur, const uint4 prv, const float* mul8, int mode) {
  const float4 m0 = *(const float4*)(mul8), m1 = *(const float4*)(mul8 + 4);
  const float mm[8] = {m0.x, m0.y, m0.z, m0.w, m1.x, m1.y, m1.z, m1.w};
  float a[8], b[8], o[8];
  UNPACK8(cur, a); UNPACK8(prv, b);
#pragma unroll
  for (int e = 0; e < 8; ++e) {
    float v = a[e] + (b[e] - a[e]) * mm[e];
    if (mode == 1) { const float t = __expf(-2.f * fabsf(v)); const float th = (1.f - t) / (1.f + t); v = (v >= 0.f) ? th : -th; }
    else if (mode == 2) v = sigm(v);
    o[e] = v;
  }
  return PACK8(o);
}
DEV bf16x8 rw_bfrag(const float* W, int k0, int col) {
  float o[8];
#pragma unroll
  for (int e = 0; e < 8; ++e) o[e] = W[(size_t)(k0 + e) * 512 + col];
  return as_frag(PACK8(o));
}

PHASE void rwkv_item(const Params& p, int l, int item, char* smem) {
  const int b = item >> 3, h = item & 7;
  const int tid = opaque_tid(), lane = tid & 63, wave = tid >> 6, fr = lane & 15, fq = lane >> 4;
  float* R = (float*)smem;
  float* K = R + 2048; float* KK = K + 2048; float* W = KK + 2048; float* BB = W + 2048;
  float* V = BB + 2048; float* G = V + 2048; float* O = G + 2048;
  float* cst = O + 2048;
  float* mul = cst + 512;
  bf16_t* rawL = (bf16_t*)smem;
  float* vloL = (float*)(smem + 17424);
  const float* mu = p.rw_mu + (size_t)l * 1792;
  const int hc_n = h * 64 + wave * 16 + fr;
  bf16x8 w2f[2], a2f[2], g2f[4], v2f;
#pragma unroll
  for (int ks = 0; ks < 2; ++ks) {
    w2f[ks] = rw_bfrag(p.rw_w2 + (size_t)l * 64 * 512, ks * 32 + fq * 8, hc_n);
    a2f[ks] = rw_bfrag(p.rw_a2 + (size_t)l * 64 * 512, ks * 32 + fq * 8, hc_n);
  }
#pragma unroll
  for (int ks = 0; ks < 4; ++ks) g2f[ks] = rw_bfrag(p.rw_g2 + (size_t)l * 128 * 512, ks * 32 + fq * 8, hc_n);
  v2f = w2f[0];
  if (l > 0) v2f = rw_bfrag(p.rw_v2, fq * 8, hc_n);
  const float w0c = p.rw_w0[l * 512 + hc_n], a0c = p.rw_a0[l * 512 + hc_n];
  const float v0c = (l > 0) ? p.rw_v0[hc_n] : 0.f;
  const int t_ = tid >> 3, n0 = (tid & 7) * 8;
  __syncthreads();
  if (tid < 64) {
    const int hc = h * 64 + tid;
    cst[tid] = p.rw_k_k[l * 512 + hc]; cst[64 + tid] = p.rw_k_a[l * 512 + hc]; cst[128 + tid] = p.rw_r_k[l * 512 + hc];
    cst[192 + tid] = p.rw_gn_w[l * 512 + hc]; cst[256 + tid] = p.rw_gn_b[l * 512 + hc];
    cst[320 + tid] = mu[hc]; cst[384 + tid] = mu[512 + hc]; cst[448 + tid] = mu[1024 + hc];
  }
  mul[tid] = mu[1536 + tid];
  const float* kkc = cst + n0; const float* kac = cst + 64 + n0; const float* rkc = cst + 128 + n0;
  const float* gnw = cst + 192 + n0; const float* gnb = cst + 256 + n0;
  const float* mur = cst + 320 + n0; const float* muk = cst + 384 + n0; const float* muv = cst + 448 + n0;
  const int kq = lane & 7, row0 = wave * 16 + (lane >> 3), row1 = row0 + 8;
  f32x2 S0p[4], S1p[4];
#pragma unroll
  for (int e = 0; e < 4; ++e) { S0p[e] = (f32x2){0.f, 0.f}; S1p[e] = (f32x2){0.f, 0.f}; }

  uint4 pl0, pl1, pl2, pl3, pl4, pcr, pck, pcv, ppr, ppk, ppv, pvf;
  float4 pvl;
#define RW_PREFETCH(ch_)                                                                                    \
  {                                                                                                         \
    const size_t tk0 = (size_t)b * SEQ + (size_t)(ch_) * 32;                                                 \
    const bf16_t* lb_ = p.u + (tk0 - 1) * US + 3072 + 1536 + (tid & 31) * 8;                                 \
    const int r0_ = tid >> 5;                                                                               \
    pl0 = make_uint4(0, 0, 0, 0); if (!((ch_) == 0 && r0_ == 0)) pl0 = *(const uint4*)(lb_ + (size_t)r0_ * US); \
    pl1 = *(const uint4*)(lb_ + (size_t)(r0_ + 8) * US);                                                     \
    pl2 = *(const uint4*)(lb_ + (size_t)(r0_ + 16) * US);                                                    \
    pl3 = *(const uint4*)(lb_ + (size_t)(r0_ + 24) * US);                                                    \
    pl4 = make_uint4(0, 0, 0, 0); if (tid < 32) pl4 = *(const uint4*)(lb_ + (size_t)32 * US);                \
    const bf16_t* cu_ = p.u + (tk0 + t_) * US + 3072 + h * 64 + n0;                                          \
    pcr = *(const uint4*)cu_; pck = *(const uint4*)(cu_ + 512); pcv = *(const uint4*)(cu_ + 1024);           \
    if ((ch_) == 0 && t_ == 0) { ppr = make_uint4(0, 0, 0, 0); ppk = ppr; ppv = ppr; }                        \
    else { ppr = *(const uint4*)(cu_ - US); ppk = *(const uint4*)(cu_ - US + 512); ppv = *(const uint4*)(cu_ - US + 1024); } \
    if (l > 0) {                                                                                            \
      pvl = *(const float4*)(p.vlo + (tk0 + (tid >> 3)) * 32 + (tid & 7) * 4);                               \
      pvf = *(const uint4*)(p.vfirst + (tk0 + t_) * 512 + h * 64 + n0);                                      \
    } else { pvl = make_float4(0.f, 0.f, 0.f, 0.f); pvf = make_uint4(0, 0, 0, 0); }                          \
  }
  RW_PREFETCH(0)

  for (int ch = 0; ch < 64; ++ch) {
    const size_t tok0 = (size_t)b * SEQ + (size_t)ch * 32;
    __syncthreads();
    {
      const int r0_ = tid >> 5, cc_ = (tid & 31) * 8;
      *(uint4*)(rawL + r0_ * 264 + cc_) = pl0;
      *(uint4*)(rawL + (r0_ + 8) * 264 + cc_) = pl1;
      *(uint4*)(rawL + (r0_ + 16) * 264 + cc_) = pl2;
      *(uint4*)(rawL + (r0_ + 24) * 264 + cc_) = pl3;
      if (tid < 32) *(uint4*)(rawL + 32 * 264 + cc_) = pl4;
      *(float4*)(vloL + (tid >> 3) * 36 + (tid & 7) * 4) = pvl;
    }
    __syncthreads();
    {
      const int cc_ = (tid & 31) * 8, tr = tid >> 5;
      const int mode = (cc_ < 64) ? 1 : ((cc_ < 128) ? 0 : 2);
      uint4 a0, a1, a2, a3;
      a0 = rw_act(*(const uint4*)(rawL + (tr + 1) * 264 + cc_), *(const uint4*)(rawL + tr * 264 + cc_), mul + cc_, mode);
      a1 = rw_act(*(const uint4*)(rawL + (tr + 9) * 264 + cc_), *(const uint4*)(rawL + (tr + 8) * 264 + cc_), mul + cc_, mode);
      a2 = rw_act(*(const uint4*)(rawL + (tr + 17) * 264 + cc_), *(const uint4*)(rawL + (tr + 16) * 264 + cc_), mul + cc_, mode);
      a3 = rw_act(*(const uint4*)(rawL + (tr + 25) * 264 + cc_), *(const uint4*)(rawL + (tr + 24) * 264 + cc_), mul + cc_, mode);
      __syncthreads();
      *(uint4*)(rawL + tr * 264 + cc_) = a0;
      *(uint4*)(rawL + (tr + 8) * 264 + cc_) = a1;
      *(uint4*)(rawL + (tr + 16) * 264 + cc_) = a2;
      *(uint4*)(rawL + (tr + 24) * 264 + cc_) = a3;
    }
    __syncthreads();
#pragma unroll 1
    for (int mt = 0; mt < 2; ++mt) {
      const int row = mt * 16 + fr;
      const bf16_t* ar = rawL + row * 264 + fq * 8;
      f32x4 aw = (f32x4){0.f, 0.f, 0.f, 0.f}, aa = aw, ag = aw, av = aw;
#pragma unroll
      for (int ks = 0; ks < 2; ++ks) {
        aw = MFMA(*(const bf16x8*)(ar + ks * 32), w2f[ks], aw);
        aa = MFMA(*(const bf16x8*)(ar + 64 + ks * 32), a2f[ks], aa);
      }
#pragma unroll
      for (int ks = 0; ks < 4; ++ks) ag = MFMA(*(const bf16x8*)(ar + 128 + ks * 32), g2f[ks], ag);
      if (l > 0) {
        const float4 x0 = *(const float4*)(vloL + row * 36 + fq * 8), x1 = *(const float4*)(vloL + row * 36 + fq * 8 + 4);
        const uint4 pk = make_uint4(pack2(x0.x, x0.y), pack2(x0.z, x0.w), pack2(x1.x, x1.y), pack2(x1.z, x1.w));
        av = MFMA(as_frag(pk), v2f, av);
      }
#pragma unroll
      for (int j = 0; j < 4; ++j) {
        const int t = mt * 16 + fq * 4 + j, n = wave * 16 + fr;
        const float wv = -(w0c + aw[j]);
        const float sp = fmaxf(wv, 0.f) + __logf(1.f + __expf(-fabsf(wv)));
        const float wl = -sp - 0.5f;
        W[t * 64 + n] = __expf(-__expf(wl));
        BB[t * 64 + n] = sigm(a0c + aa[j]);
        G[t * 64 + n] = ag[j];
        if (l > 0) O[t * 64 + n] = sigm(v0c + av[j]);
      }
    }
    __syncthreads();
    {
      const size_t tok = tok0 + t_;
      float cr[8], ck[8], cv[8], pr[8], pk[8], pv[8];
      UNPACK8(pcr, cr); UNPACK8(pck, ck); UNPACK8(pcv, cv);
      UNPACK8(ppr, pr); UNPACK8(ppk, pk); UNPACK8(ppv, pv);
      float kx[8], kkv[8], vs[8], ss = 0.f;
#pragma unroll
      for (int e = 0; e < 8; ++e) {
        R[t_ * 64 + n0 + e] = cr[e] + (pr[e] - cr[e]) * mur[e];
        kx[e] = ck[e] + (pk[e] - ck[e]) * muk[e];
        vs[e] = cv[e] + (pv[e] - cv[e]) * muv[e];
        kkv[e] = kx[e] * kkc[e]; ss += kkv[e] * kkv[e];
      }
      ss = red8_sum(ss);
      const float rn = rsqrtf(fmaxf(ss, 1e-24f));
#pragma unroll
      for (int e = 0; e < 8; ++e) {
        const float a = BB[t_ * 64 + n0 + e];
        const float kn = kkv[e] * rn;
        K[t_ * 64 + n0 + e] = kx[e] * (1.f + (a - 1.f) * kac[e]);
        KK[t_ * 64 + n0 + e] = kn;
        BB[t_ * 64 + n0 + e] = kn * a;
      }
      if (l == 0) {
        *(uint4*)(p.vfirst + tok * 512 + h * 64 + n0) = PACK8(vs);
      } else {
        float vf[8]; UNPACK8(pvf, vf);
#pragma unroll
        for (int e = 0; e < 8; ++e) vs[e] = vs[e] + (vf[e] - vs[e]) * O[t_ * 64 + n0 + e];
      }
#pragma unroll
      for (int e = 0; e < 8; ++e) V[t_ * 64 + n0 + e] = vs[e];
    }
    __syncthreads();
    if (ch + 1 < 64) RW_PREFETCH(ch + 1)
    asm volatile("" ::: "memory");
#pragma unroll 4
    for (int t = 0; t < 32; ++t) {
      const float* base = R + t * 64 + kq * 8;
      const float4 r0 = *(const float4*)(base), r1 = *(const float4*)(base + 4);
      const float4 k0 = *(const float4*)(base + 2048), k1 = *(const float4*)(base + 2048 + 4);
      const float4 q0 = *(const float4*)(base + 4096), q1 = *(const float4*)(base + 4096 + 4);
      const float4 w0 = *(const float4*)(base + 6144), w1 = *(const float4*)(base + 6144 + 4);
      const float4 b0 = *(const float4*)(base + 8192), b1 = *(const float4*)(base + 8192 + 4);
      const float va = V[t * 64 + row0], vb = V[t * 64 + row1];
      const f32x2 rr[4] = {{r0.x, r0.y}, {r0.z, r0.w}, {r1.x, r1.y}, {r1.z, r1.w}};
      const f32x2 ww[4] = {{w0.x, w0.y}, {w0.z, w0.w}, {w1.x, w1.y}, {w1.z, w1.w}};
      const f32x2 kk_[4] = {{k0.x, k0.y}, {k0.z, k0.w}, {k1.x, k1.y}, {k1.z, k1.w}};
      const f32x2 qq[4] = {{q0.x, q0.y}, {q0.z, q0.w}, {q1.x, q1.y}, {q1.z, q1.w}};
      const f32x2 bb[4] = {{b0.x, b0.y}, {b0.z, b0.w}, {b1.x, b1.y}, {b1.z, b1.w}};
      f32x2 a0 = S0p[0] * qq[0], a1 = S1p[0] * qq[0];
#pragma unroll
      for (int e = 1; e < 4; ++e) { a0 += S0p[e] * qq[e]; a1 += S1p[e] * qq[e]; }
      const float sa0 = -red8_sum(a0.x + a0.y), sa1 = -red8_sum(a1.x + a1.y);
      f32x2 sa0v, sa1v, vav, vbv;
      sa0v.x = sa0; sa0v.y = sa0; sa1v.x = sa1; sa1v.y = sa1; vav.x = va; vav.y = va; vbv.x = vb; vbv.y = vb;
      f32x2 o0v = {0.f, 0.f}, o1v = {0.f, 0.f};
#pragma unroll
      for (int e = 0; e < 4; ++e) {
        S0p[e] = S0p[e] * ww[e] + sa0v * bb[e] + vav * kk_[e];
        S1p[e] = S1p[e] * ww[e] + sa1v * bb[e] + vbv * kk_[e];
        o0v += S0p[e] * rr[e]; o1v += S1p[e] * rr[e];
      }
      const float o0 = red8_sum(o0v.x + o0v.y), o1 = red8_sum(o1v.x + o1v.y);
      if (kq == 0) { O[t * 64 + row0] = o0; O[t * 64 + row1] = o1; }
    }
    asm volatile("s_waitcnt vmcnt(0)" ::: "memory");
    __syncthreads();
    {
      const size_t tok = tok0 + t_;
      float ov[8], s1 = 0.f, bon = 0.f;
#pragma unroll
      for (int e = 0; e < 8; ++e) {
        ov[e] = O[t_ * 64 + n0 + e]; s1 += ov[e];
        bon += R[t_ * 64 + n0 + e] * K[t_ * 64 + n0 + e] * rkc[e];
      }
      s1 = red8_sum(s1); bon = red8_sum(bon);
      const float mean = s1 * (1.f / 64.f);
      float s2 = 0.f;
#pragma unroll
      for (int e = 0; e < 8; ++e) { const float d = ov[e] - mean; s2 += d * d; }
      s2 = red8_sum(s2);
      const float rstd = rsqrtf(s2 * (1.f / 64.f) + 64e-5f);
      float y[8];
#pragma unroll
      for (int e = 0; e < 8; ++e)
        y[e] = ((ov[e] - mean) * rstd * gnw[e] + gnb[e] + bon * V[t_ * 64 + n0 + e]) * G[t_ * 64 + n0 + e];
      *(uint4*)(p.u + tok * US + 3072 + h * 64 + n0) = PACK8(y);
    }
  }
#undef RW_PREFETCH
  __syncthreads();
}

PHASE void phase_mix(const Params& p, int l, char* smem) {
  int* sitem = (int*)(smem + SMEM_BYTES - 16);
  const int tid0 = opaque_tid();
  while (true) {
    __syncthreads();
    if (tid0 == 0) *sitem = (int)atomicAdd(p.counters + l * 4 + 0, 1u);
    __syncthreads();
    const int item = *sitem;
    if (item >= 256) break;
    rwkv_item(p, l, item, smem);
  }
  while (true) {
    __syncthreads();
    if (tid0 == 0) *sitem = (int)atomicAdd(p.counters + l * 4 + 1, 1u);
    __syncthreads();
    const int item = *sitem;
    if (item >= 128) break;
    hgrn_item(p, l, item, smem);
  }
  while (true) {
    __syncthreads();
    if (tid0 == 0) *sitem = (int)atomicAdd(p.counters + l * 4 + 2, 1u);
    __syncthreads();
    const int item = *sitem;
    if (item >= 4096) break;
    att_item(p, l, item, smem);
  }
}

DEV void gemm_gates(const int tid, const bf16_t* A, const bf16_t* Wg, int tn, char* smem, unsigned (&Gp)[4][6][2]) {
  bf16_t* As = (bf16_t*)smem;
  bf16_t* Bs = As + 3 * 4096;
  const int lane = tid & 63, wave = tid >> 6, wr = wave >> 1, wc = wave & 1;
  const int fr = lane & 15, fq = lane >> 4;
  f32x4 acc[4][6];
#pragma unroll
  for (int m = 0; m < 4; ++m)
#pragma unroll
    for (int n = 0; n < 6; ++n) acc[m][n] = (f32x4){0.f, 0.f, 0.f, 0.f};
  const int nk = DM >> 5;
  const int drow = tid >> 2, dphys = tid & 3, dg = (0 - (tid >> 4)) & 3;
  const int cofs = (dphys ^ dg) * 8;
  const bf16_t* Ap = A + (size_t)drow * DM + cofs;
  const bf16_t* Bp0; const bf16_t* Bp1; const bf16_t* Bp2;
  {
    int r = drow;
    int wcb = r / 96, br = (r % 96) >> 5, c = r & 31;
    c = (r % 96) & 31;
    Bp0 = Wg + (size_t)(5376 + br * 1024 + tn * 64 + wcb * 32 + c) * DM + cofs;
    r = drow + 64; wcb = r / 96; br = (r % 96) >> 5; c = (r % 96) & 31;
    Bp1 = Wg + (size_t)(5376 + br * 1024 + tn * 64 + wcb * 32 + c) * DM + cofs;
    r = drow + 128; wcb = r / 96; br = (r % 96) >> 5; c = (r % 96) & 31;
    Bp2 = Wg + (size_t)(5376 + br * 1024 + tn * 64 + wcb * 32 + c) * DM + cofs;
  }
  const int rofs = (fq ^ ((0 - (fr >> 2)) & 3)) * 8;
#define GG_DMA(st, kk)                                                                                       \
  {                                                                                                          \
    __builtin_amdgcn_global_load_lds((const unsigned*)(Ap + (kk) * 32), (unsigned*)(As + (st) * 4096 + tid * 8), 16, 0, 0);                     \
    __builtin_amdgcn_global_load_lds((const unsigned*)(Ap + (size_t)64 * DM + (kk) * 32), (unsigned*)(As + (st) * 4096 + tid * 8 + 2048), 16, 0, 0); \
    __builtin_amdgcn_global_load_lds((const unsigned*)(Bp0 + (kk) * 32), (unsigned*)(Bs + (st) * 6144 + tid * 8), 16, 0, 0);                    \
    __builtin_amdgcn_global_load_lds((const unsigned*)(Bp1 + (kk) * 32), (unsigned*)(Bs + (st) * 6144 + tid * 8 + 2048), 16, 0, 0);             \
    __builtin_amdgcn_global_load_lds((const unsigned*)(Bp2 + (kk) * 32), (unsigned*)(Bs + (st) * 6144 + tid * 8 + 4096), 16, 0, 0);             \
  }
  GG_DMA(0, 0)
  GG_DMA(1, 1)
  int st = 0;
  for (int kt = 0; kt < nk; ++kt) {
    if (kt + 1 < nk) asm volatile("s_waitcnt vmcnt(5)" ::: "memory");
    else asm volatile("s_waitcnt vmcnt(0)" ::: "memory");
    __builtin_amdgcn_s_barrier();
    asm volatile("" ::: "memory");
    const int s2 = (st >= 1) ? st - 1 : 2;
    const bf16_t* Ab = As + st * 4096 + (wr * 64 + fr) * 32 + rofs;
    const bf16_t* Bb = Bs + st * 6144 + (wc * 96 + fr) * 32 + rofs;
    bf16x8 bfr[6], af[4];
#pragma unroll
    for (int n = 0; n < 6; ++n) bfr[n] = *(const bf16x8*)(Bb + n * 512);
#pragma unroll
    for (int m = 0; m < 4; ++m) af[m] = *(const bf16x8*)(Ab + m * 512);
    if (kt + 2 < nk) GG_DMA(s2, kt + 2)
#pragma unroll
    for (int m = 0; m < 4; ++m)
#pragma unroll
      for (int n = 0; n < 6; ++n) acc[m][n] = MFMA(af[m], bfr[n], acc[m][n]);
    st = (st == 2) ? 0 : st + 1;
  }
#undef GG_DMA
  __syncthreads();
#pragma unroll
  for (int m = 0; m < 4; ++m)
#pragma unroll
    for (int n = 0; n < 6; ++n) {
      Gp[m][n][0] = pack2(sigm(acc[m][n][0]), sigm(acc[m][n][1]));
      Gp[m][n][1] = pack2(sigm(acc[m][n][2]), sigm(acc[m][n][3]));
    }
}

PHASE void phase_merge(const Params& p, int l, char* smem) {
  const bf16_t* Wl = p.wt + (size_t)l * WLAYER;
  float* Cs = (float*)smem;
  const int tid = opaque_tid();
  for (int it = 0;; ++it) {
    int tm, tn;
    if (!tile_for(it, 512, 16, tm, tn)) break;
    const size_t row0 = (size_t)tm * 128;
    unsigned Gp[4][6][2];
    gemm_gates(tid, p.h + row0 * DM, Wl + WIN, tn, smem, Gp);
    f32x4 acc[4][2], M[4][2];
#pragma unroll
    for (int m = 0; m < 4; ++m)
#pragma unroll
      for (int n = 0; n < 2; ++n) M[m][n] = (f32x4){0.f, 0.f, 0.f, 0.f};
#pragma unroll
    for (int br = 0; br < 3; ++br) {
      const int aoff = (br == 0) ? 0 : (br == 1 ? 2560 : 3072);
      const size_t woff = (br == 0) ? WBA : (br == 1 ? WBB : WBC);
      gemm_tile<2>(tid, p.u + row0 * US + aoff, US, Wl + woff + (size_t)(tn * 64) * 512, 512, 512, smem, acc);
#pragma unroll
      for (int m = 0; m < 4; ++m)
#pragma unroll
        for (int n = 0; n < 2; ++n) {
          M[m][n][0] += lo16(Gp[m][2 * br + n][0]) * acc[m][n][0];
          M[m][n][1] += hi16(Gp[m][2 * br + n][0]) * acc[m][n][1];
          M[m][n][2] += lo16(Gp[m][2 * br + n][1]) * acc[m][n][2];
          M[m][n][3] += hi16(Gp[m][2 * br + n][1]) * acc[m][n][3];
        }
    }
    stage_acc<2>(tid, Cs, M);
    __syncthreads();
    {
      const int ch = tid & 7;
#pragma unroll 1
      for (int i = 0; i < 4; ++i) {
        const int r = (tid >> 3) + i * 32;
        const float4 a = *(const float4*)(Cs + r * 68 + ch * 8), b = *(const float4*)(Cs + r * 68 + ch * 8 + 4);
        *(uint4*)(p.u + (row0 + r) * US + 1024 + tn * 64 + ch * 8) = make_uint4(pack2(a.x, a.y), pack2(a.z, a.w), pack2(b.x, b.y), pack2(b.z, b.w));
      }
    }
    __syncthreads();
  }
}

PHASE void phase_gemm_res(const bf16_t* A, int lda, const bf16_t* Wt, int K, const float* xin, float* xout,
                        const float* ada_l, int gate_off, char* smem) {
  float* Cs = (float*)smem;
  const int tid = opaque_tid();
  for (int it = 0;; ++it) {
    int tm, tn;
    if (!tile_for(it, 256, 8, tm, tn)) break;
    const size_t row0 = (size_t)tm * 256;
    f32x4 acc[8][4];
    gemm_tile256(tid, A + row0 * lda, lda, Wt + (size_t)(tn * 128) * K, K, K, smem, acc);
    const float* gate = ada_l + (size_t)(row0 / SEQ) * ADAW + gate_off + tn * 128;
    const int c4 = (tid & 31) * 4;
    const float4 gv = *(const float4*)(gate + c4);
#pragma unroll
    for (int ps = 0; ps < 2; ++ps) {
      if (ps == 0) stage_half<0>(tid, Cs, acc); else stage_half<1>(tid, Cs, acc);
      __syncthreads();
#pragma unroll 1
      for (int i = 0; i < 16; ++i) {
        const int r = (tid >> 5) + i * 8;
        const float4 cv = *(const float4*)(Cs + r * 132 + c4);
        const size_t off = (row0 + RMAP(r, ps)) * DM + tn * 128 + c4;
        const float4 xv = *(const float4*)(xin + off);
        *(float4*)(xout + off) = make_float4(xv.x + gv.x * cv.x, xv.y + gv.y * cv.y, xv.z + gv.z * cv.z, xv.w + gv.w * cv.w);
      }
      __syncthreads();
    }
  }
}

PHASE void phase_ffn_in(const Params& p, int l, char* smem) {
  const bf16_t* Wt = p.wt + (size_t)l * WLAYER + WFI;
  float* Cs = (float*)smem;
  const int tid = opaque_tid();
  for (int it = 0;; ++it) {
    int tm, tn;
    if (!tile_for(it, 256, 44, tm, tn)) break;
    const size_t row0 = (size_t)tm * 256;
    f32x4 acc[8][4];
    gemm_tile256(tid, p.h + row0 * DM, DM, Wt + (size_t)(tn * 128) * DM, DM, DM, smem, acc);
    const int ch = tid & 7;
#pragma unroll
    for (int ps = 0; ps < 2; ++ps) {
      if (ps == 0) stage_half<0>(tid, Cs, acc); else stage_half<1>(tid, Cs, acc);
      __syncthreads();
#pragma unroll 1
      for (int i = 0; i < 4; ++i) {
        const int r = (tid >> 3) + i * 32;
        const float* cp = Cs + r * 132 + ch * 8;
        float o[8];
#pragma unroll
        for (int e = 0; e < 8; ++e) { const float g = cp[e], uu = cp[64 + e]; o[e] = g * sigm(g) * uu; }
        *(uint4*)(p.u + (row0 + RMAP(r, ps)) * FFH + tn * 64 + ch * 8) = PACK8(o);
      }
      __syncthreads();
    }
  }
}

#define XB_TMO      128
#define XB_XCNT(j)  (256  + 64 * (j))
#define XB_XSUB(j)  (1280 + 64 * (j))
#define XB_XGEN(j)  (2304 + 64 * (j))
#define XB_TOP      3328
#define XB_TOPGEN   3392
#define XCD_BAR_WORDS 3456
#define XB_SPIN_CAP (1u << 18)
#define LAS __attribute__((address_space(3)))
DEV unsigned xb_ld(unsigned* p) { return __hip_atomic_load(p, __ATOMIC_RELAXED, __HIP_MEMORY_SCOPE_AGENT); }
DEV unsigned xb_add(unsigned* p, unsigned v) { return __hip_atomic_fetch_add(p, v, __ATOMIC_RELAXED, __HIP_MEMORY_SCOPE_AGENT); }
DEV unsigned xb_xcc_id() { return (unsigned)__builtin_amdgcn_s_getreg((3 << 11) | 20) & 0xFu; }
#define XB_SPIN(cond, bar) do { unsigned _sp = 0; while (cond) { __builtin_amdgcn_s_sleep(1); \
    if ((++_sp & 255u) == 0u) { if (xb_ld(&(bar)[XB_TMO])) break; if (_sp > XB_SPIN_CAP) { atomicAdd(&(bar)[XB_TMO], 1u); break; } } } } while (0)
struct XcdBarrier { unsigned* bar; unsigned x; volatile LAS unsigned* st; };
DEV XcdBarrier xcd_barrier_post(unsigned* bar, volatile LAS unsigned* st) {
  XcdBarrier b; b.bar = bar; b.x = xb_xcc_id(); b.st = st;
  if (threadIdx.x == 0) (void)xb_add(&bar[XB_XCNT(b.x)], 1u);
  return b;
}
DEV void xcd_barrier_complete(unsigned* bar, unsigned x, unsigned& nloc, unsigned& nx) {
  const unsigned G = gridDim.x * gridDim.y * gridDim.z;
  unsigned sum, cnt, mine, sp = 0u;
  for (;;) {
    sum = 0u; cnt = 0u; mine = 0u;
#pragma unroll
    for (unsigned j = 0; j < 16; ++j) { const unsigned c = xb_ld(&bar[XB_XCNT(j)]); sum += c; cnt += (c > 0u) ? 1u : 0u; mine = (j == x) ? c : mine; }
    if (sum == G) break;
    __builtin_amdgcn_s_sleep(1);
    if ((++sp & 255u) == 0u) { if (xb_ld(&bar[XB_TMO])) break; if (sp > XB_SPIN_CAP) { atomicAdd(&bar[XB_TMO], 1u); break; } }
  }
  nloc = mine > 0u ? mine : 1u; nx = cnt > 0u ? cnt : 1u;
}
DEV void xcd_barrier(const XcdBarrier& b) {
  asm volatile("s_waitcnt vmcnt(0)" ::: "memory");
  __syncthreads();
  if (threadIdx.x == 0) {
    unsigned* bar = b.bar;
    __builtin_amdgcn_s_waitcnt(0);
    unsigned nloc = b.st[0], nx = b.st[1];
    if (nloc == 0u) { xcd_barrier_complete(bar, b.x, nloc, nx); b.st[0] = nloc; b.st[1] = nx; }
    const unsigned old = xb_add(&bar[XB_XSUB(b.x)], 1u);
    const unsigned gen = old / nloc;
    if (old + 1u == (gen + 1u) * nloc) {
      __builtin_amdgcn_fence(__ATOMIC_RELEASE, "agent");
      asm volatile("s_waitcnt vmcnt(0)" ::: "memory");
      const unsigned og = xb_add(&bar[XB_TOP], 1u);
      const unsigned tg = og / nx;
      if (og + 1u == (tg + 1u) * nx) xb_add(&bar[XB_TOPGEN], 1u);
      else XB_SPIN(xb_ld(&bar[XB_TOPGEN]) == tg, bar);
      __builtin_amdgcn_fence(__ATOMIC_ACQUIRE, "agent");
      xb_add(&bar[XB_XGEN(b.x)], 1u);
      asm volatile("s_waitcnt vmcnt(0)" ::: "memory");
    } else {
      XB_SPIN(xb_ld(&bar[XB_XGEN(b.x)]) == gen, bar);
      __builtin_amdgcn_fence(__ATOMIC_ACQUIRE, "agent");
      asm volatile("s_waitcnt vmcnt(0)" ::: "memory");
    }
  }
  __syncthreads();
}

__global__ void __launch_bounds__(256, 2) mega(Params p_in, int ph_lo, int ph_hi) {
  extern __shared__ __attribute__((aligned(16))) char smem[];
  cg::grid_group grid = cg::this_grid();
  const Params& p = p_in;
  bool first = true;
#define RUN(ph) if ((ph) >= ph_lo && (ph) < ph_hi)
  unsigned epoch = 0;
  __shared__ unsigned xb_words[4];
  if (threadIdx.x < 4) xb_words[threadIdx.x] = 0u;
  __syncthreads();
  XcdBarrier xb;
  xb.bar = p.counters + 256; xb.x = 0u; xb.st = (volatile LAS unsigned*)xb_words;
#define SYNC { if (!first) { ++epoch; if (epoch == 1) { grid.sync(); xb = xcd_barrier_post(p.counters + 256, (volatile LAS unsigned*)xb_words); } else xcd_barrier(xb); } first = false; }
  RUN(0) { SYNC; phase_prep(p, smem); }
#pragma unroll 1
  for (int l = 0; l < 2; ++l) {
    const int base = 1 + 9 * l;
    const float* ada_l = p.ada + (size_t)l * 32 * ADAW;
    const bf16_t* Wl = p.wt + (size_t)l * WLAYER;
    const float* xin = (l == 0) ? p.x : p.out;
    RUN(base + 0) { SYNC; phase_norm(xin, p.norm_mix_w + l * DM, ada_l, 0, 1024, p.h); }
    RUN(base + 1) { SYNC; phase_gemm_in(p, l, smem); }
    RUN(base + 2) { if (l > 0) { SYNC; phase_vlo(p, l, smem); } }
    RUN(base + 3) { SYNC; phase_mix(p, l, smem); }
    RUN(base + 4) { SYNC; phase_merge(p, l, smem); }
    RUN(base + 5) { SYNC; phase_gemm_res(p.u + 1024, US, Wl + WOUT, DM, xin, p.out, ada_l, 2048, smem); }
    RUN(base + 6) { SYNC; phase_norm(p.out, p.norm_ffn_w + l * DM, ada_l, 3072, 4096, p.h); }
    RUN(base + 7) { SYNC; phase_ffn_in(p, l, smem); }
    RUN(base + 8) { SYNC; phase_gemm_res(p.u, FFH, Wl + WFO, FFH, p.out, p.out, ada_l, 5120, smem); }
  }
  RUN(NPHASE - 1) { SYNC; phase_final(p.out, p.final_norm_w); }
}

extern "C" void kernel_launch(void* const* d_in, const int* in_sizes, int n_in, void* d_out, int out_size, void* d_ws,
                              size_t ws_size, hipStream_t stream) {
  Params p{};
  p.x = (const float*)d_in[0]; p.c = (const float*)d_in[1]; p.pos = (const int*)d_in[2];
  p.ada_w = (const float*)d_in[3]; p.ada_b = (const float*)d_in[4]; p.norm_mix_w = (const float*)d_in[5];
  p.norm_ffn_w = (const float*)d_in[6]; p.w_in = (const float*)d_in[7]; p.da_lambda = (const float*)d_in[8];
  p.da_subln_w = (const float*)d_in[9]; p.hg_lb = (const float*)d_in[10]; p.hg_norm_w = (const float*)d_in[11];
  p.rw_mu = (const float*)d_in[12]; p.rw_w0 = (const float*)d_in[13]; p.rw_w2 = (const float*)d_in[14];
  p.rw_a0 = (const float*)d_in[15]; p.rw_a2 = (const float*)d_in[16]; p.rw_g2 = (const float*)d_in[17];
  p.rw_k_k = (const float*)d_in[18]; p.rw_k_a = (const float*)d_in[19]; p.rw_r_k = (const float*)d_in[20];
  p.rw_gn_w = (const float*)d_in[21]; p.rw_gn_b = (const float*)d_in[22]; p.rw_v0 = (const float*)d_in[23];
  p.rw_v1 = (const float*)d_in[24]; p.rw_v2 = (const float*)d_in[25]; p.w_br_a = (const float*)d_in[26];
  p.w_br_b = (const float*)d_in[27]; p.w_br_c = (const float*)d_in[28]; p.w_out = (const float*)d_in[29];
  p.ffn_w_in = (const float*)d_in[30]; p.ffn_w_out = (const float*)d_in[31]; p.final_norm_w = (const float*)d_in[32];
  p.out = (float*)d_out;
  char* ws = (char*)d_ws;
  size_t off = 0;
  auto take = [&](size_t bytes) { char* r = ws + off; off += (bytes + 255) & ~(size_t)255; return r; };
  p.counters = (unsigned*)take(16384);
  p.wt = (bf16_t*)take(2 * WLAYER * 2);
  p.ada = (float*)take((size_t)2 * 32 * ADAW * 4);
  p.h = (bf16_t*)take((size_t)T_TOK * DM * 2);
  p.u = (bf16_t*)take((size_t)T_TOK * US * 2);
  p.vT = (bf16_t*)take((size_t)T_TOK * 512 * 2);
  p.vfirst = (bf16_t*)take((size_t)T_TOK * 512 * 2);
  p.vlo = (float*)take((size_t)T_TOK * 32 * 4);
  if (off > ws_size) { fprintf(stderr, "workspace too small: need %zu have %zu\n", off, ws_size); return; }

  static int grid_blocks = 0;
  if (!grid_blocks) {
    hipFuncSetAttribute((const void*)mega, hipFuncAttributeMaxDynamicSharedMemorySize, SMEM_BYTES);
    int dev = 0, cus = 0, per_cu = 0;
    hipGetDevice(&dev);
    hipDeviceGetAttribute(&cus, hipDeviceAttributeMultiprocessorCount, dev);
    hipOccupancyMaxActiveBlocksPerMultiprocessor(&per_cu, mega, 256, SMEM_BYTES);
    if (per_cu > 2) per_cu = 2;
    if (per_cu < 1) per_cu = 1;
    grid_blocks = cus * per_cu;
  }
#if SINGLE_LAUNCH
  int lo = 0, hi = NPHASE;
  void* args[] = {&p, &lo, &hi};
  hipError_t e = hipLaunchCooperativeKernel((void*)mega, dim3(grid_blocks), dim3(256), args, SMEM_BYTES, stream);
  if (e != hipSuccess) fprintf(stderr, "cooperative launch failed: %s (grid %d)\n", hipGetErrorString(e), grid_blocks);
#else
  for (int ph = 0; ph < NPHASE; ++ph) {
    if (ph == 3) continue;
    hipLaunchKernelGGL(mega, dim3(grid_blocks), dim3(256), SMEM_BYTES, stream, p, ph, ph + 1);
  }
#endif
}
```

```cpp
#include <hip/hip_runtime.h>
#include <hip/hip_cooperative_groups.h>
#include <stdint.h>
#include <cstdio>
namespace cg = cooperative_groups;

typedef unsigned short bf16_t;
typedef short bf16x8 __attribute__((ext_vector_type(8)));
typedef float f32x4 __attribute__((ext_vector_type(4)));
typedef float f32x2 __attribute__((ext_vector_type(2)));
#define DEV __device__ __forceinline__
#define PHASE __device__ __forceinline__

#ifndef SINGLE_LAUNCH
#define SINGLE_LAUNCH 1
#endif

constexpr int T_TOK = 65536, DM = 1024, SEQ = 2048, US = 4864, ADAW = 6144, FFH = 2816;
constexpr size_t WIN = 0, WBA = 8650752, WBB = 9175040, WBC = 9699328, WOUT = 10223616, WFI = 11272192,
                 WFO = 17039360, WLAYER = 19922944;
constexpr int SMEM_BYTES = 80896;
constexpr int NPHASE = 20;

struct Params {
  const float* x; const float* c; const int* pos;
  const float *ada_w, *ada_b, *norm_mix_w, *norm_ffn_w, *w_in, *da_lambda, *da_subln_w, *hg_lb, *hg_norm_w;
  const float *rw_mu, *rw_w0, *rw_w2, *rw_a0, *rw_a2, *rw_g2, *rw_k_k, *rw_k_a, *rw_r_k, *rw_gn_w, *rw_gn_b;
  const float *rw_v0, *rw_v1, *rw_v2, *w_br_a, *w_br_b, *w_br_c, *w_out, *ffn_w_in, *ffn_w_out, *final_norm_w;
  float* out;
  bf16_t* wt; float* ada; bf16_t* h; bf16_t* u; bf16_t* vT; bf16_t* vfirst; float* vlo; unsigned* counters;
};

DEV unsigned short f2bf(float f) { unsigned u = __float_as_uint(f); u += 0x7FFFu + ((u >> 16) & 1u); return (unsigned short)(u >> 16); }
DEV float bf2f(unsigned short h) { return __uint_as_float(((unsigned)h) << 16); }
DEV unsigned pack2(float a, float b) { return (unsigned)f2bf(a) | ((unsigned)f2bf(b) << 16); }
DEV float sigm(float x) { return 1.f / (1.f + __expf(-x)); }
DEV float lo16(unsigned v) { return __uint_as_float(v << 16); }
DEV float hi16(unsigned v) { return __uint_as_float(v & 0xFFFF0000u); }
#define UNPACK8(v, f) { f[0]=lo16(v.x); f[1]=hi16(v.x); f[2]=lo16(v.y); f[3]=hi16(v.y); f[4]=lo16(v.z); f[5]=hi16(v.z); f[6]=lo16(v.w); f[7]=hi16(v.w); }
#define PACK8(f) make_uint4(pack2(f[0],f[1]), pack2(f[2],f[3]), pack2(f[4],f[5]), pack2(f[6],f[7]))
template <int CTRL> DEV float dpp(float x) { return __int_as_float(__builtin_amdgcn_update_dpp(0, __float_as_int(x), CTRL, 0xF, 0xF, true)); }
DEV float red8_sum(float x) { x += dpp<0xB1>(x); x += dpp<0x4E>(x); x += dpp<0x141>(x); return x; }
DEV float red16_sum(float x) { x = red8_sum(x); x += dpp<0x140>(x); return x; }
DEV float red16_max(float x) { x = fmaxf(x, dpp<0xB1>(x)); x = fmaxf(x, dpp<0x4E>(x)); x = fmaxf(x, dpp<0x141>(x)); x = fmaxf(x, dpp<0x140>(x)); return x; }
DEV float wave_sum(float x) {
  x = red16_sum(x);
  const int xi = __float_as_int(x);
  return __int_as_float(__builtin_amdgcn_readlane(xi, 0)) + __int_as_float(__builtin_amdgcn_readlane(xi, 16)) +
         __int_as_float(__builtin_amdgcn_readlane(xi, 32)) + __int_as_float(__builtin_amdgcn_readlane(xi, 48));
}
DEV int opaque_tid() { int t = threadIdx.x & 255; asm volatile("" : "+v"(t)); return t; }
DEV int opaque_tid512() { int t = threadIdx.x; asm volatile("" : "+v"(t)); return t; }
DEV int vhalf() { return __builtin_amdgcn_readfirstlane((int)(threadIdx.x >> 8)); }
DEV int vblock() { return (int)blockIdx.x * 2 + vhalf(); }
DEV int vgrid() { return (int)gridDim.x * 2; }
DEV bf16x8 as_frag(uint4 v) { union { uint4 u; bf16x8 b; } c; c.u = v; return c.b; }
#define MFMA(a, b, c) __builtin_amdgcn_mfma_f32_16x16x32_bf16(a, b, c, 0, 0, 0)

template <int NT>
DEV void gemm_tile(const int tid_in, const bf16_t* A, int lda, const bf16_t* B, int ldb, int K, char* smem,
                   f32x4 (&acc)[4][NT]) {
  int tid = tid_in; asm volatile("" : "+v"(tid));
  constexpr int BN = NT * 32;
  constexpr int LS = 64;
  bf16_t* As = (bf16_t*)smem;
  bf16_t* Bs = As + 2 * 128 * LS;
  const int lane = tid & 63, wave = tid >> 6, wr = wave >> 1, wc = wave & 1;
  const int fr = lane & 15, fq = lane >> 4;
  constexpr int NB = BN * 8 / 256;
#pragma unroll
  for (int m = 0; m < 4; ++m)
#pragma unroll
    for (int n = 0; n < NT; ++n) acc[m][n] = (f32x4){0.f, 0.f, 0.f, 0.f};
  const int nk = K >> 6;
  const int lrow = tid >> 3, lcc = tid & 7;
  const bf16_t* Ap = A + (size_t)lrow * lda + ((lcc ^ (lrow & 7)) * 8);
  const bf16_t* Bp = B + (size_t)lrow * ldb + ((lcc ^ (lrow & 7)) * 8);
  const size_t a32 = (size_t)32 * lda, b32 = (size_t)32 * ldb;
  const int rofs0 = (fq ^ (fr & 7)) * 8, rofs1 = rofs0 ^ 32;
#define GT_DMA(buf, koff)                                                                                    \
  {                                                                                                          \
    bf16_t* Ad = As + (buf) * 128 * LS + tid * 8;                                                            \
    bf16_t* Bd = Bs + (buf) * BN * LS + tid * 8;                                                             \
    _Pragma("unroll") for (int i = 0; i < 4; ++i)                                                            \
      __builtin_amdgcn_global_load_lds((const unsigned*)(Ap + i * a32 + (koff)), (unsigned*)(Ad + i * 32 * LS), 16, 0, 0); \
    _Pragma("unroll") for (int i = 0; i < NB; ++i)                                                           \
      __builtin_amdgcn_global_load_lds((const unsigned*)(Bp + i * b32 + (koff)), (unsigned*)(Bd + i * 32 * LS), 16, 0, 0); \
  }
  GT_DMA(0, 0)
  asm volatile("s_waitcnt vmcnt(0)" ::: "memory");
  __syncthreads();
  for (int kt = 0; kt < nk; ++kt) {
    const int buf = kt & 1;
    if (kt + 1 < nk) GT_DMA(buf ^ 1, (kt + 1) * 64)
    const bf16_t* Ab = As + buf * 128 * LS + (wr * 64 + fr) * LS;
    const bf16_t* Bb = Bs + buf * BN * LS + (wc * (NT * 16) + fr) * LS;
#pragma unroll
    for (int ks = 0; ks < 2; ++ks) {
      const int ro = ks ? rofs1 : rofs0;
      bf16x8 af[4], bfr[NT];
#pragma unroll
      for (int m = 0; m < 4; ++m) af[m] = *(const bf16x8*)(Ab + m * 16 * LS + ro);
#pragma unroll
      for (int n = 0; n < NT; ++n) bfr[n] = *(const bf16x8*)(Bb + n * 16 * LS + ro);
#pragma unroll
      for (int m = 0; m < 4; ++m)
#pragma unroll
        for (int n = 0; n < NT; ++n) acc[m][n] = MFMA(af[m], bfr[n], acc[m][n]);
    }
    asm volatile("s_waitcnt vmcnt(0)" ::: "memory");
    __syncthreads();
  }
#undef GT_DMA
}

template <int NT>
DEV void stage_acc(const int tid, float* Cs, const f32x4 (&acc)[4][NT]) {
  constexpr int LDC = NT * 32 + 4;
  const int lane = tid & 63, wave = tid >> 6, wr = wave >> 1, wc = wave & 1, fr = lane & 15, fq = lane >> 4;
#pragma unroll
  for (int m = 0; m < 4; ++m)
#pragma unroll
    for (int n = 0; n < NT; ++n)
#pragma unroll
      for (int j = 0; j < 4; ++j) Cs[(wr * 64 + m * 16 + fq * 4 + j) * LDC + wc * (NT * 16) + n * 16 + fr] = acc[m][n][j];
}

DEV void gemm_tile256(const int tid, const bf16_t* A, int lda, const bf16_t* B, int ldb, int K, char* smem,
                      f32x4 (&acc)[8][4]) {
  bf16_t* As = (bf16_t*)smem;
  bf16_t* Bs = As + 3 * 8192;
  const int lane = tid & 63, wave = tid >> 6, wr = wave >> 1, wc = wave & 1;
  const int fr = lane & 15, fq = lane >> 4;
#pragma unroll
  for (int m = 0; m < 8; ++m)
#pragma unroll
    for (int n = 0; n < 4; ++n) acc[m][n] = (f32x4){0.f, 0.f, 0.f, 0.f};
  const int nk = K >> 5;
  const int drow = tid >> 2, dphys = tid & 3, dg = (0 - (tid >> 4)) & 3;
  const bf16_t* Ap = A + (size_t)drow * lda + ((dphys ^ dg) * 8);
  const bf16_t* Bp = B + (size_t)drow * ldb + ((dphys ^ dg) * 8);
  const size_t a64 = (size_t)64 * lda, b64 = (size_t)64 * ldb;
  const int rofs = (fq ^ ((0 - (fr >> 2)) & 3)) * 8;
#define G2_DMA(st, kk)                                                                                        \
  {                                                                                                           \
    bf16_t* Ad = As + (st) * 8192 + tid * 8;                                                                  \
    bf16_t* Bd = Bs + (st) * 4096 + tid * 8;                                                                  \
    _Pragma("unroll") for (int i = 0; i < 4; ++i)                                                             \
      __builtin_amdgcn_global_load_lds((const unsigned*)(Ap + i * a64 + (kk) * 32), (unsigned*)(Ad + i * 2048), 16, 0, 0); \
    _Pragma("unroll") for (int i = 0; i < 2; ++i)                                                             \
      __builtin_amdgcn_global_load_lds((const unsigned*)(Bp + i * b64 + (kk) * 32), (unsigned*)(Bd + i * 2048), 16, 0, 0); \
  }
  G2_DMA(0, 0)
  G2_DMA(1, 1)
  int st = 0;
  for (int kt = 0; kt < nk; ++kt) {
    if (kt + 1 < nk) asm volatile("s_waitcnt vmcnt(6)" ::: "memory");
    else asm volatile("s_waitcnt vmcnt(0)" ::: "memory");
    __builtin_amdgcn_s_barrier();
    asm volatile("" ::: "memory");
    const int s2 = (st >= 1) ? st - 1 : 2;
    const bool pf = (kt + 2 < nk);
    bf16_t* Ad = As + s2 * 8192 + tid * 8;
    bf16_t* Bd = Bs + s2 * 4096 + tid * 8;
    const bf16_t* Asrc = Ap + (kt + 2) * 32;
    const bf16_t* Bsrc = Bp + (kt + 2) * 32;
    const bf16_t* Ab = As + st * 8192 + (wr * 128 + fr) * 32 + rofs;
    const bf16_t* Bb = Bs + st * 4096 + (wc * 64 + fr) * 32 + rofs;
    bf16x8 bfr[4], af[4];
#pragma unroll
    for (int n = 0; n < 4; ++n) bfr[n] = *(const bf16x8*)(Bb + n * 512);
#pragma unroll
    for (int m = 0; m < 4; ++m) af[m] = *(const bf16x8*)(Ab + m * 512);
#pragma unroll
    for (int m = 0; m < 8; ++m) {
#pragma unroll
      for (int n = 0; n < 4; ++n) acc[m][n] = MFMA(af[m & 3], bfr[n], acc[m][n]);
      if (m + 4 < 8) af[m & 3] = *(const bf16x8*)(Ab + (m + 4) * 512);
      if (pf) {
        if (m < 4) __builtin_amdgcn_global_load_lds((const unsigned*)(Asrc + m * a64), (unsigned*)(Ad + m * 2048), 16, 0, 0);
        else if (m < 6) __builtin_amdgcn_global_load_lds((const unsigned*)(Bsrc + (m - 4) * b64), (unsigned*)(Bd + (m - 4) * 2048), 16, 0, 0);
      }
      __builtin_amdgcn_sched_barrier(0);
    }
    st = (st == 2) ? 0 : st + 1;
  }
#undef G2_DMA
  __syncthreads();
}

template <int PS>
DEV void stage_half(const int tid, float* Cs, const f32x4 (&acc)[8][4]) {
  const int lane = tid & 63, wave = tid >> 6, wr = wave >> 1, wc = wave & 1, fr = lane & 15, fq = lane >> 4;
#pragma unroll
  for (int m = 0; m < 4; ++m)
#pragma unroll
    for (int n = 0; n < 4; ++n)
#pragma unroll
      for (int j = 0; j < 4; ++j) Cs[(wr * 64 + m * 16 + fq * 4 + j) * 132 + wc * 64 + n * 16 + fr] = acc[PS * 4 + m][n][j];
}
#define RMAP(r, ps) ((((r) >> 6) << 7) + (ps) * 64 + ((r) & 63))

DEV void gemm_tile512(const int T, const bf16_t* A, int lda, const bf16_t* B, int ldb, int K, char* smem0,
                      f32x4 (&acc)[8][4]) {
  bf16_t* As = (bf16_t*)smem0;
  bf16_t* Bs = As + 3 * 8192;
  const int lane = T & 63, wave = T >> 6, wr = wave >> 2, wc = wave & 3;
  const int fr = lane & 15, fq = lane >> 4;
#pragma unroll
  for (int m = 0; m < 8; ++m)
#pragma unroll
    for (int n = 0; n < 4; ++n) acc[m][n] = (f32x4){0.f, 0.f, 0.f, 0.f};
  const int nk = K >> 5;
  const int drow = T >> 2, dphys = T & 3, dg = (0 - (T >> 4)) & 3;
  const bf16_t* Ap = A + (size_t)drow * lda + ((dphys ^ dg) * 8);
  const bf16_t* Bp = B + (size_t)drow * ldb + ((dphys ^ dg) * 8);
  const size_t a128 = (size_t)128 * lda, b128 = (size_t)128 * ldb;
  const int rofs = (fq ^ ((0 - (fr >> 2)) & 3)) * 8;
#pragma unroll
  for (int ps = 0; ps < 2; ++ps)
#pragma unroll
    for (int i = 0; i < 2; ++i) {
      __builtin_amdgcn_global_load_lds((const unsigned*)(Ap + i * a128 + ps * 32), (unsigned*)(As + ps * 8192 + T * 8 + i * 4096), 16, 0, 0);
      __builtin_amdgcn_global_load_lds((const unsigned*)(Bp + i * b128 + ps * 32), (unsigned*)(Bs + ps * 8192 + T * 8 + i * 4096), 16, 0, 0);
    }
  int st = 0;
  for (int kt = 0; kt < nk; ++kt) {
    if (kt + 1 < nk) asm volatile("s_waitcnt vmcnt(4)" ::: "memory");
    else asm volatile("s_waitcnt vmcnt(0)" ::: "memory");
    __builtin_amdgcn_s_barrier();
    asm volatile("" ::: "memory");
    const int s2 = (st >= 1) ? st - 1 : 2;
    const bool pf = (kt + 2 < nk);
    bf16_t* Ad = As + s2 * 8192 + T * 8;
    bf16_t* Bd = Bs + s2 * 8192 + T * 8;
    const bf16_t* Asrc = Ap + (kt + 2) * 32;
    const bf16_t* Bsrc = Bp + (kt + 2) * 32;
    const bf16_t* Ab = As + st * 8192 + (wr * 128 + fr) * 32 + rofs;
    const bf16_t* Bb = Bs + st * 8192 + (wc * 64 + fr) * 32 + rofs;
    bf16x8 bfr[4], af[4];
#pragma unroll
    for (int n = 0; n < 4; ++n) bfr[n] = *(const bf16x8*)(Bb + n * 512);
#pragma unroll
    for (int m = 0; m < 4; ++m) af[m] = *(const bf16x8*)(Ab + m * 512);
#pragma unroll
    for (int m = 0; m < 8; ++m) {
#pragma unroll
      for (int n = 0; n < 4; ++n) acc[m][n] = MFMA(af[m & 3], bfr[n], acc[m][n]);
      if (m + 4 < 8) af[m & 3] = *(const bf16x8*)(Ab + (m + 4) * 512);
      if (pf) {
        if (m == 1) __builtin_amdgcn_global_load_lds((const unsigned*)(Asrc), (unsigned*)(Ad), 16, 0, 0);
        else if (m == 2) __builtin_amdgcn_global_load_lds((const unsigned*)(Asrc + a128), (unsigned*)(Ad + 4096), 16, 0, 0);
        else if (m == 3) __builtin_amdgcn_global_load_lds((const unsigned*)(Bsrc), (unsigned*)(Bd), 16, 0, 0);
        else if (m == 4) __builtin_amdgcn_global_load_lds((const unsigned*)(Bsrc + b128), (unsigned*)(Bd + 4096), 16, 0, 0);
      }
      __builtin_amdgcn_sched_barrier(0);
    }
    st = (st == 2) ? 0 : st + 1;
  }
  __syncthreads();
}
template <int PS>
DEV void stage_half512(const int T, float* Cs, const f32x4 (&acc)[8][4]) {
  const int lane = T & 63, wave = T >> 6, wc = wave & 3, fr = lane & 15, fq = lane >> 4;
#pragma unroll
  for (int m = 0; m < 4; ++m)
#pragma unroll
    for (int n = 0; n < 4; ++n)
#pragma unroll
      for (int j = 0; j < 4; ++j) Cs[((wc >> 1) * 64 + m * 16 + fq * 4 + j) * 132 + (wc & 1) * 64 + n * 16 + fr] = acc[PS * 4 + m][n][j];
}
#define GROW(r, ps) (row0 + (size_t)(hf * 128 + (ps) * 64 + ((r) & 63)))
#define TNC(r) (tn * 2 + ((r) >> 6))

DEV bool tile_for(int it, int nM, int nN, int& tm, int& tn) {
  const int nx = (gridDim.x >> 3) * 2;
  const int xcd = blockIdx.x & 7, local = (blockIdx.x >> 3) * 2 + vhalf();
  const long id = ((long)it * 8 + xcd) * nx + local;
  if (local >= nx || id >= (long)nM * nN) return false;
  const int per_group = 8 * nN;
  const int g = (int)(id / per_group), r = (int)(id % per_group);
  tn = r >> 3; tm = g * 8 + (r & 7);
  return true;
}

DEV bool tile_for_real(int it, int nM, int nN, int& tm, int& tn) {
  const int nx = (gridDim.x >> 3);
  const int xcd = blockIdx.x & 7, local = (blockIdx.x >> 3);
  const long id = ((long)it * 8 + xcd) * nx + local;
  if (local >= nx || id >= (long)nM * nN) return false;
  const int per_group = 8 * nN;
  const int g = (int)(id / per_group), r = (int)(id % per_group);
  tn = r >> 3; tm = g * 8 + (r & 7);
  return true;
}

PHASE void phase_prep(const Params& p, char* smem) {
  const int tid = opaque_tid();
  const int vb = vblock(), vg = vgrid();
  if (vb == 0 && tid < 8) p.counters[tid] = 0u;
  if (vb == 0) for (int i = tid; i < 3456; i += 256) p.counters[256 + i] = 0u;
  float* tile = (float*)smem;
  const int NCONV = 2 * 4864, NADA = 192;
  for (int item0 = vb; item0 < NCONV + NADA; item0 += vg) {
    const int item = (item0 < NADA) ? (NCONV + item0) : (item0 - NADA);
    if (item < NCONV) {
      const int l = item / 4864; int r = item % 4864;
      const float* src; int K, Nsrc, nT, perm = 0; size_t dst;
      if (r < 2112) { src = p.w_in + (size_t)l * 1024 * 8448; K = 1024; Nsrc = 8448; dst = WIN; nT = 132; }
      else if (r < 2240) { r -= 2112; src = p.w_br_a + (size_t)l * 512 * 1024; K = 512; Nsrc = 1024; dst = WBA; nT = 16; }
      else if (r < 2368) { r -= 2240; src = p.w_br_b + (size_t)l * 512 * 1024; K = 512; Nsrc = 1024; dst = WBB; nT = 16; }
      else if (r < 2496) { r -= 2368; src = p.w_br_c + (size_t)l * 512 * 1024; K = 512; Nsrc = 1024; dst = WBC; nT = 16; }
      else if (r < 2752) { r -= 2496; src = p.w_out + (size_t)l * 1024 * 1024; K = 1024; Nsrc = 1024; dst = WOUT; nT = 16; }
      else if (r < 4160) { r -= 2752; src = p.ffn_w_in + (size_t)l * 1024 * 5632; K = 1024; Nsrc = 5632; dst = WFI; nT = 88; perm = 1; }
      else { r -= 4160; src = p.ffn_w_out + (size_t)l * 2816 * 1024; K = 2816; Nsrc = 1024; dst = WFO; nT = 16; }
      const int kt = r / nT, nt = r % nT;
      const int colbase = perm ? ((nt & 1) * FFH + 64 * (nt >> 1)) : nt * 64;
      __syncthreads();
#pragma unroll
      for (int i = 0; i < 16; ++i) {
        const int k = i * 4 + (tid >> 6), j = tid & 63;
        tile[k * 65 + j] = src[(size_t)(kt * 64 + k) * Nsrc + colbase + j];
      }
      __syncthreads();
      const int row = tid >> 2, kc = (tid & 3) * 16;
      float f[16];
#pragma unroll
      for (int i = 0; i < 16; ++i) f[i] = tile[(kc + i) * 65 + row];
      bf16_t* d = p.wt + (size_t)l * WLAYER + dst + (size_t)(nt * 64 + row) * K + kt * 64 + kc;
      *(uint4*)d = make_uint4(pack2(f[0], f[1]), pack2(f[2], f[3]), pack2(f[4], f[5]), pack2(f[6], f[7]));
      *(uint4*)(d + 8) = make_uint4(pack2(f[8], f[9]), pack2(f[10], f[11]), pack2(f[12], f[13]), pack2(f[14], f[15]));
    } else {
      const int a = item - NCONV;
      const int l = a / 96, r = a % 96, ntile = r >> 2, bg = r & 3;
      float* cact = (float*)smem;
      __syncthreads();
      for (int i = tid; i < 8 * 1024; i += 256) {
        const float cv = p.c[(size_t)(bg * 8 + (i >> 10)) * DM + (i & 1023)];
        cact[i] = cv * sigm(cv);
      }
      __syncthreads();
      const int n = ntile * 256 + tid;
      const float* W = p.ada_w + (size_t)l * DM * ADAW + n;
      float acc[8];
#pragma unroll
      for (int b = 0; b < 8; ++b) acc[b] = 0.f;
      for (int k0 = 0; k0 < DM; k0 += 16) {
        float w[16];
#pragma unroll
        for (int kk = 0; kk < 16; ++kk) w[kk] = W[(size_t)(k0 + kk) * ADAW];
#pragma unroll
        for (int kk = 0; kk < 16; ++kk)
#pragma unroll
          for (int b = 0; b < 8; ++b) acc[b] += cact[b * 1024 + k0 + kk] * w[kk];
      }
      const float bias = p.ada_b[l * ADAW + n];
#pragma unroll
      for (int b = 0; b < 8; ++b) p.ada[((size_t)l * 32 + bg * 8 + b) * ADAW + n] = acc[b] + bias;
    }
  }
}

PHASE void phase_norm(const float* __restrict__ x, const float* __restrict__ w, const float* __restrict__ ada_l,
                    int shift_off, int scale_off, bf16_t* __restrict__ h) {
  const int tid = opaque_tid();
  const int lane = tid & 63, wave = tid >> 6;
  for (int row = vblock() * 4 + wave; row < T_TOK; row += vgrid() * 4) {
    const float* xr = x + (size_t)row * DM;
    float4 v[4]; float ss = 0.f;
#pragma unroll
    for (int i = 0; i < 4; ++i) { v[i] = *(const float4*)(xr + i * 256 + lane * 4); ss += v[i].x * v[i].x + v[i].y * v[i].y + v[i].z * v[i].z + v[i].w * v[i].w; }
    ss = wave_sum(ss);
    const float rstd = rsqrtf(ss * (1.f / DM) + 1e-6f);
    const float* ad = ada_l + (size_t)(row / SEQ) * ADAW;
#pragma unroll
    for (int i = 0; i < 4; ++i) {
      const int col = i * 256 + lane * 4;
      const float4 ww = *(const float4*)(w + col), sc = *(const float4*)(ad + scale_off + col), sh = *(const float4*)(ad + shift_off + col);
      const float o0 = v[i].x * rstd * ww.x * (1.f + sc.x) + sh.x, o1 = v[i].y * rstd * ww.y * (1.f + sc.y) + sh.y;
      const float o2 = v[i].z * rstd * ww.z * (1.f + sc.z) + sh.z, o3 = v[i].w * rstd * ww.w * (1.f + sc.w) + sh.w;
      *(uint2*)(h + (size_t)row * DM + col) = make_uint2(pack2(o0, o1), pack2(o2, o3));
    }
  }
}

PHASE void phase_final(float* __restrict__ x, const float* __restrict__ w) {
  const int tid = opaque_tid();
  const int lane = tid & 63, wave = tid >> 6;
  for (int row = vblock() * 4 + wave; row < T_TOK; row += vgrid() * 4) {
    float* xr = x + (size_t)row * DM;
    float4 v[4]; float ss = 0.f;
#pragma unroll
    for (int i = 0; i < 4; ++i) { v[i] = *(const float4*)(xr + i * 256 + lane * 4); ss += v[i].x * v[i].x + v[i].y * v[i].y + v[i].z * v[i].z + v[i].w * v[i].w; }
    ss = wave_sum(ss);
    const float rstd = rsqrtf(ss * (1.f / DM) + 1e-6f);
#pragma unroll
    for (int i = 0; i < 4; ++i) {
      const int col = i * 256 + lane * 4;
      const float4 ww = *(const float4*)(w + col);
      *(float4*)(xr + col) = make_float4(v[i].x * rstd * ww.x, v[i].y * rstd * ww.y, v[i].z * rstd * ww.z, v[i].w * rstd * ww.w);
    }
  }
}

PHASE void phase_gemm_in(const Params& p, int l, char* smem0) {
  const bf16_t* Wt = p.wt + (size_t)l * WLAYER + WIN;
  const int T = opaque_tid512(), tid = T & 255, hf = vhalf();
  float* Cs = (float*)(smem0 + hf * SMEM_BYTES);
  for (int it = 0;; ++it) {
    int tm, tn;
    if (!tile_for_real(it, 256, 21, tm, tn)) break;
    f32x4 acc[8][4];
    gemm_tile512(T, p.h + (size_t)tm * 256 * DM, DM, Wt + (size_t)tn * 256 * DM, DM, DM, smem0, acc);
    const size_t row0 = (size_t)tm * 256;
#pragma unroll
    for (int ps = 0; ps < 2; ++ps) {
      if (ps == 0) stage_half512<0>(T, Cs, acc); else stage_half512<1>(T, Cs, acc);
      __syncthreads();
      if (tn < 4) {
        const float qs = (tn < 2) ? 0.125f : 1.f;
        const int ch = tid & 15, g = ch >> 3, cc = ch & 7;
        if (cc < 4) {
#pragma unroll 1
          for (int i = 0; i < 8; ++i) {
            const int r = (tid >> 4) + i * 16;
            const size_t grow = GROW(r, ps);
            const float pos = (float)p.pos[grow];
            const float* c1 = Cs + r * 132 + g * 64 + cc * 8;
            float o1[8], o2[8];
#pragma unroll
            for (int e = 0; e < 8; ++e) {
              const float x1 = c1[e], x2 = c1[32 + e];
              const float inv = exp2f(-(float)(cc * 8 + e) * 0.41524101186092029f);
              float rev = pos * inv * 0.15915494309189535f;
              rev -= rintf(rev);
              const float sn = __builtin_amdgcn_sinf(rev), cs = __builtin_amdgcn_cosf(rev);
              o1[e] = (x1 * cs - x2 * sn) * qs; o2[e] = (x2 * cs + x1 * sn) * qs;
            }
            bf16_t* d = p.u + grow * US + TNC(r) * 128 + g * 64 + cc * 8;
            *(uint4*)d = PACK8(o1);
            *(uint4*)(d + 32) = PACK8(o2);
          }
        }
      } else if (tn < 6) {
        const int b = (int)(row0 / SEQ), s0 = (int)(row0 % SEQ);
        const int rch = tid & 15;
        const int vc0 = (TNC(rch * 8) - 8) * 128;
#pragma unroll 1
        for (int i = 0; i < 8; ++i) {
          const int c = (tid >> 4) + i * 16;
          float f[8];
#pragma unroll
          for (int j = 0; j < 8; ++j) f[j] = Cs[(rch * 8 + j) * 132 + c];
          *(uint4*)(p.vT + ((size_t)b * 512 + vc0 + c) * SEQ + s0 + hf * 128 + ps * 64 + ((rch * 8) & 63)) = PACK8(f);
        }
      } else {
        const int ch = tid & 15;
#pragma unroll 1
        for (int i = 0; i < 8; ++i) {
          const int r = (tid >> 4) + i * 16;
          const float4 a = *(const float4*)(Cs + r * 132 + ch * 8), b = *(const float4*)(Cs + r * 132 + ch * 8 + 4);
          *(uint4*)(p.u + GROW(r, ps) * US + TNC(r) * 128 - 512 + ch * 8) = make_uint4(pack2(a.x, a.y), pack2(a.z, a.w), pack2(b.x, b.y), pack2(b.z, b.w));
        }
      }
      __syncthreads();
    }
  }
}

PHASE void phase_vlo(const Params& p, int l, char* smem) {
  float* vs = (float*)smem;
  const int tid = opaque_tid();
  const float* mu = p.rw_mu + (size_t)l * 1792 + 1024;
  const float* v1 = p.rw_v1;
  for (int item = vblock(); item < T_TOK / 32; item += vgrid()) {
    const size_t tok0 = (size_t)item * 32;
    __syncthreads();
#pragma unroll 1
    for (int i = 0; i < 8; ++i) {
      const int c = tid + i * 256;
      const int t = c >> 6, cc = c & 63;
      const size_t tok = tok0 + t;
      const uint4 cur = *(const uint4*)(p.u + tok * US + 3072 + 1024 + cc * 8);
      uint4 prv = make_uint4(0, 0, 0, 0);
      if ((tok % SEQ) != 0) prv = *(const uint4*)(p.u + (tok - 1) * US + 3072 + 1024 + cc * 8);
      float a[8], b[8];
      UNPACK8(cur, a); UNPACK8(prv, b);
#pragma unroll
      for (int e = 0; e < 8; ++e) vs[t * 512 + cc * 8 + e] = a[e] + (b[e] - a[e]) * mu[cc * 8 + e];
    }
    __syncthreads();
    const int j = tid & 31, tg = tid >> 5;
    float acc[4] = {0.f, 0.f, 0.f, 0.f};
    for (int k0 = 0; k0 < 512; k0 += 16) {
      float w[16];
#pragma unroll
      for (int kk = 0; kk < 16; ++kk) w[kk] = v1[(k0 + kk) * 32 + j];
#pragma unroll
      for (int kk = 0; kk < 16; ++kk)
#pragma unroll
        for (int i = 0; i < 4; ++i) acc[i] += vs[(tg * 4 + i) * 512 + k0 + kk] * w[kk];
    }
#pragma unroll
    for (int i = 0; i < 4; ++i) p.vlo[(tok0 + tg * 4 + i) * 32 + j] = acc[i];
  }
}

PHASE void att_item(const Params& p, int l, int item, char* smem) {
  const int qc = 31 - (item >> 7);
  const int bh = item & 127, b = bh >> 2, h = bh & 3;
  const int tid = opaque_tid(), lane = tid & 63, wave = tid >> 6, fr = lane & 15, fq = lane >> 4;
  const int m = wave >> 1, rh = wave & 1;
  bf16_t* Ks = (bf16_t*)smem;
  bf16_t* Vt = Ks + 2 * 64 * 64;
  bf16_t* Ps = Vt + 128 * 64;
  float* Ox = (float*)smem;
  const size_t tok0 = (size_t)b * SEQ + (size_t)qc * 64;
  const float* lv = p.da_lambda + (size_t)l * 256;
  float d1 = 0.f, d2 = 0.f;
  for (int i = 0; i < 64; ++i) { d1 += lv[i] * lv[64 + i]; d2 += lv[128 + i] * lv[192 + i]; }
  const float lam_init = 0.8f - 0.6f * __expf(-0.3f * (float)l);
  const float lam = __expf(d1) - __expf(d2) + lam_init;

  bf16x8 qf[2][2];
#pragma unroll
  for (int mt = 0; mt < 2; ++mt)
#pragma unroll
    for (int ks = 0; ks < 2; ++ks)
      qf[mt][ks] = *(const bf16x8*)(p.u + (tok0 + rh * 32 + mt * 16 + fr) * US + h * 128 + m * 64 + ks * 32 + fq * 8);
  f32x4 o[2][8];
  float mx[2][4], ls[2][4];
#pragma unroll
  for (int mt = 0; mt < 2; ++mt) {
#pragma unroll
    for (int n = 0; n < 8; ++n) o[mt][n] = (f32x4){0.f, 0.f, 0.f, 0.f};
#pragma unroll
    for (int j = 0; j < 4; ++j) { mx[mt][j] = -1e30f; ls[mt][j] = 0.f; }
  }
  bf16_t* Pw = Ps + wave * 32 * 72;
  const int drow = tid >> 3, dlog = ((tid & 7) ^ ((tid >> 3) & 7)) * 8;
  const bf16_t* Kg = p.u + ((size_t)b * SEQ + (drow & 63)) * US + 512 + h * 128 + dlog;
  const bf16_t* Vg = p.vT + ((size_t)b * 512 + h * 128 + drow) * SEQ + dlog;
  const int rsw = fr & 7;
#define ATT_DMA_K(kt_)                                                                                              \
  _Pragma("unroll") for (int i = 0; i < 4; ++i)                                                                     \
    __builtin_amdgcn_global_load_lds((const unsigned*)(Kg + ((size_t)(kt_) * 64 + (i & 1) * 32) * US + (i >> 1) * 64), \
                                     (unsigned*)(Ks + tid * 8 + i * 2048), 16, 0, 0);
#define ATT_DMA_V(kt_)                                                                                              \
  _Pragma("unroll") for (int i = 0; i < 4; ++i)                                                                     \
    __builtin_amdgcn_global_load_lds((const unsigned*)(Vg + (size_t)(i * 32) * SEQ + (kt_) * 64),                  \
                                     (unsigned*)(Vt + tid * 8 + i * 2048), 16, 0, 0);
  __syncthreads();
  ATT_DMA_K(0)
  for (int kt = 0; kt <= qc; ++kt) {
    asm volatile("s_waitcnt vmcnt(0)" ::: "memory");
    __syncthreads();
    ATT_DMA_V(kt)
    f32x4 s[2][4];
#pragma unroll
    for (int mt = 0; mt < 2; ++mt)
#pragma unroll
      for (int n = 0; n < 4; ++n) s[mt][n] = (f32x4){0.f, 0.f, 0.f, 0.f};
#pragma unroll
    for (int ks = 0; ks < 2; ++ks)
#pragma unroll
      for (int n = 0; n < 4; ++n) {
        const bf16x8 kf = *(const bf16x8*)(Ks + (m * 64 + n * 16 + fr) * 64 + (((ks * 4 + fq) ^ rsw) * 8));
#pragma unroll
        for (int mt = 0; mt < 2; ++mt) s[mt][n] = MFMA(qf[mt][ks], kf, s[mt][n]);
      }
#pragma unroll
    for (int mt = 0; mt < 2; ++mt)
#pragma unroll
      for (int j = 0; j < 4; ++j) {
        float tmax = fmaxf(fmaxf(s[mt][0][j], s[mt][1][j]), fmaxf(s[mt][2][j], s[mt][3][j]));
        tmax = red16_max(tmax);
        const float mnew = fmaxf(mx[mt][j], tmax);
        const float alpha = __expf(mx[mt][j] - mnew);
        float rs = 0.f;
#pragma unroll
        for (int n = 0; n < 4; ++n) {
          const float pv = __expf(s[mt][n][j] - mnew);
          rs += pv;
          Pw[(mt * 16 + fq * 4 + j) * 72 + n * 16 + fr] = f2bf(pv);
        }
        rs = red16_sum(rs);
        ls[mt][j] = ls[mt][j] * alpha + rs;
        mx[mt][j] = mnew;
#pragma unroll
        for (int n = 0; n < 8; ++n) o[mt][n][j] *= alpha;
      }
    asm volatile("s_waitcnt vmcnt(0)" ::: "memory");
    __syncthreads();
    if (kt < qc) { ATT_DMA_K(kt + 1) }
#pragma unroll
    for (int ks = 0; ks < 2; ++ks) {
      bf16x8 pf[2];
#pragma unroll
      for (int mt = 0; mt < 2; ++mt) pf[mt] = *(const bf16x8*)(Pw + (mt * 16 + fr) * 72 + ks * 32 + fq * 8);
#pragma unroll
      for (int n = 0; n < 8; ++n) {
        const bf16x8 vf = *(const bf16x8*)(Vt + (n * 16 + fr) * 64 + (((ks * 4 + fq) ^ rsw) * 8));
#pragma unroll
        for (int mt = 0; mt < 2; ++mt) o[mt][n] = MFMA(pf[mt], vf, o[mt][n]);
      }
    }
  }
#undef ATT_DMA_K
#undef ATT_DMA_V
  __syncthreads();
#pragma unroll
  for (int mt = 0; mt < 2; ++mt)
#pragma unroll
    for (int j = 0; j < 4; ++j) {
      const float inv = 1.f / ls[mt][j];
#pragma unroll
      for (int n = 0; n < 8; ++n) o[mt][n][j] *= inv;
    }
  if (m == 1) {
#pragma unroll
    for (int mt = 0; mt < 2; ++mt)
#pragma unroll
      for (int n = 0; n < 8; ++n)
#pragma unroll
        for (int j = 0; j < 4; ++j) Ox[(rh * 32 + mt * 16 + fq * 4 + j) * 132 + n * 16 + fr] = o[mt][n][j];
  }
  __syncthreads();
  if (m == 0) {
    const float* sw = p.da_subln_w + (size_t)l * 128;
    float wv[8];
#pragma unroll
    for (int n = 0; n < 8; ++n) wv[n] = sw[n * 16 + fr] * (1.f - lam_init);
#pragma unroll
    for (int mt = 0; mt < 2; ++mt)
#pragma unroll
      for (int j = 0; j < 4; ++j) {
        float ss = 0.f;
        float d[8];
#pragma unroll
        for (int n = 0; n < 8; ++n) {
          d[n] = o[mt][n][j] - lam * Ox[(rh * 32 + mt * 16 + fq * 4 + j) * 132 + n * 16 + fr];
          ss += d[n] * d[n];
        }
        ss = red16_sum(ss);
        const float rstd = rsqrtf(ss * (1.f / 128.f) + 1e-6f);
        bf16_t* dst = p.u + (tok0 + rh * 32 + mt * 16 + fq * 4 + j) * US + h * 128 + fr;
#pragma unroll
        for (int n = 0; n < 8; ++n) dst[n * 16] = f2bf(d[n] * rstd * wv[n]);
      }
  }
  __syncthreads();
}

PHASE void hgrn_item(const Params& p, int l, int item, char* smem) {
  const int b = item >> 2, h = item & 3;
  const int tid = opaque_tid(), lane = tid & 63, wave = tid >> 6, fr = lane & 15, fq = lane >> 4;
  bf16_t* Qs = (bf16_t*)smem;
  bf16_t* Kn = Qs + 32 * 136;
  bf16_t* KT = Kn + 32 * 136;
  bf16_t* VT = KT + 128 * 40;
  bf16_t* Ps = VT + 128 * 40;
  bf16_t* ST = Ps + 32 * 40;
  float* lfb = (float*)ST;
  float* red = (float*)(ST + 128 * 136);
  float* blast = red + 64;
  const int t_ = tid >> 3, d0 = (tid & 7) * 16;
  float lbv[16];
#pragma unroll
  for (int i = 0; i < 16; ++i) {
    const int c = h * 128 + d0 + i;
    lbv[i] = (l == 0) ? 0.f : sigm(p.hg_lb[512 + c] - p.hg_lb[c]);
  }
  f32x4 S[2][8];
#pragma unroll
  for (int mm = 0; mm < 2; ++mm)
#pragma unroll
    for (int n = 0; n < 8; ++n) S[mm][n] = (f32x4){0.f, 0.f, 0.f, 0.f};
  const float* nw = p.hg_norm_w + (size_t)l * 128;

  for (int ch = 0; ch < 64; ++ch) {
    const size_t tok0 = (size_t)b * SEQ + (size_t)ch * 32;
    __syncthreads();
    float qv[16], kv[16];
    {
      const bf16_t* base = p.u + (tok0 + t_) * US + h * 128 + d0;
      float zv[16], iv[16];
      { const uint4 a = *(const uint4*)(base + 1024), c = *(const uint4*)(base + 1024 + 8); float* z0 = zv; float* z1 = zv + 8; UNPACK8(a, z0); UNPACK8(c, z1); }
      { const uint4 a = *(const uint4*)(base + 1536), c = *(const uint4*)(base + 1536 + 8); float* z0 = iv; float* z1 = iv + 8; UNPACK8(a, z0); UNPACK8(c, z1); }
      { const uint4 a = *(const uint4*)(base + 2048), c = *(const uint4*)(base + 2048 + 8); float* z0 = qv; float* z1 = qv + 8; UNPACK8(a, z0); UNPACK8(c, z1); }
#pragma unroll
      for (int i = 0; i < 16; ++i) {
        const float z = zv[i], lb = lbv[i];
        const float ez = __expf(-fabsf(z));
        float lf;
        if (lb > 0.f) {
          const float sg = (z >= 0.f) ? 1.f / (1.f + ez) : ez / (1.f + ez);
          lf = __logf(lb + (1.f - lb) * sg);
        } else {
          lf = -(fmaxf(-z, 0.f) + __logf(1.f + ez));
        }
        const float sgn = (z >= 0.f) ? ez / (1.f + ez) : 1.f / (1.f + ez);
        kv[i] = (1.f - lb) * sgn;
        lfb[t_ * 128 + d0 + i] = lf;
        VT[(d0 + i) * 40 + t_] = f2bf(iv[i]);
      }
    }
    __syncthreads();
    if (tid < 128) {
      float v[32];
#pragma unroll
      for (int t = 0; t < 32; ++t) v[t] = lfb[t * 128 + tid];
      float bsum = 0.f;
#pragma unroll
      for (int t = 0; t < 32; ++t) { bsum += v[t]; lfb[t * 128 + tid] = bsum; }
      blast[tid] = bsum;
    }
    __syncthreads();
    {
      float qo[16], ko[16];
#pragma unroll
      for (int i = 0; i < 16; ++i) {
        const float bb = lfb[t_ * 128 + d0 + i];
        qo[i] = qv[i] * __expf(bb);
        ko[i] = kv[i] * __expf(fminf(-bb, 80.f));
        KT[(d0 + i) * 40 + t_] = f2bf(ko[i]);
      }
      float* q0 = qo; float* q1 = qo + 8; float* k0 = ko; float* k1 = ko + 8;
      *(uint4*)(Qs + t_ * 136 + d0) = PACK8(q0);
      *(uint4*)(Qs + t_ * 136 + d0 + 8) = PACK8(q1);
      *(uint4*)(Kn + t_ * 136 + d0) = PACK8(k0);
      *(uint4*)(Kn + t_ * 136 + d0 + 8) = PACK8(k1);
    }
    __syncthreads();
#pragma unroll
    for (int mm = 0; mm < 2; ++mm)
#pragma unroll
      for (int n = 0; n < 8; ++n)
        *(uint2*)(ST + (n * 16 + fr) * 136 + wave * 32 + mm * 16 + fq * 4) =
            make_uint2(pack2(S[mm][n][0], S[mm][n][1]), pack2(S[mm][n][2], S[mm][n][3]));
    {
      const int mt = wave >> 1, nt = wave & 1;
      f32x4 sc = (f32x4){0.f, 0.f, 0.f, 0.f};
#pragma unroll
      for (int ks = 0; ks < 4; ++ks) {
        const bf16x8 a = *(const bf16x8*)(Qs + (mt * 16 + fr) * 136 + ks * 32 + fq * 8);
        const bf16x8 bb = *(const bf16x8*)(Kn + (nt * 16 + fr) * 136 + ks * 32 + fq * 8);
        sc = MFMA(a, bb, sc);
      }
#pragma unroll
      for (int j = 0; j < 4; ++j) {
        const int t = mt * 16 + fq * 4 + j, key = nt * 16 + fr;
        Ps[t * 40 + key] = f2bf(key <= t ? sc[j] : 0.f);
      }
    }
    __syncthreads();
    {
      const int mt = wave & 1, nb = (wave >> 1) * 4;
      f32x4 oo[4];
#pragma unroll
      for (int n = 0; n < 4; ++n) oo[n] = (f32x4){0.f, 0.f, 0.f, 0.f};
      {
        const bf16x8 a = *(const bf16x8*)(Ps + (mt * 16 + fr) * 40 + fq * 8);
#pragma unroll
        for (int n = 0; n < 4; ++n) {
          const bf16x8 bb = *(const bf16x8*)(VT + ((nb + n) * 16 + fr) * 40 + fq * 8);
          oo[n] = MFMA(a, bb, oo[n]);
        }
      }
#pragma unroll
      for (int ks = 0; ks < 4; ++ks) {
        const bf16x8 a = *(const bf16x8*)(Qs + (mt * 16 + fr) * 136 + ks * 32 + fq * 8);
#pragma unroll
        for (int n = 0; n < 4; ++n) {
          const bf16x8 bb = *(const bf16x8*)(ST + ((nb + n) * 16 + fr) * 136 + ks * 32 + fq * 8);
          oo[n] = MFMA(a, bb, oo[n]);
        }
      }
#pragma unroll
      for (int j = 0; j < 4; ++j) {
        float ss = 0.f;
#pragma unroll
        for (int n = 0; n < 4; ++n) ss += oo[n][j] * oo[n][j];
        ss = red16_sum(ss);
        if (fr == 0) red[(mt * 16 + fq * 4 + j) * 2 + (wave >> 1)] = ss;
      }
      __syncthreads();
#pragma unroll
      for (int j = 0; j < 4; ++j) {
        const int t = mt * 16 + fq * 4 + j;
        const float rstd = rsqrtf((red[t * 2] + red[t * 2 + 1]) * (1.f / 128.f) + 1e-6f);
        bf16_t* gp = p.u + (tok0 + t) * US + 2560 + h * 128 + nb * 16 + fr;
#pragma unroll
        for (int n = 0; n < 4; ++n) {
          const float g = bf2f(gp[n * 16]);
          gp[n * 16] = f2bf(oo[n][j] * rstd * nw[(nb + n) * 16 + fr] * (g * sigm(g)));
        }
      }
    }
    {
      bf16x8 af[2];
#pragma unroll
      for (int mm = 0; mm < 2; ++mm) af[mm] = *(const bf16x8*)(KT + (wave * 32 + mm * 16 + fr) * 40 + fq * 8);
#pragma unroll
      for (int n = 0; n < 8; ++n) {
        const bf16x8 bb = *(const bf16x8*)(VT + (n * 16 + fr) * 40 + fq * 8);
#pragma unroll
        for (int mm = 0; mm < 2; ++mm) S[mm][n] = MFMA(af[mm], bb, S[mm][n]);
      }
#pragma unroll
      for (int mm = 0; mm < 2; ++mm)
#pragma unroll
        for (int j = 0; j < 4; ++j) {
          const float e = __expf(blast[wave * 32 + mm * 16 + fq * 4 + j]);
#pragma unroll
          for (int n = 0; n < 8; ++n) S[mm][n][j] *= e;
        }
    }
  }
  __syncthreads();
}

DEV uint4 rw_act(const uint4 cur, const uint4 prv, const float* mul8, int mode) {
  const float4 m0 = *(const float4*)(mul8), m1 = *(const float4*)(mul8 + 4);
  const float mm[8] = {m0.x, m0.y, m0.z, m0.w, m1.x, m1.y, m1.z, m1.w};
  float a[8], b[8], o[8];
  UNPACK8(cur, a); UNPACK8(prv, b);
#pragma unroll
  for (int e = 0; e < 8; ++e) {
    float v = a[e] + (b[e] - a[e]) * mm[e];
    if (mode == 1) { const float t = __expf(-2.f * fabsf(v)); const float th = (1.f - t) / (1.f + t); v = (v >= 0.f) ? th : -th; }
    else if (mode == 2) v = sigm(v);
    o[e] = v;
  }
  return PACK8(o);
}
DEV bf16x8 rw_bfrag(const float* W, int k0, int col) {
  float o[8];
#pragma unroll
  for (int e = 0; e < 8; ++e) o[e] = W[(size_t)(k0 + e) * 512 + col];
  return as_frag(PACK8(o));
}

PHASE void rwkv_item(const Params& p, int l, int item, char* smem) {
  const int b = item >> 3, h = item & 7;
  const int tid = opaque_tid(), lane = tid & 63, wave = tid >> 6, fr = lane & 15, fq = lane >> 4;
  float* R = (float*)smem;
  float* K = R + 2048; float* KK = K + 2048; float* W = KK + 2048; float* BB = W + 2048;
  float* V = BB + 2048; float* G = V + 2048; float* O = G + 2048;
  float* cst = O + 2048;
  float* mul = cst + 512;
  bf16_t* rawL = (bf16_t*)smem;
  float* vloL = (float*)(smem + 17424);
  const float* mu = p.rw_mu + (size_t)l * 1792;
  const int hc_n = h * 64 + wave * 16 + fr;
  bf16x8 w2f[2], a2f[2], g2f[4], v2f;
#pragma unroll
  for (int ks = 0; ks < 2; ++ks) {
    w2f[ks] = rw_bfrag(p.rw_w2 + (size_t)l * 64 * 512, ks * 32 + fq * 8, hc_n);
    a2f[ks] = rw_bfrag(p.rw_a2 + (size_t)l * 64 * 512, ks * 32 + fq * 8, hc_n);
  }
#pragma unroll
  for (int ks = 0; ks < 4; ++ks) g2f[ks] = rw_bfrag(p.rw_g2 + (size_t)l * 128 * 512, ks * 32 + fq * 8, hc_n);
  v2f = w2f[0];
  if (l > 0) v2f = rw_bfrag(p.rw_v2, fq * 8, hc_n);
  const float w0c = p.rw_w0[l * 512 + hc_n], a0c = p.rw_a0[l * 512 + hc_n];
  const float v0c = (l > 0) ? p.rw_v0[hc_n] : 0.f;
  const int t_ = tid >> 3, n0 = (tid & 7) * 8;
  __syncthreads();
  if (tid < 64) {
    const int hc = h * 64 + tid;
    cst[tid] = p.rw_k_k[l * 512 + hc]; cst[64 + tid] = p.rw_k_a[l * 512 + hc]; cst[128 + tid] = p.rw_r_k[l * 512 + hc];
    cst[192 + tid] = p.rw_gn_w[l * 512 + hc]; cst[256 + tid] = p.rw_gn_b[l * 512 + hc];
    cst[320 + tid] = mu[hc]; cst[384 + tid] = mu[512 + hc]; cst[448 + tid] = mu[1024 + hc];
  }
  mul[tid] = mu[1536 + tid];
  const float* kkc = cst + n0; const float* kac = cst + 64 + n0; const float* rkc = cst + 128 + n0;
  const float* gnw = cst + 192 + n0; const float* gnb = cst + 256 + n0;
  const float* mur = cst + 320 + n0; const float* muk = cst + 384 + n0; const float* muv = cst + 448 + n0;
  const int kq = lane & 7, row0 = wave * 16 + (lane >> 3), row1 = row0 + 8;
  f32x2 S0p[4], S1p[4];
#pragma unroll
  for (int e = 0; e < 4; ++e) { S0p[e] = (f32x2){0.f, 0.f}; S1p[e] = (f32x2){0.f, 0.f}; }

  uint4 pl0, pl1, pl2, pl3, pl4, pcr, pck, pcv, ppr, ppk, ppv, pvf;
  float4 pvl;
#define RW_PREFETCH(ch_)                                                                                    \
  {                                                                                                         \
    const size_t tk0 = (size_t)b * SEQ + (size_t)(ch_) * 32;                                                 \
    const bf16_t* lb_ = p.u + (tk0 - 1) * US + 3072 + 1536 + (tid & 31) * 8;                                 \
    const int r0_ = tid >> 5;                                                                               \
    pl0 = make_uint4(0, 0, 0, 0); if (!((ch_) == 0 && r0_ == 0)) pl0 = *(const uint4*)(lb_ + (size_t)r0_ * US); \
    pl1 = *(const uint4*)(lb_ + (size_t)(r0_ + 8) * US);                                                     \
    pl2 = *(const uint4*)(lb_ + (size_t)(r0_ + 16) * US);                                                    \
    pl3 = *(const uint4*)(lb_ + (size_t)(r0_ + 24) * US);                                                    \
    pl4 = make_uint4(0, 0, 0, 0); if (tid < 32) pl4 = *(const uint4*)(lb_ + (size_t)32 * US);                \
    const bf16_t* cu_ = p.u + (tk0 + t_) * US + 3072 + h * 64 + n0;                                          \
    pcr = *(const uint4*)cu_; pck = *(const uint4*)(cu_ + 512); pcv = *(const uint4*)(cu_ + 1024);           \
    if ((ch_) == 0 && t_ == 0) { ppr = make_uint4(0, 0, 0, 0); ppk = ppr; ppv = ppr; }                        \
    else { ppr = *(const uint4*)(cu_ - US); ppk = *(const uint4*)(cu_ - US + 512); ppv = *(const uint4*)(cu_ - US + 1024); } \
    if (l > 0) {                                                                                            \
      pvl = *(const float4*)(p.vlo + (tk0 + (tid >> 3)) * 32 + (tid & 7) * 4);                               \
      pvf = *(const uint4*)(p.vfirst + (tk0 + t_) * 512 + h * 64 + n0);                                      \
    } else { pvl = make_float4(0.f, 0.f, 0.f, 0.f); pvf = make_uint4(0, 0, 0, 0); }                          \
  }
  RW_PREFETCH(0)

  for (int ch = 0; ch < 64; ++ch) {
    const size_t tok0 = (size_t)b * SEQ + (size_t)ch * 32;
    __syncthreads();
    {
      const int r0_ = tid >> 5, cc_ = (tid & 31) * 8;
      *(uint4*)(rawL + r0_ * 264 + cc_) = pl0;
      *(uint4*)(rawL + (r0_ + 8) * 264 + cc_) = pl1;
      *(uint4*)(rawL + (r0_ + 16) * 264 + cc_) = pl2;
      *(uint4*)(rawL + (r0_ + 24) * 264 + cc_) = pl3;
      if (tid < 32) *(uint4*)(rawL + 32 * 264 + cc_) = pl4;
      *(float4*)(vloL + (tid >> 3) * 36 + (tid & 7) * 4) = pvl;
    }
    __syncthreads();
    {
      const int cc_ = (tid & 31) * 8, tr = tid >> 5;
      const int mode = (cc_ < 64) ? 1 : ((cc_ < 128) ? 0 : 2);
      uint4 a0, a1, a2, a3;
      a0 = rw_act(*(const uint4*)(rawL + (tr + 1) * 264 + cc_), *(const uint4*)(rawL + tr * 264 + cc_), mul + cc_, mode);
      a1 = rw_act(*(const uint4*)(rawL + (tr + 9) * 264 + cc_), *(const uint4*)(rawL + (tr + 8) * 264 + cc_), mul + cc_, mode);
      a2 = rw_act(*(const uint4*)(rawL + (tr + 17) * 264 + cc_), *(const uint4*)(rawL + (tr + 16) * 264 + cc_), mul + cc_, mode);
      a3 = rw_act(*(const uint4*)(rawL + (tr + 25) * 264 + cc_), *(const uint4*)(rawL + (tr + 24) * 264 + cc_), mul + cc_, mode);
      __syncthreads();
      *(uint4*)(rawL + tr * 264 + cc_) = a0;
      *(uint4*)(rawL + (tr + 8) * 264 + cc_) = a1;
      *(uint4*)(rawL + (tr + 16) * 264 + cc_) = a2;
      *(uint4*)(rawL + (tr + 24) * 264 + cc_) = a3;
    }
    __syncthreads();
#pragma unroll 1
    for (int mt = 0; mt < 2; ++mt) {
      const int row = mt * 16 + fr;
      const bf16_t* ar = rawL + row * 264 + fq * 8;
      f32x4 aw = (f32x4){0.f, 0.f, 0.f, 0.f}, aa = aw, ag = aw, av = aw;
#pragma unroll
      for (int ks = 0; ks < 2; ++ks) {
        aw = MFMA(*(const bf16x8*)(ar + ks * 32), w2f[ks], aw);
        aa = MFMA(*(const bf16x8*)(ar + 64 + ks * 32), a2f[ks], aa);
      }
#pragma unroll
      for (int ks = 0; ks < 4; ++ks) ag = MFMA(*(const bf16x8*)(ar + 128 + ks * 32), g2f[ks], ag);
      if (l > 0) {
        const float4 x0 = *(const float4*)(vloL + row * 36 + fq * 8), x1 = *(const float4*)(vloL + row * 36 + fq * 8 + 4);
        const uint4 pk = make_uint4(pack2(x0.x, x0.y), pack2(x0.z, x0.w), pack2(x1.x, x1.y), pack2(x1.z, x1.w));
        av = MFMA(as_frag(pk), v2f, av);
      }
#pragma unroll
      for (int j = 0; j < 4; ++j) {
        const int t = mt * 16 + fq * 4 + j, n = wave * 16 + fr;
        const float wv = -(w0c + aw[j]);
        const float sp = fmaxf(wv, 0.f) + __logf(1.f + __expf(-fabsf(wv)));
        const float wl = -sp - 0.5f;
        W[t * 64 + n] = __expf(-__expf(wl));
        BB[t * 64 + n] = sigm(a0c + aa[j]);
        G[t * 64 + n] = ag[j];
        if (l > 0) O[t * 64 + n] = sigm(v0c + av[j]);
      }
    }
    __syncthreads();
    {
      const size_t tok = tok0 + t_;
      float cr[8], ck[8], cv[8], pr[8], pk[8], pv[8];
      UNPACK8(pcr, cr); UNPACK8(pck, ck); UNPACK8(pcv, cv);
      UNPACK8(ppr, pr); UNPACK8(ppk, pk); UNPACK8(ppv, pv);
      float kx[8], kkv[8], vs[8], ss = 0.f;
#pragma unroll
      for (int e = 0; e < 8; ++e) {
        R[t_ * 64 + n0 + e] = cr[e] + (pr[e] - cr[e]) * mur[e];
        kx[e] = ck[e] + (pk[e] - ck[e]) * muk[e];
        vs[e] = cv[e] + (pv[e] - cv[e]) * muv[e];
        kkv[e] = kx[e] * kkc[e]; ss += kkv[e] * kkv[e];
      }
      ss = red8_sum(ss);
      const float rn = rsqrtf(fmaxf(ss, 1e-24f));
#pragma unroll
      for (int e = 0; e < 8; ++e) {
        const float a = BB[t_ * 64 + n0 + e];
        const float kn = kkv[e] * rn;
        K[t_ * 64 + n0 + e] = kx[e] * (1.f + (a - 1.f) * kac[e]);
        KK[t_ * 64 + n0 + e] = kn;
        BB[t_ * 64 + n0 + e] = kn * a;
      }
      if (l == 0) {
        *(uint4*)(p.vfirst + tok * 512 + h * 64 + n0) = PACK8(vs);
      } else {
        float vf[8]; UNPACK8(pvf, vf);
#pragma unroll
        for (int e = 0; e < 8; ++e) vs[e] = vs[e] + (vf[e] - vs[e]) * O[t_ * 64 + n0 + e];
      }
#pragma unroll
      for (int e = 0; e < 8; ++e) V[t_ * 64 + n0 + e] = vs[e];
    }
    __syncthreads();
    if (ch + 1 < 64) RW_PREFETCH(ch + 1)
    asm volatile("" ::: "memory");
#pragma unroll 4
    for (int t = 0; t < 32; ++t) {
      const float* base = R + t * 64 + kq * 8;
      const float4 r0 = *(const float4*)(base), r1 = *(const float4*)(base + 4);
      const float4 k0 = *(const float4*)(base + 2048), k1 = *(const float4*)(base + 2048 + 4);
      const float4 q0 = *(const float4*)(base + 4096), q1 = *(const float4*)(base + 4096 + 4);
      const float4 w0 = *(const float4*)(base + 6144), w1 = *(const float4*)(base + 6144 + 4);
      const float4 b0 = *(const float4*)(base + 8192), b1 = *(const float4*)(base + 8192 + 4);
      const float va = V[t * 64 + row0], vb = V[t * 64 + row1];
      const f32x2 rr[4] = {{r0.x, r0.y}, {r0.z, r0.w}, {r1.x, r1.y}, {r1.z, r1.w}};
      const f32x2 ww[4] = {{w0.x, w0.y}, {w0.z, w0.w}, {w1.x, w1.y}, {w1.z, w1.w}};
      const f32x2 kk_[4] = {{k0.x, k0.y}, {k0.z, k0.w}, {k1.x, k1.y}, {k1.z, k1.w}};
      const f32x2 qq[4] = {{q0.x, q0.y}, {q0.z, q0.w}, {q1.x, q1.y}, {q1.z, q1.w}};
      const f32x2 bb[4] = {{b0.x, b0.y}, {b0.z, b0.w}, {b1.x, b1.y}, {b1.z, b1.w}};
      f32x2 a0 = S0p[0] * qq[0], a1 = S1p[0] * qq[0];
#pragma unroll
      for (int e = 1; e < 4; ++e) { a0 += S0p[e] * qq[e]; a1 += S1p[e] * qq[e]; }
      const float sa0 = -red8_sum(a0.x + a0.y), sa1 = -red8_sum(a1.x + a1.y);
      f32x2 sa0v, sa1v, vav, vbv;
      sa0v.x = sa0; sa0v.y = sa0; sa1v.x = sa1; sa1v.y = sa1; vav.x = va; vav.y = va; vbv.x = vb; vbv.y = vb;
      f32x2 o0v = {0.f, 0.f}, o1v = {0.f, 0.f};
#pragma unroll
      for (int e = 0; e < 4; ++e) {
        S0p[e] = S0p[e] * ww[e] + sa0v * bb[e] + vav * kk_[e];
        S1p[e] = S1p[e] * ww[e] + sa1v * bb[e] + vbv * kk_[e];
        o0v += S0p[e] * rr[e]; o1v += S1p[e] * rr[e];
      }
      const float o0 = red8_sum(o0v.x + o0v.y), o1 = red8_sum(o1v.x + o1v.y);
      if (kq == 0) { O[t * 64 + row0] = o0; O[t * 64 + row1] = o1; }
    }
    asm volatile("s_waitcnt vmcnt(0)" ::: "memory");
    __syncthreads();
    {
      const size_t tok = tok0 + t_;
      float ov[8], s1 = 0.f, bon = 0.f;
#pragma unroll
      for (int e = 0; e < 8; ++e) {
        ov[e] = O[t_ * 64 + n0 + e]; s1 += ov[e];
        bon += R[t_ * 64 + n0 + e] * K[t_ * 64 + n0 + e] * rkc[e];
      }
      s1 = red8_sum(s1); bon = red8_sum(bon);
      const float mean = s1 * (1.f / 64.f);
      float s2 = 0.f;
#pragma unroll
      for (int e = 0; e < 8; ++e) { const float d = ov[e] - mean; s2 += d * d; }
      s2 = red8_sum(s2);
      const float rstd = rsqrtf(s2 * (1.f / 64.f) + 64e-5f);
      float y[8];
#pragma unroll
      for (int e = 0; e < 8; ++e)
        y[e] = ((ov[e] - mean) * rstd * gnw[e] + gnb[e] + bon * V[t_ * 64 + n0 + e]) * G[t_ * 64 + n0 + e];
      *(uint4*)(p.u + tok * US + 3072 + h * 64 + n0) = PACK8(y);
    }
  }
#undef RW_PREFETCH
  __syncthreads();
}

PHASE void phase_mix(const Params& p, int l, char* smem) {
  const int hf = vhalf();
  int* sitem = (int*)(smem - hf * SMEM_BYTES + SMEM_BYTES - 16);
  const int t512 = opaque_tid512();
  while (true) {
    __syncthreads();
    if (t512 == 0) *sitem = (int)atomicAdd(p.counters + l * 4 + 0, 1u);
    __syncthreads();
    const int tk = *sitem;
    if (tk >= 128) break;
    rwkv_item(p, l, tk * 2 + hf, smem);
  }
  while (true) {
    __syncthreads();
    if (t512 == 0) *sitem = (int)atomicAdd(p.counters + l * 4 + 1, 1u);
    __syncthreads();
    const int tk = *sitem;
    if (tk >= 64) break;
    hgrn_item(p, l, tk * 2 + hf, smem);
  }
  while (true) {
    __syncthreads();
    if (t512 == 0) *sitem = (int)atomicAdd(p.counters + l * 4 + 2, 1u);
    __syncthreads();
    const int tk = *sitem;
    if (tk >= 2048) break;
    att_item(p, l, tk * 2 + hf, smem);
  }
}

DEV void gemm_gates(const int tid_in, const bf16_t* A, const bf16_t* Wg, int tn, char* smem, unsigned (&Gp)[4][6][2]) {
  int tid = tid_in; asm volatile("" : "+v"(tid));
  bf16_t* As = (bf16_t*)smem;
  bf16_t* Bs = As + 3 * 4096;
  const int lane = tid & 63, wave = tid >> 6, wr = wave >> 1, wc = wave & 1;
  const int fr = lane & 15, fq = lane >> 4;
  f32x4 acc[4][6];
#pragma unroll
  for (int m = 0; m < 4; ++m)
#pragma unroll
    for (int n = 0; n < 6; ++n) acc[m][n] = (f32x4){0.f, 0.f, 0.f, 0.f};
  const int nk = DM >> 5;
  const int drow = tid >> 2, dphys = tid & 3, dg = (0 - (tid >> 4)) & 3;
  const int cofs = (dphys ^ dg) * 8;
  const unsigned aofs = (unsigned)(drow * DM + cofs);
  unsigned bofs0, bofs1, bofs2;
  {
    int r = drow; int wcb = r / 96, br = (r % 96) >> 5, c = (r % 96) & 31;
    bofs0 = (unsigned)((5376 + br * 1024 + tn * 64 + wcb * 32 + c) * DM + cofs);
    r = drow + 64; wcb = r / 96; br = (r % 96) >> 5; c = (r % 96) & 31;
    bofs1 = (unsigned)((5376 + br * 1024 + tn * 64 + wcb * 32 + c) * DM + cofs);
    r = drow + 128; wcb = r / 96; br = (r % 96) >> 5; c = (r % 96) & 31;
    bofs2 = (unsigned)((5376 + br * 1024 + tn * 64 + wcb * 32 + c) * DM + cofs);
  }
  const int rofs = (fq ^ ((0 - (fr >> 2)) & 3)) * 8;
#define GG_DMA(st, kk)                                                                                       \
  {                                                                                                          \
    __builtin_amdgcn_global_load_lds((const unsigned*)(A + aofs + (kk) * 32), (unsigned*)(As + (st) * 4096 + tid * 8), 16, 0, 0);                     \
    __builtin_amdgcn_global_load_lds((const unsigned*)(A + aofs + 64 * DM + (kk) * 32), (unsigned*)(As + (st) * 4096 + tid * 8 + 2048), 16, 0, 0); \
    __builtin_amdgcn_global_load_lds((const unsigned*)(Wg + bofs0 + (kk) * 32), (unsigned*)(Bs + (st) * 6144 + tid * 8), 16, 0, 0);                    \
    __builtin_amdgcn_global_load_lds((const unsigned*)(Wg + bofs1 + (kk) * 32), (unsigned*)(Bs + (st) * 6144 + tid * 8 + 2048), 16, 0, 0);             \
    __builtin_amdgcn_global_load_lds((const unsigned*)(Wg + bofs2 + (kk) * 32), (unsigned*)(Bs + (st) * 6144 + tid * 8 + 4096), 16, 0, 0);             \
  }
  GG_DMA(0, 0)
  GG_DMA(1, 1)
  int st = 0;
  for (int kt = 0; kt < nk; ++kt) {
    if (kt + 1 < nk) asm volatile("s_waitcnt vmcnt(5)" ::: "memory");
    else asm volatile("s_waitcnt vmcnt(0)" ::: "memory");
    __builtin_amdgcn_s_barrier();
    asm volatile("" ::: "memory");
    const int s2 = (st >= 1) ? st - 1 : 2;
    const bf16_t* Ab = As + st * 4096 + (wr * 64 + fr) * 32 + rofs;
    const bf16_t* Bb = Bs + st * 6144 + (wc * 96 + fr) * 32 + rofs;
    bf16x8 bfr[6], af[4];
#pragma unroll
    for (int n = 0; n < 6; ++n) bfr[n] = *(const bf16x8*)(Bb + n * 512);
#pragma unroll
    for (int m = 0; m < 4; ++m) af[m] = *(const bf16x8*)(Ab + m * 512);
    if (kt + 2 < nk) GG_DMA(s2, kt + 2)
#pragma unroll
    for (int m = 0; m < 4; ++m)
#pragma unroll
      for (int n = 0; n < 6; ++n) acc[m][n] = MFMA(af[m], bfr[n], acc[m][n]);
    st = (st == 2) ? 0 : st + 1;
  }
#undef GG_DMA
  __syncthreads();
#pragma unroll
  for (int m = 0; m < 4; ++m)
#pragma unroll
    for (int n = 0; n < 6; ++n) {
      Gp[m][n][0] = pack2(sigm(acc[m][n][0]), sigm(acc[m][n][1]));
      Gp[m][n][1] = pack2(sigm(acc[m][n][2]), sigm(acc[m][n][3]));
    }
}

PHASE void phase_merge(const Params& p, int l, char* smem) {
  const bf16_t* Wl = p.wt + (size_t)l * WLAYER;
  float* Cs = (float*)smem;
  const int tid = opaque_tid();
  for (int it = 0;; ++it) {
    int tm, tn;
    if (!tile_for(it, 512, 16, tm, tn)) break;
    const size_t row0 = (size_t)tm * 128;
    unsigned Gp[4][6][2];
    gemm_gates(tid, p.h + row0 * DM, Wl + WIN, tn, smem, Gp);
    f32x4 acc[4][2], M[4][2];
#pragma unroll
    for (int m = 0; m < 4; ++m)
#pragma unroll
      for (int n = 0; n < 2; ++n) M[m][n] = (f32x4){0.f, 0.f, 0.f, 0.f};
#pragma unroll
    for (int br = 0; br < 3; ++br) {
      const int aoff = (br == 0) ? 0 : (br == 1 ? 2560 : 3072);
      const size_t woff = (br == 0) ? WBA : (br == 1 ? WBB : WBC);
      gemm_tile<2>(tid, p.u + row0 * US + aoff, US, Wl + woff + (size_t)(tn * 64) * 512, 512, 512, smem, acc);
#pragma unroll
      for (int m = 0; m < 4; ++m)
#pragma unroll
        for (int n = 0; n < 2; ++n) {
          M[m][n][0] += lo16(Gp[m][2 * br + n][0]) * acc[m][n][0];
          M[m][n][1] += hi16(Gp[m][2 * br + n][0]) * acc[m][n][1];
          M[m][n][2] += lo16(Gp[m][2 * br + n][1]) * acc[m][n][2];
          M[m][n][3] += hi16(Gp[m][2 * br + n][1]) * acc[m][n][3];
        }
    }
    stage_acc<2>(tid, Cs, M);
    __syncthreads();
    {
      const int ch = tid & 7;
#pragma unroll 1
      for (int i = 0; i < 4; ++i) {
        const int r = (tid >> 3) + i * 32;
        const float4 a = *(const float4*)(Cs + r * 68 + ch * 8), b = *(const float4*)(Cs + r * 68 + ch * 8 + 4);
        *(uint4*)(p.u + (row0 + r) * US + 1024 + tn * 64 + ch * 8) = make_uint4(pack2(a.x, a.y), pack2(a.z, a.w), pack2(b.x, b.y), pack2(b.z, b.w));
      }
    }
    __syncthreads();
  }
}

PHASE void phase_gemm_res(const bf16_t* A, int lda, const bf16_t* Wt, int K, const float* xin, float* xout,
                        const float* ada_l, int gate_off, char* smem0) {
  const int T = opaque_tid512(), tid = T & 255, hf = vhalf();
  float* Cs = (float*)(smem0 + hf * SMEM_BYTES);
  for (int it = 0;; ++it) {
    int tm, tn;
    if (!tile_for_real(it, 256, 4, tm, tn)) break;
    const size_t row0 = (size_t)tm * 256;
    f32x4 acc[8][4];
    gemm_tile512(T, A + row0 * lda, lda, Wt + (size_t)(tn * 256) * K, K, K, smem0, acc);
    const float* gate = ada_l + (size_t)(row0 / SEQ) * ADAW + gate_off;
    const int c4 = (tid & 31) * 4;
#pragma unroll
    for (int ps = 0; ps < 2; ++ps) {
      if (ps == 0) stage_half512<0>(T, Cs, acc); else stage_half512<1>(T, Cs, acc);
      __syncthreads();
#pragma unroll 1
      for (int i = 0; i < 16; ++i) {
        const int r = (tid >> 5) + i * 8;
        const int colb = TNC(r) * 128 + c4;
        const float4 gv = *(const float4*)(gate + colb);
        const float4 cv = *(const float4*)(Cs + r * 132 + c4);
        const size_t off = GROW(r, ps) * DM + colb;
        const float4 xv = *(const float4*)(xin + off);
        *(float4*)(xout + off) = make_float4(xv.x + gv.x * cv.x, xv.y + gv.y * cv.y, xv.z + gv.z * cv.z, xv.w + gv.w * cv.w);
      }
      __syncthreads();
    }
  }
}

PHASE void phase_ffn_in(const Params& p, int l, char* smem0) {
  const bf16_t* Wt = p.wt + (size_t)l * WLAYER + WFI;
  const int T = opaque_tid512(), tid = T & 255, hf = vhalf();
  float* Cs = (float*)(smem0 + hf * SMEM_BYTES);
  for (int it = 0;; ++it) {
    int tm, tn;
    if (!tile_for_real(it, 256, 22, tm, tn)) break;
    const size_t row0 = (size_t)tm * 256;
    f32x4 acc[8][4];
    gemm_tile512(T, p.h + row0 * DM, DM, Wt + (size_t)(tn * 256) * DM, DM, DM, smem0, acc);
    const int ch = tid & 7;
#pragma unroll
    for (int ps = 0; ps < 2; ++ps) {
      if (ps == 0) stage_half512<0>(T, Cs, acc); else stage_half512<1>(T, Cs, acc);
      __syncthreads();
#pragma unroll 1
      for (int i = 0; i < 4; ++i) {
        const int r = (tid >> 3) + i * 32;
        const float* cp = Cs + r * 132 + ch * 8;
        float o[8];
#pragma unroll
        for (int e = 0; e < 8; ++e) { const float g = cp[e], uu = cp[64 + e]; o[e] = g * sigm(g) * uu; }
        *(uint4*)(p.u + GROW(r, ps) * FFH + TNC(r) * 64 + ch * 8) = PACK8(o);
      }
      __syncthreads();
    }
  }
}

#define XB_TMO      128
#define XB_XCNT(j)  (256  + 64 * (j))
#define XB_XSUB(j)  (1280 + 64 * (j))
#define XB_XGEN(j)  (2304 + 64 * (j))
#define XB_TOP      3328
#define XB_TOPGEN   3392
#define XCD_BAR_WORDS 3456
#define XB_SPIN_CAP (1u << 18)
#define LAS __attribute__((address_space(3)))
DEV unsigned xb_ld(unsigned* p) { return __hip_atomic_load(p, __ATOMIC_RELAXED, __HIP_MEMORY_SCOPE_AGENT); }
DEV unsigned xb_add(unsigned* p, unsigned v) { return __hip_atomic_fetch_add(p, v, __ATOMIC_RELAXED, __HIP_MEMORY_SCOPE_AGENT); }
DEV unsigned xb_xcc_id() { return (unsigned)__builtin_amdgcn_s_getreg((3 << 11) | 20) & 0xFu; }
#define XB_SPIN(cond, bar) do { unsigned _sp = 0; while (cond) { __builtin_amdgcn_s_sleep(1); \
    if ((++_sp & 255u) == 0u) { if (xb_ld(&(bar)[XB_TMO])) break; if (_sp > XB_SPIN_CAP) { atomicAdd(&(bar)[XB_TMO], 1u); break; } } } } while (0)
struct XcdBarrier { unsigned* bar; unsigned x; volatile LAS unsigned* st; };
DEV XcdBarrier xcd_barrier_post(unsigned* bar, volatile LAS unsigned* st) {
  XcdBarrier b; b.bar = bar; b.x = xb_xcc_id(); b.st = st;
  if (threadIdx.x == 0) (void)xb_add(&bar[XB_XCNT(b.x)], 1u);
  return b;
}
DEV void xcd_barrier_complete(unsigned* bar, unsigned x, unsigned& nloc, unsigned& nx) {
  const unsigned G = gridDim.x * gridDim.y * gridDim.z;
  unsigned sum, cnt, mine, sp = 0u;
  for (;;) {
    sum = 0u; cnt = 0u; mine = 0u;
#pragma unroll
    for (unsigned j = 0; j < 16; ++j) { const unsigned c = xb_ld(&bar[XB_XCNT(j)]); sum += c; cnt += (c > 0u) ? 1u : 0u; mine = (j == x) ? c : mine; }
    if (sum == G) break;
    __builtin_amdgcn_s_sleep(1);
    if ((++sp & 255u) == 0u) { if (xb_ld(&bar[XB_TMO])) break; if (sp > XB_SPIN_CAP) { atomicAdd(&bar[XB_TMO], 1u); break; } }
  }
  nloc = mine > 0u ? mine : 1u; nx = cnt > 0u ? cnt : 1u;
}
DEV void xcd_barrier(const XcdBarrier& b) {
  asm volatile("s_waitcnt vmcnt(0)" ::: "memory");
  __syncthreads();
  if (threadIdx.x == 0) {
    unsigned* bar = b.bar;
    __builtin_amdgcn_s_waitcnt(0);
    unsigned nloc = b.st[0], nx = b.st[1];
    if (nloc == 0u) { xcd_barrier_complete(bar, b.x, nloc, nx); b.st[0] = nloc; b.st[1] = nx; }
    const unsigned old = xb_add(&bar[XB_XSUB(b.x)], 1u);
    const unsigned gen = old / nloc;
    if (old + 1u == (gen + 1u) * nloc) {
      __builtin_amdgcn_fence(__ATOMIC_RELEASE, "agent");
      asm volatile("s_waitcnt vmcnt(0)" ::: "memory");
      const unsigned og = xb_add(&bar[XB_TOP], 1u);
      const unsigned tg = og / nx;
      if (og + 1u == (tg + 1u) * nx) xb_add(&bar[XB_TOPGEN], 1u);
      else XB_SPIN(xb_ld(&bar[XB_TOPGEN]) == tg, bar);
      __builtin_amdgcn_fence(__ATOMIC_ACQUIRE, "agent");
      xb_add(&bar[XB_XGEN(b.x)], 1u);
      asm volatile("s_waitcnt vmcnt(0)" ::: "memory");
    } else {
      XB_SPIN(xb_ld(&bar[XB_XGEN(b.x)]) == gen, bar);
      __builtin_amdgcn_fence(__ATOMIC_ACQUIRE, "agent");
      asm volatile("s_waitcnt vmcnt(0)" ::: "memory");
    }
  }
  __syncthreads();
}

__global__ void __launch_bounds__(512, 2) mega(Params p_in, int ph_lo, int ph_hi) {
  extern __shared__ __attribute__((aligned(16))) char smem0[];
  char* smem = smem0 + vhalf() * SMEM_BYTES;
  cg::grid_group grid = cg::this_grid();
  const Params& p = p_in;
  bool first = true;
#define RUN(ph) if ((ph) >= ph_lo && (ph) < ph_hi)
  unsigned epoch = 0;
  __shared__ unsigned xb_words[4];
  if (threadIdx.x < 4) xb_words[threadIdx.x] = 0u;
  __syncthreads();
  XcdBarrier xb;
  xb.bar = p.counters + 256; xb.x = 0u; xb.st = (volatile LAS unsigned*)xb_words;
#define SYNC { if (!first) { ++epoch; if (epoch == 1) { grid.sync(); xb = xcd_barrier_post(p.counters + 256, (volatile LAS unsigned*)xb_words); } else xcd_barrier(xb); } first = false; }
  RUN(0) { SYNC; phase_prep(p, smem); }
#pragma unroll 1
  for (int l = 0; l < 2; ++l) {
    const int base = 1 + 9 * l;
    const float* ada_l = p.ada + (size_t)l * 32 * ADAW;
    const bf16_t* Wl = p.wt + (size_t)l * WLAYER;
    const float* xin = (l == 0) ? p.x : p.out;
    RUN(base + 0) { SYNC; phase_norm(xin, p.norm_mix_w + l * DM, ada_l, 0, 1024, p.h); }
    RUN(base + 1) { SYNC; phase_gemm_in(p, l, smem0); }
    RUN(base + 2) { if (l > 0) { SYNC; phase_vlo(p, l, smem); } }
    RUN(base + 3) { SYNC; phase_mix(p, l, smem); }
    RUN(base + 4) { SYNC; phase_merge(p, l, smem); }
    RUN(base + 5) { SYNC; phase_gemm_res(p.u + 1024, US, Wl + WOUT, DM, xin, p.out, ada_l, 2048, smem0); }
    RUN(base + 6) { SYNC; phase_norm(p.out, p.norm_ffn_w + l * DM, ada_l, 3072, 4096, p.h); }
    RUN(base + 7) { SYNC; phase_ffn_in(p, l, smem0); }
    RUN(base + 8) { SYNC; phase_gemm_res(p.u, FFH, Wl + WFO, FFH, p.out, p.out, ada_l, 5120, smem0); }
  }
  RUN(NPHASE - 1) { SYNC; phase_final(p.out, p.final_norm_w); }
}

extern "C" void kernel_launch(void* const* d_in, const int* in_sizes, int n_in, void* d_out, int out_size, void* d_ws,
                              size_t ws_size, hipStream_t stream) {
  Params p{};
  p.x = (const float*)d_in[0]; p.c = (const float*)d_in[1]; p.pos = (const int*)d_in[2];
  p.ada_w = (const float*)d_in[3]; p.ada_b = (const float*)d_in[4]; p.norm_mix_w = (const float*)d_in[5];
  p.norm_ffn_w = (const float*)d_in[6]; p.w_in = (const float*)d_in[7]; p.da_lambda = (const float*)d_in[8];
  p.da_subln_w = (const float*)d_in[9]; p.hg_lb = (const float*)d_in[10]; p.hg_norm_w = (const float*)d_in[11];
  p.rw_mu = (const float*)d_in[12]; p.rw_w0 = (const float*)d_in[13]; p.rw_w2 = (const float*)d_in[14];
  p.rw_a0 = (const float*)d_in[15]; p.rw_a2 = (const float*)d_in[16]; p.rw_g2 = (const float*)d_in[17];
  p.rw_k_k = (const float*)d_in[18]; p.rw_k_a = (const float*)d_in[19]; p.rw_r_k = (const float*)d_in[20];
  p.rw_gn_w = (const float*)d_in[21]; p.rw_gn_b = (const float*)d_in[22]; p.rw_v0 = (const float*)d_in[23];
  p.rw_v1 = (const float*)d_in[24]; p.rw_v2 = (const float*)d_in[25]; p.w_br_a = (const float*)d_in[26];
  p.w_br_b = (const float*)d_in[27]; p.w_br_c = (const float*)d_in[28]; p.w_out = (const float*)d_in[29];
  p.ffn_w_in = (const float*)d_in[30]; p.ffn_w_out = (const float*)d_in[31]; p.final_norm_w = (const float*)d_in[32];
  p.out = (float*)d_out;
  char* ws = (char*)d_ws;
  size_t off = 0;
  auto take = [&](size_t bytes) { char* r = ws + off; off += (bytes + 255) & ~(size_t)255; return r; };
  p.counters = (unsigned*)take(16384);
  p.wt = (bf16_t*)take(2 * WLAYER * 2);
  p.ada = (float*)take((size_t)2 * 32 * ADAW * 4);
  p.h = (bf16_t*)take((size_t)T_TOK * DM * 2);
  p.u = (bf16_t*)take((size_t)T_TOK * US * 2);
  p.vT = (bf16_t*)take((size_t)T_TOK * 512 * 2);
  p.vfirst = (bf16_t*)take((size_t)T_TOK * 512 * 2);
  p.vlo = (float*)take((size_t)T_TOK * 32 * 4);
  if (off > ws_size) { fprintf(stderr, "workspace too small: need %zu have %zu\n", off, ws_size); return; }

  static int grid_blocks = 0;
  if (!grid_blocks) {
    hipFuncSetAttribute((const void*)mega, hipFuncAttributeMaxDynamicSharedMemorySize, 2 * SMEM_BYTES);
    int dev = 0, cus = 0, per_cu = 0;
    hipGetDevice(&dev);
    hipDeviceGetAttribute(&cus, hipDeviceAttributeMultiprocessorCount, dev);
    hipOccupancyMaxActiveBlocksPerMultiprocessor(&per_cu, mega, 512, 2 * SMEM_BYTES);
    if (per_cu > 1) per_cu = 1;
    if (per_cu < 1) per_cu = 1;
    grid_blocks = cus * per_cu;
  }
#if SINGLE_LAUNCH
  int lo = 0, hi = NPHASE;
  void* args[] = {&p, &lo, &hi};
  hipError_t e = hipLaunchCooperativeKernel((void*)mega, dim3(grid_blocks), dim3(512), args, 2 * SMEM_BYTES, stream);
  if (e != hipSuccess) fprintf(stderr, "cooperative launch failed: %s (grid %d)\n", hipGetErrorString(e), grid_blocks);
#else
  for (int ph = 0; ph < NPHASE; ++ph) {
    if (ph == 3) continue;
    hipLaunchKernelGGL(mega, dim3(grid_blocks), dim3(512), 2 * SMEM_BYTES, stream, p, ph, ph + 1);
  }
#endif
}
```

```cpp
#include <hip/hip_runtime.h>
#include <hip/hip_cooperative_groups.h>
#include <stdint.h>
#include <cstdio>
namespace cg = cooperative_groups;

typedef unsigned short bf16_t;
typedef short bf16x8 __attribute__((ext_vector_type(8)));
typedef float f32x4 __attribute__((ext_vector_type(4)));
typedef float f32x2 __attribute__((ext_vector_type(2)));
#define DEV __device__ __forceinline__
#define PHASE __device__ __forceinline__

#ifndef SINGLE_LAUNCH
#define SINGLE_LAUNCH 1
#endif

constexpr int T_TOK = 65536, DM = 1024, SEQ = 2048, US = 4864, ADAW = 6144, FFH = 2816;
constexpr size_t WIN = 0, WBA = 8650752, WBB = 9175040, WBC = 9699328, WOUT = 10223616, WFI = 11272192,
                 WFO = 17039360, WLAYER = 19922944;
constexpr int SMEM_BYTES = 80896;
constexpr int NPHASE = 20;

struct Params {
  const float* x; const float* c; const int* pos;
  const float *ada_w, *ada_b, *norm_mix_w, *norm_ffn_w, *w_in, *da_lambda, *da_subln_w, *hg_lb, *hg_norm_w;
  const float *rw_mu, *rw_w0, *rw_w2, *rw_a0, *rw_a2, *rw_g2, *rw_k_k, *rw_k_a, *rw_r_k, *rw_gn_w, *rw_gn_b;
  const float *rw_v0, *rw_v1, *rw_v2, *w_br_a, *w_br_b, *w_br_c, *w_out, *ffn_w_in, *ffn_w_out, *final_norm_w;
  float* out;
  bf16_t* wt; float* ada; bf16_t* h; bf16_t* u; bf16_t* vT; bf16_t* vfirst; float* vlo; unsigned* counters;
};

DEV unsigned short f2bf(float f) { unsigned u = __float_as_uint(f); u += 0x7FFFu + ((u >> 16) & 1u); return (unsigned short)(u >> 16); }
DEV float bf2f(unsigned short h) { return __uint_as_float(((unsigned)h) << 16); }
DEV unsigned pack2(float a, float b) { return (unsigned)f2bf(a) | ((unsigned)f2bf(b) << 16); }
DEV float sigm(float x) { return 1.f / (1.f + __expf(-x)); }
DEV float lo16(unsigned v) { return __uint_as_float(v << 16); }
DEV float hi16(unsigned v) { return __uint_as_float(v & 0xFFFF0000u); }
#define UNPACK8(v, f) { f[0]=lo16(v.x); f[1]=hi16(v.x); f[2]=lo16(v.y); f[3]=hi16(v.y); f[4]=lo16(v.z); f[5]=hi16(v.z); f[6]=lo16(v.w); f[7]=hi16(v.w); }
#define PACK8(f) make_uint4(pack2(f[0],f[1]), pack2(f[2],f[3]), pack2(f[4],f[5]), pack2(f[6],f[7]))
template <int CTRL> DEV float dpp(float x) { return __int_as_float(__builtin_amdgcn_update_dpp(0, __float_as_int(x), CTRL, 0xF, 0xF, true)); }
DEV float red8_sum(float x) { x += dpp<0xB1>(x); x += dpp<0x4E>(x); x += dpp<0x141>(x); return x; }
DEV float red16_sum(float x) { x = red8_sum(x); x += dpp<0x140>(x); return x; }
DEV float red16_max(float x) { x = fmaxf(x, dpp<0xB1>(x)); x = fmaxf(x, dpp<0x4E>(x)); x = fmaxf(x, dpp<0x141>(x)); x = fmaxf(x, dpp<0x140>(x)); return x; }
DEV float wave_sum(float x) {
  x = red16_sum(x);
  const int xi = __float_as_int(x);
  return __int_as_float(__builtin_amdgcn_readlane(xi, 0)) + __int_as_float(__builtin_amdgcn_readlane(xi, 16)) +
         __int_as_float(__builtin_amdgcn_readlane(xi, 32)) + __int_as_float(__builtin_amdgcn_readlane(xi, 48));
}
DEV int opaque_tid() { int t = threadIdx.x & 255; asm volatile("" : "+v"(t)); return t; }
DEV int opaque_tid512() { int t = threadIdx.x; asm volatile("" : "+v"(t)); return t; }
DEV int vhalf() { return __builtin_amdgcn_readfirstlane((int)(threadIdx.x >> 8)); }
DEV int vblock() { return (int)blockIdx.x * 2 + vhalf(); }
DEV int vgrid() { return (int)gridDim.x * 2; }
DEV bf16x8 as_frag(uint4 v) { union { uint4 u; bf16x8 b; } c; c.u = v; return c.b; }
#define MFMA(a, b, c) __builtin_amdgcn_mfma_f32_16x16x32_bf16(a, b, c, 0, 0, 0)

template <int NT>
DEV void gemm_tile(const int tid_in, const bf16_t* A, int lda, const bf16_t* B, int ldb, int K, char* smem,
                   f32x4 (&acc)[4][NT]) {
  int tid = tid_in; asm volatile("" : "+v"(tid));
  constexpr int BN = NT * 32;
  constexpr int LS = 64;
  bf16_t* As = (bf16_t*)smem;
  bf16_t* Bs = As + 2 * 128 * LS;
  const int lane = tid & 63, wave = tid >> 6, wr = wave >> 1, wc = wave & 1;
  const int fr = lane & 15, fq = lane >> 4;
  constexpr int NB = BN * 8 / 256;
#pragma unroll
  for (int m = 0; m < 4; ++m)
#pragma unroll
    for (int n = 0; n < NT; ++n) acc[m][n] = (f32x4){0.f, 0.f, 0.f, 0.f};
  const int nk = K >> 6;
  const int lrow = tid >> 3, lcc = tid & 7;
  const bf16_t* Ap = A + (size_t)lrow * lda + ((lcc ^ (lrow & 7)) * 8);
  const bf16_t* Bp = B + (size_t)lrow * ldb + ((lcc ^ (lrow & 7)) * 8);
  const size_t a32 = (size_t)32 * lda, b32 = (size_t)32 * ldb;
  const int rofs0 = (fq ^ (fr & 7)) * 8, rofs1 = rofs0 ^ 32;
#define GT_DMA(buf, koff)                                                                                    \
  {                                                                                                          \
    bf16_t* Ad = As + (buf) * 128 * LS + tid * 8;                                                            \
    bf16_t* Bd = Bs + (buf) * BN * LS + tid * 8;                                                             \
    _Pragma("unroll") for (int i = 0; i < 4; ++i)                                                            \
      __builtin_amdgcn_global_load_lds((const unsigned*)(Ap + i * a32 + (koff)), (unsigned*)(Ad + i * 32 * LS), 16, 0, 0); \
    _Pragma("unroll") for (int i = 0; i < NB; ++i)                                                           \
      __builtin_amdgcn_global_load_lds((const unsigned*)(Bp + i * b32 + (koff)), (unsigned*)(Bd + i * 32 * LS), 16, 0, 0); \
  }
  GT_DMA(0, 0)
  asm volatile("s_waitcnt vmcnt(0)" ::: "memory");
  __syncthreads();
  for (int kt = 0; kt < nk; ++kt) {
    const int buf = kt & 1;
    if (kt + 1 < nk) GT_DMA(buf ^ 1, (kt + 1) * 64)
    const bf16_t* Ab = As + buf * 128 * LS + (wr * 64 + fr) * LS;
    const bf16_t* Bb = Bs + buf * BN * LS + (wc * (NT * 16) + fr) * LS;
#pragma unroll
    for (int ks = 0; ks < 2; ++ks) {
      const int ro = ks ? rofs1 : rofs0;
      bf16x8 af[4], bfr[NT];
#pragma unroll
      for (int m = 0; m < 4; ++m) af[m] = *(const bf16x8*)(Ab + m * 16 * LS + ro);
#pragma unroll
      for (int n = 0; n < NT; ++n) bfr[n] = *(const bf16x8*)(Bb + n * 16 * LS + ro);
#pragma unroll
      for (int m = 0; m < 4; ++m)
#pragma unroll
        for (int n = 0; n < NT; ++n) acc[m][n] = MFMA(af[m], bfr[n], acc[m][n]);
    }
    asm volatile("s_waitcnt vmcnt(0)" ::: "memory");
    __syncthreads();
  }
#undef GT_DMA
}

template <int NT>
DEV void stage_acc(const int tid, float* Cs, const f32x4 (&acc)[4][NT]) {
  constexpr int LDC = NT * 32 + 4;
  const int lane = tid & 63, wave = tid >> 6, wr = wave >> 1, wc = wave & 1, fr = lane & 15, fq = lane >> 4;
#pragma unroll
  for (int m = 0; m < 4; ++m)
#pragma unroll
    for (int n = 0; n < NT; ++n)
#pragma unroll
      for (int j = 0; j < 4; ++j) Cs[(wr * 64 + m * 16 + fq * 4 + j) * LDC + wc * (NT * 16) + n * 16 + fr] = acc[m][n][j];
}

DEV void gemm_tile256(const int tid, const bf16_t* A, int lda, const bf16_t* B, int ldb, int K, char* smem,
                      f32x4 (&acc)[8][4]) {
  bf16_t* As = (bf16_t*)smem;
  bf16_t* Bs = As + 3 * 8192;
  const int lane = tid & 63, wave = tid >> 6, wr = wave >> 1, wc = wave & 1;
  const int fr = lane & 15, fq = lane >> 4;
#pragma unroll
  for (int m = 0; m < 8; ++m)
#pragma unroll
    for (int n = 0; n < 4; ++n) acc[m][n] = (f32x4){0.f, 0.f, 0.f, 0.f};
  const int nk = K >> 5;
  const int drow = tid >> 2, dphys = tid & 3, dg = (0 - (tid >> 4)) & 3;
  const bf16_t* Ap = A + (size_t)drow * lda + ((dphys ^ dg) * 8);
  const bf16_t* Bp = B + (size_t)drow * ldb + ((dphys ^ dg) * 8);
  const size_t a64 = (size_t)64 * lda, b64 = (size_t)64 * ldb;
  const int rofs = (fq ^ ((0 - (fr >> 2)) & 3)) * 8;
#define G2_DMA(st, kk)                                                                                        \
  {                                                                                                           \
    bf16_t* Ad = As + (st) * 8192 + tid * 8;                                                                  \
    bf16_t* Bd = Bs + (st) * 4096 + tid * 8;                                                                  \
    _Pragma("unroll") for (int i = 0; i < 4; ++i)                                                             \
      __builtin_amdgcn_global_load_lds((const unsigned*)(Ap + i * a64 + (kk) * 32), (unsigned*)(Ad + i * 2048), 16, 0, 0); \
    _Pragma("unroll") for (int i = 0; i < 2; ++i)                                                             \
      __builtin_amdgcn_global_load_lds((const unsigned*)(Bp + i * b64 + (kk) * 32), (unsigned*)(Bd + i * 2048), 16, 0, 0); \
  }
  G2_DMA(0, 0)
  G2_DMA(1, 1)
  int st = 0;
  for (int kt = 0; kt < nk; ++kt) {
    if (kt + 1 < nk) asm volatile("s_waitcnt vmcnt(6)" ::: "memory");
    else asm volatile("s_waitcnt vmcnt(0)" ::: "memory");
    __builtin_amdgcn_s_barrier();
    asm volatile("" ::: "memory");
    const int s2 = (st >= 1) ? st - 1 : 2;
    const bool pf = (kt + 2 < nk);
    bf16_t* Ad = As + s2 * 8192 + tid * 8;
    bf16_t* Bd = Bs + s2 * 4096 + tid * 8;
    const bf16_t* Asrc = Ap + (kt + 2) * 32;
    const bf16_t* Bsrc = Bp + (kt + 2) * 32;
    const bf16_t* Ab = As + st * 8192 + (wr * 128 + fr) * 32 + rofs;
    const bf16_t* Bb = Bs + st * 4096 + (wc * 64 + fr) * 32 + rofs;
    bf16x8 bfr[4], af[4];
#pragma unroll
    for (int n = 0; n < 4; ++n) bfr[n] = *(const bf16x8*)(Bb + n * 512);
#pragma unroll
    for (int m = 0; m < 4; ++m) af[m] = *(const bf16x8*)(Ab + m * 512);
#pragma unroll
    for (int m = 0; m < 8; ++m) {
#pragma unroll
      for (int n = 0; n < 4; ++n) acc[m][n] = MFMA(af[m & 3], bfr[n], acc[m][n]);
      if (m + 4 < 8) af[m & 3] = *(const bf16x8*)(Ab + (m + 4) * 512);
      if (pf) {
        if (m < 4) __builtin_amdgcn_global_load_lds((const unsigned*)(Asrc + m * a64), (unsigned*)(Ad + m * 2048), 16, 0, 0);
        else if (m < 6) __builtin_amdgcn_global_load_lds((const unsigned*)(Bsrc + (m - 4) * b64), (unsigned*)(Bd + (m - 4) * 2048), 16, 0, 0);
      }
      __builtin_amdgcn_sched_barrier(0);
    }
    st = (st == 2) ? 0 : st + 1;
  }
#undef G2_DMA
  __syncthreads();
}

template <int PS>
DEV void stage_half(const int tid, float* Cs, const f32x4 (&acc)[8][4]) {
  const int lane = tid & 63, wave = tid >> 6, wr = wave >> 1, wc = wave & 1, fr = lane & 15, fq = lane >> 4;
#pragma unroll
  for (int m = 0; m < 4; ++m)
#pragma unroll
    for (int n = 0; n < 4; ++n)
#pragma unroll
      for (int j = 0; j < 4; ++j) Cs[(wr * 64 + m * 16 + fq * 4 + j) * 132 + wc * 64 + n * 16 + fr] = acc[PS * 4 + m][n][j];
}
#define RMAP(r, ps) ((((r) >> 6) << 7) + (ps) * 64 + ((r) & 63))

DEV void gemm_tile512(const int T, const bf16_t* A, int lda, const bf16_t* B, int ldb, int K, char* smem0,
                      f32x4 (&acc)[8][4]) {
  bf16_t* As = (bf16_t*)smem0;
  bf16_t* Bs = As + 2 * 16384;
  const int lane = T & 63, wave = T >> 6, wr = wave >> 2, wc = wave & 3;
  const int fr = lane & 15, fq = lane >> 4;
#pragma unroll
  for (int m = 0; m < 8; ++m)
#pragma unroll
    for (int n = 0; n < 4; ++n) acc[m][n] = (f32x4){0.f, 0.f, 0.f, 0.f};
  const int nk = K >> 6;
  const int drow = T >> 3, dlog = ((T & 7) ^ ((T >> 3) & 7)) * 8;
  const bf16_t* Ap = A + (size_t)drow * lda + dlog;
  const bf16_t* Bp = B + (size_t)drow * ldb + dlog;
  const size_t a64 = (size_t)64 * lda, b64 = (size_t)64 * ldb;
  const int rofs0 = (fq ^ (fr & 7)) * 8, rofs1 = rofs0 ^ 32;
#pragma unroll
  for (int i = 0; i < 4; ++i) {
    __builtin_amdgcn_global_load_lds((const unsigned*)(Ap + i * a64), (unsigned*)(As + T * 8 + i * 4096), 16, 0, 0);
    __builtin_amdgcn_global_load_lds((const unsigned*)(Bp + i * b64), (unsigned*)(Bs + T * 8 + i * 4096), 16, 0, 0);
  }
  asm volatile("s_waitcnt vmcnt(0)" ::: "memory");
  __syncthreads();
  for (int kt = 0; kt < nk; ++kt) {
    const int buf = kt & 1;
    const bool pf = (kt + 1 < nk);
    bf16_t* Ad = As + (buf ^ 1) * 16384 + T * 8;
    bf16_t* Bd = Bs + (buf ^ 1) * 16384 + T * 8;
    const bf16_t* Asrc = Ap + (kt + 1) * 64;
    const bf16_t* Bsrc = Bp + (kt + 1) * 64;
    const bf16_t* Ab = As + buf * 16384 + (wr * 128 + fr) * 64;
    const bf16_t* Bb = Bs + buf * 16384 + (wc * 64 + fr) * 64;
#pragma unroll
    for (int ks = 0; ks < 2; ++ks) {
      const int ro = ks ? rofs1 : rofs0;
      bf16x8 bfr[4], af[4];
#pragma unroll
      for (int n = 0; n < 4; ++n) bfr[n] = *(const bf16x8*)(Bb + n * 1024 + ro);
#pragma unroll
      for (int m = 0; m < 4; ++m) af[m] = *(const bf16x8*)(Ab + m * 1024 + ro);
#pragma unroll
      for (int m = 0; m < 8; ++m) {
#pragma unroll
        for (int n = 0; n < 4; ++n) acc[m][n] = MFMA(af[m & 3], bfr[n], acc[m][n]);
        if (m + 4 < 8) af[m & 3] = *(const bf16x8*)(Ab + (m + 4) * 1024 + ro);
        if (pf && (m & 1)) {
          const int piece = ks * 4 + (m >> 1);
          if (piece < 4) __builtin_amdgcn_global_load_lds((const unsigned*)(Asrc + piece * a64), (unsigned*)(Ad + piece * 4096), 16, 0, 0);
          else __builtin_amdgcn_global_load_lds((const unsigned*)(Bsrc + (piece - 4) * b64), (unsigned*)(Bd + (piece - 4) * 4096), 16, 0, 0);
        }
        __builtin_amdgcn_sched_barrier(0);
      }
    }
    asm volatile("s_waitcnt vmcnt(0)" ::: "memory");
    __builtin_amdgcn_s_barrier();
    asm volatile("" ::: "memory");
  }
  __syncthreads();
}
template <int PS>
DEV void stage_half512(const int T, float* Cs, const f32x4 (&acc)[8][4]) {
  const int lane = T & 63, wave = T >> 6, wc = wave & 3, fr = lane & 15, fq = lane >> 4;
#pragma unroll
  for (int m = 0; m < 4; ++m)
#pragma unroll
    for (int n = 0; n < 4; ++n)
#pragma unroll
      for (int j = 0; j < 4; ++j) Cs[((wc >> 1) * 64 + m * 16 + fq * 4 + j) * 132 + (wc & 1) * 64 + n * 16 + fr] = acc[PS * 4 + m][n][j];
}
#define GROW(r, ps) (row0 + (size_t)(hf * 128 + (ps) * 64 + ((r) & 63)))
#define TNC(r) (tn * 2 + ((r) >> 6))

DEV bool tile_for(int it, int nM, int nN, int& tm, int& tn) {
  const int nx = (gridDim.x >> 3) * 2;
  const int xcd = blockIdx.x & 7, local = (blockIdx.x >> 3) * 2 + vhalf();
  const long id = ((long)it * 8 + xcd) * nx + local;
  if (local >= nx || id >= (long)nM * nN) return false;
  const int per_group = 8 * nN;
  const int g = (int)(id / per_group), r = (int)(id % per_group);
  tn = r >> 3; tm = g * 8 + (r & 7);
  return true;
}

DEV bool tile_for_real(int it, int nM, int nN, int& tm, int& tn) {
  const int nx = (gridDim.x >> 3);
  const int xcd = blockIdx.x & 7, local = (blockIdx.x >> 3);
  const long id = ((long)it * 8 + xcd) * nx + local;
  if (local >= nx || id >= (long)nM * nN) return false;
  const int per_group = 8 * nN;
  const int g = (int)(id / per_group), r = (int)(id % per_group);
  tn = r >> 3; tm = g * 8 + (r & 7);
  return true;
}

PHASE void phase_prep(const Params& p, char* smem) {
  const int tid = opaque_tid();
  const int vb = vblock(), vg = vgrid();
  if (vb == 0 && tid < 8) p.counters[tid] = 0u;
  if (vb == 0) for (int i = tid; i < 3456; i += 256) p.counters[256 + i] = 0u;
  float* tile = (float*)smem;
  const int NCONV = 2 * 4864, NADA = 192;
  for (int item0 = vb; item0 < NCONV + NADA; item0 += vg) {
    const int item = (item0 < NADA) ? (NCONV + item0) : (item0 - NADA);
    if (item < NCONV) {
      const int l = item / 4864; int r = item % 4864;
      const float* src; int K, Nsrc, nT, perm = 0; size_t dst;
      if (r < 2112) { src = p.w_in + (size_t)l * 1024 * 8448; K = 1024; Nsrc = 8448; dst = WIN; nT = 132; }
      else if (r < 2240) { r -= 2112; src = p.w_br_a + (size_t)l * 512 * 1024; K = 512; Nsrc = 1024; dst = WBA; nT = 16; }
      else if (r < 2368) { r -= 2240; src = p.w_br_b + (size_t)l * 512 * 1024; K = 512; Nsrc = 1024; dst = WBB; nT = 16; }
      else if (r < 2496) { r -= 2368; src = p.w_br_c + (size_t)l * 512 * 1024; K = 512; Nsrc = 1024; dst = WBC; nT = 16; }
      else if (r < 2752) { r -= 2496; src = p.w_out + (size_t)l * 1024 * 1024; K = 1024; Nsrc = 1024; dst = WOUT; nT = 16; }
      else if (r < 4160) { r -= 2752; src = p.ffn_w_in + (size_t)l * 1024 * 5632; K = 1024; Nsrc = 5632; dst = WFI; nT = 88; perm = 1; }
      else { r -= 4160; src = p.ffn_w_out + (size_t)l * 2816 * 1024; K = 2816; Nsrc = 1024; dst = WFO; nT = 16; }
      const int kt = r / nT, nt = r % nT;
      const int colbase = perm ? ((nt & 1) * FFH + 64 * (nt >> 1)) : nt * 64;
      __syncthreads();
#pragma unroll
      for (int i = 0; i < 16; ++i) {
        const int k = i * 4 + (tid >> 6), j = tid & 63;
        tile[k * 65 + j] = src[(size_t)(kt * 64 + k) * Nsrc + colbase + j];
      }
      __syncthreads();
      const int row = tid >> 2, kc = (tid & 3) * 16;
      float f[16];
#pragma unroll
      for (int i = 0; i < 16; ++i) f[i] = tile[(kc + i) * 65 + row];
      bf16_t* d = p.wt + (size_t)l * WLAYER + dst + (size_t)(nt * 64 + row) * K + kt * 64 + kc;
      *(uint4*)d = make_uint4(pack2(f[0], f[1]), pack2(f[2], f[3]), pack2(f[4], f[5]), pack2(f[6], f[7]));
      *(uint4*)(d + 8) = make_uint4(pack2(f[8], f[9]), pack2(f[10], f[11]), pack2(f[12], f[13]), pack2(f[14], f[15]));
    } else {
      const int a = item - NCONV;
      const int l = a / 96, r = a % 96, ntile = r >> 2, bg = r & 3;
      float* cact = (float*)smem;
      __syncthreads();
      for (int i = tid; i < 8 * 1024; i += 256) {
        const float cv = p.c[(size_t)(bg * 8 + (i >> 10)) * DM + (i & 1023)];
        cact[i] = cv * sigm(cv);
      }
      __syncthreads();
      const int n = ntile * 256 + tid;
      const float* W = p.ada_w + (size_t)l * DM * ADAW + n;
      float acc[8];
#pragma unroll
      for (int b = 0; b < 8; ++b) acc[b] = 0.f;
      for (int k0 = 0; k0 < DM; k0 += 16) {
        float w[16];
#pragma unroll
        for (int kk = 0; kk < 16; ++kk) w[kk] = W[(size_t)(k0 + kk) * ADAW];
#pragma unroll
        for (int kk = 0; kk < 16; ++kk)
#pragma unroll
          for (int b = 0; b < 8; ++b) acc[b] += cact[b * 1024 + k0 + kk] * w[kk];
      }
      const float bias = p.ada_b[l * ADAW + n];
#pragma unroll
      for (int b = 0; b < 8; ++b) p.ada[((size_t)l * 32 + bg * 8 + b) * ADAW + n] = acc[b] + bias;
    }
  }
}

PHASE void phase_norm(const float* __restrict__ x, const float* __restrict__ w, const float* __restrict__ ada_l,
                    int shift_off, int scale_off, bf16_t* __restrict__ h) {
  const int tid = opaque_tid();
  const int lane = tid & 63, wave = tid >> 6;
  for (int row = vblock() * 4 + wave; row < T_TOK; row += vgrid() * 4) {
    const float* xr = x + (size_t)row * DM;
    float4 v[4]; float ss = 0.f;
#pragma unroll
    for (int i = 0; i < 4; ++i) { v[i] = *(const float4*)(xr + i * 256 + lane * 4); ss += v[i].x * v[i].x + v[i].y * v[i].y + v[i].z * v[i].z + v[i].w * v[i].w; }
    ss = wave_sum(ss);
    const float rstd = rsqrtf(ss * (1.f / DM) + 1e-6f);
    const float* ad = ada_l + (size_t)(row / SEQ) * ADAW;
#pragma unroll
    for (int i = 0; i < 4; ++i) {
      const int col = i * 256 + lane * 4;
      const float4 ww = *(const float4*)(w + col), sc = *(const float4*)(ad + scale_off + col), sh = *(const float4*)(ad + shift_off + col);
      const float o0 = v[i].x * rstd * ww.x * (1.f + sc.x) + sh.x, o1 = v[i].y * rstd * ww.y * (1.f + sc.y) + sh.y;
      const float o2 = v[i].z * rstd * ww.z * (1.f + sc.z) + sh.z, o3 = v[i].w * rstd * ww.w * (1.f + sc.w) + sh.w;
      *(uint2*)(h + (size_t)row * DM + col) = make_uint2(pack2(o0, o1), pack2(o2, o3));
    }
  }
}

PHASE void phase_final(float* __restrict__ x, const float* __restrict__ w) {
  const int tid = opaque_tid();
  const int lane = tid & 63, wave = tid >> 6;
  for (int row = vblock() * 4 + wave; row < T_TOK; row += vgrid() * 4) {
    float* xr = x + (size_t)row * DM;
    float4 v[4]; float ss = 0.f;
#pragma unroll
    for (int i = 0; i < 4; ++i) { v[i] = *(const float4*)(xr + i * 256 + lane * 4); ss += v[i].x * v[i].x + v[i].y * v[i].y + v[i].z * v[i].z + v[i].w * v[i].w; }
    ss = wave_sum(ss);
    const float rstd = rsqrtf(ss * (1.f / DM) + 1e-6f);
#pragma unroll
    for (int i = 0; i < 4; ++i) {
      const int col = i * 256 + lane * 4;
      const float4 ww = *(const float4*)(w + col);
      *(float4*)(xr + col) = make_float4(v[i].x * rstd * ww.x, v[i].y * rstd * ww.y, v[i].z * rstd * ww.z, v[i].w * rstd * ww.w);
    }
  }
}

PHASE void phase_gemm_in(const Params& p, int l, char* smem0) {
  const bf16_t* Wt = p.wt + (size_t)l * WLAYER + WIN;
  const int T = opaque_tid512(), tid = T & 255, hf = vhalf();
  float* Cs = (float*)(smem0 + hf * SMEM_BYTES);
  for (int it = 0;; ++it) {
    int tm, tn;
    if (!tile_for_real(it, 256, 21, tm, tn)) break;
    f32x4 acc[8][4];
    gemm_tile512(T, p.h + (size_t)tm * 256 * DM, DM, Wt + (size_t)tn * 256 * DM, DM, DM, smem0, acc);
    const size_t row0 = (size_t)tm * 256;
#pragma unroll
    for (int ps = 0; ps < 2; ++ps) {
      if (ps == 0) stage_half512<0>(T, Cs, acc); else stage_half512<1>(T, Cs, acc);
      __syncthreads();
      if (tn < 4) {
        const float qs = (tn < 2) ? 0.125f : 1.f;
        const int ch = tid & 15, g = ch >> 3, cc = ch & 7;
        if (cc < 4) {
#pragma unroll 1
          for (int i = 0; i < 8; ++i) {
            const int r = (tid >> 4) + i * 16;
            const size_t grow = GROW(r, ps);
            const float pos = (float)p.pos[grow];
            const float* c1 = Cs + r * 132 + g * 64 + cc * 8;
            float o1[8], o2[8];
#pragma unroll
            for (int e = 0; e < 8; ++e) {
              const float x1 = c1[e], x2 = c1[32 + e];
              const float inv = exp2f(-(float)(cc * 8 + e) * 0.41524101186092029f);
              float rev = pos * inv * 0.15915494309189535f;
              rev -= rintf(rev);
              const float sn = __builtin_amdgcn_sinf(rev), cs = __builtin_amdgcn_cosf(rev);
              o1[e] = (x1 * cs - x2 * sn) * qs; o2[e] = (x2 * cs + x1 * sn) * qs;
            }
            bf16_t* d = p.u + grow * US + TNC(r) * 128 + g * 64 + cc * 8;
            *(uint4*)d = PACK8(o1);
            *(uint4*)(d + 32) = PACK8(o2);
          }
        }
      } else if (tn < 6) {
        const int b = (int)(row0 / SEQ), s0 = (int)(row0 % SEQ);
        const int rch = tid & 15;
        const int vc0 = (TNC(rch * 8) - 8) * 128;
#pragma unroll 1
        for (int i = 0; i < 8; ++i) {
          const int c = (tid >> 4) + i * 16;
          float f[8];
#pragma unroll
          for (int j = 0; j < 8; ++j) f[j] = Cs[(rch * 8 + j) * 132 + c];
          *(uint4*)(p.vT + ((size_t)b * 512 + vc0 + c) * SEQ + s0 + hf * 128 + ps * 64 + ((rch * 8) & 63)) = PACK8(f);
        }
      } else {
        const int ch = tid & 15;
#pragma unroll 1
        for (int i = 0; i < 8; ++i) {
          const int r = (tid >> 4) + i * 16;
          const float4 a = *(const float4*)(Cs + r * 132 + ch * 8), b = *(const float4*)(Cs + r * 132 + ch * 8 + 4);
          *(uint4*)(p.u + GROW(r, ps) * US + TNC(r) * 128 - 512 + ch * 8) = make_uint4(pack2(a.x, a.y), pack2(a.z, a.w), pack2(b.x, b.y), pack2(b.z, b.w));
        }
      }
      __syncthreads();
    }
  }
}

PHASE void phase_vlo(const Params& p, int l, char* smem) {
  float* vs = (float*)smem;
  const int tid = opaque_tid();
  const float* mu = p.rw_mu + (size_t)l * 1792 + 1024;
  const float* v1 = p.rw_v1;
  for (int item = vblock(); item < T_TOK / 32; item += vgrid()) {
    const size_t tok0 = (size_t)item * 32;
    __syncthreads();
#pragma unroll 1
    for (int i = 0; i < 8; ++i) {
      const int c = tid + i * 256;
      const int t = c >> 6, cc = c & 63;
      const size_t tok = tok0 + t;
      const uint4 cur = *(const uint4*)(p.u + tok * US + 3072 + 1024 + cc * 8);
      uint4 prv = make_uint4(0, 0, 0, 0);
      if ((tok % SEQ) != 0) prv = *(const uint4*)(p.u + (tok - 1) * US + 3072 + 1024 + cc * 8);
      float a[8], b[8];
      UNPACK8(cur, a); UNPACK8(prv, b);
#pragma unroll
      for (int e = 0; e < 8; ++e) vs[t * 512 + cc * 8 + e] = a[e] + (b[e] - a[e]) * mu[cc * 8 + e];
    }
    __syncthreads();
    const int j = tid & 31, tg = tid >> 5;
    float acc[4] = {0.f, 0.f, 0.f, 0.f};
    for (int k0 = 0; k0 < 512; k0 += 16) {
      float w[16];
#pragma unroll
      for (int kk = 0; kk < 16; ++kk) w[kk] = v1[(k0 + kk) * 32 + j];
#pragma unroll
      for (int kk = 0; kk < 16; ++kk)
#pragma unroll
        for (int i = 0; i < 4; ++i) acc[i] += vs[(tg * 4 + i) * 512 + k0 + kk] * w[kk];
    }
#pragma unroll
    for (int i = 0; i < 4; ++i) p.vlo[(tok0 + tg * 4 + i) * 32 + j] = acc[i];
  }
}

PHASE void att_item(const Params& p, int l, int item, char* smem) {
  const int qc = 31 - (item >> 7);
  const int bh = item & 127, b = bh >> 2, h = bh & 3;
  const int tid = opaque_tid(), lane = tid & 63, wave = tid >> 6, fr = lane & 15, fq = lane >> 4;
  const int m = wave >> 1, rh = wave & 1;
  bf16_t* Ks = (bf16_t*)smem;
  bf16_t* Vt = Ks + 2 * 64 * 64;
  bf16_t* Ps = Vt + 128 * 64;
  float* Ox = (float*)smem;
  const size_t tok0 = (size_t)b * SEQ + (size_t)qc * 64;
  const float* lv = p.da_lambda + (size_t)l * 256;
  float d1 = 0.f, d2 = 0.f;
  for (int i = 0; i < 64; ++i) { d1 += lv[i] * lv[64 + i]; d2 += lv[128 + i] * lv[192 + i]; }
  const float lam_init = 0.8f - 0.6f * __expf(-0.3f * (float)l);
  const float lam = __expf(d1) - __expf(d2) + lam_init;

  bf16x8 qf[2][2];
#pragma unroll
  for (int mt = 0; mt < 2; ++mt)
#pragma unroll
    for (int ks = 0; ks < 2; ++ks)
      qf[mt][ks] = *(const bf16x8*)(p.u + (tok0 + rh * 32 + mt * 16 + fr) * US + h * 128 + m * 64 + ks * 32 + fq * 8);
  f32x4 o[2][8];
  float mx[2][4], ls[2][4];
#pragma unroll
  for (int mt = 0; mt < 2; ++mt) {
#pragma unroll
    for (int n = 0; n < 8; ++n) o[mt][n] = (f32x4){0.f, 0.f, 0.f, 0.f};
#pragma unroll
    for (int j = 0; j < 4; ++j) { mx[mt][j] = -1e30f; ls[mt][j] = 0.f; }
  }
  bf16_t* Pw = Ps + wave * 32 * 72;
  const int drow = tid >> 3, dlog = ((tid & 7) ^ ((tid >> 3) & 7)) * 8;
  const bf16_t* Kg = p.u + ((size_t)b * SEQ + (drow & 63)) * US + 512 + h * 128 + dlog;
  const bf16_t* Vg = p.vT + ((size_t)b * 512 + h * 128 + drow) * SEQ + dlog;
  const int rsw = fr & 7;
#define ATT_DMA_K(kt_)                                                                                              \
  _Pragma("unroll") for (int i = 0; i < 4; ++i)                                                                     \
    __builtin_amdgcn_global_load_lds((const unsigned*)(Kg + ((size_t)(kt_) * 64 + (i & 1) * 32) * US + (i >> 1) * 64), \
                                     (unsigned*)(Ks + tid * 8 + i * 2048), 16, 0, 0);
#define ATT_DMA_V(kt_)                                                                                              \
  _Pragma("unroll") for (int i = 0; i < 4; ++i)                                                                     \
    __builtin_amdgcn_global_load_lds((const unsigned*)(Vg + (size_t)(i * 32) * SEQ + (kt_) * 64),                  \
                                     (unsigned*)(Vt + tid * 8 + i * 2048), 16, 0, 0);
  __syncthreads();
  ATT_DMA_K(0)
  for (int kt = 0; kt <= qc; ++kt) {
    asm volatile("s_waitcnt vmcnt(0)" ::: "memory");
    __syncthreads();
    ATT_DMA_V(kt)
    f32x4 s[2][4];
#pragma unroll
    for (int mt = 0; mt < 2; ++mt)
#pragma unroll
      for (int n = 0; n < 4; ++n) s[mt][n] = (f32x4){0.f, 0.f, 0.f, 0.f};
#pragma unroll
    for (int ks = 0; ks < 2; ++ks)
#pragma unroll
      for (int n = 0; n < 4; ++n) {
        const bf16x8 kf = *(const bf16x8*)(Ks + (m * 64 + n * 16 + fr) * 64 + (((ks * 4 + fq) ^ rsw) * 8));
#pragma unroll
        for (int mt = 0; mt < 2; ++mt) s[mt][n] = MFMA(qf[mt][ks], kf, s[mt][n]);
      }
#pragma unroll
    for (int mt = 0; mt < 2; ++mt)
#pragma unroll
      for (int j = 0; j < 4; ++j) {
        float tmax = fmaxf(fmaxf(s[mt][0][j], s[mt][1][j]), fmaxf(s[mt][2][j], s[mt][3][j]));
        tmax = red16_max(tmax);
        const float mnew = fmaxf(mx[mt][j], tmax);
        const float alpha = __expf(mx[mt][j] - mnew);
        float rs = 0.f;
#pragma unroll
        for (int n = 0; n < 4; ++n) {
          const float pv = __expf(s[mt][n][j] - mnew);
          rs += pv;
          Pw[(mt * 16 + fq * 4 + j) * 72 + n * 16 + fr] = f2bf(pv);
        }
        rs = red16_sum(rs);
        ls[mt][j] = ls[mt][j] * alpha + rs;
        mx[mt][j] = mnew;
#pragma unroll
        for (int n = 0; n < 8; ++n) o[mt][n][j] *= alpha;
      }
    asm volatile("s_waitcnt vmcnt(0)" ::: "memory");
    __syncthreads();
    if (kt < qc) { ATT_DMA_K(kt + 1) }
#pragma unroll
    for (int ks = 0; ks < 2; ++ks) {
      bf16x8 pf[2];
#pragma unroll
      for (int mt = 0; mt < 2; ++mt) pf[mt] = *(const bf16x8*)(Pw + (mt * 16 + fr) * 72 + ks * 32 + fq * 8);
#pragma unroll
      for (int n = 0; n < 8; ++n) {
        const bf16x8 vf = *(const bf16x8*)(Vt + (n * 16 + fr) * 64 + (((ks * 4 + fq) ^ rsw) * 8));
#pragma unroll
        for (int mt = 0; mt < 2; ++mt) o[mt][n] = MFMA(pf[mt], vf, o[mt][n]);
      }
    }
  }
#undef ATT_DMA_K
#undef ATT_DMA_V
  __syncthreads();
#pragma unroll
  for (int mt = 0; mt < 2; ++mt)
#pragma unroll
    for (int j = 0; j < 4; ++j) {
      const float inv = 1.f / ls[mt][j];
#pragma unroll
      for (int n = 0; n < 8; ++n) o[mt][n][j] *= inv;
    }
  if (m == 1) {
#pragma unroll
    for (int mt = 0; mt < 2; ++mt)
#pragma unroll
      for (int n = 0; n < 8; ++n)
#pragma unroll
        for (int j = 0; j < 4; ++j) Ox[(rh * 32 + mt * 16 + fq * 4 + j) * 132 + n * 16 + fr] = o[mt][n][j];
  }
  __syncthreads();
  if (m == 0) {
    const float* sw = p.da_subln_w + (size_t)l * 128;
    float wv[8];
#pragma unroll
    for (int n = 0; n < 8; ++n) wv[n] = sw[n * 16 + fr] * (1.f - lam_init);
#pragma unroll
    for (int mt = 0; mt < 2; ++mt)
#pragma unroll
      for (int j = 0; j < 4; ++j) {
        float ss = 0.f;
        float d[8];
#pragma unroll
        for (int n = 0; n < 8; ++n) {
          d[n] = o[mt][n][j] - lam * Ox[(rh * 32 + mt * 16 + fq * 4 + j) * 132 + n * 16 + fr];
          ss += d[n] * d[n];
        }
        ss = red16_sum(ss);
        const float rstd = rsqrtf(ss * (1.f / 128.f) + 1e-6f);
        bf16_t* dst = p.u + (tok0 + rh * 32 + mt * 16 + fq * 4 + j) * US + h * 128 + fr;
#pragma unroll
        for (int n = 0; n < 8; ++n) dst[n * 16] = f2bf(d[n] * rstd * wv[n]);
      }
  }
  __syncthreads();
}

PHASE void hgrn_item(const Params& p, int l, int item, char* smem) {
  const int b = item >> 2, h = item & 3;
  const int tid = opaque_tid(), lane = tid & 63, wave = tid >> 6, fr = lane & 15, fq = lane >> 4;
  bf16_t* Qs = (bf16_t*)smem;
  bf16_t* Kn = Qs + 32 * 136;
  bf16_t* KT = Kn + 32 * 136;
  bf16_t* VT = KT + 128 * 40;
  bf16_t* Ps = VT + 128 * 40;
  bf16_t* ST = Ps + 32 * 40;
  float* lfb = (float*)ST;
  float* red = (float*)(ST + 128 * 136);
  float* blast = red + 64;
  const int t_ = tid >> 3, d0 = (tid & 7) * 16;
  float lbv[16];
#pragma unroll
  for (int i = 0; i < 16; ++i) {
    const int c = h * 128 + d0 + i;
    lbv[i] = (l == 0) ? 0.f : sigm(p.hg_lb[512 + c] - p.hg_lb[c]);
  }
  f32x4 S[2][8];
#pragma unroll
  for (int mm = 0; mm < 2; ++mm)
#pragma unroll
    for (int n = 0; n < 8; ++n) S[mm][n] = (f32x4){0.f, 0.f, 0.f, 0.f};
  const float* nw = p.hg_norm_w + (size_t)l * 128;

  for (int ch = 0; ch < 64; ++ch) {
    const size_t tok0 = (size_t)b * SEQ + (size_t)ch * 32;
    __syncthreads();
    float qv[16], kv[16];
    {
      const bf16_t* base = p.u + (tok0 + t_) * US + h * 128 + d0;
      float zv[16], iv[16];
      { const uint4 a = *(const uint4*)(base + 1024), c = *(const uint4*)(base + 1024 + 8); float* z0 = zv; float* z1 = zv + 8; UNPACK8(a, z0); UNPACK8(c, z1); }
      { const uint4 a = *(const uint4*)(base + 1536), c = *(const uint4*)(base + 1536 + 8); float* z0 = iv; float* z1 = iv + 8; UNPACK8(a, z0); UNPACK8(c, z1); }
      { const uint4 a = *(const uint4*)(base + 2048), c = *(const uint4*)(base + 2048 + 8); float* z0 = qv; float* z1 = qv + 8; UNPACK8(a, z0); UNPACK8(c, z1); }
#pragma unroll
      for (int i = 0; i < 16; ++i) {
        const float z = zv[i], lb = lbv[i];
        const float ez = __expf(-fabsf(z));
        float lf;
        if (lb > 0.f) {
          const float sg = (z >= 0.f) ? 1.f / (1.f + ez) : ez / (1.f + ez);
          lf = __logf(lb + (1.f - lb) * sg);
        } else {
          lf = -(fmaxf(-z, 0.f) + __logf(1.f + ez));
        }
        const float sgn = (z >= 0.f) ? ez / (1.f + ez) : 1.f / (1.f + ez);
        kv[i] = (1.f - lb) * sgn;
        lfb[t_ * 128 + d0 + i] = lf;
        VT[(d0 + i) * 40 + t_] = f2bf(iv[i]);
      }
    }
    __syncthreads();
    if (tid < 128) {
      float v[32];
#pragma unroll
      for (int t = 0; t < 32; ++t) v[t] = lfb[t * 128 + tid];
      float bsum = 0.f;
#pragma unroll
      for (int t = 0; t < 32; ++t) { bsum += v[t]; lfb[t * 128 + tid] = bsum; }
      blast[tid] = bsum;
    }
    __syncthreads();
    {
      float qo[16], ko[16];
#pragma unroll
      for (int i = 0; i < 16; ++i) {
        const float bb = lfb[t_ * 128 + d0 + i];
        qo[i] = qv[i] * __expf(bb);
        ko[i] = kv[i] * __expf(fminf(-bb, 80.f));
        KT[(d0 + i) * 40 + t_] = f2bf(ko[i]);
      }
      float* q0 = qo; float* q1 = qo + 8; float* k0 = ko; float* k1 = ko + 8;
      *(uint4*)(Qs + t_ * 136 + d0) = PACK8(q0);
      *(uint4*)(Qs + t_ * 136 + d0 + 8) = PACK8(q1);
      *(uint4*)(Kn + t_ * 136 + d0) = PACK8(k0);
      *(uint4*)(Kn + t_ * 136 + d0 + 8) = PACK8(k1);
    }
    __syncthreads();
#pragma unroll
    for (int mm = 0; mm < 2; ++mm)
#pragma unroll
      for (int n = 0; n < 8; ++n)
        *(uint2*)(ST + (n * 16 + fr) * 136 + wave * 32 + mm * 16 + fq * 4) =
            make_uint2(pack2(S[mm][n][0], S[mm][n][1]), pack2(S[mm][n][2], S[mm][n][3]));
    {
      const int mt = wave >> 1, nt = wave & 1;
      f32x4 sc = (f32x4){0.f, 0.f, 0.f, 0.f};
#pragma unroll
      for (int ks = 0; ks < 4; ++ks) {
        const bf16x8 a = *(const bf16x8*)(Qs + (mt * 16 + fr) * 136 + ks * 32 + fq * 8);
        const bf16x8 bb = *(const bf16x8*)(Kn + (nt * 16 + fr) * 136 + ks * 32 + fq * 8);
        sc = MFMA(a, bb, sc);
      }
#pragma unroll
      for (int j = 0; j < 4; ++j) {
        const int t = mt * 16 + fq * 4 + j, key = nt * 16 + fr;
        Ps[t * 40 + key] = f2bf(key <= t ? sc[j] : 0.f);
      }
    }
    __syncthreads();
    {
      const int mt = wave & 1, nb = (wave >> 1) * 4;
      f32x4 oo[4];
#pragma unroll
      for (int n = 0; n < 4; ++n) oo[n] = (f32x4){0.f, 0.f, 0.f, 0.f};
      {
        const bf16x8 a = *(const bf16x8*)(Ps + (mt * 16 + fr) * 40 + fq * 8);
#pragma unroll
        for (int n = 0; n < 4; ++n) {
          const bf16x8 bb = *(const bf16x8*)(VT + ((nb + n) * 16 + fr) * 40 + fq * 8);
          oo[n] = MFMA(a, bb, oo[n]);
        }
      }
#pragma unroll
      for (int ks = 0; ks < 4; ++ks) {
        const bf16x8 a = *(const bf16x8*)(Qs + (mt * 16 + fr) * 136 + ks * 32 + fq * 8);
#pragma unroll
        for (int n = 0; n < 4; ++n) {
          const bf16x8 bb = *(const bf16x8*)(ST + ((nb + n) * 16 + fr) * 136 + ks * 32 + fq * 8);
          oo[n] = MFMA(a, bb, oo[n]);
        }
      }
#pragma unroll
      for (int j = 0; j < 4; ++j) {
        float ss = 0.f;
#pragma unroll
        for (int n = 0; n < 4; ++n) ss += oo[n][j] * oo[n][j];
        ss = red16_sum(ss);
        if (fr == 0) red[(mt * 16 + fq * 4 + j) * 2 + (wave >> 1)] = ss;
      }
      __syncthreads();
#pragma unroll
      for (int j = 0; j < 4; ++j) {
        const int t = mt * 16 + fq * 4 + j;
        const float rstd = rsqrtf((red[t * 2] + red[t * 2 + 1]) * (1.f / 128.f) + 1e-6f);
        bf16_t* gp = p.u + (tok0 + t) * US + 2560 + h * 128 + nb * 16 + fr;
#pragma unroll
        for (int n = 0; n < 4; ++n) {
          const float g = bf2f(gp[n * 16]);
          gp[n * 16] = f2bf(oo[n][j] * rstd * nw[(nb + n) * 16 + fr] * (g * sigm(g)));
        }
      }
    }
    {
      bf16x8 af[2];
#pragma unroll
      for (int mm = 0; mm < 2; ++mm) af[mm] = *(const bf16x8*)(KT + (wave * 32 + mm * 16 + fr) * 40 + fq * 8);
#pragma unroll
      for (int n = 0; n < 8; ++n) {
        const bf16x8 bb = *(const bf16x8*)(VT + (n * 16 + fr) * 40 + fq * 8);
#pragma unroll
        for (int mm = 0; mm < 2; ++mm) S[mm][n] = MFMA(af[mm], bb, S[mm][n]);
      }
#pragma unroll
      for (int mm = 0; mm < 2; ++mm)
#pragma unroll
        for (int j = 0; j < 4; ++j) {
          const float e = __expf(blast[wave * 32 + mm * 16 + fq * 4 + j]);
#pragma unroll
          for (int n = 0; n < 8; ++n) S[mm][n][j] *= e;
        }
    }
  }
  __syncthreads();
}

DEV uint4 rw_act(const uint4 cur, const uint4 prv, const float* mul8, int mode) {
  const float4 m0 = *(const float4*)(mul8), m1 = *(const float4*)(mul8 + 4);
  const float mm[8] = {m0.x, m0.y, m0.z, m0.w, m1.x, m1.y, m1.z, m1.w};
  float a[8], b[8], o[8];
  UNPACK8(cur, a); UNPACK8(prv, b);
#pragma unroll
  for (int e = 0; e < 8; ++e) {
    float v = a[e] + (b[e] - a[e]) * mm[e];
    if (mode == 1) { const float t = __expf(-2.f * fabsf(v)); const float th = (1.f - t) / (1.f + t); v = (v >= 0.f) ? th : -th; }
    else if (mode == 2) v = sigm(v);
    o[e] = v;
  }
  return PACK8(o);
}
DEV bf16x8 rw_bfrag(const float* W, int k0, int col) {
  float o[8];
#pragma unroll
  for (int e = 0; e < 8; ++e) o[e] = W[(size_t)(k0 + e) * 512 + col];
  return as_frag(PACK8(o));
}

PHASE void rwkv_item(const Params& p, int l, int item, char* smem) {
  const int b = item >> 3, h = item & 7;
  const int tid = opaque_tid(), lane = tid & 63, wave = tid >> 6, fr = lane & 15, fq = lane >> 4;
  float* R = (float*)smem;
  float* K = R + 2048; float* KK = K + 2048; float* W = KK + 2048; float* BB = W + 2048;
  float* V = BB + 2048; float* G = V + 2048; float* O = G + 2048;
  float* cst = O + 2048;
  float* mul = cst + 512;
  bf16_t* rawL = (bf16_t*)smem;
  float* vloL = (float*)(smem + 17424);
  const float* mu = p.rw_mu + (size_t)l * 1792;
  const int hc_n = h * 64 + wave * 16 + fr;
  bf16x8 w2f[2], a2f[2], g2f[4], v2f;
#pragma unroll
  for (int ks = 0; ks < 2; ++ks) {
    w2f[ks] = rw_bfrag(p.rw_w2 + (size_t)l * 64 * 512, ks * 32 + fq * 8, hc_n);
    a2f[ks] = rw_bfrag(p.rw_a2 + (size_t)l * 64 * 512, ks * 32 + fq * 8, hc_n);
  }
#pragma unroll
  for (int ks = 0; ks < 4; ++ks) g2f[ks] = rw_bfrag(p.rw_g2 + (size_t)l * 128 * 512, ks * 32 + fq * 8, hc_n);
  v2f = w2f[0];
  if (l > 0) v2f = rw_bfrag(p.rw_v2, fq * 8, hc_n);
  const float w0c = p.rw_w0[l * 512 + hc_n], a0c = p.rw_a0[l * 512 + hc_n];
  const float v0c = (l > 0) ? p.rw_v0[hc_n] : 0.f;
  const int t_ = tid >> 3, n0 = (tid & 7) * 8;
  __syncthreads();
  if (tid < 64) {
    const int hc = h * 64 + tid;
    cst[tid] = p.rw_k_k[l * 512 + hc]; cst[64 + tid] = p.rw_k_a[l * 512 + hc]; cst[128 + tid] = p.rw_r_k[l * 512 + hc];
    cst[192 + tid] = p.rw_gn_w[l * 512 + hc]; cst[256 + tid] = p.rw_gn_b[l * 512 + hc];
    cst[320 + tid] = mu[hc]; cst[384 + tid] = mu[512 + hc]; cst[448 + tid] = mu[1024 + hc];
  }
  mul[tid] = mu[1536 + tid];
  const float* kkc = cst + n0; const float* kac = cst + 64 + n0; const float* rkc = cst + 128 + n0;
  const float* gnw = cst + 192 + n0; const float* gnb = cst + 256 + n0;
  const float* mur = cst + 320 + n0; const float* muk = cst + 384 + n0; const float* muv = cst + 448 + n0;
  const int kq = lane & 7, row0 = wave * 16 + (lane >> 3), row1 = row0 + 8;
  f32x2 S0p[4], S1p[4];
#pragma unroll
  for (int e = 0; e < 4; ++e) { S0p[e] = (f32x2){0.f, 0.f}; S1p[e] = (f32x2){0.f, 0.f}; }

  uint4 pl0, pl1, pl2, pl3, pl4, pcr, pck, pcv, ppr, ppk, ppv, pvf;
  float4 pvl;
#define RW_PREFETCH(ch_)                                                                                    \
  {                                                                                                         \
    const size_t tk0 = (size_t)b * SEQ + (size_t)(ch_) * 32;                                                 \
    const bf16_t* lb_ = p.u + (tk0 - 1) * US + 3072 + 1536 + (tid & 31) * 8;                                 \
    const int r0_ = tid >> 5;                                                                               \
    pl0 = make_uint4(0, 0, 0, 0); if (!((ch_) == 0 && r0_ == 0)) pl0 = *(const uint4*)(lb_ + (size_t)r0_ * US); \
    pl1 = *(const uint4*)(lb_ + (size_t)(r0_ + 8) * US);                                                     \
    pl2 = *(const uint4*)(lb_ + (size_t)(r0_ + 16) * US);                                                    \
    pl3 = *(const uint4*)(lb_ + (size_t)(r0_ + 24) * US);                                                    \
    pl4 = make_uint4(0, 0, 0, 0); if (tid < 32) pl4 = *(const uint4*)(lb_ + (size_t)32 * US);                \
    const bf16_t* cu_ = p.u + (tk0 + t_) * US + 3072 + h * 64 + n0;                                          \
    pcr = *(const uint4*)cu_; pck = *(const uint4*)(cu_ + 512); pcv = *(const uint4*)(cu_ + 1024);           \
    if ((ch_) == 0 && t_ == 0) { ppr = make_uint4(0, 0, 0, 0); ppk = ppr; ppv = ppr; }                        \
    else { ppr = *(const uint4*)(cu_ - US); ppk = *(const uint4*)(cu_ - US + 512); ppv = *(const uint4*)(cu_ - US + 1024); } \
    if (l > 0) {                                                                                            \
      pvl = *(const float4*)(p.vlo + (tk0 + (tid >> 3)) * 32 + (tid & 7) * 4);                               \
      pvf = *(const uint4*)(p.vfirst + (tk0 + t_) * 512 + h * 64 + n0);                                      \
    } else { pvl = make_float4(0.f, 0.f, 0.f, 0.f); pvf = make_uint4(0, 0, 0, 0); }                          \
  }
  RW_PREFETCH(0)

  for (int ch = 0; ch < 64; ++ch) {
    const size_t tok0 = (size_t)b * SEQ + (size_t)ch * 32;
    __syncthreads();
    {
      const int r0_ = tid >> 5, cc_ = (tid & 31) * 8;
      *(uint4*)(rawL + r0_ * 264 + cc_) = pl0;
      *(uint4*)(rawL + (r0_ + 8) * 264 + cc_) = pl1;
      *(uint4*)(rawL + (r0_ + 16) * 264 + cc_) = pl2;
      *(uint4*)(rawL + (r0_ + 24) * 264 + cc_) = pl3;
      if (tid < 32) *(uint4*)(rawL + 32 * 264 + cc_) = pl4;
      *(float4*)(vloL + (tid >> 3) * 36 + (tid & 7) * 4) = pvl;
    }
    __syncthreads();
    {
      const int cc_ = (tid & 31) * 8, tr = tid >> 5;
      const int mode = (cc_ < 64) ? 1 : ((cc_ < 128) ? 0 : 2);
      uint4 a0, a1, a2, a3;
      a0 = rw_act(*(const uint4*)(rawL + (tr + 1) * 264 + cc_), *(const uint4*)(rawL + tr * 264 + cc_), mul + cc_, mode);
      a1 = rw_act(*(const uint4*)(rawL + (tr + 9) * 264 + cc_), *(const uint4*)(rawL + (tr + 8) * 264 + cc_), mul + cc_, mode);
      a2 = rw_act(*(const uint4*)(rawL + (tr + 17) * 264 + cc_), *(const uint4*)(rawL + (tr + 16) * 264 + cc_), mul + cc_, mode);
      a3 = rw_act(*(const uint4*)(rawL + (tr + 25) * 264 + cc_), *(const uint4*)(rawL + (tr + 24) * 264 + cc_), mul + cc_, mode);
      __syncthreads();
      *(uint4*)(rawL + tr * 264 + cc_) = a0;
      *(uint4*)(rawL + (tr + 8) * 264 + cc_) = a1;
      *(uint4*)(rawL + (tr + 16) * 264 + cc_) = a2;
      *(uint4*)(rawL + (tr + 24) * 264 + cc_) = a3;
    }
    __syncthreads();
#pragma unroll 1
    for (int mt = 0; mt < 2; ++mt) {
      const int row = mt * 16 + fr;
      const bf16_t* ar = rawL + row * 264 + fq * 8;
      f32x4 aw = (f32x4){0.f, 0.f, 0.f, 0.f}, aa = aw, ag = aw, av = aw;
#pragma unroll
      for (int ks = 0; ks < 2; ++ks) {
        aw = MFMA(*(const bf16x8*)(ar + ks * 32), w2f[ks], aw);
        aa = MFMA(*(const bf16x8*)(ar + 64 + ks * 32), a2f[ks], aa);
      }
#pragma unroll
      for (int ks = 0; ks < 4; ++ks) ag = MFMA(*(const bf16x8*)(ar + 128 + ks * 32), g2f[ks], ag);
      if (l > 0) {
        const float4 x0 = *(const float4*)(vloL + row * 36 + fq * 8), x1 = *(const float4*)(vloL + row * 36 + fq * 8 + 4);
        const uint4 pk = make_uint4(pack2(x0.x, x0.y), pack2(x0.z, x0.w), pack2(x1.x, x1.y), pack2(x1.z, x1.w));
        av = MFMA(as_frag(pk), v2f, av);
      }
#pragma unroll
      for (int j = 0; j < 4; ++j) {
        const int t = mt * 16 + fq * 4 + j, n = wave * 16 + fr;
        const float wv = -(w0c + aw[j]);
        const float sp = fmaxf(wv, 0.f) + __logf(1.f + __expf(-fabsf(wv)));
        const float wl = -sp - 0.5f;
        W[t * 64 + n] = __expf(-__expf(wl));
        BB[t * 64 + n] = sigm(a0c + aa[j]);
        G[t * 64 + n] = ag[j];
        if (l > 0) O[t * 64 + n] = sigm(v0c + av[j]);
      }
    }
    __syncthreads();
    {
      const size_t tok = tok0 + t_;
      float cr[8], ck[8], cv[8], pr[8], pk[8], pv[8];
      UNPACK8(pcr, cr); UNPACK8(pck, ck); UNPACK8(pcv, cv);
      UNPACK8(ppr, pr); UNPACK8(ppk, pk); UNPACK8(ppv, pv);
      float kx[8], kkv[8], vs[8], ss = 0.f;
#pragma unroll
      for (int e = 0; e < 8; ++e) {
        R[t_ * 64 + n0 + e] = cr[e] + (pr[e] - cr[e]) * mur[e];
        kx[e] = ck[e] + (pk[e] - ck[e]) * muk[e];
        vs[e] = cv[e] + (pv[e] - cv[e]) * muv[e];
        kkv[e] = kx[e] * kkc[e]; ss += kkv[e] * kkv[e];
      }
      ss = red8_sum(ss);
      const float rn = rsqrtf(fmaxf(ss, 1e-24f));
#pragma unroll
      for (int e = 0; e < 8; ++e) {
        const float a = BB[t_ * 64 + n0 + e];
        const float kn = kkv[e] * rn;
        K[t_ * 64 + n0 + e] = kx[e] * (1.f + (a - 1.f) * kac[e]);
        KK[t_ * 64 + n0 + e] = kn;
        BB[t_ * 64 + n0 + e] = kn * a;
      }
      if (l == 0) {
        *(uint4*)(p.vfirst + tok * 512 + h * 64 + n0) = PACK8(vs);
      } else {
        float vf[8]; UNPACK8(pvf, vf);
#pragma unroll
        for (int e = 0; e < 8; ++e) vs[e] = vs[e] + (vf[e] - vs[e]) * O[t_ * 64 + n0 + e];
      }
#pragma unroll
      for (int e = 0; e < 8; ++e) V[t_ * 64 + n0 + e] = vs[e];
    }
    __syncthreads();
    if (ch + 1 < 64) RW_PREFETCH(ch + 1)
    asm volatile("" ::: "memory");
#pragma unroll 4
    for (int t = 0; t < 32; ++t) {
      const float* base = R + t * 64 + kq * 8;
      const float4 r0 = *(const float4*)(base), r1 = *(const float4*)(base + 4);
      const float4 k0 = *(const float4*)(base + 2048), k1 = *(const float4*)(base + 2048 + 4);
      const float4 q0 = *(const float4*)(base + 4096), q1 = *(const float4*)(base + 4096 + 4);
      const float4 w0 = *(const float4*)(base + 6144), w1 = *(const float4*)(base + 6144 + 4);
      const float4 b0 = *(const float4*)(base + 8192), b1 = *(const float4*)(base + 8192 + 4);
      const float va = V[t * 64 + row0], vb = V[t * 64 + row1];
      const f32x2 rr[4] = {{r0.x, r0.y}, {r0.z, r0.w}, {r1.x, r1.y}, {r1.z, r1.w}};
      const f32x2 ww[4] = {{w0.x, w0.y}, {w0.z, w0.w}, {w1.x, w1.y}, {w1.z, w1.w}};
      const f32x2 kk_[4] = {{k0.x, k0.y}, {k0.z, k0.w}, {k1.x, k1.y}, {k1.z, k1.w}};
      const f32x2 qq[4] = {{q0.x, q0.y}, {q0.z, q0.w}, {q1.x, q1.y}, {q1.z, q1.w}};
      const f32x2 bb[4] = {{b0.x, b0.y}, {b0.z, b0.w}, {b1.x, b1.y}, {b1.z, b1.w}};
      f32x2 a0 = S0p[0] * qq[0], a1 = S1p[0] * qq[0];
#pragma unroll
      for (int e = 1; e < 4; ++e) { a0 += S0p[e] * qq[e]; a1 += S1p[e] * qq[e]; }
      const float sa0 = -red8_sum(a0.x + a0.y), sa1 = -red8_sum(a1.x + a1.y);
      f32x2 sa0v, sa1v, vav, vbv;
      sa0v.x = sa0; sa0v.y = sa0; sa1v.x = sa1; sa1v.y = sa1; vav.x = va; vav.y = va; vbv.x = vb; vbv.y = vb;
      f32x2 o0v = {0.f, 0.f}, o1v = {0.f, 0.f};
#pragma unroll
      for (int e = 0; e < 4; ++e) {
        S0p[e] = S0p[e] * ww[e] + sa0v * bb[e] + vav * kk_[e];
        S1p[e] = S1p[e] * ww[e] + sa1v * bb[e] + vbv * kk_[e];
        o0v += S0p[e] * rr[e]; o1v += S1p[e] * rr[e];
      }
      const float o0 = red8_sum(o0v.x + o0v.y), o1 = red8_sum(o1v.x + o1v.y);
      if (kq == 0) { O[t * 64 + row0] = o0; O[t * 64 + row1] = o1; }
    }
    asm volatile("s_waitcnt vmcnt(0)" ::: "memory");
    __syncthreads();
    {
      const size_t tok = tok0 + t_;
      float ov[8], s1 = 0.f, bon = 0.f;
#pragma unroll
      for (int e = 0; e < 8; ++e) {
        ov[e] = O[t_ * 64 + n0 + e]; s1 += ov[e];
        bon += R[t_ * 64 + n0 + e] * K[t_ * 64 + n0 + e] * rkc[e];
      }
      s1 = red8_sum(s1); bon = red8_sum(bon);
      const float mean = s1 * (1.f / 64.f);
      float s2 = 0.f;
#pragma unroll
      for (int e = 0; e < 8; ++e) { const float d = ov[e] - mean; s2 += d * d; }
      s2 = red8_sum(s2);
      const float rstd = rsqrtf(s2 * (1.f / 64.f) + 64e-5f);
      float y[8];
#pragma unroll
      for (int e = 0; e < 8; ++e)
        y[e] = ((ov[e] - mean) * rstd * gnw[e] + gnb[e] + bon * V[t_ * 64 + n0 + e]) * G[t_ * 64 + n0 + e];
      *(uint4*)(p.u + tok * US + 3072 + h * 64 + n0) = PACK8(y);
    }
  }
#undef RW_PREFETCH
  __syncthreads();
}

PHASE void phase_mix(const Params& p, int l, char* smem) {
  const int hf = vhalf();
  int* sitem = (int*)(smem - hf * SMEM_BYTES + SMEM_BYTES - 16);
  const int t512 = opaque_tid512();
  while (true) {
    __syncthreads();
    if (t512 == 0) *sitem = (int)atomicAdd(p.counters + l * 4 + 0, 1u);
    __syncthreads();
    const int tk = *sitem;
    if (tk >= 128) break;
    rwkv_item(p, l, tk * 2 + hf, smem);
  }
  while (true) {
    __syncthreads();
    if (t512 == 0) *sitem = (int)atomicAdd(p.counters + l * 4 + 1, 1u);
    __syncthreads();
    const int tk = *sitem;
    if (tk >= 64) break;
    hgrn_item(p, l, tk * 2 + hf, smem);
  }
  while (true) {
    __syncthreads();
    if (t512 == 0) *sitem = (int)atomicAdd(p.counters + l * 4 + 2, 1u);
    __syncthreads();
    const int tk = *sitem;
    if (tk >= 2048) break;
    att_item(p, l, tk * 2 + hf, smem);
  }
}

DEV void gemm_gates(const int tid_in, const bf16_t* A, const bf16_t* Wg, int tn, char* smem, unsigned (&Gp)[4][6][2]) {
  int tid = tid_in; asm volatile("" : "+v"(tid));
  bf16_t* As = (bf16_t*)smem;
  bf16_t* Bs = As + 3 * 4096;
  const int lane = tid & 63, wave = tid >> 6, wr = wave >> 1, wc = wave & 1;
  const int fr = lane & 15, fq = lane >> 4;
  f32x4 acc[4][6];
#pragma unroll
  for (int m = 0; m < 4; ++m)
#pragma unroll
    for (int n = 0; n < 6; ++n) acc[m][n] = (f32x4){0.f, 0.f, 0.f, 0.f};
  const int nk = DM >> 5;
  const int drow = tid >> 2, dphys = tid & 3, dg = (0 - (tid >> 4)) & 3;
  const int cofs = (dphys ^ dg) * 8;
  const unsigned aofs = (unsigned)(drow * DM + cofs);
  unsigned bofs0, bofs1, bofs2;
  {
    int r = drow; int wcb = r / 96, br = (r % 96) >> 5, c = (r % 96) & 31;
    bofs0 = (unsigned)((5376 + br * 1024 + tn * 64 + wcb * 32 + c) * DM + cofs);
    r = drow + 64; wcb = r / 96; br = (r % 96) >> 5; c = (r % 96) & 31;
    bofs1 = (unsigned)((5376 + br * 1024 + tn * 64 + wcb * 32 + c) * DM + cofs);
    r = drow + 128; wcb = r / 96; br = (r % 96) >> 5; c = (r % 96) & 31;
    bofs2 = (unsigned)((5376 + br * 1024 + tn * 64 + wcb * 32 + c) * DM + cofs);
  }
  const int rofs = (fq ^ ((0 - (fr >> 2)) & 3)) * 8;
#define GG_DMA(st, kk)                                                                                       \
  {                                                                                                          \
    __builtin_amdgcn_global_load_lds((const unsigned*)(A + aofs + (kk) * 32), (unsigned*)(As + (st) * 4096 + tid * 8), 16, 0, 0);                     \
    __builtin_amdgcn_global_load_lds((const unsigned*)(A + aofs + 64 * DM + (kk) * 32), (unsigned*)(As + (st) * 4096 + tid * 8 + 2048), 16, 0, 0); \
    __builtin_amdgcn_global_load_lds((const unsigned*)(Wg + bofs0 + (kk) * 32), (unsigned*)(Bs + (st) * 6144 + tid * 8), 16, 0, 0);                    \
    __builtin_amdgcn_global_load_lds((const unsigned*)(Wg + bofs1 + (kk) * 32), (unsigned*)(Bs + (st) * 6144 + tid * 8 + 2048), 16, 0, 0);             \
    __builtin_amdgcn_global_load_lds((const unsigned*)(Wg + bofs2 + (kk) * 32), (unsigned*)(Bs + (st) * 6144 + tid * 8 + 4096), 16, 0, 0);             \
  }
  GG_DMA(0, 0)
  GG_DMA(1, 1)
  int st = 0;
  for (int kt = 0; kt < nk; ++kt) {
    if (kt + 1 < nk) asm volatile("s_waitcnt vmcnt(5)" ::: "memory");
    else asm volatile("s_waitcnt vmcnt(0)" ::: "memory");
    __builtin_amdgcn_s_barrier();
    asm volatile("" ::: "memory");
    const int s2 = (st >= 1) ? st - 1 : 2;
    const bf16_t* Ab = As + st * 4096 + (wr * 64 + fr) * 32 + rofs;
    const bf16_t* Bb = Bs + st * 6144 + (wc * 96 + fr) * 32 + rofs;
    bf16x8 bfr[6], af[4];
#pragma unroll
    for (int n = 0; n < 6; ++n) bfr[n] = *(const bf16x8*)(Bb + n * 512);
#pragma unroll
    for (int m = 0; m < 4; ++m) af[m] = *(const bf16x8*)(Ab + m * 512);
    if (kt + 2 < nk) GG_DMA(s2, kt + 2)
#pragma unroll
    for (int m = 0; m < 4; ++m)
#pragma unroll
      for (int n = 0; n < 6; ++n) acc[m][n] = MFMA(af[m], bfr[n], acc[m][n]);
    st = (st == 2) ? 0 : st + 1;
  }
#undef GG_DMA
  __syncthreads();
#pragma unroll
  for (int m = 0; m < 4; ++m)
#pragma unroll
    for (int n = 0; n < 6; ++n) {
      Gp[m][n][0] = pack2(sigm(acc[m][n][0]), sigm(acc[m][n][1]));
      Gp[m][n][1] = pack2(sigm(acc[m][n][2]), sigm(acc[m][n][3]));
    }
}

PHASE void phase_merge(const Params& p, int l, char* smem) {
  const bf16_t* Wl = p.wt + (size_t)l * WLAYER;
  float* Cs = (float*)smem;
  const int tid = opaque_tid();
  for (int it = 0;; ++it) {
    int tm, tn;
    if (!tile_for(it, 512, 16, tm, tn)) break;
    const size_t row0 = (size_t)tm * 128;
    unsigned Gp[4][6][2];
    gemm_gates(tid, p.h + row0 * DM, Wl + WIN, tn, smem, Gp);
    f32x4 acc[4][2], M[4][2];
#pragma unroll
    for (int m = 0; m < 4; ++m)
#pragma unroll
      for (int n = 0; n < 2; ++n) M[m][n] = (f32x4){0.f, 0.f, 0.f, 0.f};
#pragma unroll
    for (int br = 0; br < 3; ++br) {
      const int aoff = (br == 0) ? 0 : (br == 1 ? 2560 : 3072);
      const size_t woff = (br == 0) ? WBA : (br == 1 ? WBB : WBC);
      gemm_tile<2>(tid, p.u + row0 * US + aoff, US, Wl + woff + (size_t)(tn * 64) * 512, 512, 512, smem, acc);
#pragma unroll
      for (int m = 0; m < 4; ++m)
#pragma unroll
        for (int n = 0; n < 2; ++n) {
          M[m][n][0] += lo16(Gp[m][2 * br + n][0]) * acc[m][n][0];
          M[m][n][1] += hi16(Gp[m][2 * br + n][0]) * acc[m][n][1];
          M[m][n][2] += lo16(Gp[m][2 * br + n][1]) * acc[m][n][2];
          M[m][n][3] += hi16(Gp[m][2 * br + n][1]) * acc[m][n][3];
        }
    }
    stage_acc<2>(tid, Cs, M);
    __syncthreads();
    {
      const int ch = tid & 7;
#pragma unroll 1
      for (int i = 0; i < 4; ++i) {
        const int r = (tid >> 3) + i * 32;
        const float4 a = *(const float4*)(Cs + r * 68 + ch * 8), b = *(const float4*)(Cs + r * 68 + ch * 8 + 4);
        *(uint4*)(p.u + (row0 + r) * US + 1024 + tn * 64 + ch * 8) = make_uint4(pack2(a.x, a.y), pack2(a.z, a.w), pack2(b.x, b.y), pack2(b.z, b.w));
      }
    }
    __syncthreads();
  }
}

PHASE void phase_gemm_res(const bf16_t* A, int lda, const bf16_t* Wt, int K, const float* xin, float* xout,
                        const float* ada_l, int gate_off, char* smem0) {
  const int T = opaque_tid512(), tid = T & 255, hf = vhalf();
  float* Cs = (float*)(smem0 + hf * SMEM_BYTES);
  for (int it = 0;; ++it) {
    int tm, tn;
    if (!tile_for_real(it, 256, 4, tm, tn)) break;
    const size_t row0 = (size_t)tm * 256;
    f32x4 acc[8][4];
    gemm_tile512(T, A + row0 * lda, lda, Wt + (size_t)(tn * 256) * K, K, K, smem0, acc);
    const float* gate = ada_l + (size_t)(row0 / SEQ) * ADAW + gate_off;
    const int c4 = (tid & 31) * 4;
#pragma unroll
    for (int ps = 0; ps < 2; ++ps) {
      if (ps == 0) stage_half512<0>(T, Cs, acc); else stage_half512<1>(T, Cs, acc);
      __syncthreads();
#pragma unroll 1
      for (int i = 0; i < 16; ++i) {
        const int r = (tid >> 5) + i * 8;
        const int colb = TNC(r) * 128 + c4;
        const float4 gv = *(const float4*)(gate + colb);
        const float4 cv = *(const float4*)(Cs + r * 132 + c4);
        const size_t off = GROW(r, ps) * DM + colb;
        const float4 xv = *(const float4*)(xin + off);
        *(float4*)(xout + off) = make_float4(xv.x + gv.x * cv.x, xv.y + gv.y * cv.y, xv.z + gv.z * cv.z, xv.w + gv.w * cv.w);
      }
      __syncthreads();
    }
  }
}

PHASE void phase_ffn_in(const Params& p, int l, char* smem0) {
  const bf16_t* Wt = p.wt + (size_t)l * WLAYER + WFI;
  const int T = opaque_tid512(), tid = T & 255, hf = vhalf();
  float* Cs = (float*)(smem0 + hf * SMEM_BYTES);
  for (int it = 0;; ++it) {
    int tm, tn;
    if (!tile_for_real(it, 256, 22, tm, tn)) break;
    const size_t row0 = (size_t)tm * 256;
    f32x4 acc[8][4];
    gemm_tile512(T, p.h + row0 * DM, DM, Wt + (size_t)(tn * 256) * DM, DM, DM, smem0, acc);
    const int ch = tid & 7;
#pragma unroll
    for (int ps = 0; ps < 2; ++ps) {
      if (ps == 0) stage_half512<0>(T, Cs, acc); else stage_half512<1>(T, Cs, acc);
      __syncthreads();
#pragma unroll 1
      for (int i = 0; i < 4; ++i) {
        const int r = (tid >> 3) + i * 32;
        const float* cp = Cs + r * 132 + ch * 8;
        float o[8];
#pragma unroll
        for (int e = 0; e < 8; ++e) { const float g = cp[e], uu = cp[64 + e]; o[e] = g * sigm(g) * uu; }
        *(uint4*)(p.u + GROW(r, ps) * FFH + TNC(r) * 64 + ch * 8) = PACK8(o);
      }
      __syncthreads();
    }
  }
}

#define XB_TMO      128
#define XB_XCNT(j)  (256  + 64 * (j))
#define XB_XSUB(j)  (1280 + 64 * (j))
#define XB_XGEN(j)  (2304 + 64 * (j))
#define XB_TOP      3328
#define XB_TOPGEN   3392
#define XCD_BAR_WORDS 3456
#define XB_SPIN_CAP (1u << 18)
#define LAS __attribute__((address_space(3)))
DEV unsigned xb_ld(unsigned* p) { return __hip_atomic_load(p, __ATOMIC_RELAXED, __HIP_MEMORY_SCOPE_AGENT); }
DEV unsigned xb_add(unsigned* p, unsigned v) { return __hip_atomic_fetch_add(p, v, __ATOMIC_RELAXED, __HIP_MEMORY_SCOPE_AGENT); }
DEV unsigned xb_xcc_id() { return (unsigned)__builtin_amdgcn_s_getreg((3 << 11) | 20) & 0xFu; }
#define XB_SPIN(cond, bar) do { unsigned _sp = 0; while (cond) { __builtin_amdgcn_s_sleep(1); \
    if ((++_sp & 255u) == 0u) { if (xb_ld(&(bar)[XB_TMO])) break; if (_sp > XB_SPIN_CAP) { atomicAdd(&(bar)[XB_TMO], 1u); break; } } } } while (0)
struct XcdBarrier { unsigned* bar; unsigned x; volatile LAS unsigned* st; };
DEV XcdBarrier xcd_barrier_post(unsigned* bar, volatile LAS unsigned* st) {
  XcdBarrier b; b.bar = bar; b.x = xb_xcc_id(); b.st = st;
  if (threadIdx.x == 0) (void)xb_add(&bar[XB_XCNT(b.x)], 1u);
  return b;
}
DEV void xcd_barrier_complete(unsigned* bar, unsigned x, unsigned& nloc, unsigned& nx) {
  const unsigned G = gridDim.x * gridDim.y * gridDim.z;
  unsigned sum, cnt, mine, sp = 0u;
  for (;;) {
    sum = 0u; cnt = 0u; mine = 0u;
#pragma unroll
    for (unsigned j = 0; j < 16; ++j) { const unsigned c = xb_ld(&bar[XB_XCNT(j)]); sum += c; cnt += (c > 0u) ? 1u : 0u; mine = (j == x) ? c : mine; }
    if (sum == G) break;
    __builtin_amdgcn_s_sleep(1);
    if ((++sp & 255u) == 0u) { if (xb_ld(&bar[XB_TMO])) break; if (sp > XB_SPIN_CAP) { atomicAdd(&bar[XB_TMO], 1u); break; } }
  }
  nloc = mine > 0u ? mine : 1u; nx = cnt > 0u ? cnt : 1u;
}
DEV void xcd_barrier(const XcdBarrier& b) {
  asm volatile("s_waitcnt vmcnt(0)" ::: "memory");
  __syncthreads();
  if (threadIdx.x == 0) {
    unsigned* bar = b.bar;
    __builtin_amdgcn_s_waitcnt(0);
    unsigned nloc = b.st[0], nx = b.st[1];
    if (nloc == 0u) { xcd_barrier_complete(bar, b.x, nloc, nx); b.st[0] = nloc; b.st[1] = nx; }
    const unsigned old = xb_add(&bar[XB_XSUB(b.x)], 1u);
    const unsigned gen = old / nloc;
    if (old + 1u == (gen + 1u) * nloc) {
      __builtin_amdgcn_fence(__ATOMIC_RELEASE, "agent");
      asm volatile("s_waitcnt vmcnt(0)" ::: "memory");
      const unsigned og = xb_add(&bar[XB_TOP], 1u);
      const unsigned tg = og / nx;
      if (og + 1u == (tg + 1u) * nx) xb_add(&bar[XB_TOPGEN], 1u);
      else XB_SPIN(xb_ld(&bar[XB_TOPGEN]) == tg, bar);
      __builtin_amdgcn_fence(__ATOMIC_ACQUIRE, "agent");
      xb_add(&bar[XB_XGEN(b.x)], 1u);
      asm volatile("s_waitcnt vmcnt(0)" ::: "memory");
    } else {
      XB_SPIN(xb_ld(&bar[XB_XGEN(b.x)]) == gen, bar);
      __builtin_amdgcn_fence(__ATOMIC_ACQUIRE, "agent");
      asm volatile("s_waitcnt vmcnt(0)" ::: "memory");
    }
  }
  __syncthreads();
}

__global__ void __launch_bounds__(512, 2) mega(Params p_in, int ph_lo, int ph_hi) {
  extern __shared__ __attribute__((aligned(16))) char smem0[];
  char* smem = smem0 + vhalf() * SMEM_BYTES;
  cg::grid_group grid = cg::this_grid();
  const Params& p = p_in;
  bool first = true;
#define RUN(ph) if ((ph) >= ph_lo && (ph) < ph_hi)
  unsigned epoch = 0;
  __shared__ unsigned xb_words[4];
  if (threadIdx.x < 4) xb_words[threadIdx.x] = 0u;
  __syncthreads();
  XcdBarrier xb;
  xb.bar = p.counters + 256; xb.x = 0u; xb.st = (volatile LAS unsigned*)xb_words;
#define SYNC { if (!first) { ++epoch; if (epoch == 1) { grid.sync(); xb = xcd_barrier_post(p.counters + 256, (volatile LAS unsigned*)xb_words); } else xcd_barrier(xb); } first = false; }
  RUN(0) { SYNC; phase_prep(p, smem); }
#pragma unroll 1
  for (int l = 0; l < 2; ++l) {
    const int base = 1 + 9 * l;
    const float* ada_l = p.ada + (size_t)l * 32 * ADAW;
    const bf16_t* Wl = p.wt + (size_t)l * WLAYER;
    const float* xin = (l == 0) ? p.x : p.out;
    RUN(base + 0) { SYNC; phase_norm(xin, p.norm_mix_w + l * DM, ada_l, 0, 1024, p.h); }
    RUN(base + 1) { SYNC; phase_gemm_in(p, l, smem0); }
    RUN(base + 2) { if (l > 0) { SYNC; phase_vlo(p, l, smem); } }
    RUN(base + 3) { SYNC; phase_mix(p, l, smem); }
    RUN(base + 4) { SYNC; phase_merge(p, l, smem); }
    RUN(base + 5) { SYNC; phase_gemm_res(p.u + 1024, US, Wl + WOUT, DM, xin, p.out, ada_l, 2048, smem0); }
    RUN(base + 6) { SYNC; phase_norm(p.out, p.norm_ffn_w + l * DM, ada_l, 3072, 4096, p.h); }
    RUN(base + 7) { SYNC; phase_ffn_in(p, l, smem0); }
    RUN(base + 8) { SYNC; phase_gemm_res(p.u, FFH, Wl + WFO, FFH, p.out, p.out, ada_l, 5120, smem0); }
  }
  RUN(NPHASE - 1) { SYNC; phase_final(p.out, p.final_norm_w); }
}

extern "C" void kernel_launch(void* const* d_in, const int* in_sizes, int n_in, void* d_out, int out_size, void* d_ws,
                              size_t ws_size, hipStream_t stream) {
  Params p{};
  p.x = (const float*)d_in[0]; p.c = (const float*)d_in[1]; p.pos = (const int*)d_in[2];
  p.ada_w = (const float*)d_in[3]; p.ada_b = (const float*)d_in[4]; p.norm_mix_w = (const float*)d_in[5];
  p.norm_ffn_w = (const float*)d_in[6]; p.w_in = (const float*)d_in[7]; p.da_lambda = (const float*)d_in[8];
  p.da_subln_w = (const float*)d_in[9]; p.hg_lb = (const float*)d_in[10]; p.hg_norm_w = (const float*)d_in[11];
  p.rw_mu = (const float*)d_in[12]; p.rw_w0 = (const float*)d_in[13]; p.rw_w2 = (const float*)d_in[14];
  p.rw_a0 = (const float*)d_in[15]; p.rw_a2 = (const float*)d_in[16]; p.rw_g2 = (const float*)d_in[17];
  p.rw_k_k = (const float*)d_in[18]; p.rw_k_a = (const float*)d_in[19]; p.rw_r_k = (const float*)d_in[20];
  p.rw_gn_w = (const float*)d_in[21]; p.rw_gn_b = (const float*)d_in[22]; p.rw_v0 = (const float*)d_in[23];
  p.rw_v1 = (const float*)d_in[24]; p.rw_v2 = (const float*)d_in[25]; p.w_br_a = (const float*)d_in[26];
  p.w_br_b = (const float*)d_in[27]; p.w_br_c = (const float*)d_in[28]; p.w_out = (const float*)d_in[29];
  p.ffn_w_in = (const float*)d_in[30]; p.ffn_w_out = (const float*)d_in[31]; p.final_norm_w = (const float*)d_in[32];
  p.out = (float*)d_out;
  char* ws = (char*)d_ws;
  size_t off = 0;
  auto take = [&](size_t bytes) { char* r = ws + off; off += (bytes + 255) & ~(size_t)255; return r; };
  p.counters = (unsigned*)take(16384);
  p.wt = (bf16_t*)take(2 * WLAYER * 2);
  p.ada = (float*)take((size_t)2 * 32 * ADAW * 4);
  p.h = (bf16_t*)take((size_t)T_TOK * DM * 2);
  p.u = (bf16_t*)take((size_t)T_TOK * US * 2);
  p.vT = (bf16_t*)take((size_t)T_TOK * 512 * 2);
  p.vfirst = (bf16_t*)take((size_t)T_TOK * 512 * 2);
  p.vlo = (float*)take((size_t)T_TOK * 32 * 4);
  if (off > ws_size) { fprintf(stderr, "workspace too small: need %zu have %zu\n", off, ws_size); return; }

  static int grid_blocks = 0;
  if (!grid_blocks) {
    hipFuncSetAttribute((const void*)mega, hipFuncAttributeMaxDynamicSharedMemorySize, 2 * SMEM_BYTES);
    int dev = 0, cus = 0, per_cu = 0;
    hipGetDevice(&dev);
    hipDeviceGetAttribute(&cus, hipDeviceAttributeMultiprocessorCount, dev);
    hipOccupancyMaxActiveBlocksPerMultiprocessor(&per_cu, mega, 512, 2 * SMEM_BYTES);
    if (per_cu > 1) per_cu = 1;
    if (per_cu < 1) per_cu = 1;
    grid_blocks = cus * per_cu;
  }
#if SINGLE_LAUNCH
  int lo = 0, hi = NPHASE;
  void* args[] = {&p, &lo, &hi};
  hipError_t e = hipLaunchCooperativeKernel((void*)mega, dim3(grid_blocks), dim3(512), args, 2 * SMEM_BYTES, stream);
  if (e != hipSuccess) fprintf(stderr, "cooperative launch failed: %s (grid %d)\n", hipGetErrorString(e), grid_blocks);
#else
  for (int ph = 0; ph < NPHASE; ++ph) {
    if (ph == 3) continue;
    hipLaunchKernelGGL(mega, dim3(grid_blocks), dim3(512), 2 * SMEM_BYTES, stream, p, ph, ph + 1);
  }
#endif
}
```

```cpp
#include <hip/hip_runtime.h>
#include <hip/hip_cooperative_groups.h>
#include <stdint.h>
#include <cstdio>
namespace cg = cooperative_groups;

typedef unsigned short bf16_t;
typedef short bf16x8 __attribute__((ext_vector_type(8)));
typedef float f32x4 __attribute__((ext_vector_type(4)));
typedef float f32x2 __attribute__((ext_vector_type(2)));
#define DEV __device__ __forceinline__
#define PHASE __device__ __forceinline__

#ifndef SINGLE_LAUNCH
#define SINGLE_LAUNCH 1
#endif

constexpr int T_TOK = 65536, DM = 1024, SEQ = 2048, US = 4864, ADAW = 6144, FFH = 2816;
constexpr size_t WIN = 0, WBA = 8650752, WBB = 9175040, WBC = 9699328, WOUT = 10223616, WFI = 11272192,
                 WFO = 17039360, WLAYER = 19922944;
constexpr int SMEM_BYTES = 80896;
constexpr int NPHASE = 20;

struct Params {
  const float* x; const float* c; const int* pos;
  const float *ada_w, *ada_b, *norm_mix_w, *norm_ffn_w, *w_in, *da_lambda, *da_subln_w, *hg_lb, *hg_norm_w;
  const float *rw_mu, *rw_w0, *rw_w2, *rw_a0, *rw_a2, *rw_g2, *rw_k_k, *rw_k_a, *rw_r_k, *rw_gn_w, *rw_gn_b;
  const float *rw_v0, *rw_v1, *rw_v2, *w_br_a, *w_br_b, *w_br_c, *w_out, *ffn_w_in, *ffn_w_out, *final_norm_w;
  float* out;
  bf16_t* wt; float* ada; bf16_t* h; bf16_t* u; bf16_t* vT; bf16_t* vfirst; float* vlo; unsigned* counters;
};

DEV unsigned short f2bf(float f) { unsigned u = __float_as_uint(f); u += 0x7FFFu + ((u >> 16) & 1u); return (unsigned short)(u >> 16); }
DEV float bf2f(unsigned short h) { return __uint_as_float(((unsigned)h) << 16); }
DEV unsigned pack2(float a, float b) { return (unsigned)f2bf(a) | ((unsigned)f2bf(b) << 16); }
DEV float sigm(float x) { return 1.f / (1.f + __expf(-x)); }
DEV float lo16(unsigned v) { return __uint_as_float(v << 16); }
DEV float hi16(unsigned v) { return __uint_as_float(v & 0xFFFF0000u); }
#define UNPACK8(v, f) { f[0]=lo16(v.x); f[1]=hi16(v.x); f[2]=lo16(v.y); f[3]=hi16(v.y); f[4]=lo16(v.z); f[5]=hi16(v.z); f[6]=lo16(v.w); f[7]=hi16(v.w); }
#define PACK8(f) make_uint4(pack2(f[0],f[1]), pack2(f[2],f[3]), pack2(f[4],f[5]), pack2(f[6],f[7]))
template <int CTRL> DEV float dpp(float x) { return __int_as_float(__builtin_amdgcn_update_dpp(0, __float_as_int(x), CTRL, 0xF, 0xF, true)); }
DEV float red8_sum(float x) { x += dpp<0xB1>(x); x += dpp<0x4E>(x); x += dpp<0x141>(x); return x; }
DEV float red16_sum(float x) { x = red8_sum(x); x += dpp<0x140>(x); return x; }
DEV float red16_max(float x) { x = fmaxf(x, dpp<0xB1>(x)); x = fmaxf(x, dpp<0x4E>(x)); x = fmaxf(x, dpp<0x141>(x)); x = fmaxf(x, dpp<0x140>(x)); return x; }
DEV float wave_sum(float x) {
  x = red16_sum(x);
  const int xi = __float_as_int(x);
  return __int_as_float(__builtin_amdgcn_readlane(xi, 0)) + __int_as_float(__builtin_amdgcn_readlane(xi, 16)) +
         __int_as_float(__builtin_amdgcn_readlane(xi, 32)) + __int_as_float(__builtin_amdgcn_readlane(xi, 48));
}
DEV int opaque_tid() { int t = threadIdx.x & 255; asm volatile("" : "+v"(t)); return t; }
DEV int opaque_tid512() { int t = threadIdx.x; asm volatile("" : "+v"(t)); return t; }
DEV int vhalf() { return __builtin_amdgcn_readfirstlane((int)(threadIdx.x >> 8)); }
DEV int vblock() { return (int)blockIdx.x * 2 + vhalf(); }
DEV int vgrid() { return (int)gridDim.x * 2; }
DEV bf16x8 as_frag(uint4 v) { union { uint4 u; bf16x8 b; } c; c.u = v; return c.b; }
#define MFMA(a, b, c) __builtin_amdgcn_mfma_f32_16x16x32_bf16(a, b, c, 0, 0, 0)

template <int NT>
DEV void gemm_tile(const int tid_in, const bf16_t* A, int lda, const bf16_t* B, int ldb, int K, char* smem,
                   f32x4 (&acc)[4][NT]) {
  int tid = tid_in; asm volatile("" : "+v"(tid));
  constexpr int BN = NT * 32;
  constexpr int LS = 64;
  bf16_t* As = (bf16_t*)smem;
  bf16_t* Bs = As + 2 * 128 * LS;
  const int lane = tid & 63, wave = tid >> 6, wr = wave >> 1, wc = wave & 1;
  const int fr = lane & 15, fq = lane >> 4;
  constexpr int NB = BN * 8 / 256;
#pragma unroll
  for (int m = 0; m < 4; ++m)
#pragma unroll
    for (int n = 0; n < NT; ++n) acc[m][n] = (f32x4){0.f, 0.f, 0.f, 0.f};
  const int nk = K >> 6;
  const int lrow = tid >> 3, lcc = tid & 7;
  const bf16_t* Ap = A + (size_t)lrow * lda + ((lcc ^ (lrow & 7)) * 8);
  const bf16_t* Bp = B + (size_t)lrow * ldb + ((lcc ^ (lrow & 7)) * 8);
  const size_t a32 = (size_t)32 * lda, b32 = (size_t)32 * ldb;
  const int rofs0 = (fq ^ (fr & 7)) * 8, rofs1 = rofs0 ^ 32;
#define GT_DMA(buf, koff)                                                                                    \
  {                                                                                                          \
    bf16_t* Ad = As + (buf) * 128 * LS + tid * 8;                                                            \
    bf16_t* Bd = Bs + (buf) * BN * LS + tid * 8;                                                             \
    _Pragma("unroll") for (int i = 0; i < 4; ++i)                                                            \
      __builtin_amdgcn_global_load_lds((const unsigned*)(Ap + i * a32 + (koff)), (unsigned*)(Ad + i * 32 * LS), 16, 0, 0); \
    _Pragma("unroll") for (int i = 0; i < NB; ++i)                                                           \
      __builtin_amdgcn_global_load_lds((const unsigned*)(Bp + i * b32 + (koff)), (unsigned*)(Bd + i * 32 * LS), 16, 0, 0); \
  }
  GT_DMA(0, 0)
  asm volatile("s_waitcnt vmcnt(0)" ::: "memory");
  __syncthreads();
  for (int kt = 0; kt < nk; ++kt) {
    const int buf = kt & 1;
    if (kt + 1 < nk) GT_DMA(buf ^ 1, (kt + 1) * 64)
    const bf16_t* Ab = As + buf * 128 * LS + (wr * 64 + fr) * LS;
    const bf16_t* Bb = Bs + buf * BN * LS + (wc * (NT * 16) + fr) * LS;
#pragma unroll
    for (int ks = 0; ks < 2; ++ks) {
      const int ro = ks ? rofs1 : rofs0;
      bf16x8 af[4], bfr[NT];
#pragma unroll
      for (int m = 0; m < 4; ++m) af[m] = *(const bf16x8*)(Ab + m * 16 * LS + ro);
#pragma unroll
      for (int n = 0; n < NT; ++n) bfr[n] = *(const bf16x8*)(Bb + n * 16 * LS + ro);
#pragma unroll
      for (int m = 0; m < 4; ++m)
#pragma unroll
        for (int n = 0; n < NT; ++n) acc[m][n] = MFMA(af[m], bfr[n], acc[m][n]);
    }
    asm volatile("s_waitcnt vmcnt(0)" ::: "memory");
    __syncthreads();
  }
#undef GT_DMA
}

template <int NT>
DEV void stage_acc(const int tid, float* Cs, const f32x4 (&acc)[4][NT]) {
  constexpr int LDC = NT * 32 + 4;
  const int lane = tid & 63, wave = tid >> 6, wr = wave >> 1, wc = wave & 1, fr = lane & 15, fq = lane >> 4;
#pragma unroll
  for (int m = 0; m < 4; ++m)
#pragma unroll
    for (int n = 0; n < NT; ++n)
#pragma unroll
      for (int j = 0; j < 4; ++j) Cs[(wr * 64 + m * 16 + fq * 4 + j) * LDC + wc * (NT * 16) + n * 16 + fr] = acc[m][n][j];
}

DEV void gemm_tile256(const int tid, const bf16_t* A, int lda, const bf16_t* B, int ldb, int K, char* smem,
                      f32x4 (&acc)[8][4]) {
  bf16_t* As = (bf16_t*)smem;
  bf16_t* Bs = As + 3 * 8192;
  const int lane = tid & 63, wave = tid >> 6, wr = wave >> 1, wc = wave & 1;
  const int fr = lane & 15, fq = lane >> 4;
#pragma unroll
  for (int m = 0; m < 8; ++m)
#pragma unroll
    for (int n = 0; n < 4; ++n) acc[m][n] = (f32x4){0.f, 0.f, 0.f, 0.f};
  const int nk = K >> 5;
  const int drow = tid >> 2, dphys = tid & 3, dg = (0 - (tid >> 4)) & 3;
  const bf16_t* Ap = A + (size_t)drow * lda + ((dphys ^ dg) * 8);
  const bf16_t* Bp = B + (size_t)drow * ldb + ((dphys ^ dg) * 8);
  const size_t a64 = (size_t)64 * lda, b64 = (size_t)64 * ldb;
  const int rofs = (fq ^ ((0 - (fr >> 2)) & 3)) * 8;
#define G2_DMA(st, kk)                                                                                        \
  {                                                                                                           \
    bf16_t* Ad = As + (st) * 8192 + tid * 8;                                                                  \
    bf16_t* Bd = Bs + (st) * 4096 + tid * 8;                                                                  \
    _Pragma("unroll") for (int i = 0; i < 4; ++i)                                                             \
      __builtin_amdgcn_global_load_lds((const unsigned*)(Ap + i * a64 + (kk) * 32), (unsigned*)(Ad + i * 2048), 16, 0, 0); \
    _Pragma("unroll") for (int i = 0; i < 2; ++i)                                                             \
      __builtin_amdgcn_global_load_lds((const unsigned*)(Bp + i * b64 + (kk) * 32), (unsigned*)(Bd + i * 2048), 16, 0, 0); \
  }
  G2_DMA(0, 0)
  G2_DMA(1, 1)
  int st = 0;
  for (int kt = 0; kt < nk; ++kt) {
    if (kt + 1 < nk) asm volatile("s_waitcnt vmcnt(6)" ::: "memory");
    else asm volatile("s_waitcnt vmcnt(0)" ::: "memory");
    __builtin_amdgcn_s_barrier();
    asm volatile("" ::: "memory");
    const int s2 = (st >= 1) ? st - 1 : 2;
    const bool pf = (kt + 2 < nk);
    bf16_t* Ad = As + s2 * 8192 + tid * 8;
    bf16_t* Bd = Bs + s2 * 4096 + tid * 8;
    const bf16_t* Asrc = Ap + (kt + 2) * 32;
    const bf16_t* Bsrc = Bp + (kt + 2) * 32;
    const bf16_t* Ab = As + st * 8192 + (wr * 128 + fr) * 32 + rofs;
    const bf16_t* Bb = Bs + st * 4096 + (wc * 64 + fr) * 32 + rofs;
    bf16x8 bfr[4], af[4];
#pragma unroll
    for (int n = 0; n < 4; ++n) bfr[n] = *(const bf16x8*)(Bb + n * 512);
#pragma unroll
    for (int m = 0; m < 4; ++m) af[m] = *(const bf16x8*)(Ab + m * 512);
#pragma unroll
    for (int m = 0; m < 8; ++m) {
#pragma unroll
      for (int n = 0; n < 4; ++n) acc[m][n] = MFMA(af[m & 3], bfr[n], acc[m][n]);
      if (m + 4 < 8) af[m & 3] = *(const bf16x8*)(Ab + (m + 4) * 512);
      if (pf) {
        if (m < 4) __builtin_amdgcn_global_load_lds((const unsigned*)(Asrc + m * a64), (unsigned*)(Ad + m * 2048), 16, 0, 0);
        else if (m < 6) __builtin_amdgcn_global_load_lds((const unsigned*)(Bsrc + (m - 4) * b64), (unsigned*)(Bd + (m - 4) * 2048), 16, 0, 0);
      }
      __builtin_amdgcn_sched_barrier(0);
    }
    st = (st == 2) ? 0 : st + 1;
  }
#undef G2_DMA
  __syncthreads();
}

template <int PS>
DEV void stage_half(const int tid, float* Cs, const f32x4 (&acc)[8][4]) {
  const int lane = tid & 63, wave = tid >> 6, wr = wave >> 1, wc = wave & 1, fr = lane & 15, fq = lane >> 4;
#pragma unroll
  for (int m = 0; m < 4; ++m)
#pragma unroll
    for (int n = 0; n < 4; ++n)
#pragma unroll
      for (int j = 0; j < 4; ++j) Cs[(wr * 64 + m * 16 + fq * 4 + j) * 132 + wc * 64 + n * 16 + fr] = acc[PS * 4 + m][n][j];
}
#define RMAP(r, ps) ((((r) >> 6) << 7) + (ps) * 64 + ((r) & 63))

DEV void gemm_tile512(const int T, const bf16_t* A, int lda, const bf16_t* B, int ldb, int K, char* smem0,
                      f32x4 (&acc)[8][4]) {
  bf16_t* As = (bf16_t*)smem0;
  bf16_t* Bs = As + 2 * 16384;
  const int lane = T & 63, wave = T >> 6, wr = wave >> 2, wc = wave & 3;
  const int fr = lane & 15, fq = lane >> 4;
#pragma unroll
  for (int m = 0; m < 8; ++m)
#pragma unroll
    for (int n = 0; n < 4; ++n) acc[m][n] = (f32x4){0.f, 0.f, 0.f, 0.f};
  const int nk = K >> 6;
  const int drow = T >> 3, dlog = ((T & 7) ^ ((T >> 3) & 7)) * 8;
  const bf16_t* Ap = A + (size_t)drow * lda + dlog;
  const bf16_t* Bp = B + (size_t)drow * ldb + dlog;
  const size_t a64 = (size_t)64 * lda, b64 = (size_t)64 * ldb;
  const int rofs0 = (fq ^ (fr & 7)) * 8, rofs1 = rofs0 ^ 32;
#pragma unroll
  for (int i = 0; i < 4; ++i) {
    __builtin_amdgcn_global_load_lds((const unsigned*)(Ap + i * a64), (unsigned*)(As + T * 8 + i * 4096), 16, 0, 0);
    __builtin_amdgcn_global_load_lds((const unsigned*)(Bp + i * b64), (unsigned*)(Bs + T * 8 + i * 4096), 16, 0, 0);
  }
  asm volatile("s_waitcnt vmcnt(0)" ::: "memory");
  __syncthreads();
  for (int kt = 0; kt < nk; ++kt) {
    const int buf = kt & 1;
    const bool pf = (kt + 1 < nk);
    bf16_t* Ad = As + (buf ^ 1) * 16384 + T * 8;
    bf16_t* Bd = Bs + (buf ^ 1) * 16384 + T * 8;
    const bf16_t* Asrc = Ap + (kt + 1) * 64;
    const bf16_t* Bsrc = Bp + (kt + 1) * 64;
    const bf16_t* Ab = As + buf * 16384 + (wr * 128 + fr) * 64;
    const bf16_t* Bb = Bs + buf * 16384 + (wc * 64 + fr) * 64;
#pragma unroll
    for (int ks = 0; ks < 2; ++ks) {
      const int ro = ks ? rofs1 : rofs0;
      bf16x8 bfr[4], af[4];
#pragma unroll
      for (int n = 0; n < 4; ++n) bfr[n] = *(const bf16x8*)(Bb + n * 1024 + ro);
#pragma unroll
      for (int m = 0; m < 4; ++m) af[m] = *(const bf16x8*)(Ab + m * 1024 + ro);
#pragma unroll
      for (int m = 0; m < 8; ++m) {
#pragma unroll
        for (int n = 0; n < 4; ++n) acc[m][n] = MFMA(af[m & 3], bfr[n], acc[m][n]);
        if (m + 4 < 8) af[m & 3] = *(const bf16x8*)(Ab + (m + 4) * 1024 + ro);
        if (pf && (m & 1)) {
          const int piece = ks * 4 + (m >> 1);
          if (piece < 4) __builtin_amdgcn_global_load_lds((const unsigned*)(Asrc + piece * a64), (unsigned*)(Ad + piece * 4096), 16, 0, 0);
          else __builtin_amdgcn_global_load_lds((const unsigned*)(Bsrc + (piece - 4) * b64), (unsigned*)(Bd + (piece - 4) * 4096), 16, 0, 0);
        }
        __builtin_amdgcn_sched_barrier(0);
      }
    }
    asm volatile("s_waitcnt vmcnt(0)" ::: "memory");
    __builtin_amdgcn_s_barrier();
    asm volatile("" ::: "memory");
  }
  __syncthreads();
}
template <int PS>
DEV void stage_half512(const int T, float* Cs, const f32x4 (&acc)[8][4]) {
  const int lane = T & 63, wave = T >> 6, wc = wave & 3, fr = lane & 15, fq = lane >> 4;
#pragma unroll
  for (int m = 0; m < 4; ++m)
#pragma unroll
    for (int n = 0; n < 4; ++n)
#pragma unroll
      for (int j = 0; j < 4; ++j) Cs[((wc >> 1) * 64 + m * 16 + fq * 4 + j) * 132 + (wc & 1) * 64 + n * 16 + fr] = acc[PS * 4 + m][n][j];
}
#define GROW(r, ps) (row0 + (size_t)(hf * 128 + (ps) * 64 + ((r) & 63)))
#define TNC(r) (tn * 2 + ((r) >> 6))

DEV bool tile_for(int it, int nM, int nN, int& tm, int& tn) {
  const int nx = (gridDim.x >> 3) * 2;
  const int xcd = blockIdx.x & 7, local = (blockIdx.x >> 3) * 2 + vhalf();
  const long id = ((long)it * 8 + xcd) * nx + local;
  if (local >= nx || id >= (long)nM * nN) return false;
  const int per_group = 8 * nN;
  const int g = (int)(id / per_group), r = (int)(id % per_group);
  tn = r >> 3; tm = g * 8 + (r & 7);
  return true;
}

DEV bool tile_for_real(int it, int nM, int nN, int& tm, int& tn) {
  const int nx = (gridDim.x >> 3);
  const int xcd = blockIdx.x & 7, local = (blockIdx.x >> 3);
  const long id = ((long)it * 8 + xcd) * nx + local;
  if (local >= nx || id >= (long)nM * nN) return false;
  const int per_group = 8 * nN;
  const int g = (int)(id / per_group), r = (int)(id % per_group);
  tn = r >> 3; tm = g * 8 + (r & 7);
  return true;
}

PHASE void phase_prep(const Params& p, char* smem) {
  const int tid = opaque_tid();
  const int vb = vblock(), vg = vgrid();
  if (vb == 0 && tid < 8) p.counters[tid] = 0u;
  if (vb == 0) for (int i = tid; i < 3456; i += 256) p.counters[256 + i] = 0u;
  float* tile = (float*)smem;
  const int NCONV = 2 * 4864, NADA = 192;
  for (int item0 = vb; item0 < NCONV + NADA; item0 += vg) {
    const int item = (item0 < NADA) ? (NCONV + item0) : (item0 - NADA);
    if (item < NCONV) {
      const int l = item / 4864; int r = item % 4864;
      const float* src; int K, Nsrc, nT, perm = 0; size_t dst;
      if (r < 2112) { src = p.w_in + (size_t)l * 1024 * 8448; K = 1024; Nsrc = 8448; dst = WIN; nT = 132; }
      else if (r < 2240) { r -= 2112; src = p.w_br_a + (size_t)l * 512 * 1024; K = 512; Nsrc = 1024; dst = WBA; nT = 16; }
      else if (r < 2368) { r -= 2240; src = p.w_br_b + (size_t)l * 512 * 1024; K = 512; Nsrc = 1024; dst = WBB; nT = 16; }
      else if (r < 2496) { r -= 2368; src = p.w_br_c + (size_t)l * 512 * 1024; K = 512; Nsrc = 1024; dst = WBC; nT = 16; }
      else if (r < 2752) { r -= 2496; src = p.w_out + (size_t)l * 1024 * 1024; K = 1024; Nsrc = 1024; dst = WOUT; nT = 16; }
      else if (r < 4160) { r -= 2752; src = p.ffn_w_in + (size_t)l * 1024 * 5632; K = 1024; Nsrc = 5632; dst = WFI; nT = 88; perm = 1; }
      else { r -= 4160; src = p.ffn_w_out + (size_t)l * 2816 * 1024; K = 2816; Nsrc = 1024; dst = WFO; nT = 16; }
      const int kt = r / nT, nt = r % nT;
      const int colbase = perm ? ((nt & 1) * FFH + 64 * (nt >> 1)) : nt * 64;
      __syncthreads();
#pragma unroll
      for (int i = 0; i < 16; ++i) {
        const int k = i * 4 + (tid >> 6), j = tid & 63;
        tile[k * 65 + j] = src[(size_t)(kt * 64 + k) * Nsrc + colbase + j];
      }
      __syncthreads();
      const int row = tid >> 2, kc = (tid & 3) * 16;
      float f[16];
#pragma unroll
      for (int i = 0; i < 16; ++i) f[i] = tile[(kc + i) * 65 + row];
      bf16_t* d = p.wt + (size_t)l * WLAYER + dst + (size_t)(nt * 64 + row) * K + kt * 64 + kc;
      *(uint4*)d = make_uint4(pack2(f[0], f[1]), pack2(f[2], f[3]), pack2(f[4], f[5]), pack2(f[6], f[7]));
      *(uint4*)(d + 8) = make_uint4(pack2(f[8], f[9]), pack2(f[10], f[11]), pack2(f[12], f[13]), pack2(f[14], f[15]));
    } else {
      const int a = item - NCONV;
      const int l = a / 96, r = a % 96, ntile = r >> 2, bg = r & 3;
      float* cact = (float*)smem;
      __syncthreads();
      for (int i = tid; i < 8 * 1024; i += 256) {
        const float cv = p.c[(size_t)(bg * 8 + (i >> 10)) * DM + (i & 1023)];
        cact[i] = cv * sigm(cv);
      }
      __syncthreads();
      const int n = ntile * 256 + tid;
      const float* W = p.ada_w + (size_t)l * DM * ADAW + n;
      float acc[8];
#pragma unroll
      for (int b = 0; b < 8; ++b) acc[b] = 0.f;
      for (int k0 = 0; k0 < DM; k0 += 16) {
        float w[16];
#pragma unroll
        for (int kk = 0; kk < 16; ++kk) w[kk] = W[(size_t)(k0 + kk) * ADAW];
#pragma unroll
        for (int kk = 0; kk < 16; ++kk)
#pragma unroll
          for (int b = 0; b < 8; ++b) acc[b] += cact[b * 1024 + k0 + kk] * w[kk];
      }
      const float bias = p.ada_b[l * ADAW + n];
#pragma unroll
      for (int b = 0; b < 8; ++b) p.ada[((size_t)l * 32 + bg * 8 + b) * ADAW + n] = acc[b] + bias;
    }
  }
}

PHASE void phase_norm(const float* __restrict__ x, const float* __restrict__ w, const float* __restrict__ ada_l,
                    int shift_off, int scale_off, bf16_t* __restrict__ h) {
  const int tid = opaque_tid();
  const int lane = tid & 63, wave = tid >> 6;
  for (int row0 = (vblock() * 4 + wave) * 4; row0 < T_TOK; row0 += vgrid() * 16) {
    float4 v[4][4]; float ss[4];
#pragma unroll
    for (int rr = 0; rr < 4; ++rr)
#pragma unroll
      for (int i = 0; i < 4; ++i) v[rr][i] = *(const float4*)(x + (size_t)(row0 + rr) * DM + i * 256 + lane * 4);
#pragma unroll
    for (int rr = 0; rr < 4; ++rr) {
      float a = 0.f;
#pragma unroll
      for (int i = 0; i < 4; ++i) a += v[rr][i].x * v[rr][i].x + v[rr][i].y * v[rr][i].y + v[rr][i].z * v[rr][i].z + v[rr][i].w * v[rr][i].w;
      ss[rr] = rsqrtf(wave_sum(a) * (1.f / DM) + 1e-6f);
    }
    const float* ad = ada_l + (size_t)(row0 / SEQ) * ADAW;
#pragma unroll
    for (int i = 0; i < 4; ++i) {
      const int col = i * 256 + lane * 4;
      const float4 ww = *(const float4*)(w + col), sc = *(const float4*)(ad + scale_off + col), sh = *(const float4*)(ad + shift_off + col);
#pragma unroll
      for (int rr = 0; rr < 4; ++rr) {
        const float rstd = ss[rr];
        const float o0 = v[rr][i].x * rstd * ww.x * (1.f + sc.x) + sh.x, o1 = v[rr][i].y * rstd * ww.y * (1.f + sc.y) + sh.y;
        const float o2 = v[rr][i].z * rstd * ww.z * (1.f + sc.z) + sh.z, o3 = v[rr][i].w * rstd * ww.w * (1.f + sc.w) + sh.w;
        *(uint2*)(h + (size_t)(row0 + rr) * DM + col) = make_uint2(pack2(o0, o1), pack2(o2, o3));
      }
    }
  }
}

PHASE void phase_final(float* __restrict__ x, const float* __restrict__ w) {
  const int tid = opaque_tid();
  const int lane = tid & 63, wave = tid >> 6;
  for (int row0 = (vblock() * 4 + wave) * 4; row0 < T_TOK; row0 += vgrid() * 16) {
    float4 v[4][4]; float ss[4];
#pragma unroll
    for (int rr = 0; rr < 4; ++rr)
#pragma unroll
      for (int i = 0; i < 4; ++i) v[rr][i] = *(const float4*)(x + (size_t)(row0 + rr) * DM + i * 256 + lane * 4);
#pragma unroll
    for (int rr = 0; rr < 4; ++rr) {
      float a = 0.f;
#pragma unroll
      for (int i = 0; i < 4; ++i) a += v[rr][i].x * v[rr][i].x + v[rr][i].y * v[rr][i].y + v[rr][i].z * v[rr][i].z + v[rr][i].w * v[rr][i].w;
      ss[rr] = rsqrtf(wave_sum(a) * (1.f / DM) + 1e-6f);
    }
#pragma unroll
    for (int i = 0; i < 4; ++i) {
      const int col = i * 256 + lane * 4;
      const float4 ww = *(const float4*)(w + col);
#pragma unroll
      for (int rr = 0; rr < 4; ++rr) {
        const float rstd = ss[rr];
        *(float4*)(x + (size_t)(row0 + rr) * DM + col) =
            make_float4(v[rr][i].x * rstd * ww.x, v[rr][i].y * rstd * ww.y, v[rr][i].z * rstd * ww.z, v[rr][i].w * rstd * ww.w);
      }
    }
  }
}

PHASE void phase_gemm_in(const Params& p, int l, char* smem0) {
  const bf16_t* Wt = p.wt + (size_t)l * WLAYER + WIN;
  const int T = opaque_tid512(), tid = T & 255, hf = vhalf();
  float* Cs = (float*)(smem0 + hf * SMEM_BYTES);
  for (int it = 0;; ++it) {
    int tm, tn;
    if (!tile_for_real(it, 256, 21, tm, tn)) break;
    f32x4 acc[8][4];
    gemm_tile512(T, p.h + (size_t)tm * 256 * DM, DM, Wt + (size_t)tn * 256 * DM, DM, DM, smem0, acc);
    const size_t row0 = (size_t)tm * 256;
#pragma unroll
    for (int ps = 0; ps < 2; ++ps) {
      if (ps == 0) stage_half512<0>(T, Cs, acc); else stage_half512<1>(T, Cs, acc);
      __syncthreads();
      if (tn < 4) {
        const float qs = (tn < 2) ? 0.125f : 1.f;
        const int ch = tid & 15, g = ch >> 3, cc = ch & 7;
        if (cc < 4) {
#pragma unroll 1
          for (int i = 0; i < 8; ++i) {
            const int r = (tid >> 4) + i * 16;
            const size_t grow = GROW(r, ps);
            const float pos = (float)p.pos[grow];
            const float* c1 = Cs + r * 132 + g * 64 + cc * 8;
            float o1[8], o2[8];
#pragma unroll
            for (int e = 0; e < 8; ++e) {
              const float x1 = c1[e], x2 = c1[32 + e];
              const float inv = exp2f(-(float)(cc * 8 + e) * 0.41524101186092029f);
              float rev = pos * inv * 0.15915494309189535f;
              rev -= rintf(rev);
              const float sn = __builtin_amdgcn_sinf(rev), cs = __builtin_amdgcn_cosf(rev);
              o1[e] = (x1 * cs - x2 * sn) * qs; o2[e] = (x2 * cs + x1 * sn) * qs;
            }
            bf16_t* d = p.u + grow * US + TNC(r) * 128 + g * 64 + cc * 8;
            *(uint4*)d = PACK8(o1);
            *(uint4*)(d + 32) = PACK8(o2);
          }
        }
      } else if (tn < 6) {
        const int b = (int)(row0 / SEQ), s0 = (int)(row0 % SEQ);
        const int rch = tid & 15;
        const int vc0 = (TNC(rch * 8) - 8) * 128;
#pragma unroll 1
        for (int i = 0; i < 8; ++i) {
          const int c = (tid >> 4) + i * 16;
          float f[8];
#pragma unroll
          for (int j = 0; j < 8; ++j) f[j] = Cs[(rch * 8 + j) * 132 + c];
          *(uint4*)(p.vT + ((size_t)b * 512 + vc0 + c) * SEQ + s0 + hf * 128 + ps * 64 + ((rch * 8) & 63)) = PACK8(f);
        }
      } else {
        const int ch = tid & 15;
#pragma unroll 1
        for (int i = 0; i < 8; ++i) {
          const int r = (tid >> 4) + i * 16;
          const float4 a = *(const float4*)(Cs + r * 132 + ch * 8), b = *(const float4*)(Cs + r * 132 + ch * 8 + 4);
          *(uint4*)(p.u + GROW(r, ps) * US + TNC(r) * 128 - 512 + ch * 8) = make_uint4(pack2(a.x, a.y), pack2(a.z, a.w), pack2(b.x, b.y), pack2(b.z, b.w));
        }
      }
      __syncthreads();
    }
  }
}

PHASE void phase_vlo(const Params& p, int l, char* smem) {
  float* vs = (float*)smem;
  const int tid = opaque_tid();
  const float* mu = p.rw_mu + (size_t)l * 1792 + 1024;
  const float* v1 = p.rw_v1;
  for (int item = vblock(); item < T_TOK / 32; item += vgrid()) {
    const size_t tok0 = (size_t)item * 32;
    __syncthreads();
#pragma unroll 1
    for (int i = 0; i < 8; ++i) {
      const int c = tid + i * 256;
      const int t = c >> 6, cc = c & 63;
      const size_t tok = tok0 + t;
      const uint4 cur = *(const uint4*)(p.u + tok * US + 3072 + 1024 + cc * 8);
      uint4 prv = make_uint4(0, 0, 0, 0);
      if ((tok % SEQ) != 0) prv = *(const uint4*)(p.u + (tok - 1) * US + 3072 + 1024 + cc * 8);
      float a[8], b[8];
      UNPACK8(cur, a); UNPACK8(prv, b);
#pragma unroll
      for (int e = 0; e < 8; ++e) vs[t * 512 + cc * 8 + e] = a[e] + (b[e] - a[e]) * mu[cc * 8 + e];
    }
    __syncthreads();
    const int j = tid & 31, tg = tid >> 5;
    float acc[4] = {0.f, 0.f, 0.f, 0.f};
    for (int k0 = 0; k0 < 512; k0 += 16) {
      float w[16];
#pragma unroll
      for (int kk = 0; kk < 16; ++kk) w[kk] = v1[(k0 + kk) * 32 + j];
#pragma unroll
      for (int kk = 0; kk < 16; ++kk)
#pragma unroll
        for (int i = 0; i < 4; ++i) acc[i] += vs[(tg * 4 + i) * 512 + k0 + kk] * w[kk];
    }
#pragma unroll
    for (int i = 0; i < 4; ++i) p.vlo[(tok0 + tg * 4 + i) * 32 + j] = acc[i];
  }
}

PHASE void att_item(const Params& p, int l, int item, char* smem) {
  const int qc = 31 - (item >> 7);
  const int bh = item & 127, b = bh >> 2, h = bh & 3;
  const int tid = opaque_tid(), lane = tid & 63, wave = tid >> 6, fr = lane & 15, fq = lane >> 4;
  const int m = wave >> 1, rh = wave & 1;
  bf16_t* Ks = (bf16_t*)smem;
  bf16_t* Vt = Ks + 2 * 64 * 64;
  bf16_t* Ps = Vt + 128 * 64;
  float* Ox = (float*)smem;
  const size_t tok0 = (size_t)b * SEQ + (size_t)qc * 64;
  const float* lv = p.da_lambda + (size_t)l * 256;
  float d1 = 0.f, d2 = 0.f;
  for (int i = 0; i < 64; ++i) { d1 += lv[i] * lv[64 + i]; d2 += lv[128 + i] * lv[192 + i]; }
  const float lam_init = 0.8f - 0.6f * __expf(-0.3f * (float)l);
  const float lam = __expf(d1) - __expf(d2) + lam_init;

  bf16x8 qf[2][2];
#pragma unroll
  for (int mt = 0; mt < 2; ++mt)
#pragma unroll
    for (int ks = 0; ks < 2; ++ks)
      qf[mt][ks] = *(const bf16x8*)(p.u + (tok0 + rh * 32 + mt * 16 + fr) * US + h * 128 + m * 64 + ks * 32 + fq * 8);
  f32x4 o[2][8];
  float mx[2][4], ls[2][4];
#pragma unroll
  for (int mt = 0; mt < 2; ++mt) {
#pragma unroll
    for (int n = 0; n < 8; ++n) o[mt][n] = (f32x4){0.f, 0.f, 0.f, 0.f};
#pragma unroll
    for (int j = 0; j < 4; ++j) { mx[mt][j] = -1e30f; ls[mt][j] = 0.f; }
  }
  bf16_t* Pw = Ps + wave * 32 * 72;
  const int drow = tid >> 3, dlog = ((tid & 7) ^ ((tid >> 3) & 7)) * 8;
  const bf16_t* Kg = p.u + ((size_t)b * SEQ + (drow & 63)) * US + 512 + h * 128 + dlog;
  const bf16_t* Vg = p.vT + ((size_t)b * 512 + h * 128 + drow) * SEQ + dlog;
  const int rsw = fr & 7;
#define ATT_DMA_K(kt_)                                                                                              \
  _Pragma("unroll") for (int i = 0; i < 4; ++i)                                                                     \
    __builtin_amdgcn_global_load_lds((const unsigned*)(Kg + ((size_t)(kt_) * 64 + (i & 1) * 32) * US + (i >> 1) * 64), \
                                     (unsigned*)(Ks + tid * 8 + i * 2048), 16, 0, 0);
#define ATT_DMA_V(kt_)                                                                                              \
  _Pragma("unroll") for (int i = 0; i < 4; ++i)                                                                     \
    __builtin_amdgcn_global_load_lds((const unsigned*)(Vg + (size_t)(i * 32) * SEQ + (kt_) * 64),                  \
                                     (unsigned*)(Vt + tid * 8 + i * 2048), 16, 0, 0);
  __syncthreads();
  ATT_DMA_K(0)
  for (int kt = 0; kt <= qc; ++kt) {
    asm volatile("s_waitcnt vmcnt(0)" ::: "memory");
    __syncthreads();
    ATT_DMA_V(kt)
    f32x4 s[2][4];
#pragma unroll
    for (int mt = 0; mt < 2; ++mt)
#pragma unroll
      for (int n = 0; n < 4; ++n) s[mt][n] = (f32x4){0.f, 0.f, 0.f, 0.f};
#pragma unroll
    for (int ks = 0; ks < 2; ++ks)
#pragma unroll
      for (int n = 0; n < 4; ++n) {
        const bf16x8 kf = *(const bf16x8*)(Ks + (m * 64 + n * 16 + fr) * 64 + (((ks * 4 + fq) ^ rsw) * 8));
#pragma unroll
        for (int mt = 0; mt < 2; ++mt) s[mt][n] = MFMA(qf[mt][ks], kf, s[mt][n]);
      }
#pragma unroll
    for (int mt = 0; mt < 2; ++mt)
#pragma unroll
      for (int j = 0; j < 4; ++j) {
        float tmax = fmaxf(fmaxf(s[mt][0][j], s[mt][1][j]), fmaxf(s[mt][2][j], s[mt][3][j]));
        tmax = red16_max(tmax);
        const float mnew = fmaxf(mx[mt][j], tmax);
        const float alpha = __expf(mx[mt][j] - mnew);
        float rs = 0.f;
#pragma unroll
        for (int n = 0; n < 4; ++n) {
          const float pv = __expf(s[mt][n][j] - mnew);
          rs += pv;
          Pw[(mt * 16 + fq * 4 + j) * 72 + n * 16 + fr] = f2bf(pv);
        }
        rs = red16_sum(rs);
        ls[mt][j] = ls[mt][j] * alpha + rs;
        mx[mt][j] = mnew;
#pragma unroll
        for (int n = 0; n < 8; ++n) o[mt][n][j] *= alpha;
      }
    asm volatile("s_waitcnt vmcnt(0)" ::: "memory");
    __syncthreads();
    if (kt < qc) { ATT_DMA_K(kt + 1) }
#pragma unroll
    for (int ks = 0; ks < 2; ++ks) {
      bf16x8 pf[2];
#pragma unroll
      for (int mt = 0; mt < 2; ++mt) pf[mt] = *(const bf16x8*)(Pw + (mt * 16 + fr) * 72 + ks * 32 + fq * 8);
#pragma unroll
      for (int n = 0; n < 8; ++n) {
        const bf16x8 vf = *(const bf16x8*)(Vt + (n * 16 + fr) * 64 + (((ks * 4 + fq) ^ rsw) * 8));
#pragma unroll
        for (int mt = 0; mt < 2; ++mt) o[mt][n] = MFMA(pf[mt], vf, o[mt][n]);
      }
    }
  }
#undef ATT_DMA_K
#undef ATT_DMA_V
  __syncthreads();
#pragma unroll
  for (int mt = 0; mt < 2; ++mt)
#pragma unroll
    for (int j = 0; j < 4; ++j) {
      const float inv = 1.f / ls[mt][j];
#pragma unroll
      for (int n = 0; n < 8; ++n) o[mt][n][j] *= inv;
    }
  if (m == 1) {
#pragma unroll
    for (int mt = 0; mt < 2; ++mt)
#pragma unroll
      for (int n = 0; n < 8; ++n)
#pragma unroll
        for (int j = 0; j < 4; ++j) Ox[(rh * 32 + mt * 16 + fq * 4 + j) * 132 + n * 16 + fr] = o[mt][n][j];
  }
  __syncthreads();
  if (m == 0) {
    const float* sw = p.da_subln_w + (size_t)l * 128;
    float wv[8];
#pragma unroll
    for (int n = 0; n < 8; ++n) wv[n] = sw[n * 16 + fr] * (1.f - lam_init);
#pragma unroll
    for (int mt = 0; mt < 2; ++mt)
#pragma unroll
      for (int j = 0; j < 4; ++j) {
        float ss = 0.f;
        float d[8];
#pragma unroll
        for (int n = 0; n < 8; ++n) {
          d[n] = o[mt][n][j] - lam * Ox[(rh * 32 + mt * 16 + fq * 4 + j) * 132 + n * 16 + fr];
          ss += d[n] * d[n];
        }
        ss = red16_sum(ss);
        const float rstd = rsqrtf(ss * (1.f / 128.f) + 1e-6f);
        bf16_t* dst = p.u + (tok0 + rh * 32 + mt * 16 + fq * 4 + j) * US + h * 128 + fr;
#pragma unroll
        for (int n = 0; n < 8; ++n) dst[n * 16] = f2bf(d[n] * rstd * wv[n]);
      }
  }
  __syncthreads();
}

PHASE void hgrn_item(const Params& p, int l, int item, char* smem) {
  const int b = item >> 2, h = item & 3;
  const int tid = opaque_tid(), lane = tid & 63, wave = tid >> 6, fr = lane & 15, fq = lane >> 4;
  bf16_t* Qs = (bf16_t*)smem;
  bf16_t* Kn = Qs + 32 * 136;
  bf16_t* KT = Kn + 32 * 136;
  bf16_t* VT = KT + 128 * 40;
  bf16_t* Ps = VT + 128 * 40;
  bf16_t* ST = Ps + 32 * 40;
  float* lfb = (float*)ST;
  float* red = (float*)(ST + 128 * 136);
  float* blast = red + 64;
  const int t_ = tid >> 3, d0 = (tid & 7) * 16;
  float lbv[16];
#pragma unroll
  for (int i = 0; i < 16; ++i) {
    const int c = h * 128 + d0 + i;
    lbv[i] = (l == 0) ? 0.f : sigm(p.hg_lb[512 + c] - p.hg_lb[c]);
  }
  f32x4 S[2][8];
#pragma unroll
  for (int mm = 0; mm < 2; ++mm)
#pragma unroll
    for (int n = 0; n < 8; ++n) S[mm][n] = (f32x4){0.f, 0.f, 0.f, 0.f};
  const float* nw = p.hg_norm_w + (size_t)l * 128;

  for (int ch = 0; ch < 64; ++ch) {
    const size_t tok0 = (size_t)b * SEQ + (size_t)ch * 32;
    __syncthreads();
    float qv[16], kv[16];
    {
      const bf16_t* base = p.u + (tok0 + t_) * US + h * 128 + d0;
      float zv[16], iv[16];
      { const uint4 a = *(const uint4*)(base + 1024), c = *(const uint4*)(base + 1024 + 8); float* z0 = zv; float* z1 = zv + 8; UNPACK8(a, z0); UNPACK8(c, z1); }
      { const uint4 a = *(const uint4*)(base + 1536), c = *(const uint4*)(base + 1536 + 8); float* z0 = iv; float* z1 = iv + 8; UNPACK8(a, z0); UNPACK8(c, z1); }
      { const uint4 a = *(const uint4*)(base + 2048), c = *(const uint4*)(base + 2048 + 8); float* z0 = qv; float* z1 = qv + 8; UNPACK8(a, z0); UNPACK8(c, z1); }
#pragma unroll
      for (int i = 0; i < 16; ++i) {
        const float z = zv[i], lb = lbv[i];
        const float ez = __expf(-fabsf(z));
        float lf;
        if (lb > 0.f) {
          const float sg = (z >= 0.f) ? 1.f / (1.f + ez) : ez / (1.f + ez);
          lf = __logf(lb + (1.f - lb) * sg);
        } else {
          lf = -(fmaxf(-z, 0.f) + __logf(1.f + ez));
        }
        const float sgn = (z >= 0.f) ? ez / (1.f + ez) : 1.f / (1.f + ez);
        kv[i] = (1.f - lb) * sgn;
        lfb[t_ * 128 + d0 + i] = lf;
        VT[(d0 + i) * 40 + t_] = f2bf(iv[i]);
      }
    }
    __syncthreads();
    if (tid < 128) {
      float v[32];
#pragma unroll
      for (int t = 0; t < 32; ++t) v[t] = lfb[t * 128 + tid];
      float bsum = 0.f;
#pragma unroll
      for (int t = 0; t < 32; ++t) { bsum += v[t]; lfb[t * 128 + tid] = bsum; }
      blast[tid] = bsum;
    }
    __syncthreads();
    {
      float qo[16], ko[16];
#pragma unroll
      for (int i = 0; i < 16; ++i) {
        const float bb = lfb[t_ * 128 + d0 + i];
        qo[i] = qv[i] * __expf(bb);
        ko[i] = kv[i] * __expf(fminf(-bb, 80.f));
        KT[(d0 + i) * 40 + t_] = f2bf(ko[i]);
      }
      float* q0 = qo; float* q1 = qo + 8; float* k0 = ko; float* k1 = ko + 8;
      *(uint4*)(Qs + t_ * 136 + d0) = PACK8(q0);
      *(uint4*)(Qs + t_ * 136 + d0 + 8) = PACK8(q1);
      *(uint4*)(Kn + t_ * 136 + d0) = PACK8(k0);
      *(uint4*)(Kn + t_ * 136 + d0 + 8) = PACK8(k1);
    }
    __syncthreads();
#pragma unroll
    for (int mm = 0; mm < 2; ++mm)
#pragma unroll
      for (int n = 0; n < 8; ++n)
        *(uint2*)(ST + (n * 16 + fr) * 136 + wave * 32 + mm * 16 + fq * 4) =
            make_uint2(pack2(S[mm][n][0], S[mm][n][1]), pack2(S[mm][n][2], S[mm][n][3]));
    {
      const int mt = wave >> 1, nt = wave & 1;
      f32x4 sc = (f32x4){0.f, 0.f, 0.f, 0.f};
#pragma unroll
      for (int ks = 0; ks < 4; ++ks) {
        const bf16x8 a = *(const bf16x8*)(Qs + (mt * 16 + fr) * 136 + ks * 32 + fq * 8);
        const bf16x8 bb = *(const bf16x8*)(Kn + (nt * 16 + fr) * 136 + ks * 32 + fq * 8);
        sc = MFMA(a, bb, sc);
      }
#pragma unroll
      for (int j = 0; j < 4; ++j) {
        const int t = mt * 16 + fq * 4 + j, key = nt * 16 + fr;
        Ps[t * 40 + key] = f2bf(key <= t ? sc[j] : 0.f);
      }
    }
    __syncthreads();
    {
      const int mt = wave & 1, nb = (wave >> 1) * 4;
      f32x4 oo[4];
#pragma unroll
      for (int n = 0; n < 4; ++n) oo[n] = (f32x4){0.f, 0.f, 0.f, 0.f};
      {
        const bf16x8 a = *(const bf16x8*)(Ps + (mt * 16 + fr) * 40 + fq * 8);
#pragma unroll
        for (int n = 0; n < 4; ++n) {
          const bf16x8 bb = *(const bf16x8*)(VT + ((nb + n) * 16 + fr) * 40 + fq * 8);
          oo[n] = MFMA(a, bb, oo[n]);
        }
      }
#pragma unroll
      for (int ks = 0; ks < 4; ++ks) {
        const bf16x8 a = *(const bf16x8*)(Qs + (mt * 16 + fr) * 136 + ks * 32 + fq * 8);
#pragma unroll
        for (int n = 0; n < 4; ++n) {
          const bf16x8 bb = *(const bf16x8*)(ST + ((nb + n) * 16 + fr) * 136 + ks * 32 + fq * 8);
          oo[n] = MFMA(a, bb, oo[n]);
        }
      }
#pragma unroll
      for (int j = 0; j < 4; ++j) {
        float ss = 0.f;
#pragma unroll
        for (int n = 0; n < 4; ++n) ss += oo[n][j] * oo[n][j];
        ss = red16_sum(ss);
        if (fr == 0) red[(mt * 16 + fq * 4 + j) * 2 + (wave >> 1)] = ss;
      }
      __syncthreads();
#pragma unroll
      for (int j = 0; j < 4; ++j) {
        const int t = mt * 16 + fq * 4 + j;
        const float rstd = rsqrtf((red[t * 2] + red[t * 2 + 1]) * (1.f / 128.f) + 1e-6f);
        bf16_t* gp = p.u + (tok0 + t) * US + 2560 + h * 128 + nb * 16 + fr;
#pragma unroll
        for (int n = 0; n < 4; ++n) {
          const float g = bf2f(gp[n * 16]);
          gp[n * 16] = f2bf(oo[n][j] * rstd * nw[(nb + n) * 16 + fr] * (g * sigm(g)));
        }
      }
    }
    {
      bf16x8 af[2];
#pragma unroll
      for (int mm = 0; mm < 2; ++mm) af[mm] = *(const bf16x8*)(KT + (wave * 32 + mm * 16 + fr) * 40 + fq * 8);
#pragma unroll
      for (int n = 0; n < 8; ++n) {
        const bf16x8 bb = *(const bf16x8*)(VT + (n * 16 + fr) * 40 + fq * 8);
#pragma unroll
        for (int mm = 0; mm < 2; ++mm) S[mm][n] = MFMA(af[mm], bb, S[mm][n]);
      }
#pragma unroll
      for (int mm = 0; mm < 2; ++mm)
#pragma unroll
        for (int j = 0; j < 4; ++j) {
          const float e = __expf(blast[wave * 32 + mm * 16 + fq * 4 + j]);
#pragma unroll
          for (int n = 0; n < 8; ++n) S[mm][n][j] *= e;
        }
    }
  }
  __syncthreads();
}

DEV uint4 rw_act(const uint4 cur, const uint4 prv, const float* mul8, int mode) {
  const float4 m0 = *(const float4*)(mul8), m1 = *(const float4*)(mul8 + 4);
  const float mm[8] = {m0.x, m0.y, m0.z, m0.w, m1.x, m1.y, m1.z, m1.w};
  float a[8], b[8], o[8];
  UNPACK8(cur, a); UNPACK8(prv, b);
#pragma unroll
  for (int e = 0; e < 8; ++e) {
    float v = a[e] + (b[e] - a[e]) * mm[e];
    if (mode == 1) { const float t = __expf(-2.f * fabsf(v)); const float th = (1.f - t) / (1.f + t); v = (v >= 0.f) ? th : -th; }
    else if (mode == 2) v = sigm(v);
    o[e] = v;
  }
  return PACK8(o);
}
DEV bf16x8 rw_bfrag(const float* W, int k0, int col) {
  float o[8];
#pragma unroll
  for (int e = 0; e < 8; ++e) o[e] = W[(size_t)(k0 + e) * 512 + col];
  return as_frag(PACK8(o));
}

PHASE void rwkv_item(const Params& p, int l, int item, char* smem) {
  const int b = item >> 3, h = item & 7;
  const int tid = opaque_tid(), lane = tid & 63, wave = tid >> 6, fr = lane & 15, fq = lane >> 4;
  float* R = (float*)smem;
  float* K = R + 2048; float* KK = K + 2048; float* W = KK + 2048; float* BB = W + 2048;
  float* V = BB + 2048; float* G = V + 2048; float* O = G + 2048;
  float* cst = O + 2048;
  float* mul = cst + 512;
  bf16_t* rawL = (bf16_t*)smem;
  float* vloL = (float*)(smem + 17424);
  const float* mu = p.rw_mu + (size_t)l * 1792;
  const int hc_n = h * 64 + wave * 16 + fr;
  bf16x8 w2f[2], a2f[2], g2f[4], v2f;
#pragma unroll
  for (int ks = 0; ks < 2; ++ks) {
    w2f[ks] = rw_bfrag(p.rw_w2 + (size_t)l * 64 * 512, ks * 32 + fq * 8, hc_n);
    a2f[ks] = rw_bfrag(p.rw_a2 + (size_t)l * 64 * 512, ks * 32 + fq * 8, hc_n);
  }
#pragma unroll
  for (int ks = 0; ks < 4; ++ks) g2f[ks] = rw_bfrag(p.rw_g2 + (size_t)l * 128 * 512, ks * 32 + fq * 8, hc_n);
  v2f = w2f[0];
  if (l > 0) v2f = rw_bfrag(p.rw_v2, fq * 8, hc_n);
  const float w0c = p.rw_w0[l * 512 + hc_n], a0c = p.rw_a0[l * 512 + hc_n];
  const float v0c = (l > 0) ? p.rw_v0[hc_n] : 0.f;
  const int t_ = tid >> 3, n0 = (tid & 7) * 8;
  __syncthreads();
  if (tid < 64) {
    const int hc = h * 64 + tid;
    cst[tid] = p.rw_k_k[l * 512 + hc]; cst[64 + tid] = p.rw_k_a[l * 512 + hc]; cst[128 + tid] = p.rw_r_k[l * 512 + hc];
    cst[192 + tid] = p.rw_gn_w[l * 512 + hc]; cst[256 + tid] = p.rw_gn_b[l * 512 + hc];
    cst[320 + tid] = mu[hc]; cst[384 + tid] = mu[512 + hc]; cst[448 + tid] = mu[1024 + hc];
  }
  mul[tid] = mu[1536 + tid];
  const float* kkc = cst + n0; const float* kac = cst + 64 + n0; const float* rkc = cst + 128 + n0;
  const float* gnw = cst + 192 + n0; const float* gnb = cst + 256 + n0;
  const float* mur = cst + 320 + n0; const float* muk = cst + 384 + n0; const float* muv = cst + 448 + n0;
  const int kq = lane & 7, row0 = wave * 16 + (lane >> 3), row1 = row0 + 8;
  f32x2 S0p[4], S1p[4];
#pragma unroll
  for (int e = 0; e < 4; ++e) { S0p[e] = (f32x2){0.f, 0.f}; S1p[e] = (f32x2){0.f, 0.f}; }

  uint4 pl0, pl1, pl2, pl3, pl4, pcr, pck, pcv, ppr, ppk, ppv, pvf;
  float4 pvl;
#define RW_PREFETCH(ch_)                                                                                    \
  {                                                                                                         \
    const size_t tk0 = (size_t)b * SEQ + (size_t)(ch_) * 32;                                                 \
    const bf16_t* lb_ = p.u + (tk0 - 1) * US + 3072 + 1536 + (tid & 31) * 8;                                 \
    const int r0_ = tid >> 5;                                                                               \
    pl0 = make_uint4(0, 0, 0, 0); if (!((ch_) == 0 && r0_ == 0)) pl0 = *(const uint4*)(lb_ + (size_t)r0_ * US); \
    pl1 = *(const uint4*)(lb_ + (size_t)(r0_ + 8) * US);                                                     \
    pl2 = *(const uint4*)(lb_ + (size_t)(r0_ + 16) * US);                                                    \
    pl3 = *(const uint4*)(lb_ + (size_t)(r0_ + 24) * US);                                                    \
    pl4 = make_uint4(0, 0, 0, 0); if (tid < 32) pl4 = *(const uint4*)(lb_ + (size_t)32 * US);                \
    const bf16_t* cu_ = p.u + (tk0 + t_) * US + 3072 + h * 64 + n0;                                          \
    pcr = *(const uint4*)cu_; pck = *(const uint4*)(cu_ + 512); pcv = *(const uint4*)(cu_ + 1024);           \
    if ((ch_) == 0 && t_ == 0) { ppr = make_uint4(0, 0, 0, 0); ppk = ppr; ppv = ppr; }                        \
    else { ppr = *(const uint4*)(cu_ - US); ppk = *(const uint4*)(cu_ - US + 512); ppv = *(const uint4*)(cu_ - US + 1024); } \
    if (l > 0) {                                                                                            \
      pvl = *(const float4*)(p.vlo + (tk0 + (tid >> 3)) * 32 + (tid & 7) * 4);                               \
      pvf = *(const uint4*)(p.vfirst + (tk0 + t_) * 512 + h * 64 + n0);                                      \
    } else { pvl = make_float4(0.f, 0.f, 0.f, 0.f); pvf = make_uint4(0, 0, 0, 0); }                          \
  }
  RW_PREFETCH(0)

  for (int ch = 0; ch < 64; ++ch) {
    const size_t tok0 = (size_t)b * SEQ + (size_t)ch * 32;
    __syncthreads();
    {
      const int r0_ = tid >> 5, cc_ = (tid & 31) * 8;
      *(uint4*)(rawL + r0_ * 264 + cc_) = pl0;
      *(uint4*)(rawL + (r0_ + 8) * 264 + cc_) = pl1;
      *(uint4*)(rawL + (r0_ + 16) * 264 + cc_) = pl2;
      *(uint4*)(rawL + (r0_ + 24) * 264 + cc_) = pl3;
      if (tid < 32) *(uint4*)(rawL + 32 * 264 + cc_) = pl4;
      *(float4*)(vloL + (tid >> 3) * 36 + (tid & 7) * 4) = pvl;
    }
    __syncthreads();
    {
      const int cc_ = (tid & 31) * 8, tr = tid >> 5;
      const int mode = (cc_ < 64) ? 1 : ((cc_ < 128) ? 0 : 2);
      uint4 a0, a1, a2, a3;
      a0 = rw_act(*(const uint4*)(rawL + (tr + 1) * 264 + cc_), *(const uint4*)(rawL + tr * 264 + cc_), mul + cc_, mode);
      a1 = rw_act(*(const uint4*)(rawL + (tr + 9) * 264 + cc_), *(const uint4*)(rawL + (tr + 8) * 264 + cc_), mul + cc_, mode);
      a2 = rw_act(*(const uint4*)(rawL + (tr + 17) * 264 + cc_), *(const uint4*)(rawL + (tr + 16) * 264 + cc_), mul + cc_, mode);
      a3 = rw_act(*(const uint4*)(rawL + (tr + 25) * 264 + cc_), *(const uint4*)(rawL + (tr + 24) * 264 + cc_), mul + cc_, mode);
      __syncthreads();
      *(uint4*)(rawL + tr * 264 + cc_) = a0;
      *(uint4*)(rawL + (tr + 8) * 264 + cc_) = a1;
      *(uint4*)(rawL + (tr + 16) * 264 + cc_) = a2;
      *(uint4*)(rawL + (tr + 24) * 264 + cc_) = a3;
    }
    __syncthreads();
#pragma unroll 1
    for (int mt = 0; mt < 2; ++mt) {
      const int row = mt * 16 + fr;
      const bf16_t* ar = rawL + row * 264 + fq * 8;
      f32x4 aw = (f32x4){0.f, 0.f, 0.f, 0.f}, aa = aw, ag = aw, av = aw;
#pragma unroll
      for (int ks = 0; ks < 2; ++ks) {
        aw = MFMA(*(const bf16x8*)(ar + ks * 32), w2f[ks], aw);
        aa = MFMA(*(const bf16x8*)(ar + 64 + ks * 32), a2f[ks], aa);
      }
#pragma unroll
      for (int ks = 0; ks < 4; ++ks) ag = MFMA(*(const bf16x8*)(ar + 128 + ks * 32), g2f[ks], ag);
      if (l > 0) {
        const float4 x0 = *(const float4*)(vloL + row * 36 + fq * 8), x1 = *(const float4*)(vloL + row * 36 + fq * 8 + 4);
        const uint4 pk = make_uint4(pack2(x0.x, x0.y), pack2(x0.z, x0.w), pack2(x1.x, x1.y), pack2(x1.z, x1.w));
        av = MFMA(as_frag(pk), v2f, av);
      }
#pragma unroll
      for (int j = 0; j < 4; ++j) {
        const int t = mt * 16 + fq * 4 + j, n = wave * 16 + fr;
        const float wv = -(w0c + aw[j]);
        const float sp = fmaxf(wv, 0.f) + __logf(1.f + __expf(-fabsf(wv)));
        const float wl = -sp - 0.5f;
        W[t * 64 + n] = __expf(-__expf(wl));
        BB[t * 64 + n] = sigm(a0c + aa[j]);
        G[t * 64 + n] = ag[j];
        if (l > 0) O[t * 64 + n] = sigm(v0c + av[j]);
      }
    }
    __syncthreads();
    {
      const size_t tok = tok0 + t_;
      float cr[8], ck[8], cv[8], pr[8], pk[8], pv[8];
      UNPACK8(pcr, cr); UNPACK8(pck, ck); UNPACK8(pcv, cv);
      UNPACK8(ppr, pr); UNPACK8(ppk, pk); UNPACK8(ppv, pv);
      float kx[8], kkv[8], vs[8], ss = 0.f;
#pragma unroll
      for (int e = 0; e < 8; ++e) {
        R[t_ * 64 + n0 + e] = cr[e] + (pr[e] - cr[e]) * mur[e];
        kx[e] = ck[e] + (pk[e] - ck[e]) * muk[e];
        vs[e] = cv[e] + (pv[e] - cv[e]) * muv[e];
        kkv[e] = kx[e] * kkc[e]; ss += kkv[e] * kkv[e];
      }
      ss = red8_sum(ss);
      const float rn = rsqrtf(fmaxf(ss, 1e-24f));
#pragma unroll
      for (int e = 0; e < 8; ++e) {
        const float a = BB[t_ * 64 + n0 + e];
        const float kn = kkv[e] * rn;
        K[t_ * 64 + n0 + e] = kx[e] * (1.f + (a - 1.f) * kac[e]);
        KK[t_ * 64 + n0 + e] = kn;
        BB[t_ * 64 + n0 + e] = kn * a;
      }
      if (l == 0) {
        *(uint4*)(p.vfirst + tok * 512 + h * 64 + n0) = PACK8(vs);
      } else {
        float vf[8]; UNPACK8(pvf, vf);
#pragma unroll
        for (int e = 0; e < 8; ++e) vs[e] = vs[e] + (vf[e] - vs[e]) * O[t_ * 64 + n0 + e];
      }
#pragma unroll
      for (int e = 0; e < 8; ++e) V[t_ * 64 + n0 + e] = vs[e];
    }
    __syncthreads();
    if (ch + 1 < 64) RW_PREFETCH(ch + 1)
    asm volatile("" ::: "memory");
#pragma unroll 4
    for (int t = 0; t < 32; ++t) {
      const float* base = R + t * 64 + kq * 8;
      const float4 r0 = *(const float4*)(base), r1 = *(const float4*)(base + 4);
      const float4 k0 = *(const float4*)(base + 2048), k1 = *(const float4*)(base + 2048 + 4);
      const float4 q0 = *(const float4*)(base + 4096), q1 = *(const float4*)(base + 4096 + 4);
      const float4 w0 = *(const float4*)(base + 6144), w1 = *(const float4*)(base + 6144 + 4);
      const float4 b0 = *(const float4*)(base + 8192), b1 = *(const float4*)(base + 8192 + 4);
      const float va = V[t * 64 + row0], vb = V[t * 64 + row1];
      const f32x2 rr[4] = {{r0.x, r0.y}, {r0.z, r0.w}, {r1.x, r1.y}, {r1.z, r1.w}};
      const f32x2 ww[4] = {{w0.x, w0.y}, {w0.z, w0.w}, {w1.x, w1.y}, {w1.z, w1.w}};
      const f32x2 kk_[4] = {{k0.x, k0.y}, {k0.z, k0.w}, {k1.x, k1.y}, {k1.z, k1.w}};
      const f32x2 qq[4] = {{q0.x, q0.y}, {q0.z, q0.w}, {q1.x, q1.y}, {q1.z, q1.w}};
      const f32x2 bb[4] = {{b0.x, b0.y}, {b0.z, b0.w}, {b1.x, b1.y}, {b1.z, b1.w}};
      f32x2 a0 = S0p[0] * qq[0], a1 = S1p[0] * qq[0];
#pragma unroll
      for (int e = 1; e < 4; ++e) { a0 += S0p[e] * qq[e]; a1 += S1p[e] * qq[e]; }
      const float sa0 = -red8_sum(a0.x + a0.y), sa1 = -red8_sum(a1.x + a1.y);
      f32x2 sa0v, sa1v, vav, vbv;
      sa0v.x = sa0; sa0v.y = sa0; sa1v.x = sa1; sa1v.y = sa1; vav.x = va; vav.y = va; vbv.x = vb; vbv.y = vb;
      f32x2 o0v = {0.f, 0.f}, o1v = {0.f, 0.f};
#pragma unroll
      for (int e = 0; e < 4; ++e) {
        S0p[e] = S0p[e] * ww[e] + sa0v * bb[e] + vav * kk_[e];
        S1p[e] = S1p[e] * ww[e] + sa1v * bb[e] + vbv * kk_[e];
        o0v += S0p[e] * rr[e]; o1v += S1p[e] * rr[e];
      }
      const float o0 = red8_sum(o0v.x + o0v.y), o1 = red8_sum(o1v.x + o1v.y);
      if (kq == 0) { O[t * 64 + row0] = o0; O[t * 64 + row1] = o1; }
    }
    asm volatile("s_waitcnt vmcnt(0)" ::: "memory");
    __syncthreads();
    {
      const size_t tok = tok0 + t_;
      float ov[8], s1 = 0.f, bon = 0.f;
#pragma unroll
      for (int e = 0; e < 8; ++e) {
        ov[e] = O[t_ * 64 + n0 + e]; s1 += ov[e];
        bon += R[t_ * 64 + n0 + e] * K[t_ * 64 + n0 + e] * rkc[e];
      }
      s1 = red8_sum(s1); bon = red8_sum(bon);
      const float mean = s1 * (1.f / 64.f);
      float s2 = 0.f;
#pragma unroll
      for (int e = 0; e < 8; ++e) { const float d = ov[e] - mean; s2 += d * d; }
      s2 = red8_sum(s2);
      const float rstd = rsqrtf(s2 * (1.f / 64.f) + 64e-5f);
      float y[8];
#pragma unroll
      for (int e = 0; e < 8; ++e)
        y[e] = ((ov[e] - mean) * rstd * gnw[e] + gnb[e] + bon * V[t_ * 64 + n0 + e]) * G[t_ * 64 + n0 + e];
      *(uint4*)(p.u + tok * US + 3072 + h * 64 + n0) = PACK8(y);
    }
  }
#undef RW_PREFETCH
  __syncthreads();
}

PHASE void phase_mix(const Params& p, int l, char* smem) {
  const int hf = vhalf();
  int* sitem = (int*)(smem - hf * SMEM_BYTES + SMEM_BYTES - 16);
  const int t512 = opaque_tid512();
  while (true) {
    __syncthreads();
    if (t512 == 0) *sitem = (int)atomicAdd(p.counters + l * 4 + 0, 1u);
    __syncthreads();
    const int tk = *sitem;
    if (tk >= 128) break;
    rwkv_item(p, l, tk * 2 + hf, smem);
  }
  while (true) {
    __syncthreads();
    if (t512 == 0) *sitem = (int)atomicAdd(p.counters + l * 4 + 1, 1u);
    __syncthreads();
    const int tk = *sitem;
    if (tk >= 64) break;
    hgrn_item(p, l, tk * 2 + hf, smem);
  }
  while (true) {
    __syncthreads();
    if (t512 == 0) *sitem = (int)atomicAdd(p.counters + l * 4 + 2, 1u);
    __syncthreads();
    const int tk = *sitem;
    if (tk >= 2048) break;
    att_item(p, l, tk * 2 + hf, smem);
  }
}

DEV void gemm_gates(const int tid_in, const bf16_t* A, const bf16_t* Wg, int tn, char* smem, unsigned (&Gp)[4][6][2]) {
  int tid = tid_in; asm volatile("" : "+v"(tid));
  bf16_t* As = (bf16_t*)smem;
  bf16_t* Bs = As + 3 * 4096;
  const int lane = tid & 63, wave = tid >> 6, wr = wave >> 1, wc = wave & 1;
  const int fr = lane & 15, fq = lane >> 4;
  f32x4 acc[4][6];
#pragma unroll
  for (int m = 0; m < 4; ++m)
#pragma unroll
    for (int n = 0; n < 6; ++n) acc[m][n] = (f32x4){0.f, 0.f, 0.f, 0.f};
  const int nk = DM >> 5;
  const int drow = tid >> 2, dphys = tid & 3, dg = (0 - (tid >> 4)) & 3;
  const int cofs = (dphys ^ dg) * 8;
  const unsigned aofs = (unsigned)(drow * DM + cofs);
  unsigned bofs0, bofs1, bofs2;
  {
    int r = drow; int wcb = r / 96, br = (r % 96) >> 5, c = (r % 96) & 31;
    bofs0 = (unsigned)((5376 + br * 1024 + tn * 64 + wcb * 32 + c) * DM + cofs);
    r = drow + 64; wcb = r / 96; br = (r % 96) >> 5; c = (r % 96) & 31;
    bofs1 = (unsigned)((5376 + br * 1024 + tn * 64 + wcb * 32 + c) * DM + cofs);
    r = drow + 128; wcb = r / 96; br = (r % 96) >> 5; c = (r % 96) & 31;
    bofs2 = (unsigned)((5376 + br * 1024 + tn * 64 + wcb * 32 + c) * DM + cofs);
  }
  const int rofs = (fq ^ ((0 - (fr >> 2)) & 3)) * 8;
#define GG_DMA(st, kk)                                                                                       \
  {                                                                                                          \
    __builtin_amdgcn_global_load_lds((const unsigned*)(A + aofs + (kk) * 32), (unsigned*)(As + (st) * 4096 + tid * 8), 16, 0, 0);                     \
    __builtin_amdgcn_global_load_lds((const unsigned*)(A + aofs + 64 * DM + (kk) * 32), (unsigned*)(As + (st) * 4096 + tid * 8 + 2048), 16, 0, 0); \
    __builtin_amdgcn_global_load_lds((const unsigned*)(Wg + bofs0 + (kk) * 32), (unsigned*)(Bs + (st) * 6144 + tid * 8), 16, 0, 0);                    \
    __builtin_amdgcn_global_load_lds((const unsigned*)(Wg + bofs1 + (kk) * 32), (unsigned*)(Bs + (st) * 6144 + tid * 8 + 2048), 16, 0, 0);             \
    __builtin_amdgcn_global_load_lds((const unsigned*)(Wg + bofs2 + (kk) * 32), (unsigned*)(Bs + (st) * 6144 + tid * 8 + 4096), 16, 0, 0);             \
  }
  GG_DMA(0, 0)
  GG_DMA(1, 1)
  int st = 0;
  for (int kt = 0; kt < nk; ++kt) {
    if (kt + 1 < nk) asm volatile("s_waitcnt vmcnt(5)" ::: "memory");
    else asm volatile("s_waitcnt vmcnt(0)" ::: "memory");
    __builtin_amdgcn_s_barrier();
    asm volatile("" ::: "memory");
    const int s2 = (st >= 1) ? st - 1 : 2;
    const bf16_t* Ab = As + st * 4096 + (wr * 64 + fr) * 32 + rofs;
    const bf16_t* Bb = Bs + st * 6144 + (wc * 96 + fr) * 32 + rofs;
    bf16x8 bfr[6], af[4];
#pragma unroll
    for (int n = 0; n < 6; ++n) bfr[n] = *(const bf16x8*)(Bb + n * 512);
#pragma unroll
    for (int m = 0; m < 4; ++m) af[m] = *(const bf16x8*)(Ab + m * 512);
    if (kt + 2 < nk) GG_DMA(s2, kt + 2)
#pragma unroll
    for (int m = 0; m < 4; ++m)
#pragma unroll
      for (int n = 0; n < 6; ++n) acc[m][n] = MFMA(af[m], bfr[n], acc[m][n]);
    st = (st == 2) ? 0 : st + 1;
  }
#undef GG_DMA
  __syncthreads();
#pragma unroll
  for (int m = 0; m < 4; ++m)
#pragma unroll
    for (int n = 0; n < 6; ++n) {
      Gp[m][n][0] = pack2(sigm(acc[m][n][0]), sigm(acc[m][n][1]));
      Gp[m][n][1] = pack2(sigm(acc[m][n][2]), sigm(acc[m][n][3]));
    }
}

PHASE void phase_merge(const Params& p, int l, char* smem) {
  const bf16_t* Wl = p.wt + (size_t)l * WLAYER;
  float* Cs = (float*)smem;
  const int tid = opaque_tid();
  for (int it = 0;; ++it) {
    int tm, tn;
    if (!tile_for(it, 512, 16, tm, tn)) break;
    const size_t row0 = (size_t)tm * 128;
    unsigned Gp[4][6][2];
    gemm_gates(tid, p.h + row0 * DM, Wl + WIN, tn, smem, Gp);
    f32x4 acc[4][2], M[4][2];
#pragma unroll
    for (int m = 0; m < 4; ++m)
#pragma unroll
      for (int n = 0; n < 2; ++n) M[m][n] = (f32x4){0.f, 0.f, 0.f, 0.f};
#pragma unroll
    for (int br = 0; br < 3; ++br) {
      const int aoff = (br == 0) ? 0 : (br == 1 ? 2560 : 3072);
      const size_t woff = (br == 0) ? WBA : (br == 1 ? WBB : WBC);
      gemm_tile<2>(tid, p.u + row0 * US + aoff, US, Wl + woff + (size_t)(tn * 64) * 512, 512, 512, smem, acc);
#pragma unroll
      for (int m = 0; m < 4; ++m)
#pragma unroll
        for (int n = 0; n < 2; ++n) {
          M[m][n][0] += lo16(Gp[m][2 * br + n][0]) * acc[m][n][0];
          M[m][n][1] += hi16(Gp[m][2 * br + n][0]) * acc[m][n][1];
          M[m][n][2] += lo16(Gp[m][2 * br + n][1]) * acc[m][n][2];
          M[m][n][3] += hi16(Gp[m][2 * br + n][1]) * acc[m][n][3];
        }
    }
    stage_acc<2>(tid, Cs, M);
    __syncthreads();
    {
      const int ch = tid & 7;
#pragma unroll 1
      for (int i = 0; i < 4; ++i) {
        const int r = (tid >> 3) + i * 32;
        const float4 a = *(const float4*)(Cs + r * 68 + ch * 8), b = *(const float4*)(Cs + r * 68 + ch * 8 + 4);
        *(uint4*)(p.u + (row0 + r) * US + 1024 + tn * 64 + ch * 8) = make_uint4(pack2(a.x, a.y), pack2(a.z, a.w), pack2(b.x, b.y), pack2(b.z, b.w));
      }
    }
    __syncthreads();
  }
}

PHASE void phase_gemm_res(const bf16_t* A, int lda, const bf16_t* Wt, int K, const float* xin, float* xout,
                        const float* ada_l, int gate_off, char* smem0) {
  const int T = opaque_tid512(), tid = T & 255, hf = vhalf();
  float* Cs = (float*)(smem0 + hf * SMEM_BYTES);
  for (int it = 0;; ++it) {
    int tm, tn;
    if (!tile_for_real(it, 256, 4, tm, tn)) break;
    const size_t row0 = (size_t)tm * 256;
    f32x4 acc[8][4];
    gemm_tile512(T, A + row0 * lda, lda, Wt + (size_t)(tn * 256) * K, K, K, smem0, acc);
    const float* gate = ada_l + (size_t)(row0 / SEQ) * ADAW + gate_off;
    const int c4 = (tid & 31) * 4;
#pragma unroll
    for (int ps = 0; ps < 2; ++ps) {
      if (ps == 0) stage_half512<0>(T, Cs, acc); else stage_half512<1>(T, Cs, acc);
      __syncthreads();
#pragma unroll 1
      for (int i = 0; i < 16; ++i) {
        const int r = (tid >> 5) + i * 8;
        const int colb = TNC(r) * 128 + c4;
        const float4 gv = *(const float4*)(gate + colb);
        const float4 cv = *(const float4*)(Cs + r * 132 + c4);
        const size_t off = GROW(r, ps) * DM + colb;
        const float4 xv = *(const float4*)(xin + off);
        *(float4*)(xout + off) = make_float4(xv.x + gv.x * cv.x, xv.y + gv.y * cv.y, xv.z + gv.z * cv.z, xv.w + gv.w * cv.w);
      }
      __syncthreads();
    }
  }
}

PHASE void phase_ffn_in(const Params& p, int l, char* smem0) {
  const bf16_t* Wt = p.wt + (size_t)l * WLAYER + WFI;
  const int T = opaque_tid512(), tid = T & 255, hf = vhalf();
  float* Cs = (float*)(smem0 + hf * SMEM_BYTES);
  for (int it = 0;; ++it) {
    int tm, tn;
    if (!tile_for_real(it, 256, 22, tm, tn)) break;
    const size_t row0 = (size_t)tm * 256;
    f32x4 acc[8][4];
    gemm_tile512(T, p.h + row0 * DM, DM, Wt + (size_t)(tn * 256) * DM, DM, DM, smem0, acc);
    const int ch = tid & 7;
#pragma unroll
    for (int ps = 0; ps < 2; ++ps) {
      if (ps == 0) stage_half512<0>(T, Cs, acc); else stage_half512<1>(T, Cs, acc);
      __syncthreads();
#pragma unroll 1
      for (int i = 0; i < 4; ++i) {
        const int r = (tid >> 3) + i * 32;
        const float* cp = Cs + r * 132 + ch * 8;
        float o[8];
#pragma unroll
        for (int e = 0; e < 8; ++e) { const float g = cp[e], uu = cp[64 + e]; o[e] = g * sigm(g) * uu; }
        *(uint4*)(p.u + GROW(r, ps) * FFH + TNC(r) * 64 + ch * 8) = PACK8(o);
      }
      __syncthreads();
    }
  }
}

#define XB_TMO      128
#define XB_XCNT(j)  (256  + 64 * (j))
#define XB_XSUB(j)  (1280 + 64 * (j))
#define XB_XGEN(j)  (2304 + 64 * (j))
#define XB_TOP      3328
#define XB_TOPGEN   3392
#define XCD_BAR_WORDS 3456
#define XB_SPIN_CAP (1u << 18)
#define LAS __attribute__((address_space(3)))
DEV unsigned xb_ld(unsigned* p) { return __hip_atomic_load(p, __ATOMIC_RELAXED, __HIP_MEMORY_SCOPE_AGENT); }
DEV unsigned xb_add(unsigned* p, unsigned v) { return __hip_atomic_fetch_add(p, v, __ATOMIC_RELAXED, __HIP_MEMORY_SCOPE_AGENT); }
DEV unsigned xb_xcc_id() { return (unsigned)__builtin_amdgcn_s_getreg((3 << 11) | 20) & 0xFu; }
#define XB_SPIN(cond, bar) do { unsigned _sp = 0; while (cond) { __builtin_amdgcn_s_sleep(1); \
    if ((++_sp & 255u) == 0u) { if (xb_ld(&(bar)[XB_TMO])) break; if (_sp > XB_SPIN_CAP) { atomicAdd(&(bar)[XB_TMO], 1u); break; } } } } while (0)
struct XcdBarrier { unsigned* bar; unsigned x; volatile LAS unsigned* st; };
DEV XcdBarrier xcd_barrier_post(unsigned* bar, volatile LAS unsigned* st) {
  XcdBarrier b; b.bar = bar; b.x = xb_xcc_id(); b.st = st;
  if (threadIdx.x == 0) (void)xb_add(&bar[XB_XCNT(b.x)], 1u);
  return b;
}
DEV void xcd_barrier_complete(unsigned* bar, unsigned x, unsigned& nloc, unsigned& nx) {
  const unsigned G = gridDim.x * gridDim.y * gridDim.z;
  unsigned sum, cnt, mine, sp = 0u;
  for (;;) {
    sum = 0u; cnt = 0u; mine = 0u;
#pragma unroll
    for (unsigned j = 0; j < 16; ++j) { const unsigned c = xb_ld(&bar[XB_XCNT(j)]); sum += c; cnt += (c > 0u) ? 1u : 0u; mine = (j == x) ? c : mine; }
    if (sum == G) break;
    __builtin_amdgcn_s_sleep(1);
    if ((++sp & 255u) == 0u) { if (xb_ld(&bar[XB_TMO])) break; if (sp > XB_SPIN_CAP) { atomicAdd(&bar[XB_TMO], 1u); break; } }
  }
  nloc = mine > 0u ? mine : 1u; nx = cnt > 0u ? cnt : 1u;
}
DEV void xcd_barrier(const XcdBarrier& b) {
  asm volatile("s_waitcnt vmcnt(0)" ::: "memory");
  __syncthreads();
  if (threadIdx.x == 0) {
    unsigned* bar = b.bar;
    __builtin_amdgcn_s_waitcnt(0);
    unsigned nloc = b.st[0], nx = b.st[1];
    if (nloc == 0u) { xcd_barrier_complete(bar, b.x, nloc, nx); b.st[0] = nloc; b.st[1] = nx; }
    const unsigned old = xb_add(&bar[XB_XSUB(b.x)], 1u);
    const unsigned gen = old / nloc;
    if (old + 1u == (gen + 1u) * nloc) {
      __builtin_amdgcn_fence(__ATOMIC_RELEASE, "agent");
      asm volatile("s_waitcnt vmcnt(0)" ::: "memory");
      const unsigned og = xb_add(&bar[XB_TOP], 1u);
      const unsigned tg = og / nx;
      if (og + 1u == (tg + 1u) * nx) xb_add(&bar[XB_TOPGEN], 1u);
      else XB_SPIN(xb_ld(&bar[XB_TOPGEN]) == tg, bar);
      __builtin_amdgcn_fence(__ATOMIC_ACQUIRE, "agent");
      xb_add(&bar[XB_XGEN(b.x)], 1u);
      asm volatile("s_waitcnt vmcnt(0)" ::: "memory");
    } else {
      XB_SPIN(xb_ld(&bar[XB_XGEN(b.x)]) == gen, bar);
      __builtin_amdgcn_fence(__ATOMIC_ACQUIRE, "agent");
      asm volatile("s_waitcnt vmcnt(0)" ::: "memory");
    }
  }
  __syncthreads();
}

__global__ void __launch_bounds__(512, 2) mega(Params p_in, int ph_lo, int ph_hi) {
  extern __shared__ __attribute__((aligned(16))) char smem0[];
  char* smem = smem0 + vhalf() * SMEM_BYTES;
  cg::grid_group grid = cg::this_grid();
  const Params& p = p_in;
  bool first = true;
#define RUN(ph) if ((ph) >= ph_lo && (ph) < ph_hi)
  unsigned epoch = 0;
  __shared__ unsigned xb_words[4];
  if (threadIdx.x < 4) xb_words[threadIdx.x] = 0u;
  __syncthreads();
  XcdBarrier xb;
  xb.bar = p.counters + 256; xb.x = 0u; xb.st = (volatile LAS unsigned*)xb_words;
#define SYNC { if (!first) { ++epoch; if (epoch == 1) { grid.sync(); xb = xcd_barrier_post(p.counters + 256, (volatile LAS unsigned*)xb_words); } else xcd_barrier(xb); } first = false; }
  RUN(0) { SYNC; phase_prep(p, smem); }
#pragma unroll 1
  for (int l = 0; l < 2; ++l) {
    const int base = 1 + 9 * l;
    const float* ada_l = p.ada + (size_t)l * 32 * ADAW;
    const bf16_t* Wl = p.wt + (size_t)l * WLAYER;
    const float* xin = (l == 0) ? p.x : p.out;
    RUN(base + 0) { SYNC; phase_norm(xin, p.norm_mix_w + l * DM, ada_l, 0, 1024, p.h); }
    RUN(base + 1) { SYNC; phase_gemm_in(p, l, smem0); }
    RUN(base + 2) { if (l > 0) { SYNC; phase_vlo(p, l, smem); } }
    RUN(base + 3) { SYNC; phase_mix(p, l, smem); }
    RUN(base + 4) { SYNC; phase_merge(p, l, smem); }
    RUN(base + 5) { SYNC; phase_gemm_res(p.u + 1024, US, Wl + WOUT, DM, xin, p.out, ada_l, 2048, smem0); }
    RUN(base + 6) { SYNC; phase_norm(p.out, p.norm_ffn_w + l * DM, ada_l, 3072, 4096, p.h); }
    RUN(base + 7) { SYNC; phase_ffn_in(p, l, smem0); }
    RUN(base + 8) { SYNC; phase_gemm_res(p.u, FFH, Wl + WFO, FFH, p.out, p.out, ada_l, 5120, smem0); }
  }
  RUN(NPHASE - 1) { SYNC; phase_final(p.out, p.final_norm_w); }
}

extern "C" void kernel_launch(void* const* d_in, const int* in_sizes, int n_in, void* d_out, int out_size, void* d_ws,
                              size_t ws_size, hipStream_t stream) {
  Params p{};
  p.x = (const float*)d_in[0]; p.c = (const float*)d_in[1]; p.pos = (const int*)d_in[2];
  p.ada_w = (const float*)d_in[3]; p.ada_b = (const float*)d_in[4]; p.norm_mix_w = (const float*)d_in[5];
  p.norm_ffn_w = (const float*)d_in[6]; p.w_in = (const float*)d_in[7]; p.da_lambda = (const float*)d_in[8];
  p.da_subln_w = (const float*)d_in[9]; p.hg_lb = (const float*)d_in[10]; p.hg_norm_w = (const float*)d_in[11];
  p.rw_mu = (const float*)d_in[12]; p.rw_w0 = (const float*)d_in[13]; p.rw_w2 = (const float*)d_in[14];
  p.rw_a0 = (const float*)d_in[15]; p.rw_a2 = (const float*)d_in[16]; p.rw_g2 = (const float*)d_in[17];
  p.rw_k_k = (const float*)d_in[18]; p.rw_k_a = (const float*)d_in[19]; p.rw_r_k = (const float*)d_in[20];
  p.rw_gn_w = (const float*)d_in[21]; p.rw_gn_b = (const float*)d_in[22]; p.rw_v0 = (const float*)d_in[23];
  p.rw_v1 = (const float*)d_in[24]; p.rw_v2 = (const float*)d_in[25]; p.w_br_a = (const float*)d_in[26];
  p.w_br_b = (const float*)d_in[27]; p.w_br_c = (const float*)d_in[28]; p.w_out = (const float*)d_in[29];
  p.ffn_w_in = (const float*)d_in[30]; p.ffn_w_out = (const float*)d_in[31]; p.final_norm_w = (const float*)d_in[32];
  p.out = (float*)d_out;
  char* ws = (char*)d_ws;
  size_t off = 0;
  auto take = [&](size_t bytes) { char* r = ws + off; off += (bytes + 255) & ~(size_t)255; return r; };
  p.counters = (unsigned*)take(16384);
  p.wt = (bf16_t*)take(2 * WLAYER * 2);
  p.ada = (float*)take((size_t)2 * 32 * ADAW * 4);
  p.h = (bf16_t*)take((size_t)T_TOK * DM * 2);
  p.u = (bf16_t*)take((size_t)T_TOK * US * 2);
  p.vT = (bf16_t*)take((size_t)T_TOK * 512 * 2);
  p.vfirst = (bf16_t*)take((size_t)T_TOK * 512 * 2);
  p.vlo = (float*)take((size_t)T_TOK * 32 * 4);
  if (off > ws_size) { fprintf(stderr, "workspace too small: need %zu have %zu\n", off, ws_size); return; }

  static int grid_blocks = 0;
  if (!grid_blocks) {
    hipFuncSetAttribute((const void*)mega, hipFuncAttributeMaxDynamicSharedMemorySize, 2 * SMEM_BYTES);
    int dev = 0, cus = 0, per_cu = 0;
    hipGetDevice(&dev);
    hipDeviceGetAttribute(&cus, hipDeviceAttributeMultiprocessorCount, dev);
    hipOccupancyMaxActiveBlocksPerMultiprocessor(&per_cu, mega, 512, 2 * SMEM_BYTES);
    if (per_cu > 1) per_cu = 1;
    if (per_cu < 1) per_cu = 1;
    grid_blocks = cus * per_cu;
  }
#if SINGLE_LAUNCH
  int lo = 0, hi = NPHASE;
  void* args[] = {&p, &lo, &hi};
  hipError_t e = hipLaunchCooperativeKernel((void*)mega, dim3(grid_blocks), dim3(512), args, 2 * SMEM_BYTES, stream);
  if (e != hipSuccess) fprintf(stderr, "cooperative launch failed: %s (grid %d)\n", hipGetErrorString(e), grid_blocks);
#else
  for (int ph = 0; ph < NPHASE; ++ph) {
    if (ph == 3) continue;
    hipLaunchKernelGGL(mega, dim3(grid_blocks), dim3(512), 2 * SMEM_BYTES, stream, p, ph, ph + 1);
  }
#endif
}
```

```cpp
#include <hip/hip_runtime.h>
#include <hip/hip_cooperative_groups.h>
#include <stdint.h>
#include <cstdio>
namespace cg = cooperative_groups;

typedef unsigned short bf16_t;
typedef short bf16x8 __attribute__((ext_vector_type(8)));
typedef float f32x4 __attribute__((ext_vector_type(4)));
typedef float f32x2 __attribute__((ext_vector_type(2)));
#define DEV __device__ __forceinline__
#define PHASE __device__ __forceinline__

#ifndef SINGLE_LAUNCH
#define SINGLE_LAUNCH 1
#endif

constexpr int T_TOK = 65536, DM = 1024, SEQ = 2048, US = 4864, ADAW = 6144, FFH = 2816;
constexpr size_t WIN = 0, WBA = 8650752, WBB = 9175040, WBC = 9699328, WOUT = 10223616, WFI = 11272192,
                 WFO = 17039360, WLAYER = 19922944;
constexpr int SMEM_BYTES = 80896;
constexpr int NPHASE = 20;

struct Params {
  const float* x; const float* c; const int* pos;
  const float *ada_w, *ada_b, *norm_mix_w, *norm_ffn_w, *w_in, *da_lambda, *da_subln_w, *hg_lb, *hg_norm_w;
  const float *rw_mu, *rw_w0, *rw_w2, *rw_a0, *rw_a2, *rw_g2, *rw_k_k, *rw_k_a, *rw_r_k, *rw_gn_w, *rw_gn_b;
  const float *rw_v0, *rw_v1, *rw_v2, *w_br_a, *w_br_b, *w_br_c, *w_out, *ffn_w_in, *ffn_w_out, *final_norm_w;
  float* out;
  bf16_t* wt; float* ada; bf16_t* h; bf16_t* u; bf16_t* vT; bf16_t* vfirst; float* vlo; unsigned* counters;
};

DEV unsigned short f2bf(float f) { unsigned u = __float_as_uint(f); u += 0x7FFFu + ((u >> 16) & 1u); return (unsigned short)(u >> 16); }
DEV float bf2f(unsigned short h) { return __uint_as_float(((unsigned)h) << 16); }
DEV unsigned pack2(float a, float b) { return (unsigned)f2bf(a) | ((unsigned)f2bf(b) << 16); }
DEV float sigm(float x) { return 1.f / (1.f + __expf(-x)); }
DEV float lo16(unsigned v) { return __uint_as_float(v << 16); }
DEV float hi16(unsigned v) { return __uint_as_float(v & 0xFFFF0000u); }
#define UNPACK8(v, f) { f[0]=lo16(v.x); f[1]=hi16(v.x); f[2]=lo16(v.y); f[3]=hi16(v.y); f[4]=lo16(v.z); f[5]=hi16(v.z); f[6]=lo16(v.w); f[7]=hi16(v.w); }
#define PACK8(f) make_uint4(pack2(f[0],f[1]), pack2(f[2],f[3]), pack2(f[4],f[5]), pack2(f[6],f[7]))
template <int CTRL> DEV float dpp(float x) { return __int_as_float(__builtin_amdgcn_update_dpp(0, __float_as_int(x), CTRL, 0xF, 0xF, true)); }
DEV float red8_sum(float x) { x += dpp<0xB1>(x); x += dpp<0x4E>(x); x += dpp<0x141>(x); return x; }
DEV float red16_sum(float x) { x = red8_sum(x); x += dpp<0x140>(x); return x; }
DEV float red16_max(float x) { x = fmaxf(x, dpp<0xB1>(x)); x = fmaxf(x, dpp<0x4E>(x)); x = fmaxf(x, dpp<0x141>(x)); x = fmaxf(x, dpp<0x140>(x)); return x; }
DEV float wave_sum(float x) {
  x = red16_sum(x);
  const int xi = __float_as_int(x);
  return __int_as_float(__builtin_amdgcn_readlane(xi, 0)) + __int_as_float(__builtin_amdgcn_readlane(xi, 16)) +
         __int_as_float(__builtin_amdgcn_readlane(xi, 32)) + __int_as_float(__builtin_amdgcn_readlane(xi, 48));
}
DEV int opaque_tid() { int t = threadIdx.x & 255; asm volatile("" : "+v"(t)); return t; }
DEV int opaque_tid512() { int t = threadIdx.x; asm volatile("" : "+v"(t)); return t; }
DEV int vhalf() { return __builtin_amdgcn_readfirstlane((int)(threadIdx.x >> 8)); }
DEV int vblock() { return (int)blockIdx.x * 2 + vhalf(); }
DEV int vgrid() { return (int)gridDim.x * 2; }
DEV bf16x8 as_frag(uint4 v) { union { uint4 u; bf16x8 b; } c; c.u = v; return c.b; }
#define MFMA(a, b, c) __builtin_amdgcn_mfma_f32_16x16x32_bf16(a, b, c, 0, 0, 0)

template <int NT>
DEV void gemm_tile(const int tid_in, const bf16_t* A, int lda, const bf16_t* B, int ldb, int K, char* smem,
                   f32x4 (&acc)[4][NT]) {
  int tid = tid_in; asm volatile("" : "+v"(tid));
  constexpr int BN = NT * 32;
  constexpr int LS = 64;
  bf16_t* As = (bf16_t*)smem;
  bf16_t* Bs = As + 2 * 128 * LS;
  const int lane = tid & 63, wave = tid >> 6, wr = wave >> 1, wc = wave & 1;
  const int fr = lane & 15, fq = lane >> 4;
  constexpr int NB = BN * 8 / 256;
#pragma unroll
  for (int m = 0; m < 4; ++m)
#pragma unroll
    for (int n = 0; n < NT; ++n) acc[m][n] = (f32x4){0.f, 0.f, 0.f, 0.f};
  const int nk = K >> 6;
  const int lrow = tid >> 3, lcc = tid & 7;
  const bf16_t* Ap = A + (size_t)lrow * lda + ((lcc ^ (lrow & 7)) * 8);
  const bf16_t* Bp = B + (size_t)lrow * ldb + ((lcc ^ (lrow & 7)) * 8);
  const size_t a32 = (size_t)32 * lda, b32 = (size_t)32 * ldb;
  const int rofs0 = (fq ^ (fr & 7)) * 8, rofs1 = rofs0 ^ 32;
#define GT_DMA(buf, koff)                                                                                    \
  {                                                                                                          \
    bf16_t* Ad = As + (buf) * 128 * LS + tid * 8;                                                            \
    bf16_t* Bd = Bs + (buf) * BN * LS + tid * 8;                                                             \
    _Pragma("unroll") for (int i = 0; i < 4; ++i)                                                            \
      __builtin_amdgcn_global_load_lds((const unsigned*)(Ap + i * a32 + (koff)), (unsigned*)(Ad + i * 32 * LS), 16, 0, 0); \
    _Pragma("unroll") for (int i = 0; i < NB; ++i)                                                           \
      __builtin_amdgcn_global_load_lds((const unsigned*)(Bp + i * b32 + (koff)), (unsigned*)(Bd + i * 32 * LS), 16, 0, 0); \
  }
  GT_DMA(0, 0)
  asm volatile("s_waitcnt vmcnt(0)" ::: "memory");
  __syncthreads();
  for (int kt = 0; kt < nk; ++kt) {
    const int buf = kt & 1;
    if (kt + 1 < nk) GT_DMA(buf ^ 1, (kt + 1) * 64)
    const bf16_t* Ab = As + buf * 128 * LS + (wr * 64 + fr) * LS;
    const bf16_t* Bb = Bs + buf * BN * LS + (wc * (NT * 16) + fr) * LS;
#pragma unroll
    for (int ks = 0; ks < 2; ++ks) {
      const int ro = ks ? rofs1 : rofs0;
      bf16x8 af[4], bfr[NT];
#pragma unroll
      for (int m = 0; m < 4; ++m) af[m] = *(const bf16x8*)(Ab + m * 16 * LS + ro);
#pragma unroll
      for (int n = 0; n < NT; ++n) bfr[n] = *(const bf16x8*)(Bb + n * 16 * LS + ro);
#pragma unroll
      for (int m = 0; m < 4; ++m)
#pragma unroll
        for (int n = 0; n < NT; ++n) acc[m][n] = MFMA(af[m], bfr[n], acc[m][n]);
    }
    asm volatile("s_waitcnt vmcnt(0)" ::: "memory");
    __syncthreads();
  }
#undef GT_DMA
}

template <int NT>
DEV void stage_acc(const int tid, float* Cs, const f32x4 (&acc)[4][NT]) {
  constexpr int LDC = NT * 32 + 4;
  const int lane = tid & 63, wave = tid >> 6, wr = wave >> 1, wc = wave & 1, fr = lane & 15, fq = lane >> 4;
#pragma unroll
  for (int m = 0; m < 4; ++m)
#pragma unroll
    for (int n = 0; n < NT; ++n)
#pragma unroll
      for (int j = 0; j < 4; ++j) Cs[(wr * 64 + m * 16 + fq * 4 + j) * LDC + wc * (NT * 16) + n * 16 + fr] = acc[m][n][j];
}

DEV void gemm_tile256(const int tid, const bf16_t* A, int lda, const bf16_t* B, int ldb, int K, char* smem,
                      f32x4 (&acc)[8][4]) {
  bf16_t* As = (bf16_t*)smem;
  bf16_t* Bs = As + 3 * 8192;
  const int lane = tid & 63, wave = tid >> 6, wr = wave >> 1, wc = wave & 1;
  const int fr = lane & 15, fq = lane >> 4;
#pragma unroll
  for (int m = 0; m < 8; ++m)
#pragma unroll
    for (int n = 0; n < 4; ++n) acc[m][n] = (f32x4){0.f, 0.f, 0.f, 0.f};
  const int nk = K >> 5;
  const int drow = tid >> 2, dphys = tid & 3, dg = (0 - (tid >> 4)) & 3;
  const bf16_t* Ap = A + (size_t)drow * lda + ((dphys ^ dg) * 8);
  const bf16_t* Bp = B + (size_t)drow * ldb + ((dphys ^ dg) * 8);
  const size_t a64 = (size_t)64 * lda, b64 = (size_t)64 * ldb;
  const int rofs = (fq ^ ((0 - (fr >> 2)) & 3)) * 8;
#define G2_DMA(st, kk)                                                                                        \
  {                                                                                                           \
    bf16_t* Ad = As + (st) * 8192 + tid * 8;                                                                  \
    bf16_t* Bd = Bs + (st) * 4096 + tid * 8;                                                                  \
    _Pragma("unroll") for (int i = 0; i < 4; ++i)                                                             \
      __builtin_amdgcn_global_load_lds((const unsigned*)(Ap + i * a64 + (kk) * 32), (unsigned*)(Ad + i * 2048), 16, 0, 0); \
    _Pragma("unroll") for (int i = 0; i < 2; ++i)                                                             \
      __builtin_amdgcn_global_load_lds((const unsigned*)(Bp + i * b64 + (kk) * 32), (unsigned*)(Bd + i * 2048), 16, 0, 0); \
  }
  G2_DMA(0, 0)
  G2_DMA(1, 1)
  int st = 0;
  for (int kt = 0; kt < nk; ++kt) {
    if (kt + 1 < nk) asm volatile("s_waitcnt vmcnt(6)" ::: "memory");
    else asm volatile("s_waitcnt vmcnt(0)" ::: "memory");
    __builtin_amdgcn_s_barrier();
    asm volatile("" ::: "memory");
    const int s2 = (st >= 1) ? st - 1 : 2;
    const bool pf = (kt + 2 < nk);
    bf16_t* Ad = As + s2 * 8192 + tid * 8;
    bf16_t* Bd = Bs + s2 * 4096 + tid * 8;
    const bf16_t* Asrc = Ap + (kt + 2) * 32;
    const bf16_t* Bsrc = Bp + (kt + 2) * 32;
    const bf16_t* Ab = As + st * 8192 + (wr * 128 + fr) * 32 + rofs;
    const bf16_t* Bb = Bs + st * 4096 + (wc * 64 + fr) * 32 + rofs;
    bf16x8 bfr[4], af[4];
#pragma unroll
    for (int n = 0; n < 4; ++n) bfr[n] = *(const bf16x8*)(Bb + n * 512);
#pragma unroll
    for (int m = 0; m < 4; ++m) af[m] = *(const bf16x8*)(Ab + m * 512);
#pragma unroll
    for (int m = 0; m < 8; ++m) {
#pragma unroll
      for (int n = 0; n < 4; ++n) acc[m][n] = MFMA(af[m & 3], bfr[n], acc[m][n]);
      if (m + 4 < 8) af[m & 3] = *(const bf16x8*)(Ab + (m + 4) * 512);
      if (pf) {
        if (m < 4) __builtin_amdgcn_global_load_lds((const unsigned*)(Asrc + m * a64), (unsigned*)(Ad + m * 2048), 16, 0, 0);
        else if (m < 6) __builtin_amdgcn_global_load_lds((const unsigned*)(Bsrc + (m - 4) * b64), (unsigned*)(Bd + (m - 4) * 2048), 16, 0, 0);
      }
      __builtin_amdgcn_sched_barrier(0);
    }
    st = (st == 2) ? 0 : st + 1;
  }
#undef G2_DMA
  __syncthreads();
}

template <int PS>
DEV void stage_half(const int tid, float* Cs, const f32x4 (&acc)[8][4]) {
  const int lane = tid & 63, wave = tid >> 6, wr = wave >> 1, wc = wave & 1, fr = lane & 15, fq = lane >> 4;
#pragma unroll
  for (int m = 0; m < 4; ++m)
#pragma unroll
    for (int n = 0; n < 4; ++n)
#pragma unroll
      for (int j = 0; j < 4; ++j) Cs[(wr * 64 + m * 16 + fq * 4 + j) * 132 + wc * 64 + n * 16 + fr] = acc[PS * 4 + m][n][j];
}
#define RMAP(r, ps) ((((r) >> 6) << 7) + (ps) * 64 + ((r) & 63))

DEV void gemm_tile512(const int T, const bf16_t* A, int lda, const bf16_t* B, int ldb, int K, char* smem0,
                      f32x4 (&acc)[8][4]) {
  bf16_t* As = (bf16_t*)smem0;
  bf16_t* Bs = As + 2 * 16384;
  const int lane = T & 63, wave = T >> 6, wr = wave >> 2, wc = wave & 3;
  const int fr = lane & 15, fq = lane >> 4;
#pragma unroll
  for (int m = 0; m < 8; ++m)
#pragma unroll
    for (int n = 0; n < 4; ++n) acc[m][n] = (f32x4){0.f, 0.f, 0.f, 0.f};
  const int nk = K >> 6;
  const int drow = T >> 3, dlog = ((T & 7) ^ ((T >> 3) & 7)) * 8;
  const bf16_t* Ap = A + (size_t)drow * lda + dlog;
  const bf16_t* Bp = B + (size_t)drow * ldb + dlog;
  const size_t a64 = (size_t)64 * lda, b64 = (size_t)64 * ldb;
  const int rofs0 = (fq ^ (fr & 7)) * 8, rofs1 = rofs0 ^ 32;
#pragma unroll
  for (int i = 0; i < 4; ++i) {
    __builtin_amdgcn_global_load_lds((const unsigned*)(Ap + i * a64), (unsigned*)(As + T * 8 + i * 4096), 16, 0, 0);
    __builtin_amdgcn_global_load_lds((const unsigned*)(Bp + i * b64), (unsigned*)(Bs + T * 8 + i * 4096), 16, 0, 0);
  }
  asm volatile("s_waitcnt vmcnt(0)" ::: "memory");
  __syncthreads();
  for (int kt = 0; kt < nk; ++kt) {
    const int buf = kt & 1;
    const bool pf = (kt + 1 < nk);
    bf16_t* Ad = As + (buf ^ 1) * 16384 + T * 8;
    bf16_t* Bd = Bs + (buf ^ 1) * 16384 + T * 8;
    const bf16_t* Asrc = Ap + (kt + 1) * 64;
    const bf16_t* Bsrc = Bp + (kt + 1) * 64;
    const bf16_t* Ab = As + buf * 16384 + (wr * 128 + fr) * 64;
    const bf16_t* Bb = Bs + buf * 16384 + (wc * 64 + fr) * 64;
#pragma unroll
    for (int ks = 0; ks < 2; ++ks) {
      const int ro = ks ? rofs1 : rofs0;
      bf16x8 bfr[4], af[4];
#pragma unroll
      for (int n = 0; n < 4; ++n) bfr[n] = *(const bf16x8*)(Bb + n * 1024 + ro);
#pragma unroll
      for (int m = 0; m < 4; ++m) af[m] = *(const bf16x8*)(Ab + m * 1024 + ro);
#pragma unroll
      for (int m = 0; m < 8; ++m) {
#pragma unroll
        for (int n = 0; n < 4; ++n) acc[m][n] = MFMA(af[m & 3], bfr[n], acc[m][n]);
        if (m + 4 < 8) af[m & 3] = *(const bf16x8*)(Ab + (m + 4) * 1024 + ro);
        if (pf && (m & 1)) {
          const int piece = ks * 4 + (m >> 1);
          if (piece < 4) __builtin_amdgcn_global_load_lds((const unsigned*)(Asrc + piece * a64), (unsigned*)(Ad + piece * 4096), 16, 0, 0);
          else __builtin_amdgcn_global_load_lds((const unsigned*)(Bsrc + (piece - 4) * b64), (unsigned*)(Bd + (piece - 4) * 4096), 16, 0, 0);
        }
        __builtin_amdgcn_sched_barrier(0);
      }
    }
    asm volatile("s_waitcnt vmcnt(0)" ::: "memory");
    __builtin_amdgcn_s_barrier();
    asm volatile("" ::: "memory");
  }
  __syncthreads();
}
template <int PS>
DEV void stage_half512(const int T, float* Cs, const f32x4 (&acc)[8][4]) {
  const int lane = T & 63, wave = T >> 6, wc = wave & 3, fr = lane & 15, fq = lane >> 4;
#pragma unroll
  for (int m = 0; m < 4; ++m)
#pragma unroll
    for (int n = 0; n < 4; ++n)
#pragma unroll
      for (int j = 0; j < 4; ++j) Cs[((wc >> 1) * 64 + m * 16 + fq * 4 + j) * 132 + (wc & 1) * 64 + n * 16 + fr] = acc[PS * 4 + m][n][j];
}
#define GROW(r, ps) (row0 + (size_t)(hf * 128 + (ps) * 64 + ((r) & 63)))
#define TNC(r) (tn * 2 + ((r) >> 6))

DEV bool tile_for(int it, int nM, int nN, int& tm, int& tn) {
  const int nx = (gridDim.x >> 3) * 2;
  const int xcd = blockIdx.x & 7, local = (blockIdx.x >> 3) * 2 + vhalf();
  const long id = ((long)it * 8 + xcd) * nx + local;
  if (local >= nx || id >= (long)nM * nN) return false;
  const int per_group = 8 * nN;
  const int g = (int)(id / per_group), r = (int)(id % per_group);
  tn = r >> 3; tm = g * 8 + (r & 7);
  return true;
}

DEV bool tile_for_real(int it, int nM, int nN, int& tm, int& tn) {
  const int nx = (gridDim.x >> 3);
  const int xcd = blockIdx.x & 7, local = (blockIdx.x >> 3);
  const long id = ((long)it * 8 + xcd) * nx + local;
  if (local >= nx || id >= (long)nM * nN) return false;
  const int per_group = 8 * nN;
  const int g = (int)(id / per_group), r = (int)(id % per_group);
  tn = r >> 3; tm = g * 8 + (r & 7);
  return true;
}

PHASE void phase_prep(const Params& p, char* smem) {
  const int tid = opaque_tid();
  const int vb = vblock(), vg = vgrid();
  if (vb == 0 && tid < 8) p.counters[tid] = 0u;
  if (vb == 0) for (int i = tid; i < 3456; i += 256) p.counters[256 + i] = 0u;
  float* tile = (float*)smem;
  const int NCONV = 2 * 4864, NADA = 192;
  for (int item0 = vb; item0 < NCONV + NADA; item0 += vg) {
    const int item = (item0 < NADA) ? (NCONV + item0) : (item0 - NADA);
    if (item < NCONV) {
      const int l = item / 4864; int r = item % 4864;
      const float* src; int K, Nsrc, nT, perm = 0; size_t dst;
      if (r < 2112) { src = p.w_in + (size_t)l * 1024 * 8448; K = 1024; Nsrc = 8448; dst = WIN; nT = 132; }
      else if (r < 2240) { r -= 2112; src = p.w_br_a + (size_t)l * 512 * 1024; K = 512; Nsrc = 1024; dst = WBA; nT = 16; }
      else if (r < 2368) { r -= 2240; src = p.w_br_b + (size_t)l * 512 * 1024; K = 512; Nsrc = 1024; dst = WBB; nT = 16; }
      else if (r < 2496) { r -= 2368; src = p.w_br_c + (size_t)l * 512 * 1024; K = 512; Nsrc = 1024; dst = WBC; nT = 16; }
      else if (r < 2752) { r -= 2496; src = p.w_out + (size_t)l * 1024 * 1024; K = 1024; Nsrc = 1024; dst = WOUT; nT = 16; }
      else if (r < 4160) { r -= 2752; src = p.ffn_w_in + (size_t)l * 1024 * 5632; K = 1024; Nsrc = 5632; dst = WFI; nT = 88; perm = 1; }
      else { r -= 4160; src = p.ffn_w_out + (size_t)l * 2816 * 1024; K = 2816; Nsrc = 1024; dst = WFO; nT = 16; }
      const int kt = r / nT, nt = r % nT;
      const int colbase = perm ? ((nt & 1) * FFH + 64 * (nt >> 1)) : nt * 64;
      __syncthreads();
#pragma unroll
      for (int i = 0; i < 16; ++i) {
        const int k = i * 4 + (tid >> 6), j = tid & 63;
        tile[k * 65 + j] = src[(size_t)(kt * 64 + k) * Nsrc + colbase + j];
      }
      __syncthreads();
      const int row = tid >> 2, kc = (tid & 3) * 16;
      float f[16];
#pragma unroll
      for (int i = 0; i < 16; ++i) f[i] = tile[(kc + i) * 65 + row];
      bf16_t* d = p.wt + (size_t)l * WLAYER + dst + (size_t)(nt * 64 + row) * K + kt * 64 + kc;
      *(uint4*)d = make_uint4(pack2(f[0], f[1]), pack2(f[2], f[3]), pack2(f[4], f[5]), pack2(f[6], f[7]));
      *(uint4*)(d + 8) = make_uint4(pack2(f[8], f[9]), pack2(f[10], f[11]), pack2(f[12], f[13]), pack2(f[14], f[15]));
    } else {
      const int a = item - NCONV;
      const int l = a / 96, r = a % 96, ntile = r >> 2, bg = r & 3;
      float* cact = (float*)smem;
      __syncthreads();
      for (int i = tid; i < 8 * 1024; i += 256) {
        const float cv = p.c[(size_t)(bg * 8 + (i >> 10)) * DM + (i & 1023)];
        cact[i] = cv * sigm(cv);
      }
      __syncthreads();
      const int n = ntile * 256 + tid;
      const float* W = p.ada_w + (size_t)l * DM * ADAW + n;
      float acc[8];
#pragma unroll
      for (int b = 0; b < 8; ++b) acc[b] = 0.f;
      for (int k0 = 0; k0 < DM; k0 += 16) {
        float w[16];
#pragma unroll
        for (int kk = 0; kk < 16; ++kk) w[kk] = W[(size_t)(k0 + kk) * ADAW];
#pragma unroll
        for (int kk = 0; kk < 16; ++kk)
#pragma unroll
          for (int b = 0; b < 8; ++b) acc[b] += cact[b * 1024 + k0 + kk] * w[kk];
      }
      const float bias = p.ada_b[l * ADAW + n];
#pragma unroll
      for (int b = 0; b < 8; ++b) p.ada[((size_t)l * 32 + bg * 8 + b) * ADAW + n] = acc[b] + bias;
    }
  }
}

PHASE void phase_norm(const float* __restrict__ x, const float* __restrict__ w, const float* __restrict__ ada_l,
                    int shift_off, int scale_off, bf16_t* __restrict__ h) {
  const int tid = opaque_tid();
  const int lane = tid & 63, wave = tid >> 6;
  for (int row0 = (vblock() * 4 + wave) * 4; row0 < T_TOK; row0 += vgrid() * 16) {
    float4 v[4][4]; float ss[4];
#pragma unroll
    for (int rr = 0; rr < 4; ++rr)
#pragma unroll
      for (int i = 0; i < 4; ++i) v[rr][i] = *(const float4*)(x + (size_t)(row0 + rr) * DM + i * 256 + lane * 4);
#pragma unroll
    for (int rr = 0; rr < 4; ++rr) {
      float a = 0.f;
#pragma unroll
      for (int i = 0; i < 4; ++i) a += v[rr][i].x * v[rr][i].x + v[rr][i].y * v[rr][i].y + v[rr][i].z * v[rr][i].z + v[rr][i].w * v[rr][i].w;
      ss[rr] = rsqrtf(wave_sum(a) * (1.f / DM) + 1e-6f);
    }
    const float* ad = ada_l + (size_t)(row0 / SEQ) * ADAW;
#pragma unroll
    for (int i = 0; i < 4; ++i) {
      const int col = i * 256 + lane * 4;
      const float4 ww = *(const float4*)(w + col), sc = *(const float4*)(ad + scale_off + col), sh = *(const float4*)(ad + shift_off + col);
#pragma unroll
      for (int rr = 0; rr < 4; ++rr) {
        const float rstd = ss[rr];
        const float o0 = v[rr][i].x * rstd * ww.x * (1.f + sc.x) + sh.x, o1 = v[rr][i].y * rstd * ww.y * (1.f + sc.y) + sh.y;
        const float o2 = v[rr][i].z * rstd * ww.z * (1.f + sc.z) + sh.z, o3 = v[rr][i].w * rstd * ww.w * (1.f + sc.w) + sh.w;
        *(uint2*)(h + (size_t)(row0 + rr) * DM + col) = make_uint2(pack2(o0, o1), pack2(o2, o3));
      }
    }
  }
}

PHASE void phase_final(float* __restrict__ x, const float* __restrict__ w) {
  const int tid = opaque_tid();
  const int lane = tid & 63, wave = tid >> 6;
  for (int row0 = (vblock() * 4 + wave) * 4; row0 < T_TOK; row0 += vgrid() * 16) {
    float4 v[4][4]; float ss[4];
#pragma unroll
    for (int rr = 0; rr < 4; ++rr)
#pragma unroll
      for (int i = 0; i < 4; ++i) v[rr][i] = *(const float4*)(x + (size_t)(row0 + rr) * DM + i * 256 + lane * 4);
#pragma unroll
    for (int rr = 0; rr < 4; ++rr) {
      float a = 0.f;
#pragma unroll
      for (int i = 0; i < 4; ++i) a += v[rr][i].x * v[rr][i].x + v[rr][i].y * v[rr][i].y + v[rr][i].z * v[rr][i].z + v[rr][i].w * v[rr][i].w;
      ss[rr] = rsqrtf(wave_sum(a) * (1.f / DM) + 1e-6f);
    }
#pragma unroll
    for (int i = 0; i < 4; ++i) {
      const int col = i * 256 + lane * 4;
      const float4 ww = *(const float4*)(w + col);
#pragma unroll
      for (int rr = 0; rr < 4; ++rr) {
        const float rstd = ss[rr];
        *(float4*)(x + (size_t)(row0 + rr) * DM + col) =
            make_float4(v[rr][i].x * rstd * ww.x, v[rr][i].y * rstd * ww.y, v[rr][i].z * rstd * ww.z, v[rr][i].w * rstd * ww.w);
      }
    }
  }
}

PHASE void phase_gemm_in(const Params& p, int l, char* smem0) {
  const bf16_t* Wt = p.wt + (size_t)l * WLAYER + WIN;
  const int T = opaque_tid512(), tid = T & 255, hf = vhalf();
  float* Cs = (float*)(smem0 + hf * SMEM_BYTES);
  for (int it = 0;; ++it) {
    int tm, tn;
    if (!tile_for_real(it, 256, 21, tm, tn)) break;
    f32x4 acc[8][4];
    gemm_tile512(T, p.h + (size_t)tm * 256 * DM, DM, Wt + (size_t)tn * 256 * DM, DM, DM, smem0, acc);
    const size_t row0 = (size_t)tm * 256;
#pragma unroll
    for (int ps = 0; ps < 2; ++ps) {
      if (ps == 0) stage_half512<0>(T, Cs, acc); else stage_half512<1>(T, Cs, acc);
      __syncthreads();
      if (tn < 4) {
        const float qs = (tn < 2) ? 0.125f : 1.f;
        const int ch = tid & 15, g = ch >> 3, cc = ch & 7;
        if (cc < 4) {
#pragma unroll 1
          for (int i = 0; i < 8; ++i) {
            const int r = (tid >> 4) + i * 16;
            const size_t grow = GROW(r, ps);
            const float pos = (float)p.pos[grow];
            const float* c1 = Cs + r * 132 + g * 64 + cc * 8;
            float o1[8], o2[8];
#pragma unroll
            for (int e = 0; e < 8; ++e) {
              const float x1 = c1[e], x2 = c1[32 + e];
              const float inv = exp2f(-(float)(cc * 8 + e) * 0.41524101186092029f);
              float rev = pos * inv * 0.15915494309189535f;
              rev -= rintf(rev);
              const float sn = __builtin_amdgcn_sinf(rev), cs = __builtin_amdgcn_cosf(rev);
              o1[e] = (x1 * cs - x2 * sn) * qs; o2[e] = (x2 * cs + x1 * sn) * qs;
            }
            bf16_t* d = p.u + grow * US + TNC(r) * 128 + g * 64 + cc * 8;
            *(uint4*)d = PACK8(o1);
            *(uint4*)(d + 32) = PACK8(o2);
          }
        }
      } else if (tn < 6) {
        const int b = (int)(row0 / SEQ), s0 = (int)(row0 % SEQ);
        const int rch = tid & 15;
        const int vc0 = (TNC(rch * 8) - 8) * 128;
#pragma unroll 1
        for (int i = 0; i < 8; ++i) {
          const int c = (tid >> 4) + i * 16;
          float f[8];
#pragma unroll
          for (int j = 0; j < 8; ++j) f[j] = Cs[(rch * 8 + j) * 132 + c];
          *(uint4*)(p.vT + ((size_t)b * 512 + vc0 + c) * SEQ + s0 + hf * 128 + ps * 64 + ((rch * 8) & 63)) = PACK8(f);
        }
      } else {
        const int ch = tid & 15;
#pragma unroll 1
        for (int i = 0; i < 8; ++i) {
          const int r = (tid >> 4) + i * 16;
          const float4 a = *(const float4*)(Cs + r * 132 + ch * 8), b = *(const float4*)(Cs + r * 132 + ch * 8 + 4);
          *(uint4*)(p.u + GROW(r, ps) * US + TNC(r) * 128 - 512 + ch * 8) = make_uint4(pack2(a.x, a.y), pack2(a.z, a.w), pack2(b.x, b.y), pack2(b.z, b.w));
        }
      }
      __syncthreads();
    }
  }
}

PHASE void phase_vlo(const Params& p, int l, char* smem) {
  float* vs = (float*)smem;
  const int tid = opaque_tid();
  const float* mu = p.rw_mu + (size_t)l * 1792 + 1024;
  const float* v1 = p.rw_v1;
  for (int item = vblock(); item < T_TOK / 32; item += vgrid()) {
    const size_t tok0 = (size_t)item * 32;
    __syncthreads();
#pragma unroll 1
    for (int i = 0; i < 8; ++i) {
      const int c = tid + i * 256;
      const int t = c >> 6, cc = c & 63;
      const size_t tok = tok0 + t;
      const uint4 cur = *(const uint4*)(p.u + tok * US + 3072 + 1024 + cc * 8);
      uint4 prv = make_uint4(0, 0, 0, 0);
      if ((tok % SEQ) != 0) prv = *(const uint4*)(p.u + (tok - 1) * US + 3072 + 1024 + cc * 8);
      float a[8], b[8];
      UNPACK8(cur, a); UNPACK8(prv, b);
#pragma unroll
      for (int e = 0; e < 8; ++e) vs[t * 512 + cc * 8 + e] = a[e] + (b[e] - a[e]) * mu[cc * 8 + e];
    }
    __syncthreads();
    const int j = tid & 31, tg = tid >> 5;
    float acc[4] = {0.f, 0.f, 0.f, 0.f};
    for (int k0 = 0; k0 < 512; k0 += 16) {
      float w[16];
#pragma unroll
      for (int kk = 0; kk < 16; ++kk) w[kk] = v1[(k0 + kk) * 32 + j];
#pragma unroll
      for (int kk = 0; kk < 16; ++kk)
#pragma unroll
        for (int i = 0; i < 4; ++i) acc[i] += vs[(tg * 4 + i) * 512 + k0 + kk] * w[kk];
    }
#pragma unroll
    for (int i = 0; i < 4; ++i) p.vlo[(tok0 + tg * 4 + i) * 32 + j] = acc[i];
  }
}

PHASE void att_item(const Params& p, int l, int item, char* smem) {
  const int qc = 31 - (item >> 7);
  const int bh = item & 127, b = bh >> 2, h = bh & 3;
  const int tid = opaque_tid(), lane = tid & 63, wave = tid >> 6, fr = lane & 15, fq = lane >> 4;
  const int m = wave >> 1, rh = wave & 1;
  bf16_t* Ks = (bf16_t*)smem;
  bf16_t* Vt = Ks + 2 * 64 * 64;
  bf16_t* Ps = Vt + 128 * 64;
  float* Ox = (float*)smem;
  const size_t tok0 = (size_t)b * SEQ + (size_t)qc * 64;
  const float* lv = p.da_lambda + (size_t)l * 256;
  float d1 = 0.f, d2 = 0.f;
  for (int i = 0; i < 64; ++i) { d1 += lv[i] * lv[64 + i]; d2 += lv[128 + i] * lv[192 + i]; }
  const float lam_init = 0.8f - 0.6f * __expf(-0.3f * (float)l);
  const float lam = __expf(d1) - __expf(d2) + lam_init;

  bf16x8 qf[2][2];
#pragma unroll
  for (int mt = 0; mt < 2; ++mt)
#pragma unroll
    for (int ks = 0; ks < 2; ++ks)
      qf[mt][ks] = *(const bf16x8*)(p.u + (tok0 + rh * 32 + mt * 16 + fr) * US + h * 128 + m * 64 + ks * 32 + fq * 8);
  f32x4 o[2][8];
  float mx[2][4], ls[2][4];
#pragma unroll
  for (int mt = 0; mt < 2; ++mt) {
#pragma unroll
    for (int n = 0; n < 8; ++n) o[mt][n] = (f32x4){0.f, 0.f, 0.f, 0.f};
#pragma unroll
    for (int j = 0; j < 4; ++j) { mx[mt][j] = -1e30f; ls[mt][j] = 0.f; }
  }
  bf16_t* Pw = Ps + wave * 32 * 72;
  const int drow = tid >> 3, dlog = ((tid & 7) ^ ((tid >> 3) & 7)) * 8;
  const bf16_t* Kg = p.u + ((size_t)b * SEQ + (drow & 63)) * US + 512 + h * 128 + dlog;
  const bf16_t* Vg = p.vT + ((size_t)b * 512 + h * 128 + drow) * SEQ + dlog;
  const int rsw = fr & 7;
#define ATT_DMA_K(kt_)                                                                                              \
  _Pragma("unroll") for (int i = 0; i < 4; ++i)                                                                     \
    __builtin_amdgcn_global_load_lds((const unsigned*)(Kg + ((size_t)(kt_) * 64 + (i & 1) * 32) * US + (i >> 1) * 64), \
                                     (unsigned*)(Ks + tid * 8 + i * 2048), 16, 0, 0);
#define ATT_DMA_V(kt_)                                                                                              \
  _Pragma("unroll") for (int i = 0; i < 4; ++i)                                                                     \
    __builtin_amdgcn_global_load_lds((const unsigned*)(Vg + (size_t)(i * 32) * SEQ + (kt_) * 64),                  \
                                     (unsigned*)(Vt + tid * 8 + i * 2048), 16, 0, 0);
  __syncthreads();
  ATT_DMA_K(0)
  for (int kt = 0; kt <= qc; ++kt) {
    asm volatile("s_waitcnt vmcnt(0)" ::: "memory");
    __syncthreads();
    ATT_DMA_V(kt)
    f32x4 s[2][4];
#pragma unroll
    for (int mt = 0; mt < 2; ++mt)
#pragma unroll
      for (int n = 0; n < 4; ++n) s[mt][n] = (f32x4){0.f, 0.f, 0.f, 0.f};
#pragma unroll
    for (int ks = 0; ks < 2; ++ks)
#pragma unroll
      for (int n = 0; n < 4; ++n) {
        const bf16x8 kf = *(const bf16x8*)(Ks + (m * 64 + n * 16 + fr) * 64 + (((ks * 4 + fq) ^ rsw) * 8));
#pragma unroll
        for (int mt = 0; mt < 2; ++mt) s[mt][n] = MFMA(qf[mt][ks], kf, s[mt][n]);
      }
#pragma unroll
    for (int mt = 0; mt < 2; ++mt)
#pragma unroll
      for (int j = 0; j < 4; ++j) {
        float tmax = fmaxf(fmaxf(s[mt][0][j], s[mt][1][j]), fmaxf(s[mt][2][j], s[mt][3][j]));
        tmax = red16_max(tmax);
        const float mnew = fmaxf(mx[mt][j], tmax);
        const float alpha = __expf(mx[mt][j] - mnew);
        float rs = 0.f;
#pragma unroll
        for (int n = 0; n < 4; ++n) {
          const float pv = __expf(s[mt][n][j] - mnew);
          rs += pv;
          Pw[(mt * 16 + fq * 4 + j) * 72 + n * 16 + fr] = f2bf(pv);
        }
        rs = red16_sum(rs);
        ls[mt][j] = ls[mt][j] * alpha + rs;
        mx[mt][j] = mnew;
#pragma unroll
        for (int n = 0; n < 8; ++n) o[mt][n][j] *= alpha;
      }
    asm volatile("s_waitcnt vmcnt(0)" ::: "memory");
    __syncthreads();
    if (kt < qc) { ATT_DMA_K(kt + 1) }
#pragma unroll
    for (int ks = 0; ks < 2; ++ks) {
      bf16x8 pf[2];
#pragma unroll
      for (int mt = 0; mt < 2; ++mt) pf[mt] = *(const bf16x8*)(Pw + (mt * 16 + fr) * 72 + ks * 32 + fq * 8);
#pragma unroll
      for (int n = 0; n < 8; ++n) {
        const bf16x8 vf = *(const bf16x8*)(Vt + (n * 16 + fr) * 64 + (((ks * 4 + fq) ^ rsw) * 8));
#pragma unroll
        for (int mt = 0; mt < 2; ++mt) o[mt][n] = MFMA(pf[mt], vf, o[mt][n]);
      }
    }
  }
#undef ATT_DMA_K
#undef ATT_DMA_V
  __syncthreads();
#pragma unroll
  for (int mt = 0; mt < 2; ++mt)
#pragma unroll
    for (int j = 0; j < 4; ++j) {
      const float inv = 1.f / ls[mt][j];
#pragma unroll
      for (int n = 0; n < 8; ++n) o[mt][n][j] *= inv;
    }
  if (m == 1) {
#pragma unroll
    for (int mt = 0; mt < 2; ++mt)
#pragma unroll
      for (int n = 0; n < 8; ++n)
#pragma unroll
        for (int j = 0; j < 4; ++j) Ox[(rh * 32 + mt * 16 + fq * 4 + j) * 132 + n * 16 + fr] = o[mt][n][j];
  }
  __syncthreads();
  if (m == 0) {
    const float* sw = p.da_subln_w + (size_t)l * 128;
    float wv[8];
#pragma unroll
    for (int n = 0; n < 8; ++n) wv[n] = sw[n * 16 + fr] * (1.f - lam_init);
#pragma unroll
    for (int mt = 0; mt < 2; ++mt)
#pragma unroll
      for (int j = 0; j < 4; ++j) {
        float ss = 0.f;
        float d[8];
#pragma unroll
        for (int n = 0; n < 8; ++n) {
          d[n] = o[mt][n][j] - lam * Ox[(rh * 32 + mt * 16 + fq * 4 + j) * 132 + n * 16 + fr];
          ss += d[n] * d[n];
        }
        ss = red16_sum(ss);
        const float rstd = rsqrtf(ss * (1.f / 128.f) + 1e-6f);
        bf16_t* dst = p.u + (tok0 + rh * 32 + mt * 16 + fq * 4 + j) * US + h * 128 + fr;
#pragma unroll
        for (int n = 0; n < 8; ++n) dst[n * 16] = f2bf(d[n] * rstd * wv[n]);
      }
  }
  __syncthreads();
}

PHASE void hgrn_item(const Params& p, int l, int item, char* smem) {
  const int b = item >> 2, h = item & 3;
  const int tid = opaque_tid(), lane = tid & 63, wave = tid >> 6, fr = lane & 15, fq = lane >> 4;
  bf16_t* Qs = (bf16_t*)smem;
  bf16_t* Kn = Qs + 32 * 136;
  bf16_t* KT = Kn + 32 * 136;
  bf16_t* VT = KT + 128 * 40;
  bf16_t* Ps = VT + 128 * 40;
  bf16_t* ST = Ps + 32 * 40;
  float* lfb = (float*)ST;
  float* red = (float*)(ST + 128 * 136);
  float* blast = red + 64;
  const int t_ = tid >> 3, d0 = (tid & 7) * 16;
  float lbv[16];
#pragma unroll
  for (int i = 0; i < 16; ++i) {
    const int c = h * 128 + d0 + i;
    lbv[i] = (l == 0) ? 0.f : sigm(p.hg_lb[512 + c] - p.hg_lb[c]);
  }
  f32x4 S[2][8];
#pragma unroll
  for (int mm = 0; mm < 2; ++mm)
#pragma unroll
    for (int n = 0; n < 8; ++n) S[mm][n] = (f32x4){0.f, 0.f, 0.f, 0.f};
  const float* nw = p.hg_norm_w + (size_t)l * 128;

  for (int ch = 0; ch < 64; ++ch) {
    const size_t tok0 = (size_t)b * SEQ + (size_t)ch * 32;
    __syncthreads();
    float qv[16], kv[16];
    {
      const bf16_t* base = p.u + (tok0 + t_) * US + h * 128 + d0;
      float zv[16], iv[16];
      { const uint4 a = *(const uint4*)(base + 1024), c = *(const uint4*)(base + 1024 + 8); float* z0 = zv; float* z1 = zv + 8; UNPACK8(a, z0); UNPACK8(c, z1); }
      { const uint4 a = *(const uint4*)(base + 1536), c = *(const uint4*)(base + 1536 + 8); float* z0 = iv; float* z1 = iv + 8; UNPACK8(a, z0); UNPACK8(c, z1); }
      { const uint4 a = *(const uint4*)(base + 2048), c = *(const uint4*)(base + 2048 + 8); float* z0 = qv; float* z1 = qv + 8; UNPACK8(a, z0); UNPACK8(c, z1); }
#pragma unroll
      for (int i = 0; i < 16; ++i) {
        const float z = zv[i], lb = lbv[i];
        const float ez = __expf(-fabsf(z));
        float lf;
        if (lb > 0.f) {
          const float sg = (z >= 0.f) ? 1.f / (1.f + ez) : ez / (1.f + ez);
          lf = __logf(lb + (1.f - lb) * sg);
        } else {
          lf = -(fmaxf(-z, 0.f) + __logf(1.f + ez));
        }
        const float sgn = (z >= 0.f) ? ez / (1.f + ez) : 1.f / (1.f + ez);
        kv[i] = (1.f - lb) * sgn;
        lfb[t_ * 128 + d0 + i] = lf;
        VT[(d0 + i) * 40 + t_] = f2bf(iv[i]);
      }
    }
    __syncthreads();
    if (tid < 128) {
      float v[32];
#pragma unroll
      for (int t = 0; t < 32; ++t) v[t] = lfb[t * 128 + tid];
      float bsum = 0.f;
#pragma unroll
      for (int t = 0; t < 32; ++t) { bsum += v[t]; lfb[t * 128 + tid] = bsum; }
      blast[tid] = bsum;
    }
    __syncthreads();
    {
      float qo[16], ko[16];
#pragma unroll
      for (int i = 0; i < 16; ++i) {
        const float bb = lfb[t_ * 128 + d0 + i];
        qo[i] = qv[i] * __expf(bb);
        ko[i] = kv[i] * __expf(fminf(-bb, 80.f));
        KT[(d0 + i) * 40 + t_] = f2bf(ko[i]);
      }
      float* q0 = qo; float* q1 = qo + 8; float* k0 = ko; float* k1 = ko + 8;
      *(uint4*)(Qs + t_ * 136 + d0) = PACK8(q0);
      *(uint4*)(Qs + t_ * 136 + d0 + 8) = PACK8(q1);
      *(uint4*)(Kn + t_ * 136 + d0) = PACK8(k0);
      *(uint4*)(Kn + t_ * 136 + d0 + 8) = PACK8(k1);
    }
    __syncthreads();
#pragma unroll
    for (int mm = 0; mm < 2; ++mm)
#pragma unroll
      for (int n = 0; n < 8; ++n)
        *(uint2*)(ST + (n * 16 + fr) * 136 + wave * 32 + mm * 16 + fq * 4) =
            make_uint2(pack2(S[mm][n][0], S[mm][n][1]), pack2(S[mm][n][2], S[mm][n][3]));
    {
      const int mt = wave >> 1, nt = wave & 1;
      f32x4 sc = (f32x4){0.f, 0.f, 0.f, 0.f};
#pragma unroll
      for (int ks = 0; ks < 4; ++ks) {
        const bf16x8 a = *(const bf16x8*)(Qs + (mt * 16 + fr) * 136 + ks * 32 + fq * 8);
        const bf16x8 bb = *(const bf16x8*)(Kn + (nt * 16 + fr) * 136 + ks * 32 + fq * 8);
        sc = MFMA(a, bb, sc);
      }
#pragma unroll
      for (int j = 0; j < 4; ++j) {
        const int t = mt * 16 + fq * 4 + j, key = nt * 16 + fr;
        Ps[t * 40 + key] = f2bf(key <= t ? sc[j] : 0.f);
      }
    }
    __syncthreads();
    {
      const int mt = wave & 1, nb = (wave >> 1) * 4;
      f32x4 oo[4];
#pragma unroll
      for (int n = 0; n < 4; ++n) oo[n] = (f32x4){0.f, 0.f, 0.f, 0.f};
      {
        const bf16x8 a = *(const bf16x8*)(Ps + (mt * 16 + fr) * 40 + fq * 8);
#pragma unroll
        for (int n = 0; n < 4; ++n) {
          const bf16x8 bb = *(const bf16x8*)(VT + ((nb + n) * 16 + fr) * 40 + fq * 8);
          oo[n] = MFMA(a, bb, oo[n]);
        }
      }
#pragma unroll
      for (int ks = 0; ks < 4; ++ks) {
        const bf16x8 a = *(const bf16x8*)(Qs + (mt * 16 + fr) * 136 + ks * 32 + fq * 8);
#pragma unroll
        for (int n = 0; n < 4; ++n) {
          const bf16x8 bb = *(const bf16x8*)(ST + ((nb + n) * 16 + fr) * 136 + ks * 32 + fq * 8);
          oo[n] = MFMA(a, bb, oo[n]);
        }
      }
#pragma unroll
      for (int j = 0; j < 4; ++j) {
        float ss = 0.f;
#pragma unroll
        for (int n = 0; n < 4; ++n) ss += oo[n][j] * oo[n][j];
        ss = red16_sum(ss);
        if (fr == 0) red[(mt * 16 + fq * 4 + j) * 2 + (wave >> 1)] = ss;
      }
      __syncthreads();
#pragma unroll
      for (int j = 0; j < 4; ++j) {
        const int t = mt * 16 + fq * 4 + j;
        const float rstd = rsqrtf((red[t * 2] + red[t * 2 + 1]) * (1.f / 128.f) + 1e-6f);
        bf16_t* gp = p.u + (tok0 + t) * US + 2560 + h * 128 + nb * 16 + fr;
#pragma unroll
        for (int n = 0; n < 4; ++n) {
          const float g = bf2f(gp[n * 16]);
          gp[n * 16] = f2bf(oo[n][j] * rstd * nw[(nb + n) * 16 + fr] * (g * sigm(g)));
        }
      }
    }
    {
      bf16x8 af[2];
#pragma unroll
      for (int mm = 0; mm < 2; ++mm) af[mm] = *(const bf16x8*)(KT + (wave * 32 + mm * 16 + fr) * 40 + fq * 8);
#pragma unroll
      for (int n = 0; n < 8; ++n) {
        const bf16x8 bb = *(const bf16x8*)(VT + (n * 16 + fr) * 40 + fq * 8);
#pragma unroll
        for (int mm = 0; mm < 2; ++mm) S[mm][n] = MFMA(af[mm], bb, S[mm][n]);
      }
#pragma unroll
      for (int mm = 0; mm < 2; ++mm)
#pragma unroll
        for (int j = 0; j < 4; ++j) {
          const float e = __expf(blast[wave * 32 + mm * 16 + fq * 4 + j]);
#pragma unroll
          for (int n = 0; n < 8; ++n) S[mm][n][j] *= e;
        }
    }
  }
  __syncthreads();
}

DEV uint4 rw_act(const uint4 cur, const uint4 prv, const float* mul8, int mode) {
  const float4 m0 = *(const float4*)(mul8), m1 = *(const float4*)(mul8 + 4);
  const float mm[8] = {m0.x, m0.y, m0.z, m0.w, m1.x, m1.y, m1.z, m1.w};
  float a[8], b[8], o[8];
  UNPACK8(cur, a); UNPACK8(prv, b);
#pragma unroll
  for (int e = 0; e < 8; ++e) {
    float v = a[e] + (b[e] - a[e]) * mm[e];
    if (mode == 1) { const float t = __expf(-2.f * fabsf(v)); const float th = (1.f - t) / (1.f + t); v = (v >= 0.f) ? th : -th; }
    else if (mode == 2) v = sigm(v);
    o[e] = v;
  }
  return PACK8(o);
}
DEV bf16x8 rw_bfrag(const float* W, int k0, int col) {
  float o[8];
#pragma unroll
  for (int e = 0; e < 8; ++e) o[e] = W[(size_t)(k0 + e) * 512 + col];
  return as_frag(PACK8(o));
}

PHASE void rwkv_item(const Params& p, int l, int item, char* smem) {
  const int b = item >> 3, h = item & 7;
  const int tid = opaque_tid(), lane = tid & 63, wave = tid >> 6, fr = lane & 15, fq = lane >> 4;
  float* R = (float*)smem;
  float* K = R + 2048; float* KK = K + 2048; float* W = KK + 2048; float* BB = W + 2048;
  float* V = BB + 2048; float* G = V + 2048; float* O = G + 2048;
  float* cst = O + 2048;
  float* mul = cst + 512;
  bf16_t* rawL = (bf16_t*)smem;
  float* vloL = (float*)(smem + 17424);
  const float* mu = p.rw_mu + (size_t)l * 1792;
  const int hc_n = h * 64 + wave * 16 + fr;
  bf16x8 w2f[2], a2f[2], g2f[4], v2f;
#pragma unroll
  for (int ks = 0; ks < 2; ++ks) {
    w2f[ks] = rw_bfrag(p.rw_w2 + (size_t)l * 64 * 512, ks * 32 + fq * 8, hc_n);
    a2f[ks] = rw_bfrag(p.rw_a2 + (size_t)l * 64 * 512, ks * 32 + fq * 8, hc_n);
  }
#pragma unroll
  for (int ks = 0; ks < 4; ++ks) g2f[ks] = rw_bfrag(p.rw_g2 + (size_t)l * 128 * 512, ks * 32 + fq * 8, hc_n);
  v2f = w2f[0];
  if (l > 0) v2f = rw_bfrag(p.rw_v2, fq * 8, hc_n);
  const float w0c = p.rw_w0[l * 512 + hc_n], a0c = p.rw_a0[l * 512 + hc_n];
  const float v0c = (l > 0) ? p.rw_v0[hc_n] : 0.f;
  const int t_ = tid >> 3, n0 = (tid & 7) * 8;
  __syncthreads();
  if (tid < 64) {
    const int hc = h * 64 + tid;
    cst[tid] = p.rw_k_k[l * 512 + hc]; cst[64 + tid] = p.rw_k_a[l * 512 + hc]; cst[128 + tid] = p.rw_r_k[l * 512 + hc];
    cst[192 + tid] = p.rw_gn_w[l * 512 + hc]; cst[256 + tid] = p.rw_gn_b[l * 512 + hc];
    cst[320 + tid] = mu[hc]; cst[384 + tid] = mu[512 + hc]; cst[448 + tid] = mu[1024 + hc];
  }
  mul[tid] = mu[1536 + tid];
  const float* kkc = cst + n0; const float* kac = cst + 64 + n0; const float* rkc = cst + 128 + n0;
  const float* gnw = cst + 192 + n0; const float* gnb = cst + 256 + n0;
  const float* mur = cst + 320 + n0; const float* muk = cst + 384 + n0; const float* muv = cst + 448 + n0;
  const int kq = lane & 7, row0 = wave * 16 + (lane >> 3), row1 = row0 + 8;
  f32x2 S0p[4], S1p[4];
#pragma unroll
  for (int e = 0; e < 4; ++e) { S0p[e] = (f32x2){0.f, 0.f}; S1p[e] = (f32x2){0.f, 0.f}; }

  uint4 pl0, pl1, pl2, pl3, pl4, pcr, pck, pcv, ppr, ppk, ppv, pvf;
  float4 pvl;
#define RW_PREFETCH(ch_)                                                                                    \
  {                                                                                                         \
    const size_t tk0 = (size_t)b * SEQ + (size_t)(ch_) * 32;                                                 \
    const bf16_t* lb_ = p.u + (tk0 - 1) * US + 3072 + 1536 + (tid & 31) * 8;                                 \
    const int r0_ = tid >> 5;                                                                               \
    pl0 = make_uint4(0, 0, 0, 0); if (!((ch_) == 0 && r0_ == 0)) pl0 = *(const uint4*)(lb_ + (size_t)r0_ * US); \
    pl1 = *(const uint4*)(lb_ + (size_t)(r0_ + 8) * US);                                                     \
    pl2 = *(const uint4*)(lb_ + (size_t)(r0_ + 16) * US);                                                    \
    pl3 = *(const uint4*)(lb_ + (size_t)(r0_ + 24) * US);                                                    \
    pl4 = make_uint4(0, 0, 0, 0); if (tid < 32) pl4 = *(const uint4*)(lb_ + (size_t)32 * US);                \
    const bf16_t* cu_ = p.u + (tk0 + t_) * US + 3072 + h * 64 + n0;                                          \
    pcr = *(const uint4*)cu_; pck = *(const uint4*)(cu_ + 512); pcv = *(const uint4*)(cu_ + 1024);           \
    if ((ch_) == 0 && t_ == 0) { ppr = make_uint4(0, 0, 0, 0); ppk = ppr; ppv = ppr; }                        \
    else { ppr = *(const uint4*)(cu_ - US); ppk = *(const uint4*)(cu_ - US + 512); ppv = *(const uint4*)(cu_ - US + 1024); } \
    if (l > 0) {                                                                                            \
      pvl = *(const float4*)(p.vlo + (tk0 + (tid >> 3)) * 32 + (tid & 7) * 4);                               \
      pvf = *(const uint4*)(p.vfirst + (tk0 + t_) * 512 + h * 64 + n0);                                      \
    } else { pvl = make_float4(0.f, 0.f, 0.f, 0.f); pvf = make_uint4(0, 0, 0, 0); }                          \
  }
  RW_PREFETCH(0)

  for (int ch = 0; ch < 64; ++ch) {
    const size_t tok0 = (size_t)b * SEQ + (size_t)ch * 32;
    __syncthreads();
    {
      const int r0_ = tid >> 5, cc_ = (tid & 31) * 8;
      *(uint4*)(rawL + r0_ * 264 + cc_) = pl0;
      *(uint4*)(rawL + (r0_ + 8) * 264 + cc_) = pl1;
      *(uint4*)(rawL + (r0_ + 16) * 264 + cc_) = pl2;
      *(uint4*)(rawL + (r0_ + 24) * 264 + cc_) = pl3;
      if (tid < 32) *(uint4*)(rawL + 32 * 264 + cc_) = pl4;
      *(float4*)(vloL + (tid >> 3) * 36 + (tid & 7) * 4) = pvl;
    }
    __syncthreads();
    {
      const int cc_ = (tid & 31) * 8, tr = tid >> 5;
      const int mode = (cc_ < 64) ? 1 : ((cc_ < 128) ? 0 : 2);
      uint4 a0, a1, a2, a3;
      a0 = rw_act(*(const uint4*)(rawL + (tr + 1) * 264 + cc_), *(const uint4*)(rawL + tr * 264 + cc_), mul + cc_, mode);
      a1 = rw_act(*(const uint4*)(rawL + (tr + 9) * 264 + cc_), *(const uint4*)(rawL + (tr + 8) * 264 + cc_), mul + cc_, mode);
      a2 = rw_act(*(const uint4*)(rawL + (tr + 17) * 264 + cc_), *(const uint4*)(rawL + (tr + 16) * 264 + cc_), mul + cc_, mode);
      a3 = rw_act(*(const uint4*)(rawL + (tr + 25) * 264 + cc_), *(const uint4*)(rawL + (tr + 24) * 264 + cc_), mul + cc_, mode);
      __syncthreads();
      *(uint4*)(rawL + tr * 264 + cc_) = a0;
      *(uint4*)(rawL + (tr + 8) * 264 + cc_) = a1;
      *(uint4*)(rawL + (tr + 16) * 264 + cc_) = a2;
      *(uint4*)(rawL + (tr + 24) * 264 + cc_) = a3;
    }
    __syncthreads();
#pragma unroll 1
    for (int mt = 0; mt < 2; ++mt) {
      const int row = mt * 16 + fr;
      const bf16_t* ar = rawL + row * 264 + fq * 8;
      f32x4 aw = (f32x4){0.f, 0.f, 0.f, 0.f}, aa = aw, ag = aw, av = aw;
#pragma unroll
      for (int ks = 0; ks < 2; ++ks) {
        aw = MFMA(*(const bf16x8*)(ar + ks * 32), w2f[ks], aw);
        aa = MFMA(*(const bf16x8*)(ar + 64 + ks * 32), a2f[ks], aa);
      }
#pragma unroll
      for (int ks = 0; ks < 4; ++ks) ag = MFMA(*(const bf16x8*)(ar + 128 + ks * 32), g2f[ks], ag);
      if (l > 0) {
        const float4 x0 = *(const float4*)(vloL + row * 36 + fq * 8), x1 = *(const float4*)(vloL + row * 36 + fq * 8 + 4);
        const uint4 pk = make_uint4(pack2(x0.x, x0.y), pack2(x0.z, x0.w), pack2(x1.x, x1.y), pack2(x1.z, x1.w));
        av = MFMA(as_frag(pk), v2f, av);
      }
#pragma unroll
      for (int j = 0; j < 4; ++j) {
        const int t = mt * 16 + fq * 4 + j, n = wave * 16 + fr;
        const float wv = -(w0c + aw[j]);
        const float sp = fmaxf(wv, 0.f) + __logf(1.f + __expf(-fabsf(wv)));
        const float wl = -sp - 0.5f;
        W[t * 64 + n] = __expf(-__expf(wl));
        BB[t * 64 + n] = sigm(a0c + aa[j]);
        G[t * 64 + n] = ag[j];
        if (l > 0) O[t * 64 + n] = sigm(v0c + av[j]);
      }
    }
    __syncthreads();
    {
      const size_t tok = tok0 + t_;
      float cr[8], ck[8], cv[8], pr[8], pk[8], pv[8];
      UNPACK8(pcr, cr); UNPACK8(pck, ck); UNPACK8(pcv, cv);
      UNPACK8(ppr, pr); UNPACK8(ppk, pk); UNPACK8(ppv, pv);
      float kx[8], kkv[8], vs[8], ss = 0.f;
#pragma unroll
      for (int e = 0; e < 8; ++e) {
        R[t_ * 64 + n0 + e] = cr[e] + (pr[e] - cr[e]) * mur[e];
        kx[e] = ck[e] + (pk[e] - ck[e]) * muk[e];
        vs[e] = cv[e] + (pv[e] - cv[e]) * muv[e];
        kkv[e] = kx[e] * kkc[e]; ss += kkv[e] * kkv[e];
      }
      ss = red8_sum(ss);
      const float rn = rsqrtf(fmaxf(ss, 1e-24f));
#pragma unroll
      for (int e = 0; e < 8; ++e) {
        const float a = BB[t_ * 64 + n0 + e];
        const float kn = kkv[e] * rn;
        K[t_ * 64 + n0 + e] = kx[e] * (1.f + (a - 1.f) * kac[e]);
        KK[t_ * 64 + n0 + e] = kn;
        BB[t_ * 64 + n0 + e] = kn * a;
      }
      if (l == 0) {
        *(uint4*)(p.vfirst + tok * 512 + h * 64 + n0) = PACK8(vs);
      } else {
        float vf[8]; UNPACK8(pvf, vf);
#pragma unroll
        for (int e = 0; e < 8; ++e) vs[e] = vs[e] + (vf[e] - vs[e]) * O[t_ * 64 + n0 + e];
      }
#pragma unroll
      for (int e = 0; e < 8; ++e) V[t_ * 64 + n0 + e] = vs[e];
    }
    __syncthreads();
    if (ch + 1 < 64) RW_PREFETCH(ch + 1)
    asm volatile("" ::: "memory");
#pragma unroll 4
    for (int t = 0; t < 32; ++t) {
      const float* base = R + t * 64 + kq * 8;
      const float4 r0 = *(const float4*)(base), r1 = *(const float4*)(base + 4);
      const float4 k0 = *(const float4*)(base + 2048), k1 = *(const float4*)(base + 2048 + 4);
      const float4 q0 = *(const float4*)(base + 4096), q1 = *(const float4*)(base + 4096 + 4);
      const float4 w0 = *(const float4*)(base + 6144), w1 = *(const float4*)(base + 6144 + 4);
      const float4 b0 = *(const float4*)(base + 8192), b1 = *(const float4*)(base + 8192 + 4);
      const float va = V[t * 64 + row0], vb = V[t * 64 + row1];
      const f32x2 rr[4] = {{r0.x, r0.y}, {r0.z, r0.w}, {r1.x, r1.y}, {r1.z, r1.w}};
      const f32x2 ww[4] = {{w0.x, w0.y}, {w0.z, w0.w}, {w1.x, w1.y}, {w1.z, w1.w}};
      const f32x2 kk_[4] = {{k0.x, k0.y}, {k0.z, k0.w}, {k1.x, k1.y}, {k1.z, k1.w}};
      const f32x2 qq[4] = {{q0.x, q0.y}, {q0.z, q0.w}, {q1.x, q1.y}, {q1.z, q1.w}};
      const f32x2 bb[4] = {{b0.x, b0.y}, {b0.z, b0.w}, {b1.x, b1.y}, {b1.z, b1.w}};
      f32x2 a0 = S0p[0] * qq[0], a1 = S1p[0] * qq[0];
#pragma unroll
      for (int e = 1; e < 4; ++e) { a0 += S0p[e] * qq[e]; a1 += S1p[e] * qq[e]; }
      const float sa0 = -red8_sum(a0.x + a0.y), sa1 = -red8_sum(a1.x + a1.y);
      f32x2 sa0v, sa1v, vav, vbv;
      sa0v.x = sa0; sa0v.y = sa0; sa1v.x = sa1; sa1v.y = sa1; vav.x = va; vav.y = va; vbv.x = vb; vbv.y = vb;
      f32x2 o0v = {0.f, 0.f}, o1v = {0.f, 0.f};
#pragma unroll
      for (int e = 0; e < 4; ++e) {
        S0p[e] = S0p[e] * ww[e] + sa0v * bb[e] + vav * kk_[e];
        S1p[e] = S1p[e] * ww[e] + sa1v * bb[e] + vbv * kk_[e];
        o0v += S0p[e] * rr[e]; o1v += S1p[e] * rr[e];
      }
      const float o0 = red8_sum(o0v.x + o0v.y), o1 = red8_sum(o1v.x + o1v.y);
      if (kq == 0) { O[t * 64 + row0] = o0; O[t * 64 + row1] = o1; }
    }
    asm volatile("s_waitcnt vmcnt(0)" ::: "memory");
    __syncthreads();
    {
      const size_t tok = tok0 + t_;
      float ov[8], s1 = 0.f, bon = 0.f;
#pragma unroll
      for (int e = 0; e < 8; ++e) {
        ov[e] = O[t_ * 64 + n0 + e]; s1 += ov[e];
        bon += R[t_ * 64 + n0 + e] * K[t_ * 64 + n0 + e] * rkc[e];
      }
      s1 = red8_sum(s1); bon = red8_sum(bon);
      const float mean = s1 * (1.f / 64.f);
      float s2 = 0.f;
#pragma unroll
      for (int e = 0; e < 8; ++e) { const float d = ov[e] - mean; s2 += d * d; }
      s2 = red8_sum(s2);
      const float rstd = rsqrtf(s2 * (1.f / 64.f) + 64e-5f);
      float y[8];
#pragma unroll
      for (int e = 0; e < 8; ++e)
        y[e] = ((ov[e] - mean) * rstd * gnw[e] + gnb[e] + bon * V[t_ * 64 + n0 + e]) * G[t_ * 64 + n0 + e];
      *(uint4*)(p.u + tok * US + 3072 + h * 64 + n0) = PACK8(y);
    }
  }
#undef RW_PREFETCH
  __syncthreads();
}

PHASE void phase_mix(const Params& p, int l, char* smem) {
  const int hf = vhalf();
  int* sitem = (int*)(smem - hf * SMEM_BYTES + SMEM_BYTES - 16);
  const int t512 = opaque_tid512();
  while (true) {
    __syncthreads();
    if (t512 == 0) *sitem = (int)atomicAdd(p.counters + l * 4 + 0, 1u);
    __syncthreads();
    const int tk = *sitem;
    if (tk >= 128) break;
    rwkv_item(p, l, tk * 2 + hf, smem);
  }
  while (true) {
    __syncthreads();
    if (t512 == 0) *sitem = (int)atomicAdd(p.counters + l * 4 + 1, 1u);
    __syncthreads();
    const int tk = *sitem;
    if (tk >= 64) break;
    hgrn_item(p, l, tk * 2 + hf, smem);
  }
  while (true) {
    __syncthreads();
    if (t512 == 0) *sitem = (int)atomicAdd(p.counters + l * 4 + 2, 1u);
    __syncthreads();
    const int tk = *sitem;
    if (tk >= 2048) break;
    att_item(p, l, tk * 2 + hf, smem);
  }
}

DEV void gemm_gates(const int tid_in, const bf16_t* A, const bf16_t* Wg, int tn, char* smem, unsigned (&Gp)[4][6][2]) {
  int tid = tid_in; asm volatile("" : "+v"(tid));
  bf16_t* As = (bf16_t*)smem;
  bf16_t* Bs = As + 3 * 4096;
  const int lane = tid & 63, wave = tid >> 6, wr = wave >> 1, wc = wave & 1;
  const int fr = lane & 15, fq = lane >> 4;
  f32x4 acc[4][6];
#pragma unroll
  for (int m = 0; m < 4; ++m)
#pragma unroll
    for (int n = 0; n < 6; ++n) acc[m][n] = (f32x4){0.f, 0.f, 0.f, 0.f};
  const int nk = DM >> 5;
  const int drow = tid >> 2, dphys = tid & 3, dg = (0 - (tid >> 4)) & 3;
  const int cofs = (dphys ^ dg) * 8;
  const unsigned aofs = (unsigned)(drow * DM + cofs);
  unsigned bofs0, bofs1, bofs2;
  {
    int r = drow; int wcb = r / 96, br = (r % 96) >> 5, c = (r % 96) & 31;
    bofs0 = (unsigned)((5376 + br * 1024 + tn * 64 + wcb * 32 + c) * DM + cofs);
    r = drow + 64; wcb = r / 96; br = (r % 96) >> 5; c = (r % 96) & 31;
    bofs1 = (unsigned)((5376 + br * 1024 + tn * 64 + wcb * 32 + c) * DM + cofs);
    r = drow + 128; wcb = r / 96; br = (r % 96) >> 5; c = (r % 96) & 31;
    bofs2 = (unsigned)((5376 + br * 1024 + tn * 64 + wcb * 32 + c) * DM + cofs);
  }
  const int rofs = (fq ^ ((0 - (fr >> 2)) & 3)) * 8;
#define GG_DMA(st, kk)                                                                                       \
  {                                                                                                          \
    __builtin_amdgcn_global_load_lds((const unsigned*)(A + aofs + (kk) * 32), (unsigned*)(As + (st) * 4096 + tid * 8), 16, 0, 0);                     \
    __builtin_amdgcn_global_load_lds((const unsigned*)(A + aofs + 64 * DM + (kk) * 32), (unsigned*)(As + (st) * 4096 + tid * 8 + 2048), 16, 0, 0); \
    __builtin_amdgcn_global_load_lds((const unsigned*)(Wg + bofs0 + (kk) * 32), (unsigned*)(Bs + (st) * 6144 + tid * 8), 16, 0, 0);                    \
    __builtin_amdgcn_global_load_lds((const unsigned*)(Wg + bofs1 + (kk) * 32), (unsigned*)(Bs + (st) * 6144 + tid * 8 + 2048), 16, 0, 0);             \
    __builtin_amdgcn_global_load_lds((const unsigned*)(Wg + bofs2 + (kk) * 32), (unsigned*)(Bs + (st) * 6144 + tid * 8 + 4096), 16, 0, 0);             \
  }
  GG_DMA(0, 0)
  GG_DMA(1, 1)
  int st = 0;
  for (int kt = 0; kt < nk; ++kt) {
    if (kt + 1 < nk) asm volatile("s_waitcnt vmcnt(5)" ::: "memory");
    else asm volatile("s_waitcnt vmcnt(0)" ::: "memory");
    __builtin_amdgcn_s_barrier();
    asm volatile("" ::: "memory");
    const int s2 = (st >= 1) ? st - 1 : 2;
    const bf16_t* Ab = As + st * 4096 + (wr * 64 + fr) * 32 + rofs;
    const bf16_t* Bb = Bs + st * 6144 + (wc * 96 + fr) * 32 + rofs;
    bf16x8 bfr[6], af[4];
#pragma unroll
    for (int n = 0; n < 6; ++n) bfr[n] = *(const bf16x8*)(Bb + n * 512);
#pragma unroll
    for (int m = 0; m < 4; ++m) af[m] = *(const bf16x8*)(Ab + m * 512);
    if (kt + 2 < nk) GG_DMA(s2, kt + 2)
#pragma unroll
    for (int m = 0; m < 4; ++m)
#pragma unroll
      for (int n = 0; n < 6; ++n) acc[m][n] = MFMA(af[m], bfr[n], acc[m][n]);
    st = (st == 2) ? 0 : st + 1;
  }
#undef GG_DMA
  __syncthreads();
#pragma unroll
  for (int m = 0; m < 4; ++m)
#pragma unroll
    for (int n = 0; n < 6; ++n) {
      Gp[m][n][0] = pack2(sigm(acc[m][n][0]), sigm(acc[m][n][1]));
      Gp[m][n][1] = pack2(sigm(acc[m][n][2]), sigm(acc[m][n][3]));
    }
}

PHASE void phase_merge(const Params& p, int l, char* smem) {
  const bf16_t* Wl = p.wt + (size_t)l * WLAYER;
  float* Cs = (float*)smem;
  const int tid = opaque_tid();
  for (int it = 0;; ++it) {
    int tm, tn;
    if (!tile_for(it, 512, 16, tm, tn)) break;
    const size_t row0 = (size_t)tm * 128;
    unsigned Gp[4][6][2];
    gemm_gates(tid, p.h + row0 * DM, Wl + WIN, tn, smem, Gp);
    f32x4 acc[4][2], M[4][2];
#pragma unroll
    for (int m = 0; m < 4; ++m)
#pragma unroll
      for (int n = 0; n < 2; ++n) M[m][n] = (f32x4){0.f, 0.f, 0.f, 0.f};
#pragma unroll
    for (int br = 0; br < 3; ++br) {
      const int aoff = (br == 0) ? 0 : (br == 1 ? 2560 : 3072);
      const size_t woff = (br == 0) ? WBA : (br == 1 ? WBB : WBC);
      gemm_tile<2>(tid, p.u + row0 * US + aoff, US, Wl + woff + (size_t)(tn * 64) * 512, 512, 512, smem, acc);
#pragma unroll
      for (int m = 0; m < 4; ++m)
#pragma unroll
        for (int n = 0; n < 2; ++n) {
          M[m][n][0] += lo16(Gp[m][2 * br + n][0]) * acc[m][n][0];
          M[m][n][1] += hi16(Gp[m][2 * br + n][0]) * acc[m][n][1];
          M[m][n][2] += lo16(Gp[m][2 * br + n][1]) * acc[m][n][2];
          M[m][n][3] += hi16(Gp[m][2 * br + n][1]) * acc[m][n][3];
        }
    }
    stage_acc<2>(tid, Cs, M);
    __syncthreads();
    {
      const int ch = tid & 7;
#pragma unroll 1
      for (int i = 0; i < 4; ++i) {
        const int r = (tid >> 3) + i * 32;
        const float4 a = *(const float4*)(Cs + r * 68 + ch * 8), b = *(const float4*)(Cs + r * 68 + ch * 8 + 4);
        *(uint4*)(p.u + (row0 + r) * US + 1024 + tn * 64 + ch * 8) = make_uint4(pack2(a.x, a.y), pack2(a.z, a.w), pack2(b.x, b.y), pack2(b.z, b.w));
      }
    }
    __syncthreads();
  }
}

PHASE void phase_gemm_res(const bf16_t* A, int lda, const bf16_t* Wt, int K, const float* xin, float* xout,
                        const float* ada_l, int gate_off, char* smem0) {
  const int T = opaque_tid512(), tid = T & 255, hf = vhalf();
  float* Cs = (float*)(smem0 + hf * SMEM_BYTES);
  for (int it = 0;; ++it) {
    int tm, tn;
    if (!tile_for_real(it, 256, 4, tm, tn)) break;
    const size_t row0 = (size_t)tm * 256;
    f32x4 acc[8][4];
    gemm_tile512(T, A + row0 * lda, lda, Wt + (size_t)(tn * 256) * K, K, K, smem0, acc);
    const float* gate = ada_l + (size_t)(row0 / SEQ) * ADAW + gate_off;
    const int c4 = (tid & 31) * 4;
#pragma unroll
    for (int ps = 0; ps < 2; ++ps) {
      if (ps == 0) stage_half512<0>(T, Cs, acc); else stage_half512<1>(T, Cs, acc);
      __syncthreads();
#pragma unroll 1
      for (int i0 = 0; i0 < 16; i0 += 4) {
        float4 xv[4], gv[4], cv[4]; size_t off[4];
#pragma unroll
        for (int ii = 0; ii < 4; ++ii) {
          const int r = (tid >> 5) + (i0 + ii) * 8;
          const int colb = TNC(r) * 128 + c4;
          off[ii] = GROW(r, ps) * DM + colb;
          xv[ii] = *(const float4*)(xin + off[ii]);
          gv[ii] = *(const float4*)(gate + colb);
          cv[ii] = *(const float4*)(Cs + r * 132 + c4);
        }
        asm volatile("" ::: "memory");
#pragma unroll
        for (int ii = 0; ii < 4; ++ii)
          *(float4*)(xout + off[ii]) = make_float4(xv[ii].x + gv[ii].x * cv[ii].x, xv[ii].y + gv[ii].y * cv[ii].y,
                                                   xv[ii].z + gv[ii].z * cv[ii].z, xv[ii].w + gv[ii].w * cv[ii].w);
      }
      __syncthreads();
    }
  }
}

PHASE void phase_ffn_in(const Params& p, int l, char* smem0) {
  const bf16_t* Wt = p.wt + (size_t)l * WLAYER + WFI;
  const int T = opaque_tid512(), tid = T & 255, hf = vhalf();
  float* Cs = (float*)(smem0 + hf * SMEM_BYTES);
  for (int it = 0;; ++it) {
    int tm, tn;
    if (!tile_for_real(it, 256, 22, tm, tn)) break;
    const size_t row0 = (size_t)tm * 256;
    f32x4 acc[8][4];
    gemm_tile512(T, p.h + row0 * DM, DM, Wt + (size_t)(tn * 256) * DM, DM, DM, smem0, acc);
    const int ch = tid & 7;
#pragma unroll
    for (int ps = 0; ps < 2; ++ps) {
      if (ps == 0) stage_half512<0>(T, Cs, acc); else stage_half512<1>(T, Cs, acc);
      __syncthreads();
#pragma unroll 1
      for (int i = 0; i < 4; ++i) {
        const int r = (tid >> 3) + i * 32;
        const float* cp = Cs + r * 132 + ch * 8;
        float o[8];
#pragma unroll
        for (int e = 0; e < 8; ++e) { const float g = cp[e], uu = cp[64 + e]; o[e] = g * sigm(g) * uu; }
        *(uint4*)(p.u + GROW(r, ps) * FFH + TNC(r) * 64 + ch * 8) = PACK8(o);
      }
      __syncthreads();
    }
  }
}

#define XB_TMO      128
#define XB_XCNT(j)  (256  + 64 * (j))
#define XB_XSUB(j)  (1280 + 64 * (j))
#define XB_XGEN(j)  (2304 + 64 * (j))
#define XB_TOP      3328
#define XB_TOPGEN   3392
#define XCD_BAR_WORDS 3456
#define XB_SPIN_CAP (1u << 18)
#define LAS __attribute__((address_space(3)))
DEV unsigned xb_ld(unsigned* p) { return __hip_atomic_load(p, __ATOMIC_RELAXED, __HIP_MEMORY_SCOPE_AGENT); }
DEV unsigned xb_add(unsigned* p, unsigned v) { return __hip_atomic_fetch_add(p, v, __ATOMIC_RELAXED, __HIP_MEMORY_SCOPE_AGENT); }
DEV unsigned xb_xcc_id() { return (unsigned)__builtin_amdgcn_s_getreg((3 << 11) | 20) & 0xFu; }
#define XB_SPIN(cond, bar) do { unsigned _sp = 0; while (cond) { __builtin_amdgcn_s_sleep(1); \
    if ((++_sp & 255u) == 0u) { if (xb_ld(&(bar)[XB_TMO])) break; if (_sp > XB_SPIN_CAP) { atomicAdd(&(bar)[XB_TMO], 1u); break; } } } } while (0)
struct XcdBarrier { unsigned* bar; unsigned x; volatile LAS unsigned* st; };
DEV XcdBarrier xcd_barrier_post(unsigned* bar, volatile LAS unsigned* st) {
  XcdBarrier b; b.bar = bar; b.x = xb_xcc_id(); b.st = st;
  if (threadIdx.x == 0) (void)xb_add(&bar[XB_XCNT(b.x)], 1u);
  return b;
}
DEV void xcd_barrier_complete(unsigned* bar, unsigned x, unsigned& nloc, unsigned& nx) {
  const unsigned G = gridDim.x * gridDim.y * gridDim.z;
  unsigned sum, cnt, mine, sp = 0u;
  for (;;) {
    sum = 0u; cnt = 0u; mine = 0u;
#pragma unroll
    for (unsigned j = 0; j < 16; ++j) { const unsigned c = xb_ld(&bar[XB_XCNT(j)]); sum += c; cnt += (c > 0u) ? 1u : 0u; mine = (j == x) ? c : mine; }
    if (sum == G) break;
    __builtin_amdgcn_s_sleep(1);
    if ((++sp & 255u) == 0u) { if (xb_ld(&bar[XB_TMO])) break; if (sp > XB_SPIN_CAP) { atomicAdd(&bar[XB_TMO], 1u); break; } }
  }
  nloc = mine > 0u ? mine : 1u; nx = cnt > 0u ? cnt : 1u;
}
DEV void xcd_barrier(const XcdBarrier& b) {
  asm volatile("s_waitcnt vmcnt(0)" ::: "memory");
  __syncthreads();
  if (threadIdx.x == 0) {
    unsigned* bar = b.bar;
    __builtin_amdgcn_s_waitcnt(0);
    unsigned nloc = b.st[0], nx = b.st[1];
    if (nloc == 0u) { xcd_barrier_complete(bar, b.x, nloc, nx); b.st[0] = nloc; b.st[1] = nx; }
    const unsigned old = xb_add(&bar[XB_XSUB(b.x)], 1u);
    const unsigned gen = old / nloc;
    if (old + 1u == (gen + 1u) * nloc) {
      __builtin_amdgcn_fence(__ATOMIC_RELEASE, "agent");
      asm volatile("s_waitcnt vmcnt(0)" ::: "memory");
      const unsigned og = xb_add(&bar[XB_TOP], 1u);
      const unsigned tg = og / nx;
      if (og + 1u == (tg + 1u) * nx) xb_add(&bar[XB_TOPGEN], 1u);
      else XB_SPIN(xb_ld(&bar[XB_TOPGEN]) == tg, bar);
      __builtin_amdgcn_fence(__ATOMIC_ACQUIRE, "agent");
      xb_add(&bar[XB_XGEN(b.x)], 1u);
      asm volatile("s_waitcnt vmcnt(0)" ::: "memory");
    } else {
      XB_SPIN(xb_ld(&bar[XB_XGEN(b.x)]) == gen, bar);
      __builtin_amdgcn_fence(__ATOMIC_ACQUIRE, "agent");
      asm volatile("s_waitcnt vmcnt(0)" ::: "memory");
    }
  }
  __syncthreads();
}

__global__ void __launch_bounds__(512, 2) mega(Params p_in, int ph_lo, int ph_hi) {
  extern __shared__ __attribute__((aligned(16))) char smem0[];
  char* smem = smem0 + vhalf() * SMEM_BYTES;
  cg::grid_group grid = cg::this_grid();
  const Params& p = p_in;
  bool first = true;
#define RUN(ph) if ((ph) >= ph_lo && (ph) < ph_hi)
  unsigned epoch = 0;
  __shared__ unsigned xb_words[4];
  if (threadIdx.x < 4) xb_words[threadIdx.x] = 0u;
  __syncthreads();
  XcdBarrier xb;
  xb.bar = p.counters + 256; xb.x = 0u; xb.st = (volatile LAS unsigned*)xb_words;
#define SYNC { if (!first) { ++epoch; if (epoch == 1) { grid.sync(); xb = xcd_barrier_post(p.counters + 256, (volatile LAS unsigned*)xb_words); } else xcd_barrier(xb); } first = false; }
  RUN(0) { SYNC; phase_prep(p, smem); }
#pragma unroll 1
  for (int l = 0; l < 2; ++l) {
    const int base = 1 + 9 * l;
    const float* ada_l = p.ada + (size_t)l * 32 * ADAW;
    const bf16_t* Wl = p.wt + (size_t)l * WLAYER;
    const float* xin = (l == 0) ? p.x : p.out;
    RUN(base + 0) { SYNC; phase_norm(xin, p.norm_mix_w + l * DM, ada_l, 0, 1024, p.h); }
    RUN(base + 1) { SYNC; phase_gemm_in(p, l, smem0); }
    RUN(base + 2) { if (l > 0) { SYNC; phase_vlo(p, l, smem); } }
    RUN(base + 3) { SYNC; phase_mix(p, l, smem); }
    RUN(base + 4) { SYNC; phase_merge(p, l, smem); }
    RUN(base + 5) { SYNC; phase_gemm_res(p.u + 1024, US, Wl + WOUT, DM, xin, p.out, ada_l, 2048, smem0); }
    RUN(base + 6) { SYNC; phase_norm(p.out, p.norm_ffn_w + l * DM, ada_l, 3072, 4096, p.h); }
    RUN(base + 7) { SYNC; phase_ffn_in(p, l, smem0); }
    RUN(base + 8) { SYNC; phase_gemm_res(p.u, FFH, Wl + WFO, FFH, p.out, p.out, ada_l, 5120, smem0); }
  }
  RUN(NPHASE - 1) { SYNC; phase_final(p.out, p.final_norm_w); }
}

extern "C" void kernel_launch(void* const* d_in, const int* in_sizes, int n_in, void* d_out, int out_size, void* d_ws,
                              size_t ws_size, hipStream_t stream) {
  Params p{};
  p.x = (const float*)d_in[0]; p.c = (const float*)d_in[1]; p.pos = (const int*)d_in[2];
  p.ada_w = (const float*)d_in[3]; p.ada_b = (const float*)d_in[4]; p.norm_mix_w = (const float*)d_in[5];
  p.norm_ffn_w = (const float*)d_in[6]; p.w_in = (const float*)d_in[7]; p.da_lambda = (const float*)d_in[8];
  p.da_subln_w = (const float*)d_in[9]; p.hg_lb = (const float*)d_in[10]; p.hg_norm_w = (const float*)d_in[11];
  p.rw_mu = (const float*)d_in[12]; p.rw_w0 = (const float*)d_in[13]; p.rw_w2 = (const float*)d_in[14];
  p.rw_a0 = (const float*)d_in[15]; p.rw_a2 = (const float*)d_in[16]; p.rw_g2 = (const float*)d_in[17];
  p.rw_k_k = (const float*)d_in[18]; p.rw_k_a = (const float*)d_in[19]; p.rw_r_k = (const float*)d_in[20];
  p.rw_gn_w = (const float*)d_in[21]; p.rw_gn_b = (const float*)d_in[22]; p.rw_v0 = (const float*)d_in[23];
  p.rw_v1 = (const float*)d_in[24]; p.rw_v2 = (const float*)d_in[25]; p.w_br_a = (const float*)d_in[26];
  p.w_br_b = (const float*)d_in[27]; p.w_br_c = (const float*)d_in[28]; p.w_out = (const float*)d_in[29];
  p.ffn_w_in = (const float*)d_in[30]; p.ffn_w_out = (const float*)d_in[31]; p.final_norm_w = (const float*)d_in[32];
  p.out = (float*)d_out;
  char* ws = (char*)d_ws;
  size_t off = 0;
  auto take = [&](size_t bytes) { char* r = ws + off; off += (bytes + 255) & ~(size_t)255; return r; };
  p.counters = (unsigned*)take(16384);
  p.wt = (bf16_t*)take(2 * WLAYER * 2);
  p.ada = (float*)take((size_t)2 * 32 * ADAW * 4);
  p.h = (bf16_t*)take((size_t)T_TOK * DM * 2);
  p.u = (bf16_t*)take((size_t)T_TOK * US * 2);
  p.vT = (bf16_t*)take((size_t)T_TOK * 512 * 2);
  p.vfirst = (bf16_t*)take((size_t)T_TOK * 512 * 2);
  p.vlo = (float*)take((size_t)T_TOK * 32 * 4);
  if (off > ws_size) { fprintf(stderr, "workspace too small: need %zu have %zu\n", off, ws_size); return; }

  static int grid_blocks = 0;
  if (!grid_blocks) {
    hipFuncSetAttribute((const void*)mega, hipFuncAttributeMaxDynamicSharedMemorySize, 2 * SMEM_BYTES);
    int dev = 0, cus = 0, per_cu = 0;
    hipGetDevice(&dev);
    hipDeviceGetAttribute(&cus, hipDeviceAttributeMultiprocessorCount, dev);
    hipOccupancyMaxActiveBlocksPerMultiprocessor(&per_cu, mega, 512, 2 * SMEM_BYTES);
    if (per_cu > 1) per_cu = 1;
    if (per_cu < 1) per_cu = 1;
    grid_blocks = cus * per_cu;
  }
#if SINGLE_LAUNCH
  int lo = 0, hi = NPHASE;
  void* args[] = {&p, &lo, &hi};
  hipError_t e = hipLaunchCooperativeKernel((void*)mega, dim3(grid_blocks), dim3(512), args, 2 * SMEM_BYTES, stream);
  if (e != hipSuccess) fprintf(stderr, "cooperative launch failed: %s (grid %d)\n", hipGetErrorString(e), grid_blocks);
#else
  for (int ph = 0; ph < NPHASE; ++ph) {
    if (ph == 3) continue;
    hipLaunchKernelGGL(mega, dim3(grid_blocks), dim3(512), 2 * SMEM_BYTES, stream, p, ph, ph + 1);
  }
#endif
}
```

```cpp
#include <hip/hip_runtime.h>
#include <hip/hip_cooperative_groups.h>
#include <stdint.h>
#include <cstdio>
namespace cg = cooperative_groups;

typedef unsigned short bf16_t;
typedef short bf16x8 __attribute__((ext_vector_type(8)));
typedef float f32x4 __attribute__((ext_vector_type(4)));
typedef float f32x2 __attribute__((ext_vector_type(2)));
#define DEV __device__ __forceinline__
#define PHASE __device__ __forceinline__

#ifndef SINGLE_LAUNCH
#define SINGLE_LAUNCH 1
#endif

constexpr int T_TOK = 65536, DM = 1024, SEQ = 2048, US = 4864, ADAW = 6144, FFH = 2816;
constexpr size_t WIN = 0, WBA = 8650752, WBB = 9175040, WBC = 9699328, WOUT = 10223616, WFI = 11272192,
                 WFO = 17039360, WLAYER = 19922944;
constexpr int SMEM_BYTES = 80896;
constexpr int NPHASE = 20;

struct Params {
  const float* x; const float* c; const int* pos;
  const float *ada_w, *ada_b, *norm_mix_w, *norm_ffn_w, *w_in, *da_lambda, *da_subln_w, *hg_lb, *hg_norm_w;
  const float *rw_mu, *rw_w0, *rw_w2, *rw_a0, *rw_a2, *rw_g2, *rw_k_k, *rw_k_a, *rw_r_k, *rw_gn_w, *rw_gn_b;
  const float *rw_v0, *rw_v1, *rw_v2, *w_br_a, *w_br_b, *w_br_c, *w_out, *ffn_w_in, *ffn_w_out, *final_norm_w;
  float* out;
  bf16_t* wt; float* ada; bf16_t* h; bf16_t* u; bf16_t* vT; bf16_t* vfirst; float* vlo; unsigned* counters;
};

DEV unsigned short f2bf(float f) { unsigned u = __float_as_uint(f); u += 0x7FFFu + ((u >> 16) & 1u); return (unsigned short)(u >> 16); }
DEV float bf2f(unsigned short h) { return __uint_as_float(((unsigned)h) << 16); }
DEV unsigned pack2(float a, float b) { return (unsigned)f2bf(a) | ((unsigned)f2bf(b) << 16); }
DEV float sigm(float x) { return 1.f / (1.f + __expf(-x)); }
DEV float lo16(unsigned v) { return __uint_as_float(v << 16); }
DEV float hi16(unsigned v) { return __uint_as_float(v & 0xFFFF0000u); }
#define UNPACK8(v, f) { f[0]=lo16(v.x); f[1]=hi16(v.x); f[2]=lo16(v.y); f[3]=hi16(v.y); f[4]=lo16(v.z); f[5]=hi16(v.z); f[6]=lo16(v.w); f[7]=hi16(v.w); }
#define PACK8(f) make_uint4(pack2(f[0],f[1]), pack2(f[2],f[3]), pack2(f[4],f[5]), pack2(f[6],f[7]))
template <int CTRL> DEV float dpp(float x) { return __int_as_float(__builtin_amdgcn_update_dpp(0, __float_as_int(x), CTRL, 0xF, 0xF, true)); }
DEV float red8_sum(float x) { x += dpp<0xB1>(x); x += dpp<0x4E>(x); x += dpp<0x141>(x); return x; }
DEV float red16_sum(float x) { x = red8_sum(x); x += dpp<0x140>(x); return x; }
DEV float red16_max(float x) { x = fmaxf(x, dpp<0xB1>(x)); x = fmaxf(x, dpp<0x4E>(x)); x = fmaxf(x, dpp<0x141>(x)); x = fmaxf(x, dpp<0x140>(x)); return x; }
DEV float wave_sum(float x) {
  x = red16_sum(x);
  const int xi = __float_as_int(x);
  return __int_as_float(__builtin_amdgcn_readlane(xi, 0)) + __int_as_float(__builtin_amdgcn_readlane(xi, 16)) +
         __int_as_float(__builtin_amdgcn_readlane(xi, 32)) + __int_as_float(__builtin_amdgcn_readlane(xi, 48));
}
DEV int opaque_tid() { int t = threadIdx.x & 255; asm volatile("" : "+v"(t)); return t; }
DEV int opaque_tid512() { int t = threadIdx.x; asm volatile("" : "+v"(t)); return t; }
DEV int vhalf() { return __builtin_amdgcn_readfirstlane((int)(threadIdx.x >> 8)); }
DEV int vblock() { return (int)blockIdx.x * 2 + vhalf(); }
DEV int vgrid() { return (int)gridDim.x * 2; }
DEV bf16x8 as_frag(uint4 v) { union { uint4 u; bf16x8 b; } c; c.u = v; return c.b; }
#define MFMA(a, b, c) __builtin_amdgcn_mfma_f32_16x16x32_bf16(a, b, c, 0, 0, 0)

template <int NT>
DEV void gemm_tile(const int tid_in, const bf16_t* A, int lda, const bf16_t* B, int ldb, int K, char* smem,
                   f32x4 (&acc)[4][NT]) {
  int tid = tid_in; asm volatile("" : "+v"(tid));
  constexpr int BN = NT * 32;
  constexpr int LS = 64;
  bf16_t* As = (bf16_t*)smem;
  bf16_t* Bs = As + 2 * 128 * LS;
  const int lane = tid & 63, wave = tid >> 6, wr = wave >> 1, wc = wave & 1;
  const int fr = lane & 15, fq = lane >> 4;
  constexpr int NB = BN * 8 / 256;
#pragma unroll
  for (int m = 0; m < 4; ++m)
#pragma unroll
    for (int n = 0; n < NT; ++n) acc[m][n] = (f32x4){0.f, 0.f, 0.f, 0.f};
  const int nk = K >> 6;
  const int lrow = tid >> 3, lcc = tid & 7;
  const bf16_t* Ap = A + (size_t)lrow * lda + ((lcc ^ (lrow & 7)) * 8);
  const bf16_t* Bp = B + (size_t)lrow * ldb + ((lcc ^ (lrow & 7)) * 8);
  const size_t a32 = (size_t)32 * lda, b32 = (size_t)32 * ldb;
  const int rofs0 = (fq ^ (fr & 7)) * 8, rofs1 = rofs0 ^ 32;
#define GT_DMA(buf, koff)                                                                                    \
  {                                                                                                          \
    bf16_t* Ad = As + (buf) * 128 * LS + tid * 8;                                                            \
    bf16_t* Bd = Bs + (buf) * BN * LS + tid * 8;                                                             \
    _Pragma("unroll") for (int i = 0; i < 4; ++i)                                                            \
      __builtin_amdgcn_global_load_lds((const unsigned*)(Ap + i * a32 + (koff)), (unsigned*)(Ad + i * 32 * LS), 16, 0, 0); \
    _Pragma("unroll") for (int i = 0; i < NB; ++i)                                                           \
      __builtin_amdgcn_global_load_lds((const unsigned*)(Bp + i * b32 + (koff)), (unsigned*)(Bd + i * 32 * LS), 16, 0, 0); \
  }
  GT_DMA(0, 0)
  asm volatile("s_waitcnt vmcnt(0)" ::: "memory");
  __syncthreads();
  for (int kt = 0; kt < nk; ++kt) {
    const int buf = kt & 1;
    if (kt + 1 < nk) GT_DMA(buf ^ 1, (kt + 1) * 64)
    const bf16_t* Ab = As + buf * 128 * LS + (wr * 64 + fr) * LS;
    const bf16_t* Bb = Bs + buf * BN * LS + (wc * (NT * 16) + fr) * LS;
#pragma unroll
    for (int ks = 0; ks < 2; ++ks) {
      const int ro = ks ? rofs1 : rofs0;
      bf16x8 af[4], bfr[NT];
#pragma unroll
      for (int m = 0; m < 4; ++m) af[m] = *(const bf16x8*)(Ab + m * 16 * LS + ro);
#pragma unroll
      for (int n = 0; n < NT; ++n) bfr[n] = *(const bf16x8*)(Bb + n * 16 * LS + ro);
#pragma unroll
      for (int m = 0; m < 4; ++m)
#pragma unroll
        for (int n = 0; n < NT; ++n) acc[m][n] = MFMA(af[m], bfr[n], acc[m][n]);
    }
    asm volatile("s_waitcnt vmcnt(0)" ::: "memory");
    __syncthreads();
  }
#undef GT_DMA
}

template <int NT>
DEV void stage_acc(const int tid, float* Cs, const f32x4 (&acc)[4][NT]) {
  constexpr int LDC = NT * 32 + 4;
  const int lane = tid & 63, wave = tid >> 6, wr = wave >> 1, wc = wave & 1, fr = lane & 15, fq = lane >> 4;
#pragma unroll
  for (int m = 0; m < 4; ++m)
#pragma unroll
    for (int n = 0; n < NT; ++n)
#pragma unroll
      for (int j = 0; j < 4; ++j) Cs[(wr * 64 + m * 16 + fq * 4 + j) * LDC + wc * (NT * 16) + n * 16 + fr] = acc[m][n][j];
}

DEV void gemm_tile256(const int tid, const bf16_t* A, int lda, const bf16_t* B, int ldb, int K, char* smem,
                      f32x4 (&acc)[8][4]) {
  bf16_t* As = (bf16_t*)smem;
  bf16_t* Bs = As + 3 * 8192;
  const int lane = tid & 63, wave = tid >> 6, wr = wave >> 1, wc = wave & 1;
  const int fr = lane & 15, fq = lane >> 4;
#pragma unroll
  for (int m = 0; m < 8; ++m)
#pragma unroll
    for (int n = 0; n < 4; ++n) acc[m][n] = (f32x4){0.f, 0.f, 0.f, 0.f};
  const int nk = K >> 5;
  const int drow = tid >> 2, dphys = tid & 3, dg = (0 - (tid >> 4)) & 3;
  const bf16_t* Ap = A + (size_t)drow * lda + ((dphys ^ dg) * 8);
  const bf16_t* Bp = B + (size_t)drow * ldb + ((dphys ^ dg) * 8);
  const size_t a64 = (size_t)64 * lda, b64 = (size_t)64 * ldb;
  const int rofs = (fq ^ ((0 - (fr >> 2)) & 3)) * 8;
#define G2_DMA(st, kk)                                                                                        \
  {                                                                                                           \
    bf16_t* Ad = As + (st) * 8192 + tid * 8;                                                                  \
    bf16_t* Bd = Bs + (st) * 4096 + tid * 8;                                                                  \
    _Pragma("unroll") for (int i = 0; i < 4; ++i)                                                             \
      __builtin_amdgcn_global_load_lds((const unsigned*)(Ap + i * a64 + (kk) * 32), (unsigned*)(Ad + i * 2048), 16, 0, 0); \
    _Pragma("unroll") for (int i = 0; i < 2; ++i)                                                             \
      __builtin_amdgcn_global_load_lds((const unsigned*)(Bp + i * b64 + (kk) * 32), (unsigned*)(Bd + i * 2048), 16, 0, 0); \
  }
  G2_DMA(0, 0)
  G2_DMA(1, 1)
  int st = 0;
  for (int kt = 0; kt < nk; ++kt) {
    if (kt + 1 < nk) asm volatile("s_waitcnt vmcnt(6)" ::: "memory");
    else asm volatile("s_waitcnt vmcnt(0)" ::: "memory");
    __builtin_amdgcn_s_barrier();
    asm volatile("" ::: "memory");
    const int s2 = (st >= 1) ? st - 1 : 2;
    const bool pf = (kt + 2 < nk);
    bf16_t* Ad = As + s2 * 8192 + tid * 8;
    bf16_t* Bd = Bs + s2 * 4096 + tid * 8;
    const bf16_t* Asrc = Ap + (kt + 2) * 32;
    const bf16_t* Bsrc = Bp + (kt + 2) * 32;
    const bf16_t* Ab = As + st * 8192 + (wr * 128 + fr) * 32 + rofs;
    const bf16_t* Bb = Bs + st * 4096 + (wc * 64 + fr) * 32 + rofs;
    bf16x8 bfr[4], af[4];
#pragma unroll
    for (int n = 0; n < 4; ++n) bfr[n] = *(const bf16x8*)(Bb + n * 512);
#pragma unroll
    for (int m = 0; m < 4; ++m) af[m] = *(const bf16x8*)(Ab + m * 512);
#pragma unroll
    for (int m = 0; m < 8; ++m) {
#pragma unroll
      for (int n = 0; n < 4; ++n) acc[m][n] = MFMA(af[m & 3], bfr[n], acc[m][n]);
      if (m + 4 < 8) af[m & 3] = *(const bf16x8*)(Ab + (m + 4) * 512);
      if (pf) {
        if (m < 4) __builtin_amdgcn_global_load_lds((const unsigned*)(Asrc + m * a64), (unsigned*)(Ad + m * 2048), 16, 0, 0);
        else if (m < 6) __builtin_amdgcn_global_load_lds((const unsigned*)(Bsrc + (m - 4) * b64), (unsigned*)(Bd + (m - 4) * 2048), 16, 0, 0);
      }
      __builtin_amdgcn_sched_barrier(0);
    }
    st = (st == 2) ? 0 : st + 1;
  }
#undef G2_DMA
  __syncthreads();
}

template <int PS>
DEV void stage_half(const int tid, float* Cs, const f32x4 (&acc)[8][4]) {
  const int lane = tid & 63, wave = tid >> 6, wr = wave >> 1, wc = wave & 1, fr = lane & 15, fq = lane >> 4;
#pragma unroll
  for (int m = 0; m < 4; ++m)
#pragma unroll
    for (int n = 0; n < 4; ++n)
#pragma unroll
      for (int j = 0; j < 4; ++j) Cs[(wr * 64 + m * 16 + fq * 4 + j) * 132 + wc * 64 + n * 16 + fr] = acc[PS * 4 + m][n][j];
}
#define RMAP(r, ps) ((((r) >> 6) << 7) + (ps) * 64 + ((r) & 63))

DEV void gemm_tile512(const int T, const bf16_t* A, int lda, const bf16_t* B, int ldb, int K, char* smem0,
                      f32x4 (&acc)[8][4]) {
  bf16_t* As = (bf16_t*)smem0;
  bf16_t* Bs = As + 2 * 16384;
  const int lane = T & 63, wave = T >> 6, wr = wave >> 2, wc = wave & 3;
  const int fr = lane & 15, fq = lane >> 4;
#pragma unroll
  for (int m = 0; m < 8; ++m)
#pragma unroll
    for (int n = 0; n < 4; ++n) acc[m][n] = (f32x4){0.f, 0.f, 0.f, 0.f};
  const int nk = K >> 6;
  const int drow = T >> 3, dlog = ((T & 7) ^ ((T >> 3) & 7)) * 8;
  const bf16_t* Ap = A + (size_t)drow * lda + dlog;
  const bf16_t* Bp = B + (size_t)drow * ldb + dlog;
  const size_t a64 = (size_t)64 * lda, b64 = (size_t)64 * ldb;
  const int rofs0 = (fq ^ (fr & 7)) * 8, rofs1 = rofs0 ^ 32;
#pragma unroll
  for (int i = 0; i < 4; ++i) {
    __builtin_amdgcn_global_load_lds((const unsigned*)(Ap + i * a64), (unsigned*)(As + T * 8 + i * 4096), 16, 0, 0);
    __builtin_amdgcn_global_load_lds((const unsigned*)(Bp + i * b64), (unsigned*)(Bs + T * 8 + i * 4096), 16, 0, 0);
  }
  asm volatile("s_waitcnt vmcnt(0)" ::: "memory");
  __syncthreads();
  for (int kt = 0; kt < nk; ++kt) {
    const int buf = kt & 1;
    const bool pf = (kt + 1 < nk);
    bf16_t* Ad = As + (buf ^ 1) * 16384 + T * 8;
    bf16_t* Bd = Bs + (buf ^ 1) * 16384 + T * 8;
    const bf16_t* Asrc = Ap + (kt + 1) * 64;
    const bf16_t* Bsrc = Bp + (kt + 1) * 64;
    const bf16_t* Ab = As + buf * 16384 + (wr * 128 + fr) * 64;
    const bf16_t* Bb = Bs + buf * 16384 + (wc * 64 + fr) * 64;
#pragma unroll
    for (int ks = 0; ks < 2; ++ks) {
      const int ro = ks ? rofs1 : rofs0;
      bf16x8 bfr[4], af[4];
#pragma unroll
      for (int n = 0; n < 4; ++n) bfr[n] = *(const bf16x8*)(Bb + n * 1024 + ro);
#pragma unroll
      for (int m = 0; m < 4; ++m) af[m] = *(const bf16x8*)(Ab + m * 1024 + ro);
#pragma unroll
      for (int m = 0; m < 8; ++m) {
#pragma unroll
        for (int n = 0; n < 4; ++n) acc[m][n] = MFMA(af[m & 3], bfr[n], acc[m][n]);
        if (m + 4 < 8) af[m & 3] = *(const bf16x8*)(Ab + (m + 4) * 1024 + ro);
        if (pf && ks == 0) {
          const int piece = m;
          if (piece < 4) __builtin_amdgcn_global_load_lds((const unsigned*)(Asrc + piece * a64), (unsigned*)(Ad + piece * 4096), 16, 0, 0);
          else __builtin_amdgcn_global_load_lds((const unsigned*)(Bsrc + (piece - 4) * b64), (unsigned*)(Bd + (piece - 4) * 4096), 16, 0, 0);
        }
        __builtin_amdgcn_sched_barrier(0);
      }
    }
    asm volatile("s_waitcnt vmcnt(0)" ::: "memory");
    __builtin_amdgcn_s_barrier();
    asm volatile("" ::: "memory");
  }
  __syncthreads();
}
template <int PS>
DEV void stage_half512(const int T, float* Cs, const f32x4 (&acc)[8][4]) {
  const int lane = T & 63, wave = T >> 6, wc = wave & 3, fr = lane & 15, fq = lane >> 4;
#pragma unroll
  for (int m = 0; m < 4; ++m)
#pragma unroll
    for (int n = 0; n < 4; ++n)
#pragma unroll
      for (int j = 0; j < 4; ++j) Cs[((wc >> 1) * 64 + m * 16 + fq * 4 + j) * 132 + (wc & 1) * 64 + n * 16 + fr] = acc[PS * 4 + m][n][j];
}
#define GROW(r, ps) (row0 + (size_t)(hf * 128 + (ps) * 64 + ((r) & 63)))
#define TNC(r) (tn * 2 + ((r) >> 6))

DEV bool tile_for(int it, int nM, int nN, int& tm, int& tn) {
  const int nx = (gridDim.x >> 3) * 2;
  const int xcd = blockIdx.x & 7, local = (blockIdx.x >> 3) * 2 + vhalf();
  const long id = ((long)it * 8 + xcd) * nx + local;
  if (local >= nx || id >= (long)nM * nN) return false;
  const int per_group = 8 * nN;
  const int g = (int)(id / per_group), r = (int)(id % per_group);
  tn = r >> 3; tm = g * 8 + (r & 7);
  return true;
}

DEV bool tile_for_real(int it, int nM, int nN, int& tm, int& tn) {
  const int nx = (gridDim.x >> 3);
  const int xcd = blockIdx.x & 7, local = (blockIdx.x >> 3);
  const long id = ((long)it * 8 + xcd) * nx + local;
  if (local >= nx || id >= (long)nM * nN) return false;
  const int per_group = 8 * nN;
  const int g = (int)(id / per_group), r = (int)(id % per_group);
  tn = r >> 3; tm = g * 8 + (r & 7);
  return true;
}

PHASE void phase_prep(const Params& p, char* smem) {
  const int tid = opaque_tid();
  const int vb = vblock(), vg = vgrid();
  if (vb == 0 && tid < 8) p.counters[tid] = 0u;
  if (vb == 0) for (int i = tid; i < 3456; i += 256) p.counters[256 + i] = 0u;
  float* tile = (float*)smem;
  const int NCONV = 2 * 4864, NADA = 192;
  for (int item0 = vb; item0 < NCONV + NADA; item0 += vg) {
    const int item = (item0 < NADA) ? (NCONV + item0) : (item0 - NADA);
    if (item < NCONV) {
      const int l = item / 4864; int r = item % 4864;
      const float* src; int K, Nsrc, nT, perm = 0; size_t dst;
      if (r < 2112) { src = p.w_in + (size_t)l * 1024 * 8448; K = 1024; Nsrc = 8448; dst = WIN; nT = 132; }
      else if (r < 2240) { r -= 2112; src = p.w_br_a + (size_t)l * 512 * 1024; K = 512; Nsrc = 1024; dst = WBA; nT = 16; }
      else if (r < 2368) { r -= 2240; src = p.w_br_b + (size_t)l * 512 * 1024; K = 512; Nsrc = 1024; dst = WBB; nT = 16; }
      else if (r < 2496) { r -= 2368; src = p.w_br_c + (size_t)l * 512 * 1024; K = 512; Nsrc = 1024; dst = WBC; nT = 16; }
      else if (r < 2752) { r -= 2496; src = p.w_out + (size_t)l * 1024 * 1024; K = 1024; Nsrc = 1024; dst = WOUT; nT = 16; }
      else if (r < 4160) { r -= 2752; src = p.ffn_w_in + (size_t)l * 1024 * 5632; K = 1024; Nsrc = 5632; dst = WFI; nT = 88; perm = 1; }
      else { r -= 4160; src = p.ffn_w_out + (size_t)l * 2816 * 1024; K = 2816; Nsrc = 1024; dst = WFO; nT = 16; }
      const int kt = r / nT, nt = r % nT;
      const int colbase = perm ? ((nt & 1) * FFH + 64 * (nt >> 1)) : nt * 64;
      __syncthreads();
#pragma unroll
      for (int i = 0; i < 16; ++i) {
        const int k = i * 4 + (tid >> 6), j = tid & 63;
        tile[k * 65 + j] = src[(size_t)(kt * 64 + k) * Nsrc + colbase + j];
      }
      __syncthreads();
      const int row = tid >> 2, kc = (tid & 3) * 16;
      float f[16];
#pragma unroll
      for (int i = 0; i < 16; ++i) f[i] = tile[(kc + i) * 65 + row];
      bf16_t* d = p.wt + (size_t)l * WLAYER + dst + (size_t)(nt * 64 + row) * K + kt * 64 + kc;
      *(uint4*)d = make_uint4(pack2(f[0], f[1]), pack2(f[2], f[3]), pack2(f[4], f[5]), pack2(f[6], f[7]));
      *(uint4*)(d + 8) = make_uint4(pack2(f[8], f[9]), pack2(f[10], f[11]), pack2(f[12], f[13]), pack2(f[14], f[15]));
    } else {
      const int a = item - NCONV;
      const int l = a / 96, r = a % 96, ntile = r >> 2, bg = r & 3;
      float* cact = (float*)smem;
      __syncthreads();
      for (int i = tid; i < 8 * 1024; i += 256) {
        const float cv = p.c[(size_t)(bg * 8 + (i >> 10)) * DM + (i & 1023)];
        cact[i] = cv * sigm(cv);
      }
      __syncthreads();
      const int n = ntile * 256 + tid;
      const float* W = p.ada_w + (size_t)l * DM * ADAW + n;
      float acc[8];
#pragma unroll
      for (int b = 0; b < 8; ++b) acc[b] = 0.f;
      for (int k0 = 0; k0 < DM; k0 += 16) {
        float w[16];
#pragma unroll
        for (int kk = 0; kk < 16; ++kk) w[kk] = W[(size_t)(k0 + kk) * ADAW];
#pragma unroll
        for (int kk = 0; kk < 16; ++kk)
#pragma unroll
          for (int b = 0; b < 8; ++b) acc[b] += cact[b * 1024 + k0 + kk] * w[kk];
      }
      const float bias = p.ada_b[l * ADAW + n];
#pragma unroll
      for (int b = 0; b < 8; ++b) p.ada[((size_t)l * 32 + bg * 8 + b) * ADAW + n] = acc[b] + bias;
    }
  }
}

PHASE void phase_norm(const float* __restrict__ x, const float* __restrict__ w, const float* __restrict__ ada_l,
                    int shift_off, int scale_off, bf16_t* __restrict__ h) {
  const int tid = opaque_tid();
  const int lane = tid & 63, wave = tid >> 6;
  for (int row0 = (vblock() * 4 + wave) * 4; row0 < T_TOK; row0 += vgrid() * 16) {
    float4 v[4][4]; float ss[4];
#pragma unroll
    for (int rr = 0; rr < 4; ++rr)
#pragma unroll
      for (int i = 0; i < 4; ++i) v[rr][i] = *(const float4*)(x + (size_t)(row0 + rr) * DM + i * 256 + lane * 4);
#pragma unroll
    for (int rr = 0; rr < 4; ++rr) {
      float a = 0.f;
#pragma unroll
      for (int i = 0; i < 4; ++i) a += v[rr][i].x * v[rr][i].x + v[rr][i].y * v[rr][i].y + v[rr][i].z * v[rr][i].z + v[rr][i].w * v[rr][i].w;
      ss[rr] = rsqrtf(wave_sum(a) * (1.f / DM) + 1e-6f);
    }
    const float* ad = ada_l + (size_t)(row0 / SEQ) * ADAW;
#pragma unroll
    for (int i = 0; i < 4; ++i) {
      const int col = i * 256 + lane * 4;
      const float4 ww = *(const float4*)(w + col), sc = *(const float4*)(ad + scale_off + col), sh = *(const float4*)(ad + shift_off + col);
#pragma unroll
      for (int rr = 0; rr < 4; ++rr) {
        const float rstd = ss[rr];
        const float o0 = v[rr][i].x * rstd * ww.x * (1.f + sc.x) + sh.x, o1 = v[rr][i].y * rstd * ww.y * (1.f + sc.y) + sh.y;
        const float o2 = v[rr][i].z * rstd * ww.z * (1.f + sc.z) + sh.z, o3 = v[rr][i].w * rstd * ww.w * (1.f + sc.w) + sh.w;
        *(uint2*)(h + (size_t)(row0 + rr) * DM + col) = make_uint2(pack2(o0, o1), pack2(o2, o3));
      }
    }
  }
}

PHASE void phase_final(float* __restrict__ x, const float* __restrict__ w) {
  const int tid = opaque_tid();
  const int lane = tid & 63, wave = tid >> 6;
  for (int row0 = (vblock() * 4 + wave) * 4; row0 < T_TOK; row0 += vgrid() * 16) {
    float4 v[4][4]; float ss[4];
#pragma unroll
    for (int rr = 0; rr < 4; ++rr)
#pragma unroll
      for (int i = 0; i < 4; ++i) v[rr][i] = *(const float4*)(x + (size_t)(row0 + rr) * DM + i * 256 + lane * 4);
#pragma unroll
    for (int rr = 0; rr < 4; ++rr) {
      float a = 0.f;
#pragma unroll
      for (int i = 0; i < 4; ++i) a += v[rr][i].x * v[rr][i].x + v[rr][i].y * v[rr][i].y + v[rr][i].z * v[rr][i].z + v[rr][i].w * v[rr][i].w;
      ss[rr] = rsqrtf(wave_sum(a) * (1.f / DM) + 1e-6f);
    }
#pragma unroll
    for (int i = 0; i < 4; ++i) {
      const int col = i * 256 + lane * 4;
      const float4 ww = *(const float4*)(w + col);
#pragma unroll
      for (int rr = 0; rr < 4; ++rr) {
        const float rstd = ss[rr];
        *(float4*)(x + (size_t)(row0 + rr) * DM + col) =
            make_float4(v[rr][i].x * rstd * ww.x, v[rr][i].y * rstd * ww.y, v[rr][i].z * rstd * ww.z, v[rr][i].w * rstd * ww.w);
      }
    }
  }
}

PHASE void phase_gemm_in(const Params& p, int l, char* smem0) {
  const bf16_t* Wt = p.wt + (size_t)l * WLAYER + WIN;
  const int T = opaque_tid512(), tid = T & 255, hf = vhalf();
  float* Cs = (float*)(smem0 + hf * SMEM_BYTES);
  for (int it = 0;; ++it) {
    int tm, tn;
    if (!tile_for_real(it, 256, 21, tm, tn)) break;
    f32x4 acc[8][4];
    gemm_tile512(T, p.h + (size_t)tm * 256 * DM, DM, Wt + (size_t)tn * 256 * DM, DM, DM, smem0, acc);
    const size_t row0 = (size_t)tm * 256;
#pragma unroll
    for (int ps = 0; ps < 2; ++ps) {
      if (ps == 0) stage_half512<0>(T, Cs, acc); else stage_half512<1>(T, Cs, acc);
      __syncthreads();
      if (tn < 4) {
        const float qs = (tn < 2) ? 0.125f : 1.f;
        const int ch = tid & 15, g = ch >> 3, cc = ch & 7;
        if (cc < 4) {
#pragma unroll 1
          for (int i = 0; i < 8; ++i) {
            const int r = (tid >> 4) + i * 16;
            const size_t grow = GROW(r, ps);
            const float pos = (float)p.pos[grow];
            const float* c1 = Cs + r * 132 + g * 64 + cc * 8;
            float o1[8], o2[8];
#pragma unroll
            for (int e = 0; e < 8; ++e) {
              const float x1 = c1[e], x2 = c1[32 + e];
              const float inv = exp2f(-(float)(cc * 8 + e) * 0.41524101186092029f);
              float rev = pos * inv * 0.15915494309189535f;
              rev -= rintf(rev);
              const float sn = __builtin_amdgcn_sinf(rev), cs = __builtin_amdgcn_cosf(rev);
              o1[e] = (x1 * cs - x2 * sn) * qs; o2[e] = (x2 * cs + x1 * sn) * qs;
            }
            bf16_t* d = p.u + grow * US + TNC(r) * 128 + g * 64 + cc * 8;
            *(uint4*)d = PACK8(o1);
            *(uint4*)(d + 32) = PACK8(o2);
          }
        }
      } else if (tn < 6) {
        const int b = (int)(row0 / SEQ), s0 = (int)(row0 % SEQ);
        const int rch = tid & 15;
        const int vc0 = (TNC(rch * 8) - 8) * 128;
#pragma unroll 1
        for (int i = 0; i < 8; ++i) {
          const int c = (tid >> 4) + i * 16;
          float f[8];
#pragma unroll
          for (int j = 0; j < 8; ++j) f[j] = Cs[(rch * 8 + j) * 132 + c];
          *(uint4*)(p.vT + ((size_t)b * 512 + vc0 + c) * SEQ + s0 + hf * 128 + ps * 64 + ((rch * 8) & 63)) = PACK8(f);
        }
      } else {
        const int ch = tid & 15;
#pragma unroll 1
        for (int i = 0; i < 8; ++i) {
          const int r = (tid >> 4) + i * 16;
          const float4 a = *(const float4*)(Cs + r * 132 + ch * 8), b = *(const float4*)(Cs + r * 132 + ch * 8 + 4);
          *(uint4*)(p.u + GROW(r, ps) * US + TNC(r) * 128 - 512 + ch * 8) = make_uint4(pack2(a.x, a.y), pack2(a.z, a.w), pack2(b.x, b.y), pack2(b.z, b.w));
        }
      }
      __syncthreads();
    }
  }
}

PHASE void phase_vlo(const Params& p, int l, char* smem) {
  float* vs = (float*)smem;
  const int tid = opaque_tid();
  const float* mu = p.rw_mu + (size_t)l * 1792 + 1024;
  const float* v1 = p.rw_v1;
  for (int item = vblock(); item < T_TOK / 32; item += vgrid()) {
    const size_t tok0 = (size_t)item * 32;
    __syncthreads();
#pragma unroll 1
    for (int i = 0; i < 8; ++i) {
      const int c = tid + i * 256;
      const int t = c >> 6, cc = c & 63;
      const size_t tok = tok0 + t;
      const uint4 cur = *(const uint4*)(p.u + tok * US + 3072 + 1024 + cc * 8);
      uint4 prv = make_uint4(0, 0, 0, 0);
      if ((tok % SEQ) != 0) prv = *(const uint4*)(p.u + (tok - 1) * US + 3072 + 1024 + cc * 8);
      float a[8], b[8];
      UNPACK8(cur, a); UNPACK8(prv, b);
#pragma unroll
      for (int e = 0; e < 8; ++e) vs[t * 512 + cc * 8 + e] = a[e] + (b[e] - a[e]) * mu[cc * 8 + e];
    }
    __syncthreads();
    const int j = tid & 31, tg = tid >> 5;
    float acc[4] = {0.f, 0.f, 0.f, 0.f};
    for (int k0 = 0; k0 < 512; k0 += 16) {
      float w[16];
#pragma unroll
      for (int kk = 0; kk < 16; ++kk) w[kk] = v1[(k0 + kk) * 32 + j];
#pragma unroll
      for (int kk = 0; kk < 16; ++kk)
#pragma unroll
        for (int i = 0; i < 4; ++i) acc[i] += vs[(tg * 4 + i) * 512 + k0 + kk] * w[kk];
    }
#pragma unroll
    for (int i = 0; i < 4; ++i) p.vlo[(tok0 + tg * 4 + i) * 32 + j] = acc[i];
  }
}

PHASE void att_item(const Params& p, int l, int item, char* smem) {
  const int qc = 31 - (item >> 7);
  const int bh = item & 127, b = bh >> 2, h = bh & 3;
  const int tid = opaque_tid(), lane = tid & 63, wave = tid >> 6, fr = lane & 15, fq = lane >> 4;
  const int m = wave >> 1, rh = wave & 1;
  bf16_t* Ks = (bf16_t*)smem;
  bf16_t* Vt = Ks + 2 * 64 * 64;
  bf16_t* Ps = Vt + 128 * 64;
  float* Ox = (float*)smem;
  const size_t tok0 = (size_t)b * SEQ + (size_t)qc * 64;
  const float* lv = p.da_lambda + (size_t)l * 256;
  float d1 = 0.f, d2 = 0.f;
  for (int i = 0; i < 64; ++i) { d1 += lv[i] * lv[64 + i]; d2 += lv[128 + i] * lv[192 + i]; }
  const float lam_init = 0.8f - 0.6f * __expf(-0.3f * (float)l);
  const float lam = __expf(d1) - __expf(d2) + lam_init;

  bf16x8 qf[2][2];
#pragma unroll
  for (int mt = 0; mt < 2; ++mt)
#pragma unroll
    for (int ks = 0; ks < 2; ++ks)
      qf[mt][ks] = *(const bf16x8*)(p.u + (tok0 + rh * 32 + mt * 16 + fr) * US + h * 128 + m * 64 + ks * 32 + fq * 8);
  f32x4 o[2][8];
  float mx[2][4], ls[2][4];
#pragma unroll
  for (int mt = 0; mt < 2; ++mt) {
#pragma unroll
    for (int n = 0; n < 8; ++n) o[mt][n] = (f32x4){0.f, 0.f, 0.f, 0.f};
#pragma unroll
    for (int j = 0; j < 4; ++j) { mx[mt][j] = -1e30f; ls[mt][j] = 0.f; }
  }
  bf16_t* Pw = Ps + wave * 32 * 72;
  const int drow = tid >> 3, dlog = ((tid & 7) ^ ((tid >> 3) & 7)) * 8;
  const bf16_t* Kg = p.u + ((size_t)b * SEQ + (drow & 63)) * US + 512 + h * 128 + dlog;
  const bf16_t* Vg = p.vT + ((size_t)b * 512 + h * 128 + drow) * SEQ + dlog;
  const int rsw = fr & 7;
#define ATT_DMA_K(kt_)                                                                                              \
  _Pragma("unroll") for (int i = 0; i < 4; ++i)                                                                     \
    __builtin_amdgcn_global_load_lds((const unsigned*)(Kg + ((size_t)(kt_) * 64 + (i & 1) * 32) * US + (i >> 1) * 64), \
                                     (unsigned*)(Ks + tid * 8 + i * 2048), 16, 0, 0);
#define ATT_DMA_V(kt_)                                                                                              \
  _Pragma("unroll") for (int i = 0; i < 4; ++i)                                                                     \
    __builtin_amdgcn_global_load_lds((const unsigned*)(Vg + (size_t)(i * 32) * SEQ + (kt_) * 64),                  \
                                     (unsigned*)(Vt + tid * 8 + i * 2048), 16, 0, 0);
  __syncthreads();
  ATT_DMA_K(0)
  for (int kt = 0; kt <= qc; ++kt) {
    asm volatile("s_waitcnt vmcnt(0)" ::: "memory");
    __syncthreads();
    ATT_DMA_V(kt)
    f32x4 s[2][4];
#pragma unroll
    for (int mt = 0; mt < 2; ++mt)
#pragma unroll
      for (int n = 0; n < 4; ++n) s[mt][n] = (f32x4){0.f, 0.f, 0.f, 0.f};
#pragma unroll
    for (int ks = 0; ks < 2; ++ks)
#pragma unroll
      for (int n = 0; n < 4; ++n) {
        const bf16x8 kf = *(const bf16x8*)(Ks + (m * 64 + n * 16 + fr) * 64 + (((ks * 4 + fq) ^ rsw) * 8));
#pragma unroll
        for (int mt = 0; mt < 2; ++mt) s[mt][n] = MFMA(qf[mt][ks], kf, s[mt][n]);
      }
#pragma unroll
    for (int mt = 0; mt < 2; ++mt)
#pragma unroll
      for (int j = 0; j < 4; ++j) {
        float tmax = fmaxf(fmaxf(s[mt][0][j], s[mt][1][j]), fmaxf(s[mt][2][j], s[mt][3][j]));
        tmax = red16_max(tmax);
        const float mnew = fmaxf(mx[mt][j], tmax);
        const float alpha = __expf(mx[mt][j] - mnew);
        float rs = 0.f;
#pragma unroll
        for (int n = 0; n < 4; ++n) {
          const float pv = __expf(s[mt][n][j] - mnew);
          rs += pv;
          Pw[(mt * 16 + fq * 4 + j) * 72 + n * 16 + fr] = f2bf(pv);
        }
        rs = red16_sum(rs);
        ls[mt][j] = ls[mt][j] * alpha + rs;
        mx[mt][j] = mnew;
#pragma unroll
        for (int n = 0; n < 8; ++n) o[mt][n][j] *= alpha;
      }
    asm volatile("s_waitcnt vmcnt(0)" ::: "memory");
    __syncthreads();
    if (kt < qc) { ATT_DMA_K(kt + 1) }
#pragma unroll
    for (int ks = 0; ks < 2; ++ks) {
      bf16x8 pf[2];
#pragma unroll
      for (int mt = 0; mt < 2; ++mt) pf[mt] = *(const bf16x8*)(Pw + (mt * 16 + fr) * 72 + ks * 32 + fq * 8);
#pragma unroll
      for (int n = 0; n < 8; ++n) {
        const bf16x8 vf = *(const bf16x8*)(Vt + (n * 16 + fr) * 64 + (((ks * 4 + fq) ^ rsw) * 8));
#pragma unroll
        for (int mt = 0; mt < 2; ++mt) o[mt][n] = MFMA(pf[mt], vf, o[mt][n]);
      }
    }
  }
#undef ATT_DMA_K
#undef ATT_DMA_V
  __syncthreads();
#pragma unroll
  for (int mt = 0; mt < 2; ++mt)
#pragma unroll
    for (int j = 0; j < 4; ++j) {
      const float inv = 1.f / ls[mt][j];
#pragma unroll
      for (int n = 0; n < 8; ++n) o[mt][n][j] *= inv;
    }
  if (m == 1) {
#pragma unroll
    for (int mt = 0; mt < 2; ++mt)
#pragma unroll
      for (int n = 0; n < 8; ++n)
#pragma unroll
        for (int j = 0; j < 4; ++j) Ox[(rh * 32 + mt * 16 + fq * 4 + j) * 132 + n * 16 + fr] = o[mt][n][j];
  }
  __syncthreads();
  if (m == 0) {
    const float* sw = p.da_subln_w + (size_t)l * 128;
    float wv[8];
#pragma unroll
    for (int n = 0; n < 8; ++n) wv[n] = sw[n * 16 + fr] * (1.f - lam_init);
#pragma unroll
    for (int mt = 0; mt < 2; ++mt)
#pragma unroll
      for (int j = 0; j < 4; ++j) {
        float ss = 0.f;
        float d[8];
#pragma unroll
        for (int n = 0; n < 8; ++n) {
          d[n] = o[mt][n][j] - lam * Ox[(rh * 32 + mt * 16 + fq * 4 + j) * 132 + n * 16 + fr];
          ss += d[n] * d[n];
        }
        ss = red16_sum(ss);
        const float rstd = rsqrtf(ss * (1.f / 128.f) + 1e-6f);
        bf16_t* dst = p.u + (tok0 + rh * 32 + mt * 16 + fq * 4 + j) * US + h * 128 + fr;
#pragma unroll
        for (int n = 0; n < 8; ++n) dst[n * 16] = f2bf(d[n] * rstd * wv[n]);
      }
  }
  __syncthreads();
}

PHASE void hgrn_item(const Params& p, int l, int item, char* smem) {
  const int b = item >> 2, h = item & 3;
  const int tid = opaque_tid(), lane = tid & 63, wave = tid >> 6, fr = lane & 15, fq = lane >> 4;
  bf16_t* Qs = (bf16_t*)smem;
  bf16_t* Kn = Qs + 32 * 136;
  bf16_t* KT = Kn + 32 * 136;
  bf16_t* VT = KT + 128 * 40;
  bf16_t* Ps = VT + 128 * 40;
  bf16_t* ST = Ps + 32 * 40;
  float* lfb = (float*)ST;
  float* red = (float*)(ST + 128 * 136);
  float* blast = red + 64;
  const int t_ = tid >> 3, d0 = (tid & 7) * 16;
  float lbv[16];
#pragma unroll
  for (int i = 0; i < 16; ++i) {
    const int c = h * 128 + d0 + i;
    lbv[i] = (l == 0) ? 0.f : sigm(p.hg_lb[512 + c] - p.hg_lb[c]);
  }
  f32x4 S[2][8];
#pragma unroll
  for (int mm = 0; mm < 2; ++mm)
#pragma unroll
    for (int n = 0; n < 8; ++n) S[mm][n] = (f32x4){0.f, 0.f, 0.f, 0.f};
  const float* nw = p.hg_norm_w + (size_t)l * 128;

  for (int ch = 0; ch < 64; ++ch) {
    const size_t tok0 = (size_t)b * SEQ + (size_t)ch * 32;
    __syncthreads();
    float qv[16], kv[16];
    {
      const bf16_t* base = p.u + (tok0 + t_) * US + h * 128 + d0;
      float zv[16], iv[16];
      { const uint4 a = *(const uint4*)(base + 1024), c = *(const uint4*)(base + 1024 + 8); float* z0 = zv; float* z1 = zv + 8; UNPACK8(a, z0); UNPACK8(c, z1); }
      { const uint4 a = *(const uint4*)(base + 1536), c = *(const uint4*)(base + 1536 + 8); float* z0 = iv; float* z1 = iv + 8; UNPACK8(a, z0); UNPACK8(c, z1); }
      { const uint4 a = *(const uint4*)(base + 2048), c = *(const uint4*)(base + 2048 + 8); float* z0 = qv; float* z1 = qv + 8; UNPACK8(a, z0); UNPACK8(c, z1); }
#pragma unroll
      for (int i = 0; i < 16; ++i) {
        const float z = zv[i], lb = lbv[i];
        const float ez = __expf(-fabsf(z));
        float lf;
        if (lb > 0.f) {
          const float sg = (z >= 0.f) ? 1.f / (1.f + ez) : ez / (1.f + ez);
          lf = __logf(lb + (1.f - lb) * sg);
        } else {
          lf = -(fmaxf(-z, 0.f) + __logf(1.f + ez));
        }
        const float sgn = (z >= 0.f) ? ez / (1.f + ez) : 1.f / (1.f + ez);
        kv[i] = (1.f - lb) * sgn;
        lfb[t_ * 128 + d0 + i] = lf;
        VT[(d0 + i) * 40 + t_] = f2bf(iv[i]);
      }
    }
    __syncthreads();
    if (tid < 128) {
      float v[32];
#pragma unroll
      for (int t = 0; t < 32; ++t) v[t] = lfb[t * 128 + tid];
      float bsum = 0.f;
#pragma unroll
      for (int t = 0; t < 32; ++t) { bsum += v[t]; lfb[t * 128 + tid] = bsum; }
      blast[tid] = bsum;
    }
    __syncthreads();
    {
      float qo[16], ko[16];
#pragma unroll
      for (int i = 0; i < 16; ++i) {
        const float bb = lfb[t_ * 128 + d0 + i];
        qo[i] = qv[i] * __expf(bb);
        ko[i] = kv[i] * __expf(fminf(-bb, 80.f));
        KT[(d0 + i) * 40 + t_] = f2bf(ko[i]);
      }
      float* q0 = qo; float* q1 = qo + 8; float* k0 = ko; float* k1 = ko + 8;
      *(uint4*)(Qs + t_ * 136 + d0) = PACK8(q0);
      *(uint4*)(Qs + t_ * 136 + d0 + 8) = PACK8(q1);
      *(uint4*)(Kn + t_ * 136 + d0) = PACK8(k0);
      *(uint4*)(Kn + t_ * 136 + d0 + 8) = PACK8(k1);
    }
    __syncthreads();
#pragma unroll
    for (int mm = 0; mm < 2; ++mm)
#pragma unroll
      for (int n = 0; n < 8; ++n)
        *(uint2*)(ST + (n * 16 + fr) * 136 + wave * 32 + mm * 16 + fq * 4) =
            make_uint2(pack2(S[mm][n][0], S[mm][n][1]), pack2(S[mm][n][2], S[mm][n][3]));
    {
      const int mt = wave >> 1, nt = wave & 1;
      f32x4 sc = (f32x4){0.f, 0.f, 0.f, 0.f};
#pragma unroll
      for (int ks = 0; ks < 4; ++ks) {
        const bf16x8 a = *(const bf16x8*)(Qs + (mt * 16 + fr) * 136 + ks * 32 + fq * 8);
        const bf16x8 bb = *(const bf16x8*)(Kn + (nt * 16 + fr) * 136 + ks * 32 + fq * 8);
        sc = MFMA(a, bb, sc);
      }
#pragma unroll
      for (int j = 0; j < 4; ++j) {
        const int t = mt * 16 + fq * 4 + j, key = nt * 16 + fr;
        Ps[t * 40 + key] = f2bf(key <= t ? sc[j] : 0.f);
      }
    }
    __syncthreads();
    {
      const int mt = wave & 1, nb = (wave >> 1) * 4;
      f32x4 oo[4];
#pragma unroll
      for (int n = 0; n < 4; ++n) oo[n] = (f32x4){0.f, 0.f, 0.f, 0.f};
      {
        const bf16x8 a = *(const bf16x8*)(Ps + (mt * 16 + fr) * 40 + fq * 8);
#pragma unroll
        for (int n = 0; n < 4; ++n) {
          const bf16x8 bb = *(const bf16x8*)(VT + ((nb + n) * 16 + fr) * 40 + fq * 8);
          oo[n] = MFMA(a, bb, oo[n]);
        }
      }
#pragma unroll
      for (int ks = 0; ks < 4; ++ks) {
        const bf16x8 a = *(const bf16x8*)(Qs + (mt * 16 + fr) * 136 + ks * 32 + fq * 8);
#pragma unroll
        for (int n = 0; n < 4; ++n) {
          const bf16x8 bb = *(const bf16x8*)(ST + ((nb + n) * 16 + fr) * 136 + ks * 32 + fq * 8);
          oo[n] = MFMA(a, bb, oo[n]);
        }
      }
#pragma unroll
      for (int j = 0; j < 4; ++j) {
        float ss = 0.f;
#pragma unroll
        for (int n = 0; n < 4; ++n) ss += oo[n][j] * oo[n][j];
        ss = red16_sum(ss);
        if (fr == 0) red[(mt * 16 + fq * 4 + j) * 2 + (wave >> 1)] = ss;
      }
      __syncthreads();
#pragma unroll
      for (int j = 0; j < 4; ++j) {
        const int t = mt * 16 + fq * 4 + j;
        const float rstd = rsqrtf((red[t * 2] + red[t * 2 + 1]) * (1.f / 128.f) + 1e-6f);
        bf16_t* gp = p.u + (tok0 + t) * US + 2560 + h * 128 + nb * 16 + fr;
#pragma unroll
        for (int n = 0; n < 4; ++n) {
          const float g = bf2f(gp[n * 16]);
          gp[n * 16] = f2bf(oo[n][j] * rstd * nw[(nb + n) * 16 + fr] * (g * sigm(g)));
        }
      }
    }
    {
      bf16x8 af[2];
#pragma unroll
      for (int mm = 0; mm < 2; ++mm) af[mm] = *(const bf16x8*)(KT + (wave * 32 + mm * 16 + fr) * 40 + fq * 8);
#pragma unroll
      for (int n = 0; n < 8; ++n) {
        const bf16x8 bb = *(const bf16x8*)(VT + (n * 16 + fr) * 40 + fq * 8);
#pragma unroll
        for (int mm = 0; mm < 2; ++mm) S[mm][n] = MFMA(af[mm], bb, S[mm][n]);
      }
#pragma unroll
      for (int mm = 0; mm < 2; ++mm)
#pragma unroll
        for (int j = 0; j < 4; ++j) {
          const float e = __expf(blast[wave * 32 + mm * 16 + fq * 4 + j]);
#pragma unroll
          for (int n = 0; n < 8; ++n) S[mm][n][j] *= e;
        }
    }
  }
  __syncthreads();
}

DEV uint4 rw_act(const uint4 cur, const uint4 prv, const float* mul8, int mode) {
  const float4 m0 = *(const float4*)(mul8), m1 = *(const float4*)(mul8 + 4);
  const float mm[8] = {m0.x, m0.y, m0.z, m0.w, m1.x, m1.y, m1.z, m1.w};
  float a[8], b[8], o[8];
  UNPACK8(cur, a); UNPACK8(prv, b);
#pragma unroll
  for (int e = 0; e < 8; ++e) {
    float v = a[e] + (b[e] - a[e]) * mm[e];
    if (mode == 1) { const float t = __expf(-2.f * fabsf(v)); const float th = (1.f - t) / (1.f + t); v = (v >= 0.f) ? th : -th; }
    else if (mode == 2) v = sigm(v);
    o[e] = v;
  }
  return PACK8(o);
}
DEV bf16x8 rw_bfrag(const float* W, int k0, int col) {
  float o[8];
#pragma unroll
  for (int e = 0; e < 8; ++e) o[e] = W[(size_t)(k0 + e) * 512 + col];
  return as_frag(PACK8(o));
}

PHASE void rwkv_item(const Params& p, int l, int item, char* smem) {
  const int b = item >> 3, h = item & 7;
  const int tid = opaque_tid(), lane = tid & 63, wave = tid >> 6, fr = lane & 15, fq = lane >> 4;
  float* R = (float*)smem;
  float* K = R + 2048; float* KK = K + 2048; float* W = KK + 2048; float* BB = W + 2048;
  float* V = BB + 2048; float* G = V + 2048; float* O = G + 2048;
  float* cst = O + 2048;
  float* mul = cst + 512;
  bf16_t* rawL = (bf16_t*)smem;
  float* vloL = (float*)(smem + 17424);
  const float* mu = p.rw_mu + (size_t)l * 1792;
  const int hc_n = h * 64 + wave * 16 + fr;
  bf16x8 w2f[2], a2f[2], g2f[4], v2f;
#pragma unroll
  for (int ks = 0; ks < 2; ++ks) {
    w2f[ks] = rw_bfrag(p.rw_w2 + (size_t)l * 64 * 512, ks * 32 + fq * 8, hc_n);
    a2f[ks] = rw_bfrag(p.rw_a2 + (size_t)l * 64 * 512, ks * 32 + fq * 8, hc_n);
  }
#pragma unroll
  for (int ks = 0; ks < 4; ++ks) g2f[ks] = rw_bfrag(p.rw_g2 + (size_t)l * 128 * 512, ks * 32 + fq * 8, hc_n);
  v2f = w2f[0];
  if (l > 0) v2f = rw_bfrag(p.rw_v2, fq * 8, hc_n);
  const float w0c = p.rw_w0[l * 512 + hc_n], a0c = p.rw_a0[l * 512 + hc_n];
  const float v0c = (l > 0) ? p.rw_v0[hc_n] : 0.f;
  const int t_ = tid >> 3, n0 = (tid & 7) * 8;
  __syncthreads();
  if (tid < 64) {
    const int hc = h * 64 + tid;
    cst[tid] = p.rw_k_k[l * 512 + hc]; cst[64 + tid] = p.rw_k_a[l * 512 + hc]; cst[128 + tid] = p.rw_r_k[l * 512 + hc];
    cst[192 + tid] = p.rw_gn_w[l * 512 + hc]; cst[256 + tid] = p.rw_gn_b[l * 512 + hc];
    cst[320 + tid] = mu[hc]; cst[384 + tid] = mu[512 + hc]; cst[448 + tid] = mu[1024 + hc];
  }
  mul[tid] = mu[1536 + tid];
  const float* kkc = cst + n0; const float* kac = cst + 64 + n0; const float* rkc = cst + 128 + n0;
  const float* gnw = cst + 192 + n0; const float* gnb = cst + 256 + n0;
  const float* mur = cst + 320 + n0; const float* muk = cst + 384 + n0; const float* muv = cst + 448 + n0;
  const int kq = lane & 7, row0 = wave * 16 + (lane >> 3), row1 = row0 + 8;
  f32x2 S0p[4], S1p[4];
#pragma unroll
  for (int e = 0; e < 4; ++e) { S0p[e] = (f32x2){0.f, 0.f}; S1p[e] = (f32x2){0.f, 0.f}; }

  uint4 pl0, pl1, pl2, pl3, pl4, pcr, pck, pcv, ppr, ppk, ppv, pvf;
  float4 pvl;
#define RW_PREFETCH(ch_)                                                                                    \
  {                                                                                                         \
    const size_t tk0 = (size_t)b * SEQ + (size_t)(ch_) * 32;                                                 \
    const bf16_t* lb_ = p.u + (tk0 - 1) * US + 3072 + 1536 + (tid & 31) * 8;                                 \
    const int r0_ = tid >> 5;                                                                               \
    pl0 = make_uint4(0, 0, 0, 0); if (!((ch_) == 0 && r0_ == 0)) pl0 = *(const uint4*)(lb_ + (size_t)r0_ * US); \
    pl1 = *(const uint4*)(lb_ + (size_t)(r0_ + 8) * US);                                                     \
    pl2 = *(const uint4*)(lb_ + (size_t)(r0_ + 16) * US);                                                    \
    pl3 = *(const uint4*)(lb_ + (size_t)(r0_ + 24) * US);                                                    \
    pl4 = make_uint4(0, 0, 0, 0); if (tid < 32) pl4 = *(const uint4*)(lb_ + (size_t)32 * US);                \
    const bf16_t* cu_ = p.u + (tk0 + t_) * US + 3072 + h * 64 + n0;                                          \
    pcr = *(const uint4*)cu_; pck = *(const uint4*)(cu_ + 512); pcv = *(const uint4*)(cu_ + 1024);           \
    if ((ch_) == 0 && t_ == 0) { ppr = make_uint4(0, 0, 0, 0); ppk = ppr; ppv = ppr; }                        \
    else { ppr = *(const uint4*)(cu_ - US); ppk = *(const uint4*)(cu_ - US + 512); ppv = *(const uint4*)(cu_ - US + 1024); } \
    if (l > 0) {                                                                                            \
      pvl = *(const float4*)(p.vlo + (tk0 + (tid >> 3)) * 32 + (tid & 7) * 4);                               \
      pvf = *(const uint4*)(p.vfirst + (tk0 + t_) * 512 + h * 64 + n0);                                      \
    } else { pvl = make_float4(0.f, 0.f, 0.f, 0.f); pvf = make_uint4(0, 0, 0, 0); }                          \
  }
  RW_PREFETCH(0)

  for (int ch = 0; ch < 64; ++ch) {
    const size_t tok0 = (size_t)b * SEQ + (size_t)ch * 32;
    __syncthreads();
    {
      const int r0_ = tid >> 5, cc_ = (tid & 31) * 8;
      *(uint4*)(rawL + r0_ * 264 + cc_) = pl0;
      *(uint4*)(rawL + (r0_ + 8) * 264 + cc_) = pl1;
      *(uint4*)(rawL + (r0_ + 16) * 264 + cc_) = pl2;
      *(uint4*)(rawL + (r0_ + 24) * 264 + cc_) = pl3;
      if (tid < 32) *(uint4*)(rawL + 32 * 264 + cc_) = pl4;
      *(float4*)(vloL + (tid >> 3) * 36 + (tid & 7) * 4) = pvl;
    }
    __syncthreads();
    {
      const int cc_ = (tid & 31) * 8, tr = tid >> 5;
      const int mode = (cc_ < 64) ? 1 : ((cc_ < 128) ? 0 : 2);
      uint4 a0, a1, a2, a3;
      a0 = rw_act(*(const uint4*)(rawL + (tr + 1) * 264 + cc_), *(const uint4*)(rawL + tr * 264 + cc_), mul + cc_, mode);
      a1 = rw_act(*(const uint4*)(rawL + (tr + 9) * 264 + cc_), *(const uint4*)(rawL + (tr + 8) * 264 + cc_), mul + cc_, mode);
      a2 = rw_act(*(const uint4*)(rawL + (tr + 17) * 264 + cc_), *(const uint4*)(rawL + (tr + 16) * 264 + cc_), mul + cc_, mode);
      a3 = rw_act(*(const uint4*)(rawL + (tr + 25) * 264 + cc_), *(const uint4*)(rawL + (tr + 24) * 264 + cc_), mul + cc_, mode);
      __syncthreads();
      *(uint4*)(rawL + tr * 264 + cc_) = a0;
      *(uint4*)(rawL + (tr + 8) * 264 + cc_) = a1;
      *(uint4*)(rawL + (tr + 16) * 264 + cc_) = a2;
      *(uint4*)(rawL + (tr + 24) * 264 + cc_) = a3;
    }
    __syncthreads();
#pragma unroll 1
    for (int mt = 0; mt < 2; ++mt) {
      const int row = mt * 16 + fr;
      const bf16_t* ar = rawL + row * 264 + fq * 8;
      f32x4 aw = (f32x4){0.f, 0.f, 0.f, 0.f}, aa = aw, ag = aw, av = aw;
#pragma unroll
      for (int ks = 0; ks < 2; ++ks) {
        aw = MFMA(*(const bf16x8*)(ar + ks * 32), w2f[ks], aw);
        aa = MFMA(*(const bf16x8*)(ar + 64 + ks * 32), a2f[ks], aa);
      }
#pragma unroll
      for (int ks = 0; ks < 4; ++ks) ag = MFMA(*(const bf16x8*)(ar + 128 + ks * 32), g2f[ks], ag);
      if (l > 0) {
        const float4 x0 = *(const float4*)(vloL + row * 36 + fq * 8), x1 = *(const float4*)(vloL + row * 36 + fq * 8 + 4);
        const uint4 pk = make_uint4(pack2(x0.x, x0.y), pack2(x0.z, x0.w), pack2(x1.x, x1.y), pack2(x1.z, x1.w));
        av = MFMA(as_frag(pk), v2f, av);
      }
#pragma unroll
      for (int j = 0; j < 4; ++j) {
        const int t = mt * 16 + fq * 4 + j, n = wave * 16 + fr;
        const float wv = -(w0c + aw[j]);
        const float sp = fmaxf(wv, 0.f) + __logf(1.f + __expf(-fabsf(wv)));
        const float wl = -sp - 0.5f;
        W[t * 64 + n] = __expf(-__expf(wl));
        BB[t * 64 + n] = sigm(a0c + aa[j]);
        G[t * 64 + n] = ag[j];
        if (l > 0) O[t * 64 + n] = sigm(v0c + av[j]);
      }
    }
    __syncthreads();
    {
      const size_t tok = tok0 + t_;
      float cr[8], ck[8], cv[8], pr[8], pk[8], pv[8];
      UNPACK8(pcr, cr); UNPACK8(pck, ck); UNPACK8(pcv, cv);
      UNPACK8(ppr, pr); UNPACK8(ppk, pk); UNPACK8(ppv, pv);
      float kx[8], kkv[8], vs[8], ss = 0.f;
#pragma unroll
      for (int e = 0; e < 8; ++e) {
        R[t_ * 64 + n0 + e] = cr[e] + (pr[e] - cr[e]) * mur[e];
        kx[e] = ck[e] + (pk[e] - ck[e]) * muk[e];
        vs[e] = cv[e] + (pv[e] - cv[e]) * muv[e];
        kkv[e] = kx[e] * kkc[e]; ss += kkv[e] * kkv[e];
      }
      ss = red8_sum(ss);
      const float rn = rsqrtf(fmaxf(ss, 1e-24f));
#pragma unroll
      for (int e = 0; e < 8; ++e) {
        const float a = BB[t_ * 64 + n0 + e];
        const float kn = kkv[e] * rn;
        K[t_ * 64 + n0 + e] = kx[e] * (1.f + (a - 1.f) * kac[e]);
        KK[t_ * 64 + n0 + e] = kn;
        BB[t_ * 64 + n0 + e] = kn * a;
      }
      if (l == 0) {
        *(uint4*)(p.vfirst + tok * 512 + h * 64 + n0) = PACK8(vs);
      } else {
        float vf[8]; UNPACK8(pvf, vf);
#pragma unroll
        for (int e = 0; e < 8; ++e) vs[e] = vs[e] + (vf[e] - vs[e]) * O[t_ * 64 + n0 + e];
      }
#pragma unroll
      for (int e = 0; e < 8; ++e) V[t_ * 64 + n0 + e] = vs[e];
    }
    __syncthreads();
    if (ch + 1 < 64) RW_PREFETCH(ch + 1)
    asm volatile("" ::: "memory");
#pragma unroll 4
    for (int t = 0; t < 32; ++t) {
      const float* base = R + t * 64 + kq * 8;
      const float4 r0 = *(const float4*)(base), r1 = *(const float4*)(base + 4);
      const float4 k0 = *(const float4*)(base + 2048), k1 = *(const float4*)(base + 2048 + 4);
      const float4 q0 = *(const float4*)(base + 4096), q1 = *(const float4*)(base + 4096 + 4);
      const float4 w0 = *(const float4*)(base + 6144), w1 = *(const float4*)(base + 6144 + 4);
      const float4 b0 = *(const float4*)(base + 8192), b1 = *(const float4*)(base + 8192 + 4);
      const float va = V[t * 64 + row0], vb = V[t * 64 + row1];
      const f32x2 rr[4] = {{r0.x, r0.y}, {r0.z, r0.w}, {r1.x, r1.y}, {r1.z, r1.w}};
      const f32x2 ww[4] = {{w0.x, w0.y}, {w0.z, w0.w}, {w1.x, w1.y}, {w1.z, w1.w}};
      const f32x2 kk_[4] = {{k0.x, k0.y}, {k0.z, k0.w}, {k1.x, k1.y}, {k1.z, k1.w}};
      const f32x2 qq[4] = {{q0.x, q0.y}, {q0.z, q0.w}, {q1.x, q1.y}, {q1.z, q1.w}};
      const f32x2 bb[4] = {{b0.x, b0.y}, {b0.z, b0.w}, {b1.x, b1.y}, {b1.z, b1.w}};
      f32x2 a0 = S0p[0] * qq[0], a1 = S1p[0] * qq[0];
#pragma unroll
      for (int e = 1; e < 4; ++e) { a0 += S0p[e] * qq[e]; a1 += S1p[e] * qq[e]; }
      const float sa0 = -red8_sum(a0.x + a0.y), sa1 = -red8_sum(a1.x + a1.y);
      f32x2 sa0v, sa1v, vav, vbv;
      sa0v.x = sa0; sa0v.y = sa0; sa1v.x = sa1; sa1v.y = sa1; vav.x = va; vav.y = va; vbv.x = vb; vbv.y = vb;
      f32x2 o0v = {0.f, 0.f}, o1v = {0.f, 0.f};
#pragma unroll
      for (int e = 0; e < 4; ++e) {
        S0p[e] = S0p[e] * ww[e] + sa0v * bb[e] + vav * kk_[e];
        S1p[e] = S1p[e] * ww[e] + sa1v * bb[e] + vbv * kk_[e];
        o0v += S0p[e] * rr[e]; o1v += S1p[e] * rr[e];
      }
      const float o0 = red8_sum(o0v.x + o0v.y), o1 = red8_sum(o1v.x + o1v.y);
      if (kq == 0) { O[t * 64 + row0] = o0; O[t * 64 + row1] = o1; }
    }
    asm volatile("s_waitcnt vmcnt(0)" ::: "memory");
    __syncthreads();
    {
      const size_t tok = tok0 + t_;
      float ov[8], s1 = 0.f, bon = 0.f;
#pragma unroll
      for (int e = 0; e < 8; ++e) {
        ov[e] = O[t_ * 64 + n0 + e]; s1 += ov[e];
        bon += R[t_ * 64 + n0 + e] * K[t_ * 64 + n0 + e] * rkc[e];
      }
      s1 = red8_sum(s1); bon = red8_sum(bon);
      const float mean = s1 * (1.f / 64.f);
      float s2 = 0.f;
#pragma unroll
      for (int e = 0; e < 8; ++e) { const float d = ov[e] - mean; s2 += d * d; }
      s2 = red8_sum(s2);
      const float rstd = rsqrtf(s2 * (1.f / 64.f) + 64e-5f);
      float y[8];
#pragma unroll
      for (int e = 0; e < 8; ++e)
        y[e] = ((ov[e] - mean) * rstd * gnw[e] + gnb[e] + bon * V[t_ * 64 + n0 + e]) * G[t_ * 64 + n0 + e];
      *(uint4*)(p.u + tok * US + 3072 + h * 64 + n0) = PACK8(y);
    }
  }
#undef RW_PREFETCH
  __syncthreads();
}

PHASE void phase_mix(const Params& p, int l, char* smem) {
  const int hf = vhalf();
  int* sitem = (int*)(smem - hf * SMEM_BYTES + SMEM_BYTES - 16);
  const int t512 = opaque_tid512();
  while (true) {
    __syncthreads();
    if (t512 == 0) *sitem = (int)atomicAdd(p.counters + l * 4 + 0, 1u);
    __syncthreads();
    const int tk = *sitem;
    if (tk >= 128) break;
    rwkv_item(p, l, tk * 2 + hf, smem);
  }
  while (true) {
    __syncthreads();
    if (t512 == 0) *sitem = (int)atomicAdd(p.counters + l * 4 + 1, 1u);
    __syncthreads();
    const int tk = *sitem;
    if (tk >= 64) break;
    hgrn_item(p, l, tk * 2 + hf, smem);
  }
  while (true) {
    __syncthreads();
    if (t512 == 0) *sitem = (int)atomicAdd(p.counters + l * 4 + 2, 1u);
    __syncthreads();
    const int tk = *sitem;
    if (tk >= 2048) break;
    att_item(p, l, tk * 2 + hf, smem);
  }
}

DEV void gemm_gates(const int tid_in, const bf16_t* A, const bf16_t* Wg, int tn, char* smem, unsigned (&Gp)[4][6][2]) {
  int tid = tid_in; asm volatile("" : "+v"(tid));
  bf16_t* As = (bf16_t*)smem;
  bf16_t* Bs = As + 3 * 4096;
  const int lane = tid & 63, wave = tid >> 6, wr = wave >> 1, wc = wave & 1;
  const int fr = lane & 15, fq = lane >> 4;
  f32x4 acc[4][6];
#pragma unroll
  for (int m = 0; m < 4; ++m)
#pragma unroll
    for (int n = 0; n < 6; ++n) acc[m][n] = (f32x4){0.f, 0.f, 0.f, 0.f};
  const int nk = DM >> 5;
  const int drow = tid >> 2, dphys = tid & 3, dg = (0 - (tid >> 4)) & 3;
  const int cofs = (dphys ^ dg) * 8;
  const unsigned aofs = (unsigned)(drow * DM + cofs);
  unsigned bofs0, bofs1, bofs2;
  {
    int r = drow; int wcb = r / 96, br = (r % 96) >> 5, c = (r % 96) & 31;
    bofs0 = (unsigned)((5376 + br * 1024 + tn * 64 + wcb * 32 + c) * DM + cofs);
    r = drow + 64; wcb = r / 96; br = (r % 96) >> 5; c = (r % 96) & 31;
    bofs1 = (unsigned)((5376 + br * 1024 + tn * 64 + wcb * 32 + c) * DM + cofs);
    r = drow + 128; wcb = r / 96; br = (r % 96) >> 5; c = (r % 96) & 31;
    bofs2 = (unsigned)((5376 + br * 1024 + tn * 64 + wcb * 32 + c) * DM + cofs);
  }
  const int rofs = (fq ^ ((0 - (fr >> 2)) & 3)) * 8;
#define GG_DMA(st, kk)                                                                                       \
  {                                                                                                          \
    __builtin_amdgcn_global_load_lds((const unsigned*)(A + aofs + (kk) * 32), (unsigned*)(As + (st) * 4096 + tid * 8), 16, 0, 0);                     \
    __builtin_amdgcn_global_load_lds((const unsigned*)(A + aofs + 64 * DM + (kk) * 32), (unsigned*)(As + (st) * 4096 + tid * 8 + 2048), 16, 0, 0); \
    __builtin_amdgcn_global_load_lds((const unsigned*)(Wg + bofs0 + (kk) * 32), (unsigned*)(Bs + (st) * 6144 + tid * 8), 16, 0, 0);                    \
    __builtin_amdgcn_global_load_lds((const unsigned*)(Wg + bofs1 + (kk) * 32), (unsigned*)(Bs + (st) * 6144 + tid * 8 + 2048), 16, 0, 0);             \
    __builtin_amdgcn_global_load_lds((const unsigned*)(Wg + bofs2 + (kk) * 32), (unsigned*)(Bs + (st) * 6144 + tid * 8 + 4096), 16, 0, 0);             \
  }
  GG_DMA(0, 0)
  GG_DMA(1, 1)
  int st = 0;
  for (int kt = 0; kt < nk; ++kt) {
    if (kt + 1 < nk) asm volatile("s_waitcnt vmcnt(5)" ::: "memory");
    else asm volatile("s_waitcnt vmcnt(0)" ::: "memory");
    __builtin_amdgcn_s_barrier();
    asm volatile("" ::: "memory");
    const int s2 = (st >= 1) ? st - 1 : 2;
    const bf16_t* Ab = As + st * 4096 + (wr * 64 + fr) * 32 + rofs;
    const bf16_t* Bb = Bs + st * 6144 + (wc * 96 + fr) * 32 + rofs;
    bf16x8 bfr[6], af[4];
#pragma unroll
    for (int n = 0; n < 6; ++n) bfr[n] = *(const bf16x8*)(Bb + n * 512);
#pragma unroll
    for (int m = 0; m < 4; ++m) af[m] = *(const bf16x8*)(Ab + m * 512);
    if (kt + 2 < nk) GG_DMA(s2, kt + 2)
#pragma unroll
    for (int m = 0; m < 4; ++m)
#pragma unroll
      for (int n = 0; n < 6; ++n) acc[m][n] = MFMA(af[m], bfr[n], acc[m][n]);
    st = (st == 2) ? 0 : st + 1;
  }
#undef GG_DMA
  __syncthreads();
#pragma unroll
  for (int m = 0; m < 4; ++m)
#pragma unroll
    for (int n = 0; n < 6; ++n) {
      Gp[m][n][0] = pack2(sigm(acc[m][n][0]), sigm(acc[m][n][1]));
      Gp[m][n][1] = pack2(sigm(acc[m][n][2]), sigm(acc[m][n][3]));
    }
}

PHASE void phase_merge(const Params& p, int l, char* smem) {
  const bf16_t* Wl = p.wt + (size_t)l * WLAYER;
  float* Cs = (float*)smem;
  const int tid = opaque_tid();
  for (int it = 0;; ++it) {
    int tm, tn;
    if (!tile_for(it, 512, 16, tm, tn)) break;
    const size_t row0 = (size_t)tm * 128;
    unsigned Gp[4][6][2];
    gemm_gates(tid, p.h + row0 * DM, Wl + WIN, tn, smem, Gp);
    f32x4 acc[4][2], M[4][2];
#pragma unroll
    for (int m = 0; m < 4; ++m)
#pragma unroll
      for (int n = 0; n < 2; ++n) M[m][n] = (f32x4){0.f, 0.f, 0.f, 0.f};
#pragma unroll
    for (int br = 0; br < 3; ++br) {
      const int aoff = (br == 0) ? 0 : (br == 1 ? 2560 : 3072);
      const size_t woff = (br == 0) ? WBA : (br == 1 ? WBB : WBC);
      gemm_tile<2>(tid, p.u + row0 * US + aoff, US, Wl + woff + (size_t)(tn * 64) * 512, 512, 512, smem, acc);
#pragma unroll
      for (int m = 0; m < 4; ++m)
#pragma unroll
        for (int n = 0; n < 2; ++n) {
          M[m][n][0] += lo16(Gp[m][2 * br + n][0]) * acc[m][n][0];
          M[m][n][1] += hi16(Gp[m][2 * br + n][0]) * acc[m][n][1];
          M[m][n][2] += lo16(Gp[m][2 * br + n][1]) * acc[m][n][2];
          M[m][n][3] += hi16(Gp[m][2 * br + n][1]) * acc[m][n][3];
        }
    }
    stage_acc<2>(tid, Cs, M);
    __syncthreads();
    {
      const int ch = tid & 7;
#pragma unroll 1
      for (int i = 0; i < 4; ++i) {
        const int r = (tid >> 3) + i * 32;
        const float4 a = *(const float4*)(Cs + r * 68 + ch * 8), b = *(const float4*)(Cs + r * 68 + ch * 8 + 4);
        *(uint4*)(p.u + (row0 + r) * US + 1024 + tn * 64 + ch * 8) = make_uint4(pack2(a.x, a.y), pack2(a.z, a.w), pack2(b.x, b.y), pack2(b.z, b.w));
      }
    }
    __syncthreads();
  }
}

PHASE void phase_gemm_res(const bf16_t* A, int lda, const bf16_t* Wt, int K, const float* xin, float* xout,
                        const float* ada_l, int gate_off, char* smem0) {
  const int T = opaque_tid512(), tid = T & 255, hf = vhalf();
  float* Cs = (float*)(smem0 + hf * SMEM_BYTES);
  for (int it = 0;; ++it) {
    int tm, tn;
    if (!tile_for_real(it, 256, 4, tm, tn)) break;
    const size_t row0 = (size_t)tm * 256;
    f32x4 acc[8][4];
    gemm_tile512(T, A + row0 * lda, lda, Wt + (size_t)(tn * 256) * K, K, K, smem0, acc);
    const float* gate = ada_l + (size_t)(row0 / SEQ) * ADAW + gate_off;
    const int c4 = (tid & 31) * 4;
#pragma unroll
    for (int ps = 0; ps < 2; ++ps) {
      if (ps == 0) stage_half512<0>(T, Cs, acc); else stage_half512<1>(T, Cs, acc);
      __syncthreads();
#pragma unroll 1
      for (int i0 = 0; i0 < 16; i0 += 4) {
        float4 xv[4], gv[4], cv[4]; size_t off[4];
#pragma unroll
        for (int ii = 0; ii < 4; ++ii) {
          const int r = (tid >> 5) + (i0 + ii) * 8;
          const int colb = TNC(r) * 128 + c4;
          off[ii] = GROW(r, ps) * DM + colb;
          xv[ii] = *(const float4*)(xin + off[ii]);
          gv[ii] = *(const float4*)(gate + colb);
          cv[ii] = *(const float4*)(Cs + r * 132 + c4);
        }
        asm volatile("" ::: "memory");
#pragma unroll
        for (int ii = 0; ii < 4; ++ii)
          *(float4*)(xout + off[ii]) = make_float4(xv[ii].x + gv[ii].x * cv[ii].x, xv[ii].y + gv[ii].y * cv[ii].y,
                                                   xv[ii].z + gv[ii].z * cv[ii].z, xv[ii].w + gv[ii].w * cv[ii].w);
      }
      __syncthreads();
    }
  }
}

PHASE void phase_ffn_in(const Params& p, int l, char* smem0) {
  const bf16_t* Wt = p.wt + (size_t)l * WLAYER + WFI;
  const int T = opaque_tid512(), tid = T & 255, hf = vhalf();
  float* Cs = (float*)(smem0 + hf * SMEM_BYTES);
  for (int it = 0;; ++it) {
    int tm, tn;
    if (!tile_for_real(it, 256, 22, tm, tn)) break;
    const size_t row0 = (size_t)tm * 256;
    f32x4 acc[8][4];
    gemm_tile512(T, p.h + row0 * DM, DM, Wt + (size_t)(tn * 256) * DM, DM, DM, smem0, acc);
    const int ch = tid & 7;
#pragma unroll
    for (int ps = 0; ps < 2; ++ps) {
      if (ps == 0) stage_half512<0>(T, Cs, acc); else stage_half512<1>(T, Cs, acc);
      __syncthreads();
#pragma unroll 1
      for (int i = 0; i < 4; ++i) {
        const int r = (tid >> 3) + i * 32;
        const float* cp = Cs + r * 132 + ch * 8;
        float o[8];
#pragma unroll
        for (int e = 0; e < 8; ++e) { const float g = cp[e], uu = cp[64 + e]; o[e] = g * sigm(g) * uu; }
        *(uint4*)(p.u + GROW(r, ps) * FFH + TNC(r) * 64 + ch * 8) = PACK8(o);
      }
      __syncthreads();
    }
  }
}

#define XB_TMO      128
#define XB_XCNT(j)  (256  + 64 * (j))
#define XB_XSUB(j)  (1280 + 64 * (j))
#define XB_XGEN(j)  (2304 + 64 * (j))
#define XB_TOP      3328
#define XB_TOPGEN   3392
#define XCD_BAR_WORDS 3456
#define XB_SPIN_CAP (1u << 18)
#define LAS __attribute__((address_space(3)))
DEV unsigned xb_ld(unsigned* p) { return __hip_atomic_load(p, __ATOMIC_RELAXED, __HIP_MEMORY_SCOPE_AGENT); }
DEV unsigned xb_add(unsigned* p, unsigned v) { return __hip_atomic_fetch_add(p, v, __ATOMIC_RELAXED, __HIP_MEMORY_SCOPE_AGENT); }
DEV unsigned xb_xcc_id() { return (unsigned)__builtin_amdgcn_s_getreg((3 << 11) | 20) & 0xFu; }
#define XB_SPIN(cond, bar) do { unsigned _sp = 0; while (cond) { __builtin_amdgcn_s_sleep(1); \
    if ((++_sp & 255u) == 0u) { if (xb_ld(&(bar)[XB_TMO])) break; if (_sp > XB_SPIN_CAP) { atomicAdd(&(bar)[XB_TMO], 1u); break; } } } } while (0)
struct XcdBarrier { unsigned* bar; unsigned x; volatile LAS unsigned* st; };
DEV XcdBarrier xcd_barrier_post(unsigned* bar, volatile LAS unsigned* st) {
  XcdBarrier b; b.bar = bar; b.x = xb_xcc_id(); b.st = st;
  if (threadIdx.x == 0) (void)xb_add(&bar[XB_XCNT(b.x)], 1u);
  return b;
}
DEV void xcd_barrier_complete(unsigned* bar, unsigned x, unsigned& nloc, unsigned& nx) {
  const unsigned G = gridDim.x * gridDim.y * gridDim.z;
  unsigned sum, cnt, mine, sp = 0u;
  for (;;) {
    sum = 0u; cnt = 0u; mine = 0u;
#pragma unroll
    for (unsigned j = 0; j < 16; ++j) { const unsigned c = xb_ld(&bar[XB_XCNT(j)]); sum += c; cnt += (c > 0u) ? 1u : 0u; mine = (j == x) ? c : mine; }
    if (sum == G) break;
    __builtin_amdgcn_s_sleep(1);
    if ((++sp & 255u) == 0u) { if (xb_ld(&bar[XB_TMO])) break; if (sp > XB_SPIN_CAP) { atomicAdd(&bar[XB_TMO], 1u); break; } }
  }
  nloc = mine > 0u ? mine : 1u; nx = cnt > 0u ? cnt : 1u;
}
DEV void xcd_barrier(const XcdBarrier& b) {
  asm volatile("s_waitcnt vmcnt(0)" ::: "memory");
  __syncthreads();
  if (threadIdx.x == 0) {
    unsigned* bar = b.bar;
    __builtin_amdgcn_s_waitcnt(0);
    unsigned nloc = b.st[0], nx = b.st[1];
    if (nloc == 0u) { xcd_barrier_complete(bar, b.x, nloc, nx); b.st[0] = nloc; b.st[1] = nx; }
    const unsigned old = xb_add(&bar[XB_XSUB(b.x)], 1u);
    const unsigned gen = old / nloc;
    if (old + 1u == (gen + 1u) * nloc) {
      __builtin_amdgcn_fence(__ATOMIC_RELEASE, "agent");
      asm volatile("s_waitcnt vmcnt(0)" ::: "memory");
      const unsigned og = xb_add(&bar[XB_TOP], 1u);
      const unsigned tg = og / nx;
      if (og + 1u == (tg + 1u) * nx) xb_add(&bar[XB_TOPGEN], 1u);
      else XB_SPIN(xb_ld(&bar[XB_TOPGEN]) == tg, bar);
      __builtin_amdgcn_fence(__ATOMIC_ACQUIRE, "agent");
      xb_add(&bar[XB_XGEN(b.x)], 1u);
      asm volatile("s_waitcnt vmcnt(0)" ::: "memory");
    } else {
      XB_SPIN(xb_ld(&bar[XB_XGEN(b.x)]) == gen, bar);
      __builtin_amdgcn_fence(__ATOMIC_ACQUIRE, "agent");
      asm volatile("s_waitcnt vmcnt(0)" ::: "memory");
    }
  }
  __syncthreads();
}

__global__ void __launch_bounds__(512, 2) mega(Params p_in, int ph_lo, int ph_hi) {
  extern __shared__ __attribute__((aligned(16))) char smem0[];
  char* smem = smem0 + vhalf() * SMEM_BYTES;
  cg::grid_group grid = cg::this_grid();
  const Params& p = p_in;
  bool first = true;
#define RUN(ph) if ((ph) >= ph_lo && (ph) < ph_hi)
  unsigned epoch = 0;
  __shared__ unsigned xb_words[4];
  if (threadIdx.x < 4) xb_words[threadIdx.x] = 0u;
  __syncthreads();
  XcdBarrier xb;
  xb.bar = p.counters + 256; xb.x = 0u; xb.st = (volatile LAS unsigned*)xb_words;
#define SYNC { if (!first) { ++epoch; if (epoch == 1) { grid.sync(); xb = xcd_barrier_post(p.counters + 256, (volatile LAS unsigned*)xb_words); } else xcd_barrier(xb); } first = false; }
  RUN(0) { SYNC; phase_prep(p, smem); }
#pragma unroll 1
  for (int l = 0; l < 2; ++l) {
    const int base = 1 + 9 * l;
    const float* ada_l = p.ada + (size_t)l * 32 * ADAW;
    const bf16_t* Wl = p.wt + (size_t)l * WLAYER;
    const float* xin = (l == 0) ? p.x : p.out;
    RUN(base + 0) { SYNC; phase_norm(xin, p.norm_mix_w + l * DM, ada_l, 0, 1024, p.h); }
    RUN(base + 1) { SYNC; phase_gemm_in(p, l, smem0); }
    RUN(base + 2) { if (l > 0) { SYNC; phase_vlo(p, l, smem); } }
    RUN(base + 3) { SYNC; phase_mix(p, l, smem); }
    RUN(base + 4) { SYNC; phase_merge(p, l, smem); }
    RUN(base + 5) { SYNC; phase_gemm_res(p.u + 1024, US, Wl + WOUT, DM, xin, p.out, ada_l, 2048, smem0); }
    RUN(base + 6) { SYNC; phase_norm(p.out, p.norm_ffn_w + l * DM, ada_l, 3072, 4096, p.h); }
    RUN(base + 7) { SYNC; phase_ffn_in(p, l, smem0); }
    RUN(base + 8) { SYNC; phase_gemm_res(p.u, FFH, Wl + WFO, FFH, p.out, p.out, ada_l, 5120, smem0); }
  }
  RUN(NPHASE - 1) { SYNC; phase_final(p.out, p.final_norm_w); }
}

extern "C" void kernel_launch(void* const* d_in, const int* in_sizes, int n_in, void* d_out, int out_size, void* d_ws,
                              size_t ws_size, hipStream_t stream) {
  Params p{};
  p.x = (const float*)d_in[0]; p.c = (const float*)d_in[1]; p.pos = (const int*)d_in[2];
  p.ada_w = (const float*)d_in[3]; p.ada_b = (const float*)d_in[4]; p.norm_mix_w = (const float*)d_in[5];
  p.norm_ffn_w = (const float*)d_in[6]; p.w_in = (const float*)d_in[7]; p.da_lambda = (const float*)d_in[8];
  p.da_subln_w = (const float*)d_in[9]; p.hg_lb = (const float*)d_in[10]; p.hg_norm_w = (const float*)d_in[11];
  p.rw_mu = (const float*)d_in[12]; p.rw_w0 = (const float*)d_in[13]; p.rw_w2 = (const float*)d_in[14];
  p.rw_a0 = (const float*)d_in[15]; p.rw_a2 = (const float*)d_in[16]; p.rw_g2 = (const float*)d_in[17];
  p.rw_k_k = (const float*)d_in[18]; p.rw_k_a = (const float*)d_in[19]; p.rw_r_k = (const float*)d_in[20];
  p.rw_gn_w = (const float*)d_in[21]; p.rw_gn_b = (const float*)d_in[22]; p.rw_v0 = (const float*)d_in[23];
  p.rw_v1 = (const float*)d_in[24]; p.rw_v2 = (const float*)d_in[25]; p.w_br_a = (const float*)d_in[26];
  p.w_br_b = (const float*)d_in[27]; p.w_br_c = (const float*)d_in[28]; p.w_out = (const float*)d_in[29];
  p.ffn_w_in = (const float*)d_in[30]; p.ffn_w_out = (const float*)d_in[31]; p.final_norm_w = (const float*)d_in[32];
  p.out = (float*)d_out;
  char* ws = (char*)d_ws;
  size_t off = 0;
  auto take = [&](size_t bytes) { char* r = ws + off; off += (bytes + 255) & ~(size_t)255; return r; };
  p.counters = (unsigned*)take(16384);
  p.wt = (bf16_t*)take(2 * WLAYER * 2);
  p.ada = (float*)take((size_t)2 * 32 * ADAW * 4);
  p.h = (bf16_t*)take((size_t)T_TOK * DM * 2);
  p.u = (bf16_t*)take((size_t)T_TOK * US * 2);
  p.vT = (bf16_t*)take((size_t)T_TOK * 512 * 2);
  p.vfirst = (bf16_t*)take((size_t)T_TOK * 512 * 2);
  p.vlo = (float*)take((size_t)T_TOK * 32 * 4);
  if (off > ws_size) { fprintf(stderr, "workspace too small: need %zu have %zu\n", off, ws_size); return; }

  static int grid_blocks = 0;
  if (!grid_blocks) {
    hipFuncSetAttribute((const void*)mega, hipFuncAttributeMaxDynamicSharedMemorySize, 2 * SMEM_BYTES);
    int dev = 0, cus = 0, per_cu = 0;
    hipGetDevice(&dev);
    hipDeviceGetAttribute(&cus, hipDeviceAttributeMultiprocessorCount, dev);
    hipOccupancyMaxActiveBlocksPerMultiprocessor(&per_cu, mega, 512, 2 * SMEM_BYTES);
    if (per_cu > 1) per_cu = 1;
    if (per_cu < 1) per_cu = 1;
    grid_blocks = cus * per_cu;
  }
#if SINGLE_LAUNCH
  int lo = 0, hi = NPHASE;
  void* args[] = {&p, &lo, &hi};
  hipError_t e = hipLaunchCooperativeKernel((void*)mega, dim3(grid_blocks), dim3(512), args, 2 * SMEM_BYTES, stream);
  if (e != hipSuccess) fprintf(stderr, "cooperative launch failed: %s (grid %d)\n", hipGetErrorString(e), grid_blocks);
#else
  for (int ph = 0; ph < NPHASE; ++ph) {
    if (ph == 3) continue;
    hipLaunchKernelGGL(mega, dim3(grid_blocks), dim3(512), 2 * SMEM_BYTES, stream, p, ph, ph + 1);
  }
#endif
}
```

```cpp
#include <hip/hip_runtime.h>
#include <hip/hip_cooperative_groups.h>
#include <stdint.h>
#include <cstdio>
namespace cg = cooperative_groups;

typedef unsigned short bf16_t;
typedef short bf16x8 __attribute__((ext_vector_type(8)));
typedef float f32x4 __attribute__((ext_vector_type(4)));
typedef float f32x2 __attribute__((ext_vector_type(2)));
#define DEV __device__ __forceinline__
#define PHASE __device__ __forceinline__

#ifndef SINGLE_LAUNCH
#define SINGLE_LAUNCH 1
#endif

constexpr int T_TOK = 65536, DM = 1024, SEQ = 2048, US = 4864, ADAW = 6144, FFH = 2816;
constexpr size_t WIN = 0, WBA = 8650752, WBB = 9175040, WBC = 9699328, WOUT = 10223616, WFI = 11272192,
                 WFO = 17039360, WLAYER = 19922944;
constexpr int SMEM_BYTES = 80896;
constexpr int NPHASE = 20;

struct Params {
  const float* x; const float* c; const int* pos;
  const float *ada_w, *ada_b, *norm_mix_w, *norm_ffn_w, *w_in, *da_lambda, *da_subln_w, *hg_lb, *hg_norm_w;
  const float *rw_mu, *rw_w0, *rw_w2, *rw_a0, *rw_a2, *rw_g2, *rw_k_k, *rw_k_a, *rw_r_k, *rw_gn_w, *rw_gn_b;
  const float *rw_v0, *rw_v1, *rw_v2, *w_br_a, *w_br_b, *w_br_c, *w_out, *ffn_w_in, *ffn_w_out, *final_norm_w;
  float* out;
  bf16_t* wt; float* ada; bf16_t* h; bf16_t* u; bf16_t* vT; bf16_t* vfirst; float* vlo; unsigned* counters;
};

DEV unsigned short f2bf(float f) { unsigned u = __float_as_uint(f); u += 0x7FFFu + ((u >> 16) & 1u); return (unsigned short)(u >> 16); }
DEV float bf2f(unsigned short h) { return __uint_as_float(((unsigned)h) << 16); }
DEV unsigned pack2(float a, float b) { return (unsigned)f2bf(a) | ((unsigned)f2bf(b) << 16); }
DEV float sigm(float x) { return 1.f / (1.f + __expf(-x)); }
DEV float lo16(unsigned v) { return __uint_as_float(v << 16); }
DEV float hi16(unsigned v) { return __uint_as_float(v & 0xFFFF0000u); }
#define UNPACK8(v, f) { f[0]=lo16(v.x); f[1]=hi16(v.x); f[2]=lo16(v.y); f[3]=hi16(v.y); f[4]=lo16(v.z); f[5]=hi16(v.z); f[6]=lo16(v.w); f[7]=hi16(v.w); }
#define PACK8(f) make_uint4(pack2(f[0],f[1]), pack2(f[2],f[3]), pack2(f[4],f[5]), pack2(f[6],f[7]))
template <int CTRL> DEV float dpp(float x) { return __int_as_float(__builtin_amdgcn_update_dpp(0, __float_as_int(x), CTRL, 0xF, 0xF, true)); }
DEV float red8_sum(float x) { x += dpp<0xB1>(x); x += dpp<0x4E>(x); x += dpp<0x141>(x); return x; }
DEV float red16_sum(float x) { x = red8_sum(x); x += dpp<0x140>(x); return x; }
DEV float red16_max(float x) { x = fmaxf(x, dpp<0xB1>(x)); x = fmaxf(x, dpp<0x4E>(x)); x = fmaxf(x, dpp<0x141>(x)); x = fmaxf(x, dpp<0x140>(x)); return x; }
DEV float wave_sum(float x) {
  x = red16_sum(x);
  const int xi = __float_as_int(x);
  return __int_as_float(__builtin_amdgcn_readlane(xi, 0)) + __int_as_float(__builtin_amdgcn_readlane(xi, 16)) +
         __int_as_float(__builtin_amdgcn_readlane(xi, 32)) + __int_as_float(__builtin_amdgcn_readlane(xi, 48));
}
DEV int opaque_tid() { int t = threadIdx.x & 255; asm volatile("" : "+v"(t)); return t; }
DEV int opaque_tid512() { int t = threadIdx.x; asm volatile("" : "+v"(t)); return t; }
DEV int vhalf() { return __builtin_amdgcn_readfirstlane((int)(threadIdx.x >> 8)); }
DEV int vblock() { return (int)blockIdx.x * 2 + vhalf(); }
DEV int vgrid() { return (int)gridDim.x * 2; }
DEV bf16x8 as_frag(uint4 v) { union { uint4 u; bf16x8 b; } c; c.u = v; return c.b; }
#define MFMA(a, b, c) __builtin_amdgcn_mfma_f32_16x16x32_bf16(a, b, c, 0, 0, 0)

template <int NT>
DEV void gemm_tile(const int tid_in, const bf16_t* A, int lda, const bf16_t* B, int ldb, int K, char* smem,
                   f32x4 (&acc)[4][NT]) {
  int tid = tid_in; asm volatile("" : "+v"(tid));
  constexpr int BN = NT * 32;
  constexpr int LS = 64;
  bf16_t* As = (bf16_t*)smem;
  bf16_t* Bs = As + 2 * 128 * LS;
  const int lane = tid & 63, wave = tid >> 6, wr = wave >> 1, wc = wave & 1;
  const int fr = lane & 15, fq = lane >> 4;
  constexpr int NB = BN * 8 / 256;
#pragma unroll
  for (int m = 0; m < 4; ++m)
#pragma unroll
    for (int n = 0; n < NT; ++n) acc[m][n] = (f32x4){0.f, 0.f, 0.f, 0.f};
  const int nk = K >> 6;
  const int lrow = tid >> 3, lcc = tid & 7;
  const bf16_t* Ap = A + (size_t)lrow * lda + ((lcc ^ (lrow & 7)) * 8);
  const bf16_t* Bp = B + (size_t)lrow * ldb + ((lcc ^ (lrow & 7)) * 8);
  const size_t a32 = (size_t)32 * lda, b32 = (size_t)32 * ldb;
  const int rofs0 = (fq ^ (fr & 7)) * 8, rofs1 = rofs0 ^ 32;
#define GT_DMA(buf, koff)                                                                                    \
  {                                                                                                          \
    bf16_t* Ad = As + (buf) * 128 * LS + tid * 8;                                                            \
    bf16_t* Bd = Bs + (buf) * BN * LS + tid * 8;                                                             \
    _Pragma("unroll") for (int i = 0; i < 4; ++i)                                                            \
      __builtin_amdgcn_global_load_lds((const unsigned*)(Ap + i * a32 + (koff)), (unsigned*)(Ad + i * 32 * LS), 16, 0, 0); \
    _Pragma("unroll") for (int i = 0; i < NB; ++i)                                                           \
      __builtin_amdgcn_global_load_lds((const unsigned*)(Bp + i * b32 + (koff)), (unsigned*)(Bd + i * 32 * LS), 16, 0, 0); \
  }
  GT_DMA(0, 0)
  asm volatile("s_waitcnt vmcnt(0)" ::: "memory");
  __syncthreads();
  for (int kt = 0; kt < nk; ++kt) {
    const int buf = kt & 1;
    if (kt + 1 < nk) GT_DMA(buf ^ 1, (kt + 1) * 64)
    const bf16_t* Ab = As + buf * 128 * LS + (wr * 64 + fr) * LS;
    const bf16_t* Bb = Bs + buf * BN * LS + (wc * (NT * 16) + fr) * LS;
#pragma unroll
    for (int ks = 0; ks < 2; ++ks) {
      const int ro = ks ? rofs1 : rofs0;
      bf16x8 af[4], bfr[NT];
#pragma unroll
      for (int m = 0; m < 4; ++m) af[m] = *(const bf16x8*)(Ab + m * 16 * LS + ro);
#pragma unroll
      for (int n = 0; n < NT; ++n) bfr[n] = *(const bf16x8*)(Bb + n * 16 * LS + ro);
#pragma unroll
      for (int m = 0; m < 4; ++m)
#pragma unroll
        for (int n = 0; n < NT; ++n) acc[m][n] = MFMA(af[m], bfr[n], acc[m][n]);
    }
    asm volatile("s_waitcnt vmcnt(0)" ::: "memory");
    __syncthreads();
  }
#undef GT_DMA
}

template <int NT>
DEV void stage_acc(const int tid, float* Cs, const f32x4 (&acc)[4][NT]) {
  constexpr int LDC = NT * 32 + 4;
  const int lane = tid & 63, wave = tid >> 6, wr = wave >> 1, wc = wave & 1, fr = lane & 15, fq = lane >> 4;
#pragma unroll
  for (int m = 0; m < 4; ++m)
#pragma unroll
    for (int n = 0; n < NT; ++n)
#pragma unroll
      for (int j = 0; j < 4; ++j) Cs[(wr * 64 + m * 16 + fq * 4 + j) * LDC + wc * (NT * 16) + n * 16 + fr] = acc[m][n][j];
}

DEV void gemm_tile256(const int tid, const bf16_t* A, int lda, const bf16_t* B, int ldb, int K, char* smem,
                      f32x4 (&acc)[8][4]) {
  bf16_t* As = (bf16_t*)smem;
  bf16_t* Bs = As + 3 * 8192;
  const int lane = tid & 63, wave = tid >> 6, wr = wave >> 1, wc = wave & 1;
  const int fr = lane & 15, fq = lane >> 4;
#pragma unroll
  for (int m = 0; m < 8; ++m)
#pragma unroll
    for (int n = 0; n < 4; ++n) acc[m][n] = (f32x4){0.f, 0.f, 0.f, 0.f};
  const int nk = K >> 5;
  const int drow = tid >> 2, dphys = tid & 3, dg = (0 - (tid >> 4)) & 3;
  const bf16_t* Ap = A + (size_t)drow * lda + ((dphys ^ dg) * 8);
  const bf16_t* Bp = B + (size_t)drow * ldb + ((dphys ^ dg) * 8);
  const size_t a64 = (size_t)64 * lda, b64 = (size_t)64 * ldb;
  const int rofs = (fq ^ ((0 - (fr >> 2)) & 3)) * 8;
#define G2_DMA(st, kk)                                                                                        \
  {                                                                                                           \
    bf16_t* Ad = As + (st) * 8192 + tid * 8;                                                                  \
    bf16_t* Bd = Bs + (st) * 4096 + tid * 8;                                                                  \
    _Pragma("unroll") for (int i = 0; i < 4; ++i)                                                             \
      __builtin_amdgcn_global_load_lds((const unsigned*)(Ap + i * a64 + (kk) * 32), (unsigned*)(Ad + i * 2048), 16, 0, 0); \
    _Pragma("unroll") for (int i = 0; i < 2; ++i)                                                             \
      __builtin_amdgcn_global_load_lds((const unsigned*)(Bp + i * b64 + (kk) * 32), (unsigned*)(Bd + i * 2048), 16, 0, 0); \
  }
  G2_DMA(0, 0)
  G2_DMA(1, 1)
  int st = 0;
  for (int kt = 0; kt < nk; ++kt) {
    if (kt + 1 < nk) asm volatile("s_waitcnt vmcnt(6)" ::: "memory");
    else asm volatile("s_waitcnt vmcnt(0)" ::: "memory");
    __builtin_amdgcn_s_barrier();
    asm volatile("" ::: "memory");
    const int s2 = (st >= 1) ? st - 1 : 2;
    const bool pf = (kt + 2 < nk);
    bf16_t* Ad = As + s2 * 8192 + tid * 8;
    bf16_t* Bd = Bs + s2 * 4096 + tid * 8;
    const bf16_t* Asrc = Ap + (kt + 2) * 32;
    const bf16_t* Bsrc = Bp + (kt + 2) * 32;
    const bf16_t* Ab = As + st * 8192 + (wr * 128 + fr) * 32 + rofs;
    const bf16_t* Bb = Bs + st * 4096 + (wc * 64 + fr) * 32 + rofs;
    bf16x8 bfr[4], af[4];
#pragma unroll
    for (int n = 0; n < 4; ++n) bfr[n] = *(const bf16x8*)(Bb + n * 512);
#pragma unroll
    for (int m = 0; m < 4; ++m) af[m] = *(const bf16x8*)(Ab + m * 512);
#pragma unroll
    for (int m = 0; m < 8; ++m) {
#pragma unroll
      for (int n = 0; n < 4; ++n) acc[m][n] = MFMA(af[m & 3], bfr[n], acc[m][n]);
      if (m + 4 < 8) af[m & 3] = *(const bf16x8*)(Ab + (m + 4) * 512);
      if (pf) {
        if (m < 4) __builtin_amdgcn_global_load_lds((const unsigned*)(Asrc + m * a64), (unsigned*)(Ad + m * 2048), 16, 0, 0);
        else if (m < 6) __builtin_amdgcn_global_load_lds((const unsigned*)(Bsrc + (m - 4) * b64), (unsigned*)(Bd + (m - 4) * 2048), 16, 0, 0);
      }
      __builtin_amdgcn_sched_barrier(0);
    }
    st = (st == 2) ? 0 : st + 1;
  }
#undef G2_DMA
  __syncthreads();
}

template <int PS>
DEV void stage_half(const int tid, float* Cs, const f32x4 (&acc)[8][4]) {
  const int lane = tid & 63, wave = tid >> 6, wr = wave >> 1, wc = wave & 1, fr = lane & 15, fq = lane >> 4;
#pragma unroll
  for (int m = 0; m < 4; ++m)
#pragma unroll
    for (int n = 0; n < 4; ++n)
#pragma unroll
      for (int j = 0; j < 4; ++j) Cs[(wr * 64 + m * 16 + fq * 4 + j) * 132 + wc * 64 + n * 16 + fr] = acc[PS * 4 + m][n][j];
}
#define RMAP(r, ps) ((((r) >> 6) << 7) + (ps) * 64 + ((r) & 63))

DEV void gemm_tile512(const int T, const bf16_t* A, int lda, const bf16_t* B, int ldb, int K, char* smem0,
                      f32x4 (&acc)[8][4]) {
  bf16_t* As = (bf16_t*)smem0;
  bf16_t* Bs = As + 2 * 16384;
  const int lane = T & 63, wave = T >> 6, wr = wave >> 2, wc = wave & 3;
  const int fr = lane & 15, fq = lane >> 4;
#pragma unroll
  for (int m = 0; m < 8; ++m)
#pragma unroll
    for (int n = 0; n < 4; ++n) acc[m][n] = (f32x4){0.f, 0.f, 0.f, 0.f};
  const int nk = K >> 6;
  const int drow = T >> 3, dlog = ((T & 7) ^ ((T >> 3) & 7)) * 8;
  const bf16_t* Ap = A + (size_t)drow * lda + dlog;
  const bf16_t* Bp = B + (size_t)drow * ldb + dlog;
  const size_t a64 = (size_t)64 * lda, b64 = (size_t)64 * ldb;
  const int rofs0 = (fq ^ (fr & 7)) * 8, rofs1 = rofs0 ^ 32;
#pragma unroll
  for (int i = 0; i < 4; ++i) {
    __builtin_amdgcn_global_load_lds((const unsigned*)(Ap + i * a64), (unsigned*)(As + T * 8 + i * 4096), 16, 0, 0);
    __builtin_amdgcn_global_load_lds((const unsigned*)(Bp + i * b64), (unsigned*)(Bs + T * 8 + i * 4096), 16, 0, 0);
  }
  asm volatile("s_waitcnt vmcnt(0)" ::: "memory");
  __syncthreads();
  for (int kt = 0; kt < nk; ++kt) {
    const int buf = kt & 1;
    const bool pf = (kt + 1 < nk);
    bf16_t* Ad = As + (buf ^ 1) * 16384 + T * 8;
    bf16_t* Bd = Bs + (buf ^ 1) * 16384 + T * 8;
    const bf16_t* Asrc = Ap + (kt + 1) * 64;
    const bf16_t* Bsrc = Bp + (kt + 1) * 64;
    const bf16_t* Ab = As + buf * 16384 + (wr * 128 + fr) * 64;
    const bf16_t* Bb = Bs + buf * 16384 + (wc * 64 + fr) * 64;
#pragma unroll
    for (int ks = 0; ks < 2; ++ks) {
      const int ro = ks ? rofs1 : rofs0;
      bf16x8 bfr[4], af[4];
#pragma unroll
      for (int n = 0; n < 4; ++n) bfr[n] = *(const bf16x8*)(Bb + n * 1024 + ro);
#pragma unroll
      for (int m = 0; m < 4; ++m) af[m] = *(const bf16x8*)(Ab + m * 1024 + ro);
#pragma unroll
      for (int m = 0; m < 8; ++m) {
#pragma unroll
        for (int n = 0; n < 4; ++n) acc[m][n] = MFMA(af[m & 3], bfr[n], acc[m][n]);
        if (m + 4 < 8) af[m & 3] = *(const bf16x8*)(Ab + (m + 4) * 1024 + ro);
        if (pf && ks == 0 && m < 4) {
          __builtin_amdgcn_global_load_lds((const unsigned*)(Asrc + m * a64), (unsigned*)(Ad + m * 4096), 16, 0, 0);
          __builtin_amdgcn_global_load_lds((const unsigned*)(Bsrc + m * b64), (unsigned*)(Bd + m * 4096), 16, 0, 0);
        }
        __builtin_amdgcn_sched_barrier(0);
      }
    }
    asm volatile("s_waitcnt vmcnt(0)" ::: "memory");
    __builtin_amdgcn_s_barrier();
    asm volatile("" ::: "memory");
  }
  __syncthreads();
}
template <int PS>
DEV void stage_half512(const int T, float* Cs, const f32x4 (&acc)[8][4]) {
  const int lane = T & 63, wave = T >> 6, wc = wave & 3, fr = lane & 15, fq = lane >> 4;
#pragma unroll
  for (int m = 0; m < 4; ++m)
#pragma unroll
    for (int n = 0; n < 4; ++n)
#pragma unroll
      for (int j = 0; j < 4; ++j) Cs[((wc >> 1) * 64 + m * 16 + fq * 4 + j) * 132 + (wc & 1) * 64 + n * 16 + fr] = acc[PS * 4 + m][n][j];
}
#define GROW(r, ps) (row0 + (size_t)(hf * 128 + (ps) * 64 + ((r) & 63)))
#define TNC(r) (tn * 2 + ((r) >> 6))

DEV bool tile_for(int it, int nM, int nN, int& tm, int& tn) {
  const int nx = (gridDim.x >> 3) * 2;
  const int xcd = blockIdx.x & 7, local = (blockIdx.x >> 3) * 2 + vhalf();
  const long id = ((long)it * 8 + xcd) * nx + local;
  if (local >= nx || id >= (long)nM * nN) return false;
  const int per_group = 8 * nN;
  const int g = (int)(id / per_group), r = (int)(id % per_group);
  tn = r >> 3; tm = g * 8 + (r & 7);
  return true;
}

DEV bool tile_for_real(int it, int nM, int nN, int& tm, int& tn) {
  const int nx = (gridDim.x >> 3);
  const int xcd = blockIdx.x & 7, local = (blockIdx.x >> 3);
  const long id = ((long)it * 8 + xcd) * nx + local;
  if (local >= nx || id >= (long)nM * nN) return false;
  const int per_group = 8 * nN;
  const int g = (int)(id / per_group), r = (int)(id % per_group);
  tn = r >> 3; tm = g * 8 + (r & 7);
  return true;
}

PHASE void phase_prep(const Params& p, char* smem) {
  const int tid = opaque_tid();
  const int vb = vblock(), vg = vgrid();
  if (vb == 0 && tid < 8) p.counters[tid] = 0u;
  if (vb == 0) for (int i = tid; i < 3456; i += 256) p.counters[256 + i] = 0u;
  float* tile = (float*)smem;
  const int NCONV = 2 * 4864, NADA = 192;
  for (int item0 = vb; item0 < NCONV + NADA; item0 += vg) {
    const int item = (item0 < NADA) ? (NCONV + item0) : (item0 - NADA);
    if (item < NCONV) {
      const int l = item / 4864; int r = item % 4864;
      const float* src; int K, Nsrc, nT, perm = 0; size_t dst;
      if (r < 2112) { src = p.w_in + (size_t)l * 1024 * 8448; K = 1024; Nsrc = 8448; dst = WIN; nT = 132; }
      else if (r < 2240) { r -= 2112; src = p.w_br_a + (size_t)l * 512 * 1024; K = 512; Nsrc = 1024; dst = WBA; nT = 16; }
      else if (r < 2368) { r -= 2240; src = p.w_br_b + (size_t)l * 512 * 1024; K = 512; Nsrc = 1024; dst = WBB; nT = 16; }
      else if (r < 2496) { r -= 2368; src = p.w_br_c + (size_t)l * 512 * 1024; K = 512; Nsrc = 1024; dst = WBC; nT = 16; }
      else if (r < 2752) { r -= 2496; src = p.w_out + (size_t)l * 1024 * 1024; K = 1024; Nsrc = 1024; dst = WOUT; nT = 16; }
      else if (r < 4160) { r -= 2752; src = p.ffn_w_in + (size_t)l * 1024 * 5632; K = 1024; Nsrc = 5632; dst = WFI; nT = 88; perm = 1; }
      else { r -= 4160; src = p.ffn_w_out + (size_t)l * 2816 * 1024; K = 2816; Nsrc = 1024; dst = WFO; nT = 16; }
      const int kt = r / nT, nt = r % nT;
      const int colbase = perm ? ((nt & 1) * FFH + 64 * (nt >> 1)) : nt * 64;
      __syncthreads();
#pragma unroll
      for (int i = 0; i < 16; ++i) {
        const int k = i * 4 + (tid >> 6), j = tid & 63;
        tile[k * 65 + j] = src[(size_t)(kt * 64 + k) * Nsrc + colbase + j];
      }
      __syncthreads();
      const int row = tid >> 2, kc = (tid & 3) * 16;
      float f[16];
#pragma unroll
      for (int i = 0; i < 16; ++i) f[i] = tile[(kc + i) * 65 + row];
      bf16_t* d = p.wt + (size_t)l * WLAYER + dst + (size_t)(nt * 64 + row) * K + kt * 64 + kc;
      *(uint4*)d = make_uint4(pack2(f[0], f[1]), pack2(f[2], f[3]), pack2(f[4], f[5]), pack2(f[6], f[7]));
      *(uint4*)(d + 8) = make_uint4(pack2(f[8], f[9]), pack2(f[10], f[11]), pack2(f[12], f[13]), pack2(f[14], f[15]));
    } else {
      const int a = item - NCONV;
      const int l = a / 96, r = a % 96, ntile = r >> 2, bg = r & 3;
      float* cact = (float*)smem;
      __syncthreads();
      for (int i = tid; i < 8 * 1024; i += 256) {
        const float cv = p.c[(size_t)(bg * 8 + (i >> 10)) * DM + (i & 1023)];
        cact[i] = cv * sigm(cv);
      }
      __syncthreads();
      const int n = ntile * 256 + tid;
      const float* W = p.ada_w + (size_t)l * DM * ADAW + n;
      float acc[8];
#pragma unroll
      for (int b = 0; b < 8; ++b) acc[b] = 0.f;
      for (int k0 = 0; k0 < DM; k0 += 16) {
        float w[16];
#pragma unroll
        for (int kk = 0; kk < 16; ++kk) w[kk] = W[(size_t)(k0 + kk) * ADAW];
#pragma unroll
        for (int kk = 0; kk < 16; ++kk)
#pragma unroll
          for (int b = 0; b < 8; ++b) acc[b] += cact[b * 1024 + k0 + kk] * w[kk];
      }
      const float bias = p.ada_b[l * ADAW + n];
#pragma unroll
      for (int b = 0; b < 8; ++b) p.ada[((size_t)l * 32 + bg * 8 + b) * ADAW + n] = acc[b] + bias;
    }
  }
}

PHASE void phase_norm(const float* __restrict__ x, const float* __restrict__ w, const float* __restrict__ ada_l,
                    int shift_off, int scale_off, bf16_t* __restrict__ h) {
  const int tid = opaque_tid();
  const int lane = tid & 63, wave = tid >> 6;
  for (int row0 = (vblock() * 4 + wave) * 4; row0 < T_TOK; row0 += vgrid() * 16) {
    float4 v[4][4]; float ss[4];
#pragma unroll
    for (int rr = 0; rr < 4; ++rr)
#pragma unroll
      for (int i = 0; i < 4; ++i) v[rr][i] = *(const float4*)(x + (size_t)(row0 + rr) * DM + i * 256 + lane * 4);
#pragma unroll
    for (int rr = 0; rr < 4; ++rr) {
      float a = 0.f;
#pragma unroll
      for (int i = 0; i < 4; ++i) a += v[rr][i].x * v[rr][i].x + v[rr][i].y * v[rr][i].y + v[rr][i].z * v[rr][i].z + v[rr][i].w * v[rr][i].w;
      ss[rr] = rsqrtf(wave_sum(a) * (1.f / DM) + 1e-6f);
    }
    const float* ad = ada_l + (size_t)(row0 / SEQ) * ADAW;
#pragma unroll
    for (int i = 0; i < 4; ++i) {
      const int col = i * 256 + lane * 4;
      const float4 ww = *(const float4*)(w + col), sc = *(const float4*)(ad + scale_off + col), sh = *(const float4*)(ad + shift_off + col);
#pragma unroll
      for (int rr = 0; rr < 4; ++rr) {
        const float rstd = ss[rr];
        const float o0 = v[rr][i].x * rstd * ww.x * (1.f + sc.x) + sh.x, o1 = v[rr][i].y * rstd * ww.y * (1.f + sc.y) + sh.y;
        const float o2 = v[rr][i].z * rstd * ww.z * (1.f + sc.z) + sh.z, o3 = v[rr][i].w * rstd * ww.w * (1.f + sc.w) + sh.w;
        *(uint2*)(h + (size_t)(row0 + rr) * DM + col) = make_uint2(pack2(o0, o1), pack2(o2, o3));
      }
    }
  }
}

PHASE void phase_final(float* __restrict__ x, const float* __restrict__ w) {
  const int tid = opaque_tid();
  const int lane = tid & 63, wave = tid >> 6;
  for (int row0 = (vblock() * 4 + wave) * 4; row0 < T_TOK; row0 += vgrid() * 16) {
    float4 v[4][4]; float ss[4];
#pragma unroll
    for (int rr = 0; rr < 4; ++rr)
#pragma unroll
      for (int i = 0; i < 4; ++i) v[rr][i] = *(const float4*)(x + (size_t)(row0 + rr) * DM + i * 256 + lane * 4);
#pragma unroll
    for (int rr = 0; rr < 4; ++rr) {
      float a = 0.f;
#pragma unroll
      for (int i = 0; i < 4; ++i) a += v[rr][i].x * v[rr][i].x + v[rr][i].y * v[rr][i].y + v[rr][i].z * v[rr][i].z + v[rr][i].w * v[rr][i].w;
      ss[rr] = rsqrtf(wave_sum(a) * (1.f / DM) + 1e-6f);
    }
#pragma unroll
    for (int i = 0; i < 4; ++i) {
      const int col = i * 256 + lane * 4;
      const float4 ww = *(const float4*)(w + col);
#pragma unroll
      for (int rr = 0; rr < 4; ++rr) {
        const float rstd = ss[rr];
        *(float4*)(x + (size_t)(row0 + rr) * DM + col) =
            make_float4(v[rr][i].x * rstd * ww.x, v[rr][i].y * rstd * ww.y, v[rr][i].z * rstd * ww.z, v[rr][i].w * rstd * ww.w);
      }
    }
  }
}

PHASE void phase_gemm_in(const Params& p, int l, char* smem0) {
  const bf16_t* Wt = p.wt + (size_t)l * WLAYER + WIN;
  const int T = opaque_tid512(), tid = T & 255, hf = vhalf();
  float* Cs = (float*)(smem0 + hf * SMEM_BYTES);
  for (int it = 0;; ++it) {
    int tm, tn;
    if (!tile_for_real(it, 256, 21, tm, tn)) break;
    f32x4 acc[8][4];
    gemm_tile512(T, p.h + (size_t)tm * 256 * DM, DM, Wt + (size_t)tn * 256 * DM, DM, DM, smem0, acc);
    const size_t row0 = (size_t)tm * 256;
#pragma unroll
    for (int ps = 0; ps < 2; ++ps) {
      if (ps == 0) stage_half512<0>(T, Cs, acc); else stage_half512<1>(T, Cs, acc);
      __syncthreads();
      if (tn < 4) {
        const float qs = (tn < 2) ? 0.125f : 1.f;
        const int ch = tid & 15, g = ch >> 3, cc = ch & 7;
        if (cc < 4) {
#pragma unroll 1
          for (int i = 0; i < 8; ++i) {
            const int r = (tid >> 4) + i * 16;
            const size_t grow = GROW(r, ps);
            const float pos = (float)p.pos[grow];
            const float* c1 = Cs + r * 132 + g * 64 + cc * 8;
            float o1[8], o2[8];
#pragma unroll
            for (int e = 0; e < 8; ++e) {
              const float x1 = c1[e], x2 = c1[32 + e];
              const float inv = exp2f(-(float)(cc * 8 + e) * 0.41524101186092029f);
              float rev = pos * inv * 0.15915494309189535f;
              rev -= rintf(rev);
              const float sn = __builtin_amdgcn_sinf(rev), cs = __builtin_amdgcn_cosf(rev);
              o1[e] = (x1 * cs - x2 * sn) * qs; o2[e] = (x2 * cs + x1 * sn) * qs;
            }
            bf16_t* d = p.u + grow * US + TNC(r) * 128 + g * 64 + cc * 8;
            *(uint4*)d = PACK8(o1);
            *(uint4*)(d + 32) = PACK8(o2);
          }
        }
      } else if (tn < 6) {
        const int b = (int)(row0 / SEQ), s0 = (int)(row0 % SEQ);
        const int rch = tid & 15;
        const int vc0 = (TNC(rch * 8) - 8) * 128;
#pragma unroll 1
        for (int i = 0; i < 8; ++i) {
          const int c = (tid >> 4) + i * 16;
          float f[8];
#pragma unroll
          for (int j = 0; j < 8; ++j) f[j] = Cs[(rch * 8 + j) * 132 + c];
          *(uint4*)(p.vT + ((size_t)b * 512 + vc0 + c) * SEQ + s0 + hf * 128 + ps * 64 + ((rch * 8) & 63)) = PACK8(f);
        }
      } else {
        const int ch = tid & 15;
#pragma unroll 1
        for (int i = 0; i < 8; ++i) {
          const int r = (tid >> 4) + i * 16;
          const float4 a = *(const float4*)(Cs + r * 132 + ch * 8), b = *(const float4*)(Cs + r * 132 + ch * 8 + 4);
          *(uint4*)(p.u + GROW(r, ps) * US + TNC(r) * 128 - 512 + ch * 8) = make_uint4(pack2(a.x, a.y), pack2(a.z, a.w), pack2(b.x, b.y), pack2(b.z, b.w));
        }
      }
      __syncthreads();
    }
  }
}

PHASE void phase_vlo(const Params& p, int l, char* smem) {
  float* vs = (float*)smem;
  const int tid = opaque_tid();
  const float* mu = p.rw_mu + (size_t)l * 1792 + 1024;
  const float* v1 = p.rw_v1;
  for (int item = vblock(); item < T_TOK / 32; item += vgrid()) {
    const size_t tok0 = (size_t)item * 32;
    __syncthreads();
#pragma unroll 1
    for (int i = 0; i < 8; ++i) {
      const int c = tid + i * 256;
      const int t = c >> 6, cc = c & 63;
      const size_t tok = tok0 + t;
      const uint4 cur = *(const uint4*)(p.u + tok * US + 3072 + 1024 + cc * 8);
      uint4 prv = make_uint4(0, 0, 0, 0);
      if ((tok % SEQ) != 0) prv = *(const uint4*)(p.u + (tok - 1) * US + 3072 + 1024 + cc * 8);
      float a[8], b[8];
      UNPACK8(cur, a); UNPACK8(prv, b);
#pragma unroll
      for (int e = 0; e < 8; ++e) vs[t * 512 + cc * 8 + e] = a[e] + (b[e] - a[e]) * mu[cc * 8 + e];
    }
    __syncthreads();
    const int j = tid & 31, tg = tid >> 5;
    float acc[4] = {0.f, 0.f, 0.f, 0.f};
    for (int k0 = 0; k0 < 512; k0 += 16) {
      float w[16];
#pragma unroll
      for (int kk = 0; kk < 16; ++kk) w[kk] = v1[(k0 + kk) * 32 + j];
#pragma unroll
      for (int kk = 0; kk < 16; ++kk)
#pragma unroll
        for (int i = 0; i < 4; ++i) acc[i] += vs[(tg * 4 + i) * 512 + k0 + kk] * w[kk];
    }
#pragma unroll
    for (int i = 0; i < 4; ++i) p.vlo[(tok0 + tg * 4 + i) * 32 + j] = acc[i];
  }
}

PHASE void att_item(const Params& p, int l, int item, char* smem) {
  const int qc = 31 - (item >> 7);
  const int bh = item & 127, b = bh >> 2, h = bh & 3;
  const int tid = opaque_tid(), lane = tid & 63, wave = tid >> 6, fr = lane & 15, fq = lane >> 4;
  const int m = wave >> 1, rh = wave & 1;
  bf16_t* Ks = (bf16_t*)smem;
  bf16_t* Vt = Ks + 2 * 64 * 64;
  bf16_t* Ps = Vt + 128 * 64;
  float* Ox = (float*)smem;
  const size_t tok0 = (size_t)b * SEQ + (size_t)qc * 64;
  const float* lv = p.da_lambda + (size_t)l * 256;
  float d1 = 0.f, d2 = 0.f;
  for (int i = 0; i < 64; ++i) { d1 += lv[i] * lv[64 + i]; d2 += lv[128 + i] * lv[192 + i]; }
  const float lam_init = 0.8f - 0.6f * __expf(-0.3f * (float)l);
  const float lam = __expf(d1) - __expf(d2) + lam_init;

  bf16x8 qf[2][2];
#pragma unroll
  for (int mt = 0; mt < 2; ++mt)
#pragma unroll
    for (int ks = 0; ks < 2; ++ks)
      qf[mt][ks] = *(const bf16x8*)(p.u + (tok0 + rh * 32 + mt * 16 + fr) * US + h * 128 + m * 64 + ks * 32 + fq * 8);
  f32x4 o[2][8];
  float mx[2][4], ls[2][4];
#pragma unroll
  for (int mt = 0; mt < 2; ++mt) {
#pragma unroll
    for (int n = 0; n < 8; ++n) o[mt][n] = (f32x4){0.f, 0.f, 0.f, 0.f};
#pragma unroll
    for (int j = 0; j < 4; ++j) { mx[mt][j] = -1e30f; ls[mt][j] = 0.f; }
  }
  bf16_t* Pw = Ps + wave * 32 * 72;
  const int drow = tid >> 3, dlog = ((tid & 7) ^ ((tid >> 3) & 7)) * 8;
  const bf16_t* Kg = p.u + ((size_t)b * SEQ + (drow & 63)) * US + 512 + h * 128 + dlog;
  const bf16_t* Vg = p.vT + ((size_t)b * 512 + h * 128 + drow) * SEQ + dlog;
  const int rsw = fr & 7;
#define ATT_DMA_K(kt_)                                                                                              \
  _Pragma("unroll") for (int i = 0; i < 4; ++i)                                                                     \
    __builtin_amdgcn_global_load_lds((const unsigned*)(Kg + ((size_t)(kt_) * 64 + (i & 1) * 32) * US + (i >> 1) * 64), \
                                     (unsigned*)(Ks + tid * 8 + i * 2048), 16, 0, 0);
#define ATT_DMA_V(kt_)                                                                                              \
  _Pragma("unroll") for (int i = 0; i < 4; ++i)                                                                     \
    __builtin_amdgcn_global_load_lds((const unsigned*)(Vg + (size_t)(i * 32) * SEQ + (kt_) * 64),                  \
                                     (unsigned*)(Vt + tid * 8 + i * 2048), 16, 0, 0);
  __syncthreads();
  ATT_DMA_K(0)
  for (int kt = 0; kt <= qc; ++kt) {
    asm volatile("s_waitcnt vmcnt(0)" ::: "memory");
    __syncthreads();
    ATT_DMA_V(kt)
    f32x4 s[2][4];
#pragma unroll
    for (int mt = 0; mt < 2; ++mt)
#pragma unroll
      for (int n = 0; n < 4; ++n) s[mt][n] = (f32x4){0.f, 0.f, 0.f, 0.f};
#pragma unroll
    for (int ks = 0; ks < 2; ++ks)
#pragma unroll
      for (int n = 0; n < 4; ++n) {
        const bf16x8 kf = *(const bf16x8*)(Ks + (m * 64 + n * 16 + fr) * 64 + (((ks * 4 + fq) ^ rsw) * 8));
#pragma unroll
        for (int mt = 0; mt < 2; ++mt) s[mt][n] = MFMA(qf[mt][ks], kf, s[mt][n]);
      }
#pragma unroll
    for (int mt = 0; mt < 2; ++mt)
#pragma unroll
      for (int j = 0; j < 4; ++j) {
        float tmax = fmaxf(fmaxf(s[mt][0][j], s[mt][1][j]), fmaxf(s[mt][2][j], s[mt][3][j]));
        tmax = red16_max(tmax);
        const float mnew = fmaxf(mx[mt][j], tmax);
        const float alpha = __expf(mx[mt][j] - mnew);
        float rs = 0.f;
#pragma unroll
        for (int n = 0; n < 4; ++n) {
          const float pv = __expf(s[mt][n][j] - mnew);
          rs += pv;
          Pw[(mt * 16 + fq * 4 + j) * 72 + n * 16 + fr] = f2bf(pv);
        }
        rs = red16_sum(rs);
        ls[mt][j] = ls[mt][j] * alpha + rs;
        mx[mt][j] = mnew;
#pragma unroll
        for (int n = 0; n < 8; ++n) o[mt][n][j] *= alpha;
      }
    asm volatile("s_waitcnt vmcnt(0)" ::: "memory");
    __syncthreads();
    if (kt < qc) { ATT_DMA_K(kt + 1) }
#pragma unroll
    for (int ks = 0; ks < 2; ++ks) {
      bf16x8 pf[2];
#pragma unroll
      for (int mt = 0; mt < 2; ++mt) pf[mt] = *(const bf16x8*)(Pw + (mt * 16 + fr) * 72 + ks * 32 + fq * 8);
#pragma unroll
      for (int n = 0; n < 8; ++n) {
        const bf16x8 vf = *(const bf16x8*)(Vt + (n * 16 + fr) * 64 + (((ks * 4 + fq) ^ rsw) * 8));
#pragma unroll
        for (int mt = 0; mt < 2; ++mt) o[mt][n] = MFMA(pf[mt], vf, o[mt][n]);
      }
    }
  }
#undef ATT_DMA_K
#undef ATT_DMA_V
  __syncthreads();
#pragma unroll
  for (int mt = 0; mt < 2; ++mt)
#pragma unroll
    for (int j = 0; j < 4; ++j) {
      const float inv = 1.f / ls[mt][j];
#pragma unroll
      for (int n = 0; n < 8; ++n) o[mt][n][j] *= inv;
    }
  if (m == 1) {
#pragma unroll
    for (int mt = 0; mt < 2; ++mt)
#pragma unroll
      for (int n = 0; n < 8; ++n)
#pragma unroll
        for (int j = 0; j < 4; ++j) Ox[(rh * 32 + mt * 16 + fq * 4 + j) * 132 + n * 16 + fr] = o[mt][n][j];
  }
  __syncthreads();
  if (m == 0) {
    const float* sw = p.da_subln_w + (size_t)l * 128;
    float wv[8];
#pragma unroll
    for (int n = 0; n < 8; ++n) wv[n] = sw[n * 16 + fr] * (1.f - lam_init);
#pragma unroll
    for (int mt = 0; mt < 2; ++mt)
#pragma unroll
      for (int j = 0; j < 4; ++j) {
        float ss = 0.f;
        float d[8];
#pragma unroll
        for (int n = 0; n < 8; ++n) {
          d[n] = o[mt][n][j] - lam * Ox[(rh * 32 + mt * 16 + fq * 4 + j) * 132 + n * 16 + fr];
          ss += d[n] * d[n];
        }
        ss = red16_sum(ss);
        const float rstd = rsqrtf(ss * (1.f / 128.f) + 1e-6f);
        bf16_t* dst = p.u + (tok0 + rh * 32 + mt * 16 + fq * 4 + j) * US + h * 128 + fr;
#pragma unroll
        for (int n = 0; n < 8; ++n) dst[n * 16] = f2bf(d[n] * rstd * wv[n]);
      }
  }
  __syncthreads();
}

PHASE void hgrn_item(const Params& p, int l, int item, char* smem) {
  const int b = item >> 2, h = item & 3;
  const int tid = opaque_tid(), lane = tid & 63, wave = tid >> 6, fr = lane & 15, fq = lane >> 4;
  bf16_t* Qs = (bf16_t*)smem;
  bf16_t* Kn = Qs + 32 * 136;
  bf16_t* KT = Kn + 32 * 136;
  bf16_t* VT = KT + 128 * 40;
  bf16_t* Ps = VT + 128 * 40;
  bf16_t* ST = Ps + 32 * 40;
  float* lfb = (float*)ST;
  float* red = (float*)(ST + 128 * 136);
  float* blast = red + 64;
  const int t_ = tid >> 3, d0 = (tid & 7) * 16;
  float lbv[16];
#pragma unroll
  for (int i = 0; i < 16; ++i) {
    const int c = h * 128 + d0 + i;
    lbv[i] = (l == 0) ? 0.f : sigm(p.hg_lb[512 + c] - p.hg_lb[c]);
  }
  f32x4 S[2][8];
#pragma unroll
  for (int mm = 0; mm < 2; ++mm)
#pragma unroll
    for (int n = 0; n < 8; ++n) S[mm][n] = (f32x4){0.f, 0.f, 0.f, 0.f};
  const float* nw = p.hg_norm_w + (size_t)l * 128;

  for (int ch = 0; ch < 64; ++ch) {
    const size_t tok0 = (size_t)b * SEQ + (size_t)ch * 32;
    __syncthreads();
    float qv[16], kv[16];
    {
      const bf16_t* base = p.u + (tok0 + t_) * US + h * 128 + d0;
      float zv[16], iv[16];
      { const uint4 a = *(const uint4*)(base + 1024), c = *(const uint4*)(base + 1024 + 8); float* z0 = zv; float* z1 = zv + 8; UNPACK8(a, z0); UNPACK8(c, z1); }
      { const uint4 a = *(const uint4*)(base + 1536), c = *(const uint4*)(base + 1536 + 8); float* z0 = iv; float* z1 = iv + 8; UNPACK8(a, z0); UNPACK8(c, z1); }
      { const uint4 a = *(const uint4*)(base + 2048), c = *(const uint4*)(base + 2048 + 8); float* z0 = qv; float* z1 = qv + 8; UNPACK8(a, z0); UNPACK8(c, z1); }
#pragma unroll
      for (int i = 0; i < 16; ++i) {
        const float z = zv[i], lb = lbv[i];
        const float ez = __expf(-fabsf(z));
        float lf;
        if (lb > 0.f) {
          const float sg = (z >= 0.f) ? 1.f / (1.f + ez) : ez / (1.f + ez);
          lf = __logf(lb + (1.f - lb) * sg);
        } else {
          lf = -(fmaxf(-z, 0.f) + __logf(1.f + ez));
        }
        const float sgn = (z >= 0.f) ? ez / (1.f + ez) : 1.f / (1.f + ez);
        kv[i] = (1.f - lb) * sgn;
        lfb[t_ * 128 + d0 + i] = lf;
        VT[(d0 + i) * 40 + t_] = f2bf(iv[i]);
      }
    }
    __syncthreads();
    if (tid < 128) {
      float v[32];
#pragma unroll
      for (int t = 0; t < 32; ++t) v[t] = lfb[t * 128 + tid];
      float bsum = 0.f;
#pragma unroll
      for (int t = 0; t < 32; ++t) { bsum += v[t]; lfb[t * 128 + tid] = bsum; }
      blast[tid] = bsum;
    }
    __syncthreads();
    {
      float qo[16], ko[16];
#pragma unroll
      for (int i = 0; i < 16; ++i) {
        const float bb = lfb[t_ * 128 + d0 + i];
        qo[i] = qv[i] * __expf(bb);
        ko[i] = kv[i] * __expf(fminf(-bb, 80.f));
        KT[(d0 + i) * 40 + t_] = f2bf(ko[i]);
      }
      float* q0 = qo; float* q1 = qo + 8; float* k0 = ko; float* k1 = ko + 8;
      *(uint4*)(Qs + t_ * 136 + d0) = PACK8(q0);
      *(uint4*)(Qs + t_ * 136 + d0 + 8) = PACK8(q1);
      *(uint4*)(Kn + t_ * 136 + d0) = PACK8(k0);
      *(uint4*)(Kn + t_ * 136 + d0 + 8) = PACK8(k1);
    }
    __syncthreads();
#pragma unroll
    for (int mm = 0; mm < 2; ++mm)
#pragma unroll
      for (int n = 0; n < 8; ++n)
        *(uint2*)(ST + (n * 16 + fr) * 136 + wave * 32 + mm * 16 + fq * 4) =
            make_uint2(pack2(S[mm][n][0], S[mm][n][1]), pack2(S[mm][n][2], S[mm][n][3]));
    {
      const int mt = wave >> 1, nt = wave & 1;
      f32x4 sc = (f32x4){0.f, 0.f, 0.f, 0.f};
#pragma unroll
      for (int ks = 0; ks < 4; ++ks) {
        const bf16x8 a = *(const bf16x8*)(Qs + (mt * 16 + fr) * 136 + ks * 32 + fq * 8);
        const bf16x8 bb = *(const bf16x8*)(Kn + (nt * 16 + fr) * 136 + ks * 32 + fq * 8);
        sc = MFMA(a, bb, sc);
      }
#pragma unroll
      for (int j = 0; j < 4; ++j) {
        const int t = mt * 16 + fq * 4 + j, key = nt * 16 + fr;
        Ps[t * 40 + key] = f2bf(key <= t ? sc[j] : 0.f);
      }
    }
    __syncthreads();
    {
      const int mt = wave & 1, nb = (wave >> 1) * 4;
      f32x4 oo[4];
#pragma unroll
      for (int n = 0; n < 4; ++n) oo[n] = (f32x4){0.f, 0.f, 0.f, 0.f};
      {
        const bf16x8 a = *(const bf16x8*)(Ps + (mt * 16 + fr) * 40 + fq * 8);
#pragma unroll
        for (int n = 0; n < 4; ++n) {
          const bf16x8 bb = *(const bf16x8*)(VT + ((nb + n) * 16 + fr) * 40 + fq * 8);
          oo[n] = MFMA(a, bb, oo[n]);
        }
      }
#pragma unroll
      for (int ks = 0; ks < 4; ++ks) {
        const bf16x8 a = *(const bf16x8*)(Qs + (mt * 16 + fr) * 136 + ks * 32 + fq * 8);
#pragma unroll
        for (int n = 0; n < 4; ++n) {
          const bf16x8 bb = *(const bf16x8*)(ST + ((nb + n) * 16 + fr) * 136 + ks * 32 + fq * 8);
          oo[n] = MFMA(a, bb, oo[n]);
        }
      }
#pragma unroll
      for (int j = 0; j < 4; ++j) {
        float ss = 0.f;
#pragma unroll
        for (int n = 0; n < 4; ++n) ss += oo[n][j] * oo[n][j];
        ss = red16_sum(ss);
        if (fr == 0) red[(mt * 16 + fq * 4 + j) * 2 + (wave >> 1)] = ss;
      }
      __syncthreads();
#pragma unroll
      for (int j = 0; j < 4; ++j) {
        const int t = mt * 16 + fq * 4 + j;
        const float rstd = rsqrtf((red[t * 2] + red[t * 2 + 1]) * (1.f / 128.f) + 1e-6f);
        bf16_t* gp = p.u + (tok0 + t) * US + 2560 + h * 128 + nb * 16 + fr;
#pragma unroll
        for (int n = 0; n < 4; ++n) {
          const float g = bf2f(gp[n * 16]);
          gp[n * 16] = f2bf(oo[n][j] * rstd * nw[(nb + n) * 16 + fr] * (g * sigm(g)));
        }
      }
    }
    {
      bf16x8 af[2];
#pragma unroll
      for (int mm = 0; mm < 2; ++mm) af[mm] = *(const bf16x8*)(KT + (wave * 32 + mm * 16 + fr) * 40 + fq * 8);
#pragma unroll
      for (int n = 0; n < 8; ++n) {
        const bf16x8 bb = *(const bf16x8*)(VT + (n * 16 + fr) * 40 + fq * 8);
#pragma unroll
        for (int mm = 0; mm < 2; ++mm) S[mm][n] = MFMA(af[mm], bb, S[mm][n]);
      }
#pragma unroll
      for (int mm = 0; mm < 2; ++mm)
#pragma unroll
        for (int j = 0; j < 4; ++j) {
          const float e = __expf(blast[wave * 32 + mm * 16 + fq * 4 + j]);
#pragma unroll
          for (int n = 0; n < 8; ++n) S[mm][n][j] *= e;
        }
    }
  }
  __syncthreads();
}

DEV uint4 rw_act(const uint4 cur, const uint4 prv, const float* mul8, int mode) {
  const float4 m0 = *(const float4*)(mul8), m1 = *(const float4*)(mul8 + 4);
  const float mm[8] = {m0.x, m0.y, m0.z, m0.w, m1.x, m1.y, m1.z, m1.w};
  float a[8], b[8], o[8];
  UNPACK8(cur, a); UNPACK8(prv, b);
#pragma unroll
  for (int e = 0; e < 8; ++e) {
    float v = a[e] + (b[e] - a[e]) * mm[e];
    if (mode == 1) { const float t = __expf(-2.f * fabsf(v)); const float th = (1.f - t) / (1.f + t); v = (v >= 0.f) ? th : -th; }
    else if (mode == 2) v = sigm(v);
    o[e] = v;
  }
  return PACK8(o);
}
DEV bf16x8 rw_bfrag(const float* W, int k0, int col) {
  float o[8];
#pragma unroll
  for (int e = 0; e < 8; ++e) o[e] = W[(size_t)(k0 + e) * 512 + col];
  return as_frag(PACK8(o));
}

PHASE void rwkv_item(const Params& p, int l, int item, char* smem) {
  const int b = item >> 3, h = item & 7;
  const int tid = opaque_tid(), lane = tid & 63, wave = tid >> 6, fr = lane & 15, fq = lane >> 4;
  float* R = (float*)smem;
  float* K = R + 2048; float* KK = K + 2048; float* W = KK + 2048; float* BB = W + 2048;
  float* V = BB + 2048; float* G = V + 2048; float* O = G + 2048;
  float* cst = O + 2048;
  float* mul = cst + 512;
  bf16_t* rawL = (bf16_t*)smem;
  float* vloL = (float*)(smem + 17424);
  const float* mu = p.rw_mu + (size_t)l * 1792;
  const int hc_n = h * 64 + wave * 16 + fr;
  bf16x8 w2f[2], a2f[2], g2f[4], v2f;
#pragma unroll
  for (int ks = 0; ks < 2; ++ks) {
    w2f[ks] = rw_bfrag(p.rw_w2 + (size_t)l * 64 * 512, ks * 32 + fq * 8, hc_n);
    a2f[ks] = rw_bfrag(p.rw_a2 + (size_t)l * 64 * 512, ks * 32 + fq * 8, hc_n);
  }
#pragma unroll
  for (int ks = 0; ks < 4; ++ks) g2f[ks] = rw_bfrag(p.rw_g2 + (size_t)l * 128 * 512, ks * 32 + fq * 8, hc_n);
  v2f = w2f[0];
  if (l > 0) v2f = rw_bfrag(p.rw_v2, fq * 8, hc_n);
  const float w0c = p.rw_w0[l * 512 + hc_n], a0c = p.rw_a0[l * 512 + hc_n];
  const float v0c = (l > 0) ? p.rw_v0[hc_n] : 0.f;
  const int t_ = tid >> 3, n0 = (tid & 7) * 8;
  __syncthreads();
  if (tid < 64) {
    const int hc = h * 64 + tid;
    cst[tid] = p.rw_k_k[l * 512 + hc]; cst[64 + tid] = p.rw_k_a[l * 512 + hc]; cst[128 + tid] = p.rw_r_k[l * 512 + hc];
    cst[192 + tid] = p.rw_gn_w[l * 512 + hc]; cst[256 + tid] = p.rw_gn_b[l * 512 + hc];
    cst[320 + tid] = mu[hc]; cst[384 + tid] = mu[512 + hc]; cst[448 + tid] = mu[1024 + hc];
  }
  mul[tid] = mu[1536 + tid];
  const float* kkc = cst + n0; const float* kac = cst + 64 + n0; const float* rkc = cst + 128 + n0;
  const float* gnw = cst + 192 + n0; const float* gnb = cst + 256 + n0;
  const float* mur = cst + 320 + n0; const float* muk = cst + 384 + n0; const float* muv = cst + 448 + n0;
  const int kq = lane & 7, row0 = wave * 16 + (lane >> 3), row1 = row0 + 8;
  f32x2 S0p[4], S1p[4];
#pragma unroll
  for (int e = 0; e < 4; ++e) { S0p[e] = (f32x2){0.f, 0.f}; S1p[e] = (f32x2){0.f, 0.f}; }

  uint4 pl0, pl1, pl2, pl3, pl4, pcr, pck, pcv, ppr, ppk, ppv, pvf;
  float4 pvl;
#define RW_PREFETCH(ch_)                                                                                    \
  {                                                                                                         \
    const size_t tk0 = (size_t)b * SEQ + (size_t)(ch_) * 32;                                                 \
    const bf16_t* lb_ = p.u + (tk0 - 1) * US + 3072 + 1536 + (tid & 31) * 8;                                 \
    const int r0_ = tid >> 5;                                                                               \
    pl0 = make_uint4(0, 0, 0, 0); if (!((ch_) == 0 && r0_ == 0)) pl0 = *(const uint4*)(lb_ + (size_t)r0_ * US); \
    pl1 = *(const uint4*)(lb_ + (size_t)(r0_ + 8) * US);                                                     \
    pl2 = *(const uint4*)(lb_ + (size_t)(r0_ + 16) * US);                                                    \
    pl3 = *(const uint4*)(lb_ + (size_t)(r0_ + 24) * US);                                                    \
    pl4 = make_uint4(0, 0, 0, 0); if (tid < 32) pl4 = *(const uint4*)(lb_ + (size_t)32 * US);                \
    const bf16_t* cu_ = p.u + (tk0 + t_) * US + 3072 + h * 64 + n0;                                          \
    pcr = *(const uint4*)cu_; pck = *(const uint4*)(cu_ + 512); pcv = *(const uint4*)(cu_ + 1024);           \
    if ((ch_) == 0 && t_ == 0) { ppr = make_uint4(0, 0, 0, 0); ppk = ppr; ppv = ppr; }                        \
    else { ppr = *(const uint4*)(cu_ - US); ppk = *(const uint4*)(cu_ - US + 512); ppv = *(const uint4*)(cu_ - US + 1024); } \
    if (l > 0) {                                                                                            \
      pvl = *(const float4*)(p.vlo + (tk0 + (tid >> 3)) * 32 + (tid & 7) * 4);                               \
      pvf = *(const uint4*)(p.vfirst + (tk0 + t_) * 512 + h * 64 + n0);                                      \
    } else { pvl = make_float4(0.f, 0.f, 0.f, 0.f); pvf = make_uint4(0, 0, 0, 0); }                          \
  }
  RW_PREFETCH(0)

  for (int ch = 0; ch < 64; ++ch) {
    const size_t tok0 = (size_t)b * SEQ + (size_t)ch * 32;
    __syncthreads();
    {
      const int r0_ = tid >> 5, cc_ = (tid & 31) * 8;
      *(uint4*)(rawL + r0_ * 264 + cc_) = pl0;
      *(uint4*)(rawL + (r0_ + 8) * 264 + cc_) = pl1;
      *(uint4*)(rawL + (r0_ + 16) * 264 + cc_) = pl2;
      *(uint4*)(rawL + (r0_ + 24) * 264 + cc_) = pl3;
      if (tid < 32) *(uint4*)(rawL + 32 * 264 + cc_) = pl4;
      *(float4*)(vloL + (tid >> 3) * 36 + (tid & 7) * 4) = pvl;
    }
    __syncthreads();
    {
      const int cc_ = (tid & 31) * 8, tr = tid >> 5;
      const int mode = (cc_ < 64) ? 1 : ((cc_ < 128) ? 0 : 2);
      uint4 a0, a1, a2, a3;
      a0 = rw_act(*(const uint4*)(rawL + (tr + 1) * 264 + cc_), *(const uint4*)(rawL + tr * 264 + cc_), mul + cc_, mode);
      a1 = rw_act(*(const uint4*)(rawL + (tr + 9) * 264 + cc_), *(const uint4*)(rawL + (tr + 8) * 264 + cc_), mul + cc_, mode);
      a2 = rw_act(*(const uint4*)(rawL + (tr + 17) * 264 + cc_), *(const uint4*)(rawL + (tr + 16) * 264 + cc_), mul + cc_, mode);
      a3 = rw_act(*(const uint4*)(rawL + (tr + 25) * 264 + cc_), *(const uint4*)(rawL + (tr + 24) * 264 + cc_), mul + cc_, mode);
      __syncthreads();
      *(uint4*)(rawL + tr * 264 + cc_) = a0;
      *(uint4*)(rawL + (tr + 8) * 264 + cc_) = a1;
      *(uint4*)(rawL + (tr + 16) * 264 + cc_) = a2;
      *(uint4*)(rawL + (tr + 24) * 264 + cc_) = a3;
    }
    __syncthreads();
#pragma unroll 1
    for (int mt = 0; mt < 2; ++mt) {
      const int row = mt * 16 + fr;
      const bf16_t* ar = rawL + row * 264 + fq * 8;
      f32x4 aw = (f32x4){0.f, 0.f, 0.f, 0.f}, aa = aw, ag = aw, av = aw;
#pragma unroll
      for (int ks = 0; ks < 2; ++ks) {
        aw = MFMA(*(const bf16x8*)(ar + ks * 32), w2f[ks], aw);
        aa = MFMA(*(const bf16x8*)(ar + 64 + ks * 32), a2f[ks], aa);
      }
#pragma unroll
      for (int ks = 0; ks < 4; ++ks) ag = MFMA(*(const bf16x8*)(ar + 128 + ks * 32), g2f[ks], ag);
      if (l > 0) {
        const float4 x0 = *(const float4*)(vloL + row * 36 + fq * 8), x1 = *(const float4*)(vloL + row * 36 + fq * 8 + 4);
        const uint4 pk = make_uint4(pack2(x0.x, x0.y), pack2(x0.z, x0.w), pack2(x1.x, x1.y), pack2(x1.z, x1.w));
        av = MFMA(as_frag(pk), v2f, av);
      }
#pragma unroll
      for (int j = 0; j < 4; ++j) {
        const int t = mt * 16 + fq * 4 + j, n = wave * 16 + fr;
        const float wv = -(w0c + aw[j]);
        const float sp = fmaxf(wv, 0.f) + __logf(1.f + __expf(-fabsf(wv)));
        const float wl = -sp - 0.5f;
        W[t * 64 + n] = __expf(-__expf(wl));
        BB[t * 64 + n] = sigm(a0c + aa[j]);
        G[t * 64 + n] = ag[j];
        if (l > 0) O[t * 64 + n] = sigm(v0c + av[j]);
      }
    }
    __syncthreads();
    {
      const size_t tok = tok0 + t_;
      float cr[8], ck[8], cv[8], pr[8], pk[8], pv[8];
      UNPACK8(pcr, cr); UNPACK8(pck, ck); UNPACK8(pcv, cv);
      UNPACK8(ppr, pr); UNPACK8(ppk, pk); UNPACK8(ppv, pv);
      float kx[8], kkv[8], vs[8], ss = 0.f;
#pragma unroll
      for (int e = 0; e < 8; ++e) {
        R[t_ * 64 + n0 + e] = cr[e] + (pr[e] - cr[e]) * mur[e];
        kx[e] = ck[e] + (pk[e] - ck[e]) * muk[e];
        vs[e] = cv[e] + (pv[e] - cv[e]) * muv[e];
        kkv[e] = kx[e] * kkc[e]; ss += kkv[e] * kkv[e];
      }
      ss = red8_sum(ss);
      const float rn = rsqrtf(fmaxf(ss, 1e-24f));
#pragma unroll
      for (int e = 0; e < 8; ++e) {
        const float a = BB[t_ * 64 + n0 + e];
        const float kn = kkv[e] * rn;
        K[t_ * 64 + n0 + e] = kx[e] * (1.f + (a - 1.f) * kac[e]);
        KK[t_ * 64 + n0 + e] = kn;
        BB[t_ * 64 + n0 + e] = kn * a;
      }
      if (l == 0) {
        *(uint4*)(p.vfirst + tok * 512 + h * 64 + n0) = PACK8(vs);
      } else {
        float vf[8]; UNPACK8(pvf, vf);
#pragma unroll
        for (int e = 0; e < 8; ++e) vs[e] = vs[e] + (vf[e] - vs[e]) * O[t_ * 64 + n0 + e];
      }
#pragma unroll
      for (int e = 0; e < 8; ++e) V[t_ * 64 + n0 + e] = vs[e];
    }
    __syncthreads();
    if (ch + 1 < 64) RW_PREFETCH(ch + 1)
    asm volatile("" ::: "memory");
#pragma unroll 4
    for (int t = 0; t < 32; ++t) {
      const float* base = R + t * 64 + kq * 8;
      const float4 r0 = *(const float4*)(base), r1 = *(const float4*)(base + 4);
      const float4 k0 = *(const float4*)(base + 2048), k1 = *(const float4*)(base + 2048 + 4);
      const float4 q0 = *(const float4*)(base + 4096), q1 = *(const float4*)(base + 4096 + 4);
      const float4 w0 = *(const float4*)(base + 6144), w1 = *(const float4*)(base + 6144 + 4);
      const float4 b0 = *(const float4*)(base + 8192), b1 = *(const float4*)(base + 8192 + 4);
      const float va = V[t * 64 + row0], vb = V[t * 64 + row1];
      const f32x2 rr[4] = {{r0.x, r0.y}, {r0.z, r0.w}, {r1.x, r1.y}, {r1.z, r1.w}};
      const f32x2 ww[4] = {{w0.x, w0.y}, {w0.z, w0.w}, {w1.x, w1.y}, {w1.z, w1.w}};
      const f32x2 kk_[4] = {{k0.x, k0.y}, {k0.z, k0.w}, {k1.x, k1.y}, {k1.z, k1.w}};
      const f32x2 qq[4] = {{q0.x, q0.y}, {q0.z, q0.w}, {q1.x, q1.y}, {q1.z, q1.w}};
      const f32x2 bb[4] = {{b0.x, b0.y}, {b0.z, b0.w}, {b1.x, b1.y}, {b1.z, b1.w}};
      f32x2 a0 = S0p[0] * qq[0], a1 = S1p[0] * qq[0];
#pragma unroll
      for (int e = 1; e < 4; ++e) { a0 += S0p[e] * qq[e]; a1 += S1p[e] * qq[e]; }
      const float sa0 = -red8_sum(a0.x + a0.y), sa1 = -red8_sum(a1.x + a1.y);
      f32x2 sa0v, sa1v, vav, vbv;
      sa0v.x = sa0; sa0v.y = sa0; sa1v.x = sa1; sa1v.y = sa1; vav.x = va; vav.y = va; vbv.x = vb; vbv.y = vb;
      f32x2 o0v = {0.f, 0.f}, o1v = {0.f, 0.f};
#pragma unroll
      for (int e = 0; e < 4; ++e) {
        S0p[e] = S0p[e] * ww[e] + sa0v * bb[e] + vav * kk_[e];
        S1p[e] = S1p[e] * ww[e] + sa1v * bb[e] + vbv * kk_[e];
        o0v += S0p[e] * rr[e]; o1v += S1p[e] * rr[e];
      }
      const float o0 = red8_sum(o0v.x + o0v.y), o1 = red8_sum(o1v.x + o1v.y);
      if (kq == 0) { O[t * 64 + row0] = o0; O[t * 64 + row1] = o1; }
    }
    asm volatile("s_waitcnt vmcnt(0)" ::: "memory");
    __syncthreads();
    {
      const size_t tok = tok0 + t_;
      float ov[8], s1 = 0.f, bon = 0.f;
#pragma unroll
      for (int e = 0; e < 8; ++e) {
        ov[e] = O[t_ * 64 + n0 + e]; s1 += ov[e];
        bon += R[t_ * 64 + n0 + e] * K[t_ * 64 + n0 + e] * rkc[e];
      }
      s1 = red8_sum(s1); bon = red8_sum(bon);
      const float mean = s1 * (1.f / 64.f);
      float s2 = 0.f;
#pragma unroll
      for (int e = 0; e < 8; ++e) { const float d = ov[e] - mean; s2 += d * d; }
      s2 = red8_sum(s2);
      const float rstd = rsqrtf(s2 * (1.f / 64.f) + 64e-5f);
      float y[8];
#pragma unroll
      for (int e = 0; e < 8; ++e)
        y[e] = ((ov[e] - mean) * rstd * gnw[e] + gnb[e] + bon * V[t_ * 64 + n0 + e]) * G[t_ * 64 + n0 + e];
      *(uint4*)(p.u + tok * US + 3072 + h * 64 + n0) = PACK8(y);
    }
  }
#undef RW_PREFETCH
  __syncthreads();
}

PHASE void phase_mix(const Params& p, int l, char* smem) {
  const int hf = vhalf();
  int* sitem = (int*)(smem - hf * SMEM_BYTES + SMEM_BYTES - 16);
  const int t512 = opaque_tid512();
  while (true) {
    __syncthreads();
    if (t512 == 0) *sitem = (int)atomicAdd(p.counters + l * 4 + 0, 1u);
    __syncthreads();
    const int tk = *sitem;
    if (tk >= 128) break;
    rwkv_item(p, l, tk * 2 + hf, smem);
  }
  while (true) {
    __syncthreads();
    if (t512 == 0) *sitem = (int)atomicAdd(p.counters + l * 4 + 1, 1u);
    __syncthreads();
    const int tk = *sitem;
    if (tk >= 64) break;
    hgrn_item(p, l, tk * 2 + hf, smem);
  }
  while (true) {
    __syncthreads();
    if (t512 == 0) *sitem = (int)atomicAdd(p.counters + l * 4 + 2, 1u);
    __syncthreads();
    const int tk = *sitem;
    if (tk >= 2048) break;
    att_item(p, l, tk * 2 + hf, smem);
  }
}

DEV void gemm_gates(const int tid_in, const bf16_t* A, const bf16_t* Wg, int tn, char* smem, unsigned (&Gp)[4][6][2]) {
  int tid = tid_in; asm volatile("" : "+v"(tid));
  bf16_t* As = (bf16_t*)smem;
  bf16_t* Bs = As + 3 * 4096;
  const int lane = tid & 63, wave = tid >> 6, wr = wave >> 1, wc = wave & 1;
  const int fr = lane & 15, fq = lane >> 4;
  f32x4 acc[4][6];
#pragma unroll
  for (int m = 0; m < 4; ++m)
#pragma unroll
    for (int n = 0; n < 6; ++n) acc[m][n] = (f32x4){0.f, 0.f, 0.f, 0.f};
  const int nk = DM >> 5;
  const int drow = tid >> 2, dphys = tid & 3, dg = (0 - (tid >> 4)) & 3;
  const int cofs = (dphys ^ dg) * 8;
  const unsigned aofs = (unsigned)(drow * DM + cofs);
  unsigned bofs0, bofs1, bofs2;
  {
    int r = drow; int wcb = r / 96, br = (r % 96) >> 5, c = (r % 96) & 31;
    bofs0 = (unsigned)((5376 + br * 1024 + tn * 64 + wcb * 32 + c) * DM + cofs);
    r = drow + 64; wcb = r / 96; br = (r % 96) >> 5; c = (r % 96) & 31;
    bofs1 = (unsigned)((5376 + br * 1024 + tn * 64 + wcb * 32 + c) * DM + cofs);
    r = drow + 128; wcb = r / 96; br = (r % 96) >> 5; c = (r % 96) & 31;
    bofs2 = (unsigned)((5376 + br * 1024 + tn * 64 + wcb * 32 + c) * DM + cofs);
  }
  const int rofs = (fq ^ ((0 - (fr >> 2)) & 3)) * 8;
#define GG_DMA(st, kk)                                                                                       \
  {                                                                                                          \
    __builtin_amdgcn_global_load_lds((const unsigned*)(A + aofs + (kk) * 32), (unsigned*)(As + (st) * 4096 + tid * 8), 16, 0, 0);                     \
    __builtin_amdgcn_global_load_lds((const unsigned*)(A + aofs + 64 * DM + (kk) * 32), (unsigned*)(As + (st) * 4096 + tid * 8 + 2048), 16, 0, 0); \
    __builtin_amdgcn_global_load_lds((const unsigned*)(Wg + bofs0 + (kk) * 32), (unsigned*)(Bs + (st) * 6144 + tid * 8), 16, 0, 0);                    \
    __builtin_amdgcn_global_load_lds((const unsigned*)(Wg + bofs1 + (kk) * 32), (unsigned*)(Bs + (st) * 6144 + tid * 8 + 2048), 16, 0, 0);             \
    __builtin_amdgcn_global_load_lds((const unsigned*)(Wg + bofs2 + (kk) * 32), (unsigned*)(Bs + (st) * 6144 + tid * 8 + 4096), 16, 0, 0);             \
  }
  GG_DMA(0, 0)
  GG_DMA(1, 1)
  int st = 0;
  for (int kt = 0; kt < nk; ++kt) {
    if (kt + 1 < nk) asm volatile("s_waitcnt vmcnt(5)" ::: "memory");
    else asm volatile("s_waitcnt vmcnt(0)" ::: "memory");
    __builtin_amdgcn_s_barrier();
    asm volatile("" ::: "memory");
    const int s2 = (st >= 1) ? st - 1 : 2;
    const bf16_t* Ab = As + st * 4096 + (wr * 64 + fr) * 32 + rofs;
    const bf16_t* Bb = Bs + st * 6144 + (wc * 96 + fr) * 32 + rofs;
    bf16x8 bfr[6], af[4];
#pragma unroll
    for (int n = 0; n < 6; ++n) bfr[n] = *(const bf16x8*)(Bb + n * 512);
#pragma unroll
    for (int m = 0; m < 4; ++m) af[m] = *(const bf16x8*)(Ab + m * 512);
    if (kt + 2 < nk) GG_DMA(s2, kt + 2)
#pragma unroll
    for (int m = 0; m < 4; ++m)
#pragma unroll
      for (int n = 0; n < 6; ++n) acc[m][n] = MFMA(af[m], bfr[n], acc[m][n]);
    st = (st == 2) ? 0 : st + 1;
  }
#undef GG_DMA
  __syncthreads();
#pragma unroll
  for (int m = 0; m < 4; ++m)
#pragma unroll
    for (int n = 0; n < 6; ++n) {
      Gp[m][n][0] = pack2(sigm(acc[m][n][0]), sigm(acc[m][n][1]));
      Gp[m][n][1] = pack2(sigm(acc[m][n][2]), sigm(acc[m][n][3]));
    }
}

PHASE void phase_merge(const Params& p, int l, char* smem) {
  const bf16_t* Wl = p.wt + (size_t)l * WLAYER;
  float* Cs = (float*)smem;
  const int tid = opaque_tid();
  for (int it = 0;; ++it) {
    int tm, tn;
    if (!tile_for(it, 512, 16, tm, tn)) break;
    const size_t row0 = (size_t)tm * 128;
    unsigned Gp[4][6][2];
    gemm_gates(tid, p.h + row0 * DM, Wl + WIN, tn, smem, Gp);
    f32x4 acc[4][2], M[4][2];
#pragma unroll
    for (int m = 0; m < 4; ++m)
#pragma unroll
      for (int n = 0; n < 2; ++n) M[m][n] = (f32x4){0.f, 0.f, 0.f, 0.f};
#pragma unroll
    for (int br = 0; br < 3; ++br) {
      const int aoff = (br == 0) ? 0 : (br == 1 ? 2560 : 3072);
      const size_t woff = (br == 0) ? WBA : (br == 1 ? WBB : WBC);
      gemm_tile<2>(tid, p.u + row0 * US + aoff, US, Wl + woff + (size_t)(tn * 64) * 512, 512, 512, smem, acc);
#pragma unroll
      for (int m = 0; m < 4; ++m)
#pragma unroll
        for (int n = 0; n < 2; ++n) {
          M[m][n][0] += lo16(Gp[m][2 * br + n][0]) * acc[m][n][0];
          M[m][n][1] += hi16(Gp[m][2 * br + n][0]) * acc[m][n][1];
          M[m][n][2] += lo16(Gp[m][2 * br + n][1]) * acc[m][n][2];
          M[m][n][3] += hi16(Gp[m][2 * br + n][1]) * acc[m][n][3];
        }
    }
    stage_acc<2>(tid, Cs, M);
    __syncthreads();
    {
      const int ch = tid & 7;
#pragma unroll 1
      for (int i = 0; i < 4; ++i) {
        const int r = (tid >> 3) + i * 32;
        const float4 a = *(const float4*)(Cs + r * 68 + ch * 8), b = *(const float4*)(Cs + r * 68 + ch * 8 + 4);
        *(uint4*)(p.u + (row0 + r) * US + 1024 + tn * 64 + ch * 8) = make_uint4(pack2(a.x, a.y), pack2(a.z, a.w), pack2(b.x, b.y), pack2(b.z, b.w));
      }
    }
    __syncthreads();
  }
}

PHASE void phase_gemm_res(const bf16_t* A, int lda, const bf16_t* Wt, int K, const float* xin, float* xout,
                        const float* ada_l, int gate_off, char* smem0) {
  const int T = opaque_tid512(), tid = T & 255, hf = vhalf();
  float* Cs = (float*)(smem0 + hf * SMEM_BYTES);
  for (int it = 0;; ++it) {
    int tm, tn;
    if (!tile_for_real(it, 256, 4, tm, tn)) break;
    const size_t row0 = (size_t)tm * 256;
    f32x4 acc[8][4];
    gemm_tile512(T, A + row0 * lda, lda, Wt + (size_t)(tn * 256) * K, K, K, smem0, acc);
    const float* gate = ada_l + (size_t)(row0 / SEQ) * ADAW + gate_off;
    const int c4 = (tid & 31) * 4;
#pragma unroll
    for (int ps = 0; ps < 2; ++ps) {
      if (ps == 0) stage_half512<0>(T, Cs, acc); else stage_half512<1>(T, Cs, acc);
      __syncthreads();
#pragma unroll 1
      for (int i0 = 0; i0 < 16; i0 += 4) {
        float4 xv[4], gv[4], cv[4]; size_t off[4];
#pragma unroll
        for (int ii = 0; ii < 4; ++ii) {
          const int r = (tid >> 5) + (i0 + ii) * 8;
          const int colb = TNC(r) * 128 + c4;
          off[ii] = GROW(r, ps) * DM + colb;
          xv[ii] = *(const float4*)(xin + off[ii]);
          gv[ii] = *(const float4*)(gate + colb);
          cv[ii] = *(const float4*)(Cs + r * 132 + c4);
        }
        asm volatile("" ::: "memory");
#pragma unroll
        for (int ii = 0; ii < 4; ++ii)
          *(float4*)(xout + off[ii]) = make_float4(xv[ii].x + gv[ii].x * cv[ii].x, xv[ii].y + gv[ii].y * cv[ii].y,
                                                   xv[ii].z + gv[ii].z * cv[ii].z, xv[ii].w + gv[ii].w * cv[ii].w);
      }
      __syncthreads();
    }
  }
}

PHASE void phase_ffn_in(const Params& p, int l, char* smem0) {
  const bf16_t* Wt = p.wt + (size_t)l * WLAYER + WFI;
  const int T = opaque_tid512(), tid = T & 255, hf = vhalf();
  float* Cs = (float*)(smem0 + hf * SMEM_BYTES);
  for (int it = 0;; ++it) {
    int tm, tn;
    if (!tile_for_real(it, 256, 22, tm, tn)) break;
    const size_t row0 = (size_t)tm * 256;
    f32x4 acc[8][4];
    gemm_tile512(T, p.h + row0 * DM, DM, Wt + (size_t)(tn * 256) * DM, DM, DM, smem0, acc);
    const int ch = tid & 7;
#pragma unroll
    for (int ps = 0; ps < 2; ++ps) {
      if (ps == 0) stage_half512<0>(T, Cs, acc); else stage_half512<1>(T, Cs, acc);
      __syncthreads();
#pragma unroll 1
      for (int i = 0; i < 4; ++i) {
        const int r = (tid >> 3) + i * 32;
        const float* cp = Cs + r * 132 + ch * 8;
        float o[8];
#pragma unroll
        for (int e = 0; e < 8; ++e) { const float g = cp[e], uu = cp[64 + e]; o[e] = g * sigm(g) * uu; }
        *(uint4*)(p.u + GROW(r, ps) * FFH + TNC(r) * 64 + ch * 8) = PACK8(o);
      }
      __syncthreads();
    }
  }
}

#define XB_TMO      128
#define XB_XCNT(j)  (256  + 64 * (j))
#define XB_XSUB(j)  (1280 + 64 * (j))
#define XB_XGEN(j)  (2304 + 64 * (j))
#define XB_TOP      3328
#define XB_TOPGEN   3392
#define XCD_BAR_WORDS 3456
#define XB_SPIN_CAP (1u << 18)
#define LAS __attribute__((address_space(3)))
DEV unsigned xb_ld(unsigned* p) { return __hip_atomic_load(p, __ATOMIC_RELAXED, __HIP_MEMORY_SCOPE_AGENT); }
DEV unsigned xb_add(unsigned* p, unsigned v) { return __hip_atomic_fetch_add(p, v, __ATOMIC_RELAXED, __HIP_MEMORY_SCOPE_AGENT); }
DEV unsigned xb_xcc_id() { return (unsigned)__builtin_amdgcn_s_getreg((3 << 11) | 20) & 0xFu; }
#define XB_SPIN(cond, bar) do { unsigned _sp = 0; while (cond) { __builtin_amdgcn_s_sleep(1); \
    if ((++_sp & 255u) == 0u) { if (xb_ld(&(bar)[XB_TMO])) break; if (_sp > XB_SPIN_CAP) { atomicAdd(&(bar)[XB_TMO], 1u); break; } } } } while (0)
struct XcdBarrier { unsigned* bar; unsigned x; volatile LAS unsigned* st; };
DEV XcdBarrier xcd_barrier_post(unsigned* bar, volatile LAS unsigned* st) {
  XcdBarrier b; b.bar = bar; b.x = xb_xcc_id(); b.st = st;
  if (threadIdx.x == 0) (void)xb_add(&bar[XB_XCNT(b.x)], 1u);
  return b;
}
DEV void xcd_barrier_complete(unsigned* bar, unsigned x, unsigned& nloc, unsigned& nx) {
  const unsigned G = gridDim.x * gridDim.y * gridDim.z;
  unsigned sum, cnt, mine, sp = 0u;
  for (;;) {
    sum = 0u; cnt = 0u; mine = 0u;
#pragma unroll
    for (unsigned j = 0; j < 16; ++j) { const unsigned c = xb_ld(&bar[XB_XCNT(j)]); sum += c; cnt += (c > 0u) ? 1u : 0u; mine = (j == x) ? c : mine; }
    if (sum == G) break;
    __builtin_amdgcn_s_sleep(1);
    if ((++sp & 255u) == 0u) { if (xb_ld(&bar[XB_TMO])) break; if (sp > XB_SPIN_CAP) { atomicAdd(&bar[XB_TMO], 1u); break; } }
  }
  nloc = mine > 0u ? mine : 1u; nx = cnt > 0u ? cnt : 1u;
}
DEV void xcd_barrier(const XcdBarrier& b) {
  asm volatile("s_waitcnt vmcnt(0)" ::: "memory");
  __syncthreads();
  if (threadIdx.x == 0) {
    unsigned* bar = b.bar;
    __builtin_amdgcn_s_waitcnt(0);
    unsigned nloc = b.st[0], nx = b.st[1];
    if (nloc == 0u) { xcd_barrier_complete(bar, b.x, nloc, nx); b.st[0] = nloc; b.st[1] = nx; }
    const unsigned old = xb_add(&bar[XB_XSUB(b.x)], 1u);
    const unsigned gen = old / nloc;
    if (old + 1u == (gen + 1u) * nloc) {
      __builtin_amdgcn_fence(__ATOMIC_RELEASE, "agent");
      asm volatile("s_waitcnt vmcnt(0)" ::: "memory");
      const unsigned og = xb_add(&bar[XB_TOP], 1u);
      const unsigned tg = og / nx;
      if (og + 1u == (tg + 1u) * nx) xb_add(&bar[XB_TOPGEN], 1u);
      else XB_SPIN(xb_ld(&bar[XB_TOPGEN]) == tg, bar);
      __builtin_amdgcn_fence(__ATOMIC_ACQUIRE, "agent");
      xb_add(&bar[XB_XGEN(b.x)], 1u);
      asm volatile("s_waitcnt vmcnt(0)" ::: "memory");
    } else {
      XB_SPIN(xb_ld(&bar[XB_XGEN(b.x)]) == gen, bar);
      __builtin_amdgcn_fence(__ATOMIC_ACQUIRE, "agent");
      asm volatile("s_waitcnt vmcnt(0)" ::: "memory");
    }
  }
  __syncthreads();
}

__global__ void __launch_bounds__(512, 2) mega(Params p_in, int ph_lo, int ph_hi) {
  extern __shared__ __attribute__((aligned(16))) char smem0[];
  char* smem = smem0 + vhalf() * SMEM_BYTES;
  cg::grid_group grid = cg::this_grid();
  const Params& p = p_in;
  bool first = true;
#define RUN(ph) if ((ph) >= ph_lo && (ph) < ph_hi)
  unsigned epoch = 0;
  __shared__ unsigned xb_words[4];
  if (threadIdx.x < 4) xb_words[threadIdx.x] = 0u;
  __syncthreads();
  XcdBarrier xb;
  xb.bar = p.counters + 256; xb.x = 0u; xb.st = (volatile LAS unsigned*)xb_words;
#define SYNC { if (!first) { ++epoch; if (epoch == 1) { grid.sync(); xb = xcd_barrier_post(p.counters + 256, (volatile LAS unsigned*)xb_words); } else xcd_barrier(xb); } first = false; }
  RUN(0) { SYNC; phase_prep(p, smem); }
#pragma unroll 1
  for (int l = 0; l < 2; ++l) {
    const int base = 1 + 9 * l;
    const float* ada_l = p.ada + (size_t)l * 32 * ADAW;
    const bf16_t* Wl = p.wt + (size_t)l * WLAYER;
    const float* xin = (l == 0) ? p.x : p.out;
    RUN(base + 0) { SYNC; phase_norm(xin, p.norm_mix_w + l * DM, ada_l, 0, 1024, p.h); }
    RUN(base + 1) { SYNC; phase_gemm_in(p, l, smem0); }
    RUN(base + 2) { if (l > 0) { SYNC; phase_vlo(p, l, smem); } }
    RUN(base + 3) { SYNC; phase_mix(p, l, smem); }
    RUN(base + 4) { SYNC; phase_merge(p, l, smem); }
    RUN(base + 5) { SYNC; phase_gemm_res(p.u + 1024, US, Wl + WOUT, DM, xin, p.out, ada_l, 2048, smem0); }
    RUN(base + 6) { SYNC; phase_norm(p.out, p.norm_ffn_w + l * DM, ada_l, 3072, 4096, p.h); }
    RUN(base + 7) { SYNC; phase_ffn_in(p, l, smem0); }
    RUN(base + 8) { SYNC; phase_gemm_res(p.u, FFH, Wl + WFO, FFH, p.out, p.out, ada_l, 5120, smem0); }
  }
  RUN(NPHASE - 1) { SYNC; phase_final(p.out, p.final_norm_w); }
}

extern "C" void kernel_launch(void* const* d_in, const int* in_sizes, int n_in, void* d_out, int out_size, void* d_ws,
                              size_t ws_size, hipStream_t stream) {
  Params p{};
  p.x = (const float*)d_in[0]; p.c = (const float*)d_in[1]; p.pos = (const int*)d_in[2];
  p.ada_w = (const float*)d_in[3]; p.ada_b = (const float*)d_in[4]; p.norm_mix_w = (const float*)d_in[5];
  p.norm_ffn_w = (const float*)d_in[6]; p.w_in = (const float*)d_in[7]; p.da_lambda = (const float*)d_in[8];
  p.da_subln_w = (const float*)d_in[9]; p.hg_lb = (const float*)d_in[10]; p.hg_norm_w = (const float*)d_in[11];
  p.rw_mu = (const float*)d_in[12]; p.rw_w0 = (const float*)d_in[13]; p.rw_w2 = (const float*)d_in[14];
  p.rw_a0 = (const float*)d_in[15]; p.rw_a2 = (const float*)d_in[16]; p.rw_g2 = (const float*)d_in[17];
  p.rw_k_k = (const float*)d_in[18]; p.rw_k_a = (const float*)d_in[19]; p.rw_r_k = (const float*)d_in[20];
  p.rw_gn_w = (const float*)d_in[21]; p.rw_gn_b = (const float*)d_in[22]; p.rw_v0 = (const float*)d_in[23];
  p.rw_v1 = (const float*)d_in[24]; p.rw_v2 = (const float*)d_in[25]; p.w_br_a = (const float*)d_in[26];
  p.w_br_b = (const float*)d_in[27]; p.w_br_c = (const float*)d_in[28]; p.w_out = (const float*)d_in[29];
  p.ffn_w_in = (const float*)d_in[30]; p.ffn_w_out = (const float*)d_in[31]; p.final_norm_w = (const float*)d_in[32];
  p.out = (float*)d_out;
  char* ws = (char*)d_ws;
  size_t off = 0;
  auto take = [&](size_t bytes) { char* r = ws + off; off += (bytes + 255) & ~(size_t)255; return r; };
  p.counters = (unsigned*)take(16384);
  p.wt = (bf16_t*)take(2 * WLAYER * 2);
  p.ada = (float*)take((size_t)2 * 32 * ADAW * 4);
  p.h = (bf16_t*)take((size_t)T_TOK * DM * 2);
  p.u = (bf16_t*)take((size_t)T_TOK * US * 2);
  p.vT = (bf16_t*)take((size_t)T_TOK * 512 * 2);
  p.vfirst = (bf16_t*)take((size_t)T_TOK * 512 * 2);
  p.vlo = (float*)take((size_t)T_TOK * 32 * 4);
  if (off > ws_size) { fprintf(stderr, "workspace too small: need %zu have %zu\n", off, ws_size); return; }

  static int grid_blocks = 0;
  if (!grid_blocks) {
    hipFuncSetAttribute((const void*)mega, hipFuncAttributeMaxDynamicSharedMemorySize, 2 * SMEM_BYTES);
    int dev = 0, cus = 0, per_cu = 0;
    hipGetDevice(&dev);
    hipDeviceGetAttribute(&cus, hipDeviceAttributeMultiprocessorCount, dev);
    hipOccupancyMaxActiveBlocksPerMultiprocessor(&per_cu, mega, 512, 2 * SMEM_BYTES);
    if (per_cu > 1) per_cu = 1;
    if (per_cu < 1) per_cu = 1;
    grid_blocks = cus * per_cu;
  }
#if SINGLE_LAUNCH
  int lo = 0, hi = NPHASE;
  void* args[] = {&p, &lo, &hi};
  hipError_t e = hipLaunchCooperativeKernel((void*)mega, dim3(grid_blocks), dim3(512), args, 2 * SMEM_BYTES, stream);
  if (e != hipSuccess) fprintf(stderr, "cooperative launch failed: %s (grid %d)\n", hipGetErrorString(e), grid_blocks);
#else
  for (int ph = 0; ph < NPHASE; ++ph) {
    if (ph == 3) continue;
    hipLaunchKernelGGL(mega, dim3(grid_blocks), dim3(512), 2 * SMEM_BYTES, stream, p, ph, ph + 1);
  }
#endif
}
```

```cpp
#include <hip/hip_runtime.h>
#include <hip/hip_cooperative_groups.h>
#include <stdint.h>
#include <cstdio>
namespace cg = cooperative_groups;

typedef unsigned short bf16_t;
typedef short bf16x8 __attribute__((ext_vector_type(8)));
typedef float f32x4 __attribute__((ext_vector_type(4)));
typedef float f32x2 __attribute__((ext_vector_type(2)));
#define DEV __device__ __forceinline__
#define PHASE __device__ __forceinline__

#ifndef SINGLE_LAUNCH
#define SINGLE_LAUNCH 1
#endif

constexpr int T_TOK = 65536, DM = 1024, SEQ = 2048, US = 4864, ADAW = 6144, FFH = 2816;
constexpr size_t WIN = 0, WBA = 8650752, WBB = 9175040, WBC = 9699328, WOUT = 10223616, WFI = 11272192,
                 WFO = 17039360, WLAYER = 19922944;
constexpr int SMEM_BYTES = 80896;
constexpr int NPHASE = 20;

struct Params {
  const float* x; const float* c; const int* pos;
  const float *ada_w, *ada_b, *norm_mix_w, *norm_ffn_w, *w_in, *da_lambda, *da_subln_w, *hg_lb, *hg_norm_w;
  const float *rw_mu, *rw_w0, *rw_w2, *rw_a0, *rw_a2, *rw_g2, *rw_k_k, *rw_k_a, *rw_r_k, *rw_gn_w, *rw_gn_b;
  const float *rw_v0, *rw_v1, *rw_v2, *w_br_a, *w_br_b, *w_br_c, *w_out, *ffn_w_in, *ffn_w_out, *final_norm_w;
  float* out;
  bf16_t* wt; float* ada; bf16_t* h; bf16_t* u; bf16_t* vT; bf16_t* vfirst; float* vlo; unsigned* counters;
};

DEV unsigned short f2bf(float f) { unsigned u = __float_as_uint(f); u += 0x7FFFu + ((u >> 16) & 1u); return (unsigned short)(u >> 16); }
DEV float bf2f(unsigned short h) { return __uint_as_float(((unsigned)h) << 16); }
DEV unsigned pack2(float a, float b) { return (unsigned)f2bf(a) | ((unsigned)f2bf(b) << 16); }
DEV float sigm(float x) { return 1.f / (1.f + __expf(-x)); }
DEV float lo16(unsigned v) { return __uint_as_float(v << 16); }
DEV float hi16(unsigned v) { return __uint_as_float(v & 0xFFFF0000u); }
#define UNPACK8(v, f) { f[0]=lo16(v.x); f[1]=hi16(v.x); f[2]=lo16(v.y); f[3]=hi16(v.y); f[4]=lo16(v.z); f[5]=hi16(v.z); f[6]=lo16(v.w); f[7]=hi16(v.w); }
#define PACK8(f) make_uint4(pack2(f[0],f[1]), pack2(f[2],f[3]), pack2(f[4],f[5]), pack2(f[6],f[7]))
template <int CTRL> DEV float dpp(float x) { return __int_as_float(__builtin_amdgcn_update_dpp(0, __float_as_int(x), CTRL, 0xF, 0xF, true)); }
DEV float red8_sum(float x) { x += dpp<0xB1>(x); x += dpp<0x4E>(x); x += dpp<0x141>(x); return x; }
DEV float red16_sum(float x) { x = red8_sum(x); x += dpp<0x140>(x); return x; }
DEV float red16_max(float x) { x = fmaxf(x, dpp<0xB1>(x)); x = fmaxf(x, dpp<0x4E>(x)); x = fmaxf(x, dpp<0x141>(x)); x = fmaxf(x, dpp<0x140>(x)); return x; }
DEV float wave_sum(float x) {
  x = red16_sum(x);
  const int xi = __float_as_int(x);
  return __int_as_float(__builtin_amdgcn_readlane(xi, 0)) + __int_as_float(__builtin_amdgcn_readlane(xi, 16)) +
         __int_as_float(__builtin_amdgcn_readlane(xi, 32)) + __int_as_float(__builtin_amdgcn_readlane(xi, 48));
}
DEV int opaque_tid() { int t = threadIdx.x & 255; asm volatile("" : "+v"(t)); return t; }
DEV int opaque_tid512() { int t = threadIdx.x; asm volatile("" : "+v"(t)); return t; }
DEV int vhalf() { return __builtin_amdgcn_readfirstlane((int)(threadIdx.x >> 8)); }
DEV int vblock() { return (int)blockIdx.x * 2 + vhalf(); }
DEV int vgrid() { return (int)gridDim.x * 2; }
DEV bf16x8 as_frag(uint4 v) { union { uint4 u; bf16x8 b; } c; c.u = v; return c.b; }
#define MFMA(a, b, c) __builtin_amdgcn_mfma_f32_16x16x32_bf16(a, b, c, 0, 0, 0)

template <int NT>
DEV void gemm_tile(const int tid_in, const bf16_t* A, int lda, const bf16_t* B, int ldb, int K, char* smem,
                   f32x4 (&acc)[4][NT]) {
  int tid = tid_in; asm volatile("" : "+v"(tid));
  constexpr int BN = NT * 32;
  constexpr int LS = 64;
  bf16_t* As = (bf16_t*)smem;
  bf16_t* Bs = As + 2 * 128 * LS;
  const int lane = tid & 63, wave = tid >> 6, wr = wave >> 1, wc = wave & 1;
  const int fr = lane & 15, fq = lane >> 4;
  constexpr int NB = BN * 8 / 256;
#pragma unroll
  for (int m = 0; m < 4; ++m)
#pragma unroll
    for (int n = 0; n < NT; ++n) acc[m][n] = (f32x4){0.f, 0.f, 0.f, 0.f};
  const int nk = K >> 6;
  const int lrow = tid >> 3, lcc = tid & 7;
  const bf16_t* Ap = A + (size_t)lrow * lda + ((lcc ^ (lrow & 7)) * 8);
  const bf16_t* Bp = B + (size_t)lrow * ldb + ((lcc ^ (lrow & 7)) * 8);
  const size_t a32 = (size_t)32 * lda, b32 = (size_t)32 * ldb;
  const int rofs0 = (fq ^ (fr & 7)) * 8, rofs1 = rofs0 ^ 32;
#define GT_DMA(buf, koff)                                                                                    \
  {                                                                                                          \
    bf16_t* Ad = As + (buf) * 128 * LS + tid * 8;                                                            \
    bf16_t* Bd = Bs + (buf) * BN * LS + tid * 8;                                                             \
    _Pragma("unroll") for (int i = 0; i < 4; ++i)                                                            \
      __builtin_amdgcn_global_load_lds((const unsigned*)(Ap + i * a32 + (koff)), (unsigned*)(Ad + i * 32 * LS), 16, 0, 0); \
    _Pragma("unroll") for (int i = 0; i < NB; ++i)                                                           \
      __builtin_amdgcn_global_load_lds((const unsigned*)(Bp + i * b32 + (koff)), (unsigned*)(Bd + i * 32 * LS), 16, 0, 0); \
  }
  GT_DMA(0, 0)
  asm volatile("s_waitcnt vmcnt(0)" ::: "memory");
  __syncthreads();
  for (int kt = 0; kt < nk; ++kt) {
    const int buf = kt & 1;
    if (kt + 1 < nk) GT_DMA(buf ^ 1, (kt + 1) * 64)
    const bf16_t* Ab = As + buf * 128 * LS + (wr * 64 + fr) * LS;
    const bf16_t* Bb = Bs + buf * BN * LS + (wc * (NT * 16) + fr) * LS;
#pragma unroll
    for (int ks = 0; ks < 2; ++ks) {
      const int ro = ks ? rofs1 : rofs0;
      bf16x8 af[4], bfr[NT];
#pragma unroll
      for (int m = 0; m < 4; ++m) af[m] = *(const bf16x8*)(Ab + m * 16 * LS + ro);
#pragma unroll
      for (int n = 0; n < NT; ++n) bfr[n] = *(const bf16x8*)(Bb + n * 16 * LS + ro);
#pragma unroll
      for (int m = 0; m < 4; ++m)
#pragma unroll
        for (int n = 0; n < NT; ++n) acc[m][n] = MFMA(af[m], bfr[n], acc[m][n]);
    }
    asm volatile("s_waitcnt vmcnt(0)" ::: "memory");
    __syncthreads();
  }
#undef GT_DMA
}

template <int NT>
DEV void stage_acc(const int tid, float* Cs, const f32x4 (&acc)[4][NT]) {
  constexpr int LDC = NT * 32 + 4;
  const int lane = tid & 63, wave = tid >> 6, wr = wave >> 1, wc = wave & 1, fr = lane & 15, fq = lane >> 4;
#pragma unroll
  for (int m = 0; m < 4; ++m)
#pragma unroll
    for (int n = 0; n < NT; ++n)
#pragma unroll
      for (int j = 0; j < 4; ++j) Cs[(wr * 64 + m * 16 + fq * 4 + j) * LDC + wc * (NT * 16) + n * 16 + fr] = acc[m][n][j];
}

DEV void gemm_tile256(const int tid, const bf16_t* A, int lda, const bf16_t* B, int ldb, int K, char* smem,
                      f32x4 (&acc)[8][4]) {
  bf16_t* As = (bf16_t*)smem;
  bf16_t* Bs = As + 3 * 8192;
  const int lane = tid & 63, wave = tid >> 6, wr = wave >> 1, wc = wave & 1;
  const int fr = lane & 15, fq = lane >> 4;
#pragma unroll
  for (int m = 0; m < 8; ++m)
#pragma unroll
    for (int n = 0; n < 4; ++n) acc[m][n] = (f32x4){0.f, 0.f, 0.f, 0.f};
  const int nk = K >> 5;
  const int drow = tid >> 2, dphys = tid & 3, dg = (0 - (tid >> 4)) & 3;
  const bf16_t* Ap = A + (size_t)drow * lda + ((dphys ^ dg) * 8);
  const bf16_t* Bp = B + (size_t)drow * ldb + ((dphys ^ dg) * 8);
  const size_t a64 = (size_t)64 * lda, b64 = (size_t)64 * ldb;
  const int rofs = (fq ^ ((0 - (fr >> 2)) & 3)) * 8;
#define G2_DMA(st, kk)                                                                                        \
  {                                                                                                           \
    bf16_t* Ad = As + (st) * 8192 + tid * 8;                                                                  \
    bf16_t* Bd = Bs + (st) * 4096 + tid * 8;                                                                  \
    _Pragma("unroll") for (int i = 0; i < 4; ++i)                                                             \
      __builtin_amdgcn_global_load_lds((const unsigned*)(Ap + i * a64 + (kk) * 32), (unsigned*)(Ad + i * 2048), 16, 0, 0); \
    _Pragma("unroll") for (int i = 0; i < 2; ++i)                                                             \
      __builtin_amdgcn_global_load_lds((const unsigned*)(Bp + i * b64 + (kk) * 32), (unsigned*)(Bd + i * 2048), 16, 0, 0); \
  }
  G2_DMA(0, 0)
  G2_DMA(1, 1)
  int st = 0;
  for (int kt = 0; kt < nk; ++kt) {
    if (kt + 1 < nk) asm volatile("s_waitcnt vmcnt(6)" ::: "memory");
    else asm volatile("s_waitcnt vmcnt(0)" ::: "memory");
    __builtin_amdgcn_s_barrier();
    asm volatile("" ::: "memory");
    const int s2 = (st >= 1) ? st - 1 : 2;
    const bool pf = (kt + 2 < nk);
    bf16_t* Ad = As + s2 * 8192 + tid * 8;
    bf16_t* Bd = Bs + s2 * 4096 + tid * 8;
    const bf16_t* Asrc = Ap + (kt + 2) * 32;
    const bf16_t* Bsrc = Bp + (kt + 2) * 32;
    const bf16_t* Ab = As + st * 8192 + (wr * 128 + fr) * 32 + rofs;
    const bf16_t* Bb = Bs + st * 4096 + (wc * 64 + fr) * 32 + rofs;
    bf16x8 bfr[4], af[4];
#pragma unroll
    for (int n = 0; n < 4; ++n) bfr[n] = *(const bf16x8*)(Bb + n * 512);
#pragma unroll
    for (int m = 0; m < 4; ++m) af[m] = *(const bf16x8*)(Ab + m * 512);
#pragma unroll
    for (int m = 0; m < 8; ++m) {
#pragma unroll
      for (int n = 0; n < 4; ++n) acc[m][n] = MFMA(af[m & 3], bfr[n], acc[m][n]);
      if (m + 4 < 8) af[m & 3] = *(const bf16x8*)(Ab + (m + 4) * 512);
      if (pf) {
        if (m < 4) __builtin_amdgcn_global_load_lds((const unsigned*)(Asrc + m * a64), (unsigned*)(Ad + m * 2048), 16, 0, 0);
        else if (m < 6) __builtin_amdgcn_global_load_lds((const unsigned*)(Bsrc + (m - 4) * b64), (unsigned*)(Bd + (m - 4) * 2048), 16, 0, 0);
      }
      __builtin_amdgcn_sched_barrier(0);
    }
    st = (st == 2) ? 0 : st + 1;
  }
#undef G2_DMA
  __syncthreads();
}

template <int PS>
DEV void stage_half(const int tid, float* Cs, const f32x4 (&acc)[8][4]) {
  const int lane = tid & 63, wave = tid >> 6, wr = wave >> 1, wc = wave & 1, fr = lane & 15, fq = lane >> 4;
#pragma unroll
  for (int m = 0; m < 4; ++m)
#pragma unroll
    for (int n = 0; n < 4; ++n)
#pragma unroll
      for (int j = 0; j < 4; ++j) Cs[(wr * 64 + m * 16 + fq * 4 + j) * 132 + wc * 64 + n * 16 + fr] = acc[PS * 4 + m][n][j];
}
#define RMAP(r, ps) ((((r) >> 6) << 7) + (ps) * 64 + ((r) & 63))

DEV void gemm_tile512(const int T, const bf16_t* A, int lda, const bf16_t* B, int ldb, int K, char* smem0,
                      f32x4 (&acc)[8][4]) {
  bf16_t* As = (bf16_t*)smem0;
  bf16_t* Bs = As + 2 * 16384;
  const int lane = T & 63, wave = T >> 6, wr = wave >> 2, wc = wave & 3;
  const int fr = lane & 15, fq = lane >> 4;
#pragma unroll
  for (int m = 0; m < 8; ++m)
#pragma unroll
    for (int n = 0; n < 4; ++n) acc[m][n] = (f32x4){0.f, 0.f, 0.f, 0.f};
  const int nk = K >> 6;
  const int drow = T >> 3, dlog = ((T & 7) ^ ((T >> 3) & 7)) * 8;
  const bf16_t* Ap = A + (size_t)drow * lda + dlog;
  const bf16_t* Bp = B + (size_t)drow * ldb + dlog;
  const size_t a64 = (size_t)64 * lda, b64 = (size_t)64 * ldb;
  const int rofs0 = (fq ^ (fr & 7)) * 8, rofs1 = rofs0 ^ 32;
#pragma unroll
  for (int i = 0; i < 4; ++i) {
    __builtin_amdgcn_global_load_lds((const unsigned*)(Ap + i * a64), (unsigned*)(As + T * 8 + i * 4096), 16, 0, 0);
    __builtin_amdgcn_global_load_lds((const unsigned*)(Bp + i * b64), (unsigned*)(Bs + T * 8 + i * 4096), 16, 0, 0);
  }
  asm volatile("s_waitcnt vmcnt(0)" ::: "memory");
  __syncthreads();
  for (int kt = 0; kt < nk; ++kt) {
    const int buf = kt & 1;
    const bool pf = (kt + 1 < nk);
    bf16_t* Ad = As + (buf ^ 1) * 16384 + T * 8;
    bf16_t* Bd = Bs + (buf ^ 1) * 16384 + T * 8;
    const bf16_t* Asrc = Ap + (kt + 1) * 64;
    const bf16_t* Bsrc = Bp + (kt + 1) * 64;
    const bf16_t* Ab = As + buf * 16384 + (wr * 128 + fr) * 64;
    const bf16_t* Bb = Bs + buf * 16384 + (wc * 64 + fr) * 64;
#pragma unroll
    for (int ks = 0; ks < 2; ++ks) {
      const int ro = ks ? rofs1 : rofs0;
      bf16x8 bfr[4], af[4];
#pragma unroll
      for (int n = 0; n < 4; ++n) bfr[n] = *(const bf16x8*)(Bb + n * 1024 + ro);
#pragma unroll
      for (int m = 0; m < 4; ++m) af[m] = *(const bf16x8*)(Ab + m * 1024 + ro);
#pragma unroll
      for (int m = 0; m < 8; ++m) {
#pragma unroll
        for (int n = 0; n < 4; ++n) acc[m][n] = MFMA(af[m & 3], bfr[n], acc[m][n]);
        if (m + 4 < 8) af[m & 3] = *(const bf16x8*)(Ab + (m + 4) * 1024 + ro);
        if (pf && ks == 0 && m < 4) {
          __builtin_amdgcn_global_load_lds((const unsigned*)(Asrc + m * a64), (unsigned*)(Ad + m * 4096), 16, 0, 0);
          __builtin_amdgcn_global_load_lds((const unsigned*)(Bsrc + m * b64), (unsigned*)(Bd + m * 4096), 16, 0, 0);
        }
        __builtin_amdgcn_sched_barrier(0);
      }
    }
    asm volatile("s_waitcnt vmcnt(0)" ::: "memory");
    __builtin_amdgcn_s_barrier();
    asm volatile("" ::: "memory");
  }
  __syncthreads();
}
template <int PS>
DEV void stage_half512(const int T, float* Cs, const f32x4 (&acc)[8][4]) {
  const int lane = T & 63, wave = T >> 6, wc = wave & 3, fr = lane & 15, fq = lane >> 4;
#pragma unroll
  for (int m = 0; m < 4; ++m)
#pragma unroll
    for (int n = 0; n < 4; ++n)
#pragma unroll
      for (int j = 0; j < 4; ++j) Cs[((wc >> 1) * 64 + m * 16 + fq * 4 + j) * 132 + (wc & 1) * 64 + n * 16 + fr] = acc[PS * 4 + m][n][j];
}
#define GROW(r, ps) (row0 + (size_t)(hf * 128 + (ps) * 64 + ((r) & 63)))
#define TNC(r) (tn * 2 + ((r) >> 6))

DEV bool tile_for(int it, int nM, int nN, int& tm, int& tn) {
  const int nx = (gridDim.x >> 3) * 2;
  const int xcd = blockIdx.x & 7, local = (blockIdx.x >> 3) * 2 + vhalf();
  const long id = ((long)it * 8 + xcd) * nx + local;
  if (local >= nx || id >= (long)nM * nN) return false;
  const int per_group = 8 * nN;
  const int g = (int)(id / per_group), r = (int)(id % per_group);
  tn = r >> 3; tm = g * 8 + (r & 7);
  return true;
}

DEV bool tile_for_real(int it, int nM, int nN, int& tm, int& tn) {
  const int nx = (gridDim.x >> 3);
  const int xcd = blockIdx.x & 7, local = (blockIdx.x >> 3);
  const long id = ((long)it * 8 + xcd) * nx + local;
  if (local >= nx || id >= (long)nM * nN) return false;
  const int per_group = 8 * nN;
  const int g = (int)(id / per_group), r = (int)(id % per_group);
  tn = r >> 3; tm = g * 8 + (r & 7);
  return true;
}

PHASE void phase_prep(const Params& p, char* smem) {
  const int tid = opaque_tid();
  const int vb = vblock(), vg = vgrid();
  if (vb == 0 && tid < 8) p.counters[tid] = 0u;
  if (vb == 1 && tid < 2) {
    const float* lv = p.da_lambda + (size_t)tid * 256;
    float d1 = 0.f, d2 = 0.f;
    for (int i = 0; i < 64; ++i) { d1 += lv[i] * lv[64 + i]; d2 += lv[128 + i] * lv[192 + i]; }
    p.counters[32 + tid] = __float_as_uint(__expf(d1) - __expf(d2) + (0.8f - 0.6f * __expf(-0.3f * (float)tid)));
  }
  if (vb == 0) for (int i = tid; i < 3456; i += 256) p.counters[256 + i] = 0u;
  float* tile = (float*)smem;
  const int NCONV = 2 * 4864, NADA = 192;
  for (int item0 = vb; item0 < NCONV + NADA; item0 += vg) {
    const int item = (item0 < NADA) ? (NCONV + item0) : (item0 - NADA);
    if (item < NCONV) {
      const int l = item / 4864; int r = item % 4864;
      const float* src; int K, Nsrc, nT, perm = 0; size_t dst;
      if (r < 2112) { src = p.w_in + (size_t)l * 1024 * 8448; K = 1024; Nsrc = 8448; dst = WIN; nT = 132; }
      else if (r < 2240) { r -= 2112; src = p.w_br_a + (size_t)l * 512 * 1024; K = 512; Nsrc = 1024; dst = WBA; nT = 16; }
      else if (r < 2368) { r -= 2240; src = p.w_br_b + (size_t)l * 512 * 1024; K = 512; Nsrc = 1024; dst = WBB; nT = 16; }
      else if (r < 2496) { r -= 2368; src = p.w_br_c + (size_t)l * 512 * 1024; K = 512; Nsrc = 1024; dst = WBC; nT = 16; }
      else if (r < 2752) { r -= 2496; src = p.w_out + (size_t)l * 1024 * 1024; K = 1024; Nsrc = 1024; dst = WOUT; nT = 16; }
      else if (r < 4160) { r -= 2752; src = p.ffn_w_in + (size_t)l * 1024 * 5632; K = 1024; Nsrc = 5632; dst = WFI; nT = 88; perm = 1; }
      else { r -= 4160; src = p.ffn_w_out + (size_t)l * 2816 * 1024; K = 2816; Nsrc = 1024; dst = WFO; nT = 16; }
      const int kt = r / nT, nt = r % nT;
      const int colbase = perm ? ((nt & 1) * FFH + 64 * (nt >> 1)) : nt * 64;
      __syncthreads();
#pragma unroll
      for (int i = 0; i < 16; ++i) {
        const int k = i * 4 + (tid >> 6), j = tid & 63;
        tile[k * 65 + j] = src[(size_t)(kt * 64 + k) * Nsrc + colbase + j];
      }
      __syncthreads();
      const int row = tid >> 2, kc = (tid & 3) * 16;
      float f[16];
#pragma unroll
      for (int i = 0; i < 16; ++i) f[i] = tile[(kc + i) * 65 + row];
      bf16_t* d = p.wt + (size_t)l * WLAYER + dst + (size_t)(nt * 64 + row) * K + kt * 64 + kc;
      *(uint4*)d = make_uint4(pack2(f[0], f[1]), pack2(f[2], f[3]), pack2(f[4], f[5]), pack2(f[6], f[7]));
      *(uint4*)(d + 8) = make_uint4(pack2(f[8], f[9]), pack2(f[10], f[11]), pack2(f[12], f[13]), pack2(f[14], f[15]));
    } else {
      const int a = item - NCONV;
      const int l = a / 96, r = a % 96, ntile = r >> 2, bg = r & 3;
      float* cact = (float*)smem;
      __syncthreads();
      for (int i = tid; i < 8 * 1024; i += 256) {
        const float cv = p.c[(size_t)(bg * 8 + (i >> 10)) * DM + (i & 1023)];
        cact[i] = cv * sigm(cv);
      }
      __syncthreads();
      const int n = ntile * 256 + tid;
      const float* W = p.ada_w + (size_t)l * DM * ADAW + n;
      float acc[8];
#pragma unroll
      for (int b = 0; b < 8; ++b) acc[b] = 0.f;
      for (int k0 = 0; k0 < DM; k0 += 16) {
        float w[16];
#pragma unroll
        for (int kk = 0; kk < 16; ++kk) w[kk] = W[(size_t)(k0 + kk) * ADAW];
#pragma unroll
        for (int kk = 0; kk < 16; ++kk)
#pragma unroll
          for (int b = 0; b < 8; ++b) acc[b] += cact[b * 1024 + k0 + kk] * w[kk];
      }
      const float bias = p.ada_b[l * ADAW + n];
#pragma unroll
      for (int b = 0; b < 8; ++b) p.ada[((size_t)l * 32 + bg * 8 + b) * ADAW + n] = acc[b] + bias;
    }
  }
}

PHASE void phase_norm(const float* __restrict__ x, const float* __restrict__ w, const float* __restrict__ ada_l,
                    int shift_off, int scale_off, bf16_t* __restrict__ h) {
  const int tid = opaque_tid();
  const int lane = tid & 63, wave = tid >> 6;
  for (int row0 = (vblock() * 4 + wave) * 4; row0 < T_TOK; row0 += vgrid() * 16) {
    float4 v[4][4]; float ss[4];
#pragma unroll
    for (int rr = 0; rr < 4; ++rr)
#pragma unroll
      for (int i = 0; i < 4; ++i) v[rr][i] = *(const float4*)(x + (size_t)(row0 + rr) * DM + i * 256 + lane * 4);
#pragma unroll
    for (int rr = 0; rr < 4; ++rr) {
      float a = 0.f;
#pragma unroll
      for (int i = 0; i < 4; ++i) a += v[rr][i].x * v[rr][i].x + v[rr][i].y * v[rr][i].y + v[rr][i].z * v[rr][i].z + v[rr][i].w * v[rr][i].w;
      ss[rr] = rsqrtf(wave_sum(a) * (1.f / DM) + 1e-6f);
    }
    const float* ad = ada_l + (size_t)(row0 / SEQ) * ADAW;
#pragma unroll
    for (int i = 0; i < 4; ++i) {
      const int col = i * 256 + lane * 4;
      const float4 ww = *(const float4*)(w + col), sc = *(const float4*)(ad + scale_off + col), sh = *(const float4*)(ad + shift_off + col);
#pragma unroll
      for (int rr = 0; rr < 4; ++rr) {
        const float rstd = ss[rr];
        const float o0 = v[rr][i].x * rstd * ww.x * (1.f + sc.x) + sh.x, o1 = v[rr][i].y * rstd * ww.y * (1.f + sc.y) + sh.y;
        const float o2 = v[rr][i].z * rstd * ww.z * (1.f + sc.z) + sh.z, o3 = v[rr][i].w * rstd * ww.w * (1.f + sc.w) + sh.w;
        *(uint2*)(h + (size_t)(row0 + rr) * DM + col) = make_uint2(pack2(o0, o1), pack2(o2, o3));
      }
    }
  }
}

PHASE void phase_final(float* __restrict__ x, const float* __restrict__ w) {
  const int tid = opaque_tid();
  const int lane = tid & 63, wave = tid >> 6;
  for (int row0 = (vblock() * 4 + wave) * 4; row0 < T_TOK; row0 += vgrid() * 16) {
    float4 v[4][4]; float ss[4];
#pragma unroll
    for (int rr = 0; rr < 4; ++rr)
#pragma unroll
      for (int i = 0; i < 4; ++i) v[rr][i] = *(const float4*)(x + (size_t)(row0 + rr) * DM + i * 256 + lane * 4);
#pragma unroll
    for (int rr = 0; rr < 4; ++rr) {
      float a = 0.f;
#pragma unroll
      for (int i = 0; i < 4; ++i) a += v[rr][i].x * v[rr][i].x + v[rr][i].y * v[rr][i].y + v[rr][i].z * v[rr][i].z + v[rr][i].w * v[rr][i].w;
      ss[rr] = rsqrtf(wave_sum(a) * (1.f / DM) + 1e-6f);
    }
#pragma unroll
    for (int i = 0; i < 4; ++i) {
      const int col = i * 256 + lane * 4;
      const float4 ww = *(const float4*)(w + col);
#pragma unroll
      for (int rr = 0; rr < 4; ++rr) {
        const float rstd = ss[rr];
        *(float4*)(x + (size_t)(row0 + rr) * DM + col) =
            make_float4(v[rr][i].x * rstd * ww.x, v[rr][i].y * rstd * ww.y, v[rr][i].z * rstd * ww.z, v[rr][i].w * rstd * ww.w);
      }
    }
  }
}

PHASE void phase_gemm_in(const Params& p, int l, char* smem0) {
  const bf16_t* Wt = p.wt + (size_t)l * WLAYER + WIN;
  const int T = opaque_tid512(), tid = T & 255, hf = vhalf();
  float* Cs = (float*)(smem0 + hf * SMEM_BYTES);
  for (int it = 0;; ++it) {
    int tm, tn;
    if (!tile_for_real(it, 256, 21, tm, tn)) break;
    f32x4 acc[8][4];
    gemm_tile512(T, p.h + (size_t)tm * 256 * DM, DM, Wt + (size_t)tn * 256 * DM, DM, DM, smem0, acc);
    const size_t row0 = (size_t)tm * 256;
#pragma unroll
    for (int ps = 0; ps < 2; ++ps) {
      if (ps == 0) stage_half512<0>(T, Cs, acc); else stage_half512<1>(T, Cs, acc);
      __syncthreads();
      if (tn < 4) {
        const float qs = (tn < 2) ? 0.125f : 1.f;
        const int ch = tid & 15, g = ch >> 3, cc = ch & 7;
        if (cc < 4) {
#pragma unroll 1
          for (int i = 0; i < 8; ++i) {
            const int r = (tid >> 4) + i * 16;
            const size_t grow = GROW(r, ps);
            const float pos = (float)p.pos[grow];
            const float* c1 = Cs + r * 132 + g * 64 + cc * 8;
            float o1[8], o2[8];
#pragma unroll
            for (int e = 0; e < 8; ++e) {
              const float x1 = c1[e], x2 = c1[32 + e];
              const float inv = exp2f(-(float)(cc * 8 + e) * 0.41524101186092029f);
              float rev = pos * inv * 0.15915494309189535f;
              rev -= rintf(rev);
              const float sn = __builtin_amdgcn_sinf(rev), cs = __builtin_amdgcn_cosf(rev);
              o1[e] = (x1 * cs - x2 * sn) * qs; o2[e] = (x2 * cs + x1 * sn) * qs;
            }
            bf16_t* d = p.u + grow * US + TNC(r) * 128 + g * 64 + cc * 8;
            *(uint4*)d = PACK8(o1);
            *(uint4*)(d + 32) = PACK8(o2);
          }
        }
      } else if (tn < 6) {
        const int b = (int)(row0 / SEQ), s0 = (int)(row0 % SEQ);
        const int rch = tid & 15;
        const int vc0 = (TNC(rch * 8) - 8) * 128;
#pragma unroll 1
        for (int i = 0; i < 8; ++i) {
          const int c = (tid >> 4) + i * 16;
          float f[8];
#pragma unroll
          for (int j = 0; j < 8; ++j) f[j] = Cs[(rch * 8 + j) * 132 + c];
          *(uint4*)(p.vT + ((size_t)b * 512 + vc0 + c) * SEQ + s0 + hf * 128 + ps * 64 + ((rch * 8) & 63)) = PACK8(f);
        }
      } else {
        const int ch = tid & 15;
#pragma unroll 1
        for (int i = 0; i < 8; ++i) {
          const int r = (tid >> 4) + i * 16;
          const float4 a = *(const float4*)(Cs + r * 132 + ch * 8), b = *(const float4*)(Cs + r * 132 + ch * 8 + 4);
          *(uint4*)(p.u + GROW(r, ps) * US + TNC(r) * 128 - 512 + ch * 8) = make_uint4(pack2(a.x, a.y), pack2(a.z, a.w), pack2(b.x, b.y), pack2(b.z, b.w));
        }
      }
      __syncthreads();
    }
  }
}

PHASE void phase_vlo(const Params& p, int l, char* smem) {
  float* vs = (float*)smem;
  const int tid = opaque_tid();
  const float* mu = p.rw_mu + (size_t)l * 1792 + 1024;
  const float* v1 = p.rw_v1;
  for (int item = vblock(); item < T_TOK / 32; item += vgrid()) {
    const size_t tok0 = (size_t)item * 32;
    __syncthreads();
#pragma unroll 1
    for (int i = 0; i < 8; ++i) {
      const int c = tid + i * 256;
      const int t = c >> 6, cc = c & 63;
      const size_t tok = tok0 + t;
      const uint4 cur = *(const uint4*)(p.u + tok * US + 3072 + 1024 + cc * 8);
      uint4 prv = make_uint4(0, 0, 0, 0);
      if ((tok % SEQ) != 0) prv = *(const uint4*)(p.u + (tok - 1) * US + 3072 + 1024 + cc * 8);
      float a[8], b[8];
      UNPACK8(cur, a); UNPACK8(prv, b);
#pragma unroll
      for (int e = 0; e < 8; ++e) vs[t * 512 + cc * 8 + e] = a[e] + (b[e] - a[e]) * mu[cc * 8 + e];
    }
    __syncthreads();
    const int j = tid & 31, tg = tid >> 5;
    float acc[4] = {0.f, 0.f, 0.f, 0.f};
    for (int k0 = 0; k0 < 512; k0 += 16) {
      float w[16];
#pragma unroll
      for (int kk = 0; kk < 16; ++kk) w[kk] = v1[(k0 + kk) * 32 + j];
#pragma unroll
      for (int kk = 0; kk < 16; ++kk)
#pragma unroll
        for (int i = 0; i < 4; ++i) acc[i] += vs[(tg * 4 + i) * 512 + k0 + kk] * w[kk];
    }
#pragma unroll
    for (int i = 0; i < 4; ++i) p.vlo[(tok0 + tg * 4 + i) * 32 + j] = acc[i];
  }
}

PHASE void att_item(const Params& p, int l, int item, char* smem) {
  const int qc = 31 - (item >> 7);
  const int bh = item & 127, b = bh >> 2, h = bh & 3;
  const int tid = opaque_tid(), lane = tid & 63, wave = tid >> 6, fr = lane & 15, fq = lane >> 4;
  const int m = wave >> 1, rh = wave & 1;
  bf16_t* Ks = (bf16_t*)smem;
  bf16_t* Vt = Ks + 2 * 64 * 64;
  bf16_t* Ps = Vt + 128 * 64;
  float* Ox = (float*)smem;
  const size_t tok0 = (size_t)b * SEQ + (size_t)qc * 64;
  const float lam_init = 0.8f - 0.6f * __expf(-0.3f * (float)l);
  const float lam = __uint_as_float(p.counters[32 + l]);

  bf16x8 qf[2][2];
#pragma unroll
  for (int mt = 0; mt < 2; ++mt)
#pragma unroll
    for (int ks = 0; ks < 2; ++ks)
      qf[mt][ks] = *(const bf16x8*)(p.u + (tok0 + rh * 32 + mt * 16 + fr) * US + h * 128 + m * 64 + ks * 32 + fq * 8);
  f32x4 o[2][8];
  float mx[2][4], ls[2][4];
#pragma unroll
  for (int mt = 0; mt < 2; ++mt) {
#pragma unroll
    for (int n = 0; n < 8; ++n) o[mt][n] = (f32x4){0.f, 0.f, 0.f, 0.f};
#pragma unroll
    for (int j = 0; j < 4; ++j) { mx[mt][j] = -1e30f; ls[mt][j] = 0.f; }
  }
  bf16_t* Pw = Ps + wave * 32 * 72;
  const int drow = tid >> 3, dlog = ((tid & 7) ^ ((tid >> 3) & 7)) * 8;
  const bf16_t* Kg = p.u + ((size_t)b * SEQ + (drow & 63)) * US + 512 + h * 128 + dlog;
  const bf16_t* Vg = p.vT + ((size_t)b * 512 + h * 128 + drow) * SEQ + dlog;
  const int rsw = fr & 7;
#define ATT_DMA_K(kt_)                                                                                              \
  _Pragma("unroll") for (int i = 0; i < 4; ++i)                                                                     \
    __builtin_amdgcn_global_load_lds((const unsigned*)(Kg + ((size_t)(kt_) * 64 + (i & 1) * 32) * US + (i >> 1) * 64), \
                                     (unsigned*)(Ks + tid * 8 + i * 2048), 16, 0, 0);
#define ATT_DMA_V(kt_)                                                                                              \
  _Pragma("unroll") for (int i = 0; i < 4; ++i)                                                                     \
    __builtin_amdgcn_global_load_lds((const unsigned*)(Vg + (size_t)(i * 32) * SEQ + (kt_) * 64),                  \
                                     (unsigned*)(Vt + tid * 8 + i * 2048), 16, 0, 0);
  __syncthreads();
  ATT_DMA_K(0)
  for (int kt = 0; kt <= qc; ++kt) {
    asm volatile("s_waitcnt vmcnt(0)" ::: "memory");
    __syncthreads();
    ATT_DMA_V(kt)
    f32x4 s[2][4];
#pragma unroll
    for (int mt = 0; mt < 2; ++mt)
#pragma unroll
      for (int n = 0; n < 4; ++n) s[mt][n] = (f32x4){0.f, 0.f, 0.f, 0.f};
#pragma unroll
    for (int ks = 0; ks < 2; ++ks)
#pragma unroll
      for (int n = 0; n < 4; ++n) {
        const bf16x8 kf = *(const bf16x8*)(Ks + (m * 64 + n * 16 + fr) * 64 + (((ks * 4 + fq) ^ rsw) * 8));
#pragma unroll
        for (int mt = 0; mt < 2; ++mt) s[mt][n] = MFMA(qf[mt][ks], kf, s[mt][n]);
      }
#pragma unroll
    for (int mt = 0; mt < 2; ++mt)
#pragma unroll
      for (int j = 0; j < 4; ++j) {
        float tmax = fmaxf(fmaxf(s[mt][0][j], s[mt][1][j]), fmaxf(s[mt][2][j], s[mt][3][j]));
        tmax = red16_max(tmax);
        const float mnew = fmaxf(mx[mt][j], tmax);
        const float alpha = __expf(mx[mt][j] - mnew);
        float rs = 0.f;
#pragma unroll
        for (int n = 0; n < 4; ++n) {
          const float pv = __expf(s[mt][n][j] - mnew);
          rs += pv;
          Pw[(mt * 16 + fq * 4 + j) * 72 + n * 16 + fr] = f2bf(pv);
        }
        rs = red16_sum(rs);
        ls[mt][j] = ls[mt][j] * alpha + rs;
        mx[mt][j] = mnew;
#pragma unroll
        for (int n = 0; n < 8; ++n) o[mt][n][j] *= alpha;
      }
    asm volatile("s_waitcnt vmcnt(0)" ::: "memory");
    __syncthreads();
    if (kt < qc) { ATT_DMA_K(kt + 1) }
#pragma unroll
    for (int ks = 0; ks < 2; ++ks) {
      bf16x8 pf[2];
#pragma unroll
      for (int mt = 0; mt < 2; ++mt) pf[mt] = *(const bf16x8*)(Pw + (mt * 16 + fr) * 72 + ks * 32 + fq * 8);
#pragma unroll
      for (int n = 0; n < 8; ++n) {
        const bf16x8 vf = *(const bf16x8*)(Vt + (n * 16 + fr) * 64 + (((ks * 4 + fq) ^ rsw) * 8));
#pragma unroll
        for (int mt = 0; mt < 2; ++mt) o[mt][n] = MFMA(pf[mt], vf, o[mt][n]);
      }
    }
  }
#undef ATT_DMA_K
#undef ATT_DMA_V
  __syncthreads();
#pragma unroll
  for (int mt = 0; mt < 2; ++mt)
#pragma unroll
    for (int j = 0; j < 4; ++j) {
      const float inv = 1.f / ls[mt][j];
#pragma unroll
      for (int n = 0; n < 8; ++n) o[mt][n][j] *= inv;
    }
  if (m == 1) {
#pragma unroll
    for (int mt = 0; mt < 2; ++mt)
#pragma unroll
      for (int n = 0; n < 8; ++n)
#pragma unroll
        for (int j = 0; j < 4; ++j) Ox[(rh * 32 + mt * 16 + fq * 4 + j) * 132 + n * 16 + fr] = o[mt][n][j];
  }
  __syncthreads();
  if (m == 0) {
    const float* sw = p.da_subln_w + (size_t)l * 128;
    float wv[8];
#pragma unroll
    for (int n = 0; n < 8; ++n) wv[n] = sw[n * 16 + fr] * (1.f - lam_init);
#pragma unroll
    for (int mt = 0; mt < 2; ++mt)
#pragma unroll
      for (int j = 0; j < 4; ++j) {
        float ss = 0.f;
        float d[8];
#pragma unroll
        for (int n = 0; n < 8; ++n) {
          d[n] = o[mt][n][j] - lam * Ox[(rh * 32 + mt * 16 + fq * 4 + j) * 132 + n * 16 + fr];
          ss += d[n] * d[n];
        }
        ss = red16_sum(ss);
        const float rstd = rsqrtf(ss * (1.f / 128.f) + 1e-6f);
        bf16_t* dst = p.u + (tok0 + rh * 32 + mt * 16 + fq * 4 + j) * US + h * 128 + fr;
#pragma unroll
        for (int n = 0; n < 8; ++n) dst[n * 16] = f2bf(d[n] * rstd * wv[n]);
      }
  }
  __syncthreads();
}

PHASE void hgrn_item(const Params& p, int l, int item, char* smem) {
  const int b = item >> 2, h = item & 3;
  const int tid = opaque_tid(), lane = tid & 63, wave = tid >> 6, fr = lane & 15, fq = lane >> 4;
  bf16_t* Qs = (bf16_t*)smem;
  bf16_t* Kn = Qs + 32 * 136;
  bf16_t* KT = Kn + 32 * 136;
  bf16_t* VT = KT + 128 * 40;
  bf16_t* Ps = VT + 128 * 40;
  bf16_t* ST = Ps + 32 * 40;
  float* lfb = (float*)ST;
  float* red = (float*)(ST + 128 * 136);
  float* blast = red + 64;
  const int t_ = tid >> 3, d0 = (tid & 7) * 16;
  float lbv[16];
#pragma unroll
  for (int i = 0; i < 16; ++i) {
    const int c = h * 128 + d0 + i;
    lbv[i] = (l == 0) ? 0.f : sigm(p.hg_lb[512 + c] - p.hg_lb[c]);
  }
  f32x4 S[2][8];
#pragma unroll
  for (int mm = 0; mm < 2; ++mm)
#pragma unroll
    for (int n = 0; n < 8; ++n) S[mm][n] = (f32x4){0.f, 0.f, 0.f, 0.f};
  const float* nw = p.hg_norm_w + (size_t)l * 128;

  for (int ch = 0; ch < 64; ++ch) {
    const size_t tok0 = (size_t)b * SEQ + (size_t)ch * 32;
    __syncthreads();
    float qv[16], kv[16];
    {
      const bf16_t* base = p.u + (tok0 + t_) * US + h * 128 + d0;
      float zv[16], iv[16];
      { const uint4 a = *(const uint4*)(base + 1024), c = *(const uint4*)(base + 1024 + 8); float* z0 = zv; float* z1 = zv + 8; UNPACK8(a, z0); UNPACK8(c, z1); }
      { const uint4 a = *(const uint4*)(base + 1536), c = *(const uint4*)(base + 1536 + 8); float* z0 = iv; float* z1 = iv + 8; UNPACK8(a, z0); UNPACK8(c, z1); }
      { const uint4 a = *(const uint4*)(base + 2048), c = *(const uint4*)(base + 2048 + 8); float* z0 = qv; float* z1 = qv + 8; UNPACK8(a, z0); UNPACK8(c, z1); }
#pragma unroll
      for (int i = 0; i < 16; ++i) {
        const float z = zv[i], lb = lbv[i];
        const float ez = __expf(-fabsf(z));
        float lf;
        if (lb > 0.f) {
          const float sg = (z >= 0.f) ? 1.f / (1.f + ez) : ez / (1.f + ez);
          lf = __logf(lb + (1.f - lb) * sg);
        } else {
          lf = -(fmaxf(-z, 0.f) + __logf(1.f + ez));
        }
        const float sgn = (z >= 0.f) ? ez / (1.f + ez) : 1.f / (1.f + ez);
        kv[i] = (1.f - lb) * sgn;
        lfb[t_ * 128 + d0 + i] = lf;
        VT[(d0 + i) * 40 + t_] = f2bf(iv[i]);
      }
    }
    __syncthreads();
    if (tid < 128) {
      float v[32];
#pragma unroll
      for (int t = 0; t < 32; ++t) v[t] = lfb[t * 128 + tid];
      float bsum = 0.f;
#pragma unroll
      for (int t = 0; t < 32; ++t) { bsum += v[t]; lfb[t * 128 + tid] = bsum; }
      blast[tid] = bsum;
    }
    __syncthreads();
    {
      float qo[16], ko[16];
#pragma unroll
      for (int i = 0; i < 16; ++i) {
        const float bb = lfb[t_ * 128 + d0 + i];
        qo[i] = qv[i] * __expf(bb);
        ko[i] = kv[i] * __expf(fminf(-bb, 80.f));
        KT[(d0 + i) * 40 + t_] = f2bf(ko[i]);
      }
      float* q0 = qo; float* q1 = qo + 8; float* k0 = ko; float* k1 = ko + 8;
      *(uint4*)(Qs + t_ * 136 + d0) = PACK8(q0);
      *(uint4*)(Qs + t_ * 136 + d0 + 8) = PACK8(q1);
      *(uint4*)(Kn + t_ * 136 + d0) = PACK8(k0);
      *(uint4*)(Kn + t_ * 136 + d0 + 8) = PACK8(k1);
    }
    __syncthreads();
#pragma unroll
    for (int mm = 0; mm < 2; ++mm)
#pragma unroll
      for (int n = 0; n < 8; ++n)
        *(uint2*)(ST + (n * 16 + fr) * 136 + wave * 32 + mm * 16 + fq * 4) =
            make_uint2(pack2(S[mm][n][0], S[mm][n][1]), pack2(S[mm][n][2], S[mm][n][3]));
    {
      const int mt = wave >> 1, nt = wave & 1;
      f32x4 sc = (f32x4){0.f, 0.f, 0.f, 0.f};
#pragma unroll
      for (int ks = 0; ks < 4; ++ks) {
        const bf16x8 a = *(const bf16x8*)(Qs + (mt * 16 + fr) * 136 + ks * 32 + fq * 8);
        const bf16x8 bb = *(const bf16x8*)(Kn + (nt * 16 + fr) * 136 + ks * 32 + fq * 8);
        sc = MFMA(a, bb, sc);
      }
#pragma unroll
      for (int j = 0; j < 4; ++j) {
        const int t = mt * 16 + fq * 4 + j, key = nt * 16 + fr;
        Ps[t * 40 + key] = f2bf(key <= t ? sc[j] : 0.f);
      }
    }
    __syncthreads();
    {
      const int mt = wave & 1, nb = (wave >> 1) * 4;
      f32x4 oo[4];
#pragma unroll
      for (int n = 0; n < 4; ++n) oo[n] = (f32x4){0.f, 0.f, 0.f, 0.f};
      {
        const bf16x8 a = *(const bf16x8*)(Ps + (mt * 16 + fr) * 40 + fq * 8);
#pragma unroll
        for (int n = 0; n < 4; ++n) {
          const bf16x8 bb = *(const bf16x8*)(VT + ((nb + n) * 16 + fr) * 40 + fq * 8);
          oo[n] = MFMA(a, bb, oo[n]);
        }
      }
#pragma unroll
      for (int ks = 0; ks < 4; ++ks) {
        const bf16x8 a = *(const bf16x8*)(Qs + (mt * 16 + fr) * 136 + ks * 32 + fq * 8);
#pragma unroll
        for (int n = 0; n < 4; ++n) {
          const bf16x8 bb = *(const bf16x8*)(ST + ((nb + n) * 16 + fr) * 136 + ks * 32 + fq * 8);
          oo[n] = MFMA(a, bb, oo[n]);
        }
      }
#pragma unroll
      for (int j = 0; j < 4; ++j) {
        float ss = 0.f;
#pragma unroll
        for (int n = 0; n < 4; ++n) ss += oo[n][j] * oo[n][j];
        ss = red16_sum(ss);
        if (fr == 0) red[(mt * 16 + fq * 4 + j) * 2 + (wave >> 1)] = ss;
      }
      __syncthreads();
#pragma unroll
      for (int j = 0; j < 4; ++j) {
        const int t = mt * 16 + fq * 4 + j;
        const float rstd = rsqrtf((red[t * 2] + red[t * 2 + 1]) * (1.f / 128.f) + 1e-6f);
        bf16_t* gp = p.u + (tok0 + t) * US + 2560 + h * 128 + nb * 16 + fr;
#pragma unroll
        for (int n = 0; n < 4; ++n) {
          const float g = bf2f(gp[n * 16]);
          gp[n * 16] = f2bf(oo[n][j] * rstd * nw[(nb + n) * 16 + fr] * (g * sigm(g)));
        }
      }
    }
    {
      bf16x8 af[2];
#pragma unroll
      for (int mm = 0; mm < 2; ++mm) af[mm] = *(const bf16x8*)(KT + (wave * 32 + mm * 16 + fr) * 40 + fq * 8);
#pragma unroll
      for (int n = 0; n < 8; ++n) {
        const bf16x8 bb = *(const bf16x8*)(VT + (n * 16 + fr) * 40 + fq * 8);
#pragma unroll
        for (int mm = 0; mm < 2; ++mm) S[mm][n] = MFMA(af[mm], bb, S[mm][n]);
      }
#pragma unroll
      for (int mm = 0; mm < 2; ++mm)
#pragma unroll
        for (int j = 0; j < 4; ++j) {
          const float e = __expf(blast[wave * 32 + mm * 16 + fq * 4 + j]);
#pragma unroll
          for (int n = 0; n < 8; ++n) S[mm][n][j] *= e;
        }
    }
  }
  __syncthreads();
}

DEV uint4 rw_act(const uint4 cur, const uint4 prv, const float* mul8, int mode) {
  const float4 m0 = *(const float4*)(mul8), m1 = *(const float4*)(mul8 + 4);
  const float mm[8] = {m0.x, m0.y, m0.z, m0.w, m1.x, m1.y, m1.z, m1.w};
  float a[8], b[8], o[8];
  UNPACK8(cur, a); UNPACK8(prv, b);
#pragma unroll
  for (int e = 0; e < 8; ++e) {
    float v = a[e] + (b[e] - a[e]) * mm[e];
    if (mode == 1) { const float t = __expf(-2.f * fabsf(v)); const float th = (1.f - t) / (1.f + t); v = (v >= 0.f) ? th : -th; }
    else if (mode == 2) v = sigm(v);
    o[e] = v;
  }
  return PACK8(o);
}
DEV bf16x8 rw_bfrag(const float* W, int k0, int col) {
  float o[8];
#pragma unroll
  for (int e = 0; e < 8; ++e) o[e] = W[(size_t)(k0 + e) * 512 + col];
  return as_frag(PACK8(o));
}

PHASE void rwkv_item(const Params& p, int l, int item, char* smem) {
  const int b = item >> 3, h = item & 7;
  const int tid = opaque_tid(), lane = tid & 63, wave = tid >> 6, fr = lane & 15, fq = lane >> 4;
  float* R = (float*)smem;
  float* K = R + 2048; float* KK = K + 2048; float* W = KK + 2048; float* BB = W + 2048;
  float* V = BB + 2048; float* G = V + 2048; float* O = G + 2048;
  float* cst = O + 2048;
  float* mul = cst + 512;
  bf16_t* rawL = (bf16_t*)smem;
  float* vloL = (float*)(smem + 17424);
  const float* mu = p.rw_mu + (size_t)l * 1792;
  const int hc_n = h * 64 + wave * 16 + fr;
  bf16x8 w2f[2], a2f[2], g2f[4], v2f;
#pragma unroll
  for (int ks = 0; ks < 2; ++ks) {
    w2f[ks] = rw_bfrag(p.rw_w2 + (size_t)l * 64 * 512, ks * 32 + fq * 8, hc_n);
    a2f[ks] = rw_bfrag(p.rw_a2 + (size_t)l * 64 * 512, ks * 32 + fq * 8, hc_n);
  }
#pragma unroll
  for (int ks = 0; ks < 4; ++ks) g2f[ks] = rw_bfrag(p.rw_g2 + (size_t)l * 128 * 512, ks * 32 + fq * 8, hc_n);
  v2f = w2f[0];
  if (l > 0) v2f = rw_bfrag(p.rw_v2, fq * 8, hc_n);
  const float w0c = p.rw_w0[l * 512 + hc_n], a0c = p.rw_a0[l * 512 + hc_n];
  const float v0c = (l > 0) ? p.rw_v0[hc_n] : 0.f;
  const int t_ = tid >> 3, n0 = (tid & 7) * 8;
  __syncthreads();
  if (tid < 64) {
    const int hc = h * 64 + tid;
    cst[tid] = p.rw_k_k[l * 512 + hc]; cst[64 + tid] = p.rw_k_a[l * 512 + hc]; cst[128 + tid] = p.rw_r_k[l * 512 + hc];
    cst[192 + tid] = p.rw_gn_w[l * 512 + hc]; cst[256 + tid] = p.rw_gn_b[l * 512 + hc];
    cst[320 + tid] = mu[hc]; cst[384 + tid] = mu[512 + hc]; cst[448 + tid] = mu[1024 + hc];
  }
  mul[tid] = mu[1536 + tid];
  const float* kkc = cst + n0; const float* kac = cst + 64 + n0; const float* rkc = cst + 128 + n0;
  const float* gnw = cst + 192 + n0; const float* gnb = cst + 256 + n0;
  const float* mur = cst + 320 + n0; const float* muk = cst + 384 + n0; const float* muv = cst + 448 + n0;
  const int kq = lane & 7, row0 = wave * 16 + (lane >> 3), row1 = row0 + 8;
  f32x2 S0p[4], S1p[4];
#pragma unroll
  for (int e = 0; e < 4; ++e) { S0p[e] = (f32x2){0.f, 0.f}; S1p[e] = (f32x2){0.f, 0.f}; }

  uint4 pl0, pl1, pl2, pl3, pl4, pcr, pck, pcv, ppr, ppk, ppv, pvf;
  float4 pvl;
#define RW_PREFETCH(ch_)                                                                                    \
  {                                                                                                         \
    const size_t tk0 = (size_t)b * SEQ + (size_t)(ch_) * 32;                                                 \
    const bf16_t* lb_ = p.u + (tk0 - 1) * US + 3072 + 1536 + (tid & 31) * 8;                                 \
    const int r0_ = tid >> 5;                                                                               \
    pl0 = make_uint4(0, 0, 0, 0); if (!((ch_) == 0 && r0_ == 0)) pl0 = *(const uint4*)(lb_ + (size_t)r0_ * US); \
    pl1 = *(const uint4*)(lb_ + (size_t)(r0_ + 8) * US);                                                     \
    pl2 = *(const uint4*)(lb_ + (size_t)(r0_ + 16) * US);                                                    \
    pl3 = *(const uint4*)(lb_ + (size_t)(r0_ + 24) * US);                                                    \
    pl4 = make_uint4(0, 0, 0, 0); if (tid < 32) pl4 = *(const uint4*)(lb_ + (size_t)32 * US);                \
    const bf16_t* cu_ = p.u + (tk0 + t_) * US + 3072 + h * 64 + n0;                                          \
    pcr = *(const uint4*)cu_; pck = *(const uint4*)(cu_ + 512); pcv = *(const uint4*)(cu_ + 1024);           \
    if ((ch_) == 0 && t_ == 0) { ppr = make_uint4(0, 0, 0, 0); ppk = ppr; ppv = ppr; }                        \
    else { ppr = *(const uint4*)(cu_ - US); ppk = *(const uint4*)(cu_ - US + 512); ppv = *(const uint4*)(cu_ - US + 1024); } \
    if (l > 0) {                                                                                            \
      pvl = *(const float4*)(p.vlo + (tk0 + (tid >> 3)) * 32 + (tid & 7) * 4);                               \
      pvf = *(const uint4*)(p.vfirst + (tk0 + t_) * 512 + h * 64 + n0);                                      \
    } else { pvl = make_float4(0.f, 0.f, 0.f, 0.f); pvf = make_uint4(0, 0, 0, 0); }                          \
  }
  RW_PREFETCH(0)

  for (int ch = 0; ch < 64; ++ch) {
    const size_t tok0 = (size_t)b * SEQ + (size_t)ch * 32;
    __syncthreads();
    {
      const int r0_ = tid >> 5, cc_ = (tid & 31) * 8;
      *(uint4*)(rawL + r0_ * 264 + cc_) = pl0;
      *(uint4*)(rawL + (r0_ + 8) * 264 + cc_) = pl1;
      *(uint4*)(rawL + (r0_ + 16) * 264 + cc_) = pl2;
      *(uint4*)(rawL + (r0_ + 24) * 264 + cc_) = pl3;
      if (tid < 32) *(uint4*)(rawL + 32 * 264 + cc_) = pl4;
      *(float4*)(vloL + (tid >> 3) * 36 + (tid & 7) * 4) = pvl;
    }
    __syncthreads();
    {
      const int cc_ = (tid & 31) * 8, tr = tid >> 5;
      const int mode = (cc_ < 64) ? 1 : ((cc_ < 128) ? 0 : 2);
      uint4 a0, a1, a2, a3;
      a0 = rw_act(*(const uint4*)(rawL + (tr + 1) * 264 + cc_), *(const uint4*)(rawL + tr * 264 + cc_), mul + cc_, mode);
      a1 = rw_act(*(const uint4*)(rawL + (tr + 9) * 264 + cc_), *(const uint4*)(rawL + (tr + 8) * 264 + cc_), mul + cc_, mode);
      a2 = rw_act(*(const uint4*)(rawL + (tr + 17) * 264 + cc_), *(const uint4*)(rawL + (tr + 16) * 264 + cc_), mul + cc_, mode);
      a3 = rw_act(*(const uint4*)(rawL + (tr + 25) * 264 + cc_), *(const uint4*)(rawL + (tr + 24) * 264 + cc_), mul + cc_, mode);
      __syncthreads();
      *(uint4*)(rawL + tr * 264 + cc_) = a0;
      *(uint4*)(rawL + (tr + 8) * 264 + cc_) = a1;
      *(uint4*)(rawL + (tr + 16) * 264 + cc_) = a2;
      *(uint4*)(rawL + (tr + 24) * 264 + cc_) = a3;
    }
    __syncthreads();
#pragma unroll 1
    for (int mt = 0; mt < 2; ++mt) {
      const int row = mt * 16 + fr;
      const bf16_t* ar = rawL + row * 264 + fq * 8;
      f32x4 aw = (f32x4){0.f, 0.f, 0.f, 0.f}, aa = aw, ag = aw, av = aw;
#pragma unroll
      for (int ks = 0; ks < 2; ++ks) {
        aw = MFMA(*(const bf16x8*)(ar + ks * 32), w2f[ks], aw);
        aa = MFMA(*(const bf16x8*)(ar + 64 + ks * 32), a2f[ks], aa);
      }
#pragma unroll
      for (int ks = 0; ks < 4; ++ks) ag = MFMA(*(const bf16x8*)(ar + 128 + ks * 32), g2f[ks], ag);
      if (l > 0) {
        const float4 x0 = *(const float4*)(vloL + row * 36 + fq * 8), x1 = *(const float4*)(vloL + row * 36 + fq * 8 + 4);
        const uint4 pk = make_uint4(pack2(x0.x, x0.y), pack2(x0.z, x0.w), pack2(x1.x, x1.y), pack2(x1.z, x1.w));
        av = MFMA(as_frag(pk), v2f, av);
      }
#pragma unroll
      for (int j = 0; j < 4; ++j) {
        const int t = mt * 16 + fq * 4 + j, n = wave * 16 + fr;
        const float wv = -(w0c + aw[j]);
        const float sp = fmaxf(wv, 0.f) + __logf(1.f + __expf(-fabsf(wv)));
        const float wl = -sp - 0.5f;
        W[t * 64 + n] = __expf(-__expf(wl));
        BB[t * 64 + n] = sigm(a0c + aa[j]);
        G[t * 64 + n] = ag[j];
        if (l > 0) O[t * 64 + n] = sigm(v0c + av[j]);
      }
    }
    __syncthreads();
    {
      const size_t tok = tok0 + t_;
      float cr[8], ck[8], cv[8], pr[8], pk[8], pv[8];
      UNPACK8(pcr, cr); UNPACK8(pck, ck); UNPACK8(pcv, cv);
      UNPACK8(ppr, pr); UNPACK8(ppk, pk); UNPACK8(ppv, pv);
      float kx[8], kkv[8], vs[8], ss = 0.f;
#pragma unroll
      for (int e = 0; e < 8; ++e) {
        R[t_ * 64 + n0 + e] = cr[e] + (pr[e] - cr[e]) * mur[e];
        kx[e] = ck[e] + (pk[e] - ck[e]) * muk[e];
        vs[e] = cv[e] + (pv[e] - cv[e]) * muv[e];
        kkv[e] = kx[e] * kkc[e]; ss += kkv[e] * kkv[e];
      }
      ss = red8_sum(ss);
      const float rn = rsqrtf(fmaxf(ss, 1e-24f));
#pragma unroll
      for (int e = 0; e < 8; ++e) {
        const float a = BB[t_ * 64 + n0 + e];
        const float kn = kkv[e] * rn;
        K[t_ * 64 + n0 + e] = kx[e] * (1.f + (a - 1.f) * kac[e]);
        KK[t_ * 64 + n0 + e] = kn;
        BB[t_ * 64 + n0 + e] = kn * a;
      }
      if (l == 0) {
        *(uint4*)(p.vfirst + tok * 512 + h * 64 + n0) = PACK8(vs);
      } else {
        float vf[8]; UNPACK8(pvf, vf);
#pragma unroll
        for (int e = 0; e < 8; ++e) vs[e] = vs[e] + (vf[e] - vs[e]) * O[t_ * 64 + n0 + e];
      }
#pragma unroll
      for (int e = 0; e < 8; ++e) V[t_ * 64 + n0 + e] = vs[e];
    }
    __syncthreads();
    if (ch + 1 < 64) RW_PREFETCH(ch + 1)
    asm volatile("" ::: "memory");
#pragma unroll 4
    for (int t = 0; t < 32; ++t) {
      const float* base = R + t * 64 + kq * 8;
      const float4 r0 = *(const float4*)(base), r1 = *(const float4*)(base + 4);
      const float4 k0 = *(const float4*)(base + 2048), k1 = *(const float4*)(base + 2048 + 4);
      const float4 q0 = *(const float4*)(base + 4096), q1 = *(const float4*)(base + 4096 + 4);
      const float4 w0 = *(const float4*)(base + 6144), w1 = *(const float4*)(base + 6144 + 4);
      const float4 b0 = *(const float4*)(base + 8192), b1 = *(const float4*)(base + 8192 + 4);
      const float va = V[t * 64 + row0], vb = V[t * 64 + row1];
      const f32x2 rr[4] = {{r0.x, r0.y}, {r0.z, r0.w}, {r1.x, r1.y}, {r1.z, r1.w}};
      const f32x2 ww[4] = {{w0.x, w0.y}, {w0.z, w0.w}, {w1.x, w1.y}, {w1.z, w1.w}};
      const f32x2 kk_[4] = {{k0.x, k0.y}, {k0.z, k0.w}, {k1.x, k1.y}, {k1.z, k1.w}};
      const f32x2 qq[4] = {{q0.x, q0.y}, {q0.z, q0.w}, {q1.x, q1.y}, {q1.z, q1.w}};
      const f32x2 bb[4] = {{b0.x, b0.y}, {b0.z, b0.w}, {b1.x, b1.y}, {b1.z, b1.w}};
      f32x2 a0 = S0p[0] * qq[0], a1 = S1p[0] * qq[0];
#pragma unroll
      for (int e = 1; e < 4; ++e) { a0 += S0p[e] * qq[e]; a1 += S1p[e] * qq[e]; }
      const float sa0 = -red8_sum(a0.x + a0.y), sa1 = -red8_sum(a1.x + a1.y);
      f32x2 sa0v, sa1v, vav, vbv;
      sa0v.x = sa0; sa0v.y = sa0; sa1v.x = sa1; sa1v.y = sa1; vav.x = va; vav.y = va; vbv.x = vb; vbv.y = vb;
      f32x2 o0v = {0.f, 0.f}, o1v = {0.f, 0.f};
#pragma unroll
      for (int e = 0; e < 4; ++e) {
        S0p[e] = S0p[e] * ww[e] + sa0v * bb[e] + vav * kk_[e];
        S1p[e] = S1p[e] * ww[e] + sa1v * bb[e] + vbv * kk_[e];
        o0v += S0p[e] * rr[e]; o1v += S1p[e] * rr[e];
      }
      const float o0 = red8_sum(o0v.x + o0v.y), o1 = red8_sum(o1v.x + o1v.y);
      if (kq == 0) { O[t * 64 + row0] = o0; O[t * 64 + row1] = o1; }
    }
    asm volatile("s_waitcnt vmcnt(0)" ::: "memory");
    __syncthreads();
    {
      const size_t tok = tok0 + t_;
      float ov[8], s1 = 0.f, bon = 0.f;
#pragma unroll
      for (int e = 0; e < 8; ++e) {
        ov[e] = O[t_ * 64 + n0 + e]; s1 += ov[e];
        bon += R[t_ * 64 + n0 + e] * K[t_ * 64 + n0 + e] * rkc[e];
      }
      s1 = red8_sum(s1); bon = red8_sum(bon);
      const float mean = s1 * (1.f / 64.f);
      float s2 = 0.f;
#pragma unroll
      for (int e = 0; e < 8; ++e) { const float d = ov[e] - mean; s2 += d * d; }
      s2 = red8_sum(s2);
      const float rstd = rsqrtf(s2 * (1.f / 64.f) + 64e-5f);
      float y[8];
#pragma unroll
      for (int e = 0; e < 8; ++e)
        y[e] = ((ov[e] - mean) * rstd * gnw[e] + gnb[e] + bon * V[t_ * 64 + n0 + e]) * G[t_ * 64 + n0 + e];
      *(uint4*)(p.u + tok * US + 3072 + h * 64 + n0) = PACK8(y);
    }
  }
#undef RW_PREFETCH
  __syncthreads();
}

PHASE void phase_mix(const Params& p, int l, char* smem) {
  const int hf = vhalf();
  int* sitem = (int*)(smem - hf * SMEM_BYTES + SMEM_BYTES - 16);
  const int t512 = opaque_tid512();
  while (true) {
    __syncthreads();
    if (t512 == 0) *sitem = (int)atomicAdd(p.counters + l * 4 + 0, 1u);
    __syncthreads();
    const int tk = *sitem;
    if (tk >= 128) break;
    rwkv_item(p, l, tk * 2 + hf, smem);
  }
  while (true) {
    __syncthreads();
    if (t512 == 0) *sitem = (int)atomicAdd(p.counters + l * 4 + 1, 1u);
    __syncthreads();
    const int tk = *sitem;
    if (tk >= 64) break;
    hgrn_item(p, l, tk * 2 + hf, smem);
  }
  while (true) {
    __syncthreads();
    if (t512 == 0) *sitem = (int)atomicAdd(p.counters + l * 4 + 2, 1u);
    __syncthreads();
    const int tk = *sitem;
    if (tk >= 2048) break;
    att_item(p, l, tk * 2 + hf, smem);
  }
}

DEV void gemm_gates(const int tid_in, const bf16_t* A, const bf16_t* Wg, int tn, char* smem, unsigned (&Gp)[4][6][2]) {
  int tid = tid_in; asm volatile("" : "+v"(tid));
  bf16_t* As = (bf16_t*)smem;
  bf16_t* Bs = As + 3 * 4096;
  const int lane = tid & 63, wave = tid >> 6, wr = wave >> 1, wc = wave & 1;
  const int fr = lane & 15, fq = lane >> 4;
  f32x4 acc[4][6];
#pragma unroll
  for (int m = 0; m < 4; ++m)
#pragma unroll
    for (int n = 0; n < 6; ++n) acc[m][n] = (f32x4){0.f, 0.f, 0.f, 0.f};
  const int nk = DM >> 5;
  const int drow = tid >> 2, dphys = tid & 3, dg = (0 - (tid >> 4)) & 3;
  const int cofs = (dphys ^ dg) * 8;
  const unsigned aofs = (unsigned)(drow * DM + cofs);
  unsigned bofs0, bofs1, bofs2;
  {
    int r = drow; int wcb = r / 96, br = (r % 96) >> 5, c = (r % 96) & 31;
    bofs0 = (unsigned)((5376 + br * 1024 + tn * 64 + wcb * 32 + c) * DM + cofs);
    r = drow + 64; wcb = r / 96; br = (r % 96) >> 5; c = (r % 96) & 31;
    bofs1 = (unsigned)((5376 + br * 1024 + tn * 64 + wcb * 32 + c) * DM + cofs);
    r = drow + 128; wcb = r / 96; br = (r % 96) >> 5; c = (r % 96) & 31;
    bofs2 = (unsigned)((5376 + br * 1024 + tn * 64 + wcb * 32 + c) * DM + cofs);
  }
  const int rofs = (fq ^ ((0 - (fr >> 2)) & 3)) * 8;
#define GG_DMA(st, kk)                                                                                       \
  {                                                                                                          \
    __builtin_amdgcn_global_load_lds((const unsigned*)(A + aofs + (kk) * 32), (unsigned*)(As + (st) * 4096 + tid * 8), 16, 0, 0);                     \
    __builtin_amdgcn_global_load_lds((const unsigned*)(A + aofs + 64 * DM + (kk) * 32), (unsigned*)(As + (st) * 4096 + tid * 8 + 2048), 16, 0, 0); \
    __builtin_amdgcn_global_load_lds((const unsigned*)(Wg + bofs0 + (kk) * 32), (unsigned*)(Bs + (st) * 6144 + tid * 8), 16, 0, 0);                    \
    __builtin_amdgcn_global_load_lds((const unsigned*)(Wg + bofs1 + (kk) * 32), (unsigned*)(Bs + (st) * 6144 + tid * 8 + 2048), 16, 0, 0);             \
    __builtin_amdgcn_global_load_lds((const unsigned*)(Wg + bofs2 + (kk) * 32), (unsigned*)(Bs + (st) * 6144 + tid * 8 + 4096), 16, 0, 0);             \
  }
  GG_DMA(0, 0)
  GG_DMA(1, 1)
  int st = 0;
  for (int kt = 0; kt < nk; ++kt) {
    if (kt + 1 < nk) asm volatile("s_waitcnt vmcnt(5)" ::: "memory");
    else asm volatile("s_waitcnt vmcnt(0)" ::: "memory");
    __builtin_amdgcn_s_barrier();
    asm volatile("" ::: "memory");
    const int s2 = (st >= 1) ? st - 1 : 2;
    const bf16_t* Ab = As + st * 4096 + (wr * 64 + fr) * 32 + rofs;
    const bf16_t* Bb = Bs + st * 6144 + (wc * 96 + fr) * 32 + rofs;
    bf16x8 bfr[6], af[4];
#pragma unroll
    for (int n = 0; n < 6; ++n) bfr[n] = *(const bf16x8*)(Bb + n * 512);
#pragma unroll
    for (int m = 0; m < 4; ++m) af[m] = *(const bf16x8*)(Ab + m * 512);
    if (kt + 2 < nk) GG_DMA(s2, kt + 2)
#pragma unroll
    for (int m = 0; m < 4; ++m)
#pragma unroll
      for (int n = 0; n < 6; ++n) acc[m][n] = MFMA(af[m], bfr[n], acc[m][n]);
    st = (st == 2) ? 0 : st + 1;
  }
#undef GG_DMA
  __syncthreads();
#pragma unroll
  for (int m = 0; m < 4; ++m)
#pragma unroll
    for (int n = 0; n < 6; ++n) {
      Gp[m][n][0] = pack2(sigm(acc[m][n][0]), sigm(acc[m][n][1]));
      Gp[m][n][1] = pack2(sigm(acc[m][n][2]), sigm(acc[m][n][3]));
    }
}

PHASE void phase_merge(const Params& p, int l, char* smem) {
  const bf16_t* Wl = p.wt + (size_t)l * WLAYER;
  float* Cs = (float*)smem;
  const int tid = opaque_tid();
  for (int it = 0;; ++it) {
    int tm, tn;
    if (!tile_for(it, 512, 16, tm, tn)) break;
    const size_t row0 = (size_t)tm * 128;
    unsigned Gp[4][6][2];
    gemm_gates(tid, p.h + row0 * DM, Wl + WIN, tn, smem, Gp);
    f32x4 acc[4][2], M[4][2];
#pragma unroll
    for (int m = 0; m < 4; ++m)
#pragma unroll
      for (int n = 0; n < 2; ++n) M[m][n] = (f32x4){0.f, 0.f, 0.f, 0.f};
#pragma unroll
    for (int br = 0; br < 3; ++br) {
      const int aoff = (br == 0) ? 0 : (br == 1 ? 2560 : 3072);
      const size_t woff = (br == 0) ? WBA : (br == 1 ? WBB : WBC);
      gemm_tile<2>(tid, p.u + row0 * US + aoff, US, Wl + woff + (size_t)(tn * 64) * 512, 512, 512, smem, acc);
#pragma unroll
      for (int m = 0; m < 4; ++m)
#pragma unroll
        for (int n = 0; n < 2; ++n) {
          M[m][n][0] += lo16(Gp[m][2 * br + n][0]) * acc[m][n][0];
          M[m][n][1] += hi16(Gp[m][2 * br + n][0]) * acc[m][n][1];
          M[m][n][2] += lo16(Gp[m][2 * br + n][1]) * acc[m][n][2];
          M[m][n][3] += hi16(Gp[m][2 * br + n][1]) * acc[m][n][3];
        }
    }
    stage_acc<2>(tid, Cs, M);
    __syncthreads();
    {
      const int ch = tid & 7;
#pragma unroll 1
      for (int i = 0; i < 4; ++i) {
        const int r = (tid >> 3) + i * 32;
        const float4 a = *(const float4*)(Cs + r * 68 + ch * 8), b = *(const float4*)(Cs + r * 68 + ch * 8 + 4);
        *(uint4*)(p.u + (row0 + r) * US + 1024 + tn * 64 + ch * 8) = make_uint4(pack2(a.x, a.y), pack2(a.z, a.w), pack2(b.x, b.y), pack2(b.z, b.w));
      }
    }
    __syncthreads();
  }
}

PHASE void phase_gemm_res(const bf16_t* A, int lda, const bf16_t* Wt, int K, const float* xin, float* xout,
                        const float* ada_l, int gate_off, char* smem0) {
  const int T = opaque_tid512(), tid = T & 255, hf = vhalf();
  float* Cs = (float*)(smem0 + hf * SMEM_BYTES);
  for (int it = 0;; ++it) {
    int tm, tn;
    if (!tile_for_real(it, 256, 4, tm, tn)) break;
    const size_t row0 = (size_t)tm * 256;
    f32x4 acc[8][4];
    gemm_tile512(T, A + row0 * lda, lda, Wt + (size_t)(tn * 256) * K, K, K, smem0, acc);
    const float* gate = ada_l + (size_t)(row0 / SEQ) * ADAW + gate_off;
    const int c4 = (tid & 31) * 4;
#pragma unroll
    for (int ps = 0; ps < 2; ++ps) {
      if (ps == 0) stage_half512<0>(T, Cs, acc); else stage_half512<1>(T, Cs, acc);
      __syncthreads();
#pragma unroll 1
      for (int i0 = 0; i0 < 16; i0 += 4) {
        float4 xv[4], gv[4], cv[4]; size_t off[4];
#pragma unroll
        for (int ii = 0; ii < 4; ++ii) {
          const int r = (tid >> 5) + (i0 + ii) * 8;
          const int colb = TNC(r) * 128 + c4;
          off[ii] = GROW(r, ps) * DM + colb;
          xv[ii] = *(const float4*)(xin + off[ii]);
          gv[ii] = *(const float4*)(gate + colb);
          cv[ii] = *(const float4*)(Cs + r * 132 + c4);
        }
        asm volatile("" ::: "memory");
#pragma unroll
        for (int ii = 0; ii < 4; ++ii)
          *(float4*)(xout + off[ii]) = make_float4(xv[ii].x + gv[ii].x * cv[ii].x, xv[ii].y + gv[ii].y * cv[ii].y,
                                                   xv[ii].z + gv[ii].z * cv[ii].z, xv[ii].w + gv[ii].w * cv[ii].w);
      }
      __syncthreads();
    }
  }
}

PHASE void phase_ffn_in(const Params& p, int l, char* smem0) {
  const bf16_t* Wt = p.wt + (size_t)l * WLAYER + WFI;
  const int T = opaque_tid512(), tid = T & 255, hf = vhalf();
  float* Cs = (float*)(smem0 + hf * SMEM_BYTES);
  for (int it = 0;; ++it) {
    int tm, tn;
    if (!tile_for_real(it, 256, 22, tm, tn)) break;
    const size_t row0 = (size_t)tm * 256;
    f32x4 acc[8][4];
    gemm_tile512(T, p.h + row0 * DM, DM, Wt + (size_t)(tn * 256) * DM, DM, DM, smem0, acc);
    const int ch = tid & 7;
#pragma unroll
    for (int ps = 0; ps < 2; ++ps) {
      if (ps == 0) stage_half512<0>(T, Cs, acc); else stage_half512<1>(T, Cs, acc);
      __syncthreads();
#pragma unroll 1
      for (int i = 0; i < 4; ++i) {
        const int r = (tid >> 3) + i * 32;
        const float* cp = Cs + r * 132 + ch * 8;
        float o[8];
#pragma unroll
        for (int e = 0; e < 8; ++e) { const float g = cp[e], uu = cp[64 + e]; o[e] = g * sigm(g) * uu; }
        *(uint4*)(p.u + GROW(r, ps) * FFH + TNC(r) * 64 + ch * 8) = PACK8(o);
      }
      __syncthreads();
    }
  }
}

#define XB_TMO      128
#define XB_XCNT(j)  (256  + 64 * (j))
#define XB_XSUB(j)  (1280 + 64 * (j))
#define XB_XGEN(j)  (2304 + 64 * (j))
#define XB_TOP      3328
#define XB_TOPGEN   3392
#define XCD_BAR_WORDS 3456
#define XB_SPIN_CAP (1u << 18)
#define LAS __attribute__((address_space(3)))
DEV unsigned xb_ld(unsigned* p) { return __hip_atomic_load(p, __ATOMIC_RELAXED, __HIP_MEMORY_SCOPE_AGENT); }
DEV unsigned xb_add(unsigned* p, unsigned v) { return __hip_atomic_fetch_add(p, v, __ATOMIC_RELAXED, __HIP_MEMORY_SCOPE_AGENT); }
DEV unsigned xb_xcc_id() { return (unsigned)__builtin_amdgcn_s_getreg((3 << 11) | 20) & 0xFu; }
#define XB_SPIN(cond, bar) do { unsigned _sp = 0; while (cond) { __builtin_amdgcn_s_sleep(1); \
    if ((++_sp & 255u) == 0u) { if (xb_ld(&(bar)[XB_TMO])) break; if (_sp > XB_SPIN_CAP) { atomicAdd(&(bar)[XB_TMO], 1u); break; } } } } while (0)
struct XcdBarrier { unsigned* bar; unsigned x; volatile LAS unsigned* st; };
DEV XcdBarrier xcd_barrier_post(unsigned* bar, volatile LAS unsigned* st) {
  XcdBarrier b; b.bar = bar; b.x = xb_xcc_id(); b.st = st;
  if (threadIdx.x == 0) (void)xb_add(&bar[XB_XCNT(b.x)], 1u);
  return b;
}
DEV void xcd_barrier_complete(unsigned* bar, unsigned x, unsigned& nloc, unsigned& nx) {
  const unsigned G = gridDim.x * gridDim.y * gridDim.z;
  unsigned sum, cnt, mine, sp = 0u;
  for (;;) {
    sum = 0u; cnt = 0u; mine = 0u;
#pragma unroll
    for (unsigned j = 0; j < 16; ++j) { const unsigned c = xb_ld(&bar[XB_XCNT(j)]); sum += c; cnt += (c > 0u) ? 1u : 0u; mine = (j == x) ? c : mine; }
    if (sum == G) break;
    __builtin_amdgcn_s_sleep(1);
    if ((++sp & 255u) == 0u) { if (xb_ld(&bar[XB_TMO])) break; if (sp > XB_SPIN_CAP) { atomicAdd(&bar[XB_TMO], 1u); break; } }
  }
  nloc = mine > 0u ? mine : 1u; nx = cnt > 0u ? cnt : 1u;
}
DEV void xcd_barrier(const XcdBarrier& b) {
  asm volatile("s_waitcnt vmcnt(0)" ::: "memory");
  __syncthreads();
  if (threadIdx.x == 0) {
    unsigned* bar = b.bar;
    __builtin_amdgcn_s_waitcnt(0);
    unsigned nloc = b.st[0], nx = b.st[1];
    if (nloc == 0u) { xcd_barrier_complete(bar, b.x, nloc, nx); b.st[0] = nloc; b.st[1] = nx; }
    const unsigned old = xb_add(&bar[XB_XSUB(b.x)], 1u);
    const unsigned gen = old / nloc;
    if (old + 1u == (gen + 1u) * nloc) {
      __builtin_amdgcn_fence(__ATOMIC_RELEASE, "agent");
      asm volatile("s_waitcnt vmcnt(0)" ::: "memory");
      const unsigned og = xb_add(&bar[XB_TOP], 1u);
      const unsigned tg = og / nx;
      if (og + 1u == (tg + 1u) * nx) xb_add(&bar[XB_TOPGEN], 1u);
      else XB_SPIN(xb_ld(&bar[XB_TOPGEN]) == tg, bar);
      __builtin_amdgcn_fence(__ATOMIC_ACQUIRE, "agent");
      xb_add(&bar[XB_XGEN(b.x)], 1u);
      asm volatile("s_waitcnt vmcnt(0)" ::: "memory");
    } else {
      XB_SPIN(xb_ld(&bar[XB_XGEN(b.x)]) == gen, bar);
      __builtin_amdgcn_fence(__ATOMIC_ACQUIRE, "agent");
      asm volatile("s_waitcnt vmcnt(0)" ::: "memory");
    }
  }
  __syncthreads();
}

__global__ void __launch_bounds__(512, 2) mega(Params p_in, int ph_lo, int ph_hi) {
  extern __shared__ __attribute__((aligned(16))) char smem0[];
  char* smem = smem0 + vhalf() * SMEM_BYTES;
  cg::grid_group grid = cg::this_grid();
  const Params& p = p_in;
  bool first = true;
#define RUN(ph) if ((ph) >= ph_lo && (ph) < ph_hi)
  unsigned epoch = 0;
  __shared__ unsigned xb_words[4];
  if (threadIdx.x < 4) xb_words[threadIdx.x] = 0u;
  __syncthreads();
  XcdBarrier xb;
  xb.bar = p.counters + 256; xb.x = 0u; xb.st = (volatile LAS unsigned*)xb_words;
#define SYNC { if (!first) { ++epoch; if (epoch == 1) { grid.sync(); xb = xcd_barrier_post(p.counters + 256, (volatile LAS unsigned*)xb_words); } else xcd_barrier(xb); } first = false; }
  RUN(0) { SYNC; phase_prep(p, smem); }
#pragma unroll 1
  for (int l = 0; l < 2; ++l) {
    const int base = 1 + 9 * l;
    const float* ada_l = p.ada + (size_t)l * 32 * ADAW;
    const bf16_t* Wl = p.wt + (size_t)l * WLAYER;
    const float* xin = (l == 0) ? p.x : p.out;
    RUN(base + 0) { SYNC; phase_norm(xin, p.norm_mix_w + l * DM, ada_l, 0, 1024, p.h); }
    RUN(base + 1) { SYNC; phase_gemm_in(p, l, smem0); }
    RUN(base + 2) { if (l > 0) { SYNC; phase_vlo(p, l, smem); } }
    RUN(base + 3) { SYNC; phase_mix(p, l, smem); }
    RUN(base + 4) { SYNC; phase_merge(p, l, smem); }
    RUN(base + 5) { SYNC; phase_gemm_res(p.u + 1024, US, Wl + WOUT, DM, xin, p.out, ada_l, 2048, smem0); }
    RUN(base + 6) { SYNC; phase_norm(p.out, p.norm_ffn_w + l * DM, ada_l, 3072, 4096, p.h); }
    RUN(base + 7) { SYNC; phase_ffn_in(p, l, smem0); }
    RUN(base + 8) { SYNC; phase_gemm_res(p.u, FFH, Wl + WFO, FFH, p.out, p.out, ada_l, 5120, smem0); }
  }
  RUN(NPHASE - 1) { SYNC; phase_final(p.out, p.final_norm_w); }
}

extern "C" void kernel_launch(void* const* d_in, const int* in_sizes, int n_in, void* d_out, int out_size, void* d_ws,
                              size_t ws_size, hipStream_t stream) {
  Params p{};
  p.x = (const float*)d_in[0]; p.c = (const float*)d_in[1]; p.pos = (const int*)d_in[2];
  p.ada_w = (const float*)d_in[3]; p.ada_b = (const float*)d_in[4]; p.norm_mix_w = (const float*)d_in[5];
  p.norm_ffn_w = (const float*)d_in[6]; p.w_in = (const float*)d_in[7]; p.da_lambda = (const float*)d_in[8];
  p.da_subln_w = (const float*)d_in[9]; p.hg_lb = (const float*)d_in[10]; p.hg_norm_w = (const float*)d_in[11];
  p.rw_mu = (const float*)d_in[12]; p.rw_w0 = (const float*)d_in[13]; p.rw_w2 = (const float*)d_in[14];
  p.rw_a0 = (const float*)d_in[15]; p.rw_a2 = (const float*)d_in[16]; p.rw_g2 = (const float*)d_in[17];
  p.rw_k_k = (const float*)d_in[18]; p.rw_k_a = (const float*)d_in[19]; p.rw_r_k = (const float*)d_in[20];
  p.rw_gn_w = (const float*)d_in[21]; p.rw_gn_b = (const float*)d_in[22]; p.rw_v0 = (const float*)d_in[23];
  p.rw_v1 = (const float*)d_in[24]; p.rw_v2 = (const float*)d_in[25]; p.w_br_a = (const float*)d_in[26];
  p.w_br_b = (const float*)d_in[27]; p.w_br_c = (const float*)d_in[28]; p.w_out = (const float*)d_in[29];
  p.ffn_w_in = (const float*)d_in[30]; p.ffn_w_out = (const float*)d_in[31]; p.final_norm_w = (const float*)d_in[32];
  p.out = (float*)d_out;
  char* ws = (char*)d_ws;
  size_t off = 0;
  auto take = [&](size_t bytes) { char* r = ws + off; off += (bytes + 255) & ~(size_t)255; return r; };
  p.counters = (unsigned*)take(16384);
  p.wt = (bf16_t*)take(2 * WLAYER * 2);
  p.ada = (float*)take((size_t)2 * 32 * ADAW * 4);
  p.h = (bf16_t*)take((size_t)T_TOK * DM * 2);
  p.u = (bf16_t*)take((size_t)T_TOK * US * 2);
  p.vT = (bf16_t*)take((size_t)T_TOK * 512 * 2);
  p.vfirst = (bf16_t*)take((size_t)T_TOK * 512 * 2);
  p.vlo = (float*)take((size_t)T_TOK * 32 * 4);
  if (off > ws_size) { fprintf(stderr, "workspace too small: need %zu have %zu\n", off, ws_size); return; }

  static int grid_blocks = 0;
  if (!grid_blocks) {
    hipFuncSetAttribute((const void*)mega, hipFuncAttributeMaxDynamicSharedMemorySize, 2 * SMEM_BYTES);
    int dev = 0, cus = 0, per_cu = 0;
    hipGetDevice(&dev);
    hipDeviceGetAttribute(&cus, hipDeviceAttributeMultiprocessorCount, dev);
    hipOccupancyMaxActiveBlocksPerMultiprocessor(&per_cu, mega, 512, 2 * SMEM_BYTES);
    if (per_cu > 1) per_cu = 1;
    if (per_cu < 1) per_cu = 1;
    grid_blocks = cus * per_cu;
  }
#if SINGLE_LAUNCH
  int lo = 0, hi = NPHASE;
  void* args[] = {&p, &lo, &hi};
  hipError_t e = hipLaunchCooperativeKernel((void*)mega, dim3(grid_blocks), dim3(512), args, 2 * SMEM_BYTES, stream);
  if (e != hipSuccess) fprintf(stderr, "cooperative launch failed: %s (grid %d)\n", hipGetErrorString(e), grid_blocks);
#else
  for (int ph = 0; ph < NPHASE; ++ph) {
    if (ph == 3) continue;
    hipLaunchKernelGGL(mega, dim3(grid_blocks), dim3(512), 2 * SMEM_BYTES, stream, p, ph, ph + 1);
  }
#endif
}
```

```cpp
#include <hip/hip_runtime.h>
#include <hip/hip_cooperative_groups.h>
#include <stdint.h>
#include <cstdio>
namespace cg = cooperative_groups;

typedef unsigned short bf16_t;
typedef short bf16x8 __attribute__((ext_vector_type(8)));
typedef float f32x4 __attribute__((ext_vector_type(4)));
typedef float f32x2 __attribute__((ext_vector_type(2)));
#define DEV __device__ __forceinline__
#define PHASE __device__ __forceinline__

#ifndef SINGLE_LAUNCH
#define SINGLE_LAUNCH 1
#endif

constexpr int T_TOK = 65536, DM = 1024, SEQ = 2048, US = 4864, ADAW = 6144, FFH = 2816;
constexpr size_t WIN = 0, WBA = 8650752, WBB = 9175040, WBC = 9699328, WOUT = 10223616, WFI = 11272192,
                 WFO = 17039360, WLAYER = 19922944;
constexpr int SMEM_BYTES = 80896;
constexpr int NPHASE = 20;

struct Params {
  const float* x; const float* c; const int* pos;
  const float *ada_w, *ada_b, *norm_mix_w, *norm_ffn_w, *w_in, *da_lambda, *da_subln_w, *hg_lb, *hg_norm_w;
  const float *rw_mu, *rw_w0, *rw_w2, *rw_a0, *rw_a2, *rw_g2, *rw_k_k, *rw_k_a, *rw_r_k, *rw_gn_w, *rw_gn_b;
  const float *rw_v0, *rw_v1, *rw_v2, *w_br_a, *w_br_b, *w_br_c, *w_out, *ffn_w_in, *ffn_w_out, *final_norm_w;
  float* out;
  bf16_t* wt; float* ada; bf16_t* h; bf16_t* u; bf16_t* vT; bf16_t* vfirst; float* vlo; unsigned* counters;
};

DEV unsigned short f2bf(float f) { return (unsigned short)((__float_as_uint(f) + 0x8000u) >> 16); }
DEV float bf2f(unsigned short h) { return __uint_as_float(((unsigned)h) << 16); }
DEV unsigned pack2(float a, float b) {
  return __builtin_amdgcn_perm(__float_as_uint(b) + 0x8000u, __float_as_uint(a) + 0x8000u, 0x07060302u);
}
DEV float sigm(float x) { return 1.f / (1.f + __expf(-x)); }
DEV float lo16(unsigned v) { return __uint_as_float(v << 16); }
DEV float hi16(unsigned v) { return __uint_as_float(v & 0xFFFF0000u); }
#define UNPACK8(v, f) { f[0]=lo16(v.x); f[1]=hi16(v.x); f[2]=lo16(v.y); f[3]=hi16(v.y); f[4]=lo16(v.z); f[5]=hi16(v.z); f[6]=lo16(v.w); f[7]=hi16(v.w); }
#define PACK8(f) make_uint4(pack2(f[0],f[1]), pack2(f[2],f[3]), pack2(f[4],f[5]), pack2(f[6],f[7]))
template <int CTRL> DEV float dpp(float x) { return __int_as_float(__builtin_amdgcn_update_dpp(0, __float_as_int(x), CTRL, 0xF, 0xF, true)); }
DEV float red8_sum(float x) { x += dpp<0xB1>(x); x += dpp<0x4E>(x); x += dpp<0x141>(x); return x; }
DEV float red16_sum(float x) { x = red8_sum(x); x += dpp<0x140>(x); return x; }
DEV float red16_max(float x) { x = fmaxf(x, dpp<0xB1>(x)); x = fmaxf(x, dpp<0x4E>(x)); x = fmaxf(x, dpp<0x141>(x)); x = fmaxf(x, dpp<0x140>(x)); return x; }
DEV float wave_sum(float x) {
  x = red16_sum(x);
  const int xi = __float_as_int(x);
  return __int_as_float(__builtin_amdgcn_readlane(xi, 0)) + __int_as_float(__builtin_amdgcn_readlane(xi, 16)) +
         __int_as_float(__builtin_amdgcn_readlane(xi, 32)) + __int_as_float(__builtin_amdgcn_readlane(xi, 48));
}
DEV int opaque_tid() { int t = threadIdx.x & 255; asm volatile("" : "+v"(t)); return t; }
DEV int opaque_tid512() { int t = threadIdx.x; asm volatile("" : "+v"(t)); return t; }
DEV int vhalf() { return __builtin_amdgcn_readfirstlane((int)(threadIdx.x >> 8)); }
DEV int vblock() { return (int)blockIdx.x * 2 + vhalf(); }
DEV int vgrid() { return (int)gridDim.x * 2; }
DEV bf16x8 as_frag(uint4 v) { union { uint4 u; bf16x8 b; } c; c.u = v; return c.b; }
#define MFMA(a, b, c) __builtin_amdgcn_mfma_f32_16x16x32_bf16(a, b, c, 0, 0, 0)

template <int NT>
DEV void gemm_tile(const int tid_in, const bf16_t* A, int lda, const bf16_t* B, int ldb, int K, char* smem,
                   f32x4 (&acc)[4][NT]) {
  int tid = tid_in; asm volatile("" : "+v"(tid));
  constexpr int BN = NT * 32;
  constexpr int LS = 64;
  bf16_t* As = (bf16_t*)smem;
  bf16_t* Bs = As + 2 * 128 * LS;
  const int lane = tid & 63, wave = tid >> 6, wr = wave >> 1, wc = wave & 1;
  const int fr = lane & 15, fq = lane >> 4;
  constexpr int NB = BN * 8 / 256;
#pragma unroll
  for (int m = 0; m < 4; ++m)
#pragma unroll
    for (int n = 0; n < NT; ++n) acc[m][n] = (f32x4){0.f, 0.f, 0.f, 0.f};
  const int nk = K >> 6;
  const int lrow = tid >> 3, lcc = tid & 7;
  const bf16_t* Ap = A + (size_t)lrow * lda + ((lcc ^ (lrow & 7)) * 8);
  const bf16_t* Bp = B + (size_t)lrow * ldb + ((lcc ^ (lrow & 7)) * 8);
  const size_t a32 = (size_t)32 * lda, b32 = (size_t)32 * ldb;
  const int rofs0 = (fq ^ (fr & 7)) * 8, rofs1 = rofs0 ^ 32;
#define GT_DMA(buf, koff)                                                                                    \
  {                                                                                                          \
    bf16_t* Ad = As + (buf) * 128 * LS + tid * 8;                                                            \
    bf16_t* Bd = Bs + (buf) * BN * LS + tid * 8;                                                             \
    _Pragma("unroll") for (int i = 0; i < 4; ++i)                                                            \
      __builtin_amdgcn_global_load_lds((const unsigned*)(Ap + i * a32 + (koff)), (unsigned*)(Ad + i * 32 * LS), 16, 0, 0); \
    _Pragma("unroll") for (int i = 0; i < NB; ++i)                                                           \
      __builtin_amdgcn_global_load_lds((const unsigned*)(Bp + i * b32 + (koff)), (unsigned*)(Bd + i * 32 * LS), 16, 0, 0); \
  }
  GT_DMA(0, 0)
  asm volatile("s_waitcnt vmcnt(0)" ::: "memory");
  __syncthreads();
  for (int kt = 0; kt < nk; ++kt) {
    const int buf = kt & 1;
    if (kt + 1 < nk) GT_DMA(buf ^ 1, (kt + 1) * 64)
    const bf16_t* Ab = As + buf * 128 * LS + (wr * 64 + fr) * LS;
    const bf16_t* Bb = Bs + buf * BN * LS + (wc * (NT * 16) + fr) * LS;
#pragma unroll
    for (int ks = 0; ks < 2; ++ks) {
      const int ro = ks ? rofs1 : rofs0;
      bf16x8 af[4], bfr[NT];
#pragma unroll
      for (int m = 0; m < 4; ++m) af[m] = *(const bf16x8*)(Ab + m * 16 * LS + ro);
#pragma unroll
      for (int n = 0; n < NT; ++n) bfr[n] = *(const bf16x8*)(Bb + n * 16 * LS + ro);
#pragma unroll
      for (int m = 0; m < 4; ++m)
#pragma unroll
        for (int n = 0; n < NT; ++n) acc[m][n] = MFMA(af[m], bfr[n], acc[m][n]);
    }
    asm volatile("s_waitcnt vmcnt(0)" ::: "memory");
    __syncthreads();
  }
#undef GT_DMA
}

template <int NT>
DEV void stage_acc(const int tid, float* Cs, const f32x4 (&acc)[4][NT]) {
  constexpr int LDC = NT * 32 + 4;
  const int lane = tid & 63, wave = tid >> 6, wr = wave >> 1, wc = wave & 1, fr = lane & 15, fq = lane >> 4;
#pragma unroll
  for (int m = 0; m < 4; ++m)
#pragma unroll
    for (int n = 0; n < NT; ++n)
#pragma unroll
      for (int j = 0; j < 4; ++j) Cs[(wr * 64 + m * 16 + fq * 4 + j) * LDC + wc * (NT * 16) + n * 16 + fr] = acc[m][n][j];
}

DEV void gemm_tile256(const int tid, const bf16_t* A, int lda, const bf16_t* B, int ldb, int K, char* smem,
                      f32x4 (&acc)[8][4]) {
  bf16_t* As = (bf16_t*)smem;
  bf16_t* Bs = As + 3 * 8192;
  const int lane = tid & 63, wave = tid >> 6, wr = wave >> 1, wc = wave & 1;
  const int fr = lane & 15, fq = lane >> 4;
#pragma unroll
  for (int m = 0; m < 8; ++m)
#pragma unroll
    for (int n = 0; n < 4; ++n) acc[m][n] = (f32x4){0.f, 0.f, 0.f, 0.f};
  const int nk = K >> 5;
  const int drow = tid >> 2, dphys = tid & 3, dg = (0 - (tid >> 4)) & 3;
  const bf16_t* Ap = A + (size_t)drow * lda + ((dphys ^ dg) * 8);
  const bf16_t* Bp = B + (size_t)drow * ldb + ((dphys ^ dg) * 8);
  const size_t a64 = (size_t)64 * lda, b64 = (size_t)64 * ldb;
  const int rofs = (fq ^ ((0 - (fr >> 2)) & 3)) * 8;
#define G2_DMA(st, kk)                                                                                        \
  {                                                                                                           \
    bf16_t* Ad = As + (st) * 8192 + tid * 8;                                                                  \
    bf16_t* Bd = Bs + (st) * 4096 + tid * 8;                                                                  \
    _Pragma("unroll") for (int i = 0; i < 4; ++i)                                                             \
      __builtin_amdgcn_global_load_lds((const unsigned*)(Ap + i * a64 + (kk) * 32), (unsigned*)(Ad + i * 2048), 16, 0, 0); \
    _Pragma("unroll") for (int i = 0; i < 2; ++i)                                                             \
      __builtin_amdgcn_global_load_lds((const unsigned*)(Bp + i * b64 + (kk) * 32), (unsigned*)(Bd + i * 2048), 16, 0, 0); \
  }
  G2_DMA(0, 0)
  G2_DMA(1, 1)
  int st = 0;
  for (int kt = 0; kt < nk; ++kt) {
    if (kt + 1 < nk) asm volatile("s_waitcnt vmcnt(6)" ::: "memory");
    else asm volatile("s_waitcnt vmcnt(0)" ::: "memory");
    __builtin_amdgcn_s_barrier();
    asm volatile("" ::: "memory");
    const int s2 = (st >= 1) ? st - 1 : 2;
    const bool pf = (kt + 2 < nk);
    bf16_t* Ad = As + s2 * 8192 + tid * 8;
    bf16_t* Bd = Bs + s2 * 4096 + tid * 8;
    const bf16_t* Asrc = Ap + (kt + 2) * 32;
    const bf16_t* Bsrc = Bp + (kt + 2) * 32;
    const bf16_t* Ab = As + st * 8192 + (wr * 128 + fr) * 32 + rofs;
    const bf16_t* Bb = Bs + st * 4096 + (wc * 64 + fr) * 32 + rofs;
    bf16x8 bfr[4], af[4];
#pragma unroll
    for (int n = 0; n < 4; ++n) bfr[n] = *(const bf16x8*)(Bb + n * 512);
#pragma unroll
    for (int m = 0; m < 4; ++m) af[m] = *(const bf16x8*)(Ab + m * 512);
#pragma unroll
    for (int m = 0; m < 8; ++m) {
#pragma unroll
      for (int n = 0; n < 4; ++n) acc[m][n] = MFMA(af[m & 3], bfr[n], acc[m][n]);
      if (m + 4 < 8) af[m & 3] = *(const bf16x8*)(Ab + (m + 4) * 512);
      if (pf) {
        if (m < 4) __builtin_amdgcn_global_load_lds((const unsigned*)(Asrc + m * a64), (unsigned*)(Ad + m * 2048), 16, 0, 0);
        else if (m < 6) __builtin_amdgcn_global_load_lds((const unsigned*)(Bsrc + (m - 4) * b64), (unsigned*)(Bd + (m - 4) * 2048), 16, 0, 0);
      }
      __builtin_amdgcn_sched_barrier(0);
    }
    st = (st == 2) ? 0 : st + 1;
  }
#undef G2_DMA
  __syncthreads();
}

template <int PS>
DEV void stage_half(const int tid, float* Cs, const f32x4 (&acc)[8][4]) {
  const int lane = tid & 63, wave = tid >> 6, wr = wave >> 1, wc = wave & 1, fr = lane & 15, fq = lane >> 4;
#pragma unroll
  for (int m = 0; m < 4; ++m)
#pragma unroll
    for (int n = 0; n < 4; ++n)
#pragma unroll
      for (int j = 0; j < 4; ++j) Cs[(wr * 64 + m * 16 + fq * 4 + j) * 132 + wc * 64 + n * 16 + fr] = acc[PS * 4 + m][n][j];
}
#define RMAP(r, ps) ((((r) >> 6) << 7) + (ps) * 64 + ((r) & 63))

DEV void gemm_tile512(const int T, const bf16_t* A, int lda, const bf16_t* B, int ldb, int K, char* smem0,
                      f32x4 (&acc)[8][4]) {
  bf16_t* As = (bf16_t*)smem0;
  bf16_t* Bs = As + 2 * 16384;
  const int lane = T & 63, wave = T >> 6, wr = wave >> 2, wc = wave & 3;
  const int fr = lane & 15, fq = lane >> 4;
#pragma unroll
  for (int m = 0; m < 8; ++m)
#pragma unroll
    for (int n = 0; n < 4; ++n) acc[m][n] = (f32x4){0.f, 0.f, 0.f, 0.f};
  const int nk = K >> 6;
  const int drow = T >> 3, dlog = ((T & 7) ^ ((T >> 3) & 7)) * 8;
  const bf16_t* Ap = A + (size_t)drow * lda + dlog;
  const bf16_t* Bp = B + (size_t)drow * ldb + dlog;
  const size_t a64 = (size_t)64 * lda, b64 = (size_t)64 * ldb;
  const int rofs0 = (fq ^ (fr & 7)) * 8, rofs1 = rofs0 ^ 32;
#pragma unroll
  for (int i = 0; i < 4; ++i) {
    __builtin_amdgcn_global_load_lds((const unsigned*)(Ap + i * a64), (unsigned*)(As + T * 8 + i * 4096), 16, 0, 0);
    __builtin_amdgcn_global_load_lds((const unsigned*)(Bp + i * b64), (unsigned*)(Bs + T * 8 + i * 4096), 16, 0, 0);
  }
  asm volatile("s_waitcnt vmcnt(0)" ::: "memory");
  __syncthreads();
  for (int kt = 0; kt < nk; ++kt) {
    const int buf = kt & 1;
    const bool pf = (kt + 1 < nk);
    bf16_t* Ad = As + (buf ^ 1) * 16384 + T * 8;
    bf16_t* Bd = Bs + (buf ^ 1) * 16384 + T * 8;
    const bf16_t* Asrc = Ap + (kt + 1) * 64;
    const bf16_t* Bsrc = Bp + (kt + 1) * 64;
    const bf16_t* Ab = As + buf * 16384 + (wr * 128 + fr) * 64;
    const bf16_t* Bb = Bs + buf * 16384 + (wc * 64 + fr) * 64;
#pragma unroll
    for (int ks = 0; ks < 2; ++ks) {
      const int ro = ks ? rofs1 : rofs0;
      bf16x8 bfr[4], af[4];
#pragma unroll
      for (int n = 0; n < 4; ++n) bfr[n] = *(const bf16x8*)(Bb + n * 1024 + ro);
#pragma unroll
      for (int m = 0; m < 4; ++m) af[m] = *(const bf16x8*)(Ab + m * 1024 + ro);
#pragma unroll
      for (int m = 0; m < 8; ++m) {
#pragma unroll
        for (int n = 0; n < 4; ++n) acc[m][n] = MFMA(af[m & 3], bfr[n], acc[m][n]);
        if (m + 4 < 8) af[m & 3] = *(const bf16x8*)(Ab + (m + 4) * 1024 + ro);
        if (pf && ks == 0 && m < 4) {
          __builtin_amdgcn_global_load_lds((const unsigned*)(Asrc + m * a64), (unsigned*)(Ad + m * 4096), 16, 0, 0);
          __builtin_amdgcn_global_load_lds((const unsigned*)(Bsrc + m * b64), (unsigned*)(Bd + m * 4096), 16, 0, 0);
        }
        __builtin_amdgcn_sched_barrier(0);
      }
    }
    asm volatile("s_waitcnt vmcnt(0)" ::: "memory");
    __builtin_amdgcn_s_barrier();
    asm volatile("" ::: "memory");
  }
  __syncthreads();
}
template <int PS>
DEV void stage_half512(const int T, float* Cs, const f32x4 (&acc)[8][4]) {
  const int lane = T & 63, wave = T >> 6, wc = wave & 3, fr = lane & 15, fq = lane >> 4;
#pragma unroll
  for (int m = 0; m < 4; ++m)
#pragma unroll
    for (int n = 0; n < 4; ++n)
#pragma unroll
      for (int j = 0; j < 4; ++j) Cs[((wc >> 1) * 64 + m * 16 + fq * 4 + j) * 132 + (wc & 1) * 64 + n * 16 + fr] = acc[PS * 4 + m][n][j];
}
#define GROW(r, ps) (row0 + (size_t)(hf * 128 + (ps) * 64 + ((r) & 63)))
#define TNC(r) (tn * 2 + ((r) >> 6))

DEV bool tile_for(int it, int nM, int nN, int& tm, int& tn) {
  const int nx = (gridDim.x >> 3) * 2;
  const int xcd = blockIdx.x & 7, local = (blockIdx.x >> 3) * 2 + vhalf();
  const long id = ((long)it * 8 + xcd) * nx + local;
  if (local >= nx || id >= (long)nM * nN) return false;
  const int per_group = 8 * nN;
  const int g = (int)(id / per_group), r = (int)(id % per_group);
  tn = r >> 3; tm = g * 8 + (r & 7);
  return true;
}

DEV bool tile_for_real(int it, int nM, int nN, int& tm, int& tn) {
  const int nx = (gridDim.x >> 3);
  const int xcd = blockIdx.x & 7, local = (blockIdx.x >> 3);
  const long id = ((long)it * 8 + xcd) * nx + local;
  if (local >= nx || id >= (long)nM * nN) return false;
  const int per_group = 8 * nN;
  const int g = (int)(id / per_group), r = (int)(id % per_group);
  tn = r >> 3; tm = g * 8 + (r & 7);
  return true;
}

PHASE void phase_prep(const Params& p, char* smem) {
  const int tid = opaque_tid();
  const int vb = vblock(), vg = vgrid();
  if (vb == 0 && tid < 8) p.counters[tid] = 0u;
  if (vb == 1 && tid < 2) {
    const float* lv = p.da_lambda + (size_t)tid * 256;
    float d1 = 0.f, d2 = 0.f;
    for (int i = 0; i < 64; ++i) { d1 += lv[i] * lv[64 + i]; d2 += lv[128 + i] * lv[192 + i]; }
    p.counters[32 + tid] = __float_as_uint(__expf(d1) - __expf(d2) + (0.8f - 0.6f * __expf(-0.3f * (float)tid)));
  }
  if (vb == 0) for (int i = tid; i < 3456; i += 256) p.counters[256 + i] = 0u;
  float* tile = (float*)smem;
  const int NCONV = 2 * 4864, NADA = 192;
  for (int item0 = vb; item0 < NCONV + NADA; item0 += vg) {
    const int item = (item0 < NADA) ? (NCONV + item0) : (item0 - NADA);
    if (item < NCONV) {
      const int l = item / 4864; int r = item % 4864;
      const float* src; int K, Nsrc, nT, perm = 0; size_t dst;
      if (r < 2112) { src = p.w_in + (size_t)l * 1024 * 8448; K = 1024; Nsrc = 8448; dst = WIN; nT = 132; }
      else if (r < 2240) { r -= 2112; src = p.w_br_a + (size_t)l * 512 * 1024; K = 512; Nsrc = 1024; dst = WBA; nT = 16; }
      else if (r < 2368) { r -= 2240; src = p.w_br_b + (size_t)l * 512 * 1024; K = 512; Nsrc = 1024; dst = WBB; nT = 16; }
      else if (r < 2496) { r -= 2368; src = p.w_br_c + (size_t)l * 512 * 1024; K = 512; Nsrc = 1024; dst = WBC; nT = 16; }
      else if (r < 2752) { r -= 2496; src = p.w_out + (size_t)l * 1024 * 1024; K = 1024; Nsrc = 1024; dst = WOUT; nT = 16; }
      else if (r < 4160) { r -= 2752; src = p.ffn_w_in + (size_t)l * 1024 * 5632; K = 1024; Nsrc = 5632; dst = WFI; nT = 88; perm = 1; }
      else { r -= 4160; src = p.ffn_w_out + (size_t)l * 2816 * 1024; K = 2816; Nsrc = 1024; dst = WFO; nT = 16; }
      const int kt = r / nT, nt = r % nT;
      const int colbase = perm ? ((nt & 1) * FFH + 64 * (nt >> 1)) : nt * 64;
      __syncthreads();
#pragma unroll
      for (int i = 0; i < 16; ++i) {
        const int k = i * 4 + (tid >> 6), j = tid & 63;
        tile[k * 65 + j] = src[(size_t)(kt * 64 + k) * Nsrc + colbase + j];
      }
      __syncthreads();
      const int row = tid >> 2, kc = (tid & 3) * 16;
      float f[16];
#pragma unroll
      for (int i = 0; i < 16; ++i) f[i] = tile[(kc + i) * 65 + row];
      bf16_t* d = p.wt + (size_t)l * WLAYER + dst + (size_t)(nt * 64 + row) * K + kt * 64 + kc;
      *(uint4*)d = make_uint4(pack2(f[0], f[1]), pack2(f[2], f[3]), pack2(f[4], f[5]), pack2(f[6], f[7]));
      *(uint4*)(d + 8) = make_uint4(pack2(f[8], f[9]), pack2(f[10], f[11]), pack2(f[12], f[13]), pack2(f[14], f[15]));
    } else {
      const int a = item - NCONV;
      const int l = a / 96, r = a % 96, ntile = r >> 2, bg = r & 3;
      float* cact = (float*)smem;
      __syncthreads();
      for (int i = tid; i < 8 * 1024; i += 256) {
        const float cv = p.c[(size_t)(bg * 8 + (i >> 10)) * DM + (i & 1023)];
        cact[i] = cv * sigm(cv);
      }
      __syncthreads();
      const int n = ntile * 256 + tid;
      const float* W = p.ada_w + (size_t)l * DM * ADAW + n;
      float acc[8];
#pragma unroll
      for (int b = 0; b < 8; ++b) acc[b] = 0.f;
      for (int k0 = 0; k0 < DM; k0 += 16) {
        float w[16];
#pragma unroll
        for (int kk = 0; kk < 16; ++kk) w[kk] = W[(size_t)(k0 + kk) * ADAW];
#pragma unroll
        for (int kk = 0; kk < 16; ++kk)
#pragma unroll
          for (int b = 0; b < 8; ++b) acc[b] += cact[b * 1024 + k0 + kk] * w[kk];
      }
      const float bias = p.ada_b[l * ADAW + n];
#pragma unroll
      for (int b = 0; b < 8; ++b) p.ada[((size_t)l * 32 + bg * 8 + b) * ADAW + n] = acc[b] + bias;
    }
  }
}

PHASE void phase_norm(const float* __restrict__ x, const float* __restrict__ w, const float* __restrict__ ada_l,
                    int shift_off, int scale_off, bf16_t* __restrict__ h) {
  const int tid = opaque_tid();
  const int lane = tid & 63, wave = tid >> 6;
  for (int row0 = (vblock() * 4 + wave) * 4; row0 < T_TOK; row0 += vgrid() * 16) {
    float4 v[4][4]; float ss[4];
#pragma unroll
    for (int rr = 0; rr < 4; ++rr)
#pragma unroll
      for (int i = 0; i < 4; ++i) v[rr][i] = *(const float4*)(x + (size_t)(row0 + rr) * DM + i * 256 + lane * 4);
#pragma unroll
    for (int rr = 0; rr < 4; ++rr) {
      float a = 0.f;
#pragma unroll
      for (int i = 0; i < 4; ++i) a += v[rr][i].x * v[rr][i].x + v[rr][i].y * v[rr][i].y + v[rr][i].z * v[rr][i].z + v[rr][i].w * v[rr][i].w;
      ss[rr] = rsqrtf(wave_sum(a) * (1.f / DM) + 1e-6f);
    }
    const float* ad = ada_l + (size_t)(row0 / SEQ) * ADAW;
#pragma unroll
    for (int i = 0; i < 4; ++i) {
      const int col = i * 256 + lane * 4;
      const float4 ww = *(const float4*)(w + col), sc = *(const float4*)(ad + scale_off + col), sh = *(const float4*)(ad + shift_off + col);
#pragma unroll
      for (int rr = 0; rr < 4; ++rr) {
        const float rstd = ss[rr];
        const float o0 = v[rr][i].x * rstd * ww.x * (1.f + sc.x) + sh.x, o1 = v[rr][i].y * rstd * ww.y * (1.f + sc.y) + sh.y;
        const float o2 = v[rr][i].z * rstd * ww.z * (1.f + sc.z) + sh.z, o3 = v[rr][i].w * rstd * ww.w * (1.f + sc.w) + sh.w;
        *(uint2*)(h + (size_t)(row0 + rr) * DM + col) = make_uint2(pack2(o0, o1), pack2(o2, o3));
      }
    }
  }
}

PHASE void phase_final(float* __restrict__ x, const float* __restrict__ w) {
  const int tid = opaque_tid();
  const int lane = tid & 63, wave = tid >> 6;
  for (int row0 = (vblock() * 4 + wave) * 4; row0 < T_TOK; row0 += vgrid() * 16) {
    float4 v[4][4]; float ss[4];
#pragma unroll
    for (int rr = 0; rr < 4; ++rr)
#pragma unroll
      for (int i = 0; i < 4; ++i) v[rr][i] = *(const float4*)(x + (size_t)(row0 + rr) * DM + i * 256 + lane * 4);
#pragma unroll
    for (int rr = 0; rr < 4; ++rr) {
      float a = 0.f;
#pragma unroll
      for (int i = 0; i < 4; ++i) a += v[rr][i].x * v[rr][i].x + v[rr][i].y * v[rr][i].y + v[rr][i].z * v[rr][i].z + v[rr][i].w * v[rr][i].w;
      ss[rr] = rsqrtf(wave_sum(a) * (1.f / DM) + 1e-6f);
    }
#pragma unroll
    for (int i = 0; i < 4; ++i) {
      const int col = i * 256 + lane * 4;
      const float4 ww = *(const float4*)(w + col);
#pragma unroll
      for (int rr = 0; rr < 4; ++rr) {
        const float rstd = ss[rr];
        *(float4*)(x + (size_t)(row0 + rr) * DM + col) =
            make_float4(v[rr][i].x * rstd * ww.x, v[rr][i].y * rstd * ww.y, v[rr][i].z * rstd * ww.z, v[rr][i].w * rstd * ww.w);
      }
    }
  }
}

PHASE void phase_gemm_in(const Params& p, int l, char* smem0) {
  const bf16_t* Wt = p.wt + (size_t)l * WLAYER + WIN;
  const int T = opaque_tid512(), tid = T & 255, hf = vhalf();
  float* Cs = (float*)(smem0 + hf * SMEM_BYTES);
  for (int it = 0;; ++it) {
    int tm, tn;
    if (!tile_for_real(it, 256, 21, tm, tn)) break;
    f32x4 acc[8][4];
    gemm_tile512(T, p.h + (size_t)tm * 256 * DM, DM, Wt + (size_t)tn * 256 * DM, DM, DM, smem0, acc);
    const size_t row0 = (size_t)tm * 256;
#pragma unroll
    for (int ps = 0; ps < 2; ++ps) {
      if (ps == 0) stage_half512<0>(T, Cs, acc); else stage_half512<1>(T, Cs, acc);
      __syncthreads();
      if (tn < 4) {
        const float qs = (tn < 2) ? 0.125f : 1.f;
        const int ch = tid & 15, g = ch >> 3, cc = ch & 7;
        if (cc < 4) {
#pragma unroll 1
          for (int i = 0; i < 8; ++i) {
            const int r = (tid >> 4) + i * 16;
            const size_t grow = GROW(r, ps);
            const float pos = (float)p.pos[grow];
            const float* c1 = Cs + r * 132 + g * 64 + cc * 8;
            float o1[8], o2[8];
#pragma unroll
            for (int e = 0; e < 8; ++e) {
              const float x1 = c1[e], x2 = c1[32 + e];
              const float inv = exp2f(-(float)(cc * 8 + e) * 0.41524101186092029f);
              float rev = pos * inv * 0.15915494309189535f;
              rev -= rintf(rev);
              const float sn = __builtin_amdgcn_sinf(rev), cs = __builtin_amdgcn_cosf(rev);
              o1[e] = (x1 * cs - x2 * sn) * qs; o2[e] = (x2 * cs + x1 * sn) * qs;
            }
            bf16_t* d = p.u + grow * US + TNC(r) * 128 + g * 64 + cc * 8;
            *(uint4*)d = PACK8(o1);
            *(uint4*)(d + 32) = PACK8(o2);
          }
        }
      } else if (tn < 6) {
        const int b = (int)(row0 / SEQ), s0 = (int)(row0 % SEQ);
        const int rch = tid & 15;
        const int vc0 = (TNC(rch * 8) - 8) * 128;
#pragma unroll 1
        for (int i = 0; i < 8; ++i) {
          const int c = (tid >> 4) + i * 16;
          float f[8];
#pragma unroll
          for (int j = 0; j < 8; ++j) f[j] = Cs[(rch * 8 + j) * 132 + c];
          *(uint4*)(p.vT + ((size_t)b * 512 + vc0 + c) * SEQ + s0 + hf * 128 + ps * 64 + ((rch * 8) & 63)) = PACK8(f);
        }
      } else {
        const int ch = tid & 15;
#pragma unroll 1
        for (int i = 0; i < 8; ++i) {
          const int r = (tid >> 4) + i * 16;
          const float4 a = *(const float4*)(Cs + r * 132 + ch * 8), b = *(const float4*)(Cs + r * 132 + ch * 8 + 4);
          *(uint4*)(p.u + GROW(r, ps) * US + TNC(r) * 128 - 512 + ch * 8) = make_uint4(pack2(a.x, a.y), pack2(a.z, a.w), pack2(b.x, b.y), pack2(b.z, b.w));
        }
      }
      __syncthreads();
    }
  }
}

PHASE void phase_vlo(const Params& p, int l, char* smem) {
  float* vs = (float*)smem;
  const int tid = opaque_tid();
  const float* mu = p.rw_mu + (size_t)l * 1792 + 1024;
  const float* v1 = p.rw_v1;
  for (int item = vblock(); item < T_TOK / 32; item += vgrid()) {
    const size_t tok0 = (size_t)item * 32;
    __syncthreads();
#pragma unroll 1
    for (int i = 0; i < 8; ++i) {
      const int c = tid + i * 256;
      const int t = c >> 6, cc = c & 63;
      const size_t tok = tok0 + t;
      const uint4 cur = *(const uint4*)(p.u + tok * US + 3072 + 1024 + cc * 8);
      uint4 prv = make_uint4(0, 0, 0, 0);
      if ((tok % SEQ) != 0) prv = *(const uint4*)(p.u + (tok - 1) * US + 3072 + 1024 + cc * 8);
      float a[8], b[8];
      UNPACK8(cur, a); UNPACK8(prv, b);
#pragma unroll
      for (int e = 0; e < 8; ++e) vs[t * 512 + cc * 8 + e] = a[e] + (b[e] - a[e]) * mu[cc * 8 + e];
    }
    __syncthreads();
    const int j = tid & 31, tg = tid >> 5;
    float acc[4] = {0.f, 0.f, 0.f, 0.f};
    for (int k0 = 0; k0 < 512; k0 += 16) {
      float w[16];
#pragma unroll
      for (int kk = 0; kk < 16; ++kk) w[kk] = v1[(k0 + kk) * 32 + j];
#pragma unroll
      for (int kk = 0; kk < 16; ++kk)
#pragma unroll
        for (int i = 0; i < 4; ++i) acc[i] += vs[(tg * 4 + i) * 512 + k0 + kk] * w[kk];
    }
#pragma unroll
    for (int i = 0; i < 4; ++i) p.vlo[(tok0 + tg * 4 + i) * 32 + j] = acc[i];
  }
}

PHASE void att_item(const Params& p, int l, int item, char* smem) {
  const int qc = 31 - (item >> 7);
  const int bh = item & 127, b = bh >> 2, h = bh & 3;
  const int tid = opaque_tid(), lane = tid & 63, wave = tid >> 6, fr = lane & 15, fq = lane >> 4;
  const int m = wave >> 1, rh = wave & 1;
  bf16_t* Ks = (bf16_t*)smem;
  bf16_t* Vt = Ks + 2 * 64 * 64;
  bf16_t* Ps = Vt + 128 * 64;
  float* Ox = (float*)smem;
  const size_t tok0 = (size_t)b * SEQ + (size_t)qc * 64;
  const float lam_init = 0.8f - 0.6f * __expf(-0.3f * (float)l);
  const float lam = __uint_as_float(p.counters[32 + l]);

  bf16x8 qf[2][2];
#pragma unroll
  for (int mt = 0; mt < 2; ++mt)
#pragma unroll
    for (int ks = 0; ks < 2; ++ks)
      qf[mt][ks] = *(const bf16x8*)(p.u + (tok0 + rh * 32 + mt * 16 + fr) * US + h * 128 + m * 64 + ks * 32 + fq * 8);
  f32x4 o[2][8];
  float mx[2][4], ls[2][4];
#pragma unroll
  for (int mt = 0; mt < 2; ++mt) {
#pragma unroll
    for (int n = 0; n < 8; ++n) o[mt][n] = (f32x4){0.f, 0.f, 0.f, 0.f};
#pragma unroll
    for (int j = 0; j < 4; ++j) { mx[mt][j] = -1e30f; ls[mt][j] = 0.f; }
  }
  bf16_t* Pw = Ps + wave * 32 * 72;
  const int drow = tid >> 3, dlog = ((tid & 7) ^ ((tid >> 3) & 7)) * 8;
  const bf16_t* Kg = p.u + ((size_t)b * SEQ + (drow & 63)) * US + 512 + h * 128 + dlog;
  const bf16_t* Vg = p.vT + ((size_t)b * 512 + h * 128 + drow) * SEQ + dlog;
  const int rsw = fr & 7;
#define ATT_DMA_K(kt_)                                                                                              \
  _Pragma("unroll") for (int i = 0; i < 4; ++i)                                                                     \
    __builtin_amdgcn_global_load_lds((const unsigned*)(Kg + ((size_t)(kt_) * 64 + (i & 1) * 32) * US + (i >> 1) * 64), \
                                     (unsigned*)(Ks + tid * 8 + i * 2048), 16, 0, 0);
#define ATT_DMA_V(kt_)                                                                                              \
  _Pragma("unroll") for (int i = 0; i < 4; ++i)                                                                     \
    __builtin_amdgcn_global_load_lds((const unsigned*)(Vg + (size_t)(i * 32) * SEQ + (kt_) * 64),                  \
                                     (unsigned*)(Vt + tid * 8 + i * 2048), 16, 0, 0);
  __syncthreads();
  ATT_DMA_K(0)
  for (int kt = 0; kt <= qc; ++kt) {
    asm volatile("s_waitcnt vmcnt(0)" ::: "memory");
    __syncthreads();
    ATT_DMA_V(kt)
    f32x4 s[2][4];
#pragma unroll
    for (int mt = 0; mt < 2; ++mt)
#pragma unroll
      for (int n = 0; n < 4; ++n) s[mt][n] = (f32x4){0.f, 0.f, 0.f, 0.f};
#pragma unroll
    for (int ks = 0; ks < 2; ++ks)
#pragma unroll
      for (int n = 0; n < 4; ++n) {
        const bf16x8 kf = *(const bf16x8*)(Ks + (m * 64 + n * 16 + fr) * 64 + (((ks * 4 + fq) ^ rsw) * 8));
#pragma unroll
        for (int mt = 0; mt < 2; ++mt) s[mt][n] = MFMA(qf[mt][ks], kf, s[mt][n]);
      }
#pragma unroll
    for (int mt = 0; mt < 2; ++mt)
#pragma unroll
      for (int j = 0; j < 4; ++j) {
        float tmax = fmaxf(fmaxf(s[mt][0][j], s[mt][1][j]), fmaxf(s[mt][2][j], s[mt][3][j]));
        tmax = red16_max(tmax);
        const float mnew = fmaxf(mx[mt][j], tmax);
        const float alpha = __expf(mx[mt][j] - mnew);
        float rs = 0.f;
#pragma unroll
        for (int n = 0; n < 4; ++n) {
          const float pv = __expf(s[mt][n][j] - mnew);
          rs += pv;
          Pw[(mt * 16 + fq * 4 + j) * 72 + n * 16 + fr] = f2bf(pv);
        }
        rs = red16_sum(rs);
        ls[mt][j] = ls[mt][j] * alpha + rs;
        mx[mt][j] = mnew;
#pragma unroll
        for (int n = 0; n < 8; ++n) o[mt][n][j] *= alpha;
      }
    asm volatile("s_waitcnt vmcnt(0)" ::: "memory");
    __syncthreads();
    if (kt < qc) { ATT_DMA_K(kt + 1) }
#pragma unroll
    for (int ks = 0; ks < 2; ++ks) {
      bf16x8 pf[2];
#pragma unroll
      for (int mt = 0; mt < 2; ++mt) pf[mt] = *(const bf16x8*)(Pw + (mt * 16 + fr) * 72 + ks * 32 + fq * 8);
#pragma unroll
      for (int n = 0; n < 8; ++n) {
        const bf16x8 vf = *(const bf16x8*)(Vt + (n * 16 + fr) * 64 + (((ks * 4 + fq) ^ rsw) * 8));
#pragma unroll
        for (int mt = 0; mt < 2; ++mt) o[mt][n] = MFMA(pf[mt], vf, o[mt][n]);
      }
    }
  }
#undef ATT_DMA_K
#undef ATT_DMA_V
  __syncthreads();
#pragma unroll
  for (int mt = 0; mt < 2; ++mt)
#pragma unroll
    for (int j = 0; j < 4; ++j) {
      const float inv = 1.f / ls[mt][j];
#pragma unroll
      for (int n = 0; n < 8; ++n) o[mt][n][j] *= inv;
    }
  if (m == 1) {
#pragma unroll
    for (int mt = 0; mt < 2; ++mt)
#pragma unroll
      for (int n = 0; n < 8; ++n)
#pragma unroll
        for (int j = 0; j < 4; ++j) Ox[(rh * 32 + mt * 16 + fq * 4 + j) * 132 + n * 16 + fr] = o[mt][n][j];
  }
  __syncthreads();
  if (m == 0) {
    const float* sw = p.da_subln_w + (size_t)l * 128;
    float wv[8];
#pragma unroll
    for (int n = 0; n < 8; ++n) wv[n] = sw[n * 16 + fr] * (1.f - lam_init);
#pragma unroll
    for (int mt = 0; mt < 2; ++mt)
#pragma unroll
      for (int j = 0; j < 4; ++j) {
        float ss = 0.f;
        float d[8];
#pragma unroll
        for (int n = 0; n < 8; ++n) {
          d[n] = o[mt][n][j] - lam * Ox[(rh * 32 + mt * 16 + fq * 4 + j) * 132 + n * 16 + fr];
          ss += d[n] * d[n];
        }
        ss = red16_sum(ss);
        const float rstd = rsqrtf(ss * (1.f / 128.f) + 1e-6f);
        bf16_t* dst = p.u + (tok0 + rh * 32 + mt * 16 + fq * 4 + j) * US + h * 128 + fr;
#pragma unroll
        for (int n = 0; n < 8; ++n) dst[n * 16] = f2bf(d[n] * rstd * wv[n]);
      }
  }
  __syncthreads();
}

PHASE void hgrn_item(const Params& p, int l, int item, char* smem) {
  const int b = item >> 2, h = item & 3;
  const int tid = opaque_tid(), lane = tid & 63, wave = tid >> 6, fr = lane & 15, fq = lane >> 4;
  bf16_t* Qs = (bf16_t*)smem;
  bf16_t* Kn = Qs + 32 * 136;
  bf16_t* KT = Kn + 32 * 136;
  bf16_t* VT = KT + 128 * 40;
  bf16_t* Ps = VT + 128 * 40;
  bf16_t* ST = Ps + 32 * 40;
  float* lfb = (float*)ST;
  float* red = (float*)(ST + 128 * 136);
  float* blast = red + 64;
  const int t_ = tid >> 3, d0 = (tid & 7) * 16;
  float lbv[16];
#pragma unroll
  for (int i = 0; i < 16; ++i) {
    const int c = h * 128 + d0 + i;
    lbv[i] = (l == 0) ? 0.f : sigm(p.hg_lb[512 + c] - p.hg_lb[c]);
  }
  f32x4 S[2][8];
#pragma unroll
  for (int mm = 0; mm < 2; ++mm)
#pragma unroll
    for (int n = 0; n < 8; ++n) S[mm][n] = (f32x4){0.f, 0.f, 0.f, 0.f};
  const float* nw = p.hg_norm_w + (size_t)l * 128;

  for (int ch = 0; ch < 64; ++ch) {
    const size_t tok0 = (size_t)b * SEQ + (size_t)ch * 32;
    __syncthreads();
    float qv[16], kv[16];
    {
      const bf16_t* base = p.u + (tok0 + t_) * US + h * 128 + d0;
      float zv[16], iv[16];
      { const uint4 a = *(const uint4*)(base + 1024), c = *(const uint4*)(base + 1024 + 8); float* z0 = zv; float* z1 = zv + 8; UNPACK8(a, z0); UNPACK8(c, z1); }
      { const uint4 a = *(const uint4*)(base + 1536), c = *(const uint4*)(base + 1536 + 8); float* z0 = iv; float* z1 = iv + 8; UNPACK8(a, z0); UNPACK8(c, z1); }
      { const uint4 a = *(const uint4*)(base + 2048), c = *(const uint4*)(base + 2048 + 8); float* z0 = qv; float* z1 = qv + 8; UNPACK8(a, z0); UNPACK8(c, z1); }
#pragma unroll
      for (int i = 0; i < 16; ++i) {
        const float z = zv[i], lb = lbv[i];
        const float ez = __expf(-fabsf(z));
        float lf;
        if (lb > 0.f) {
          const float sg = (z >= 0.f) ? 1.f / (1.f + ez) : ez / (1.f + ez);
          lf = __logf(lb + (1.f - lb) * sg);
        } else {
          lf = -(fmaxf(-z, 0.f) + __logf(1.f + ez));
        }
        const float sgn = (z >= 0.f) ? ez / (1.f + ez) : 1.f / (1.f + ez);
        kv[i] = (1.f - lb) * sgn;
        lfb[t_ * 128 + d0 + i] = lf;
        VT[(d0 + i) * 40 + t_] = f2bf(iv[i]);
      }
    }
    __syncthreads();
    if (tid < 128) {
      float v[32];
#pragma unroll
      for (int t = 0; t < 32; ++t) v[t] = lfb[t * 128 + tid];
      float bsum = 0.f;
#pragma unroll
      for (int t = 0; t < 32; ++t) { bsum += v[t]; lfb[t * 128 + tid] = bsum; }
      blast[tid] = bsum;
    }
    __syncthreads();
    {
      float qo[16], ko[16];
#pragma unroll
      for (int i = 0; i < 16; ++i) {
        const float bb = lfb[t_ * 128 + d0 + i];
        qo[i] = qv[i] * __expf(bb);
        ko[i] = kv[i] * __expf(fminf(-bb, 80.f));
        KT[(d0 + i) * 40 + t_] = f2bf(ko[i]);
      }
      float* q0 = qo; float* q1 = qo + 8; float* k0 = ko; float* k1 = ko + 8;
      *(uint4*)(Qs + t_ * 136 + d0) = PACK8(q0);
      *(uint4*)(Qs + t_ * 136 + d0 + 8) = PACK8(q1);
      *(uint4*)(Kn + t_ * 136 + d0) = PACK8(k0);
      *(uint4*)(Kn + t_ * 136 + d0 + 8) = PACK8(k1);
    }
    __syncthreads();
#pragma unroll
    for (int mm = 0; mm < 2; ++mm)
#pragma unroll
      for (int n = 0; n < 8; ++n)
        *(uint2*)(ST + (n * 16 + fr) * 136 + wave * 32 + mm * 16 + fq * 4) =
            make_uint2(pack2(S[mm][n][0], S[mm][n][1]), pack2(S[mm][n][2], S[mm][n][3]));
    {
      const int mt = wave >> 1, nt = wave & 1;
      f32x4 sc = (f32x4){0.f, 0.f, 0.f, 0.f};
#pragma unroll
      for (int ks = 0; ks < 4; ++ks) {
        const bf16x8 a = *(const bf16x8*)(Qs + (mt * 16 + fr) * 136 + ks * 32 + fq * 8);
        const bf16x8 bb = *(const bf16x8*)(Kn + (nt * 16 + fr) * 136 + ks * 32 + fq * 8);
        sc = MFMA(a, bb, sc);
      }
#pragma unroll
      for (int j = 0; j < 4; ++j) {
        const int t = mt * 16 + fq * 4 + j, key = nt * 16 + fr;
        Ps[t * 40 + key] = f2bf(key <= t ? sc[j] : 0.f);
      }
    }
    __syncthreads();
    {
      const int mt = wave & 1, nb = (wave >> 1) * 4;
      f32x4 oo[4];
#pragma unroll
      for (int n = 0; n < 4; ++n) oo[n] = (f32x4){0.f, 0.f, 0.f, 0.f};
      {
        const bf16x8 a = *(const bf16x8*)(Ps + (mt * 16 + fr) * 40 + fq * 8);
#pragma unroll
        for (int n = 0; n < 4; ++n) {
          const bf16x8 bb = *(const bf16x8*)(VT + ((nb + n) * 16 + fr) * 40 + fq * 8);
          oo[n] = MFMA(a, bb, oo[n]);
        }
      }
#pragma unroll
      for (int ks = 0; ks < 4; ++ks) {
        const bf16x8 a = *(const bf16x8*)(Qs + (mt * 16 + fr) * 136 + ks * 32 + fq * 8);
#pragma unroll
        for (int n = 0; n < 4; ++n) {
          const bf16x8 bb = *(const bf16x8*)(ST + ((nb + n) * 16 + fr) * 136 + ks * 32 + fq * 8);
          oo[n] = MFMA(a, bb, oo[n]);
        }
      }
#pragma unroll
      for (int j = 0; j < 4; ++j) {
        float ss = 0.f;
#pragma unroll
        for (int n = 0; n < 4; ++n) ss += oo[n][j] * oo[n][j];
        ss = red16_sum(ss);
        if (fr == 0) red[(mt * 16 + fq * 4 + j) * 2 + (wave >> 1)] = ss;
      }
      __syncthreads();
#pragma unroll
      for (int j = 0; j < 4; ++j) {
        const int t = mt * 16 + fq * 4 + j;
        const float rstd = rsqrtf((red[t * 2] + red[t * 2 + 1]) * (1.f / 128.f) + 1e-6f);
        bf16_t* gp = p.u + (tok0 + t) * US + 2560 + h * 128 + nb * 16 + fr;
#pragma unroll
        for (int n = 0; n < 4; ++n) {
          const float g = bf2f(gp[n * 16]);
          gp[n * 16] = f2bf(oo[n][j] * rstd * nw[(nb + n) * 16 + fr] * (g * sigm(g)));
        }
      }
    }
    {
      bf16x8 af[2];
#pragma unroll
      for (int mm = 0; mm < 2; ++mm) af[mm] = *(const bf16x8*)(KT + (wave * 32 + mm * 16 + fr) * 40 + fq * 8);
#pragma unroll
      for (int n = 0; n < 8; ++n) {
        const bf16x8 bb = *(const bf16x8*)(VT + (n * 16 + fr) * 40 + fq * 8);
#pragma unroll
        for (int mm = 0; mm < 2; ++mm) S[mm][n] = MFMA(af[mm], bb, S[mm][n]);
      }
#pragma unroll
      for (int mm = 0; mm < 2; ++mm)
#pragma unroll
        for (int j = 0; j < 4; ++j) {
          const float e = __expf(blast[wave * 32 + mm * 16 + fq * 4 + j]);
#pragma unroll
          for (int n = 0; n < 8; ++n) S[mm][n][j] *= e;
        }
    }
  }
  __syncthreads();
}

DEV uint4 rw_act(const uint4 cur, const uint4 prv, const float* mul8, int mode) {
  const float4 m0 = *(const float4*)(mul8), m1 = *(const float4*)(mul8 + 4);
  const float mm[8] = {m0.x, m0.y, m0.z, m0.w, m1.x, m1.y, m1.z, m1.w};
  float a[8], b[8], o[8];
  UNPACK8(cur, a); UNPACK8(prv, b);
#pragma unroll
  for (int e = 0; e < 8; ++e) {
    float v = a[e] + (b[e] - a[e]) * mm[e];
    if (mode == 1) { const float t = __expf(-2.f * fabsf(v)); const float th = (1.f - t) / (1.f + t); v = (v >= 0.f) ? th : -th; }
    else if (mode == 2) v = sigm(v);
    o[e] = v;
  }
  return PACK8(o);
}
DEV bf16x8 rw_bfrag(const float* W, int k0, int col) {
  float o[8];
#pragma unroll
  for (int e = 0; e < 8; ++e) o[e] = W[(size_t)(k0 + e) * 512 + col];
  return as_frag(PACK8(o));
}

PHASE void rwkv_item(const Params& p, int l, int item, char* smem) {
  const int b = item >> 3, h = item & 7;
  const int tid = opaque_tid(), lane = tid & 63, wave = tid >> 6, fr = lane & 15, fq = lane >> 4;
  float* R = (float*)smem;
  float* K = R + 2048; float* KK = K + 2048; float* W = KK + 2048; float* BB = W + 2048;
  float* V = BB + 2048; float* G = V + 2048; float* O = G + 2048;
  float* cst = O + 2048;
  float* mul = cst + 512;
  bf16_t* rawL = (bf16_t*)smem;
  float* vloL = (float*)(smem + 17424);
  const float* mu = p.rw_mu + (size_t)l * 1792;
  const int hc_n = h * 64 + wave * 16 + fr;
  bf16x8 w2f[2], a2f[2], g2f[4], v2f;
#pragma unroll
  for (int ks = 0; ks < 2; ++ks) {
    w2f[ks] = rw_bfrag(p.rw_w2 + (size_t)l * 64 * 512, ks * 32 + fq * 8, hc_n);
    a2f[ks] = rw_bfrag(p.rw_a2 + (size_t)l * 64 * 512, ks * 32 + fq * 8, hc_n);
  }
#pragma unroll
  for (int ks = 0; ks < 4; ++ks) g2f[ks] = rw_bfrag(p.rw_g2 + (size_t)l * 128 * 512, ks * 32 + fq * 8, hc_n);
  v2f = w2f[0];
  if (l > 0) v2f = rw_bfrag(p.rw_v2, fq * 8, hc_n);
  const float w0c = p.rw_w0[l * 512 + hc_n], a0c = p.rw_a0[l * 512 + hc_n];
  const float v0c = (l > 0) ? p.rw_v0[hc_n] : 0.f;
  const int t_ = tid >> 3, n0 = (tid & 7) * 8;
  __syncthreads();
  if (tid < 64) {
    const int hc = h * 64 + tid;
    cst[tid] = p.rw_k_k[l * 512 + hc]; cst[64 + tid] = p.rw_k_a[l * 512 + hc]; cst[128 + tid] = p.rw_r_k[l * 512 + hc];
    cst[192 + tid] = p.rw_gn_w[l * 512 + hc]; cst[256 + tid] = p.rw_gn_b[l * 512 + hc];
    cst[320 + tid] = mu[hc]; cst[384 + tid] = mu[512 + hc]; cst[448 + tid] = mu[1024 + hc];
  }
  mul[tid] = mu[1536 + tid];
  const float* kkc = cst + n0; const float* kac = cst + 64 + n0; const float* rkc = cst + 128 + n0;
  const float* gnw = cst + 192 + n0; const float* gnb = cst + 256 + n0;
  const float* mur = cst + 320 + n0; const float* muk = cst + 384 + n0; const float* muv = cst + 448 + n0;
  const int kq = lane & 7, row0 = wave * 16 + (lane >> 3), row1 = row0 + 8;
  f32x2 S0p[4], S1p[4];
#pragma unroll
  for (int e = 0; e < 4; ++e) { S0p[e] = (f32x2){0.f, 0.f}; S1p[e] = (f32x2){0.f, 0.f}; }

  uint4 pl0, pl1, pl2, pl3, pl4, pcr, pck, pcv, ppr, ppk, ppv, pvf;
  float4 pvl;
#define RW_PREFETCH(ch_)                                                                                    \
  {                                                                                                         \
    const size_t tk0 = (size_t)b * SEQ + (size_t)(ch_) * 32;                                                 \
    const bf16_t* lb_ = p.u + (tk0 - 1) * US + 3072 + 1536 + (tid & 31) * 8;                                 \
    const int r0_ = tid >> 5;                                                                               \
    pl0 = make_uint4(0, 0, 0, 0); if (!((ch_) == 0 && r0_ == 0)) pl0 = *(const uint4*)(lb_ + (size_t)r0_ * US); \
    pl1 = *(const uint4*)(lb_ + (size_t)(r0_ + 8) * US);                                                     \
    pl2 = *(const uint4*)(lb_ + (size_t)(r0_ + 16) * US);                                                    \
    pl3 = *(const uint4*)(lb_ + (size_t)(r0_ + 24) * US);                                                    \
    pl4 = make_uint4(0, 0, 0, 0); if (tid < 32) pl4 = *(const uint4*)(lb_ + (size_t)32 * US);                \
    const bf16_t* cu_ = p.u + (tk0 + t_) * US + 3072 + h * 64 + n0;                                          \
    pcr = *(const uint4*)cu_; pck = *(const uint4*)(cu_ + 512); pcv = *(const uint4*)(cu_ + 1024);           \
    if ((ch_) == 0 && t_ == 0) { ppr = make_uint4(0, 0, 0, 0); ppk = ppr; ppv = ppr; }                        \
    else { ppr = *(const uint4*)(cu_ - US); ppk = *(const uint4*)(cu_ - US + 512); ppv = *(const uint4*)(cu_ - US + 1024); } \
    if (l > 0) {                                                                                            \
      pvl = *(const float4*)(p.vlo + (tk0 + (tid >> 3)) * 32 + (tid & 7) * 4);                               \
      pvf = *(const uint4*)(p.vfirst + (tk0 + t_) * 512 + h * 64 + n0);                                      \
    } else { pvl = make_float4(0.f, 0.f, 0.f, 0.f); pvf = make_uint4(0, 0, 0, 0); }                          \
  }
  RW_PREFETCH(0)

  for (int ch = 0; ch < 64; ++ch) {
    const size_t tok0 = (size_t)b * SEQ + (size_t)ch * 32;
    __syncthreads();
    {
      const int r0_ = tid >> 5, cc_ = (tid & 31) * 8;
      *(uint4*)(rawL + r0_ * 264 + cc_) = pl0;
      *(uint4*)(rawL + (r0_ + 8) * 264 + cc_) = pl1;
      *(uint4*)(rawL + (r0_ + 16) * 264 + cc_) = pl2;
      *(uint4*)(rawL + (r0_ + 24) * 264 + cc_) = pl3;
      if (tid < 32) *(uint4*)(rawL + 32 * 264 + cc_) = pl4;
      *(float4*)(vloL + (tid >> 3) * 36 + (tid & 7) * 4) = pvl;
    }
    __syncthreads();
    {
      const int cc_ = (tid & 31) * 8, tr = tid >> 5;
      const int mode = (cc_ < 64) ? 1 : ((cc_ < 128) ? 0 : 2);
      uint4 a0, a1, a2, a3;
      a0 = rw_act(*(const uint4*)(rawL + (tr + 1) * 264 + cc_), *(const uint4*)(rawL + tr * 264 + cc_), mul + cc_, mode);
      a1 = rw_act(*(const uint4*)(rawL + (tr + 9) * 264 + cc_), *(const uint4*)(rawL + (tr + 8) * 264 + cc_), mul + cc_, mode);
      a2 = rw_act(*(const uint4*)(rawL + (tr + 17) * 264 + cc_), *(const uint4*)(rawL + (tr + 16) * 264 + cc_), mul + cc_, mode);
      a3 = rw_act(*(const uint4*)(rawL + (tr + 25) * 264 + cc_), *(const uint4*)(rawL + (tr + 24) * 264 + cc_), mul + cc_, mode);
      __syncthreads();
      *(uint4*)(rawL + tr * 264 + cc_) = a0;
      *(uint4*)(rawL + (tr + 8) * 264 + cc_) = a1;
      *(uint4*)(rawL + (tr + 16) * 264 + cc_) = a2;
      *(uint4*)(rawL + (tr + 24) * 264 + cc_) = a3;
    }
    __syncthreads();
#pragma unroll 1
    for (int mt = 0; mt < 2; ++mt) {
      const int row = mt * 16 + fr;
      const bf16_t* ar = rawL + row * 264 + fq * 8;
      f32x4 aw = (f32x4){0.f, 0.f, 0.f, 0.f}, aa = aw, ag = aw, av = aw;
#pragma unroll
      for (int ks = 0; ks < 2; ++ks) {
        aw = MFMA(*(const bf16x8*)(ar + ks * 32), w2f[ks], aw);
        aa = MFMA(*(const bf16x8*)(ar + 64 + ks * 32), a2f[ks], aa);
      }
#pragma unroll
      for (int ks = 0; ks < 4; ++ks) ag = MFMA(*(const bf16x8*)(ar + 128 + ks * 32), g2f[ks], ag);
      if (l > 0) {
        const float4 x0 = *(const float4*)(vloL + row * 36 + fq * 8), x1 = *(const float4*)(vloL + row * 36 + fq * 8 + 4);
        const uint4 pk = make_uint4(pack2(x0.x, x0.y), pack2(x0.z, x0.w), pack2(x1.x, x1.y), pack2(x1.z, x1.w));
        av = MFMA(as_frag(pk), v2f, av);
      }
#pragma unroll
      for (int j = 0; j < 4; ++j) {
        const int t = mt * 16 + fq * 4 + j, n = wave * 16 + fr;
        const float wv = -(w0c + aw[j]);
        const float sp = fmaxf(wv, 0.f) + __logf(1.f + __expf(-fabsf(wv)));
        const float wl = -sp - 0.5f;
        W[t * 64 + n] = __expf(-__expf(wl));
        BB[t * 64 + n] = sigm(a0c + aa[j]);
        G[t * 64 + n] = ag[j];
        if (l > 0) O[t * 64 + n] = sigm(v0c + av[j]);
      }
    }
    __syncthreads();
    {
      const size_t tok = tok0 + t_;
      float cr[8], ck[8], cv[8], pr[8], pk[8], pv[8];
      UNPACK8(pcr, cr); UNPACK8(pck, ck); UNPACK8(pcv, cv);
      UNPACK8(ppr, pr); UNPACK8(ppk, pk); UNPACK8(ppv, pv);
      float kx[8], kkv[8], vs[8], ss = 0.f;
#pragma unroll
      for (int e = 0; e < 8; ++e) {
        R[t_ * 64 + n0 + e] = cr[e] + (pr[e] - cr[e]) * mur[e];
        kx[e] = ck[e] + (pk[e] - ck[e]) * muk[e];
        vs[e] = cv[e] + (pv[e] - cv[e]) * muv[e];
        kkv[e] = kx[e] * kkc[e]; ss += kkv[e] * kkv[e];
      }
      ss = red8_sum(ss);
      const float rn = rsqrtf(fmaxf(ss, 1e-24f));
#pragma unroll
      for (int e = 0; e < 8; ++e) {
        const float a = BB[t_ * 64 + n0 + e];
        const float kn = kkv[e] * rn;
        K[t_ * 64 + n0 + e] = kx[e] * (1.f + (a - 1.f) * kac[e]);
        KK[t_ * 64 + n0 + e] = kn;
        BB[t_ * 64 + n0 + e] = kn * a;
      }
      if (l == 0) {
        *(uint4*)(p.vfirst + tok * 512 + h * 64 + n0) = PACK8(vs);
      } else {
        float vf[8]; UNPACK8(pvf, vf);
#pragma unroll
        for (int e = 0; e < 8; ++e) vs[e] = vs[e] + (vf[e] - vs[e]) * O[t_ * 64 + n0 + e];
      }
#pragma unroll
      for (int e = 0; e < 8; ++e) V[t_ * 64 + n0 + e] = vs[e];
    }
    __syncthreads();
    if (ch + 1 < 64) RW_PREFETCH(ch + 1)
    asm volatile("" ::: "memory");
#pragma unroll 4
    for (int t = 0; t < 32; ++t) {
      const float* base = R + t * 64 + kq * 8;
      const float4 r0 = *(const float4*)(base), r1 = *(const float4*)(base + 4);
      const float4 k0 = *(const float4*)(base + 2048), k1 = *(const float4*)(base + 2048 + 4);
      const float4 q0 = *(const float4*)(base + 4096), q1 = *(const float4*)(base + 4096 + 4);
      const float4 w0 = *(const float4*)(base + 6144), w1 = *(const float4*)(base + 6144 + 4);
      const float4 b0 = *(const float4*)(base + 8192), b1 = *(const float4*)(base + 8192 + 4);
      const float va = V[t * 64 + row0], vb = V[t * 64 + row1];
      const f32x2 rr[4] = {{r0.x, r0.y}, {r0.z, r0.w}, {r1.x, r1.y}, {r1.z, r1.w}};
      const f32x2 ww[4] = {{w0.x, w0.y}, {w0.z, w0.w}, {w1.x, w1.y}, {w1.z, w1.w}};
      const f32x2 kk_[4] = {{k0.x, k0.y}, {k0.z, k0.w}, {k1.x, k1.y}, {k1.z, k1.w}};
      const f32x2 qq[4] = {{q0.x, q0.y}, {q0.z, q0.w}, {q1.x, q1.y}, {q1.z, q1.w}};
      const f32x2 bb[4] = {{b0.x, b0.y}, {b0.z, b0.w}, {b1.x, b1.y}, {b1.z, b1.w}};
      f32x2 a0 = S0p[0] * qq[0], a1 = S1p[0] * qq[0];
#pragma unroll
      for (int e = 1; e < 4; ++e) { a0 += S0p[e] * qq[e]; a1 += S1p[e] * qq[e]; }
      const float sa0 = -red8_sum(a0.x + a0.y), sa1 = -red8_sum(a1.x + a1.y);
      f32x2 sa0v, sa1v, vav, vbv;
      sa0v.x = sa0; sa0v.y = sa0; sa1v.x = sa1; sa1v.y = sa1; vav.x = va; vav.y = va; vbv.x = vb; vbv.y = vb;
      f32x2 o0v = {0.f, 0.f}, o1v = {0.f, 0.f};
#pragma unroll
      for (int e = 0; e < 4; ++e) {
        S0p[e] = S0p[e] * ww[e] + sa0v * bb[e] + vav * kk_[e];
        S1p[e] = S1p[e] * ww[e] + sa1v * bb[e] + vbv * kk_[e];
        o0v += S0p[e] * rr[e]; o1v += S1p[e] * rr[e];
      }
      const float o0 = red8_sum(o0v.x + o0v.y), o1 = red8_sum(o1v.x + o1v.y);
      if (kq == 0) { O[t * 64 + row0] = o0; O[t * 64 + row1] = o1; }
    }
    asm volatile("s_waitcnt vmcnt(0)" ::: "memory");
    __syncthreads();
    {
      const size_t tok = tok0 + t_;
      float ov[8], s1 = 0.f, bon = 0.f;
#pragma unroll
      for (int e = 0; e < 8; ++e) {
        ov[e] = O[t_ * 64 + n0 + e]; s1 += ov[e];
        bon += R[t_ * 64 + n0 + e] * K[t_ * 64 + n0 + e] * rkc[e];
      }
      s1 = red8_sum(s1); bon = red8_sum(bon);
      const float mean = s1 * (1.f / 64.f);
      float s2 = 0.f;
#pragma unroll
      for (int e = 0; e < 8; ++e) { const float d = ov[e] - mean; s2 += d * d; }
      s2 = red8_sum(s2);
      const float rstd = rsqrtf(s2 * (1.f / 64.f) + 64e-5f);
      float y[8];
#pragma unroll
      for (int e = 0; e < 8; ++e)
        y[e] = ((ov[e] - mean) * rstd * gnw[e] + gnb[e] + bon * V[t_ * 64 + n0 + e]) * G[t_ * 64 + n0 + e];
      *(uint4*)(p.u + tok * US + 3072 + h * 64 + n0) = PACK8(y);
    }
  }
#undef RW_PREFETCH
  __syncthreads();
}

PHASE void phase_mix(const Params& p, int l, char* smem) {
  const int hf = vhalf();
  int* sitem = (int*)(smem - hf * SMEM_BYTES + SMEM_BYTES - 16);
  const int t512 = opaque_tid512();
  while (true) {
    __syncthreads();
    if (t512 == 0) *sitem = (int)atomicAdd(p.counters + l * 4 + 0, 1u);
    __syncthreads();
    const int tk = *sitem;
    if (tk >= 128) break;
    rwkv_item(p, l, tk * 2 + hf, smem);
  }
  while (true) {
    __syncthreads();
    if (t512 == 0) *sitem = (int)atomicAdd(p.counters + l * 4 + 1, 1u);
    __syncthreads();
    const int tk = *sitem;
    if (tk >= 64) break;
    hgrn_item(p, l, tk * 2 + hf, smem);
  }
  while (true) {
    __syncthreads();
    if (t512 == 0) *sitem = (int)atomicAdd(p.counters + l * 4 + 2, 1u);
    __syncthreads();
    const int tk = *sitem;
    if (tk >= 2048) break;
    att_item(p, l, tk * 2 + hf, smem);
  }
}

DEV void gemm_gates(const int tid_in, const bf16_t* A, const bf16_t* Wg, int tn, char* smem, unsigned (&Gp)[4][6][2]) {
  int tid = tid_in; asm volatile("" : "+v"(tid));
  bf16_t* As = (bf16_t*)smem;
  bf16_t* Bs = As + 3 * 4096;
  const int lane = tid & 63, wave = tid >> 6, wr = wave >> 1, wc = wave & 1;
  const int fr = lane & 15, fq = lane >> 4;
  f32x4 acc[4][6];
#pragma unroll
  for (int m = 0; m < 4; ++m)
#pragma unroll
    for (int n = 0; n < 6; ++n) acc[m][n] = (f32x4){0.f, 0.f, 0.f, 0.f};
  const int nk = DM >> 5;
  const int drow = tid >> 2, dphys = tid & 3, dg = (0 - (tid >> 4)) & 3;
  const int cofs = (dphys ^ dg) * 8;
  const unsigned aofs = (unsigned)(drow * DM + cofs);
  unsigned bofs0, bofs1, bofs2;
  {
    int r = drow; int wcb = r / 96, br = (r % 96) >> 5, c = (r % 96) & 31;
    bofs0 = (unsigned)((5376 + br * 1024 + tn * 64 + wcb * 32 + c) * DM + cofs);
    r = drow + 64; wcb = r / 96; br = (r % 96) >> 5; c = (r % 96) & 31;
    bofs1 = (unsigned)((5376 + br * 1024 + tn * 64 + wcb * 32 + c) * DM + cofs);
    r = drow + 128; wcb = r / 96; br = (r % 96) >> 5; c = (r % 96) & 31;
    bofs2 = (unsigned)((5376 + br * 1024 + tn * 64 + wcb * 32 + c) * DM + cofs);
  }
  const int rofs = (fq ^ ((0 - (fr >> 2)) & 3)) * 8;
#define GG_DMA(st, kk)                                                                                       \
  {                                                                                                          \
    __builtin_amdgcn_global_load_lds((const unsigned*)(A + aofs + (kk) * 32), (unsigned*)(As + (st) * 4096 + tid * 8), 16, 0, 0);                     \
    __builtin_amdgcn_global_load_lds((const unsigned*)(A + aofs + 64 * DM + (kk) * 32), (unsigned*)(As + (st) * 4096 + tid * 8 + 2048), 16, 0, 0); \
    __builtin_amdgcn_global_load_lds((const unsigned*)(Wg + bofs0 + (kk) * 32), (unsigned*)(Bs + (st) * 6144 + tid * 8), 16, 0, 0);                    \
    __builtin_amdgcn_global_load_lds((const unsigned*)(Wg + bofs1 + (kk) * 32), (unsigned*)(Bs + (st) * 6144 + tid * 8 + 2048), 16, 0, 0);             \
    __builtin_amdgcn_global_load_lds((const unsigned*)(Wg + bofs2 + (kk) * 32), (unsigned*)(Bs + (st) * 6144 + tid * 8 + 4096), 16, 0, 0);             \
  }
  GG_DMA(0, 0)
  GG_DMA(1, 1)
  int st = 0;
  for (int kt = 0; kt < nk; ++kt) {
    if (kt + 1 < nk) asm volatile("s_waitcnt vmcnt(5)" ::: "memory");
    else asm volatile("s_waitcnt vmcnt(0)" ::: "memory");
    __builtin_amdgcn_s_barrier();
    asm volatile("" ::: "memory");
    const int s2 = (st >= 1) ? st - 1 : 2;
    const bf16_t* Ab = As + st * 4096 + (wr * 64 + fr) * 32 + rofs;
    const bf16_t* Bb = Bs + st * 6144 + (wc * 96 + fr) * 32 + rofs;
    bf16x8 bfr[6], af[4];
#pragma unroll
    for (int n = 0; n < 6; ++n) bfr[n] = *(const bf16x8*)(Bb + n * 512);
#pragma unroll
    for (int m = 0; m < 4; ++m) af[m] = *(const bf16x8*)(Ab + m * 512);
    if (kt + 2 < nk) GG_DMA(s2, kt + 2)
#pragma unroll
    for (int m = 0; m < 4; ++m)
#pragma unroll
      for (int n = 0; n < 6; ++n) acc[m][n] = MFMA(af[m], bfr[n], acc[m][n]);
    st = (st == 2) ? 0 : st + 1;
  }
#undef GG_DMA
  __syncthreads();
#pragma unroll
  for (int m = 0; m < 4; ++m)
#pragma unroll
    for (int n = 0; n < 6; ++n) {
      Gp[m][n][0] = pack2(sigm(acc[m][n][0]), sigm(acc[m][n][1]));
      Gp[m][n][1] = pack2(sigm(acc[m][n][2]), sigm(acc[m][n][3]));
    }
}

PHASE void phase_merge(const Params& p, int l, char* smem) {
  const bf16_t* Wl = p.wt + (size_t)l * WLAYER;
  float* Cs = (float*)smem;
  const int tid = opaque_tid();
  for (int it = 0;; ++it) {
    int tm, tn;
    if (!tile_for(it, 512, 16, tm, tn)) break;
    const size_t row0 = (size_t)tm * 128;
    unsigned Gp[4][6][2];
    gemm_gates(tid, p.h + row0 * DM, Wl + WIN, tn, smem, Gp);
    f32x4 acc[4][2], M[4][2];
#pragma unroll
    for (int m = 0; m < 4; ++m)
#pragma unroll
      for (int n = 0; n < 2; ++n) M[m][n] = (f32x4){0.f, 0.f, 0.f, 0.f};
#pragma unroll
    for (int br = 0; br < 3; ++br) {
      const int aoff = (br == 0) ? 0 : (br == 1 ? 2560 : 3072);
      const size_t woff = (br == 0) ? WBA : (br == 1 ? WBB : WBC);
      gemm_tile<2>(tid, p.u + row0 * US + aoff, US, Wl + woff + (size_t)(tn * 64) * 512, 512, 512, smem, acc);
#pragma unroll
      for (int m = 0; m < 4; ++m)
#pragma unroll
        for (int n = 0; n < 2; ++n) {
          M[m][n][0] += lo16(Gp[m][2 * br + n][0]) * acc[m][n][0];
          M[m][n][1] += hi16(Gp[m][2 * br + n][0]) * acc[m][n][1];
          M[m][n][2] += lo16(Gp[m][2 * br + n][1]) * acc[m][n][2];
          M[m][n][3] += hi16(Gp[m][2 * br + n][1]) * acc[m][n][3];
        }
    }
    stage_acc<2>(tid, Cs, M);
    __syncthreads();
    {
      const int ch = tid & 7;
#pragma unroll 1
      for (int i = 0; i < 4; ++i) {
        const int r = (tid >> 3) + i * 32;
        const float4 a = *(const float4*)(Cs + r * 68 + ch * 8), b = *(const float4*)(Cs + r * 68 + ch * 8 + 4);
        *(uint4*)(p.u + (row0 + r) * US + 1024 + tn * 64 + ch * 8) = make_uint4(pack2(a.x, a.y), pack2(a.z, a.w), pack2(b.x, b.y), pack2(b.z, b.w));
      }
    }
    __syncthreads();
  }
}

PHASE void phase_gemm_res(const bf16_t* A, int lda, const bf16_t* Wt, int K, const float* xin, float* xout,
                        const float* ada_l, int gate_off, char* smem0) {
  const int T = opaque_tid512(), tid = T & 255, hf = vhalf();
  float* Cs = (float*)(smem0 + hf * SMEM_BYTES);
  for (int it = 0;; ++it) {
    int tm, tn;
    if (!tile_for_real(it, 256, 4, tm, tn)) break;
    const size_t row0 = (size_t)tm * 256;
    f32x4 acc[8][4];
    gemm_tile512(T, A + row0 * lda, lda, Wt + (size_t)(tn * 256) * K, K, K, smem0, acc);
    const float* gate = ada_l + (size_t)(row0 / SEQ) * ADAW + gate_off;
    const int c4 = (tid & 31) * 4;
#pragma unroll
    for (int ps = 0; ps < 2; ++ps) {
      if (ps == 0) stage_half512<0>(T, Cs, acc); else stage_half512<1>(T, Cs, acc);
      __syncthreads();
#pragma unroll 1
      for (int i0 = 0; i0 < 16; i0 += 4) {
        float4 xv[4], gv[4], cv[4]; size_t off[4];
#pragma unroll
        for (int ii = 0; ii < 4; ++ii) {
          const int r = (tid >> 5) + (i0 + ii) * 8;
          const int colb = TNC(r) * 128 + c4;
          off[ii] = GROW(r, ps) * DM + colb;
          xv[ii] = *(const float4*)(xin + off[ii]);
          gv[ii] = *(const float4*)(gate + colb);
          cv[ii] = *(const float4*)(Cs + r * 132 + c4);
        }
        asm volatile("" ::: "memory");
#pragma unroll
        for (int ii = 0; ii < 4; ++ii)
          *(float4*)(xout + off[ii]) = make_float4(xv[ii].x + gv[ii].x * cv[ii].x, xv[ii].y + gv[ii].y * cv[ii].y,
                                                   xv[ii].z + gv[ii].z * cv[ii].z, xv[ii].w + gv[ii].w * cv[ii].w);
      }
      __syncthreads();
    }
  }
}

PHASE void phase_ffn_in(const Params& p, int l, char* smem0) {
  const bf16_t* Wt = p.wt + (size_t)l * WLAYER + WFI;
  const int T = opaque_tid512(), tid = T & 255, hf = vhalf();
  float* Cs = (float*)(smem0 + hf * SMEM_BYTES);
  for (int it = 0;; ++it) {
    int tm, tn;
    if (!tile_for_real(it, 256, 22, tm, tn)) break;
    const size_t row0 = (size_t)tm * 256;
    f32x4 acc[8][4];
    gemm_tile512(T, p.h + row0 * DM, DM, Wt + (size_t)(tn * 256) * DM, DM, DM, smem0, acc);
    const int ch = tid & 7;
#pragma unroll
    for (int ps = 0; ps < 2; ++ps) {
      if (ps == 0) stage_half512<0>(T, Cs, acc); else stage_half512<1>(T, Cs, acc);
      __syncthreads();
#pragma unroll 1
      for (int i = 0; i < 4; ++i) {
        const int r = (tid >> 3) + i * 32;
        const float* cp = Cs + r * 132 + ch * 8;
        float o[8];
#pragma unroll
        for (int e = 0; e < 8; ++e) { const float g = cp[e], uu = cp[64 + e]; o[e] = g * sigm(g) * uu; }
        *(uint4*)(p.u + GROW(r, ps) * FFH + TNC(r) * 64 + ch * 8) = PACK8(o);
      }
      __syncthreads();
    }
  }
}

#define XB_TMO      128
#define XB_XCNT(j)  (256  + 64 * (j))
#define XB_XSUB(j)  (1280 + 64 * (j))
#define XB_XGEN(j)  (2304 + 64 * (j))
#define XB_TOP      3328
#define XB_TOPGEN   3392
#define XCD_BAR_WORDS 3456
#define XB_SPIN_CAP (1u << 18)
#define LAS __attribute__((address_space(3)))
DEV unsigned xb_ld(unsigned* p) { return __hip_atomic_load(p, __ATOMIC_RELAXED, __HIP_MEMORY_SCOPE_AGENT); }
DEV unsigned xb_add(unsigned* p, unsigned v) { return __hip_atomic_fetch_add(p, v, __ATOMIC_RELAXED, __HIP_MEMORY_SCOPE_AGENT); }
DEV unsigned xb_xcc_id() { return (unsigned)__builtin_amdgcn_s_getreg((3 << 11) | 20) & 0xFu; }
#define XB_SPIN(cond, bar) do { unsigned _sp = 0; while (cond) { __builtin_amdgcn_s_sleep(1); \
    if ((++_sp & 255u) == 0u) { if (xb_ld(&(bar)[XB_TMO])) break; if (_sp > XB_SPIN_CAP) { atomicAdd(&(bar)[XB_TMO], 1u); break; } } } } while (0)
struct XcdBarrier { unsigned* bar; unsigned x; volatile LAS unsigned* st; };
DEV XcdBarrier xcd_barrier_post(unsigned* bar, volatile LAS unsigned* st) {
  XcdBarrier b; b.bar = bar; b.x = xb_xcc_id(); b.st = st;
  if (threadIdx.x == 0) (void)xb_add(&bar[XB_XCNT(b.x)], 1u);
  return b;
}
DEV void xcd_barrier_complete(unsigned* bar, unsigned x, unsigned& nloc, unsigned& nx) {
  const unsigned G = gridDim.x * gridDim.y * gridDim.z;
  unsigned sum, cnt, mine, sp = 0u;
  for (;;) {
    sum = 0u; cnt = 0u; mine = 0u;
#pragma unroll
    for (unsigned j = 0; j < 16; ++j) { const unsigned c = xb_ld(&bar[XB_XCNT(j)]); sum += c; cnt += (c > 0u) ? 1u : 0u; mine = (j == x) ? c : mine; }
    if (sum == G) break;
    __builtin_amdgcn_s_sleep(1);
    if ((++sp & 255u) == 0u) { if (xb_ld(&bar[XB_TMO])) break; if (sp > XB_SPIN_CAP) { atomicAdd(&bar[XB_TMO], 1u); break; } }
  }
  nloc = mine > 0u ? mine : 1u; nx = cnt > 0u ? cnt : 1u;
}
DEV void xcd_barrier(const XcdBarrier& b) {
  asm volatile("s_waitcnt vmcnt(0)" ::: "memory");
  __syncthreads();
  if (threadIdx.x == 0) {
    unsigned* bar = b.bar;
    __builtin_amdgcn_s_waitcnt(0);
    unsigned nloc = b.st[0], nx = b.st[1];
    if (nloc == 0u) { xcd_barrier_complete(bar, b.x, nloc, nx); b.st[0] = nloc; b.st[1] = nx; }
    const unsigned old = xb_add(&bar[XB_XSUB(b.x)], 1u);
    const unsigned gen = old / nloc;
    if (old + 1u == (gen + 1u) * nloc) {
      __builtin_amdgcn_fence(__ATOMIC_RELEASE, "agent");
      asm volatile("s_waitcnt vmcnt(0)" ::: "memory");
      const unsigned og = xb_add(&bar[XB_TOP], 1u);
      const unsigned tg = og / nx;
      if (og + 1u == (tg + 1u) * nx) xb_add(&bar[XB_TOPGEN], 1u);
      else XB_SPIN(xb_ld(&bar[XB_TOPGEN]) == tg, bar);
      __builtin_amdgcn_fence(__ATOMIC_ACQUIRE, "agent");
      xb_add(&bar[XB_XGEN(b.x)], 1u);
      asm volatile("s_waitcnt vmcnt(0)" ::: "memory");
    } else {
      XB_SPIN(xb_ld(&bar[XB_XGEN(b.x)]) == gen, bar);
      __builtin_amdgcn_fence(__ATOMIC_ACQUIRE, "agent");
      asm volatile("s_waitcnt vmcnt(0)" ::: "memory");
    }
  }
  __syncthreads();
}

__global__ void __launch_bounds__(512, 2) mega(Params p_in, int ph_lo, int ph_hi) {
  extern __shared__ __attribute__((aligned(16))) char smem0[];
  char* smem = smem0 + vhalf() * SMEM_BYTES;
  cg::grid_group grid = cg::this_grid();
  const Params& p = p_in;
  bool first = true;
#define RUN(ph) if ((ph) >= ph_lo && (ph) < ph_hi)
  unsigned epoch = 0;
  __shared__ unsigned xb_words[4];
  if (threadIdx.x < 4) xb_words[threadIdx.x] = 0u;
  __syncthreads();
  XcdBarrier xb;
  xb.bar = p.counters + 256; xb.x = 0u; xb.st = (volatile LAS unsigned*)xb_words;
#define SYNC { if (!first) { ++epoch; if (epoch == 1) { grid.sync(); xb = xcd_barrier_post(p.counters + 256, (volatile LAS unsigned*)xb_words); } else xcd_barrier(xb); } first = false; }
  RUN(0) { SYNC; phase_prep(p, smem); }
#pragma unroll 1
  for (int l = 0; l < 2; ++l) {
    const int base = 1 + 9 * l;
    const float* ada_l = p.ada + (size_t)l * 32 * ADAW;
    const bf16_t* Wl = p.wt + (size_t)l * WLAYER;
    const float* xin = (l == 0) ? p.x : p.out;
    RUN(base + 0) { SYNC; phase_norm(xin, p.norm_mix_w + l * DM, ada_l, 0, 1024, p.h); }
    RUN(base + 1) { SYNC; phase_gemm_in(p, l, smem0); }
    RUN(base + 2) { if (l > 0) { SYNC; phase_vlo(p, l, smem); } }
    RUN(base + 3) { SYNC; phase_mix(p, l, smem); }
    RUN(base + 4) { SYNC; phase_merge(p, l, smem); }
    RUN(base + 5) { SYNC; phase_gemm_res(p.u + 1024, US, Wl + WOUT, DM, xin, p.out, ada_l, 2048, smem0); }
    RUN(base + 6) { SYNC; phase_norm(p.out, p.norm_ffn_w + l * DM, ada_l, 3072, 4096, p.h); }
    RUN(base + 7) { SYNC; phase_ffn_in(p, l, smem0); }
    RUN(base + 8) { SYNC; phase_gemm_res(p.u, FFH, Wl + WFO, FFH, p.out, p.out, ada_l, 5120, smem0); }
  }
  RUN(NPHASE - 1) { SYNC; phase_final(p.out, p.final_norm_w); }
}

extern "C" void kernel_launch(void* const* d_in, const int* in_sizes, int n_in, void* d_out, int out_size, void* d_ws,
                              size_t ws_size, hipStream_t stream) {
  Params p{};
  p.x = (const float*)d_in[0]; p.c = (const float*)d_in[1]; p.pos = (const int*)d_in[2];
  p.ada_w = (const float*)d_in[3]; p.ada_b = (const float*)d_in[4]; p.norm_mix_w = (const float*)d_in[5];
  p.norm_ffn_w = (const float*)d_in[6]; p.w_in = (const float*)d_in[7]; p.da_lambda = (const float*)d_in[8];
  p.da_subln_w = (const float*)d_in[9]; p.hg_lb = (const float*)d_in[10]; p.hg_norm_w = (const float*)d_in[11];
  p.rw_mu = (const float*)d_in[12]; p.rw_w0 = (const float*)d_in[13]; p.rw_w2 = (const float*)d_in[14];
  p.rw_a0 = (const float*)d_in[15]; p.rw_a2 = (const float*)d_in[16]; p.rw_g2 = (const float*)d_in[17];
  p.rw_k_k = (const float*)d_in[18]; p.rw_k_a = (const float*)d_in[19]; p.rw_r_k = (const float*)d_in[20];
  p.rw_gn_w = (const float*)d_in[21]; p.rw_gn_b = (const float*)d_in[22]; p.rw_v0 = (const float*)d_in[23];
  p.rw_v1 = (const float*)d_in[24]; p.rw_v2 = (const float*)d_in[25]; p.w_br_a = (const float*)d_in[26];
  p.w_br_b = (const float*)d_in[27]; p.w_br_c = (const float*)d_in[28]; p.w_out = (const float*)d_in[29];
  p.ffn_w_in = (const float*)d_in[30]; p.ffn_w_out = (const float*)d_in[31]; p.final_norm_w = (const float*)d_in[32];
  p.out = (float*)d_out;
  char* ws = (char*)d_ws;
  size_t off = 0;
  auto take = [&](size_t bytes) { char* r = ws + off; off += (bytes + 255) & ~(size_t)255; return r; };
  p.counters = (unsigned*)take(16384);
  p.wt = (bf16_t*)take(2 * WLAYER * 2);
  p.ada = (float*)take((size_t)2 * 32 * ADAW * 4);
  p.h = (bf16_t*)take((size_t)T_TOK * DM * 2);
  p.u = (bf16_t*)take((size_t)T_TOK * US * 2);
  p.vT = (bf16_t*)take((size_t)T_TOK * 512 * 2);
  p.vfirst = (bf16_t*)take((size_t)T_TOK * 512 * 2);
  p.vlo = (float*)take((size_t)T_TOK * 32 * 4);
  if (off > ws_size) { fprintf(stderr, "workspace too small: need %zu have %zu\n", off, ws_size); return; }

  static int grid_blocks = 0;
  if (!grid_blocks) {
    hipFuncSetAttribute((const void*)mega, hipFuncAttributeMaxDynamicSharedMemorySize, 2 * SMEM_BYTES);
    int dev = 0, cus = 0, per_cu = 0;
    hipGetDevice(&dev);
    hipDeviceGetAttribute(&cus, hipDeviceAttributeMultiprocessorCount, dev);
    hipOccupancyMaxActiveBlocksPerMultiprocessor(&per_cu, mega, 512, 2 * SMEM_BYTES);
    if (per_cu > 1) per_cu = 1;
    if (per_cu < 1) per_cu = 1;
    grid_blocks = cus * per_cu;
  }
#if SINGLE_LAUNCH
  int lo = 0, hi = NPHASE;
  void* args[] = {&p, &lo, &hi};
  hipError_t e = hipLaunchCooperativeKernel((void*)mega, dim3(grid_blocks), dim3(512), args, 2 * SMEM_BYTES, stream);
  if (e != hipSuccess) fprintf(stderr, "cooperative launch failed: %s (grid %d)\n", hipGetErrorString(e), grid_blocks);
#else
  for (int ph = 0; ph < NPHASE; ++ph) {
    if (ph == 3) continue;
    hipLaunchKernelGGL(mega, dim3(grid_blocks), dim3(512), 2 * SMEM_BYTES, stream, p, ph, ph + 1);
  }
#endif
}
```

```cpp
#include <hip/hip_runtime.h>
#include <hip/hip_cooperative_groups.h>
#include <stdint.h>
#include <cstdio>
namespace cg = cooperative_groups;

typedef unsigned short bf16_t;
typedef short bf16x8 __attribute__((ext_vector_type(8)));
typedef float f32x4 __attribute__((ext_vector_type(4)));
typedef float f32x2 __attribute__((ext_vector_type(2)));
#define DEV __device__ __forceinline__
#define PHASE __device__ __forceinline__

#ifndef SINGLE_LAUNCH
#define SINGLE_LAUNCH 1
#endif

constexpr int T_TOK = 65536, DM = 1024, SEQ = 2048, US = 4864, ADAW = 6144, FFH = 2816;
constexpr size_t WIN = 0, WBA = 8650752, WBB = 9175040, WBC = 9699328, WOUT = 10223616, WFI = 11272192,
                 WFO = 17039360, WLAYER = 19922944;
constexpr int SMEM_BYTES = 80896;
constexpr int NPHASE = 20;

struct Params {
  const float* x; const float* c; const int* pos;
  const float *ada_w, *ada_b, *norm_mix_w, *norm_ffn_w, *w_in, *da_lambda, *da_subln_w, *hg_lb, *hg_norm_w;
  const float *rw_mu, *rw_w0, *rw_w2, *rw_a0, *rw_a2, *rw_g2, *rw_k_k, *rw_k_a, *rw_r_k, *rw_gn_w, *rw_gn_b;
  const float *rw_v0, *rw_v1, *rw_v2, *w_br_a, *w_br_b, *w_br_c, *w_out, *ffn_w_in, *ffn_w_out, *final_norm_w;
  float* out;
  bf16_t* wt; float* ada; bf16_t* h; bf16_t* u; bf16_t* vT; bf16_t* vfirst; float* vlo; unsigned* counters;
};

DEV unsigned short f2bf(float f) { return (unsigned short)((__float_as_uint(f) + 0x8000u) >> 16); }
DEV float bf2f(unsigned short h) { return __uint_as_float(((unsigned)h) << 16); }
DEV unsigned pack2(float a, float b) {
  return __builtin_amdgcn_perm(__float_as_uint(b) + 0x8000u, __float_as_uint(a) + 0x8000u, 0x07060302u);
}
DEV float sigm(float x) { return __builtin_amdgcn_rcpf(1.f + __expf(-x)); }
DEV float lo16(unsigned v) { return __uint_as_float(v << 16); }
DEV float hi16(unsigned v) { return __uint_as_float(v & 0xFFFF0000u); }
#define UNPACK8(v, f) { f[0]=lo16(v.x); f[1]=hi16(v.x); f[2]=lo16(v.y); f[3]=hi16(v.y); f[4]=lo16(v.z); f[5]=hi16(v.z); f[6]=lo16(v.w); f[7]=hi16(v.w); }
#define PACK8(f) make_uint4(pack2(f[0],f[1]), pack2(f[2],f[3]), pack2(f[4],f[5]), pack2(f[6],f[7]))
template <int CTRL> DEV float dpp(float x) { return __int_as_float(__builtin_amdgcn_update_dpp(0, __float_as_int(x), CTRL, 0xF, 0xF, true)); }
DEV float red8_sum(float x) { x += dpp<0xB1>(x); x += dpp<0x4E>(x); x += dpp<0x141>(x); return x; }
DEV float red16_sum(float x) { x = red8_sum(x); x += dpp<0x140>(x); return x; }
DEV float red16_max(float x) { x = fmaxf(x, dpp<0xB1>(x)); x = fmaxf(x, dpp<0x4E>(x)); x = fmaxf(x, dpp<0x141>(x)); x = fmaxf(x, dpp<0x140>(x)); return x; }
DEV float wave_sum(float x) {
  x = red16_sum(x);
  const int xi = __float_as_int(x);
  return __int_as_float(__builtin_amdgcn_readlane(xi, 0)) + __int_as_float(__builtin_amdgcn_readlane(xi, 16)) +
         __int_as_float(__builtin_amdgcn_readlane(xi, 32)) + __int_as_float(__builtin_amdgcn_readlane(xi, 48));
}
DEV int opaque_tid() { int t = threadIdx.x & 255; asm volatile("" : "+v"(t)); return t; }
DEV int opaque_tid512() { int t = threadIdx.x; asm volatile("" : "+v"(t)); return t; }
DEV int vhalf() { return __builtin_amdgcn_readfirstlane((int)(threadIdx.x >> 8)); }
DEV int vblock() { return (int)blockIdx.x * 2 + vhalf(); }
DEV int vgrid() { return (int)gridDim.x * 2; }
DEV bf16x8 as_frag(uint4 v) { union { uint4 u; bf16x8 b; } c; c.u = v; return c.b; }
#define MFMA(a, b, c) __builtin_amdgcn_mfma_f32_16x16x32_bf16(a, b, c, 0, 0, 0)

template <int NT>
DEV void gemm_tile(const int tid_in, const bf16_t* A, int lda, const bf16_t* B, int ldb, int K, char* smem,
                   f32x4 (&acc)[4][NT]) {
  int tid = tid_in; asm volatile("" : "+v"(tid));
  constexpr int BN = NT * 32;
  constexpr int LS = 64;
  bf16_t* As = (bf16_t*)smem;
  bf16_t* Bs = As + 2 * 128 * LS;
  const int lane = tid & 63, wave = tid >> 6, wr = wave >> 1, wc = wave & 1;
  const int fr = lane & 15, fq = lane >> 4;
  constexpr int NB = BN * 8 / 256;
#pragma unroll
  for (int m = 0; m < 4; ++m)
#pragma unroll
    for (int n = 0; n < NT; ++n) acc[m][n] = (f32x4){0.f, 0.f, 0.f, 0.f};
  const int nk = K >> 6;
  const int lrow = tid >> 3, lcc = tid & 7;
  const bf16_t* Ap = A + (size_t)lrow * lda + ((lcc ^ (lrow & 7)) * 8);
  const bf16_t* Bp = B + (size_t)lrow * ldb + ((lcc ^ (lrow & 7)) * 8);
  const size_t a32 = (size_t)32 * lda, b32 = (size_t)32 * ldb;
  const int rofs0 = (fq ^ (fr & 7)) * 8, rofs1 = rofs0 ^ 32;
#define GT_DMA(buf, koff)                                                                                    \
  {                                                                                                          \
    bf16_t* Ad = As + (buf) * 128 * LS + tid * 8;                                                            \
    bf16_t* Bd = Bs + (buf) * BN * LS + tid * 8;                                                             \
    _Pragma("unroll") for (int i = 0; i < 4; ++i)                                                            \
      __builtin_amdgcn_global_load_lds((const unsigned*)(Ap + i * a32 + (koff)), (unsigned*)(Ad + i * 32 * LS), 16, 0, 0); \
    _Pragma("unroll") for (int i = 0; i < NB; ++i)                                                           \
      __builtin_amdgcn_global_load_lds((const unsigned*)(Bp + i * b32 + (koff)), (unsigned*)(Bd + i * 32 * LS), 16, 0, 0); \
  }
  GT_DMA(0, 0)
  asm volatile("s_waitcnt vmcnt(0)" ::: "memory");
  __syncthreads();
  for (int kt = 0; kt < nk; ++kt) {
    const int buf = kt & 1;
    if (kt + 1 < nk) GT_DMA(buf ^ 1, (kt + 1) * 64)
    const bf16_t* Ab = As + buf * 128 * LS + (wr * 64 + fr) * LS;
    const bf16_t* Bb = Bs + buf * BN * LS + (wc * (NT * 16) + fr) * LS;
#pragma unroll
    for (int ks = 0; ks < 2; ++ks) {
      const int ro = ks ? rofs1 : rofs0;
      bf16x8 af[4], bfr[NT];
#pragma unroll
      for (int m = 0; m < 4; ++m) af[m] = *(const bf16x8*)(Ab + m * 16 * LS + ro);
#pragma unroll
      for (int n = 0; n < NT; ++n) bfr[n] = *(const bf16x8*)(Bb + n * 16 * LS + ro);
#pragma unroll
      for (int m = 0; m < 4; ++m)
#pragma unroll
        for (int n = 0; n < NT; ++n) acc[m][n] = MFMA(af[m], bfr[n], acc[m][n]);
    }
    asm volatile("s_waitcnt vmcnt(0)" ::: "memory");
    __syncthreads();
  }
#undef GT_DMA
}

template <int NT>
DEV void stage_acc(const int tid, float* Cs, const f32x4 (&acc)[4][NT]) {
  constexpr int LDC = NT * 32 + 4;
  const int lane = tid & 63, wave = tid >> 6, wr = wave >> 1, wc = wave & 1, fr = lane & 15, fq = lane >> 4;
#pragma unroll
  for (int m = 0; m < 4; ++m)
#pragma unroll
    for (int n = 0; n < NT; ++n)
#pragma unroll
      for (int j = 0; j < 4; ++j) Cs[(wr * 64 + m * 16 + fq * 4 + j) * LDC + wc * (NT * 16) + n * 16 + fr] = acc[m][n][j];
}

DEV void gemm_tile256(const int tid, const bf16_t* A, int lda, const bf16_t* B, int ldb, int K, char* smem,
                      f32x4 (&acc)[8][4]) {
  bf16_t* As = (bf16_t*)smem;
  bf16_t* Bs = As + 3 * 8192;
  const int lane = tid & 63, wave = tid >> 6, wr = wave >> 1, wc = wave & 1;
  const int fr = lane & 15, fq = lane >> 4;
#pragma unroll
  for (int m = 0; m < 8; ++m)
#pragma unroll
    for (int n = 0; n < 4; ++n) acc[m][n] = (f32x4){0.f, 0.f, 0.f, 0.f};
  const int nk = K >> 5;
  const int drow = tid >> 2, dphys = tid & 3, dg = (0 - (tid >> 4)) & 3;
  const bf16_t* Ap = A + (size_t)drow * lda + ((dphys ^ dg) * 8);
  const bf16_t* Bp = B + (size_t)drow * ldb + ((dphys ^ dg) * 8);
  const size_t a64 = (size_t)64 * lda, b64 = (size_t)64 * ldb;
  const int rofs = (fq ^ ((0 - (fr >> 2)) & 3)) * 8;
#define G2_DMA(st, kk)                                                                                        \
  {                                                                                                           \
    bf16_t* Ad = As + (st) * 8192 + tid * 8;                                                                  \
    bf16_t* Bd = Bs + (st) * 4096 + tid * 8;                                                                  \
    _Pragma("unroll") for (int i = 0; i < 4; ++i)                                                             \
      __builtin_amdgcn_global_load_lds((const unsigned*)(Ap + i * a64 + (kk) * 32), (unsigned*)(Ad + i * 2048), 16, 0, 0); \
    _Pragma("unroll") for (int i = 0; i < 2; ++i)                                                             \
      __builtin_amdgcn_global_load_lds((const unsigned*)(Bp + i * b64 + (kk) * 32), (unsigned*)(Bd + i * 2048), 16, 0, 0); \
  }
  G2_DMA(0, 0)
  G2_DMA(1, 1)
  int st = 0;
  for (int kt = 0; kt < nk; ++kt) {
    if (kt + 1 < nk) asm volatile("s_waitcnt vmcnt(6)" ::: "memory");
    else asm volatile("s_waitcnt vmcnt(0)" ::: "memory");
    __builtin_amdgcn_s_barrier();
    asm volatile("" ::: "memory");
    const int s2 = (st >= 1) ? st - 1 : 2;
    const bool pf = (kt + 2 < nk);
    bf16_t* Ad = As + s2 * 8192 + tid * 8;
    bf16_t* Bd = Bs + s2 * 4096 + tid * 8;
    const bf16_t* Asrc = Ap + (kt + 2) * 32;
    const bf16_t* Bsrc = Bp + (kt + 2) * 32;
    const bf16_t* Ab = As + st * 8192 + (wr * 128 + fr) * 32 + rofs;
    const bf16_t* Bb = Bs + st * 4096 + (wc * 64 + fr) * 32 + rofs;
    bf16x8 bfr[4], af[4];
#pragma unroll
    for (int n = 0; n < 4; ++n) bfr[n] = *(const bf16x8*)(Bb + n * 512);
#pragma unroll
    for (int m = 0; m < 4; ++m) af[m] = *(const bf16x8*)(Ab + m * 512);
#pragma unroll
    for (int m = 0; m < 8; ++m) {
#pragma unroll
      for (int n = 0; n < 4; ++n) acc[m][n] = MFMA(af[m & 3], bfr[n], acc[m][n]);
      if (m + 4 < 8) af[m & 3] = *(const bf16x8*)(Ab + (m + 4) * 512);
      if (pf) {
        if (m < 4) __builtin_amdgcn_global_load_lds((const unsigned*)(Asrc + m * a64), (unsigned*)(Ad + m * 2048), 16, 0, 0);
        else if (m < 6) __builtin_amdgcn_global_load_lds((const unsigned*)(Bsrc + (m - 4) * b64), (unsigned*)(Bd + (m - 4) * 2048), 16, 0, 0);
      }
      __builtin_amdgcn_sched_barrier(0);
    }
    st = (st == 2) ? 0 : st + 1;
  }
#undef G2_DMA
  __syncthreads();
}

template <int PS>
DEV void stage_half(const int tid, float* Cs, const f32x4 (&acc)[8][4]) {
  const int lane = tid & 63, wave = tid >> 6, wr = wave >> 1, wc = wave & 1, fr = lane & 15, fq = lane >> 4;
#pragma unroll
  for (int m = 0; m < 4; ++m)
#pragma unroll
    for (int n = 0; n < 4; ++n)
#pragma unroll
      for (int j = 0; j < 4; ++j) Cs[(wr * 64 + m * 16 + fq * 4 + j) * 132 + wc * 64 + n * 16 + fr] = acc[PS * 4 + m][n][j];
}
#define RMAP(r, ps) ((((r) >> 6) << 7) + (ps) * 64 + ((r) & 63))

DEV void gemm_tile512(const int T, const bf16_t* A, int lda, const bf16_t* B, int ldb, int K, char* smem0,
                      f32x4 (&acc)[8][4]) {
  bf16_t* As = (bf16_t*)smem0;
  bf16_t* Bs = As + 2 * 16384;
  const int lane = T & 63, wave = T >> 6, wr = wave >> 2, wc = wave & 3;
  const int fr = lane & 15, fq = lane >> 4;
#pragma unroll
  for (int m = 0; m < 8; ++m)
#pragma unroll
    for (int n = 0; n < 4; ++n) acc[m][n] = (f32x4){0.f, 0.f, 0.f, 0.f};
  const int nk = K >> 6;
  const int drow = T >> 3, dlog = ((T & 7) ^ ((T >> 3) & 7)) * 8;
  const bf16_t* Ap = A + (size_t)drow * lda + dlog;
  const bf16_t* Bp = B + (size_t)drow * ldb + dlog;
  const size_t a64 = (size_t)64 * lda, b64 = (size_t)64 * ldb;
  const int rofs0 = (fq ^ (fr & 7)) * 8, rofs1 = rofs0 ^ 32;
#pragma unroll
  for (int i = 0; i < 4; ++i) {
    __builtin_amdgcn_global_load_lds((const unsigned*)(Ap + i * a64), (unsigned*)(As + T * 8 + i * 4096), 16, 0, 0);
    __builtin_amdgcn_global_load_lds((const unsigned*)(Bp + i * b64), (unsigned*)(Bs + T * 8 + i * 4096), 16, 0, 0);
  }
  asm volatile("s_waitcnt vmcnt(0)" ::: "memory");
  __syncthreads();
  for (int kt = 0; kt < nk; ++kt) {
    const int buf = kt & 1;
    const bool pf = (kt + 1 < nk);
    bf16_t* Ad = As + (buf ^ 1) * 16384 + T * 8;
    bf16_t* Bd = Bs + (buf ^ 1) * 16384 + T * 8;
    const bf16_t* Asrc = Ap + (kt + 1) * 64;
    const bf16_t* Bsrc = Bp + (kt + 1) * 64;
    const bf16_t* Ab = As + buf * 16384 + (wr * 128 + fr) * 64;
    const bf16_t* Bb = Bs + buf * 16384 + (wc * 64 + fr) * 64;
#pragma unroll
    for (int ks = 0; ks < 2; ++ks) {
      const int ro = ks ? rofs1 : rofs0;
      bf16x8 bfr[4], af[4];
#pragma unroll
      for (int n = 0; n < 4; ++n) bfr[n] = *(const bf16x8*)(Bb + n * 1024 + ro);
#pragma unroll
      for (int m = 0; m < 4; ++m) af[m] = *(const bf16x8*)(Ab + m * 1024 + ro);
#pragma unroll
      for (int m = 0; m < 8; ++m) {
#pragma unroll
        for (int n = 0; n < 4; ++n) acc[m][n] = MFMA(af[m & 3], bfr[n], acc[m][n]);
        if (m + 4 < 8) af[m & 3] = *(const bf16x8*)(Ab + (m + 4) * 1024 + ro);
        if (pf && ks == 0 && m < 4) {
          __builtin_amdgcn_global_load_lds((const unsigned*)(Asrc + m * a64), (unsigned*)(Ad + m * 4096), 16, 0, 0);
          __builtin_amdgcn_global_load_lds((const unsigned*)(Bsrc + m * b64), (unsigned*)(Bd + m * 4096), 16, 0, 0);
        }
        __builtin_amdgcn_sched_barrier(0);
      }
    }
    asm volatile("s_waitcnt vmcnt(0)" ::: "memory");
    __builtin_amdgcn_s_barrier();
    asm volatile("" ::: "memory");
  }
  __syncthreads();
}
template <int PS>
DEV void stage_half512(const int T, float* Cs, const f32x4 (&acc)[8][4]) {
  const int lane = T & 63, wave = T >> 6, wc = wave & 3, fr = lane & 15, fq = lane >> 4;
#pragma unroll
  for (int m = 0; m < 4; ++m)
#pragma unroll
    for (int n = 0; n < 4; ++n)
#pragma unroll
      for (int j = 0; j < 4; ++j) Cs[((wc >> 1) * 64 + m * 16 + fq * 4 + j) * 132 + (wc & 1) * 64 + n * 16 + fr] = acc[PS * 4 + m][n][j];
}
#define GROW(r, ps) (row0 + (size_t)(hf * 128 + (ps) * 64 + ((r) & 63)))
#define TNC(r) (tn * 2 + ((r) >> 6))

DEV bool tile_for(int it, int nM, int nN, int& tm, int& tn) {
  const int nx = (gridDim.x >> 3) * 2;
  const int xcd = blockIdx.x & 7, local = (blockIdx.x >> 3) * 2 + vhalf();
  const long id = ((long)it * 8 + xcd) * nx + local;
  if (local >= nx || id >= (long)nM * nN) return false;
  const int per_group = 8 * nN;
  const int g = (int)(id / per_group), r = (int)(id % per_group);
  tn = r >> 3; tm = g * 8 + (r & 7);
  return true;
}

DEV bool tile_for_real(int it, int nM, int nN, int& tm, int& tn) {
  const int nx = (gridDim.x >> 3);
  const int xcd = blockIdx.x & 7, local = (blockIdx.x >> 3);
  const long id = ((long)it * 8 + xcd) * nx + local;
  if (local >= nx || id >= (long)nM * nN) return false;
  const int per_group = 8 * nN;
  const int g = (int)(id / per_group), r = (int)(id % per_group);
  tn = r >> 3; tm = g * 8 + (r & 7);
  return true;
}

PHASE void phase_prep(const Params& p, char* smem) {
  const int tid = opaque_tid();
  const int vb = vblock(), vg = vgrid();
  if (vb == 0 && tid < 8) p.counters[tid] = 0u;
  if (vb == 1 && tid < 2) {
    const float* lv = p.da_lambda + (size_t)tid * 256;
    float d1 = 0.f, d2 = 0.f;
    for (int i = 0; i < 64; ++i) { d1 += lv[i] * lv[64 + i]; d2 += lv[128 + i] * lv[192 + i]; }
    p.counters[32 + tid] = __float_as_uint(__expf(d1) - __expf(d2) + (0.8f - 0.6f * __expf(-0.3f * (float)tid)));
  }
  if (vb == 0) for (int i = tid; i < 3456; i += 256) p.counters[256 + i] = 0u;
  float* tile = (float*)smem;
  const int NCONV = 2 * 4864, NADA = 192;
  for (int item0 = vb; item0 < NCONV + NADA; item0 += vg) {
    const int item = (item0 < NADA) ? (NCONV + item0) : (item0 - NADA);
    if (item < NCONV) {
      const int l = item / 4864; int r = item % 4864;
      const float* src; int K, Nsrc, nT, perm = 0; size_t dst;
      if (r < 2112) { src = p.w_in + (size_t)l * 1024 * 8448; K = 1024; Nsrc = 8448; dst = WIN; nT = 132; }
      else if (r < 2240) { r -= 2112; src = p.w_br_a + (size_t)l * 512 * 1024; K = 512; Nsrc = 1024; dst = WBA; nT = 16; }
      else if (r < 2368) { r -= 2240; src = p.w_br_b + (size_t)l * 512 * 1024; K = 512; Nsrc = 1024; dst = WBB; nT = 16; }
      else if (r < 2496) { r -= 2368; src = p.w_br_c + (size_t)l * 512 * 1024; K = 512; Nsrc = 1024; dst = WBC; nT = 16; }
      else if (r < 2752) { r -= 2496; src = p.w_out + (size_t)l * 1024 * 1024; K = 1024; Nsrc = 1024; dst = WOUT; nT = 16; }
      else if (r < 4160) { r -= 2752; src = p.ffn_w_in + (size_t)l * 1024 * 5632; K = 1024; Nsrc = 5632; dst = WFI; nT = 88; perm = 1; }
      else { r -= 4160; src = p.ffn_w_out + (size_t)l * 2816 * 1024; K = 2816; Nsrc = 1024; dst = WFO; nT = 16; }
      const int kt = r / nT, nt = r % nT;
      const int colbase = perm ? ((nt & 1) * FFH + 64 * (nt >> 1)) : nt * 64;
      __syncthreads();
#pragma unroll
      for (int i = 0; i < 16; ++i) {
        const int k = i * 4 + (tid >> 6), j = tid & 63;
        tile[k * 65 + j] = src[(size_t)(kt * 64 + k) * Nsrc + colbase + j];
      }
      __syncthreads();
      const int row = tid >> 2, kc = (tid & 3) * 16;
      float f[16];
#pragma unroll
      for (int i = 0; i < 16; ++i) f[i] = tile[(kc + i) * 65 + row];
      bf16_t* d = p.wt + (size_t)l * WLAYER + dst + (size_t)(nt * 64 + row) * K + kt * 64 + kc;
      *(uint4*)d = make_uint4(pack2(f[0], f[1]), pack2(f[2], f[3]), pack2(f[4], f[5]), pack2(f[6], f[7]));
      *(uint4*)(d + 8) = make_uint4(pack2(f[8], f[9]), pack2(f[10], f[11]), pack2(f[12], f[13]), pack2(f[14], f[15]));
    } else {
      const int a = item - NCONV;
      const int l = a / 96, r = a % 96, ntile = r >> 2, bg = r & 3;
      float* cact = (float*)smem;
      __syncthreads();
      for (int i = tid; i < 8 * 1024; i += 256) {
        const float cv = p.c[(size_t)(bg * 8 + (i >> 10)) * DM + (i & 1023)];
        cact[i] = cv * sigm(cv);
      }
      __syncthreads();
      const int n = ntile * 256 + tid;
      const float* W = p.ada_w + (size_t)l * DM * ADAW + n;
      float acc[8];
#pragma unroll
      for (int b = 0; b < 8; ++b) acc[b] = 0.f;
      for (int k0 = 0; k0 < DM; k0 += 16) {
        float w[16];
#pragma unroll
        for (int kk = 0; kk < 16; ++kk) w[kk] = W[(size_t)(k0 + kk) * ADAW];
#pragma unroll
        for (int kk = 0; kk < 16; ++kk)
#pragma unroll
          for (int b = 0; b < 8; ++b) acc[b] += cact[b * 1024 + k0 + kk] * w[kk];
      }
      const float bias = p.ada_b[l * ADAW + n];
#pragma unroll
      for (int b = 0; b < 8; ++b) p.ada[((size_t)l * 32 + bg * 8 + b) * ADAW + n] = acc[b] + bias;
    }
  }
}

PHASE void phase_norm(const float* __restrict__ x, const float* __restrict__ w, const float* __restrict__ ada_l,
                    int shift_off, int scale_off, bf16_t* __restrict__ h) {
  const int tid = opaque_tid();
  const int lane = tid & 63, wave = tid >> 6;
  for (int row0 = (vblock() * 4 + wave) * 4; row0 < T_TOK; row0 += vgrid() * 16) {
    float4 v[4][4]; float ss[4];
#pragma unroll
    for (int rr = 0; rr < 4; ++rr)
#pragma unroll
      for (int i = 0; i < 4; ++i) v[rr][i] = *(const float4*)(x + (size_t)(row0 + rr) * DM + i * 256 + lane * 4);
#pragma unroll
    for (int rr = 0; rr < 4; ++rr) {
      float a = 0.f;
#pragma unroll
      for (int i = 0; i < 4; ++i) a += v[rr][i].x * v[rr][i].x + v[rr][i].y * v[rr][i].y + v[rr][i].z * v[rr][i].z + v[rr][i].w * v[rr][i].w;
      ss[rr] = rsqrtf(wave_sum(a) * (1.f / DM) + 1e-6f);
    }
    const float* ad = ada_l + (size_t)(row0 / SEQ) * ADAW;
#pragma unroll
    for (int i = 0; i < 4; ++i) {
      const int col = i * 256 + lane * 4;
      const float4 ww = *(const float4*)(w + col), sc = *(const float4*)(ad + scale_off + col), sh = *(const float4*)(ad + shift_off + col);
#pragma unroll
      for (int rr = 0; rr < 4; ++rr) {
        const float rstd = ss[rr];
        const float o0 = v[rr][i].x * rstd * ww.x * (1.f + sc.x) + sh.x, o1 = v[rr][i].y * rstd * ww.y * (1.f + sc.y) + sh.y;
        const float o2 = v[rr][i].z * rstd * ww.z * (1.f + sc.z) + sh.z, o3 = v[rr][i].w * rstd * ww.w * (1.f + sc.w) + sh.w;
        *(uint2*)(h + (size_t)(row0 + rr) * DM + col) = make_uint2(pack2(o0, o1), pack2(o2, o3));
      }
    }
  }
}

PHASE void phase_final(float* __restrict__ x, const float* __restrict__ w) {
  const int tid = opaque_tid();
  const int lane = tid & 63, wave = tid >> 6;
  for (int row0 = (vblock() * 4 + wave) * 4; row0 < T_TOK; row0 += vgrid() * 16) {
    float4 v[4][4]; float ss[4];
#pragma unroll
    for (int rr = 0; rr < 4; ++rr)
#pragma unroll
      for (int i = 0; i < 4; ++i) v[rr][i] = *(const float4*)(x + (size_t)(row0 + rr) * DM + i * 256 + lane * 4);
#pragma unroll
    for (int rr = 0; rr < 4; ++rr) {
      float a = 0.f;
#pragma unroll
      for (int i = 0; i < 4; ++i) a += v[rr][i].x * v[rr][i].x + v[rr][i].y * v[rr][i].y + v[rr][i].z * v[rr][i].z + v[rr][i].w * v[rr][i].w;
      ss[rr] = rsqrtf(wave_sum(a) * (1.f / DM) + 1e-6f);
    }
#pragma unroll
    for (int i = 0; i < 4; ++i) {
      const int col = i * 256 + lane * 4;
      const float4 ww = *(const float4*)(w + col);
#pragma unroll
      for (int rr = 0; rr < 4; ++rr) {
        const float rstd = ss[rr];
        *(float4*)(x + (size_t)(row0 + rr) * DM + col) =
            make_float4(v[rr][i].x * rstd * ww.x, v[rr][i].y * rstd * ww.y, v[rr][i].z * rstd * ww.z, v[rr][i].w * rstd * ww.w);
      }
    }
  }
}

PHASE void phase_gemm_in(const Params& p, int l, char* smem0) {
  const bf16_t* Wt = p.wt + (size_t)l * WLAYER + WIN;
  const int T = opaque_tid512(), tid = T & 255, hf = vhalf();
  float* Cs = (float*)(smem0 + hf * SMEM_BYTES);
  for (int it = 0;; ++it) {
    int tm, tn;
    if (!tile_for_real(it, 256, 21, tm, tn)) break;
    f32x4 acc[8][4];
    gemm_tile512(T, p.h + (size_t)tm * 256 * DM, DM, Wt + (size_t)tn * 256 * DM, DM, DM, smem0, acc);
    const size_t row0 = (size_t)tm * 256;
#pragma unroll
    for (int ps = 0; ps < 2; ++ps) {
      if (ps == 0) stage_half512<0>(T, Cs, acc); else stage_half512<1>(T, Cs, acc);
      __syncthreads();
      if (tn < 4) {
        const float qs = (tn < 2) ? 0.125f : 1.f;
        const int ch = tid & 15, g = ch >> 3, cc = ch & 7;
        if (cc < 4) {
#pragma unroll 1
          for (int i = 0; i < 8; ++i) {
            const int r = (tid >> 4) + i * 16;
            const size_t grow = GROW(r, ps);
            const float pos = (float)p.pos[grow];
            const float* c1 = Cs + r * 132 + g * 64 + cc * 8;
            float o1[8], o2[8];
#pragma unroll
            for (int e = 0; e < 8; ++e) {
              const float x1 = c1[e], x2 = c1[32 + e];
              const float inv = exp2f(-(float)(cc * 8 + e) * 0.41524101186092029f);
              float rev = pos * inv * 0.15915494309189535f;
              rev -= rintf(rev);
              const float sn = __builtin_amdgcn_sinf(rev), cs = __builtin_amdgcn_cosf(rev);
              o1[e] = (x1 * cs - x2 * sn) * qs; o2[e] = (x2 * cs + x1 * sn) * qs;
            }
            bf16_t* d = p.u + grow * US + TNC(r) * 128 + g * 64 + cc * 8;
            *(uint4*)d = PACK8(o1);
            *(uint4*)(d + 32) = PACK8(o2);
          }
        }
      } else if (tn < 6) {
        const int b = (int)(row0 / SEQ), s0 = (int)(row0 % SEQ);
        const int rch = tid & 15;
        const int vc0 = (TNC(rch * 8) - 8) * 128;
#pragma unroll 1
        for (int i = 0; i < 8; ++i) {
          const int c = (tid >> 4) + i * 16;
          float f[8];
#pragma unroll
          for (int j = 0; j < 8; ++j) f[j] = Cs[(rch * 8 + j) * 132 + c];
          *(uint4*)(p.vT + ((size_t)b * 512 + vc0 + c) * SEQ + s0 + hf * 128 + ps * 64 + ((rch * 8) & 63)) = PACK8(f);
        }
      } else {
        const int ch = tid & 15;
#pragma unroll 1
        for (int i = 0; i < 8; ++i) {
          const int r = (tid >> 4) + i * 16;
          const float4 a = *(const float4*)(Cs + r * 132 + ch * 8), b = *(const float4*)(Cs + r * 132 + ch * 8 + 4);
          *(uint4*)(p.u + GROW(r, ps) * US + TNC(r) * 128 - 512 + ch * 8) = make_uint4(pack2(a.x, a.y), pack2(a.z, a.w), pack2(b.x, b.y), pack2(b.z, b.w));
        }
      }
      __syncthreads();
    }
  }
}

PHASE void phase_vlo(const Params& p, int l, char* smem) {
  float* vs = (float*)smem;
  const int tid = opaque_tid();
  const float* mu = p.rw_mu + (size_t)l * 1792 + 1024;
  const float* v1 = p.rw_v1;
  for (int item = vblock(); item < T_TOK / 32; item += vgrid()) {
    const size_t tok0 = (size_t)item * 32;
    __syncthreads();
#pragma unroll 1
    for (int i = 0; i < 8; ++i) {
      const int c = tid + i * 256;
      const int t = c >> 6, cc = c & 63;
      const size_t tok = tok0 + t;
      const uint4 cur = *(const uint4*)(p.u + tok * US + 3072 + 1024 + cc * 8);
      uint4 prv = make_uint4(0, 0, 0, 0);
      if ((tok % SEQ) != 0) prv = *(const uint4*)(p.u + (tok - 1) * US + 3072 + 1024 + cc * 8);
      float a[8], b[8];
      UNPACK8(cur, a); UNPACK8(prv, b);
#pragma unroll
      for (int e = 0; e < 8; ++e) vs[t * 512 + cc * 8 + e] = a[e] + (b[e] - a[e]) * mu[cc * 8 + e];
    }
    __syncthreads();
    const int j = tid & 31, tg = tid >> 5;
    float acc[4] = {0.f, 0.f, 0.f, 0.f};
    for (int k0 = 0; k0 < 512; k0 += 16) {
      float w[16];
#pragma unroll
      for (int kk = 0; kk < 16; ++kk) w[kk] = v1[(k0 + kk) * 32 + j];
#pragma unroll
      for (int kk = 0; kk < 16; ++kk)
#pragma unroll
        for (int i = 0; i < 4; ++i) acc[i] += vs[(tg * 4 + i) * 512 + k0 + kk] * w[kk];
    }
#pragma unroll
    for (int i = 0; i < 4; ++i) p.vlo[(tok0 + tg * 4 + i) * 32 + j] = acc[i];
  }
}

PHASE void att_item(const Params& p, int l, int item, char* smem) {
  const int qc = 31 - (item >> 7);
  const int bh = item & 127, b = bh >> 2, h = bh & 3;
  const int tid = opaque_tid(), lane = tid & 63, wave = tid >> 6, fr = lane & 15, fq = lane >> 4;
  const int m = wave >> 1, rh = wave & 1;
  bf16_t* Ks = (bf16_t*)smem;
  bf16_t* Vt = Ks + 2 * 64 * 64;
  bf16_t* Ps = Vt + 128 * 64;
  float* Ox = (float*)smem;
  const size_t tok0 = (size_t)b * SEQ + (size_t)qc * 64;
  const float lam_init = 0.8f - 0.6f * __expf(-0.3f * (float)l);
  const float lam = __uint_as_float(p.counters[32 + l]);

  bf16x8 qf[2][2];
#pragma unroll
  for (int mt = 0; mt < 2; ++mt)
#pragma unroll
    for (int ks = 0; ks < 2; ++ks)
      qf[mt][ks] = *(const bf16x8*)(p.u + (tok0 + rh * 32 + mt * 16 + fr) * US + h * 128 + m * 64 + ks * 32 + fq * 8);
  f32x4 o[2][8];
  float mx[2][4], ls[2][4];
#pragma unroll
  for (int mt = 0; mt < 2; ++mt) {
#pragma unroll
    for (int n = 0; n < 8; ++n) o[mt][n] = (f32x4){0.f, 0.f, 0.f, 0.f};
#pragma unroll
    for (int j = 0; j < 4; ++j) { mx[mt][j] = -1e30f; ls[mt][j] = 0.f; }
  }
  bf16_t* Pw = Ps + wave * 32 * 72;
  const int drow = tid >> 3, dlog = ((tid & 7) ^ ((tid >> 3) & 7)) * 8;
  const bf16_t* Kg = p.u + ((size_t)b * SEQ + (drow & 63)) * US + 512 + h * 128 + dlog;
  const bf16_t* Vg = p.vT + ((size_t)b * 512 + h * 128 + drow) * SEQ + dlog;
  const int rsw = fr & 7;
#define ATT_DMA_K(kt_)                                                                                              \
  _Pragma("unroll") for (int i = 0; i < 4; ++i)                                                                     \
    __builtin_amdgcn_global_load_lds((const unsigned*)(Kg + ((size_t)(kt_) * 64 + (i & 1) * 32) * US + (i >> 1) * 64), \
                                     (unsigned*)(Ks + tid * 8 + i * 2048), 16, 0, 0);
#define ATT_DMA_V(kt_)                                                                                              \
  _Pragma("unroll") for (int i = 0; i < 4; ++i)                                                                     \
    __builtin_amdgcn_global_load_lds((const unsigned*)(Vg + (size_t)(i * 32) * SEQ + (kt_) * 64),                  \
                                     (unsigned*)(Vt + tid * 8 + i * 2048), 16, 0, 0);
  __syncthreads();
  ATT_DMA_K(0)
  for (int kt = 0; kt <= qc; ++kt) {
    asm volatile("s_waitcnt vmcnt(0)" ::: "memory");
    __syncthreads();
    ATT_DMA_V(kt)
    f32x4 s[2][4];
#pragma unroll
    for (int mt = 0; mt < 2; ++mt)
#pragma unroll
      for (int n = 0; n < 4; ++n) s[mt][n] = (f32x4){0.f, 0.f, 0.f, 0.f};
#pragma unroll
    for (int ks = 0; ks < 2; ++ks)
#pragma unroll
      for (int n = 0; n < 4; ++n) {
        const bf16x8 kf = *(const bf16x8*)(Ks + (m * 64 + n * 16 + fr) * 64 + (((ks * 4 + fq) ^ rsw) * 8));
#pragma unroll
        for (int mt = 0; mt < 2; ++mt) s[mt][n] = MFMA(qf[mt][ks], kf, s[mt][n]);
      }
#pragma unroll
    for (int mt = 0; mt < 2; ++mt)
#pragma unroll
      for (int j = 0; j < 4; ++j) {
        float tmax = fmaxf(fmaxf(s[mt][0][j], s[mt][1][j]), fmaxf(s[mt][2][j], s[mt][3][j]));
        tmax = red16_max(tmax);
        const float mnew = fmaxf(mx[mt][j], tmax);
        const float alpha = __expf(mx[mt][j] - mnew);
        float rs = 0.f;
#pragma unroll
        for (int n = 0; n < 4; ++n) {
          const float pv = __expf(s[mt][n][j] - mnew);
          rs += pv;
          Pw[(mt * 16 + fq * 4 + j) * 72 + n * 16 + fr] = f2bf(pv);
        }
        rs = red16_sum(rs);
        ls[mt][j] = ls[mt][j] * alpha + rs;
        mx[mt][j] = mnew;
#pragma unroll
        for (int n = 0; n < 8; ++n) o[mt][n][j] *= alpha;
      }
    asm volatile("s_waitcnt vmcnt(0)" ::: "memory");
    __syncthreads();
    if (kt < qc) { ATT_DMA_K(kt + 1) }
#pragma unroll
    for (int ks = 0; ks < 2; ++ks) {
      bf16x8 pf[2];
#pragma unroll
      for (int mt = 0; mt < 2; ++mt) pf[mt] = *(const bf16x8*)(Pw + (mt * 16 + fr) * 72 + ks * 32 + fq * 8);
#pragma unroll
      for (int n = 0; n < 8; ++n) {
        const bf16x8 vf = *(const bf16x8*)(Vt + (n * 16 + fr) * 64 + (((ks * 4 + fq) ^ rsw) * 8));
#pragma unroll
        for (int mt = 0; mt < 2; ++mt) o[mt][n] = MFMA(pf[mt], vf, o[mt][n]);
      }
    }
  }
#undef ATT_DMA_K
#undef ATT_DMA_V
  __syncthreads();
#pragma unroll
  for (int mt = 0; mt < 2; ++mt)
#pragma unroll
    for (int j = 0; j < 4; ++j) {
      const float inv = __builtin_amdgcn_rcpf(ls[mt][j]);
#pragma unroll
      for (int n = 0; n < 8; ++n) o[mt][n][j] *= inv;
    }
  if (m == 1) {
#pragma unroll
    for (int mt = 0; mt < 2; ++mt)
#pragma unroll
      for (int n = 0; n < 8; ++n)
#pragma unroll
        for (int j = 0; j < 4; ++j) Ox[(rh * 32 + mt * 16 + fq * 4 + j) * 132 + n * 16 + fr] = o[mt][n][j];
  }
  __syncthreads();
  if (m == 0) {
    const float* sw = p.da_subln_w + (size_t)l * 128;
    float wv[8];
#pragma unroll
    for (int n = 0; n < 8; ++n) wv[n] = sw[n * 16 + fr] * (1.f - lam_init);
#pragma unroll
    for (int mt = 0; mt < 2; ++mt)
#pragma unroll
      for (int j = 0; j < 4; ++j) {
        float ss = 0.f;
        float d[8];
#pragma unroll
        for (int n = 0; n < 8; ++n) {
          d[n] = o[mt][n][j] - lam * Ox[(rh * 32 + mt * 16 + fq * 4 + j) * 132 + n * 16 + fr];
          ss += d[n] * d[n];
        }
        ss = red16_sum(ss);
        const float rstd = rsqrtf(ss * (1.f / 128.f) + 1e-6f);
        bf16_t* dst = p.u + (tok0 + rh * 32 + mt * 16 + fq * 4 + j) * US + h * 128 + fr;
#pragma unroll
        for (int n = 0; n < 8; ++n) dst[n * 16] = f2bf(d[n] * rstd * wv[n]);
      }
  }
  __syncthreads();
}

PHASE void hgrn_item(const Params& p, int l, int item, char* smem) {
  const int b = item >> 2, h = item & 3;
  const int tid = opaque_tid(), lane = tid & 63, wave = tid >> 6, fr = lane & 15, fq = lane >> 4;
  bf16_t* Qs = (bf16_t*)smem;
  bf16_t* Kn = Qs + 32 * 136;
  bf16_t* KT = Kn + 32 * 136;
  bf16_t* VT = KT + 128 * 40;
  bf16_t* Ps = VT + 128 * 40;
  bf16_t* ST = Ps + 32 * 40;
  float* lfb = (float*)ST;
  float* red = (float*)(ST + 128 * 136);
  float* blast = red + 64;
  const int t_ = tid >> 3, d0 = (tid & 7) * 16;
  float lbv[16];
#pragma unroll
  for (int i = 0; i < 16; ++i) {
    const int c = h * 128 + d0 + i;
    lbv[i] = (l == 0) ? 0.f : sigm(p.hg_lb[512 + c] - p.hg_lb[c]);
  }
  f32x4 S[2][8];
#pragma unroll
  for (int mm = 0; mm < 2; ++mm)
#pragma unroll
    for (int n = 0; n < 8; ++n) S[mm][n] = (f32x4){0.f, 0.f, 0.f, 0.f};
  const float* nw = p.hg_norm_w + (size_t)l * 128;

  for (int ch = 0; ch < 64; ++ch) {
    const size_t tok0 = (size_t)b * SEQ + (size_t)ch * 32;
    __syncthreads();
    float qv[16], kv[16];
    {
      const bf16_t* base = p.u + (tok0 + t_) * US + h * 128 + d0;
      float zv[16], iv[16];
      { const uint4 a = *(const uint4*)(base + 1024), c = *(const uint4*)(base + 1024 + 8); float* z0 = zv; float* z1 = zv + 8; UNPACK8(a, z0); UNPACK8(c, z1); }
      { const uint4 a = *(const uint4*)(base + 1536), c = *(const uint4*)(base + 1536 + 8); float* z0 = iv; float* z1 = iv + 8; UNPACK8(a, z0); UNPACK8(c, z1); }
      { const uint4 a = *(const uint4*)(base + 2048), c = *(const uint4*)(base + 2048 + 8); float* z0 = qv; float* z1 = qv + 8; UNPACK8(a, z0); UNPACK8(c, z1); }
#pragma unroll
      for (int i = 0; i < 16; ++i) {
        const float z = zv[i], lb = lbv[i];
        const float ez = __expf(-fabsf(z));
        float lf;
        if (lb > 0.f) {
          const float rz = __builtin_amdgcn_rcpf(1.f + ez);
          const float sg = (z >= 0.f) ? rz : ez * rz;
          lf = __logf(lb + (1.f - lb) * sg);
        } else {
          lf = -(fmaxf(-z, 0.f) + __logf(1.f + ez));
        }
        const float rz2 = __builtin_amdgcn_rcpf(1.f + ez);
        const float sgn = (z >= 0.f) ? ez * rz2 : rz2;
        kv[i] = (1.f - lb) * sgn;
        lfb[t_ * 128 + d0 + i] = lf;
        VT[(d0 + i) * 40 + t_] = f2bf(iv[i]);
      }
    }
    __syncthreads();
    if (tid < 128) {
      float v[32];
#pragma unroll
      for (int t = 0; t < 32; ++t) v[t] = lfb[t * 128 + tid];
      float bsum = 0.f;
#pragma unroll
      for (int t = 0; t < 32; ++t) { bsum += v[t]; lfb[t * 128 + tid] = bsum; }
      blast[tid] = bsum;
    }
    __syncthreads();
    {
      float qo[16], ko[16];
#pragma unroll
      for (int i = 0; i < 16; ++i) {
        const float bb = lfb[t_ * 128 + d0 + i];
        qo[i] = qv[i] * __expf(bb);
        ko[i] = kv[i] * __expf(fminf(-bb, 80.f));
        KT[(d0 + i) * 40 + t_] = f2bf(ko[i]);
      }
      float* q0 = qo; float* q1 = qo + 8; float* k0 = ko; float* k1 = ko + 8;
      *(uint4*)(Qs + t_ * 136 + d0) = PACK8(q0);
      *(uint4*)(Qs + t_ * 136 + d0 + 8) = PACK8(q1);
      *(uint4*)(Kn + t_ * 136 + d0) = PACK8(k0);
      *(uint4*)(Kn + t_ * 136 + d0 + 8) = PACK8(k1);
    }
    __syncthreads();
#pragma unroll
    for (int mm = 0; mm < 2; ++mm)
#pragma unroll
      for (int n = 0; n < 8; ++n)
        *(uint2*)(ST + (n * 16 + fr) * 136 + wave * 32 + mm * 16 + fq * 4) =
            make_uint2(pack2(S[mm][n][0], S[mm][n][1]), pack2(S[mm][n][2], S[mm][n][3]));
    {
      const int mt = wave >> 1, nt = wave & 1;
      f32x4 sc = (f32x4){0.f, 0.f, 0.f, 0.f};
#pragma unroll
      for (int ks = 0; ks < 4; ++ks) {
        const bf16x8 a = *(const bf16x8*)(Qs + (mt * 16 + fr) * 136 + ks * 32 + fq * 8);
        const bf16x8 bb = *(const bf16x8*)(Kn + (nt * 16 + fr) * 136 + ks * 32 + fq * 8);
        sc = MFMA(a, bb, sc);
      }
#pragma unroll
      for (int j = 0; j < 4; ++j) {
        const int t = mt * 16 + fq * 4 + j, key = nt * 16 + fr;
        Ps[t * 40 + key] = f2bf(key <= t ? sc[j] : 0.f);
      }
    }
    __syncthreads();
    {
      const int mt = wave & 1, nb = (wave >> 1) * 4;
      f32x4 oo[4];
#pragma unroll
      for (int n = 0; n < 4; ++n) oo[n] = (f32x4){0.f, 0.f, 0.f, 0.f};
      {
        const bf16x8 a = *(const bf16x8*)(Ps + (mt * 16 + fr) * 40 + fq * 8);
#pragma unroll
        for (int n = 0; n < 4; ++n) {
          const bf16x8 bb = *(const bf16x8*)(VT + ((nb + n) * 16 + fr) * 40 + fq * 8);
          oo[n] = MFMA(a, bb, oo[n]);
        }
      }
#pragma unroll
      for (int ks = 0; ks < 4; ++ks) {
        const bf16x8 a = *(const bf16x8*)(Qs + (mt * 16 + fr) * 136 + ks * 32 + fq * 8);
#pragma unroll
        for (int n = 0; n < 4; ++n) {
          const bf16x8 bb = *(const bf16x8*)(ST + ((nb + n) * 16 + fr) * 136 + ks * 32 + fq * 8);
          oo[n] = MFMA(a, bb, oo[n]);
        }
      }
#pragma unroll
      for (int j = 0; j < 4; ++j) {
        float ss = 0.f;
#pragma unroll
        for (int n = 0; n < 4; ++n) ss += oo[n][j] * oo[n][j];
        ss = red16_sum(ss);
        if (fr == 0) red[(mt * 16 + fq * 4 + j) * 2 + (wave >> 1)] = ss;
      }
      __syncthreads();
#pragma unroll
      for (int j = 0; j < 4; ++j) {
        const int t = mt * 16 + fq * 4 + j;
        const float rstd = rsqrtf((red[t * 2] + red[t * 2 + 1]) * (1.f / 128.f) + 1e-6f);
        bf16_t* gp = p.u + (tok0 + t) * US + 2560 + h * 128 + nb * 16 + fr;
#pragma unroll
        for (int n = 0; n < 4; ++n) {
          const float g = bf2f(gp[n * 16]);
          gp[n * 16] = f2bf(oo[n][j] * rstd * nw[(nb + n) * 16 + fr] * (g * sigm(g)));
        }
      }
    }
    {
      bf16x8 af[2];
#pragma unroll
      for (int mm = 0; mm < 2; ++mm) af[mm] = *(const bf16x8*)(KT + (wave * 32 + mm * 16 + fr) * 40 + fq * 8);
#pragma unroll
      for (int n = 0; n < 8; ++n) {
        const bf16x8 bb = *(const bf16x8*)(VT + (n * 16 + fr) * 40 + fq * 8);
#pragma unroll
        for (int mm = 0; mm < 2; ++mm) S[mm][n] = MFMA(af[mm], bb, S[mm][n]);
      }
#pragma unroll
      for (int mm = 0; mm < 2; ++mm)
#pragma unroll
        for (int j = 0; j < 4; ++j) {
          const float e = __expf(blast[wave * 32 + mm * 16 + fq * 4 + j]);
#pragma unroll
          for (int n = 0; n < 8; ++n) S[mm][n][j] *= e;
        }
    }
  }
  __syncthreads();
}

DEV uint4 rw_act(const uint4 cur, const uint4 prv, const float* mul8, int mode) {
  const float4 m0 = *(const float4*)(mul8), m1 = *(const float4*)(mul8 + 4);
  const float mm[8] = {m0.x, m0.y, m0.z, m0.w, m1.x, m1.y, m1.z, m1.w};
  float a[8], b[8], o[8];
  UNPACK8(cur, a); UNPACK8(prv, b);
#pragma unroll
  for (int e = 0; e < 8; ++e) {
    float v = a[e] + (b[e] - a[e]) * mm[e];
    if (mode == 1) { const float t = __expf(-2.f * fabsf(v)); const float th = (1.f - t) * __builtin_amdgcn_rcpf(1.f + t); v = (v >= 0.f) ? th : -th; }
    else if (mode == 2) v = sigm(v);
    o[e] = v;
  }
  return PACK8(o);
}
DEV bf16x8 rw_bfrag(const float* W, int k0, int col) {
  float o[8];
#pragma unroll
  for (int e = 0; e < 8; ++e) o[e] = W[(size_t)(k0 + e) * 512 + col];
  return as_frag(PACK8(o));
}

PHASE void rwkv_item(const Params& p, int l, int item, char* smem) {
  const int b = item >> 3, h = item & 7;
  const int tid = opaque_tid(), lane = tid & 63, wave = tid >> 6, fr = lane & 15, fq = lane >> 4;
  float* R = (float*)smem;
  float* K = R + 2048; float* KK = K + 2048; float* W = KK + 2048; float* BB = W + 2048;
  float* V = BB + 2048; float* G = V + 2048; float* O = G + 2048;
  float* cst = O + 2048;
  float* mul = cst + 512;
  bf16_t* rawL = (bf16_t*)smem;
  float* vloL = (float*)(smem + 17424);
  const float* mu = p.rw_mu + (size_t)l * 1792;
  const int hc_n = h * 64 + wave * 16 + fr;
  bf16x8 w2f[2], a2f[2], g2f[4], v2f;
#pragma unroll
  for (int ks = 0; ks < 2; ++ks) {
    w2f[ks] = rw_bfrag(p.rw_w2 + (size_t)l * 64 * 512, ks * 32 + fq * 8, hc_n);
    a2f[ks] = rw_bfrag(p.rw_a2 + (size_t)l * 64 * 512, ks * 32 + fq * 8, hc_n);
  }
#pragma unroll
  for (int ks = 0; ks < 4; ++ks) g2f[ks] = rw_bfrag(p.rw_g2 + (size_t)l * 128 * 512, ks * 32 + fq * 8, hc_n);
  v2f = w2f[0];
  if (l > 0) v2f = rw_bfrag(p.rw_v2, fq * 8, hc_n);
  const float w0c = p.rw_w0[l * 512 + hc_n], a0c = p.rw_a0[l * 512 + hc_n];
  const float v0c = (l > 0) ? p.rw_v0[hc_n] : 0.f;
  const int t_ = tid >> 3, n0 = (tid & 7) * 8;
  __syncthreads();
  if (tid < 64) {
    const int hc = h * 64 + tid;
    cst[tid] = p.rw_k_k[l * 512 + hc]; cst[64 + tid] = p.rw_k_a[l * 512 + hc]; cst[128 + tid] = p.rw_r_k[l * 512 + hc];
    cst[192 + tid] = p.rw_gn_w[l * 512 + hc]; cst[256 + tid] = p.rw_gn_b[l * 512 + hc];
    cst[320 + tid] = mu[hc]; cst[384 + tid] = mu[512 + hc]; cst[448 + tid] = mu[1024 + hc];
  }
  mul[tid] = mu[1536 + tid];
  const float* kkc = cst + n0; const float* kac = cst + 64 + n0; const float* rkc = cst + 128 + n0;
  const float* gnw = cst + 192 + n0; const float* gnb = cst + 256 + n0;
  const float* mur = cst + 320 + n0; const float* muk = cst + 384 + n0; const float* muv = cst + 448 + n0;
  const int kq = lane & 7, row0 = wave * 16 + (lane >> 3), row1 = row0 + 8;
  f32x2 S0p[4], S1p[4];
#pragma unroll
  for (int e = 0; e < 4; ++e) { S0p[e] = (f32x2){0.f, 0.f}; S1p[e] = (f32x2){0.f, 0.f}; }

  uint4 pl0, pl1, pl2, pl3, pl4, pcr, pck, pcv, ppr, ppk, ppv, pvf;
  float4 pvl;
#define RW_PREFETCH(ch_)                                                                                    \
  {                                                                                                         \
    const size_t tk0 = (size_t)b * SEQ + (size_t)(ch_) * 32;                                                 \
    const bf16_t* lb_ = p.u + (tk0 - 1) * US + 3072 + 1536 + (tid & 31) * 8;                                 \
    const int r0_ = tid >> 5;                                                                               \
    pl0 = make_uint4(0, 0, 0, 0); if (!((ch_) == 0 && r0_ == 0)) pl0 = *(const uint4*)(lb_ + (size_t)r0_ * US); \
    pl1 = *(const uint4*)(lb_ + (size_t)(r0_ + 8) * US);                                                     \
    pl2 = *(const uint4*)(lb_ + (size_t)(r0_ + 16) * US);                                                    \
    pl3 = *(const uint4*)(lb_ + (size_t)(r0_ + 24) * US);                                                    \
    pl4 = make_uint4(0, 0, 0, 0); if (tid < 32) pl4 = *(const uint4*)(lb_ + (size_t)32 * US);                \
    const bf16_t* cu_ = p.u + (tk0 + t_) * US + 3072 + h * 64 + n0;                                          \
    pcr = *(const uint4*)cu_; pck = *(const uint4*)(cu_ + 512); pcv = *(const uint4*)(cu_ + 1024);           \
    if ((ch_) == 0 && t_ == 0) { ppr = make_uint4(0, 0, 0, 0); ppk = ppr; ppv = ppr; }                        \
    else { ppr = *(const uint4*)(cu_ - US); ppk = *(const uint4*)(cu_ - US + 512); ppv = *(const uint4*)(cu_ - US + 1024); } \
    if (l > 0) {                                                                                            \
      pvl = *(const float4*)(p.vlo + (tk0 + (tid >> 3)) * 32 + (tid & 7) * 4);                               \
      pvf = *(const uint4*)(p.vfirst + (tk0 + t_) * 512 + h * 64 + n0);                                      \
    } else { pvl = make_float4(0.f, 0.f, 0.f, 0.f); pvf = make_uint4(0, 0, 0, 0); }                          \
  }
  RW_PREFETCH(0)

  for (int ch = 0; ch < 64; ++ch) {
    const size_t tok0 = (size_t)b * SEQ + (size_t)ch * 32;
    __syncthreads();
    {
      const int r0_ = tid >> 5, cc_ = (tid & 31) * 8;
      *(uint4*)(rawL + r0_ * 264 + cc_) = pl0;
      *(uint4*)(rawL + (r0_ + 8) * 264 + cc_) = pl1;
      *(uint4*)(rawL + (r0_ + 16) * 264 + cc_) = pl2;
      *(uint4*)(rawL + (r0_ + 24) * 264 + cc_) = pl3;
      if (tid < 32) *(uint4*)(rawL + 32 * 264 + cc_) = pl4;
      *(float4*)(vloL + (tid >> 3) * 36 + (tid & 7) * 4) = pvl;
    }
    __syncthreads();
    {
      const int cc_ = (tid & 31) * 8, tr = tid >> 5;
      const int mode = (cc_ < 64) ? 1 : ((cc_ < 128) ? 0 : 2);
      uint4 a0, a1, a2, a3;
      a0 = rw_act(*(const uint4*)(rawL + (tr + 1) * 264 + cc_), *(const uint4*)(rawL + tr * 264 + cc_), mul + cc_, mode);
      a1 = rw_act(*(const uint4*)(rawL + (tr + 9) * 264 + cc_), *(const uint4*)(rawL + (tr + 8) * 264 + cc_), mul + cc_, mode);
      a2 = rw_act(*(const uint4*)(rawL + (tr + 17) * 264 + cc_), *(const uint4*)(rawL + (tr + 16) * 264 + cc_), mul + cc_, mode);
      a3 = rw_act(*(const uint4*)(rawL + (tr + 25) * 264 + cc_), *(const uint4*)(rawL + (tr + 24) * 264 + cc_), mul + cc_, mode);
      __syncthreads();
      *(uint4*)(rawL + tr * 264 + cc_) = a0;
      *(uint4*)(rawL + (tr + 8) * 264 + cc_) = a1;
      *(uint4*)(rawL + (tr + 16) * 264 + cc_) = a2;
      *(uint4*)(rawL + (tr + 24) * 264 + cc_) = a3;
    }
    __syncthreads();
#pragma unroll 1
    for (int mt = 0; mt < 2; ++mt) {
      const int row = mt * 16 + fr;
      const bf16_t* ar = rawL + row * 264 + fq * 8;
      f32x4 aw = (f32x4){0.f, 0.f, 0.f, 0.f}, aa = aw, ag = aw, av = aw;
#pragma unroll
      for (int ks = 0; ks < 2; ++ks) {
        aw = MFMA(*(const bf16x8*)(ar + ks * 32), w2f[ks], aw);
        aa = MFMA(*(const bf16x8*)(ar + 64 + ks * 32), a2f[ks], aa);
      }
#pragma unroll
      for (int ks = 0; ks < 4; ++ks) ag = MFMA(*(const bf16x8*)(ar + 128 + ks * 32), g2f[ks], ag);
      if (l > 0) {
        const float4 x0 = *(const float4*)(vloL + row * 36 + fq * 8), x1 = *(const float4*)(vloL + row * 36 + fq * 8 + 4);
        const uint4 pk = make_uint4(pack2(x0.x, x0.y), pack2(x0.z, x0.w), pack2(x1.x, x1.y), pack2(x1.z, x1.w));
        av = MFMA(as_frag(pk), v2f, av);
      }
#pragma unroll
      for (int j = 0; j < 4; ++j) {
        const int t = mt * 16 + fq * 4 + j, n = wave * 16 + fr;
        const float wv = -(w0c + aw[j]);
        const float sp = fmaxf(wv, 0.f) + __logf(1.f + __expf(-fabsf(wv)));
        const float wl = -sp - 0.5f;
        W[t * 64 + n] = __expf(-__expf(wl));
        BB[t * 64 + n] = sigm(a0c + aa[j]);
        G[t * 64 + n] = ag[j];
        if (l > 0) O[t * 64 + n] = sigm(v0c + av[j]);
      }
    }
    __syncthreads();
    {
      const size_t tok = tok0 + t_;
      float cr[8], ck[8], cv[8], pr[8], pk[8], pv[8];
      UNPACK8(pcr, cr); UNPACK8(pck, ck); UNPACK8(pcv, cv);
      UNPACK8(ppr, pr); UNPACK8(ppk, pk); UNPACK8(ppv, pv);
      float kx[8], kkv[8], vs[8], ss = 0.f;
#pragma unroll
      for (int e = 0; e < 8; ++e) {
        R[t_ * 64 + n0 + e] = cr[e] + (pr[e] - cr[e]) * mur[e];
        kx[e] = ck[e] + (pk[e] - ck[e]) * muk[e];
        vs[e] = cv[e] + (pv[e] - cv[e]) * muv[e];
        kkv[e] = kx[e] * kkc[e]; ss += kkv[e] * kkv[e];
      }
      ss = red8_sum(ss);
      const float rn = rsqrtf(fmaxf(ss, 1e-24f));
#pragma unroll
      for (int e = 0; e < 8; ++e) {
        const float a = BB[t_ * 64 + n0 + e];
        const float kn = kkv[e] * rn;
        K[t_ * 64 + n0 + e] = kx[e] * (1.f + (a - 1.f) * kac[e]);
        KK[t_ * 64 + n0 + e] = kn;
        BB[t_ * 64 + n0 + e] = kn * a;
      }
      if (l == 0) {
        *(uint4*)(p.vfirst + tok * 512 + h * 64 + n0) = PACK8(vs);
      } else {
        float vf[8]; UNPACK8(pvf, vf);
#pragma unroll
        for (int e = 0; e < 8; ++e) vs[e] = vs[e] + (vf[e] - vs[e]) * O[t_ * 64 + n0 + e];
      }
#pragma unroll
      for (int e = 0; e < 8; ++e) V[t_ * 64 + n0 + e] = vs[e];
    }
    __syncthreads();
    if (ch + 1 < 64) RW_PREFETCH(ch + 1)
    asm volatile("" ::: "memory");
#pragma unroll 4
    for (int t = 0; t < 32; ++t) {
      const float* base = R + t * 64 + kq * 8;
      const float4 r0 = *(const float4*)(base), r1 = *(const float4*)(base + 4);
      const float4 k0 = *(const float4*)(base + 2048), k1 = *(const float4*)(base + 2048 + 4);
      const float4 q0 = *(const float4*)(base + 4096), q1 = *(const float4*)(base + 4096 + 4);
      const float4 w0 = *(const float4*)(base + 6144), w1 = *(const float4*)(base + 6144 + 4);
      const float4 b0 = *(const float4*)(base + 8192), b1 = *(const float4*)(base + 8192 + 4);
      const float va = V[t * 64 + row0], vb = V[t * 64 + row1];
      const f32x2 rr[4] = {{r0.x, r0.y}, {r0.z, r0.w}, {r1.x, r1.y}, {r1.z, r1.w}};
      const f32x2 ww[4] = {{w0.x, w0.y}, {w0.z, w0.w}, {w1.x, w1.y}, {w1.z, w1.w}};
      const f32x2 kk_[4] = {{k0.x, k0.y}, {k0.z, k0.w}, {k1.x, k1.y}, {k1.z, k1.w}};
      const f32x2 qq[4] = {{q0.x, q0.y}, {q0.z, q0.w}, {q1.x, q1.y}, {q1.z, q1.w}};
      const f32x2 bb[4] = {{b0.x, b0.y}, {b0.z, b0.w}, {b1.x, b1.y}, {b1.z, b1.w}};
      f32x2 a0 = S0p[0] * qq[0], a1 = S1p[0] * qq[0];
#pragma unroll
      for (int e = 1; e < 4; ++e) { a0 += S0p[e] * qq[e]; a1 += S1p[e] * qq[e]; }
      const float sa0 = -red8_sum(a0.x + a0.y), sa1 = -red8_sum(a1.x + a1.y);
      f32x2 sa0v, sa1v, vav, vbv;
      sa0v.x = sa0; sa0v.y = sa0; sa1v.x = sa1; sa1v.y = sa1; vav.x = va; vav.y = va; vbv.x = vb; vbv.y = vb;
      f32x2 o0v = {0.f, 0.f}, o1v = {0.f, 0.f};
#pragma unroll
      for (int e = 0; e < 4; ++e) {
        S0p[e] = S0p[e] * ww[e] + sa0v * bb[e] + vav * kk_[e];
        S1p[e] = S1p[e] * ww[e] + sa1v * bb[e] + vbv * kk_[e];
        o0v += S0p[e] * rr[e]; o1v += S1p[e] * rr[e];
      }
      const float o0 = red8_sum(o0v.x + o0v.y), o1 = red8_sum(o1v.x + o1v.y);
      if (kq == 0) { O[t * 64 + row0] = o0; O[t * 64 + row1] = o1; }
    }
    asm volatile("s_waitcnt vmcnt(0)" ::: "memory");
    __syncthreads();
    {
      const size_t tok = tok0 + t_;
      float ov[8], s1 = 0.f, bon = 0.f;
#pragma unroll
      for (int e = 0; e < 8; ++e) {
        ov[e] = O[t_ * 64 + n0 + e]; s1 += ov[e];
        bon += R[t_ * 64 + n0 + e] * K[t_ * 64 + n0 + e] * rkc[e];
      }
      s1 = red8_sum(s1); bon = red8_sum(bon);
      const float mean = s1 * (1.f / 64.f);
      float s2 = 0.f;
#pragma unroll
      for (int e = 0; e < 8; ++e) { const float d = ov[e] - mean; s2 += d * d; }
      s2 = red8_sum(s2);
      const float rstd = rsqrtf(s2 * (1.f / 64.f) + 64e-5f);
      float y[8];
#pragma unroll
      for (int e = 0; e < 8; ++e)
        y[e] = ((ov[e] - mean) * rstd * gnw[e] + gnb[e] + bon * V[t_ * 64 + n0 + e]) * G[t_ * 64 + n0 + e];
      *(uint4*)(p.u + tok * US + 3072 + h * 64 + n0) = PACK8(y);
    }
  }
#undef RW_PREFETCH
  __syncthreads();
}

PHASE void phase_mix(const Params& p, int l, char* smem) {
  const int hf = vhalf();
  int* sitem = (int*)(smem - hf * SMEM_BYTES + SMEM_BYTES - 16);
  const int t512 = opaque_tid512();
  while (true) {
    __syncthreads();
    if (t512 == 0) *sitem = (int)atomicAdd(p.counters + l * 4 + 0, 1u);
    __syncthreads();
    const int tk = *sitem;
    if (tk >= 128) break;
    rwkv_item(p, l, tk * 2 + hf, smem);
  }
  while (true) {
    __syncthreads();
    if (t512 == 0) *sitem = (int)atomicAdd(p.counters + l * 4 + 1, 1u);
    __syncthreads();
    const int tk = *sitem;
    if (tk >= 64) break;
    hgrn_item(p, l, tk * 2 + hf, smem);
  }
  while (true) {
    __syncthreads();
    if (t512 == 0) *sitem = (int)atomicAdd(p.counters + l * 4 + 2, 1u);
    __syncthreads();
    const int tk = *sitem;
    if (tk >= 2048) break;
    att_item(p, l, tk * 2 + hf, smem);
  }
}

DEV void gemm_gates(const int tid_in, const bf16_t* A, const bf16_t* Wg, int tn, char* smem, unsigned (&Gp)[4][6][2]) {
  int tid = tid_in; asm volatile("" : "+v"(tid));
  bf16_t* As = (bf16_t*)smem;
  bf16_t* Bs = As + 3 * 4096;
  const int lane = tid & 63, wave = tid >> 6, wr = wave >> 1, wc = wave & 1;
  const int fr = lane & 15, fq = lane >> 4;
  f32x4 acc[4][6];
#pragma unroll
  for (int m = 0; m < 4; ++m)
#pragma unroll
    for (int n = 0; n < 6; ++n) acc[m][n] = (f32x4){0.f, 0.f, 0.f, 0.f};
  const int nk = DM >> 5;
  const int drow = tid >> 2, dphys = tid & 3, dg = (0 - (tid >> 4)) & 3;
  const int cofs = (dphys ^ dg) * 8;
  const unsigned aofs = (unsigned)(drow * DM + cofs);
  unsigned bofs0, bofs1, bofs2;
  {
    int r = drow; int wcb = r / 96, br = (r % 96) >> 5, c = (r % 96) & 31;
    bofs0 = (unsigned)((5376 + br * 1024 + tn * 64 + wcb * 32 + c) * DM + cofs);
    r = drow + 64; wcb = r / 96; br = (r % 96) >> 5; c = (r % 96) & 31;
    bofs1 = (unsigned)((5376 + br * 1024 + tn * 64 + wcb * 32 + c) * DM + cofs);
    r = drow + 128; wcb = r / 96; br = (r % 96) >> 5; c = (r % 96) & 31;
    bofs2 = (unsigned)((5376 + br * 1024 + tn * 64 + wcb * 32 + c) * DM + cofs);
  }
  const int rofs = (fq ^ ((0 - (fr >> 2)) & 3)) * 8;
#define GG_DMA(st, kk)                                                                                       \
  {                                                                                                          \
    __builtin_amdgcn_global_load_lds((const unsigned*)(A + aofs + (kk) * 32), (unsigned*)(As + (st) * 4096 + tid * 8), 16, 0, 0);                     \
    __builtin_amdgcn_global_load_lds((const unsigned*)(A + aofs + 64 * DM + (kk) * 32), (unsigned*)(As + (st) * 4096 + tid * 8 + 2048), 16, 0, 0); \
    __builtin_amdgcn_global_load_lds((const unsigned*)(Wg + bofs0 + (kk) * 32), (unsigned*)(Bs + (st) * 6144 + tid * 8), 16, 0, 0);                    \
    __builtin_amdgcn_global_load_lds((const unsigned*)(Wg + bofs1 + (kk) * 32), (unsigned*)(Bs + (st) * 6144 + tid * 8 + 2048), 16, 0, 0);             \
    __builtin_amdgcn_global_load_lds((const unsigned*)(Wg + bofs2 + (kk) * 32), (unsigned*)(Bs + (st) * 6144 + tid * 8 + 4096), 16, 0, 0);             \
  }
  GG_DMA(0, 0)
  GG_DMA(1, 1)
  int st = 0;
  for (int kt = 0; kt < nk; ++kt) {
    if (kt + 1 < nk) asm volatile("s_waitcnt vmcnt(5)" ::: "memory");
    else asm volatile("s_waitcnt vmcnt(0)" ::: "memory");
    __builtin_amdgcn_s_barrier();
    asm volatile("" ::: "memory");
    const int s2 = (st >= 1) ? st - 1 : 2;
    const bf16_t* Ab = As + st * 4096 + (wr * 64 + fr) * 32 + rofs;
    const bf16_t* Bb = Bs + st * 6144 + (wc * 96 + fr) * 32 + rofs;
    bf16x8 bfr[6], af[4];
#pragma unroll
    for (int n = 0; n < 6; ++n) bfr[n] = *(const bf16x8*)(Bb + n * 512);
#pragma unroll
    for (int m = 0; m < 4; ++m) af[m] = *(const bf16x8*)(Ab + m * 512);
    if (kt + 2 < nk) GG_DMA(s2, kt + 2)
#pragma unroll
    for (int m = 0; m < 4; ++m)
#pragma unroll
      for (int n = 0; n < 6; ++n) acc[m][n] = MFMA(af[m], bfr[n], acc[m][n]);
    st = (st == 2) ? 0 : st + 1;
  }
#undef GG_DMA
  __syncthreads();
#pragma unroll
  for (int m = 0; m < 4; ++m)
#pragma unroll
    for (int n = 0; n < 6; ++n) {
      Gp[m][n][0] = pack2(sigm(acc[m][n][0]), sigm(acc[m][n][1]));
      Gp[m][n][1] = pack2(sigm(acc[m][n][2]), sigm(acc[m][n][3]));
    }
}

PHASE void phase_merge(const Params& p, int l, char* smem) {
  const bf16_t* Wl = p.wt + (size_t)l * WLAYER;
  float* Cs = (float*)smem;
  const int tid = opaque_tid();
  for (int it = 0;; ++it) {
    int tm, tn;
    if (!tile_for(it, 512, 16, tm, tn)) break;
    const size_t row0 = (size_t)tm * 128;
    unsigned Gp[4][6][2];
    gemm_gates(tid, p.h + row0 * DM, Wl + WIN, tn, smem, Gp);
    f32x4 acc[4][2], M[4][2];
#pragma unroll
    for (int m = 0; m < 4; ++m)
#pragma unroll
      for (int n = 0; n < 2; ++n) M[m][n] = (f32x4){0.f, 0.f, 0.f, 0.f};
#pragma unroll
    for (int br = 0; br < 3; ++br) {
      const int aoff = (br == 0) ? 0 : (br == 1 ? 2560 : 3072);
      const size_t woff = (br == 0) ? WBA : (br == 1 ? WBB : WBC);
      gemm_tile<2>(tid, p.u + row0 * US + aoff, US, Wl + woff + (size_t)(tn * 64) * 512, 512, 512, smem, acc);
#pragma unroll
      for (int m = 0; m < 4; ++m)
#pragma unroll
        for (int n = 0; n < 2; ++n) {
          M[m][n][0] += lo16(Gp[m][2 * br + n][0]) * acc[m][n][0];
          M[m][n][1] += hi16(Gp[m][2 * br + n][0]) * acc[m][n][1];
          M[m][n][2] += lo16(Gp[m][2 * br + n][1]) * acc[m][n][2];
          M[m][n][3] += hi16(Gp[m][2 * br + n][1]) * acc[m][n][3];
        }
    }
    stage_acc<2>(tid, Cs, M);
    __syncthreads();
    {
      const int ch = tid & 7;
#pragma unroll 1
      for (int i = 0; i < 4; ++i) {
        const int r = (tid >> 3) + i * 32;
        const float4 a = *(const float4*)(Cs + r * 68 + ch * 8), b = *(const float4*)(Cs + r * 68 + ch * 8 + 4);
        *(uint4*)(p.u + (row0 + r) * US + 1024 + tn * 64 + ch * 8) = make_uint4(pack2(a.x, a.y), pack2(a.z, a.w), pack2(b.x, b.y), pack2(b.z, b.w));
      }
    }
    __syncthreads();
  }
}

PHASE void phase_gemm_res(const bf16_t* A, int lda, const bf16_t* Wt, int K, const float* xin, float* xout,
                        const float* ada_l, int gate_off, char* smem0) {
  const int T = opaque_tid512(), tid = T & 255, hf = vhalf();
  float* Cs = (float*)(smem0 + hf * SMEM_BYTES);
  for (int it = 0;; ++it) {
    int tm, tn;
    if (!tile_for_real(it, 256, 4, tm, tn)) break;
    const size_t row0 = (size_t)tm * 256;
    f32x4 acc[8][4];
    gemm_tile512(T, A + row0 * lda, lda, Wt + (size_t)(tn * 256) * K, K, K, smem0, acc);
    const float* gate = ada_l + (size_t)(row0 / SEQ) * ADAW + gate_off;
    const int c4 = (tid & 31) * 4;
#pragma unroll
    for (int ps = 0; ps < 2; ++ps) {
      if (ps == 0) stage_half512<0>(T, Cs, acc); else stage_half512<1>(T, Cs, acc);
      __syncthreads();
#pragma unroll 1
      for (int i0 = 0; i0 < 16; i0 += 4) {
        float4 xv[4], gv[4], cv[4]; size_t off[4];
#pragma unroll
        for (int ii = 0; ii < 4; ++ii) {
          const int r = (tid >> 5) + (i0 + ii) * 8;
          const int colb = TNC(r) * 128 + c4;
          off[ii] = GROW(r, ps) * DM + colb;
          xv[ii] = *(const float4*)(xin + off[ii]);
          gv[ii] = *(const float4*)(gate + colb);
          cv[ii] = *(const float4*)(Cs + r * 132 + c4);
        }
        asm volatile("" ::: "memory");
#pragma unroll
        for (int ii = 0; ii < 4; ++ii)
          *(float4*)(xout + off[ii]) = make_float4(xv[ii].x + gv[ii].x * cv[ii].x, xv[ii].y + gv[ii].y * cv[ii].y,
                                                   xv[ii].z + gv[ii].z * cv[ii].z, xv[ii].w + gv[ii].w * cv[ii].w);
      }
      __syncthreads();
    }
  }
}

PHASE void phase_ffn_in(const Params& p, int l, char* smem0) {
  const bf16_t* Wt = p.wt + (size_t)l * WLAYER + WFI;
  const int T = opaque_tid512(), tid = T & 255, hf = vhalf();
  float* Cs = (float*)(smem0 + hf * SMEM_BYTES);
  for (int it = 0;; ++it) {
    int tm, tn;
    if (!tile_for_real(it, 256, 22, tm, tn)) break;
    const size_t row0 = (size_t)tm * 256;
    f32x4 acc[8][4];
    gemm_tile512(T, p.h + row0 * DM, DM, Wt + (size_t)(tn * 256) * DM, DM, DM, smem0, acc);
    const int ch = tid & 7;
#pragma unroll
    for (int ps = 0; ps < 2; ++ps) {
      if (ps == 0) stage_half512<0>(T, Cs, acc); else stage_half512<1>(T, Cs, acc);
      __syncthreads();
#pragma unroll 1
      for (int i = 0; i < 4; ++i) {
        const int r = (tid >> 3) + i * 32;
        const float* cp = Cs + r * 132 + ch * 8;
        float o[8];
#pragma unroll
        for (int e = 0; e < 8; ++e) { const float g = cp[e], uu = cp[64 + e]; o[e] = g * sigm(g) * uu; }
        *(uint4*)(p.u + GROW(r, ps) * FFH + TNC(r) * 64 + ch * 8) = PACK8(o);
      }
      __syncthreads();
    }
  }
}

#define XB_TMO      128
#define XB_XCNT(j)  (256  + 64 * (j))
#define XB_XSUB(j)  (1280 + 64 * (j))
#define XB_XGEN(j)  (2304 + 64 * (j))
#define XB_TOP      3328
#define XB_TOPGEN   3392
#define XCD_BAR_WORDS 3456
#define XB_SPIN_CAP (1u << 18)
#define LAS __attribute__((address_space(3)))
DEV unsigned xb_ld(unsigned* p) { return __hip_atomic_load(p, __ATOMIC_RELAXED, __HIP_MEMORY_SCOPE_AGENT); }
DEV unsigned xb_add(unsigned* p, unsigned v) { return __hip_atomic_fetch_add(p, v, __ATOMIC_RELAXED, __HIP_MEMORY_SCOPE_AGENT); }
DEV unsigned xb_xcc_id() { return (unsigned)__builtin_amdgcn_s_getreg((3 << 11) | 20) & 0xFu; }
#define XB_SPIN(cond, bar) do { unsigned _sp = 0; while (cond) { __builtin_amdgcn_s_sleep(1); \
    if ((++_sp & 255u) == 0u) { if (xb_ld(&(bar)[XB_TMO])) break; if (_sp > XB_SPIN_CAP) { atomicAdd(&(bar)[XB_TMO], 1u); break; } } } } while (0)
struct XcdBarrier { unsigned* bar; unsigned x; volatile LAS unsigned* st; };
DEV XcdBarrier xcd_barrier_post(unsigned* bar, volatile LAS unsigned* st) {
  XcdBarrier b; b.bar = bar; b.x = xb_xcc_id(); b.st = st;
  if (threadIdx.x == 0) (void)xb_add(&bar[XB_XCNT(b.x)], 1u);
  return b;
}
DEV void xcd_barrier_complete(unsigned* bar, unsigned x, unsigned& nloc, unsigned& nx) {
  const unsigned G = gridDim.x * gridDim.y * gridDim.z;
  unsigned sum, cnt, mine, sp = 0u;
  for (;;) {
    sum = 0u; cnt = 0u; mine = 0u;
#pragma unroll
    for (unsigned j = 0; j < 16; ++j) { const unsigned c = xb_ld(&bar[XB_XCNT(j)]); sum += c; cnt += (c > 0u) ? 1u : 0u; mine = (j == x) ? c : mine; }
    if (sum == G) break;
    __builtin_amdgcn_s_sleep(1);
    if ((++sp & 255u) == 0u) { if (xb_ld(&bar[XB_TMO])) break; if (sp > XB_SPIN_CAP) { atomicAdd(&bar[XB_TMO], 1u); break; } }
  }
  nloc = mine > 0u ? mine : 1u; nx = cnt > 0u ? cnt : 1u;
}
DEV void xcd_barrier(const XcdBarrier& b) {
  asm volatile("s_waitcnt vmcnt(0)" ::: "memory");
  __syncthreads();
  if (threadIdx.x == 0) {
    unsigned* bar = b.bar;
    __builtin_amdgcn_s_waitcnt(0);
    unsigned nloc = b.st[0], nx = b.st[1];
    if (nloc == 0u) { xcd_barrier_complete(bar, b.x, nloc, nx); b.st[0] = nloc; b.st[1] = nx; }
    const unsigned old = xb_add(&bar[XB_XSUB(b.x)], 1u);
    const unsigned gen = old / nloc;
    if (old + 1u == (gen + 1u) * nloc) {
      __builtin_amdgcn_fence(__ATOMIC_RELEASE, "agent");
      asm volatile("s_waitcnt vmcnt(0)" ::: "memory");
      const unsigned og = xb_add(&bar[XB_TOP], 1u);
      const unsigned tg = og / nx;
      if (og + 1u == (tg + 1u) * nx) xb_add(&bar[XB_TOPGEN], 1u);
      else XB_SPIN(xb_ld(&bar[XB_TOPGEN]) == tg, bar);
      __builtin_amdgcn_fence(__ATOMIC_ACQUIRE, "agent");
      xb_add(&bar[XB_XGEN(b.x)], 1u);
      asm volatile("s_waitcnt vmcnt(0)" ::: "memory");
    } else {
      XB_SPIN(xb_ld(&bar[XB_XGEN(b.x)]) == gen, bar);
      __builtin_amdgcn_fence(__ATOMIC_ACQUIRE, "agent");
      asm volatile("s_waitcnt vmcnt(0)" ::: "memory");
    }
  }
  __syncthreads();
}

__global__ void __launch_bounds__(512, 2) mega(Params p_in, int ph_lo, int ph_hi) {
  extern __shared__ __attribute__((aligned(16))) char smem0[];
  char* smem = smem0 + vhalf() * SMEM_BYTES;
  cg::grid_group grid = cg::this_grid();
  const Params& p = p_in;
  bool first = true;
#define RUN(ph) if ((ph) >= ph_lo && (ph) < ph_hi)
  unsigned epoch = 0;
  __shared__ unsigned xb_words[4];
  if (threadIdx.x < 4) xb_words[threadIdx.x] = 0u;
  __syncthreads();
  XcdBarrier xb;
  xb.bar = p.counters + 256; xb.x = 0u; xb.st = (volatile LAS unsigned*)xb_words;
#define SYNC { if (!first) { ++epoch; if (epoch == 1) { grid.sync(); xb = xcd_barrier_post(p.counters + 256, (volatile LAS unsigned*)xb_words); } else xcd_barrier(xb); } first = false; }
  RUN(0) { SYNC; phase_prep(p, smem); }
#pragma unroll 1
  for (int l = 0; l < 2; ++l) {
    const int base = 1 + 9 * l;
    const float* ada_l = p.ada + (size_t)l * 32 * ADAW;
    const bf16_t* Wl = p.wt + (size_t)l * WLAYER;
    const float* xin = (l == 0) ? p.x : p.out;
    RUN(base + 0) { SYNC; phase_norm(xin, p.norm_mix_w + l * DM, ada_l, 0, 1024, p.h); }
    RUN(base + 1) { SYNC; phase_gemm_in(p, l, smem0); }
    RUN(base + 2) { if (l > 0) { SYNC; phase_vlo(p, l, smem); } }
    RUN(base + 3) { SYNC; phase_mix(p, l, smem); }
    RUN(base + 4) { SYNC; phase_merge(p, l, smem); }
    RUN(base + 5) { SYNC; phase_gemm_res(p.u + 1024, US, Wl + WOUT, DM, xin, p.out, ada_l, 2048, smem0); }
    RUN(base + 6) { SYNC; phase_norm(p.out, p.norm_ffn_w + l * DM, ada_l, 3072, 4096, p.h); }
    RUN(base + 7) { SYNC; phase_ffn_in(p, l, smem0); }
    RUN(base + 8) { SYNC; phase_gemm_res(p.u, FFH, Wl + WFO, FFH, p.out, p.out, ada_l, 5120, smem0); }
  }
  RUN(NPHASE - 1) { SYNC; phase_final(p.out, p.final_norm_w); }
}

extern "C" void kernel_launch(void* const* d_in, const int* in_sizes, int n_in, void* d_out, int out_size, void* d_ws,
                              size_t ws_size, hipStream_t stream) {
  Params p{};
  p.x = (const float*)d_in[0]; p.c = (const float*)d_in[1]; p.pos = (const int*)d_in[2];
  p.ada_w = (const float*)d_in[3]; p.ada_b = (const float*)d_in[4]; p.norm_mix_w = (const float*)d_in[5];
  p.norm_ffn_w = (const float*)d_in[6]; p.w_in = (const float*)d_in[7]; p.da_lambda = (const float*)d_in[8];
  p.da_subln_w = (const float*)d_in[9]; p.hg_lb = (const float*)d_in[10]; p.hg_norm_w = (const float*)d_in[11];
  p.rw_mu = (const float*)d_in[12]; p.rw_w0 = (const float*)d_in[13]; p.rw_w2 = (const float*)d_in[14];
  p.rw_a0 = (const float*)d_in[15]; p.rw_a2 = (const float*)d_in[16]; p.rw_g2 = (const float*)d_in[17];
  p.rw_k_k = (const float*)d_in[18]; p.rw_k_a = (const float*)d_in[19]; p.rw_r_k = (const float*)d_in[20];
  p.rw_gn_w = (const float*)d_in[21]; p.rw_gn_b = (const float*)d_in[22]; p.rw_v0 = (const float*)d_in[23];
  p.rw_v1 = (const float*)d_in[24]; p.rw_v2 = (const float*)d_in[25]; p.w_br_a = (const float*)d_in[26];
  p.w_br_b = (const float*)d_in[27]; p.w_br_c = (const float*)d_in[28]; p.w_out = (const float*)d_in[29];
  p.ffn_w_in = (const float*)d_in[30]; p.ffn_w_out = (const float*)d_in[31]; p.final_norm_w = (const float*)d_in[32];
  p.out = (float*)d_out;
  char* ws = (char*)d_ws;
  size_t off = 0;
  auto take = [&](size_t bytes) { char* r = ws + off; off += (bytes + 255) & ~(size_t)255; return r; };
  p.counters = (unsigned*)take(16384);
  p.wt = (bf16_t*)take(2 * WLAYER * 2);
  p.ada = (float*)take((size_t)2 * 32 * ADAW * 4);
  p.h = (bf16_t*)take((size_t)T_TOK * DM * 2);
  p.u = (bf16_t*)take((size_t)T_TOK * US * 2);
  p.vT = (bf16_t*)take((size_t)T_TOK * 512 * 2);
  p.vfirst = (bf16_t*)take((size_t)T_TOK * 512 * 2);
  p.vlo = (float*)take((size_t)T_TOK * 32 * 4);
  if (off > ws_size) { fprintf(stderr, "workspace too small: need %zu have %zu\n", off, ws_size); return; }

  static int grid_blocks = 0;
  if (!grid_blocks) {
    hipFuncSetAttribute((const void*)mega, hipFuncAttributeMaxDynamicSharedMemorySize, 2 * SMEM_BYTES);
    int dev = 0, cus = 0, per_cu = 0;
    hipGetDevice(&dev);
    hipDeviceGetAttribute(&cus, hipDeviceAttributeMultiprocessorCount, dev);
    hipOccupancyMaxActiveBlocksPerMultiprocessor(&per_cu, mega, 512, 2 * SMEM_BYTES);
    if (per_cu > 1) per_cu = 1;
    if (per_cu < 1) per_cu = 1;
    grid_blocks = cus * per_cu;
  }
#if SINGLE_LAUNCH
  int lo = 0, hi = NPHASE;
  void* args[] = {&p, &lo, &hi};
  hipError_t e = hipLaunchCooperativeKernel((void*)mega, dim3(grid_blocks), dim3(512), args, 2 * SMEM_BYTES, stream);
  if (e != hipSuccess) fprintf(stderr, "cooperative launch failed: %s (grid %d)\n", hipGetErrorString(e), grid_blocks);
#else
  for (int ph = 0; ph < NPHASE; ++ph) {
    if (ph == 3) continue;
    hipLaunchKernelGGL(mega, dim3(grid_blocks), dim3(512), 2 * SMEM_BYTES, stream, p, ph, ph + 1);
  }
#endif
}
```

```cpp
#include <hip/hip_runtime.h>
#include <hip/hip_cooperative_groups.h>
#include <stdint.h>
#include <cstdio>
namespace cg = cooperative_groups;

typedef unsigned short bf16_t;
typedef short bf16x8 __attribute__((ext_vector_type(8)));
typedef float f32x4 __attribute__((ext_vector_type(4)));
typedef float f32x2 __attribute__((ext_vector_type(2)));
#define DEV __device__ __forceinline__
#define PHASE __device__ __forceinline__

#ifndef SINGLE_LAUNCH
#define SINGLE_LAUNCH 1
#endif

constexpr int T_TOK = 65536, DM = 1024, SEQ = 2048, US = 4864, ADAW = 6144, FFH = 2816;
constexpr size_t WIN = 0, WBA = 8650752, WBB = 9175040, WBC = 9699328, WOUT = 10223616, WFI = 11272192,
                 WFO = 17039360, WLAYER = 19922944;
constexpr int SMEM_BYTES = 80896;
constexpr int NPHASE = 20;

struct Params {
  const float* x; const float* c; const int* pos;
  const float *ada_w, *ada_b, *norm_mix_w, *norm_ffn_w, *w_in, *da_lambda, *da_subln_w, *hg_lb, *hg_norm_w;
  const float *rw_mu, *rw_w0, *rw_w2, *rw_a0, *rw_a2, *rw_g2, *rw_k_k, *rw_k_a, *rw_r_k, *rw_gn_w, *rw_gn_b;
  const float *rw_v0, *rw_v1, *rw_v2, *w_br_a, *w_br_b, *w_br_c, *w_out, *ffn_w_in, *ffn_w_out, *final_norm_w;
  float* out;
  bf16_t* wt; float* ada; bf16_t* h; bf16_t* u; bf16_t* vT; bf16_t* vfirst; float* vlo; unsigned* counters;
};

DEV unsigned short f2bf(float f) { return (unsigned short)((__float_as_uint(f) + 0x8000u) >> 16); }
DEV float bf2f(unsigned short h) { return __uint_as_float(((unsigned)h) << 16); }
DEV unsigned pack2(float a, float b) {
  return __builtin_amdgcn_perm(__float_as_uint(b) + 0x8000u, __float_as_uint(a) + 0x8000u, 0x07060302u);
}
DEV float sigm(float x) { return __builtin_amdgcn_rcpf(1.f + __expf(-x)); }
DEV float lo16(unsigned v) { return __uint_as_float(v << 16); }
DEV float hi16(unsigned v) { return __uint_as_float(v & 0xFFFF0000u); }
#define UNPACK8(v, f) { f[0]=lo16(v.x); f[1]=hi16(v.x); f[2]=lo16(v.y); f[3]=hi16(v.y); f[4]=lo16(v.z); f[5]=hi16(v.z); f[6]=lo16(v.w); f[7]=hi16(v.w); }
#define PACK8(f) make_uint4(pack2(f[0],f[1]), pack2(f[2],f[3]), pack2(f[4],f[5]), pack2(f[6],f[7]))
template <int CTRL> DEV float dpp(float x) { return __int_as_float(__builtin_amdgcn_update_dpp(0, __float_as_int(x), CTRL, 0xF, 0xF, true)); }
DEV float red8_sum(float x) { x += dpp<0xB1>(x); x += dpp<0x4E>(x); x += dpp<0x141>(x); return x; }
DEV float red16_sum(float x) { x = red8_sum(x); x += dpp<0x140>(x); return x; }
DEV float red16_max(float x) { x = fmaxf(x, dpp<0xB1>(x)); x = fmaxf(x, dpp<0x4E>(x)); x = fmaxf(x, dpp<0x141>(x)); x = fmaxf(x, dpp<0x140>(x)); return x; }
DEV float wave_sum(float x) {
  x = red16_sum(x);
  const int xi = __float_as_int(x);
  return __int_as_float(__builtin_amdgcn_readlane(xi, 0)) + __int_as_float(__builtin_amdgcn_readlane(xi, 16)) +
         __int_as_float(__builtin_amdgcn_readlane(xi, 32)) + __int_as_float(__builtin_amdgcn_readlane(xi, 48));
}
DEV int opaque_tid() { int t = threadIdx.x & 255; asm volatile("" : "+v"(t)); return t; }
DEV int opaque_tid512() { int t = threadIdx.x; asm volatile("" : "+v"(t)); return t; }
DEV int vhalf() { return __builtin_amdgcn_readfirstlane((int)(threadIdx.x >> 8)); }
DEV int vblock() { return (int)blockIdx.x * 2 + vhalf(); }
DEV int vgrid() { return (int)gridDim.x * 2; }
DEV bf16x8 as_frag(uint4 v) { union { uint4 u; bf16x8 b; } c; c.u = v; return c.b; }
#define MFMA(a, b, c) __builtin_amdgcn_mfma_f32_16x16x32_bf16(a, b, c, 0, 0, 0)

template <int NT>
DEV void gemm_tile(const int tid_in, const bf16_t* A, int lda, const bf16_t* B, int ldb, int K, char* smem,
                   f32x4 (&acc)[4][NT]) {
  int tid = tid_in; asm volatile("" : "+v"(tid));
  constexpr int BN = NT * 32;
  constexpr int LS = 64;
  bf16_t* As = (bf16_t*)smem;
  bf16_t* Bs = As + 2 * 128 * LS;
  const int lane = tid & 63, wave = tid >> 6, wr = wave >> 1, wc = wave & 1;
  const int fr = lane & 15, fq = lane >> 4;
  constexpr int NB = BN * 8 / 256;
#pragma unroll
  for (int m = 0; m < 4; ++m)
#pragma unroll
    for (int n = 0; n < NT; ++n) acc[m][n] = (f32x4){0.f, 0.f, 0.f, 0.f};
  const int nk = K >> 6;
  const int lrow = tid >> 3, lcc = tid & 7;
  const bf16_t* Ap = A + (size_t)lrow * lda + ((lcc ^ (lrow & 7)) * 8);
  const bf16_t* Bp = B + (size_t)lrow * ldb + ((lcc ^ (lrow & 7)) * 8);
  const size_t a32 = (size_t)32 * lda, b32 = (size_t)32 * ldb;
  const int rofs0 = (fq ^ (fr & 7)) * 8, rofs1 = rofs0 ^ 32;
#define GT_DMA(buf, koff)                                                                                    \
  {                                                                                                          \
    bf16_t* Ad = As + (buf) * 128 * LS + tid * 8;                                                            \
    bf16_t* Bd = Bs + (buf) * BN * LS + tid * 8;                                                             \
    _Pragma("unroll") for (int i = 0; i < 4; ++i)                                                            \
      __builtin_amdgcn_global_load_lds((const unsigned*)(Ap + i * a32 + (koff)), (unsigned*)(Ad + i * 32 * LS), 16, 0, 0); \
    _Pragma("unroll") for (int i = 0; i < NB; ++i)                                                           \
      __builtin_amdgcn_global_load_lds((const unsigned*)(Bp + i * b32 + (koff)), (unsigned*)(Bd + i * 32 * LS), 16, 0, 0); \
  }
  GT_DMA(0, 0)
  asm volatile("s_waitcnt vmcnt(0)" ::: "memory");
  __syncthreads();
  for (int kt = 0; kt < nk; ++kt) {
    const int buf = kt & 1;
    if (kt + 1 < nk) GT_DMA(buf ^ 1, (kt + 1) * 64)
    const bf16_t* Ab = As + buf * 128 * LS + (wr * 64 + fr) * LS;
    const bf16_t* Bb = Bs + buf * BN * LS + (wc * (NT * 16) + fr) * LS;
#pragma unroll
    for (int ks = 0; ks < 2; ++ks) {
      const int ro = ks ? rofs1 : rofs0;
      bf16x8 af[4], bfr[NT];
#pragma unroll
      for (int m = 0; m < 4; ++m) af[m] = *(const bf16x8*)(Ab + m * 16 * LS + ro);
#pragma unroll
      for (int n = 0; n < NT; ++n) bfr[n] = *(const bf16x8*)(Bb + n * 16 * LS + ro);
#pragma unroll
      for (int m = 0; m < 4; ++m)
#pragma unroll
        for (int n = 0; n < NT; ++n) acc[m][n] = MFMA(af[m], bfr[n], acc[m][n]);
    }
    asm volatile("s_waitcnt vmcnt(0)" ::: "memory");
    __syncthreads();
  }
#undef GT_DMA
}

template <int NT>
DEV void stage_acc(const int tid, float* Cs, const f32x4 (&acc)[4][NT]) {
  constexpr int LDC = NT * 32 + 4;
  const int lane = tid & 63, wave = tid >> 6, wr = wave >> 1, wc = wave & 1, fr = lane & 15, fq = lane >> 4;
#pragma unroll
  for (int m = 0; m < 4; ++m)
#pragma unroll
    for (int n = 0; n < NT; ++n)
#pragma unroll
      for (int j = 0; j < 4; ++j) Cs[(wr * 64 + m * 16 + fq * 4 + j) * LDC + wc * (NT * 16) + n * 16 + fr] = acc[m][n][j];
}

DEV void gemm_tile256(const int tid, const bf16_t* A, int lda, const bf16_t* B, int ldb, int K, char* smem,
                      f32x4 (&acc)[8][4]) {
  bf16_t* As = (bf16_t*)smem;
  bf16_t* Bs = As + 3 * 8192;
  const int lane = tid & 63, wave = tid >> 6, wr = wave >> 1, wc = wave & 1;
  const int fr = lane & 15, fq = lane >> 4;
#pragma unroll
  for (int m = 0; m < 8; ++m)
#pragma unroll
    for (int n = 0; n < 4; ++n) acc[m][n] = (f32x4){0.f, 0.f, 0.f, 0.f};
  const int nk = K >> 5;
  const int drow = tid >> 2, dphys = tid & 3, dg = (0 - (tid >> 4)) & 3;
  const bf16_t* Ap = A + (size_t)drow * lda + ((dphys ^ dg) * 8);
  const bf16_t* Bp = B + (size_t)drow * ldb + ((dphys ^ dg) * 8);
  const size_t a64 = (size_t)64 * lda, b64 = (size_t)64 * ldb;
  const int rofs = (fq ^ ((0 - (fr >> 2)) & 3)) * 8;
#define G2_DMA(st, kk)                                                                                        \
  {                                                                                                           \
    bf16_t* Ad = As + (st) * 8192 + tid * 8;                                                                  \
    bf16_t* Bd = Bs + (st) * 4096 + tid * 8;                                                                  \
    _Pragma("unroll") for (int i = 0; i < 4; ++i)                                                             \
      __builtin_amdgcn_global_load_lds((const unsigned*)(Ap + i * a64 + (kk) * 32), (unsigned*)(Ad + i * 2048), 16, 0, 0); \
    _Pragma("unroll") for (int i = 0; i < 2; ++i)                                                             \
      __builtin_amdgcn_global_load_lds((const unsigned*)(Bp + i * b64 + (kk) * 32), (unsigned*)(Bd + i * 2048), 16, 0, 0); \
  }
  G2_DMA(0, 0)
  G2_DMA(1, 1)
  int st = 0;
  for (int kt = 0; kt < nk; ++kt) {
    if (kt + 1 < nk) asm volatile("s_waitcnt vmcnt(6)" ::: "memory");
    else asm volatile("s_waitcnt vmcnt(0)" ::: "memory");
    __builtin_amdgcn_s_barrier();
    asm volatile("" ::: "memory");
    const int s2 = (st >= 1) ? st - 1 : 2;
    const bool pf = (kt + 2 < nk);
    bf16_t* Ad = As + s2 * 8192 + tid * 8;
    bf16_t* Bd = Bs + s2 * 4096 + tid * 8;
    const bf16_t* Asrc = Ap + (kt + 2) * 32;
    const bf16_t* Bsrc = Bp + (kt + 2) * 32;
    const bf16_t* Ab = As + st * 8192 + (wr * 128 + fr) * 32 + rofs;
    const bf16_t* Bb = Bs + st * 4096 + (wc * 64 + fr) * 32 + rofs;
    bf16x8 bfr[4], af[4];
#pragma unroll
    for (int n = 0; n < 4; ++n) bfr[n] = *(const bf16x8*)(Bb + n * 512);
#pragma unroll
    for (int m = 0; m < 4; ++m) af[m] = *(const bf16x8*)(Ab + m * 512);
#pragma unroll
    for (int m = 0; m < 8; ++m) {
#pragma unroll
      for (int n = 0; n < 4; ++n) acc[m][n] = MFMA(af[m & 3], bfr[n], acc[m][n]);
      if (m + 4 < 8) af[m & 3] = *(const bf16x8*)(Ab + (m + 4) * 512);
      if (pf) {
        if (m < 4) __builtin_amdgcn_global_load_lds((const unsigned*)(Asrc + m * a64), (unsigned*)(Ad + m * 2048), 16, 0, 0);
        else if (m < 6) __builtin_amdgcn_global_load_lds((const unsigned*)(Bsrc + (m - 4) * b64), (unsigned*)(Bd + (m - 4) * 2048), 16, 0, 0);
      }
      __builtin_amdgcn_sched_barrier(0);
    }
    st = (st == 2) ? 0 : st + 1;
  }
#undef G2_DMA
  __syncthreads();
}

template <int PS>
DEV void stage_half(const int tid, float* Cs, const f32x4 (&acc)[8][4]) {
  const int lane = tid & 63, wave = tid >> 6, wr = wave >> 1, wc = wave & 1, fr = lane & 15, fq = lane >> 4;
#pragma unroll
  for (int m = 0; m < 4; ++m)
#pragma unroll
    for (int n = 0; n < 4; ++n)
#pragma unroll
      for (int j = 0; j < 4; ++j) Cs[(wr * 64 + m * 16 + fq * 4 + j) * 132 + wc * 64 + n * 16 + fr] = acc[PS * 4 + m][n][j];
}
#define RMAP(r, ps) ((((r) >> 6) << 7) + (ps) * 64 + ((r) & 63))

DEV void gemm_tile512(const int T, const bf16_t* A, int lda, const bf16_t* B, int ldb, int K, char* smem0,
                      f32x4 (&acc)[8][4]) {
  bf16_t* As = (bf16_t*)smem0;
  bf16_t* Bs = As + 2 * 16384;
  const int lane = T & 63, wave = T >> 6, wr = wave >> 2, wc = wave & 3;
  const int fr = lane & 15, fq = lane >> 4;
#pragma unroll
  for (int m = 0; m < 8; ++m)
#pragma unroll
    for (int n = 0; n < 4; ++n) acc[m][n] = (f32x4){0.f, 0.f, 0.f, 0.f};
  const int nk = K >> 6;
  const int drow = T >> 3, dlog = ((T & 7) ^ ((T >> 3) & 7)) * 8;
  const bf16_t* Ap = A + (size_t)drow * lda + dlog;
  const bf16_t* Bp = B + (size_t)drow * ldb + dlog;
  const size_t a64 = (size_t)64 * lda, b64 = (size_t)64 * ldb;
  const int rofs0 = (fq ^ (fr & 7)) * 8, rofs1 = rofs0 ^ 32;
#pragma unroll
  for (int i = 0; i < 4; ++i) {
    __builtin_amdgcn_global_load_lds((const unsigned*)(Ap + i * a64), (unsigned*)(As + T * 8 + i * 4096), 16, 0, 0);
    __builtin_amdgcn_global_load_lds((const unsigned*)(Bp + i * b64), (unsigned*)(Bs + T * 8 + i * 4096), 16, 0, 0);
  }
  asm volatile("s_waitcnt vmcnt(0)" ::: "memory");
  __syncthreads();
  for (int kt = 0; kt < nk; ++kt) {
    const int buf = kt & 1;
    const bool pf = (kt + 1 < nk);
    bf16_t* Ad = As + (buf ^ 1) * 16384 + T * 8;
    bf16_t* Bd = Bs + (buf ^ 1) * 16384 + T * 8;
    const bf16_t* Asrc = Ap + (kt + 1) * 64;
    const bf16_t* Bsrc = Bp + (kt + 1) * 64;
    const bf16_t* Ab = As + buf * 16384 + (wr * 128 + fr) * 64;
    const bf16_t* Bb = Bs + buf * 16384 + (wc * 64 + fr) * 64;
#pragma unroll
    for (int ks = 0; ks < 2; ++ks) {
      const int ro = ks ? rofs1 : rofs0;
      bf16x8 bfr[4], af[4];
#pragma unroll
      for (int n = 0; n < 4; ++n) bfr[n] = *(const bf16x8*)(Bb + n * 1024 + ro);
#pragma unroll
      for (int m = 0; m < 4; ++m) af[m] = *(const bf16x8*)(Ab + m * 1024 + ro);
#pragma unroll
      for (int m = 0; m < 8; ++m) {
#pragma unroll
        for (int n = 0; n < 4; ++n) acc[m][n] = MFMA(bfr[n], af[m & 3], acc[m][n]);
        if (m + 4 < 8) af[m & 3] = *(const bf16x8*)(Ab + (m + 4) * 1024 + ro);
        if (pf && ks == 0 && m < 4) {
          __builtin_amdgcn_global_load_lds((const unsigned*)(Asrc + m * a64), (unsigned*)(Ad + m * 4096), 16, 0, 0);
          __builtin_amdgcn_global_load_lds((const unsigned*)(Bsrc + m * b64), (unsigned*)(Bd + m * 4096), 16, 0, 0);
        }
        __builtin_amdgcn_sched_barrier(0);
      }
    }
    asm volatile("s_waitcnt vmcnt(0)" ::: "memory");
    __builtin_amdgcn_s_barrier();
    asm volatile("" ::: "memory");
  }
  __syncthreads();
}
template <int PS>
DEV void stage_half512(const int T, float* Cs, const f32x4 (&acc)[8][4]) {
  const int lane = T & 63, wave = T >> 6, wc = wave & 3, fr = lane & 15, fq = lane >> 4;
#pragma unroll
  for (int m = 0; m < 4; ++m)
#pragma unroll
    for (int n = 0; n < 4; ++n)
      *(f32x4*)(Cs + ((wc >> 1) * 64 + m * 16 + fr) * 132 + (wc & 1) * 64 + n * 16 + fq * 4) = acc[PS * 4 + m][n];
}
#define GROW(r, ps) (row0 + (size_t)(hf * 128 + (ps) * 64 + ((r) & 63)))
#define TNC(r) (tn * 2 + ((r) >> 6))

DEV bool tile_for(int it, int nM, int nN, int& tm, int& tn) {
  const int nx = (gridDim.x >> 3) * 2;
  const int xcd = blockIdx.x & 7, local = (blockIdx.x >> 3) * 2 + vhalf();
  const long id = ((long)it * 8 + xcd) * nx + local;
  if (local >= nx || id >= (long)nM * nN) return false;
  const int per_group = 8 * nN;
  const int g = (int)(id / per_group), r = (int)(id % per_group);
  tn = r >> 3; tm = g * 8 + (r & 7);
  return true;
}

DEV bool tile_for_real(int it, int nM, int nN, int& tm, int& tn) {
  const int nx = (gridDim.x >> 3);
  const int xcd = blockIdx.x & 7, local = (blockIdx.x >> 3);
  const long id = ((long)it * 8 + xcd) * nx + local;
  if (local >= nx || id >= (long)nM * nN) return false;
  const int per_group = 8 * nN;
  const int g = (int)(id / per_group), r = (int)(id % per_group);
  tn = r >> 3; tm = g * 8 + (r & 7);
  return true;
}

PHASE void phase_prep(const Params& p, char* smem) {
  const int tid = opaque_tid();
  const int vb = vblock(), vg = vgrid();
  if (vb == 0 && tid < 8) p.counters[tid] = 0u;
  if (vb == 1 && tid < 2) {
    const float* lv = p.da_lambda + (size_t)tid * 256;
    float d1 = 0.f, d2 = 0.f;
    for (int i = 0; i < 64; ++i) { d1 += lv[i] * lv[64 + i]; d2 += lv[128 + i] * lv[192 + i]; }
    p.counters[32 + tid] = __float_as_uint(__expf(d1) - __expf(d2) + (0.8f - 0.6f * __expf(-0.3f * (float)tid)));
  }
  if (vb == 0) for (int i = tid; i < 3456; i += 256) p.counters[256 + i] = 0u;
  float* tile = (float*)smem;
  const int NCONV = 2 * 4864, NADA = 192;
  for (int item0 = vb; item0 < NCONV + NADA; item0 += vg) {
    const int item = (item0 < NADA) ? (NCONV + item0) : (item0 - NADA);
    if (item < NCONV) {
      const int l = item / 4864; int r = item % 4864;
      const float* src; int K, Nsrc, nT, perm = 0; size_t dst;
      if (r < 2112) { src = p.w_in + (size_t)l * 1024 * 8448; K = 1024; Nsrc = 8448; dst = WIN; nT = 132; }
      else if (r < 2240) { r -= 2112; src = p.w_br_a + (size_t)l * 512 * 1024; K = 512; Nsrc = 1024; dst = WBA; nT = 16; }
      else if (r < 2368) { r -= 2240; src = p.w_br_b + (size_t)l * 512 * 1024; K = 512; Nsrc = 1024; dst = WBB; nT = 16; }
      else if (r < 2496) { r -= 2368; src = p.w_br_c + (size_t)l * 512 * 1024; K = 512; Nsrc = 1024; dst = WBC; nT = 16; }
      else if (r < 2752) { r -= 2496; src = p.w_out + (size_t)l * 1024 * 1024; K = 1024; Nsrc = 1024; dst = WOUT; nT = 16; }
      else if (r < 4160) { r -= 2752; src = p.ffn_w_in + (size_t)l * 1024 * 5632; K = 1024; Nsrc = 5632; dst = WFI; nT = 88; perm = 1; }
      else { r -= 4160; src = p.ffn_w_out + (size_t)l * 2816 * 1024; K = 2816; Nsrc = 1024; dst = WFO; nT = 16; }
      const int kt = r / nT, nt = r % nT;
      const int colbase = perm ? ((nt & 1) * FFH + 64 * (nt >> 1)) : nt * 64;
      __syncthreads();
#pragma unroll
      for (int i = 0; i < 16; ++i) {
        const int k = i * 4 + (tid >> 6), j = tid & 63;
        tile[k * 65 + j] = src[(size_t)(kt * 64 + k) * Nsrc + colbase + j];
      }
      __syncthreads();
      const int row = tid >> 2, kc = (tid & 3) * 16;
      float f[16];
#pragma unroll
      for (int i = 0; i < 16; ++i) f[i] = tile[(kc + i) * 65 + row];
      bf16_t* d = p.wt + (size_t)l * WLAYER + dst + (size_t)(nt * 64 + row) * K + kt * 64 + kc;
      *(uint4*)d = make_uint4(pack2(f[0], f[1]), pack2(f[2], f[3]), pack2(f[4], f[5]), pack2(f[6], f[7]));
      *(uint4*)(d + 8) = make_uint4(pack2(f[8], f[9]), pack2(f[10], f[11]), pack2(f[12], f[13]), pack2(f[14], f[15]));
    } else {
      const int a = item - NCONV;
      const int l = a / 96, r = a % 96, ntile = r >> 2, bg = r & 3;
      float* cact = (float*)smem;
      __syncthreads();
      for (int i = tid; i < 8 * 1024; i += 256) {
        const float cv = p.c[(size_t)(bg * 8 + (i >> 10)) * DM + (i & 1023)];
        cact[i] = cv * sigm(cv);
      }
      __syncthreads();
      const int n = ntile * 256 + tid;
      const float* W = p.ada_w + (size_t)l * DM * ADAW + n;
      float acc[8];
#pragma unroll
      for (int b = 0; b < 8; ++b) acc[b] = 0.f;
      for (int k0 = 0; k0 < DM; k0 += 16) {
        float w[16];
#pragma unroll
        for (int kk = 0; kk < 16; ++kk) w[kk] = W[(size_t)(k0 + kk) * ADAW];
#pragma unroll
        for (int kk = 0; kk < 16; ++kk)
#pragma unroll
          for (int b = 0; b < 8; ++b) acc[b] += cact[b * 1024 + k0 + kk] * w[kk];
      }
      const float bias = p.ada_b[l * ADAW + n];
#pragma unroll
      for (int b = 0; b < 8; ++b) p.ada[((size_t)l * 32 + bg * 8 + b) * ADAW + n] = acc[b] + bias;
    }
  }
}

PHASE void phase_norm(const float* __restrict__ x, const float* __restrict__ w, const float* __restrict__ ada_l,
                    int shift_off, int scale_off, bf16_t* __restrict__ h) {
  const int tid = opaque_tid();
  const int lane = tid & 63, wave = tid >> 6;
  for (int row0 = (vblock() * 4 + wave) * 4; row0 < T_TOK; row0 += vgrid() * 16) {
    float4 v[4][4]; float ss[4];
#pragma unroll
    for (int rr = 0; rr < 4; ++rr)
#pragma unroll
      for (int i = 0; i < 4; ++i) v[rr][i] = *(const float4*)(x + (size_t)(row0 + rr) * DM + i * 256 + lane * 4);
#pragma unroll
    for (int rr = 0; rr < 4; ++rr) {
      float a = 0.f;
#pragma unroll
      for (int i = 0; i < 4; ++i) a += v[rr][i].x * v[rr][i].x + v[rr][i].y * v[rr][i].y + v[rr][i].z * v[rr][i].z + v[rr][i].w * v[rr][i].w;
      ss[rr] = rsqrtf(wave_sum(a) * (1.f / DM) + 1e-6f);
    }
    const float* ad = ada_l + (size_t)(row0 / SEQ) * ADAW;
#pragma unroll
    for (int i = 0; i < 4; ++i) {
      const int col = i * 256 + lane * 4;
      const float4 ww = *(const float4*)(w + col), sc = *(const float4*)(ad + scale_off + col), sh = *(const float4*)(ad + shift_off + col);
#pragma unroll
      for (int rr = 0; rr < 4; ++rr) {
        const float rstd = ss[rr];
        const float o0 = v[rr][i].x * rstd * ww.x * (1.f + sc.x) + sh.x, o1 = v[rr][i].y * rstd * ww.y * (1.f + sc.y) + sh.y;
        const float o2 = v[rr][i].z * rstd * ww.z * (1.f + sc.z) + sh.z, o3 = v[rr][i].w * rstd * ww.w * (1.f + sc.w) + sh.w;
        *(uint2*)(h + (size_t)(row0 + rr) * DM + col) = make_uint2(pack2(o0, o1), pack2(o2, o3));
      }
    }
  }
}

PHASE void phase_final(float* __restrict__ x, const float* __restrict__ w) {
  const int tid = opaque_tid();
  const int lane = tid & 63, wave = tid >> 6;
  for (int row0 = (vblock() * 4 + wave) * 4; row0 < T_TOK; row0 += vgrid() * 16) {
    float4 v[4][4]; float ss[4];
#pragma unroll
    for (int rr = 0; rr < 4; ++rr)
#pragma unroll
      for (int i = 0; i < 4; ++i) v[rr][i] = *(const float4*)(x + (size_t)(row0 + rr) * DM + i * 256 + lane * 4);
#pragma unroll
    for (int rr = 0; rr < 4; ++rr) {
      float a = 0.f;
#pragma unroll
      for (int i = 0; i < 4; ++i) a += v[rr][i].x * v[rr][i].x + v[rr][i].y * v[rr][i].y + v[rr][i].z * v[rr][i].z + v[rr][i].w * v[rr][i].w;
      ss[rr] = rsqrtf(wave_sum(a) * (1.f / DM) + 1e-6f);
    }
#pragma unroll
    for (int i = 0; i < 4; ++i) {
      const int col = i * 256 + lane * 4;
      const float4 ww = *(const float4*)(w + col);
#pragma unroll
      for (int rr = 0; rr < 4; ++rr) {
        const float rstd = ss[rr];
        *(float4*)(x + (size_t)(row0 + rr) * DM + col) =
            make_float4(v[rr][i].x * rstd * ww.x, v[rr][i].y * rstd * ww.y, v[rr][i].z * rstd * ww.z, v[rr][i].w * rstd * ww.w);
      }
    }
  }
}

PHASE void phase_gemm_in(const Params& p, int l, char* smem0) {
  const bf16_t* Wt = p.wt + (size_t)l * WLAYER + WIN;
  const int T = opaque_tid512(), tid = T & 255, hf = vhalf();
  float* Cs = (float*)(smem0 + hf * SMEM_BYTES);
  for (int it = 0;; ++it) {
    int tm, tn;
    if (!tile_for_real(it, 256, 21, tm, tn)) break;
    f32x4 acc[8][4];
    gemm_tile512(T, p.h + (size_t)tm * 256 * DM, DM, Wt + (size_t)tn * 256 * DM, DM, DM, smem0, acc);
    const size_t row0 = (size_t)tm * 256;
#pragma unroll
    for (int ps = 0; ps < 2; ++ps) {
      if (ps == 0) stage_half512<0>(T, Cs, acc); else stage_half512<1>(T, Cs, acc);
      __syncthreads();
      if (tn < 4) {
        const float qs = (tn < 2) ? 0.125f : 1.f;
        const int ch = tid & 15, g = ch >> 3, cc = ch & 7;
        if (cc < 4) {
#pragma unroll 1
          for (int i = 0; i < 8; ++i) {
            const int r = (tid >> 4) + i * 16;
            const size_t grow = GROW(r, ps);
            const float pos = (float)p.pos[grow];
            const float* c1 = Cs + r * 132 + g * 64 + cc * 8;
            float o1[8], o2[8];
#pragma unroll
            for (int e = 0; e < 8; ++e) {
              const float x1 = c1[e], x2 = c1[32 + e];
              const float inv = exp2f(-(float)(cc * 8 + e) * 0.41524101186092029f);
              float rev = pos * inv * 0.15915494309189535f;
              rev -= rintf(rev);
              const float sn = __builtin_amdgcn_sinf(rev), cs = __builtin_amdgcn_cosf(rev);
              o1[e] = (x1 * cs - x2 * sn) * qs; o2[e] = (x2 * cs + x1 * sn) * qs;
            }
            bf16_t* d = p.u + grow * US + TNC(r) * 128 + g * 64 + cc * 8;
            *(uint4*)d = PACK8(o1);
            *(uint4*)(d + 32) = PACK8(o2);
          }
        }
      } else if (tn < 6) {
        const int b = (int)(row0 / SEQ), s0 = (int)(row0 % SEQ);
        const int rch = tid & 15;
        const int vc0 = (TNC(rch * 8) - 8) * 128;
#pragma unroll 1
        for (int i = 0; i < 8; ++i) {
          const int c = (tid >> 4) + i * 16;
          float f[8];
#pragma unroll
          for (int j = 0; j < 8; ++j) f[j] = Cs[(rch * 8 + j) * 132 + c];
          *(uint4*)(p.vT + ((size_t)b * 512 + vc0 + c) * SEQ + s0 + hf * 128 + ps * 64 + ((rch * 8) & 63)) = PACK8(f);
        }
      } else {
        const int ch = tid & 15;
#pragma unroll 1
        for (int i = 0; i < 8; ++i) {
          const int r = (tid >> 4) + i * 16;
          const float4 a = *(const float4*)(Cs + r * 132 + ch * 8), b = *(const float4*)(Cs + r * 132 + ch * 8 + 4);
          *(uint4*)(p.u + GROW(r, ps) * US + TNC(r) * 128 - 512 + ch * 8) = make_uint4(pack2(a.x, a.y), pack2(a.z, a.w), pack2(b.x, b.y), pack2(b.z, b.w));
        }
      }
      __syncthreads();
    }
  }
}

PHASE void phase_vlo(const Params& p, int l, char* smem) {
  float* vs = (float*)smem;
  const int tid = opaque_tid();
  const float* mu = p.rw_mu + (size_t)l * 1792 + 1024;
  const float* v1 = p.rw_v1;
  for (int item = vblock(); item < T_TOK / 32; item += vgrid()) {
    const size_t tok0 = (size_t)item * 32;
    __syncthreads();
#pragma unroll 1
    for (int i = 0; i < 8; ++i) {
      const int c = tid + i * 256;
      const int t = c >> 6, cc = c & 63;
      const size_t tok = tok0 + t;
      const uint4 cur = *(const uint4*)(p.u + tok * US + 3072 + 1024 + cc * 8);
      uint4 prv = make_uint4(0, 0, 0, 0);
      if ((tok % SEQ) != 0) prv = *(const uint4*)(p.u + (tok - 1) * US + 3072 + 1024 + cc * 8);
      float a[8], b[8];
      UNPACK8(cur, a); UNPACK8(prv, b);
#pragma unroll
      for (int e = 0; e < 8; ++e) vs[t * 512 + cc * 8 + e] = a[e] + (b[e] - a[e]) * mu[cc * 8 + e];
    }
    __syncthreads();
    const int j = tid & 31, tg = tid >> 5;
    float acc[4] = {0.f, 0.f, 0.f, 0.f};
    for (int k0 = 0; k0 < 512; k0 += 16) {
      float w[16];
#pragma unroll
      for (int kk = 0; kk < 16; ++kk) w[kk] = v1[(k0 + kk) * 32 + j];
#pragma unroll
      for (int kk = 0; kk < 16; ++kk)
#pragma unroll
        for (int i = 0; i < 4; ++i) acc[i] += vs[(tg * 4 + i) * 512 + k0 + kk] * w[kk];
    }
#pragma unroll
    for (int i = 0; i < 4; ++i) p.vlo[(tok0 + tg * 4 + i) * 32 + j] = acc[i];
  }
}

PHASE void att_item(const Params& p, int l, int item, char* smem) {
  const int qc = 31 - (item >> 7);
  const int bh = item & 127, b = bh >> 2, h = bh & 3;
  const int tid = opaque_tid(), lane = tid & 63, wave = tid >> 6, fr = lane & 15, fq = lane >> 4;
  const int m = wave >> 1, rh = wave & 1;
  bf16_t* Ks = (bf16_t*)smem;
  bf16_t* Vt = Ks + 2 * 64 * 64;
  bf16_t* Ps = Vt + 128 * 64;
  float* Ox = (float*)smem;
  const size_t tok0 = (size_t)b * SEQ + (size_t)qc * 64;
  const float lam_init = 0.8f - 0.6f * __expf(-0.3f * (float)l);
  const float lam = __uint_as_float(p.counters[32 + l]);

  bf16x8 qf[2][2];
#pragma unroll
  for (int mt = 0; mt < 2; ++mt)
#pragma unroll
    for (int ks = 0; ks < 2; ++ks)
      qf[mt][ks] = *(const bf16x8*)(p.u + (tok0 + rh * 32 + mt * 16 + fr) * US + h * 128 + m * 64 + ks * 32 + fq * 8);
  f32x4 o[2][8];
  float mx[2][4], ls[2][4];
#pragma unroll
  for (int mt = 0; mt < 2; ++mt) {
#pragma unroll
    for (int n = 0; n < 8; ++n) o[mt][n] = (f32x4){0.f, 0.f, 0.f, 0.f};
#pragma unroll
    for (int j = 0; j < 4; ++j) { mx[mt][j] = -1e30f; ls[mt][j] = 0.f; }
  }
  bf16_t* Pw = Ps + wave * 32 * 72;
  const int drow = tid >> 3, dlog = ((tid & 7) ^ ((tid >> 3) & 7)) * 8;
  const bf16_t* Kg = p.u + ((size_t)b * SEQ + (drow & 63)) * US + 512 + h * 128 + dlog;
  const bf16_t* Vg = p.vT + ((size_t)b * 512 + h * 128 + drow) * SEQ + dlog;
  const int rsw = fr & 7;
#define ATT_DMA_K(kt_)                                                                                              \
  _Pragma("unroll") for (int i = 0; i < 4; ++i)                                                                     \
    __builtin_amdgcn_global_load_lds((const unsigned*)(Kg + ((size_t)(kt_) * 64 + (i & 1) * 32) * US + (i >> 1) * 64), \
                                     (unsigned*)(Ks + tid * 8 + i * 2048), 16, 0, 0);
#define ATT_DMA_V(kt_)                                                                                              \
  _Pragma("unroll") for (int i = 0; i < 4; ++i)                                                                     \
    __builtin_amdgcn_global_load_lds((const unsigned*)(Vg + (size_t)(i * 32) * SEQ + (kt_) * 64),                  \
                                     (unsigned*)(Vt + tid * 8 + i * 2048), 16, 0, 0);
  __syncthreads();
  ATT_DMA_K(0)
  for (int kt = 0; kt <= qc; ++kt) {
    asm volatile("s_waitcnt vmcnt(0)" ::: "memory");
    __syncthreads();
    ATT_DMA_V(kt)
    f32x4 s[2][4];
#pragma unroll
    for (int mt = 0; mt < 2; ++mt)
#pragma unroll
      for (int n = 0; n < 4; ++n) s[mt][n] = (f32x4){0.f, 0.f, 0.f, 0.f};
#pragma unroll
    for (int ks = 0; ks < 2; ++ks)
#pragma unroll
      for (int n = 0; n < 4; ++n) {
        const bf16x8 kf = *(const bf16x8*)(Ks + (m * 64 + n * 16 + fr) * 64 + (((ks * 4 + fq) ^ rsw) * 8));
#pragma unroll
        for (int mt = 0; mt < 2; ++mt) s[mt][n] = MFMA(qf[mt][ks], kf, s[mt][n]);
      }
#pragma unroll
    for (int mt = 0; mt < 2; ++mt)
#pragma unroll
      for (int j = 0; j < 4; ++j) {
        float tmax = fmaxf(fmaxf(s[mt][0][j], s[mt][1][j]), fmaxf(s[mt][2][j], s[mt][3][j]));
        tmax = red16_max(tmax);
        const float mnew = fmaxf(mx[mt][j], tmax);
        const float alpha = __expf(mx[mt][j] - mnew);
        float rs = 0.f;
#pragma unroll
        for (int n = 0; n < 4; ++n) {
          const float pv = __expf(s[mt][n][j] - mnew);
          rs += pv;
          Pw[(mt * 16 + fq * 4 + j) * 72 + n * 16 + fr] = f2bf(pv);
        }
        rs = red16_sum(rs);
        ls[mt][j] = ls[mt][j] * alpha + rs;
        mx[mt][j] = mnew;
#pragma unroll
        for (int n = 0; n < 8; ++n) o[mt][n][j] *= alpha;
      }
    asm volatile("s_waitcnt vmcnt(0)" ::: "memory");
    __syncthreads();
    if (kt < qc) { ATT_DMA_K(kt + 1) }
#pragma unroll
    for (int ks = 0; ks < 2; ++ks) {
      bf16x8 pf[2];
#pragma unroll
      for (int mt = 0; mt < 2; ++mt) pf[mt] = *(const bf16x8*)(Pw + (mt * 16 + fr) * 72 + ks * 32 + fq * 8);
#pragma unroll
      for (int n = 0; n < 8; ++n) {
        const bf16x8 vf = *(const bf16x8*)(Vt + (n * 16 + fr) * 64 + (((ks * 4 + fq) ^ rsw) * 8));
#pragma unroll
        for (int mt = 0; mt < 2; ++mt) o[mt][n] = MFMA(pf[mt], vf, o[mt][n]);
      }
    }
  }
#undef ATT_DMA_K
#undef ATT_DMA_V
  __syncthreads();
#pragma unroll
  for (int mt = 0; mt < 2; ++mt)
#pragma unroll
    for (int j = 0; j < 4; ++j) {
      const float inv = __builtin_amdgcn_rcpf(ls[mt][j]);
#pragma unroll
      for (int n = 0; n < 8; ++n) o[mt][n][j] *= inv;
    }
  if (m == 1) {
#pragma unroll
    for (int mt = 0; mt < 2; ++mt)
#pragma unroll
      for (int n = 0; n < 8; ++n)
#pragma unroll
        for (int j = 0; j < 4; ++j) Ox[(rh * 32 + mt * 16 + fq * 4 + j) * 132 + n * 16 + fr] = o[mt][n][j];
  }
  __syncthreads();
  if (m == 0) {
    const float* sw = p.da_subln_w + (size_t)l * 128;
    float wv[8];
#pragma unroll
    for (int n = 0; n < 8; ++n) wv[n] = sw[n * 16 + fr] * (1.f - lam_init);
#pragma unroll
    for (int mt = 0; mt < 2; ++mt)
#pragma unroll
      for (int j = 0; j < 4; ++j) {
        float ss = 0.f;
        float d[8];
#pragma unroll
        for (int n = 0; n < 8; ++n) {
          d[n] = o[mt][n][j] - lam * Ox[(rh * 32 + mt * 16 + fq * 4 + j) * 132 + n * 16 + fr];
          ss += d[n] * d[n];
        }
        ss = red16_sum(ss);
        const float rstd = rsqrtf(ss * (1.f / 128.f) + 1e-6f);
        bf16_t* dst = p.u + (tok0 + rh * 32 + mt * 16 + fq * 4 + j) * US + h * 128 + fr;
#pragma unroll
        for (int n = 0; n < 8; ++n) dst[n * 16] = f2bf(d[n] * rstd * wv[n]);
      }
  }
  __syncthreads();
}

PHASE void hgrn_item(const Params& p, int l, int item, char* smem) {
  const int b = item >> 2, h = item & 3;
  const int tid = opaque_tid(), lane = tid & 63, wave = tid >> 6, fr = lane & 15, fq = lane >> 4;
  bf16_t* Qs = (bf16_t*)smem;
  bf16_t* Kn = Qs + 32 * 136;
  bf16_t* KT = Kn + 32 * 136;
  bf16_t* VT = KT + 128 * 40;
  bf16_t* Ps = VT + 128 * 40;
  bf16_t* ST = Ps + 32 * 40;
  float* lfb = (float*)ST;
  float* red = (float*)(ST + 128 * 136);
  float* blast = red + 64;
  const int t_ = tid >> 3, d0 = (tid & 7) * 16;
  float lbv[16];
#pragma unroll
  for (int i = 0; i < 16; ++i) {
    const int c = h * 128 + d0 + i;
    lbv[i] = (l == 0) ? 0.f : sigm(p.hg_lb[512 + c] - p.hg_lb[c]);
  }
  f32x4 S[2][8];
#pragma unroll
  for (int mm = 0; mm < 2; ++mm)
#pragma unroll
    for (int n = 0; n < 8; ++n) S[mm][n] = (f32x4){0.f, 0.f, 0.f, 0.f};
  const float* nw = p.hg_norm_w + (size_t)l * 128;

  for (int ch = 0; ch < 64; ++ch) {
    const size_t tok0 = (size_t)b * SEQ + (size_t)ch * 32;
    __syncthreads();
    float qv[16], kv[16];
    {
      const bf16_t* base = p.u + (tok0 + t_) * US + h * 128 + d0;
      float zv[16], iv[16];
      { const uint4 a = *(const uint4*)(base + 1024), c = *(const uint4*)(base + 1024 + 8); float* z0 = zv; float* z1 = zv + 8; UNPACK8(a, z0); UNPACK8(c, z1); }
      { const uint4 a = *(const uint4*)(base + 1536), c = *(const uint4*)(base + 1536 + 8); float* z0 = iv; float* z1 = iv + 8; UNPACK8(a, z0); UNPACK8(c, z1); }
      { const uint4 a = *(const uint4*)(base + 2048), c = *(const uint4*)(base + 2048 + 8); float* z0 = qv; float* z1 = qv + 8; UNPACK8(a, z0); UNPACK8(c, z1); }
#pragma unroll
      for (int i = 0; i < 16; ++i) {
        const float z = zv[i], lb = lbv[i];
        const float ez = __expf(-fabsf(z));
        float lf;
        if (lb > 0.f) {
          const float rz = __builtin_amdgcn_rcpf(1.f + ez);
          const float sg = (z >= 0.f) ? rz : ez * rz;
          lf = __logf(lb + (1.f - lb) * sg);
        } else {
          lf = -(fmaxf(-z, 0.f) + __logf(1.f + ez));
        }
        const float rz2 = __builtin_amdgcn_rcpf(1.f + ez);
        const float sgn = (z >= 0.f) ? ez * rz2 : rz2;
        kv[i] = (1.f - lb) * sgn;
        lfb[t_ * 128 + d0 + i] = lf;
        VT[(d0 + i) * 40 + t_] = f2bf(iv[i]);
      }
    }
    __syncthreads();
    if (tid < 128) {
      float v[32];
#pragma unroll
      for (int t = 0; t < 32; ++t) v[t] = lfb[t * 128 + tid];
      float bsum = 0.f;
#pragma unroll
      for (int t = 0; t < 32; ++t) { bsum += v[t]; lfb[t * 128 + tid] = bsum; }
      blast[tid] = bsum;
    }
    __syncthreads();
    {
      float qo[16], ko[16];
#pragma unroll
      for (int i = 0; i < 16; ++i) {
        const float bb = lfb[t_ * 128 + d0 + i];
        qo[i] = qv[i] * __expf(bb);
        ko[i] = kv[i] * __expf(fminf(-bb, 80.f));
        KT[(d0 + i) * 40 + t_] = f2bf(ko[i]);
      }
      float* q0 = qo; float* q1 = qo + 8; float* k0 = ko; float* k1 = ko + 8;
      *(uint4*)(Qs + t_ * 136 + d0) = PACK8(q0);
      *(uint4*)(Qs + t_ * 136 + d0 + 8) = PACK8(q1);
      *(uint4*)(Kn + t_ * 136 + d0) = PACK8(k0);
      *(uint4*)(Kn + t_ * 136 + d0 + 8) = PACK8(k1);
    }
    __syncthreads();
#pragma unroll
    for (int mm = 0; mm < 2; ++mm)
#pragma unroll
      for (int n = 0; n < 8; ++n)
        *(uint2*)(ST + (n * 16 + fr) * 136 + wave * 32 + mm * 16 + fq * 4) =
            make_uint2(pack2(S[mm][n][0], S[mm][n][1]), pack2(S[mm][n][2], S[mm][n][3]));
    {
      const int mt = wave >> 1, nt = wave & 1;
      f32x4 sc = (f32x4){0.f, 0.f, 0.f, 0.f};
#pragma unroll
      for (int ks = 0; ks < 4; ++ks) {
        const bf16x8 a = *(const bf16x8*)(Qs + (mt * 16 + fr) * 136 + ks * 32 + fq * 8);
        const bf16x8 bb = *(const bf16x8*)(Kn + (nt * 16 + fr) * 136 + ks * 32 + fq * 8);
        sc = MFMA(a, bb, sc);
      }
#pragma unroll
      for (int j = 0; j < 4; ++j) {
        const int t = mt * 16 + fq * 4 + j, key = nt * 16 + fr;
        Ps[t * 40 + key] = f2bf(key <= t ? sc[j] : 0.f);
      }
    }
    __syncthreads();
    {
      const int mt = wave & 1, nb = (wave >> 1) * 4;
      f32x4 oo[4];
#pragma unroll
      for (int n = 0; n < 4; ++n) oo[n] = (f32x4){0.f, 0.f, 0.f, 0.f};
      {
        const bf16x8 a = *(const bf16x8*)(Ps + (mt * 16 + fr) * 40 + fq * 8);
#pragma unroll
        for (int n = 0; n < 4; ++n) {
          const bf16x8 bb = *(const bf16x8*)(VT + ((nb + n) * 16 + fr) * 40 + fq * 8);
          oo[n] = MFMA(a, bb, oo[n]);
        }
      }
#pragma unroll
      for (int ks = 0; ks < 4; ++ks) {
        const bf16x8 a = *(const bf16x8*)(Qs + (mt * 16 + fr) * 136 + ks * 32 + fq * 8);
#pragma unroll
        for (int n = 0; n < 4; ++n) {
          const bf16x8 bb = *(const bf16x8*)(ST + ((nb + n) * 16 + fr) * 136 + ks * 32 + fq * 8);
          oo[n] = MFMA(a, bb, oo[n]);
        }
      }
#pragma unroll
      for (int j = 0; j < 4; ++j) {
        float ss = 0.f;
#pragma unroll
        for (int n = 0; n < 4; ++n) ss += oo[n][j] * oo[n][j];
        ss = red16_sum(ss);
        if (fr == 0) red[(mt * 16 + fq * 4 + j) * 2 + (wave >> 1)] = ss;
      }
      __syncthreads();
#pragma unroll
      for (int j = 0; j < 4; ++j) {
        const int t = mt * 16 + fq * 4 + j;
        const float rstd = rsqrtf((red[t * 2] + red[t * 2 + 1]) * (1.f / 128.f) + 1e-6f);
        bf16_t* gp = p.u + (tok0 + t) * US + 2560 + h * 128 + nb * 16 + fr;
#pragma unroll
        for (int n = 0; n < 4; ++n) {
          const float g = bf2f(gp[n * 16]);
          gp[n * 16] = f2bf(oo[n][j] * rstd * nw[(nb + n) * 16 + fr] * (g * sigm(g)));
        }
      }
    }
    {
      bf16x8 af[2];
#pragma unroll
      for (int mm = 0; mm < 2; ++mm) af[mm] = *(const bf16x8*)(KT + (wave * 32 + mm * 16 + fr) * 40 + fq * 8);
#pragma unroll
      for (int n = 0; n < 8; ++n) {
        const bf16x8 bb = *(const bf16x8*)(VT + (n * 16 + fr) * 40 + fq * 8);
#pragma unroll
        for (int mm = 0; mm < 2; ++mm) S[mm][n] = MFMA(af[mm], bb, S[mm][n]);
      }
#pragma unroll
      for (int mm = 0; mm < 2; ++mm)
#pragma unroll
        for (int j = 0; j < 4; ++j) {
          const float e = __expf(blast[wave * 32 + mm * 16 + fq * 4 + j]);
#pragma unroll
          for (int n = 0; n < 8; ++n) S[mm][n][j] *= e;
        }
    }
  }
  __syncthreads();
}

DEV uint4 rw_act(const uint4 cur, const uint4 prv, const float* mul8, int mode) {
  const float4 m0 = *(const float4*)(mul8), m1 = *(const float4*)(mul8 + 4);
  const float mm[8] = {m0.x, m0.y, m0.z, m0.w, m1.x, m1.y, m1.z, m1.w};
  float a[8], b[8], o[8];
  UNPACK8(cur, a); UNPACK8(prv, b);
#pragma unroll
  for (int e = 0; e < 8; ++e) {
    float v = a[e] + (b[e] - a[e]) * mm[e];
    if (mode == 1) { const float t = __expf(-2.f * fabsf(v)); const float th = (1.f - t) * __builtin_amdgcn_rcpf(1.f + t); v = (v >= 0.f) ? th : -th; }
    else if (mode == 2) v = sigm(v);
    o[e] = v;
  }
  return PACK8(o);
}
DEV bf16x8 rw_bfrag(const float* W, int k0, int col) {
  float o[8];
#pragma unroll
  for (int e = 0; e < 8; ++e) o[e] = W[(size_t)(k0 + e) * 512 + col];
  return as_frag(PACK8(o));
}

PHASE void rwkv_item(const Params& p, int l, int item, char* smem) {
  const int b = item >> 3, h = item & 7;
  const int tid = opaque_tid(), lane = tid & 63, wave = tid >> 6, fr = lane & 15, fq = lane >> 4;
  float* R = (float*)smem;
  float* K = R + 2048; float* KK = K + 2048; float* W = KK + 2048; float* BB = W + 2048;
  float* V = BB + 2048; float* G = V + 2048; float* O = G + 2048;
  float* cst = O + 2048;
  float* mul = cst + 512;
  bf16_t* rawL = (bf16_t*)smem;
  float* vloL = (float*)(smem + 17424);
  const float* mu = p.rw_mu + (size_t)l * 1792;
  const int hc_n = h * 64 + wave * 16 + fr;
  bf16x8 w2f[2], a2f[2], g2f[4], v2f;
#pragma unroll
  for (int ks = 0; ks < 2; ++ks) {
    w2f[ks] = rw_bfrag(p.rw_w2 + (size_t)l * 64 * 512, ks * 32 + fq * 8, hc_n);
    a2f[ks] = rw_bfrag(p.rw_a2 + (size_t)l * 64 * 512, ks * 32 + fq * 8, hc_n);
  }
#pragma unroll
  for (int ks = 0; ks < 4; ++ks) g2f[ks] = rw_bfrag(p.rw_g2 + (size_t)l * 128 * 512, ks * 32 + fq * 8, hc_n);
  v2f = w2f[0];
  if (l > 0) v2f = rw_bfrag(p.rw_v2, fq * 8, hc_n);
  const float w0c = p.rw_w0[l * 512 + hc_n], a0c = p.rw_a0[l * 512 + hc_n];
  const float v0c = (l > 0) ? p.rw_v0[hc_n] : 0.f;
  const int t_ = tid >> 3, n0 = (tid & 7) * 8;
  __syncthreads();
  if (tid < 64) {
    const int hc = h * 64 + tid;
    cst[tid] = p.rw_k_k[l * 512 + hc]; cst[64 + tid] = p.rw_k_a[l * 512 + hc]; cst[128 + tid] = p.rw_r_k[l * 512 + hc];
    cst[192 + tid] = p.rw_gn_w[l * 512 + hc]; cst[256 + tid] = p.rw_gn_b[l * 512 + hc];
    cst[320 + tid] = mu[hc]; cst[384 + tid] = mu[512 + hc]; cst[448 + tid] = mu[1024 + hc];
  }
  mul[tid] = mu[1536 + tid];
  const float* kkc = cst + n0; const float* kac = cst + 64 + n0; const float* rkc = cst + 128 + n0;
  const float* gnw = cst + 192 + n0; const float* gnb = cst + 256 + n0;
  const float* mur = cst + 320 + n0; const float* muk = cst + 384 + n0; const float* muv = cst + 448 + n0;
  const int kq = lane & 7, row0 = wave * 16 + (lane >> 3), row1 = row0 + 8;
  f32x2 S0p[4], S1p[4];
#pragma unroll
  for (int e = 0; e < 4; ++e) { S0p[e] = (f32x2){0.f, 0.f}; S1p[e] = (f32x2){0.f, 0.f}; }

  uint4 pl0, pl1, pl2, pl3, pl4, pcr, pck, pcv, ppr, ppk, ppv, pvf;
  float4 pvl;
#define RW_PREFETCH(ch_)                                                                                    \
  {                                                                                                         \
    const size_t tk0 = (size_t)b * SEQ + (size_t)(ch_) * 32;                                                 \
    const bf16_t* lb_ = p.u + (tk0 - 1) * US + 3072 + 1536 + (tid & 31) * 8;                                 \
    const int r0_ = tid >> 5;                                                                               \
    pl0 = make_uint4(0, 0, 0, 0); if (!((ch_) == 0 && r0_ == 0)) pl0 = *(const uint4*)(lb_ + (size_t)r0_ * US); \
    pl1 = *(const uint4*)(lb_ + (size_t)(r0_ + 8) * US);                                                     \
    pl2 = *(const uint4*)(lb_ + (size_t)(r0_ + 16) * US);                                                    \
    pl3 = *(const uint4*)(lb_ + (size_t)(r0_ + 24) * US);                                                    \
    pl4 = make_uint4(0, 0, 0, 0); if (tid < 32) pl4 = *(const uint4*)(lb_ + (size_t)32 * US);                \
    const bf16_t* cu_ = p.u + (tk0 + t_) * US + 3072 + h * 64 + n0;                                          \
    pcr = *(const uint4*)cu_; pck = *(const uint4*)(cu_ + 512); pcv = *(const uint4*)(cu_ + 1024);           \
    if ((ch_) == 0 && t_ == 0) { ppr = make_uint4(0, 0, 0, 0); ppk = ppr; ppv = ppr; }                        \
    else { ppr = *(const uint4*)(cu_ - US); ppk = *(const uint4*)(cu_ - US + 512); ppv = *(const uint4*)(cu_ - US + 1024); } \
    if (l > 0) {                                                                                            \
      pvl = *(const float4*)(p.vlo + (tk0 + (tid >> 3)) * 32 + (tid & 7) * 4);                               \
      pvf = *(const uint4*)(p.vfirst + (tk0 + t_) * 512 + h * 64 + n0);                                      \
    } else { pvl = make_float4(0.f, 0.f, 0.f, 0.f); pvf = make_uint4(0, 0, 0, 0); }                          \
  }
  RW_PREFETCH(0)

  for (int ch = 0; ch < 64; ++ch) {
    const size_t tok0 = (size_t)b * SEQ + (size_t)ch * 32;
    __syncthreads();
    {
      const int r0_ = tid >> 5, cc_ = (tid & 31) * 8;
      *(uint4*)(rawL + r0_ * 264 + cc_) = pl0;
      *(uint4*)(rawL + (r0_ + 8) * 264 + cc_) = pl1;
      *(uint4*)(rawL + (r0_ + 16) * 264 + cc_) = pl2;
      *(uint4*)(rawL + (r0_ + 24) * 264 + cc_) = pl3;
      if (tid < 32) *(uint4*)(rawL + 32 * 264 + cc_) = pl4;
      *(float4*)(vloL + (tid >> 3) * 36 + (tid & 7) * 4) = pvl;
    }
    __syncthreads();
    {
      const int cc_ = (tid & 31) * 8, tr = tid >> 5;
      const int mode = (cc_ < 64) ? 1 : ((cc_ < 128) ? 0 : 2);
      uint4 a0, a1, a2, a3;
      a0 = rw_act(*(const uint4*)(rawL + (tr + 1) * 264 + cc_), *(const uint4*)(rawL + tr * 264 + cc_), mul + cc_, mode);
      a1 = rw_act(*(const uint4*)(rawL + (tr + 9) * 264 + cc_), *(const uint4*)(rawL + (tr + 8) * 264 + cc_), mul + cc_, mode);
      a2 = rw_act(*(const uint4*)(rawL + (tr + 17) * 264 + cc_), *(const uint4*)(rawL + (tr + 16) * 264 + cc_), mul + cc_, mode);
      a3 = rw_act(*(const uint4*)(rawL + (tr + 25) * 264 + cc_), *(const uint4*)(rawL + (tr + 24) * 264 + cc_), mul + cc_, mode);
      __syncthreads();
      *(uint4*)(rawL + tr * 264 + cc_) = a0;
      *(uint4*)(rawL + (tr + 8) * 264 + cc_) = a1;
      *(uint4*)(rawL + (tr + 16) * 264 + cc_) = a2;
      *(uint4*)(rawL + (tr + 24) * 264 + cc_) = a3;
    }
    __syncthreads();
#pragma unroll 1
    for (int mt = 0; mt < 2; ++mt) {
      const int row = mt * 16 + fr;
      const bf16_t* ar = rawL + row * 264 + fq * 8;
      f32x4 aw = (f32x4){0.f, 0.f, 0.f, 0.f}, aa = aw, ag = aw, av = aw;
#pragma unroll
      for (int ks = 0; ks < 2; ++ks) {
        aw = MFMA(*(const bf16x8*)(ar + ks * 32), w2f[ks], aw);
        aa = MFMA(*(const bf16x8*)(ar + 64 + ks * 32), a2f[ks], aa);
      }
#pragma unroll
      for (int ks = 0; ks < 4; ++ks) ag = MFMA(*(const bf16x8*)(ar + 128 + ks * 32), g2f[ks], ag);
      if (l > 0) {
        const float4 x0 = *(const float4*)(vloL + row * 36 + fq * 8), x1 = *(const float4*)(vloL + row * 36 + fq * 8 + 4);
        const uint4 pk = make_uint4(pack2(x0.x, x0.y), pack2(x0.z, x0.w), pack2(x1.x, x1.y), pack2(x1.z, x1.w));
        av = MFMA(as_frag(pk), v2f, av);
      }
#pragma unroll
      for (int j = 0; j < 4; ++j) {
        const int t = mt * 16 + fq * 4 + j, n = wave * 16 + fr;
        const float wv = -(w0c + aw[j]);
        const float sp = fmaxf(wv, 0.f) + __logf(1.f + __expf(-fabsf(wv)));
        const float wl = -sp - 0.5f;
        W[t * 64 + n] = __expf(-__expf(wl));
        BB[t * 64 + n] = sigm(a0c + aa[j]);
        G[t * 64 + n] = ag[j];
        if (l > 0) O[t * 64 + n] = sigm(v0c + av[j]);
      }
    }
    __syncthreads();
    {
      const size_t tok = tok0 + t_;
      float cr[8], ck[8], cv[8], pr[8], pk[8], pv[8];
      UNPACK8(pcr, cr); UNPACK8(pck, ck); UNPACK8(pcv, cv);
      UNPACK8(ppr, pr); UNPACK8(ppk, pk); UNPACK8(ppv, pv);
      float kx[8], kkv[8], vs[8], ss = 0.f;
#pragma unroll
      for (int e = 0; e < 8; ++e) {
        R[t_ * 64 + n0 + e] = cr[e] + (pr[e] - cr[e]) * mur[e];
        kx[e] = ck[e] + (pk[e] - ck[e]) * muk[e];
        vs[e] = cv[e] + (pv[e] - cv[e]) * muv[e];
        kkv[e] = kx[e] * kkc[e]; ss += kkv[e] * kkv[e];
      }
      ss = red8_sum(ss);
      const float rn = rsqrtf(fmaxf(ss, 1e-24f));
#pragma unroll
      for (int e = 0; e < 8; ++e) {
        const float a = BB[t_ * 64 + n0 + e];
        const float kn = kkv[e] * rn;
        K[t_ * 64 + n0 + e] = kx[e] * (1.f + (a - 1.f) * kac[e]);
        KK[t_ * 64 + n0 + e] = kn;
        BB[t_ * 64 + n0 + e] = kn * a;
      }
      if (l == 0) {
        *(uint4*)(p.vfirst + tok * 512 + h * 64 + n0) = PACK8(vs);
      } else {
        float vf[8]; UNPACK8(pvf, vf);
#pragma unroll
        for (int e = 0; e < 8; ++e) vs[e] = vs[e] + (vf[e] - vs[e]) * O[t_ * 64 + n0 + e];
      }
#pragma unroll
      for (int e = 0; e < 8; ++e) V[t_ * 64 + n0 + e] = vs[e];
    }
    __syncthreads();
    if (ch + 1 < 64) RW_PREFETCH(ch + 1)
    asm volatile("" ::: "memory");
#pragma unroll 4
    for (int t = 0; t < 32; ++t) {
      const float* base = R + t * 64 + kq * 8;
      const float4 r0 = *(const float4*)(base), r1 = *(const float4*)(base + 4);
      const float4 k0 = *(const float4*)(base + 2048), k1 = *(const float4*)(base + 2048 + 4);
      const float4 q0 = *(const float4*)(base + 4096), q1 = *(const float4*)(base + 4096 + 4);
      const float4 w0 = *(const float4*)(base + 6144), w1 = *(const float4*)(base + 6144 + 4);
      const float4 b0 = *(const float4*)(base + 8192), b1 = *(const float4*)(base + 8192 + 4);
      const float va = V[t * 64 + row0], vb = V[t * 64 + row1];
      const f32x2 rr[4] = {{r0.x, r0.y}, {r0.z, r0.w}, {r1.x, r1.y}, {r1.z, r1.w}};
      const f32x2 ww[4] = {{w0.x, w0.y}, {w0.z, w0.w}, {w1.x, w1.y}, {w1.z, w1.w}};
      const f32x2 kk_[4] = {{k0.x, k0.y}, {k0.z, k0.w}, {k1.x, k1.y}, {k1.z, k1.w}};
      const f32x2 qq[4] = {{q0.x, q0.y}, {q0.z, q0.w}, {q1.x, q1.y}, {q1.z, q1.w}};
      const f32x2 bb[4] = {{b0.x, b0.y}, {b0.z, b0.w}, {b1.x, b1.y}, {b1.z, b1.w}};
      f32x2 a0 = S0p[0] * qq[0], a1 = S1p[0] * qq[0];
#pragma unroll
      for (int e = 1; e < 4; ++e) { a0 += S0p[e] * qq[e]; a1 += S1p[e] * qq[e]; }
      const float sa0 = -red8_sum(a0.x + a0.y), sa1 = -red8_sum(a1.x + a1.y);
      f32x2 sa0v, sa1v, vav, vbv;
      sa0v.x = sa0; sa0v.y = sa0; sa1v.x = sa1; sa1v.y = sa1; vav.x = va; vav.y = va; vbv.x = vb; vbv.y = vb;
      f32x2 o0v = {0.f, 0.f}, o1v = {0.f, 0.f};
#pragma unroll
      for (int e = 0; e < 4; ++e) {
        S0p[e] = S0p[e] * ww[e] + sa0v * bb[e] + vav * kk_[e];
        S1p[e] = S1p[e] * ww[e] + sa1v * bb[e] + vbv * kk_[e];
        o0v += S0p[e] * rr[e]; o1v += S1p[e] * rr[e];
      }
      const float o0 = red8_sum(o0v.x + o0v.y), o1 = red8_sum(o1v.x + o1v.y);
      if (kq == 0) { O[t * 64 + row0] = o0; O[t * 64 + row1] = o1; }
    }
    asm volatile("s_waitcnt vmcnt(0)" ::: "memory");
    __syncthreads();
    {
      const size_t tok = tok0 + t_;
      float ov[8], s1 = 0.f, bon = 0.f;
#pragma unroll
      for (int e = 0; e < 8; ++e) {
        ov[e] = O[t_ * 64 + n0 + e]; s1 += ov[e];
        bon += R[t_ * 64 + n0 + e] * K[t_ * 64 + n0 + e] * rkc[e];
      }
      s1 = red8_sum(s1); bon = red8_sum(bon);
      const float mean = s1 * (1.f / 64.f);
      float s2 = 0.f;
#pragma unroll
      for (int e = 0; e < 8; ++e) { const float d = ov[e] - mean; s2 += d * d; }
      s2 = red8_sum(s2);
      const float rstd = rsqrtf(s2 * (1.f / 64.f) + 64e-5f);
      float y[8];
#pragma unroll
      for (int e = 0; e < 8; ++e)
        y[e] = ((ov[e] - mean) * rstd * gnw[e] + gnb[e] + bon * V[t_ * 64 + n0 + e]) * G[t_ * 64 + n0 + e];
      *(uint4*)(p.u + tok * US + 3072 + h * 64 + n0) = PACK8(y);
    }
  }
#undef RW_PREFETCH
  __syncthreads();
}

PHASE void phase_mix(const Params& p, int l, char* smem) {
  const int hf = vhalf();
  int* sitem = (int*)(smem - hf * SMEM_BYTES + SMEM_BYTES - 16);
  const int t512 = opaque_tid512();
  while (true) {
    __syncthreads();
    if (t512 == 0) *sitem = (int)atomicAdd(p.counters + l * 4 + 0, 1u);
    __syncthreads();
    const int tk = *sitem;
    if (tk >= 128) break;
    rwkv_item(p, l, tk * 2 + hf, smem);
  }
  while (true) {
    __syncthreads();
    if (t512 == 0) *sitem = (int)atomicAdd(p.counters + l * 4 + 1, 1u);
    __syncthreads();
    const int tk = *sitem;
    if (tk >= 64) break;
    hgrn_item(p, l, tk * 2 + hf, smem);
  }
  while (true) {
    __syncthreads();
    if (t512 == 0) *sitem = (int)atomicAdd(p.counters + l * 4 + 2, 1u);
    __syncthreads();
    const int tk = *sitem;
    if (tk >= 2048) break;
    att_item(p, l, tk * 2 + hf, smem);
  }
}

DEV void gemm_gates(const int tid_in, const bf16_t* A, const bf16_t* Wg, int tn, char* smem, unsigned (&Gp)[4][6][2]) {
  int tid = tid_in; asm volatile("" : "+v"(tid));
  bf16_t* As = (bf16_t*)smem;
  bf16_t* Bs = As + 3 * 4096;
  const int lane = tid & 63, wave = tid >> 6, wr = wave >> 1, wc = wave & 1;
  const int fr = lane & 15, fq = lane >> 4;
  f32x4 acc[4][6];
#pragma unroll
  for (int m = 0; m < 4; ++m)
#pragma unroll
    for (int n = 0; n < 6; ++n) acc[m][n] = (f32x4){0.f, 0.f, 0.f, 0.f};
  const int nk = DM >> 5;
  const int drow = tid >> 2, dphys = tid & 3, dg = (0 - (tid >> 4)) & 3;
  const int cofs = (dphys ^ dg) * 8;
  const unsigned aofs = (unsigned)(drow * DM + cofs);
  unsigned bofs0, bofs1, bofs2;
  {
    int r = drow; int wcb = r / 96, br = (r % 96) >> 5, c = (r % 96) & 31;
    bofs0 = (unsigned)((5376 + br * 1024 + tn * 64 + wcb * 32 + c) * DM + cofs);
    r = drow + 64; wcb = r / 96; br = (r % 96) >> 5; c = (r % 96) & 31;
    bofs1 = (unsigned)((5376 + br * 1024 + tn * 64 + wcb * 32 + c) * DM + cofs);
    r = drow + 128; wcb = r / 96; br = (r % 96) >> 5; c = (r % 96) & 31;
    bofs2 = (unsigned)((5376 + br * 1024 + tn * 64 + wcb * 32 + c) * DM + cofs);
  }
  const int rofs = (fq ^ ((0 - (fr >> 2)) & 3)) * 8;
#define GG_DMA(st, kk)                                                                                       \
  {                                                                                                          \
    __builtin_amdgcn_global_load_lds((const unsigned*)(A + aofs + (kk) * 32), (unsigned*)(As + (st) * 4096 + tid * 8), 16, 0, 0);                     \
    __builtin_amdgcn_global_load_lds((const unsigned*)(A + aofs + 64 * DM + (kk) * 32), (unsigned*)(As + (st) * 4096 + tid * 8 + 2048), 16, 0, 0); \
    __builtin_amdgcn_global_load_lds((const unsigned*)(Wg + bofs0 + (kk) * 32), (unsigned*)(Bs + (st) * 6144 + tid * 8), 16, 0, 0);                    \
    __builtin_amdgcn_global_load_lds((const unsigned*)(Wg + bofs1 + (kk) * 32), (unsigned*)(Bs + (st) * 6144 + tid * 8 + 2048), 16, 0, 0);             \
    __builtin_amdgcn_global_load_lds((const unsigned*)(Wg + bofs2 + (kk) * 32), (unsigned*)(Bs + (st) * 6144 + tid * 8 + 4096), 16, 0, 0);             \
  }
  GG_DMA(0, 0)
  GG_DMA(1, 1)
  int st = 0;
  for (int kt = 0; kt < nk; ++kt) {
    if (kt + 1 < nk) asm volatile("s_waitcnt vmcnt(5)" ::: "memory");
    else asm volatile("s_waitcnt vmcnt(0)" ::: "memory");
    __builtin_amdgcn_s_barrier();
    asm volatile("" ::: "memory");
    const int s2 = (st >= 1) ? st - 1 : 2;
    const bf16_t* Ab = As + st * 4096 + (wr * 64 + fr) * 32 + rofs;
    const bf16_t* Bb = Bs + st * 6144 + (wc * 96 + fr) * 32 + rofs;
    bf16x8 bfr[6], af[4];
#pragma unroll
    for (int n = 0; n < 6; ++n) bfr[n] = *(const bf16x8*)(Bb + n * 512);
#pragma unroll
    for (int m = 0; m < 4; ++m) af[m] = *(const bf16x8*)(Ab + m * 512);
    if (kt + 2 < nk) GG_DMA(s2, kt + 2)
#pragma unroll
    for (int m = 0; m < 4; ++m)
#pragma unroll
      for (int n = 0; n < 6; ++n) acc[m][n] = MFMA(af[m], bfr[n], acc[m][n]);
    st = (st == 2) ? 0 : st + 1;
  }
#undef GG_DMA
  __syncthreads();
#pragma unroll
  for (int m = 0; m < 4; ++m)
#pragma unroll
    for (int n = 0; n < 6; ++n) {
      Gp[m][n][0] = pack2(sigm(acc[m][n][0]), sigm(acc[m][n][1]));
      Gp[m][n][1] = pack2(sigm(acc[m][n][2]), sigm(acc[m][n][3]));
    }
}

PHASE void phase_merge(const Params& p, int l, char* smem) {
  const bf16_t* Wl = p.wt + (size_t)l * WLAYER;
  float* Cs = (float*)smem;
  const int tid = opaque_tid();
  for (int it = 0;; ++it) {
    int tm, tn;
    if (!tile_for(it, 512, 16, tm, tn)) break;
    const size_t row0 = (size_t)tm * 128;
    unsigned Gp[4][6][2];
    gemm_gates(tid, p.h + row0 * DM, Wl + WIN, tn, smem, Gp);
    f32x4 acc[4][2], M[4][2];
#pragma unroll
    for (int m = 0; m < 4; ++m)
#pragma unroll
      for (int n = 0; n < 2; ++n) M[m][n] = (f32x4){0.f, 0.f, 0.f, 0.f};
#pragma unroll
    for (int br = 0; br < 3; ++br) {
      const int aoff = (br == 0) ? 0 : (br == 1 ? 2560 : 3072);
      const size_t woff = (br == 0) ? WBA : (br == 1 ? WBB : WBC);
      gemm_tile<2>(tid, p.u + row0 * US + aoff, US, Wl + woff + (size_t)(tn * 64) * 512, 512, 512, smem, acc);
#pragma unroll
      for (int m = 0; m < 4; ++m)
#pragma unroll
        for (int n = 0; n < 2; ++n) {
          M[m][n][0] += lo16(Gp[m][2 * br + n][0]) * acc[m][n][0];
          M[m][n][1] += hi16(Gp[m][2 * br + n][0]) * acc[m][n][1];
          M[m][n][2] += lo16(Gp[m][2 * br + n][1]) * acc[m][n][2];
          M[m][n][3] += hi16(Gp[m][2 * br + n][1]) * acc[m][n][3];
        }
    }
    stage_acc<2>(tid, Cs, M);
    __syncthreads();
    {
      const int ch = tid & 7;
#pragma unroll 1
      for (int i = 0; i < 4; ++i) {
        const int r = (tid >> 3) + i * 32;
        const float4 a = *(const float4*)(Cs + r * 68 + ch * 8), b = *(const float4*)(Cs + r * 68 + ch * 8 + 4);
        *(uint4*)(p.u + (row0 + r) * US + 1024 + tn * 64 + ch * 8) = make_uint4(pack2(a.x, a.y), pack2(a.z, a.w), pack2(b.x, b.y), pack2(b.z, b.w));
      }
    }
    __syncthreads();
  }
}

PHASE void phase_gemm_res(const bf16_t* A, int lda, const bf16_t* Wt, int K, const float* xin, float* xout,
                        const float* ada_l, int gate_off, char* smem0) {
  const int T = opaque_tid512(), tid = T & 255, hf = vhalf();
  float* Cs = (float*)(smem0 + hf * SMEM_BYTES);
  for (int it = 0;; ++it) {
    int tm, tn;
    if (!tile_for_real(it, 256, 4, tm, tn)) break;
    const size_t row0 = (size_t)tm * 256;
    f32x4 acc[8][4];
    gemm_tile512(T, A + row0 * lda, lda, Wt + (size_t)(tn * 256) * K, K, K, smem0, acc);
    const float* gate = ada_l + (size_t)(row0 / SEQ) * ADAW + gate_off;
    const int c4 = (tid & 31) * 4;
#pragma unroll
    for (int ps = 0; ps < 2; ++ps) {
      if (ps == 0) stage_half512<0>(T, Cs, acc); else stage_half512<1>(T, Cs, acc);
      __syncthreads();
#pragma unroll 1
      for (int i0 = 0; i0 < 16; i0 += 4) {
        float4 xv[4], gv[4], cv[4]; size_t off[4];
#pragma unroll
        for (int ii = 0; ii < 4; ++ii) {
          const int r = (tid >> 5) + (i0 + ii) * 8;
          const int colb = TNC(r) * 128 + c4;
          off[ii] = GROW(r, ps) * DM + colb;
          xv[ii] = *(const float4*)(xin + off[ii]);
          gv[ii] = *(const float4*)(gate + colb);
          cv[ii] = *(const float4*)(Cs + r * 132 + c4);
        }
        asm volatile("" ::: "memory");
#pragma unroll
        for (int ii = 0; ii < 4; ++ii)
          *(float4*)(xout + off[ii]) = make_float4(xv[ii].x + gv[ii].x * cv[ii].x, xv[ii].y + gv[ii].y * cv[ii].y,
                                                   xv[ii].z + gv[ii].z * cv[ii].z, xv[ii].w + gv[ii].w * cv[ii].w);
      }
      __syncthreads();
    }
  }
}

PHASE void phase_ffn_in(const Params& p, int l, char* smem0) {
  const bf16_t* Wt = p.wt + (size_t)l * WLAYER + WFI;
  const int T = opaque_tid512(), tid = T & 255, hf = vhalf();
  float* Cs = (float*)(smem0 + hf * SMEM_BYTES);
  for (int it = 0;; ++it) {
    int tm, tn;
    if (!tile_for_real(it, 256, 22, tm, tn)) break;
    const size_t row0 = (size_t)tm * 256;
    f32x4 acc[8][4];
    gemm_tile512(T, p.h + row0 * DM, DM, Wt + (size_t)(tn * 256) * DM, DM, DM, smem0, acc);
    const int ch = tid & 7;
#pragma unroll
    for (int ps = 0; ps < 2; ++ps) {
      if (ps == 0) stage_half512<0>(T, Cs, acc); else stage_half512<1>(T, Cs, acc);
      __syncthreads();
#pragma unroll 1
      for (int i = 0; i < 4; ++i) {
        const int r = (tid >> 3) + i * 32;
        const float* cp = Cs + r * 132 + ch * 8;
        float o[8];
#pragma unroll
        for (int e = 0; e < 8; ++e) { const float g = cp[e], uu = cp[64 + e]; o[e] = g * sigm(g) * uu; }
        *(uint4*)(p.u + GROW(r, ps) * FFH + TNC(r) * 64 + ch * 8) = PACK8(o);
      }
      __syncthreads();
    }
  }
}

#define XB_TMO      128
#define XB_XCNT(j)  (256  + 64 * (j))
#define XB_XSUB(j)  (1280 + 64 * (j))
#define XB_XGEN(j)  (2304 + 64 * (j))
#define XB_TOP      3328
#define XB_TOPGEN   3392
#define XCD_BAR_WORDS 3456
#define XB_SPIN_CAP (1u << 18)
#define LAS __attribute__((address_space(3)))
DEV unsigned xb_ld(unsigned* p) { return __hip_atomic_load(p, __ATOMIC_RELAXED, __HIP_MEMORY_SCOPE_AGENT); }
DEV unsigned xb_add(unsigned* p, unsigned v) { return __hip_atomic_fetch_add(p, v, __ATOMIC_RELAXED, __HIP_MEMORY_SCOPE_AGENT); }
DEV unsigned xb_xcc_id() { return (unsigned)__builtin_amdgcn_s_getreg((3 << 11) | 20) & 0xFu; }
#define XB_SPIN(cond, bar) do { unsigned _sp = 0; while (cond) { __builtin_amdgcn_s_sleep(1); \
    if ((++_sp & 255u) == 0u) { if (xb_ld(&(bar)[XB_TMO])) break; if (_sp > XB_SPIN_CAP) { atomicAdd(&(bar)[XB_TMO], 1u); break; } } } } while (0)
struct XcdBarrier { unsigned* bar; unsigned x; volatile LAS unsigned* st; };
DEV XcdBarrier xcd_barrier_post(unsigned* bar, volatile LAS unsigned* st) {
  XcdBarrier b; b.bar = bar; b.x = xb_xcc_id(); b.st = st;
  if (threadIdx.x == 0) (void)xb_add(&bar[XB_XCNT(b.x)], 1u);
  return b;
}
DEV void xcd_barrier_complete(unsigned* bar, unsigned x, unsigned& nloc, unsigned& nx) {
  const unsigned G = gridDim.x * gridDim.y * gridDim.z;
  unsigned sum, cnt, mine, sp = 0u;
  for (;;) {
    sum = 0u; cnt = 0u; mine = 0u;
#pragma unroll
    for (unsigned j = 0; j < 16; ++j) { const unsigned c = xb_ld(&bar[XB_XCNT(j)]); sum += c; cnt += (c > 0u) ? 1u : 0u; mine = (j == x) ? c : mine; }
    if (sum == G) break;
    __builtin_amdgcn_s_sleep(1);
    if ((++sp & 255u) == 0u) { if (xb_ld(&bar[XB_TMO])) break; if (sp > XB_SPIN_CAP) { atomicAdd(&bar[XB_TMO], 1u); break; } }
  }
  nloc = mine > 0u ? mine : 1u; nx = cnt > 0u ? cnt : 1u;
}
DEV void xcd_barrier(const XcdBarrier& b) {
  asm volatile("s_waitcnt vmcnt(0)" ::: "memory");
  __syncthreads();
  if (threadIdx.x == 0) {
    unsigned* bar = b.bar;
    __builtin_amdgcn_s_waitcnt(0);
    unsigned nloc = b.st[0], nx = b.st[1];
    if (nloc == 0u) { xcd_barrier_complete(bar, b.x, nloc, nx); b.st[0] = nloc; b.st[1] = nx; }
    const unsigned old = xb_add(&bar[XB_XSUB(b.x)], 1u);
    const unsigned gen = old / nloc;
    if (old + 1u == (gen + 1u) * nloc) {
      __builtin_amdgcn_fence(__ATOMIC_RELEASE, "agent");
      asm volatile("s_waitcnt vmcnt(0)" ::: "memory");
      const unsigned og = xb_add(&bar[XB_TOP], 1u);
      const unsigned tg = og / nx;
      if (og + 1u == (tg + 1u) * nx) xb_add(&bar[XB_TOPGEN], 1u);
      else XB_SPIN(xb_ld(&bar[XB_TOPGEN]) == tg, bar);
      __builtin_amdgcn_fence(__ATOMIC_ACQUIRE, "agent");
      xb_add(&bar[XB_XGEN(b.x)], 1u);
      asm volatile("s_waitcnt vmcnt(0)" ::: "memory");
    } else {
      XB_SPIN(xb_ld(&bar[XB_XGEN(b.x)]) == gen, bar);
      __builtin_amdgcn_fence(__ATOMIC_ACQUIRE, "agent");
      asm volatile("s_waitcnt vmcnt(0)" ::: "memory");
    }
  }
  __syncthreads();
}

__global__ void __launch_bounds__(512, 2) mega(Params p_in, int ph_lo, int ph_hi) {
  extern __shared__ __attribute__((aligned(16))) char smem0[];
  char* smem = smem0 + vhalf() * SMEM_BYTES;
  cg::grid_group grid = cg::this_grid();
  const Params& p = p_in;
  bool first = true;
#define RUN(ph) if ((ph) >= ph_lo && (ph) < ph_hi)
  unsigned epoch = 0;
  __shared__ unsigned xb_words[4];
  if (threadIdx.x < 4) xb_words[threadIdx.x] = 0u;
  __syncthreads();
  XcdBarrier xb;
  xb.bar = p.counters + 256; xb.x = 0u; xb.st = (volatile LAS unsigned*)xb_words;
#define SYNC { if (!first) { ++epoch; if (epoch == 1) { grid.sync(); xb = xcd_barrier_post(p.counters + 256, (volatile LAS unsigned*)xb_words); } else xcd_barrier(xb); } first = false; }
  RUN(0) { SYNC; phase_prep(p, smem); }
#pragma unroll 1
  for (int l = 0; l < 2; ++l) {
    const int base = 1 + 9 * l;
    const float* ada_l = p.ada + (size_t)l * 32 * ADAW;
    const bf16_t* Wl = p.wt + (size_t)l * WLAYER;
    const float* xin = (l == 0) ? p.x : p.out;
    RUN(base + 0) { SYNC; phase_norm(xin, p.norm_mix_w + l * DM, ada_l, 0, 1024, p.h); }
    RUN(base + 1) { SYNC; phase_gemm_in(p, l, smem0); }
    RUN(base + 2) { if (l > 0) { SYNC; phase_vlo(p, l, smem); } }
    RUN(base + 3) { SYNC; phase_mix(p, l, smem); }
    RUN(base + 4) { SYNC; phase_merge(p, l, smem); }
    RUN(base + 5) { SYNC; phase_gemm_res(p.u + 1024, US, Wl + WOUT, DM, xin, p.out, ada_l, 2048, smem0); }
    RUN(base + 6) { SYNC; phase_norm(p.out, p.norm_ffn_w + l * DM, ada_l, 3072, 4096, p.h); }
    RUN(base + 7) { SYNC; phase_ffn_in(p, l, smem0); }
    RUN(base + 8) { SYNC; phase_gemm_res(p.u, FFH, Wl + WFO, FFH, p.out, p.out, ada_l, 5120, smem0); }
  }
  RUN(NPHASE - 1) { SYNC; phase_final(p.out, p.final_norm_w); }
}

extern "C" void kernel_launch(void* const* d_in, const int* in_sizes, int n_in, void* d_out, int out_size, void* d_ws,
                              size_t ws_size, hipStream_t stream) {
  Params p{};
  p.x = (const float*)d_in[0]; p.c = (const float*)d_in[1]; p.pos = (const int*)d_in[2];
  p.ada_w = (const float*)d_in[3]; p.ada_b = (const float*)d_in[4]; p.norm_mix_w = (const float*)d_in[5];
  p.norm_ffn_w = (const float*)d_in[6]; p.w_in = (const float*)d_in[7]; p.da_lambda = (const float*)d_in[8];
  p.da_subln_w = (const float*)d_in[9]; p.hg_lb = (const float*)d_in[10]; p.hg_norm_w = (const float*)d_in[11];
  p.rw_mu = (const float*)d_in[12]; p.rw_w0 = (const float*)d_in[13]; p.rw_w2 = (const float*)d_in[14];
  p.rw_a0 = (const float*)d_in[15]; p.rw_a2 = (const float*)d_in[16]; p.rw_g2 = (const float*)d_in[17];
  p.rw_k_k = (const float*)d_in[18]; p.rw_k_a = (const float*)d_in[19]; p.rw_r_k = (const float*)d_in[20];
  p.rw_gn_w = (const float*)d_in[21]; p.rw_gn_b = (const float*)d_in[22]; p.rw_v0 = (const float*)d_in[23];
  p.rw_v1 = (const float*)d_in[24]; p.rw_v2 = (const float*)d_in[25]; p.w_br_a = (const float*)d_in[26];
  p.w_br_b = (const float*)d_in[27]; p.w_br_c = (const float*)d_in[28]; p.w_out = (const float*)d_in[29];
  p.ffn_w_in = (const float*)d_in[30]; p.ffn_w_out = (const float*)d_in[31]; p.final_norm_w = (const float*)d_in[32];
  p.out = (float*)d_out;
  char* ws = (char*)d_ws;
  size_t off = 0;
  auto take = [&](size_t bytes) { char* r = ws + off; off += (bytes + 255) & ~(size_t)255; return r; };
  p.counters = (unsigned*)take(16384);
  p.wt = (bf16_t*)take(2 * WLAYER * 2);
  p.ada = (float*)take((size_t)2 * 32 * ADAW * 4);
  p.h = (bf16_t*)take((size_t)T_TOK * DM * 2);
  p.u = (bf16_t*)take((size_t)T_TOK * US * 2);
  p.vT = (bf16_t*)take((size_t)T_TOK * 512 * 2);
  p.vfirst = (bf16_t*)take((size_t)T_TOK * 512 * 2);
  p.vlo = (float*)take((size_t)T_TOK * 32 * 4);
  if (off > ws_size) { fprintf(stderr, "workspace too small: need %zu have %zu\n", off, ws_size); return; }

  static int grid_blocks = 0;
  if (!grid_blocks) {
    hipFuncSetAttribute((const void*)mega, hipFuncAttributeMaxDynamicSharedMemorySize, 2 * SMEM_BYTES);
    int dev = 0, cus = 0, per_cu = 0;
    hipGetDevice(&dev);
    hipDeviceGetAttribute(&cus, hipDeviceAttributeMultiprocessorCount, dev);
    hipOccupancyMaxActiveBlocksPerMultiprocessor(&per_cu, mega, 512, 2 * SMEM_BYTES);
    if (per_cu > 1) per_cu = 1;
    if (per_cu < 1) per_cu = 1;
    grid_blocks = cus * per_cu;
  }
#if SINGLE_LAUNCH
  int lo = 0, hi = NPHASE;
  void* args[] = {&p, &lo, &hi};
  hipError_t e = hipLaunchCooperativeKernel((void*)mega, dim3(grid_blocks), dim3(512), args, 2 * SMEM_BYTES, stream);
  if (e != hipSuccess) fprintf(stderr, "cooperative launch failed: %s (grid %d)\n", hipGetErrorString(e), grid_blocks);
#else
  for (int ph = 0; ph < NPHASE; ++ph) {
    if (ph == 3) continue;
    hipLaunchKernelGGL(mega, dim3(grid_blocks), dim3(512), 2 * SMEM_BYTES, stream, p, ph, ph + 1);
  }
#endif
}
```
